# Optimizing an MI355X kernel written in HIP

```python
import jax, jax.numpy as jnp
from jax import lax
import numpy as np

D_MODEL = 1024
BATCH = 8
SEQ = 8192
DEPTH = 2

GRID_W = 64
CTX_LEN = 256
M_HEADS = 4
M_HEAD_DIM = D_MODEL // 8
M_WIDTH = M_HEADS * M_HEAD_DIM
M_CONV = 5
MLSTM_CHUNK = 64
A_HEADS = 4
A_NOPE = D_MODEL // 8
A_ROPE = D_MODEL // 16
A_V = D_MODEL // 8
A_WIDTH = A_HEADS * A_V
Q_LORA = 3 * D_MODEL // 8
KV_LORA = D_MODEL // 4
A_SCALE = (A_NOPE + A_ROPE) ** -0.5
ROPE_BASE = 10000.0
Q_BLOCK = 128
MIX_WIDTH = M_WIDTH + A_WIDTH
OFF_Q = 0
OFF_K = M_WIDTH
OFF_V = 2 * M_WIDTH
OFF_O = 3 * M_WIDTH
OFF_G = 4 * M_WIDTH
OFF_CQ = OFF_G + 4 * M_HEADS
OFF_CKV = OFF_CQ + Q_LORA
OFF_KR = OFF_CKV + KV_LORA
IN_COLS = OFF_KR + A_ROPE
N_EXPERTS = 16
EXPERT_FF = D_MODEL
EC_CAPACITY = 2
ALPHA = (2 * DEPTH) ** 0.25
BETA = (8 * DEPTH) ** -0.25

kernel_name = 'hybrid_mlstm_mla_ecmoe_dit'


def layer_norm(x, eps=1e-6):
    xf = x.astype(jnp.float32)
    mu = jnp.mean(xf, axis=-1, keepdims=True)
    var = jnp.mean(jnp.square(xf - mu), axis=-1, keepdims=True)
    return ((xf - mu) * lax.rsqrt(var + eps)).astype(x.dtype)


def rms_norm(x, g, eps=1e-6):
    xf = x.astype(jnp.float32)
    return (xf * lax.rsqrt(jnp.mean(jnp.square(xf), axis=-1, keepdims=True) + eps)).astype(x.dtype) * g


def modulate(x, shift, scale):
    return layer_norm(x) * (1.0 + scale) + shift


def post_norm(x, y, g, b):
    return layer_norm(ALPHA * x + y, eps=1e-5) * g + b


def split_heads(a, nh):
    B, T, _ = a.shape
    return a.reshape(B, T, nh, -1).transpose(0, 2, 1, 3)


def flip_t(a):
    return jnp.flip(a, axis=2)


def short_conv(x, w, b):
    y = lax.conv_general_dilated(x, w[:, None, :].astype(x.dtype), window_strides=(1,), padding='SAME',
                                 dimension_numbers=('NWC', 'WIO', 'NWC'), feature_group_count=x.shape[-1])
    return jax.nn.silu(y + b)


def axial_rope(T):
    ROWS = T // GRID_W
    half = A_ROPE // 2
    inv = ROPE_BASE ** (-jnp.arange(0, half, 2, dtype=jnp.float32) / half)
    row = jnp.repeat(jnp.arange(ROWS, dtype=jnp.float32), GRID_W)
    col = jnp.tile(jnp.arange(GRID_W, dtype=jnp.float32), ROWS)
    ang = jnp.concatenate([row[:, None] * inv, col[:, None] * inv], axis=-1)
    return jnp.cos(ang), jnp.sin(ang)


def apply_rope(x, cos, sin):
    half = A_ROPE // 2
    cos = cos.astype(x.dtype)
    sin = sin.astype(x.dtype)
    x1, x2 = x[..., :half], x[..., half:]
    return jnp.concatenate([x1 * cos - x2 * sin, x2 * cos + x1 * sin], axis=-1)


def zero_state(B):
    f32 = jnp.float32
    return (jnp.zeros((B, M_HEADS, M_HEAD_DIM, M_HEAD_DIM), f32), jnp.zeros((B, M_HEADS, M_HEAD_DIM), f32),
            jnp.zeros((B, M_HEADS), f32))


def mlstm_chunkwise(q, k, v, i_pre, f_pre, state):
    B, H, T, DH = q.shape
    L = MLSTM_CHUNK
    nc = T // L
    f32 = jnp.float32

    def chunks(a):
        return jnp.moveaxis(a.reshape(a.shape[:2] + (nc, L) + a.shape[3:]), 2, 0)

    xs = (chunks(q.astype(f32) * DH ** -0.5), chunks(k.astype(f32)), chunks(v.astype(f32)),
          chunks(i_pre.astype(f32)), chunks(jax.nn.log_sigmoid(f_pre.astype(f32))))
    tri = jnp.tril(jnp.ones((L, L), dtype=bool))

    def step(carry, blk):
        C, n, m = carry
        qb, kb, vb, ig, lf = blk
        b = jnp.cumsum(lf, axis=-1)
        d_log = jnp.where(tri, b[..., :, None] - b[..., None, :] + ig[..., None, :], -jnp.inf)
        m_inter = b + m[..., None]
        m_t = jnp.maximum(jnp.max(d_log, axis=-1), m_inter)
        s = jnp.einsum('bhqd,bhkd->bhqk', qb, kb) * jnp.exp(d_log - m_t[..., None])
        w_inter = jnp.exp(m_inter - m_t)
        num = jnp.einsum('bhqk,bhkd->bhqd', s, vb) + w_inter[..., None] * jnp.einsum('bhqd,bhde->bhqe', qb, C)
        den = jnp.sum(s, axis=-1) + w_inter * jnp.einsum('bhqd,bhd->bhq', qb, n)
        h = num / jnp.maximum(jnp.abs(den), jnp.exp(-m_t))[..., None]
        g = b[..., -1:] - b + ig
        m_new = jnp.maximum(b[..., -1] + m, jnp.max(g, axis=-1))
        w_s = jnp.exp(g - m_new[..., None])
        decay = jnp.exp(b[..., -1] + m - m_new)
        C_new = decay[..., None, None] * C + jnp.einsum('bhl,bhld,bhle->bhde', w_s, kb, vb)
        n_new = decay[..., None] * n + jnp.einsum('bhl,bhld->bhd', w_s, kb)
        return (C_new, n_new, m_new), h

    state, hs = lax.scan(step, state, xs)
    h = jnp.moveaxis(hs, 0, 2).reshape(B, H, T, DH)
    return h.astype(q.dtype), state


def mlstm_final_state(k, v, i_pre, f_pre):
    kf, vf = k.astype(jnp.float32), v.astype(jnp.float32)
    b = jnp.cumsum(jax.nn.log_sigmoid(f_pre.astype(jnp.float32)), axis=-1)
    g = b[..., -1:] - b + i_pre.astype(jnp.float32)
    m = jnp.maximum(b[..., -1], jnp.max(g, axis=-1))
    w = jnp.exp(g - m[..., None])
    return (jnp.einsum('bht,bhtd,bhte->bhde', w, kf, vf), jnp.einsum('bht,bhtd->bhd', w, kf), m)


def mlstm_q_o(p, conv_w, conv_b):
    q = short_conv(p[..., OFF_Q:OFF_K], conv_w[:, :M_WIDTH], conv_b[:M_WIDTH])
    return split_heads(q, M_HEADS), p[..., OFF_O:OFF_G]


def mlstm_kv_gates(p, conv_w, conv_b, b_gates):
    B, T, _ = p.shape
    k = short_conv(p[..., OFF_K:OFF_V], conv_w[:, M_WIDTH:], conv_b[M_WIDTH:])
    v = p[..., OFF_V:OFF_O]
    g = (p[..., OFF_G:OFF_CQ] + b_gates).reshape(B, T, 4, M_HEADS).transpose(2, 0, 3, 1)
    return split_heads(k, M_HEADS), split_heads(v, M_HEADS), g[0], g[1], g[2], g[3]


def mlstm_merge(h_f, h_b, o, norm_w):
    h = layer_norm(h_f + h_b)
    B, H, T, DH = h.shape
    h = h.transpose(0, 2, 1, 3).reshape(B, T, H * DH)
    return h * norm_w * jax.nn.sigmoid(o)


def mla_q(p, q_norm_w, w_uq):
    B, T, _ = p.shape
    cq = rms_norm(p[..., OFF_CQ:OFF_CKV], q_norm_w)
    q = jnp.einsum('btr,rc->btc', cq, w_uq).reshape(B, T, A_HEADS, A_NOPE + A_ROPE).transpose(0, 2, 1, 3)
    return q[..., :A_NOPE], q[..., A_NOPE:]


def mla_kv(p, kv_norm_w, w_ukv):
    B, T, _ = p.shape
    ckv = rms_norm(p[..., OFF_CKV:OFF_KR], kv_norm_w)
    kv = jnp.einsum('btr,rc->btc', ckv, w_ukv).reshape(B, T, A_HEADS, A_NOPE + A_V).transpose(0, 2, 1, 3)
    return kv[..., :A_NOPE], p[..., OFF_KR:IN_COLS], kv[..., A_NOPE:]


def mla_attend(qn, qr, kn, kr, v):
    s = (jnp.einsum('bhqd,bhkd->bhqk', qn, kn, preferred_element_type=jnp.float32)
         + jnp.einsum('bhqr,bkr->bhqk', qr, kr, preferred_element_type=jnp.float32)) * A_SCALE
    p = jax.nn.softmax(s, axis=-1)
    return jnp.einsum('bhqk,bhkd->bhqd', p.astype(v.dtype), v)


def mla_blocked(qn, qr, kn, kr, v):
    B, H, T, _ = qn.shape
    nb = T // Q_BLOCK

    def blocks(a):
        return jnp.moveaxis(a.reshape(B, H, nb, Q_BLOCK, a.shape[-1]), 2, 0)

    out = lax.map(lambda qs: mla_attend(qs[0], qs[1], kn, kr, v), (blocks(qn), blocks(qr)))
    return jnp.moveaxis(out, 0, 2).reshape(B, H, T, -1)


def heads_to_tokens(a):
    B, H, T, D = a.shape
    return a.transpose(0, 2, 1, 3).reshape(B, T, H * D)


def token_mixer(h_x, h_c, cos, sin, w_in, b_gates, conv_w, conv_b, m_norm_w, q_norm_w, kv_norm_w,
                w_uq, w_ukv, w_out, ctx_out):
    p_x = jnp.einsum('btd,dc->btc', h_x, w_in)
    p_c = jnp.einsum('btd,dc->btc', h_c, w_in)
    k_c, v_c, if_c, ff_c, ib_c, fb_c = mlstm_kv_gates(p_c, conv_w, conv_b, b_gates)
    if ctx_out:
        q_c, o_c = mlstm_q_o(p_c, conv_w, conv_b)
        h_cf, st_f = mlstm_chunkwise(q_c, k_c, v_c, if_c, ff_c, zero_state(h_c.shape[0]))
        h_cb, st_b = mlstm_chunkwise(flip_t(q_c), flip_t(k_c), flip_t(v_c), flip_t(ib_c), flip_t(fb_c),
                                     zero_state(h_c.shape[0]))
        m_out_c = mlstm_merge(h_cf, flip_t(h_cb), o_c, m_norm_w)
    else:
        st_f = mlstm_final_state(k_c, v_c, if_c, ff_c)
        st_b = mlstm_final_state(flip_t(k_c), flip_t(v_c), flip_t(ib_c), flip_t(fb_c))
    q_x, o_x = mlstm_q_o(p_x, conv_w, conv_b)
    k_x, v_x, if_x, ff_x, ib_x, fb_x = mlstm_kv_gates(p_x, conv_w, conv_b, b_gates)
    h_xf, _ = mlstm_chunkwise(q_x, k_x, v_x, if_x, ff_x, st_f)
    h_xb, _ = mlstm_chunkwise(flip_t(q_x), flip_t(k_x), flip_t(v_x), flip_t(ib_x), flip_t(fb_x), st_b)
    m_out_x = mlstm_merge(h_xf, flip_t(h_xb), o_x, m_norm_w)
    kn_c, kr_c, va_c = mla_kv(p_c, kv_norm_w, w_ukv)
    qn_x, qr_x = mla_q(p_x, q_norm_w, w_uq)
    kn_x, kr_x, va_x = mla_kv(p_x, kv_norm_w, w_ukv)
    qr_x = apply_rope(qr_x, cos, sin)
    kr_x = apply_rope(kr_x, cos, sin)
    kn_all = jnp.concatenate([kn_c, kn_x], axis=2)
    kr_all = jnp.concatenate([kr_c, kr_x], axis=1)
    va_all = jnp.concatenate([va_c, va_x], axis=2)
    a_out_x = heads_to_tokens(mla_blocked(qn_x, qr_x, kn_all, kr_all, va_all))
    y_x = jnp.einsum('btc,cd->btd', jnp.concatenate([m_out_x, a_out_x], axis=-1), w_out)
    if ctx_out:
        qn_c, qr_c = mla_q(p_c, q_norm_w, w_uq)
        a_out_c = heads_to_tokens(mla_attend(qn_c, qr_c, kn_c, kr_c, va_c))
        y_c = jnp.einsum('btc,cd->btd', jnp.concatenate([m_out_c, a_out_c], axis=-1), w_out)
        return y_x, y_c
    return y_x, None


def ec_moe(h, w_router, w_gate, w_up, w_down):
    B, n, D = h.shape
    cap = EC_CAPACITY * n // N_EXPERTS
    aff = jax.nn.softmax(jnp.einsum('bnd,de->bne', h, w_router, preferred_element_type=jnp.float32), axis=-1)
    gate, idx = lax.top_k(aff.transpose(0, 2, 1), cap)
    flat = idx.reshape(B, N_EXPERTS * cap)
    xin = jnp.take_along_axis(h, flat[..., None], axis=1).reshape(B, N_EXPERTS, cap, D)
    act = jax.nn.silu(jnp.einsum('becd,edf->becf', xin, w_gate)) * jnp.einsum('becd,edf->becf', xin, w_up)
    out = jnp.einsum('becf,efd->becd', act, w_down) * gate[..., None].astype(h.dtype)
    return jax.vmap(lambda o, i: jnp.zeros((n, D), o.dtype).at[i].add(o))(out.reshape(B, N_EXPERTS * cap, D), flat)


def setup_inputs(seed: int = 0) -> dict:
    key = jax.random.key(seed)
    ks = jax.random.split(key, 24)
    f32 = jnp.float32
    L = DEPTH

    def nrm(k, shape, scale):
        return jax.random.normal(k, shape, f32) * scale

    gate_base = jnp.concatenate([jnp.zeros((M_HEADS,), f32), jnp.linspace(3.0, 6.0, M_HEADS, dtype=f32),
                                 jnp.zeros((M_HEADS,), f32), jnp.linspace(3.0, 6.0, M_HEADS, dtype=f32)])
    return {
        'x': nrm(ks[0], (BATCH, SEQ, D_MODEL), 1.0),
        'c': nrm(ks[1], (BATCH, D_MODEL), 1.0),
        'ctx': nrm(ks[2], (BATCH, CTX_LEN, D_MODEL), 1.0),
        'c_ctx': nrm(ks[3], (D_MODEL,), 1.0),
        'w_mod': nrm(ks[4], (L, D_MODEL, 6 * D_MODEL), 0.5 * D_MODEL ** -0.5),
        'b_mod': nrm(ks[5], (L, 6 * D_MODEL), 0.02),
        'w_in': nrm(ks[6], (L, D_MODEL, IN_COLS), D_MODEL ** -0.5),
        'b_gates': gate_base + nrm(ks[7], (L, 4 * M_HEADS), 0.1),
        'conv_w': nrm(ks[8], (L, M_CONV, 2 * M_WIDTH), M_CONV ** -0.5),
        'conv_b': nrm(ks[9], (L, 2 * M_WIDTH), 0.02),
        'm_norm_w': 1.0 + nrm(ks[10], (L, M_WIDTH), 0.1),
        'q_norm_w': 1.0 + nrm(ks[11], (L, Q_LORA), 0.1),
        'kv_norm_w': 1.0 + nrm(ks[12], (L, KV_LORA), 0.1),
        'w_uq': nrm(ks[13], (L, Q_LORA, A_HEADS * (A_NOPE + A_ROPE)), Q_LORA ** -0.5),
        'w_ukv': nrm(ks[14], (L, KV_LORA, A_HEADS * (A_NOPE + A_V)), KV_LORA ** -0.5),
        'w_out': nrm(ks[15], (L, MIX_WIDTH, D_MODEL), BETA * MIX_WIDTH ** -0.5),
        'ln1_g': 1.0 + nrm(ks[16], (L, D_MODEL), 0.1),
        'ln1_b': nrm(ks[17], (L, D_MODEL), 0.02),
        'w_router': nrm(ks[18], (L, D_MODEL, N_EXPERTS), D_MODEL ** -0.5),
        'w_gate': nrm(ks[19], (L, N_EXPERTS, D_MODEL, EXPERT_FF), D_MODEL ** -0.5),
        'w_up': nrm(ks[20], (L, N_EXPERTS, D_MODEL, EXPERT_FF), D_MODEL ** -0.5),
        'w_down': nrm(ks[21], (L, N_EXPERTS, EXPERT_FF, D_MODEL), BETA * EXPERT_FF ** -0.5),
        'ln2_g': 1.0 + nrm(ks[22], (L, D_MODEL), 0.1),
        'ln2_b': nrm(ks[23], (L, D_MODEL), 0.02),
    }


def reference(x, c, ctx, c_ctx, w_mod, b_mod, w_in, b_gates, conv_w, conv_b, m_norm_w, q_norm_w, kv_norm_w,
              w_uq, w_ukv, w_out, ln1_g, ln1_b, w_router, w_gate, w_up, w_down, ln2_g, ln2_b):
    cos, sin = axial_rope(x.shape[1])
    for l in range(DEPTH):
        ctx_out = l < DEPTH - 1
        mx = jnp.split((jnp.einsum('bd,dc->bc', jax.nn.silu(c), w_mod[l]) + b_mod[l])[:, None, :], 6, axis=-1)
        mc = jnp.split((jnp.einsum('d,dc->c', jax.nn.silu(c_ctx), w_mod[l]) + b_mod[l])[None, None, :], 6, axis=-1)
        h_x = modulate(x, mx[0], mx[1])
        h_c = modulate(ctx, mc[0], mc[1])
        y_x, y_c = token_mixer(h_x, h_c, cos, sin, w_in[l], b_gates[l], conv_w[l], conv_b[l], m_norm_w[l],
                               q_norm_w[l], kv_norm_w[l], w_uq[l], w_ukv[l], w_out[l], ctx_out)
        x = post_norm(x, mx[2] * y_x, ln1_g[l], ln1_b[l])
        x = post_norm(x, mx[5] * ec_moe(modulate(x, mx[3], mx[4]), w_router[l], w_gate[l], w_up[l], w_down[l]),
                      ln2_g[l], ln2_b[l])
        if ctx_out:
            ctx = post_norm(ctx, mc[2] * y_c, ln1_g[l], ln1_b[l])
            ctx = post_norm(ctx, mc[5] * ec_moe(modulate(ctx, mc[3], mc[4]), w_router[l], w_gate[l], w_up[l],
                                                w_down[l]), ln2_g[l], ln2_b[l])
    return x
```

```cpp
#include <hip/hip_runtime.h>
#include <hip/hip_cooperative_groups.h>
#include <cstdio>
#include <cstdint>
namespace cg = cooperative_groups;
#ifndef DBG_BAR
#define DBG_BAR 0
#endif
#ifndef DBG_STOP
#define DBG_STOP 99
#endif

typedef unsigned short bf16_t;
typedef short bf16x8 __attribute__((ext_vector_type(8)));
typedef short s16x4 __attribute__((ext_vector_type(4)));
typedef float f32x4 __attribute__((ext_vector_type(4)));
typedef float f32x16 __attribute__((ext_vector_type(16)));
typedef unsigned u32x4 __attribute__((ext_vector_type(4)));
typedef unsigned u32x2 __attribute__((ext_vector_type(2)));
#define LAS __attribute__((address_space(3)))

constexpr int DM = 1024, NB = 8, SEQ = 8192, CTXL = 256, DEPTH = 2;
constexpr int MX = NB * SEQ, MC = NB * CTXL, MT = MX + MC;
constexpr int PLD = 2816;
constexpr int OFF_Q = 0, OFF_K = 512, OFF_V = 1024, OFF_O = 1536, OFF_G = 2048, OFF_CQ = 2064, OFF_CKV = 2448, OFF_KR = 2704, IN_COLS = 2768;
constexpr int SKV = SEQ + CTXL;
constexpr int NE = 16, CAPX = 1024, CAPC = 32;
constexpr int NSLOT = NB * NE * CAPX + NB * NE * CAPC;
constexpr float ALPHA = 1.4142135623730951f;
constexpr float A_SCALE = 0.07216878364870322f;

constexpr size_t al256(size_t v) { return (v + 255) / 256 * 256; }
constexpr size_t WS_H = 0;
constexpr size_t WS_P = WS_H + al256((size_t)MT * 1024 * 2);
constexpr size_t WS_Q = WS_P + al256((size_t)MT * PLD * 2);
constexpr size_t WS_KV = WS_Q + al256((size_t)MT * 768 * 2);
constexpr size_t WS_KR = WS_KV + al256((size_t)NB * SKV * 1024 * 2);
constexpr size_t WS_MIX = WS_KR + al256((size_t)NB * SKV * 64 * 2);
constexpr size_t WS_ACT = WS_P;
constexpr size_t WS_HB = WS_H;
constexpr size_t WS_OUTE = WS_P + al256((size_t)NSLOT * 1024 * 2);
constexpr size_t WS_WGU = WS_MIX;
constexpr size_t WS_WDN = WS_MIX + (size_t)NE * 2048 * 1024 * 2;
constexpr size_t WS_WIN = WS_MIX + al256((size_t)MT * 1024 * 2);
constexpr size_t WS_WUQ = WS_WIN + (size_t)2 * PLD * 1024 * 2;
constexpr size_t WS_WUKV = WS_WUQ + (size_t)2 * 768 * 384 * 2;
constexpr size_t WS_WOUT = WS_WUKV + (size_t)2 * 1024 * 256 * 2;
constexpr size_t WS_MOD = WS_WOUT + (size_t)2 * 1024 * 1024 * 2;
constexpr size_t WS_COS = WS_MOD + al256((size_t)2 * 9 * 6144 * 4);
constexpr size_t WS_SIN = WS_COS + (size_t)SEQ * 32 * 4;
constexpr size_t WS_GATES = WS_SIN + (size_t)SEQ * 32 * 4;
constexpr size_t WS_AFF = WS_GATES + (size_t)MT * 16 * 4;
constexpr size_t WS_IDX = WS_AFF + (size_t)MT * 16 * 4;
constexpr size_t WS_GV = WS_IDX + (size_t)NSLOT * 4;
constexpr size_t WS_TS = WS_GV + (size_t)NSLOT * 4;
constexpr size_t WS_CTXZ = WS_TS + (size_t)MT * 16 * 4;
constexpr size_t WS_END = WS_CTXZ + (size_t)MC * 1024 * 4;
static_assert(WS_OUTE + (size_t)NSLOT * 1024 * 2 <= WS_KR, "out_e overlay");
static_assert(WS_WDN + (size_t)NE * 1024 * 1024 * 2 <= WS_WIN, "expert weights overlay");

struct Params {
  const float *x, *c, *ctx, *c_ctx, *w_mod, *b_mod, *w_in, *b_gates, *conv_w, *conv_b, *m_norm_w, *q_norm_w, *kv_norm_w, *w_uq, *w_ukv, *w_out,
      *ln1_g, *ln1_b, *w_router, *w_gate, *w_up, *w_down, *ln2_g, *ln2_b;
  float* out; char* ws;
};

typedef const __attribute__((address_space(4))) Params& PRef;
__device__ __forceinline__ PRef kparams() { const __attribute__((address_space(4))) Params* kp = (const __attribute__((address_space(4))) Params*)__builtin_amdgcn_kernarg_segment_ptr(); asm volatile("" : "+s"(kp)); return *kp; }
__device__ __forceinline__ int otid() { int t = threadIdx.x; asm volatile("" : "+v"(t)); return t; }
__device__ __forceinline__ int obid() { int t = blockIdx.x; asm volatile("" : "+s"(t)); return t; }
__device__ __forceinline__ int opaque_s(int v) { asm volatile("" : "+s"(v)); return v; }
typedef __bf16 bf16v2_t __attribute__((ext_vector_type(2)));
typedef float f32x2_t __attribute__((ext_vector_type(2)));
__device__ __forceinline__ unsigned cvtpk(float lo, float hi) { const f32x2_t f = {lo, hi}; const bf16v2_t b = __builtin_convertvector(f, bf16v2_t); return __builtin_bit_cast(unsigned, b); }
__device__ __forceinline__ bf16_t f2bf(float v) { return (bf16_t)(cvtpk(v, v) & 0xffffu); }
__device__ __forceinline__ float bf2f(unsigned v) { return __uint_as_float(v << 16); }
__device__ __forceinline__ float bflo(unsigned w) { return __uint_as_float(w << 16); }
__device__ __forceinline__ float bfhi(unsigned w) { return __uint_as_float(w & 0xffff0000u); }
__device__ __forceinline__ float wave_sum(float v) { for (int o = 32; o > 0; o >>= 1) v += __shfl_xor(v, o); return v; }
__device__ __forceinline__ float wave_max(float v) { for (int o = 32; o > 0; o >>= 1) v = fmaxf(v, __shfl_xor(v, o)); return v; }
__device__ __forceinline__ float silu_f(float v) { return v / (1.f + __expf(-v)); }
__device__ __forceinline__ float sigmoid_f(float v) { return 1.f / (1.f + __expf(-v)); }

namespace g8 {
constexpr int BK = 64, HALF = 128, HTB = HALF * BK * 2, STAGE_BYTES = 8 * HTB;
__device__ __forceinline__ int lds_byte(int r, int c) { const int st = (r >> 4) * 2 + (c >> 5), rr = r & 15, cc = c & 31, ob = rr * 64 + cc * 2; return st * 1024 + (ob ^ (((ob >> 9) & 1) << 5)); }
__device__ __forceinline__ void stage_rc(int b, int& R, int& C) { const int st = b / 1024, sb = b % 1024, swz = sb ^ (((sb >> 9) & 1) << 5); R = (st >> 1) * 16 + swz / 64; C = (st & 1) * 32 + (swz % 64) / 2; }

template <bool GATHER>
__device__ __forceinline__ void gemm_tile(LAS unsigned char* lds, const char* __restrict__ Ab, const unsigned (&voffA)[GATHER ? 4 : 2], size_t hstepA, const char* __restrict__ Bb, int K,
                                          f32x4 (&acc)[2][2][4][2]) {
  const int tid = otid(), wid = __builtin_amdgcn_readfirstlane(tid >> 6), lane = tid & 63, wr = wid >> 2, wc = wid & 3, fr = lane & 15, fq = lane >> 4;
  const int nt = K / BK;
  unsigned voffB[2];
#pragma unroll
  for (int i = 0; i < 2; ++i) { int R, C; stage_rc(tid * 16 + i * 8192, R, C); voffB[i] = (unsigned)(R * K + C) * 2u; }
  const char* Bb1 = Bb + (size_t)HALF * K * 2; const char* Ab1 = GATHER ? Ab : Ab + hstepA;
  const unsigned* vA0 = &voffA[0]; const unsigned* vA1 = GATHER ? &voffA[2] : &voffA[0];
  const unsigned ldsw = (unsigned)wid * 1024u;
  const int aoff = lds_byte(wr * 64 + fr, fq * 8), boff = lds_byte(wc * 32 + fr, fq * 8);
#define G8_SA(b, h) (((b) * 2 + (h)) * HTB)
#define G8_SB(b, h) ((4 + (b) * 2 + (h)) * HTB)
#define G8_STAGE(bufoff, gbase, voff, kt) do { _Pragma("unroll") for (int _i = 0; _i < 2; ++_i) \
    __builtin_amdgcn_global_load_lds((const unsigned*)((gbase) + (size_t)(kt) * (BK * 2) + (voff)[_i]), (LAS unsigned*)(lds + (bufoff) + ldsw + _i * 8192), 16, 0, 0); } while (0)
#define G8_LDA(dst, b, h) do { _Pragma("unroll") for (int m = 0; m < 4; ++m) _Pragma("unroll") for (int k = 0; k < 2; ++k) dst[m][k] = *(const LAS bf16x8*)(lds + G8_SA(b, h) + aoff + m * 2048 + k * 1024); } while (0)
#define G8_LDB(dst, b, h) do { _Pragma("unroll") for (int n = 0; n < 2; ++n) _Pragma("unroll") for (int k = 0; k < 2; ++k) dst[n][k] = *(const LAS bf16x8*)(lds + G8_SB(b, h) + boff + n * 2048 + k * 1024); } while (0)
#define G8_MMA(ai, bj, At, Bt) do { __builtin_amdgcn_s_setprio(1); _Pragma("unroll") for (int m = 0; m < 4; ++m) _Pragma("unroll") for (int n = 0; n < 2; ++n) _Pragma("unroll") for (int k = 0; k < 2; ++k) \
    acc[ai][bj][m][n] = __builtin_amdgcn_mfma_f32_16x16x32_bf16(Bt[n][k], At[m][k], acc[ai][bj][m][n], 0, 0, 0); __builtin_amdgcn_s_setprio(0); } while (0)
#define G8_WAIT_V(n) asm volatile("s_waitcnt vmcnt(" #n ")" ::: "memory")
#define G8_WAIT_L(n) asm volatile("s_waitcnt lgkmcnt(" #n ")" ::: "memory")
#define G8_BAR __builtin_amdgcn_s_barrier()
#define G8_SCHED __builtin_amdgcn_sched_barrier(0)
#pragma unroll
  for (int a = 0; a < 2; ++a)
#pragma unroll
    for (int b = 0; b < 2; ++b)
#pragma unroll
      for (int m = 0; m < 4; ++m)
#pragma unroll
        for (int n = 0; n < 2; ++n) acc[a][b][m][n] = (f32x4){0.f, 0.f, 0.f, 0.f};
  bf16x8 At[4][2], B0[2][2], B1[2][2];
  G8_WAIT_V(0); __syncthreads();
  G8_STAGE(G8_SB(0, 0), Bb, voffB, 0); G8_STAGE(G8_SA(0, 0), Ab, vA0, 0); G8_STAGE(G8_SB(0, 1), Bb1, voffB, 0); G8_STAGE(G8_SA(0, 1), Ab1, vA1, 0);
  if (wr == 1) G8_BAR;
  G8_WAIT_V(4); G8_BAR;
  G8_STAGE(G8_SB(1, 0), Bb, voffB, 1); G8_STAGE(G8_SA(1, 0), Ab, vA0, 1); G8_STAGE(G8_SB(1, 1), Bb1, voffB, 1);
  G8_WAIT_V(6); G8_BAR;
  for (int t = 0; t < nt - 2; t += 2) {
    G8_LDB(B0, 0, 0); G8_SCHED; G8_LDA(At, 0, 0); G8_STAGE(G8_SA(1, 1), Ab1, vA1, t + 1);
    G8_WAIT_L(8); G8_BAR; G8_WAIT_L(0); G8_MMA(0, 0, At, B0); G8_BAR; G8_SCHED;
    G8_LDB(B1, 0, 1); G8_STAGE(G8_SB(0, 0), Bb, voffB, t + 2);
    G8_BAR; G8_WAIT_L(0); G8_MMA(0, 1, At, B1); G8_BAR;
    G8_LDA(At, 0, 1); G8_STAGE(G8_SA(0, 0), Ab, vA0, t + 2);
    G8_BAR; G8_WAIT_L(0); G8_MMA(1, 0, At, B0); G8_BAR; G8_SCHED;
    G8_STAGE(G8_SB(0, 1), Bb1, voffB, t + 2);
    G8_WAIT_V(6); G8_BAR; G8_MMA(1, 1, At, B1); G8_BAR;
    G8_LDB(B0, 1, 0); G8_SCHED; G8_LDA(At, 1, 0); G8_STAGE(G8_SA(0, 1), Ab1, vA1, t + 2);
    G8_WAIT_L(8); G8_BAR; G8_WAIT_L(0); G8_MMA(0, 0, At, B0); G8_BAR; G8_SCHED;
    G8_LDB(B1, 1, 1); G8_STAGE(G8_SB(1, 0), Bb, voffB, t + 3);
    G8_BAR; G8_WAIT_L(0); G8_MMA(0, 1, At, B1); G8_BAR;
    G8_LDA(At, 1, 1); G8_STAGE(G8_SA(1, 0), Ab, vA0, t + 3);
    G8_BAR; G8_WAIT_L(0); G8_MMA(1, 0, At, B0); G8_BAR; G8_SCHED;
    G8_STAGE(G8_SB(1, 1), Bb1, voffB, t + 3);
    G8_WAIT_V(6); G8_BAR; G8_MMA(1, 1, At, B1); G8_BAR;
  }
  { G8_LDB(B0, 0, 0); G8_LDA(At, 0, 0); G8_STAGE(G8_SA(1, 1), Ab1, vA1, nt - 1);
    G8_BAR; G8_WAIT_L(0); G8_MMA(0, 0, At, B0); G8_BAR;
    G8_LDB(B1, 0, 1); G8_BAR; G8_WAIT_L(0); G8_MMA(0, 1, At, B1); G8_BAR;
    G8_LDA(At, 0, 1); G8_WAIT_V(4); G8_BAR; G8_WAIT_L(0); G8_MMA(1, 0, At, B0); G8_MMA(1, 1, At, B1); G8_BAR; }
  { G8_LDB(B0, 1, 0); G8_LDA(At, 1, 0); G8_WAIT_V(2); G8_BAR; G8_WAIT_L(0); G8_MMA(0, 0, At, B0); G8_BAR;
    G8_LDB(B1, 1, 1); G8_WAIT_V(0); G8_BAR; G8_WAIT_L(0); G8_MMA(0, 1, At, B1); G8_BAR;
    G8_LDA(At, 1, 1); G8_BAR; G8_WAIT_L(0); G8_MMA(1, 0, At, B0); G8_MMA(1, 1, At, B1); G8_BAR; }
  if (wr == 0) G8_BAR;
}
__device__ __forceinline__ unsigned piece_off(int i, int ld, int c0) { int R, C; stage_rc((int)otid() * 16 + i * 8192, R, C); return (unsigned)(R * ld + c0 + C) * 2u; }
__device__ __forceinline__ void piece_rc(int i, int& R, int& C) { stage_rc((int)otid() * 16 + i * 8192, R, C); }
struct TileIter {
  int nM, nN, x, j, J, cnt, idx;
  __device__ __forceinline__ void init(int nM_, int nN_) { nM = nM_; nN = nN_; x = obid() & 7; j = obid() >> 3; J = gridDim.x >> 3; cnt = ((nM - x + 7) >> 3) * nN; idx = j; }
  __device__ __forceinline__ bool next(int& pm, int& pn) { if (idx >= cnt) return false; pm = x + 8 * (idx / nN); pn = idx % nN; idx += J; return true; }
};
}

#define ACC_FOR(ai, bj, m, n) _Pragma("unroll") for (int ai = 0; ai < 2; ++ai) _Pragma("unroll") for (int bj = 0; bj < 2; ++bj) _Pragma("unroll") for (int m = 0; m < 4; ++m) _Pragma("unroll") for (int n = 0; n < 2; ++n)

__device__ __forceinline__ void cvt_tile(const float* __restrict__ src, int N, int K, int k0, int n0, bf16_t* __restrict__ dst, long drow0, const float* __restrict__ kscale, float* lds) {
  const int tid = otid();
  { const int kr = tid >> 6, n = tid & 63;
#pragma unroll
    for (int i = 0; i < 8; ++i) { const int k = kr + 8 * i; float v = (n0 + n < N) ? src[(size_t)(k0 + k) * N + n0 + n] : 0.f; if (kscale) v *= kscale[k0 + k]; lds[k * 65 + n] = v; } }
  __syncthreads();
  { const int n = tid >> 3, k8 = (tid & 7) * 8; float v[8];
#pragma unroll
    for (int i = 0; i < 8; ++i) v[i] = lds[(k8 + i) * 65 + n];
    u32x4 w = {cvtpk(v[0], v[1]), cvtpk(v[2], v[3]), cvtpk(v[4], v[5]), cvtpk(v[6], v[7])};
    *(u32x4*)(dst + (size_t)(drow0 + n) * K + k0 + k8) = w; }
  __syncthreads();
}

__device__ void phase_prep(PRef p, char* smem) {
  float* lds = (float*)smem;
  bf16_t* Wt_in = (bf16_t*)(p.ws + WS_WIN); bf16_t* Wt_uq = (bf16_t*)(p.ws + WS_WUQ); bf16_t* Wt_ukv = (bf16_t*)(p.ws + WS_WUKV); bf16_t* Wt_out = (bf16_t*)(p.ws + WS_WOUT);
  float* mod = (float*)(p.ws + WS_MOD);
  constexpr int T_MOD = 192, T_IN = 2 * 16 * 44, T_UQ = 2 * 6 * 12, T_UKV = 2 * 4 * 16, T_OUT = 2 * 16 * 16, T_ROPE = 64;
  constexpr int E0 = T_MOD, E1 = E0 + T_IN, E2 = E1 + T_UQ, E3 = E2 + T_UKV, E4 = E3 + T_OUT, E5 = E4 + T_ROPE;
  const int tid = otid();
  for (int task = obid(); task < E5; task += gridDim.x) {
    if (task < E0) {
      const int l = task / 96, j0 = (task % 96) * 64;
      float* sc = lds;
      for (int i = tid; i < 9 * 1024; i += 512) { const int bb = i >> 10, d = i & 1023; const float v = bb < 8 ? p.c[bb * 1024 + d] : p.c_ctx[d]; sc[i] = v / (1.f + expf(-v)); }
      __syncthreads();
      const int col = tid & 63, ks = tid >> 6; float a[9];
#pragma unroll
      for (int bb = 0; bb < 9; ++bb) a[bb] = 0.f;
      const float* wm = p.w_mod + (size_t)l * 1024 * 6144 + j0 + col;
      for (int d = ks * 128; d < ks * 128 + 128; ++d) { const float w = wm[(size_t)d * 6144];
#pragma unroll
        for (int bb = 0; bb < 9; ++bb) a[bb] += sc[bb * 1024 + d] * w; }
      float* red = lds + 9 * 1024;
#pragma unroll
      for (int bb = 0; bb < 9; ++bb) red[(ks * 9 + bb) * 64 + col] = a[bb];
      __syncthreads();
      for (int i = tid; i < 9 * 64; i += 512) { const int bb = i >> 6, cc = i & 63; float s = 0.f;
        for (int k = 0; k < 8; ++k) s += red[(k * 9 + bb) * 64 + cc];
        mod[((size_t)l * 9 + bb) * 6144 + j0 + cc] = s + p.b_mod[l * 6144 + j0 + cc]; }
      __syncthreads();
    } else if (task < E1) { const int t = task - E0, l = t / 704, r = t % 704, kt = r / 44, nt = r % 44;
      cvt_tile(p.w_in + (size_t)l * 1024 * IN_COLS, IN_COLS, 1024, kt * 64, nt * 64, Wt_in + (size_t)l * PLD * 1024, nt * 64, nullptr, lds);
    } else if (task < E2) { const int t = task - E1, l = t / 72, r = t % 72, kt = r / 12, nt = r % 12;
      cvt_tile(p.w_uq + (size_t)l * 384 * 768, 768, 384, kt * 64, nt * 64, Wt_uq + (size_t)l * 768 * 384, nt * 64, p.q_norm_w + l * 384, lds);
    } else if (task < E3) { const int t = task - E2, l = t / 64, r = t % 64, kt = r / 16, nt = r % 16;
      cvt_tile(p.w_ukv + (size_t)l * 256 * 1024, 1024, 256, kt * 64, nt * 64, Wt_ukv + (size_t)l * 1024 * 256, nt * 64, p.kv_norm_w + l * 256, lds);
    } else if (task < E4) { const int t = task - E3, l = t / 256, r = t % 256, kt = r / 16, nt = r % 16;
      cvt_tile(p.w_out + (size_t)l * 1024 * 1024, 1024, 1024, kt * 64, nt * 64, Wt_out + (size_t)l * 1024 * 1024, nt * 64, nullptr, lds);
    } else {
      float* cs = (float*)(p.ws + WS_COS); float* sn = (float*)(p.ws + WS_SIN);
      for (int i = (task - E4) * 4096 + tid; i < (task - E4 + 1) * 4096; i += 512) { const int t = i >> 5, j = i & 31;
        const float inv = exp2f(-(float)(j & 15) * (13.287712379549449f / 16.f));
        const float pos = (float)(j < 16 ? (t >> 6) : (t & 63)); const float ang = pos * inv;
        const double a = (double)ang; const double k = rint(a * 0.15915494309189535); const float r = (float)(a - k * 6.283185307179586);
        cs[i] = __cosf(r); sn[i] = __sinf(r); }
    }
  }
}

__device__ void phase_cvt_experts(PRef p, int l, char* smem) {
  float* lds = (float*)smem;
  bf16_t* Wgu = (bf16_t*)(p.ws + WS_WGU); bf16_t* Wdn = (bf16_t*)(p.ws + WS_WDN);
  for (int task = obid(); task < NE * 768; task += gridDim.x) {
    const int e = task / 768, r = task % 768, which = r >> 8, kt = (r & 255) >> 4, nt = r & 15, n0 = nt * 64;
    const size_t eo = ((size_t)l * NE + e) * 1024 * 1024;
    if (which == 0) cvt_tile(p.w_gate + eo, 1024, 1024, kt * 64, n0, Wgu + (size_t)e * 2048 * 1024, (n0 >> 7) * 256 + (n0 & 127), nullptr, lds);
    else if (which == 1) cvt_tile(p.w_up + eo, 1024, 1024, kt * 64, n0, Wgu + (size_t)e * 2048 * 1024, (n0 >> 7) * 256 + 128 + (n0 & 127), nullptr, lds);
    else cvt_tile(p.w_down + eo, 1024, 1024, kt * 64, n0, Wdn + (size_t)e * 1024 * 1024, n0, nullptr, lds);
  }
}

__device__ __forceinline__ void ln_row(f32x4 (&v)[4], float eps) {
  float s = 0.f;
#pragma unroll
  for (int i = 0; i < 4; ++i) s += v[i][0] + v[i][1] + v[i][2] + v[i][3];
  const float mu = wave_sum(s) * (1.f / 1024.f);
  float q = 0.f;
#pragma unroll
  for (int i = 0; i < 4; ++i)
#pragma unroll
    for (int k = 0; k < 4; ++k) { v[i][k] -= mu; q += v[i][k] * v[i][k]; }
  const float rs = rsqrtf(wave_sum(q) * (1.f / 1024.f) + eps);
#pragma unroll
  for (int i = 0; i < 4; ++i) v[i] *= rs;
}
__device__ __forceinline__ void store_mod_bf16(const f32x4 (&v)[4], const float* __restrict__ shift, const float* __restrict__ scale, bf16_t* __restrict__ hrow, int lane, f32x4 (*keep)[4]) {
#pragma unroll
  for (int i = 0; i < 4; ++i) { const int c = lane * 4 + 256 * i; const f32x4 sh = *(const f32x4*)(shift + c), sc = *(const f32x4*)(scale + c);
    f32x4 o = v[i] * (sc + 1.f) + sh; if (keep) (*keep)[i] = o;
    u32x2 w = {cvtpk(o[0], o[1]), cvtpk(o[2], o[3])}; *(u32x2*)(hrow + c) = w; }
}
__device__ __forceinline__ const float* mod_ptr(PRef p, int l, int row, int which) {
  const int bb = row < MX ? (row >> 13) : 8;
  return (const float*)(p.ws + WS_MOD) + ((size_t)l * 9 + bb) * 6144 + which * 1024;
}

__device__ void phase_h0(PRef p) {
  const int lane = otid() & 63, gw = obid() * 8 + (otid() >> 6), nw = gridDim.x * 8;
  bf16_t* h = (bf16_t*)(p.ws + WS_H);
  for (int row = gw; row < MT; row += nw) {
    const float* src = row < MX ? p.x + (size_t)row * 1024 : p.ctx + (size_t)(row - MX) * 1024;
    f32x4 v[4];
#pragma unroll
    for (int i = 0; i < 4; ++i) v[i] = *(const f32x4*)(src + lane * 4 + 256 * i);
    ln_row(v, 1e-6f);
    store_mod_bf16(v, mod_ptr(p, 0, row, 0), mod_ptr(p, 0, row, 1), h + (size_t)row * 1024, lane, nullptr);
  }
}

__device__ void phase_inproj(PRef p, int l, char* smem) {
  LAS unsigned char* lds = (LAS unsigned char*)smem;
  const bf16_t* h = (const bf16_t*)(p.ws + WS_H); const bf16_t* Wt = (const bf16_t*)(p.ws + WS_WIN) + (size_t)l * PLD * 1024;
  bf16_t* P = (bf16_t*)(p.ws + WS_P); float* gates = (float*)(p.ws + WS_GATES);
  const int tid = otid(), wid = tid >> 6, lane = tid & 63, wr = wid >> 2, wc = wid & 3, fr = lane & 15, fq = lane >> 4;
  g8::TileIter it; it.init(MT / 256, PLD / 256);
  int pm, pn;
  while (it.next(pm, pn)) {
    unsigned voffA[2] = {g8::piece_off(0, 1024, 0), g8::piece_off(1, 1024, 0)};
    f32x4 acc[2][2][4][2];
    g8::gemm_tile<false>(lds, (const char*)(h + (size_t)pm * 256 * 1024), voffA, (size_t)128 * 1024 * 2, (const char*)(Wt + (size_t)pn * 256 * 1024), 1024, acc);
    ACC_FOR(ai, bj, m, n) {
      const int row = pm * 256 + ai * 128 + wr * 64 + m * 16 + fr, col = pn * 256 + bj * 128 + wc * 32 + n * 16 + fq * 4;
      const f32x4 v = acc[ai][bj][m][n];
      u32x2 w = {cvtpk(v[0], v[1]), cvtpk(v[2], v[3])}; *(u32x2*)(P + (size_t)row * PLD + col) = w;
      if (col >= OFF_G && col < OFF_G + 16) { const f32x4 bg = *(const f32x4*)(p.b_gates + l * 16 + (col - OFF_G)); *(f32x4*)(gates + (size_t)row * 16 + (col - OFF_G)) = v + bg; }
    }
  }
}


__device__ void phase_mlstm(PRef p, int l, char* smem, size_t hb_off = WS_HB) {
  bf16_t* RAWQ = (bf16_t*)(smem); bf16_t* RAWK = (bf16_t*)(smem + 17408);
  bf16_t* QB = (bf16_t*)(smem + 34816); bf16_t* KB = (bf16_t*)(smem + 52224);
  bf16_t* KT = (bf16_t*)(smem + 69632);
  bf16_t* VT = (bf16_t*)(smem + 88064); bf16_t* VWT = (bf16_t*)(smem + 94976);
  bf16_t* PB = (bf16_t*)(smem + 101888);
  bf16_t* CT = (bf16_t*)(smem + 111104);
  float* SC = (float*)(smem + 124160);
  const bf16_t* P = (const bf16_t*)(p.ws + WS_P); const float* gates = (const float*)(p.ws + WS_GATES);
  bf16_t* hbuf = (bf16_t*)(p.ws + hb_off);
  const int tid = otid(), wid = tid >> 6, lane = tid & 63, fr = lane & 15, fq = lane >> 4;
  for (int w = obid(); w < 256; w += gridDim.x) {
    const int slice = w & 3, dir = (w >> 2) & 1, hd = (w >> 3) & 3, b = w >> 5;
    const int c2 = (tid & 63) * 2;
    float wq0[5], wq1[5], wk0[5], wk1[5];
#pragma unroll
    for (int j = 0; j < 5; ++j) { const float* cw = p.conv_w + ((size_t)l * 5 + j) * 1024; wq0[j] = cw[hd * 128 + c2]; wq1[j] = cw[hd * 128 + c2 + 1]; wk0[j] = cw[512 + hd * 128 + c2]; wk1[j] = cw[512 + hd * 128 + c2 + 1]; }
    const float bq0 = p.conv_b[l * 1024 + hd * 128 + c2], bq1 = p.conv_b[l * 1024 + hd * 128 + c2 + 1], bk0 = p.conv_b[l * 1024 + 512 + hd * 128 + c2], bk1 = p.conv_b[l * 1024 + 512 + hd * 128 + c2 + 1];
    __syncthreads();
    for (int i = tid; i < 48 * 136 / 2; i += 512) ((unsigned*)CT)[i] = 0u;
    for (int i = tid; i < 48 * 72 / 2; i += 512) { ((unsigned*)VT)[i] = 0u; ((unsigned*)VWT)[i] = 0u; }
    f32x4 accC[3];
#pragma unroll
    for (int i = 0; i < 3; ++i) accC[i] = (f32x4){0.f, 0.f, 0.f, 0.f};
    float m_state = 0.f;
    __syncthreads();
    for (int ci = 0; ci < 132; ++ci) {
      const bool isctx = ci < 4; const int cc = isctx ? ci : ci - 4, T = isctx ? CTXL : SEQ, rowbase = isctx ? MX + b * CTXL : b * SEQ;
      const int tlo = dir ? T - 64 - cc * 64 : cc * 64;
      float* S = SC + (ci & 1) * 384;
      const bool need_out = !(l == DEPTH - 1 && isctx);
      if (wid == 0) {
        const int t = dir ? tlo + 63 - lane : tlo + lane;
        const float* g = gates + (size_t)(rowbase + t) * 16;
        const float ig = g[dir * 8 + hd], fg = g[dir * 8 + 4 + hd];
        const float lf = fminf(fg, 0.f) - log1pf(expf(-fabsf(fg)));
        float bc = lf;
#pragma unroll
        for (int o = 1; o < 64; o <<= 1) { const float u = __shfl_up(bc, o); if (lane >= o) bc += u; }
        const float a = ig - bc; float pmx = a;
#pragma unroll
        for (int o = 1; o < 64; o <<= 1) { const float u = __shfl_up(pmx, o); if (lane >= o) pmx = fmaxf(pmx, u); }
        const float Mx = fmaxf(pmx, m_state), M63 = __shfl(Mx, 63), b63 = __shfl(bc, 63);
        S[lane] = a; S[64 + lane] = Mx; S[128 + lane] = expf(m_state - Mx); S[192 + lane] = expf(-(bc + Mx)); S[256 + lane] = expf(a - M63);
        if (lane == 0) { S[320] = expf(m_state - M63); S[321] = b63 + M63; }
      }
      for (int pc = tid; pc < 2176; pc += 512) {
        const int tens = pc >= 1088, rem = tens ? pc - 1088 : pc, rr = rem >> 4, c16 = rem & 15, t = tlo - 2 + rr;
        u32x4 v = {0u, 0u, 0u, 0u};
        if (t >= 0 && t < T) v = *(const u32x4*)(P + (size_t)(rowbase + t) * PLD + (tens ? OFF_K : OFF_Q) + hd * 128 + c16 * 8);
        *(u32x4*)((tens ? RAWK : RAWQ) + rr * 128 + c16 * 8) = v;
      }
      const int vl = tid >> 3, ve4 = (tid & 7) * 4, vt = dir ? tlo + 63 - vl : tlo + vl;
      const u32x2 vraw = *(const u32x2*)(P + (size_t)(rowbase + vt) * PLD + OFF_V + hd * 128 + slice * 32 + ve4);
      __syncthreads();
      {
        const int rg = wid; unsigned rq[12], rk[12];
#pragma unroll
        for (int i = 0; i < 12; ++i) { rq[i] = *(const unsigned*)(RAWQ + (rg * 8 + i) * 128 + c2); rk[i] = *(const unsigned*)(RAWK + (rg * 8 + i) * 128 + c2); }
#pragma unroll
        for (int jj = 0; jj < 8; ++jj) {
          float yq0 = bq0, yq1 = bq1, yk0 = bk0, yk1 = bk1;
#pragma unroll
          for (int tp = 0; tp < 5; ++tp) { yq0 += wq0[tp] * bflo(rq[jj + tp]); yq1 += wq1[tp] * bfhi(rq[jj + tp]); yk0 += wk0[tp] * bflo(rk[jj + tp]); yk1 += wk1[tp] * bfhi(rk[jj + tp]); }
          const int j = rg * 8 + jj, lr = dir ? 63 - j : j;
          const float q0 = silu_f(yq0) * 0.08838834764831845f, q1 = silu_f(yq1) * 0.08838834764831845f, k0 = silu_f(yk0), k1 = silu_f(yk1);
          *(unsigned*)(QB + lr * 136 + c2) = cvtpk(q0, q1);
          const unsigned kw = cvtpk(k0, k1);
          *(unsigned*)(KB + lr * 136 + c2) = kw;
          KT[c2 * 72 + lr] = (bf16_t)(kw & 0xffffu); KT[(c2 + 1) * 72 + lr] = (bf16_t)(kw >> 16);
        }
        const float wsl = S[256 + vl];
        const float v0 = bflo(vraw[0]), v1 = bfhi(vraw[0]), v2 = bflo(vraw[1]), v3 = bfhi(vraw[1]);
        VT[(ve4 + 0) * 72 + vl] = (bf16_t)(vraw[0] & 0xffffu); VT[(ve4 + 1) * 72 + vl] = (bf16_t)(vraw[0] >> 16);
        VT[(ve4 + 2) * 72 + vl] = (bf16_t)(vraw[1] & 0xffffu); VT[(ve4 + 3) * 72 + vl] = (bf16_t)(vraw[1] >> 16);
        VWT[(ve4 + 0) * 72 + vl] = f2bf(v0 * wsl); VWT[(ve4 + 1) * 72 + vl] = f2bf(v1 * wsl); VWT[(ve4 + 2) * 72 + vl] = f2bf(v2 * wsl); VWT[(ve4 + 3) * 72 + vl] = f2bf(v3 * wsl);
        if (tid < 64) { VT[32 * 72 + tid] = (bf16_t)0x3F80u; VWT[32 * 72 + tid] = f2bf(S[256 + tid]); }
      }
      __syncthreads();
      if (need_out) {
        const int mt = wid >> 1;
#pragma unroll
        for (int u = 0; u < 2; ++u) {
          const int ntl = (wid & 1) * 2 + u;
          f32x4 s = {0.f, 0.f, 0.f, 0.f};
          if (ntl <= mt) {
#pragma unroll
            for (int kk = 0; kk < 4; ++kk) {
              const bf16x8 a = *(const bf16x8*)(QB + (mt * 16 + fr) * 136 + kk * 32 + fq * 8), bb = *(const bf16x8*)(KB + (ntl * 16 + fr) * 136 + kk * 32 + fq * 8);
              s = __builtin_amdgcn_mfma_f32_16x16x32_bf16(a, bb, s, 0, 0, 0); }
          }
          const int j = ntl * 16 + fr; const float aj = S[j];
#pragma unroll
          for (int jj = 0; jj < 4; ++jj) { const int lr = mt * 16 + fq * 4 + jj;
            const float pv = (j <= lr) ? s[jj] * __expf(fminf(aj - S[64 + lr], 0.f)) : 0.f;
            PB[lr * 72 + j] = f2bf(pv); }
        }
      }
      __syncthreads();
      if (need_out && wid < 4) {
        const int mt = wid; f32x4 num[3];
#pragma unroll
        for (int ntl = 0; ntl < 3; ++ntl) {
          f32x4 a1 = {0.f, 0.f, 0.f, 0.f}, a2 = {0.f, 0.f, 0.f, 0.f};
#pragma unroll
          for (int kk = 0; kk < 2; ++kk) { const bf16x8 a = *(const bf16x8*)(PB + (mt * 16 + fr) * 72 + kk * 32 + fq * 8), bb = *(const bf16x8*)(VT + (ntl * 16 + fr) * 72 + kk * 32 + fq * 8);
            a1 = __builtin_amdgcn_mfma_f32_16x16x32_bf16(a, bb, a1, 0, 0, 0); }
#pragma unroll
          for (int kk = 0; kk < 4; ++kk) { const bf16x8 a = *(const bf16x8*)(QB + (mt * 16 + fr) * 136 + kk * 32 + fq * 8), bb = *(const bf16x8*)(CT + (ntl * 16 + fr) * 136 + kk * 32 + fq * 8);
            a2 = __builtin_amdgcn_mfma_f32_16x16x32_bf16(a, bb, a2, 0, 0, 0); }
#pragma unroll
          for (int jj = 0; jj < 4; ++jj) num[ntl][jj] = a1[jj] + S[128 + mt * 16 + fq * 4 + jj] * a2[jj];
        }
#pragma unroll
        for (int jj = 0; jj < 4; ++jj) {
          const int lr = mt * 16 + fq * 4 + jj; const float den = __shfl(num[2][jj], lane & 48);
          const float rd = 1.f / fmaxf(fabsf(den), S[192 + lr]);
          const int t = dir ? tlo + 63 - lr : tlo + lr;
          bf16_t* hp = hbuf + ((size_t)((dir * 4 + hd) * 4 + slice) * MT + rowbase + t) * 32 + fr;
          hp[0] = f2bf(num[0][jj] * rd); hp[16] = f2bf(num[1][jj] * rd);
#if DBG_STOP == 23
          { const size_t di = (size_t)(hp - hbuf); if (di + 16 < (size_t)MX * 1024) { p.out[di] = num[0][jj] * rd; p.out[di + 16] = num[1][jj] * rd; } }
#endif
        }
      }
      __syncthreads();
      {
        const float decay = S[320];
#pragma unroll
        for (int mt = 0; mt < 3; ++mt) {
          accC[mt] *= decay;
#pragma unroll
          for (int kk = 0; kk < 2; ++kk) { const bf16x8 a = *(const bf16x8*)(VWT + (mt * 16 + fr) * 72 + kk * 32 + fq * 8), bb = *(const bf16x8*)(KT + (wid * 16 + fr) * 72 + kk * 32 + fq * 8);
            accC[mt] = __builtin_amdgcn_mfma_f32_16x16x32_bf16(a, bb, accC[mt], 0, 0, 0); }
#pragma unroll
          for (int jj = 0; jj < 4; ++jj) CT[(mt * 16 + fq * 4 + jj) * 136 + wid * 16 + fr] = f2bf(accC[mt][jj]);
        }
        m_state = S[321];
      }
    }
  }
}

template <int WHICH>
__device__ __forceinline__ void mla_gemm(PRef p, int l, char* smem) {
  LAS unsigned char* lds = (LAS unsigned char*)smem; float* rsb = (float*)(smem + g8::STAGE_BYTES);
  const bf16_t* P = (const bf16_t*)(p.ws + WS_P);
  const int tid = otid(), wid = tid >> 6, lane = tid & 63, wr = wid >> 2, wc = wid & 3, fr = lane & 15, fq = lane >> 4;
  constexpr int K = WHICH ? 256 : 384, OFFC = WHICH ? OFF_CKV : OFF_CQ, N = WHICH ? 1024 : 768;
  const bf16_t* Wt = WHICH ? (const bf16_t*)(p.ws + WS_WUKV) + (size_t)l * 1024 * 256 : (const bf16_t*)(p.ws + WS_WUQ) + (size_t)l * 768 * 384;
  bf16_t* O = (bf16_t*)(p.ws + (WHICH ? WS_KV : WS_Q));
  g8::TileIter it; it.init((WHICH || l == 0) ? MT / 256 : MX / 256, N / 256);
  int pm, pn;
  while (it.next(pm, pn)) {
    __syncthreads();
    { const int r = tid >> 1, hf = tid & 1; const bf16_t* src = P + (size_t)(pm * 256 + r) * PLD + OFFC + hf * (K / 2); float s = 0.f;
#pragma unroll 4
      for (int i = 0; i < K / 16; ++i) { const u32x4 v = *(const u32x4*)(src + i * 8);
#pragma unroll
        for (int k = 0; k < 4; ++k) { const float a = bflo(v[k]), bq = bfhi(v[k]); s += a * a + bq * bq; } }
      s += __shfl_xor(s, 1);
      if (hf == 0) rsb[r] = rsqrtf(s / (float)K + 1e-6f); }
    unsigned voffA[2] = {g8::piece_off(0, PLD, OFFC), g8::piece_off(1, PLD, OFFC)};
    f32x4 acc[2][2][4][2];
    g8::gemm_tile<false>(lds, (const char*)(P + (size_t)pm * 256 * PLD), voffA, (size_t)128 * PLD * 2, (const char*)(Wt + (size_t)pn * 256 * K), opaque_s(K), acc);
    ACC_FOR(ai, bj, m, n) {
      const int rl = ai * 128 + wr * 64 + m * 16 + fr, row = pm * 256 + rl, col = pn * 256 + bj * 128 + wc * 32 + n * 16 + fq * 4;
      const f32x4 v = acc[ai][bj][m][n] * rsb[rl];
      size_t orow = row;
      if (WHICH) orow = row < MX ? (size_t)(row >> 13) * SKV + CTXL + (row & 8191) : (size_t)((row - MX) >> 8) * SKV + ((row - MX) & 255);
      u32x2 w = {cvtpk(v[0], v[1]), cvtpk(v[2], v[3])}; *(u32x2*)(O + orow * N + col) = w;
    }
  }
}
__device__ void phase_mla_prep(PRef p, int l, char* smem) {
  mla_gemm<0>(p, l, smem);
  mla_gemm<1>(p, l, smem);
  const bf16_t* P = (const bf16_t*)(p.ws + WS_P);
  const int tid = otid(), wid = tid >> 6, lane = tid & 63;
  const bf16_t* hbuf = (const bf16_t*)(p.ws + WS_HB); bf16_t* mix = (bf16_t*)(p.ws + WS_MIX); bf16_t* KR = (bf16_t*)(p.ws + WS_KR);
  const float* cs = (const float*)(p.ws + WS_COS); const float* sn = (const float*)(p.ws + WS_SIN);
  const int gw = obid() * 8 + wid, nw = gridDim.x * 8;
  for (int row = gw; row < MT; row += nw) {
    if (row < MX || l == 0) {
      const size_t ho = ((size_t)(lane >> 2) * MT + row) * 32 + (lane & 3) * 8;
      const u32x4 hf = *(const u32x4*)(hbuf + ho), hb = *(const u32x4*)(hbuf + (size_t)16 * MT * 32 + ho);
      const u32x4 ov = *(const u32x4*)(P + (size_t)row * PLD + OFF_O + lane * 8);
      float v[8]; float s = 0.f;
#pragma unroll
      for (int k = 0; k < 4; ++k) { v[2 * k] = bflo(hf[k]) + bflo(hb[k]); v[2 * k + 1] = bfhi(hf[k]) + bfhi(hb[k]); s += v[2 * k] + v[2 * k + 1]; }
      s += __shfl_xor(s, 1); s += __shfl_xor(s, 2); s += __shfl_xor(s, 4); s += __shfl_xor(s, 8);
      const float mu = s * (1.f / 128.f); float q = 0.f;
#pragma unroll
      for (int k = 0; k < 8; ++k) { v[k] -= mu; q += v[k] * v[k]; }
      q += __shfl_xor(q, 1); q += __shfl_xor(q, 2); q += __shfl_xor(q, 4); q += __shfl_xor(q, 8);
      const float rs = rsqrtf(q * (1.f / 128.f) + 1e-6f);
      const float* nw_ = p.m_norm_w + l * 512 + lane * 8; float o[8];
#pragma unroll
      for (int k = 0; k < 4; ++k) { o[2 * k] = v[2 * k] * rs * nw_[2 * k] * sigmoid_f(bflo(ov[k])); o[2 * k + 1] = v[2 * k + 1] * rs * nw_[2 * k + 1] * sigmoid_f(bfhi(ov[k])); }
      u32x4 wv = {cvtpk(o[0], o[1]), cvtpk(o[2], o[3]), cvtpk(o[4], o[5]), cvtpk(o[6], o[7])};
      *(u32x4*)(mix + (size_t)row * 1024 + lane * 8) = wv;
    }
    {
      const int j = lane & 31;
      const float x1 = bf2f(P[(size_t)row * PLD + OFF_KR + j]), x2 = bf2f(P[(size_t)row * PLD + OFF_KR + 32 + j]);
      float o1 = x1, o2 = x2; size_t orow;
      if (row < MX) { const int t = row & 8191; const float c = cs[t * 32 + j], s_ = sn[t * 32 + j]; o1 = x1 * c - x2 * s_; o2 = x2 * c + x1 * s_; orow = (size_t)(row >> 13) * SKV + CTXL + t; }
      else orow = (size_t)((row - MX) >> 8) * SKV + ((row - MX) & 255);
      if (lane < 32) { KR[orow * 64 + j] = f2bf(o1); KR[orow * 64 + 32 + j] = f2bf(o2); }
    }
  }
}

namespace att {
constexpr int NW = 8, QBLK = 32, KVBLK = 64, LDQ = 768, LDK = 1024, LDKR = 64, LDO = 1024;
constexpr float SCALE = A_SCALE;
constexpr float THR = 8.f;
constexpr size_t SHM_V = KVBLK * 128 * 2, SHM_K = KVBLK * 128 * 2, SHM_R = KVBLK * 64 * 2;
typedef float f32x8 __attribute__((ext_vector_type(8)));
#define KSWZ(row, colB) ((row) * 256 + ((colB) ^ (((row) & 7) << 4)))
#define RSWZ(row, colB) ((row) * 128 + ((colB) ^ (((row) & 7) << 4)))
#define SBAR() __builtin_amdgcn_sched_barrier(0)
__device__ __forceinline__ int crow(int r, int hi) { return (r & 3) + 8 * (r >> 2) + 4 * hi; }
__device__ __forceinline__ void partialSM(f32x16& p0, f32x16& p1, float& m_reg, float& mn, float& alpha) {
  constexpr float C = SCALE * 1.4426950408889634f;
  float pmax = p0[0];
#pragma unroll
  for (int r = 1; r < 16; ++r) pmax = fmaxf(pmax, p0[r]);
#pragma unroll
  for (int r = 0; r < 16; ++r) pmax = fmaxf(pmax, p1[r]);
  { auto rr = __builtin_amdgcn_permlane32_swap(__float_as_uint(pmax), __float_as_uint(pmax), false, false);
    pmax = fmaxf(__uint_as_float(rr[0]), __uint_as_float(rr[1])); }
  if (__builtin_expect(__all(pmax - m_reg <= THR / SCALE), 1)) { mn = m_reg; alpha = 1.f; }
  else { mn = fmaxf(m_reg, pmax); alpha = __builtin_amdgcn_exp2f((m_reg - mn) * C); m_reg = mn; }
  const float mnC = -mn * C;
#pragma unroll
  for (int r = 0; r < 16; ++r) p0[r] = fmaf(p0[r], C, mnC);
#pragma unroll
  for (int r = 0; r < 16; ++r) p1[r] = fmaf(p1[r], C, mnC);
#pragma unroll
  for (int r = 0; r < 16; ++r) p0[r] = __builtin_amdgcn_exp2f(p0[r]);
}
__device__ __forceinline__ void finishSM(f32x16& p0, f32x16& p1, float alpha, float& l_reg, bf16x8& pa0, bf16x8& pa1, bf16x8& pa2, bf16x8& pa3) {
#pragma unroll
  for (int r = 0; r < 16; ++r) p1[r] = __builtin_amdgcn_exp2f(p1[r]);
  float ps = 0;
#pragma unroll
  for (int r = 0; r < 16; ++r) ps += p0[r];
#pragma unroll
  for (int r = 0; r < 16; ++r) ps += p1[r];
  { auto rr = __builtin_amdgcn_permlane32_swap(__float_as_uint(ps), __float_as_uint(ps), false, false);
    ps = __uint_as_float(rr[0]) + __uint_as_float(rr[1]); }
  l_reg = l_reg * alpha + ps;
#define PK4(P, BASE, OUT) do { unsigned a0 = cvtpk(P[BASE + 0], P[BASE + 1]), a1 = cvtpk(P[BASE + 2], P[BASE + 3]);   \
    unsigned b0 = cvtpk(P[BASE + 4], P[BASE + 5]), b1 = cvtpk(P[BASE + 6], P[BASE + 7]);                              \
    auto r0 = __builtin_amdgcn_permlane32_swap(a0, b0, false, false); auto r1 = __builtin_amdgcn_permlane32_swap(a1, b1, false, false); \
    u32x4 w = {r0[0], r1[0], r0[1], r1[1]}; OUT = *reinterpret_cast<bf16x8*>(&w); } while (0)
  PK4(p0, 0, pa0); PK4(p0, 8, pa1); PK4(p1, 0, pa2); PK4(p1, 8, pa3);
#undef PK4
}
__device__ __forceinline__ void qkt(f32x16& p0, f32x16& p1, const char* Ks, const char* Rs, const bf16x8* qr, const char* qrl, int r32, int hi) {
  p0 = f32x16{}; p1 = f32x16{};
#pragma unroll
  for (int d0 = 0; d0 < 8; ++d0) { const int cb = (d0 * 16 + hi * 8) * 2;
    const bf16x8 b0 = *reinterpret_cast<const bf16x8*>(Ks + KSWZ(r32, cb));
    const bf16x8 b1 = *reinterpret_cast<const bf16x8*>(Ks + KSWZ(32 + r32, cb));
    p0 = __builtin_amdgcn_mfma_f32_32x32x16_bf16(b0, qr[d0], p0, 0, 0, 0);
    p1 = __builtin_amdgcn_mfma_f32_32x32x16_bf16(b1, qr[d0], p1, 0, 0, 0); }
#pragma unroll
  for (int d0 = 0; d0 < 4; ++d0) { const int cb = (d0 * 16 + hi * 8) * 2;
    const bf16x8 b0 = *reinterpret_cast<const bf16x8*>(Rs + RSWZ(r32, cb));
    const bf16x8 b1 = *reinterpret_cast<const bf16x8*>(Rs + RSWZ(32 + r32, cb));
    const bf16x8 qv = *reinterpret_cast<const bf16x8*>(qrl + d0 * 1024);
    p0 = __builtin_amdgcn_mfma_f32_32x32x16_bf16(b0, qv, p0, 0, 0, 0);
    p1 = __builtin_amdgcn_mfma_f32_32x32x16_bf16(b1, qv, p1, 0, 0, 0); }
}
__device__ __forceinline__ int v_st(int k, int c) { const int kk = (k & ~0xC) | ((k & 4) << 1) | ((k & 8) >> 1); return ((kk >> 3) * 4 + (c >> 5)) * 512 + ((kk & 7) * 32 + (c & 31)) * 2; }
__device__ __forceinline__ int v_rd_base(int lane) { return ((lane & 3) << 3) | (((lane >> 2) & 3) << 6) | (((lane >> 4) & 1) << 5) | (((lane >> 5) & 1) << 8); }
constexpr int v_rd_off(int d0, int ks, int half) { return d0 * 512 + ks * 4096 + half * 2048; }
template <int OFF> __device__ __forceinline__ s16x4 tr_read(int vb) {
  s16x4 r; asm volatile("ds_read_b64_tr_b16 %0, %1 offset:%2" : "=&v"(r) : "v"(vb), "i"(OFF) : "memory"); return r;
}
template <int D0> __device__ __forceinline__ void pv_one(f32x16& od, int vb, bf16x8 pa0, bf16x8 pa1, bf16x8 pa2, bf16x8 pa3) {
  const s16x4 l0 = tr_read<v_rd_off(D0, 0, 0)>(vb), h0 = tr_read<v_rd_off(D0, 0, 1)>(vb), l1 = tr_read<v_rd_off(D0, 1, 0)>(vb), h1 = tr_read<v_rd_off(D0, 1, 1)>(vb);
  const s16x4 l2 = tr_read<v_rd_off(D0, 2, 0)>(vb), h2 = tr_read<v_rd_off(D0, 2, 1)>(vb), l3 = tr_read<v_rd_off(D0, 3, 0)>(vb), h3 = tr_read<v_rd_off(D0, 3, 1)>(vb);
  asm volatile("s_waitcnt lgkmcnt(0)" ::: "memory"); SBAR();
#define PK(L, H) (bf16x8){L[0], L[1], L[2], L[3], H[0], H[1], H[2], H[3]}
  od = __builtin_amdgcn_mfma_f32_32x32x16_bf16(pa0, PK(l0, h0), od, 0, 0, 0);
  od = __builtin_amdgcn_mfma_f32_32x32x16_bf16(pa1, PK(l1, h1), od, 0, 0, 0);
  od = __builtin_amdgcn_mfma_f32_32x32x16_bf16(pa2, PK(l2, h2), od, 0, 0, 0);
  od = __builtin_amdgcn_mfma_f32_32x32x16_bf16(pa3, PK(l3, h3), od, 0, 0, 0);
#undef PK
}
__device__ __forceinline__ void pv_d0(f32x16* o, int vb, bf16x8 pa0, bf16x8 pa1, bf16x8 pa2, bf16x8 pa3) {
  pv_one<0>(o[0], vb, pa0, pa1, pa2, pa3); pv_one<1>(o[1], vb, pa0, pa1, pa2, pa3); pv_one<2>(o[2], vb, pa0, pa1, pa2, pa3); pv_one<3>(o[3], vb, pa0, pa1, pa2, pa3);
}
__device__ __forceinline__ void attn_body(const bf16_t* __restrict__ Qb, const float* __restrict__ cs, const float* __restrict__ sn, const bf16_t* __restrict__ Kn,
                                          const bf16_t* __restrict__ Vh, const bf16_t* __restrict__ Kr, bf16_t* __restrict__ Ob, int seq, char* lds) {
  const int tid = otid(), wid = tid >> 6, lane = tid & 63, r32 = lane & 31, hi = lane >> 5;
  char* V_lds = lds; char* K_lds = lds + 2 * SHM_V; char* R_lds = lds + 2 * SHM_V + 2 * SHM_K;
  float* wsf = (float*)(lds + 2 * SHM_V + 2 * SHM_K + 2 * SHM_R) + wid * 64; float* li_l = wsf; float* al_l = wsf + 32;
  char* qrl = lds + 2 * SHM_V + 2 * SHM_K + 2 * SHM_R + 2048 + wid * 4096 + lane * 16;
  float m_reg = -1e30f, l_reg = 0; f32x16 o[4] = {}; bf16x8 qr[8];
  { const bf16_t* Qw = Qb + (size_t)(wid * QBLK + r32) * LDQ + hi * 8;
#pragma unroll
    for (int d0 = 0; d0 < 8; ++d0) qr[d0] = *(const bf16x8*)(Qw + d0 * 16);
#pragma unroll
    for (int d0 = 0; d0 < 2; ++d0) {
      const u32x4 a = *(const u32x4*)(Qw + 128 + d0 * 16), bq = *(const u32x4*)(Qw + 160 + d0 * 16);
      if (cs) {
        const float* cp = cs + (size_t)(wid * QBLK + r32) * 32 + d0 * 16 + hi * 8; const float* sp = sn + (size_t)(wid * QBLK + r32) * 32 + d0 * 16 + hi * 8;
        const f32x4 c0 = *(const f32x4*)cp, c1 = *(const f32x4*)(cp + 4), s0 = *(const f32x4*)sp, s1 = *(const f32x4*)(sp + 4);
        float x1[8], x2[8], y1[8], y2[8];
#pragma unroll
        for (int k = 0; k < 4; ++k) { x1[2 * k] = bflo(a[k]); x1[2 * k + 1] = bfhi(a[k]); x2[2 * k] = bflo(bq[k]); x2[2 * k + 1] = bfhi(bq[k]); }
#pragma unroll
        for (int k = 0; k < 8; ++k) { const float c = k < 4 ? c0[k & 3] : c1[k & 3], s = k < 4 ? s0[k & 3] : s1[k & 3]; y1[k] = x1[k] * c - x2[k] * s; y2[k] = x2[k] * c + x1[k] * s; }
        u32x4 w1 = {cvtpk(y1[0], y1[1]), cvtpk(y1[2], y1[3]), cvtpk(y1[4], y1[5]), cvtpk(y1[6], y1[7])}, w2 = {cvtpk(y2[0], y2[1]), cvtpk(y2[2], y2[3]), cvtpk(y2[4], y2[5]), cvtpk(y2[6], y2[7])};
        *(u32x4*)(qrl + d0 * 1024) = w1; *(u32x4*)(qrl + (2 + d0) * 1024) = w2;
      } else { *(u32x4*)(qrl + d0 * 1024) = a; *(u32x4*)(qrl + (2 + d0) * 1024) = bq; }
    } }
  const int sr = tid >> 4, sc = (tid & 15) * 8, vst0 = v_st(sr, sc), vst1 = v_st(32 + sr, sc);
  const int rr_ = tid >> 3, rc = (tid & 7) * 8;
  const int vb0 = (int)(uintptr_t)V_lds + v_rd_base(lane);
  bf16x8 vs0, vs1, ks0, ks1, rs0;
  const unsigned voffKV = (unsigned)(sr * LDK + sc) * 2u, voffR = (unsigned)(rr_ * LDKR + rc) * 2u;
#define SLOAD(k0) do { const char* kb_ = (const char*)Kn + (size_t)(k0) * (LDK * 2); const char* vb_ = (const char*)Vh + (size_t)(k0) * (LDK * 2); \
    vs0 = *(const bf16x8*)(vb_ + voffKV); vs1 = *(const bf16x8*)(vb_ + 32 * LDK * 2 + voffKV); \
    ks0 = *(const bf16x8*)(kb_ + voffKV); ks1 = *(const bf16x8*)(kb_ + 32 * LDK * 2 + voffKV); \
    rs0 = *(const bf16x8*)((const char*)Kr + (size_t)(k0) * (LDKR * 2) + voffR); } while (0)
#define SWRITE(b) do { *(bf16x8*)(V_lds + (b) * SHM_V + vst0) = vs0; *(bf16x8*)(V_lds + (b) * SHM_V + vst1) = vs1; const int kc = sc * 2;  \
    *(bf16x8*)(K_lds + (b) * SHM_K + KSWZ(sr, kc)) = ks0; *(bf16x8*)(K_lds + (b) * SHM_K + KSWZ(32 + sr, kc)) = ks1;                      \
    *(bf16x8*)(R_lds + (b) * SHM_R + RSWZ(rr_, rc * 2)) = rs0; } while (0)
#define RESC(a) do { if (__any((a) < 1.f)) { if (hi == 0) al_l[r32] = (a); asm volatile("s_waitcnt lgkmcnt(0)" ::: "memory"); \
    _Pragma("unroll") for (int d = 0; d < 4; ++d) _Pragma("unroll") for (int r = 0; r < 16; ++r) o[d][r] *= al_l[crow(r, hi)]; } } while (0)
  f32x16 pA0, pA1, pB0, pB1; float mnA, mnB, alA, alB; bf16x8 pa0, pa1, pa2, pa3; const int NT = seq / KVBLK;
  SLOAD(0); SWRITE(0); __syncthreads();
  qkt(pA0, pA1, K_lds, R_lds, qr, qrl, r32, hi); partialSM(pA0, pA1, m_reg, mnA, alA);
  SLOAD(KVBLK); SWRITE(1); __syncthreads();
  for (int j = 1; j + 1 < NT; j += 2) {
    SBAR(); qkt(pB0, pB1, K_lds + SHM_K, R_lds + SHM_R, qr, qrl, r32, hi);
    finishSM(pA0, pA1, alA, l_reg, pa0, pa1, pa2, pa3); SBAR();
    SLOAD((j + 1) * KVBLK); SBAR();
    pv_d0(o, vb0, pa0, pa1, pa2, pa3); partialSM(pB0, pB1, m_reg, mnB, alB);
    __syncthreads(); SWRITE(0);
    RESC(alB); __syncthreads();
    SBAR(); qkt(pA0, pA1, K_lds, R_lds, qr, qrl, r32, hi);
    finishSM(pB0, pB1, alB, l_reg, pa0, pa1, pa2, pa3); SBAR();
    SLOAD((j + 2) * KVBLK); SBAR();
    pv_d0(o, vb0 + (int)SHM_V, pa0, pa1, pa2, pa3); partialSM(pA0, pA1, m_reg, mnA, alA);
    __syncthreads(); SWRITE(1);
    RESC(alA); __syncthreads();
  }
  SBAR(); qkt(pB0, pB1, K_lds + SHM_K, R_lds + SHM_R, qr, qrl, r32, hi);
  finishSM(pA0, pA1, alA, l_reg, pa0, pa1, pa2, pa3); SBAR();
  pv_d0(o, vb0, pa0, pa1, pa2, pa3); partialSM(pB0, pB1, m_reg, mnB, alB);
  __syncthreads(); RESC(alB);
  finishSM(pB0, pB1, alB, l_reg, pa0, pa1, pa2, pa3); SBAR();
  pv_d0(o, vb0 + (int)SHM_V, pa0, pa1, pa2, pa3);
  if (hi == 0) li_l[r32] = l_reg; asm volatile("s_waitcnt lgkmcnt(0)" ::: "memory");
  float rli[16];
#pragma unroll
  for (int r = 0; r < 16; ++r) rli[r] = __builtin_amdgcn_rcpf(li_l[crow(r, hi)]);
  bf16_t* Ow = Ob + (size_t)(wid * QBLK) * LDO;
#pragma unroll
  for (int r = 0; r < 16; ++r) { const int orow = crow(r, hi);
#pragma unroll
    for (int d0 = 0; d0 < 4; ++d0) Ow[(size_t)orow * LDO + d0 * 32 + r32] = f2bf(o[d0][r] * rli[r]); }
  __syncthreads();
#undef SLOAD
#undef SWRITE
#undef RESC
}
}

__device__ void phase_attn(PRef p, int l, char* smem) {
  const bf16_t* Q = (const bf16_t*)(p.ws + WS_Q); const bf16_t* KV = (const bf16_t*)(p.ws + WS_KV); const bf16_t* KR = (const bf16_t*)(p.ws + WS_KR);
  bf16_t* mix = (bf16_t*)(p.ws + WS_MIX); const float* cs = (const float*)(p.ws + WS_COS); const float* sn = (const float*)(p.ws + WS_SIN);
  const int nunits = 1024 + (l == 0 ? 32 : 0);
  for (int u = obid(); u < nunits; u += gridDim.x) {
    if (u < 1024) {
      const int qb = u & 31, hd = (u >> 5) & 3, b = u >> 7; const size_t row0 = (size_t)b * SEQ + qb * 256;
      att::attn_body(Q + row0 * 768 + hd * 192, cs + (size_t)qb * 256 * 32, sn + (size_t)qb * 256 * 32, KV + (size_t)b * SKV * 1024 + hd * 256,
                     KV + (size_t)b * SKV * 1024 + hd * 256 + 128, KR + (size_t)b * SKV * 64, mix + row0 * 1024 + 512 + hd * 128, SKV, smem);
    } else {
      const int v = u - 1024, hd = v & 3, b = v >> 2; const size_t row0 = (size_t)MX + b * CTXL;
      att::attn_body(Q + row0 * 768 + hd * 192, nullptr, nullptr, KV + (size_t)b * SKV * 1024 + hd * 256,
                     KV + (size_t)b * SKV * 1024 + hd * 256 + 128, KR + (size_t)b * SKV * 64, mix + row0 * 1024 + 512 + hd * 128, CTXL, smem);
    }
  }
}

__device__ void phase_outproj(PRef p, int l, char* smem) {
  LAS unsigned char* lds = (LAS unsigned char*)smem;
  const bf16_t* mix = (const bf16_t*)(p.ws + WS_MIX); const bf16_t* Wt = (const bf16_t*)(p.ws + WS_WOUT) + (size_t)l * 1024 * 1024;
  float* ctxz = (float*)(p.ws + WS_CTXZ);
  const int tid = otid(), wid = tid >> 6, lane = tid & 63, wr = wid >> 2, wc = wid & 3, fr = lane & 15, fq = lane >> 4;
  g8::TileIter it; it.init(l == 0 ? MT / 256 : MX / 256, 4);
  int pm, pn;
  while (it.next(pm, pn)) {
    unsigned voffA[2] = {g8::piece_off(0, 1024, 0), g8::piece_off(1, 1024, 0)};
    f32x4 acc[2][2][4][2];
    g8::gemm_tile<false>(lds, (const char*)(mix + (size_t)pm * 256 * 1024), voffA, (size_t)128 * 1024 * 2, (const char*)(Wt + (size_t)pn * 256 * 1024), 1024, acc);
    ACC_FOR(ai, bj, m, n) {
      const int row = pm * 256 + ai * 128 + wr * 64 + m * 16 + fr, col = pn * 256 + bj * 128 + wc * 32 + n * 16 + fq * 4;
      const float* res = l == 0 ? (row < MX ? p.x + (size_t)row * 1024 : p.ctx + (size_t)(row - MX) * 1024) : p.out + (size_t)row * 1024;
      float* dst = row < MX ? p.out + (size_t)row * 1024 : ctxz + (size_t)(row - MX) * 1024;
      const f32x4 r = *(const f32x4*)(res + col), g = *(const f32x4*)(mod_ptr(p, l, row, 2) + col);
      *(f32x4*)(dst + col) = r * ALPHA + g * acc[ai][bj][m][n];
    }
  }
}

__device__ void phase_ln1(PRef p, int l, char* smem) {
  float* wrt = (float*)smem;
  for (int i = otid(); i < 16384; i += 512) wrt[(i & 15) * 1024 + (i >> 4)] = p.w_router[(size_t)l * 16384 + i];
  __syncthreads();
  const int lane = otid() & 63, gw = obid() * 8 + (otid() >> 6), nw = gridDim.x * 8;
  bf16_t* h = (bf16_t*)(p.ws + WS_H); float* ctxz = (float*)(p.ws + WS_CTXZ); float* aff = (float*)(p.ws + WS_AFF);
  const int nrows = l == 0 ? MT : MX;
  for (int row = gw; row < nrows; row += nw) {
    asm volatile("" ::: "memory");
    float* zr = row < MX ? p.out + (size_t)row * 1024 : ctxz + (size_t)(row - MX) * 1024;
    f32x4 v[4];
#pragma unroll
    for (int i = 0; i < 4; ++i) v[i] = *(const f32x4*)(zr + lane * 4 + 256 * i);
    ln_row(v, 1e-5f);
#pragma unroll
    for (int i = 0; i < 4; ++i) { const int c = lane * 4 + 256 * i; v[i] = v[i] * *(const f32x4*)(p.ln1_g + l * 1024 + c) + *(const f32x4*)(p.ln1_b + l * 1024 + c); *(f32x4*)(zr + c) = v[i]; }
    ln_row(v, 1e-6f);
    f32x4 hm[4];
    store_mod_bf16(v, mod_ptr(p, l, row, 3), mod_ptr(p, l, row, 4), h + (size_t)row * 1024, lane, &hm);
    float lg[16];
#pragma unroll
    for (int e = 0; e < 16; ++e) { float s = 0.f;
#pragma unroll
      for (int i = 0; i < 4; ++i) { const f32x4 w = *(const f32x4*)(wrt + e * 1024 + lane * 4 + 256 * i); s += hm[i][0] * w[0] + hm[i][1] * w[1] + hm[i][2] * w[2] + hm[i][3] * w[3]; }
      lg[e] = wave_sum(s); }
    float mx = lg[0];
#pragma unroll
    for (int e = 1; e < 16; ++e) mx = fmaxf(mx, lg[e]);
    float den = 0.f;
#pragma unroll
    for (int e = 0; e < 16; ++e) { lg[e] = expf(lg[e] - mx); den += lg[e]; }
    float mine = 0.f;
#pragma unroll
    for (int e = 0; e < 16; ++e) if (lane == e) mine = lg[e] / den;
    if (lane < 16) aff[(size_t)row * 16 + lane] = mine;
  }
}

template <int PER>
__device__ __forceinline__ void topk_item(const float* __restrict__ affp, int n, int kcap, int rowbase, int slotbase, int e, int* __restrict__ IDX, float* __restrict__ GV, int* __restrict__ TS, char* smem) {
  unsigned* hist = (unsigned*)smem; unsigned* sel = hist + 256; unsigned* wtot = hist + 272;
  const int tid = otid(), lane = tid & 63, wid = tid >> 6;
  const bool active = tid * PER < n;
  unsigned key[PER];
#pragma unroll
  for (int i = 0; i < PER; ++i) key[i] = active ? __float_as_uint(affp[(size_t)(tid * PER + i) * 16]) : 0u;
  unsigned prefix = 0u, mask = 0u; int kk = kcap;
#pragma unroll 1
  for (int shift = 24; shift >= 0; shift -= 8) {
    __syncthreads();
    if (tid < 256) hist[tid] = 0u;
    __syncthreads();
#pragma unroll
    for (int i = 0; i < PER; ++i) if (active && (key[i] & mask) == prefix) atomicAdd(&hist[(key[i] >> shift) & 255u], 1u);
    __syncthreads();
    if (wid == 0) {
      const unsigned h0 = hist[lane * 4], h1 = hist[lane * 4 + 1], h2 = hist[lane * 4 + 2], h3 = hist[lane * 4 + 3];
      const unsigned tot = h0 + h1 + h2 + h3; unsigned suf = tot;
#pragma unroll
      for (int o = 1; o < 64; o <<= 1) { const unsigned u = __shfl_down(suf, o); if (lane + o < 64) suf += u; }
      const unsigned above = suf - tot;
      if (above < (unsigned)kk && suf >= (unsigned)kk) {
        unsigned a = above; int bin;
        if (a + h3 >= (unsigned)kk) bin = 3; else { a += h3; if (a + h2 >= (unsigned)kk) bin = 2; else { a += h2; if (a + h1 >= (unsigned)kk) bin = 1; else { a += h1; bin = 0; } } }
        sel[0] = prefix | ((unsigned)(lane * 4 + bin) << shift); sel[1] = (unsigned)kk - a;
      }
    }
    __syncthreads();
    prefix = sel[0]; kk = (int)sel[1]; mask |= 0xffu << shift;
  }
  const unsigned Tk = prefix;
  unsigned cg_ = 0, ce = 0;
#pragma unroll
  for (int i = 0; i < PER; ++i) { cg_ += key[i] > Tk; ce += key[i] == Tk; }
  unsigned pk = active ? (cg_ | (ce << 16)) : 0u, inc = pk;
#pragma unroll
  for (int o = 1; o < 64; o <<= 1) { const unsigned u = __shfl_up(inc, o); if (lane >= o) inc += u; }
  __syncthreads();
  if (lane == 63) wtot[wid] = inc;
  __syncthreads();
  unsigned base = 0;
  for (int w2 = 0; w2 < wid; ++w2) base += wtot[w2];
  const unsigned exc = base + inc - pk; unsigned gt_before = exc & 0xffffu, eq_before = exc >> 16;
  if (active) {
#pragma unroll
    for (int i = 0; i < PER; ++i) {
      const int t = tid * PER + i; int R = -1;
      const bool isgt = key[i] > Tk, iseq = key[i] == Tk;
      if (isgt || (iseq && (int)eq_before < kk)) {
        const int slot = (int)gt_before + min((int)eq_before, kk);
        R = slotbase + slot; IDX[R] = rowbase + t; GV[R] = __uint_as_float(key[i]);
      }
      TS[t] = R;
      gt_before += isgt; eq_before += iseq;
    }
  }
}
__device__ void phase_topk(PRef p, int l, char* smem) {
  const float* aff = (const float*)(p.ws + WS_AFF); int* IDX = (int*)(p.ws + WS_IDX); float* GV = (float*)(p.ws + WS_GV); int* TS = (int*)(p.ws + WS_TS);
  const int nitems = l == 0 ? 256 : 128;
  for (int it = obid(); it < nitems; it += gridDim.x) {
    if (it < 128) { const int b = it >> 4, e = it & 15; topk_item<16>(aff + (size_t)b * SEQ * 16 + e, SEQ, CAPX, b * SEQ, it * CAPX, e, IDX, GV, TS + (size_t)it * SEQ, smem); }
    else { const int v = it - 128, b = v >> 4, e = v & 15; topk_item<1>(aff + ((size_t)MX + b * CTXL) * 16 + e, CTXL, CAPC, MX + b * CTXL, NB * NE * CAPX + e * 256 + b * CAPC, e, IDX, GV, TS + (size_t)NB * 16 * SEQ + (size_t)v * CTXL, smem); }
  }
  __syncthreads();
}

__device__ void phase_moe_up(PRef p, int l, char* smem) {
  LAS unsigned char* lds = (LAS unsigned char*)smem;
  const bf16_t* h = (const bf16_t*)(p.ws + WS_H); const bf16_t* Wgu = (const bf16_t*)(p.ws + WS_WGU); bf16_t* act = (bf16_t*)(p.ws + WS_ACT); const int* IDX = (const int*)(p.ws + WS_IDX);
  const int tid = otid(), wid = tid >> 6, lane = tid & 63, wr = wid >> 2, wc = wid & 3, fr = lane & 15, fq = lane >> 4;
  g8::TileIter it; it.init(l == 0 ? 528 : 512, 8);
  int pm, pn;
  while (it.next(pm, pn)) {
    const int e = pm < 512 ? (pm >> 2) & 15 : pm - 512;
    unsigned voffA[4];
#pragma unroll
    for (int hh = 0; hh < 2; ++hh)
#pragma unroll
      for (int i = 0; i < 2; ++i) { int R, C; g8::piece_rc(i, R, C); voffA[hh * 2 + i] = (unsigned)(IDX[pm * 256 + hh * 128 + R] * 1024 + C) * 2u; }
    f32x4 acc[2][2][4][2];
    g8::gemm_tile<true>(lds, (const char*)h, voffA, 0, (const char*)(Wgu + ((size_t)e * 2048 + pn * 256) * 1024), 1024, acc);
#pragma unroll
    for (int ai = 0; ai < 2; ++ai)
#pragma unroll
      for (int m = 0; m < 4; ++m)
#pragma unroll
        for (int n = 0; n < 2; ++n) {
          const int row = pm * 256 + ai * 128 + wr * 64 + m * 16 + fr, col = pn * 128 + wc * 32 + n * 16 + fq * 4;
          const f32x4 g = acc[ai][0][m][n], u = acc[ai][1][m][n]; float a[4];
#pragma unroll
          for (int k = 0; k < 4; ++k) a[k] = silu_f(g[k]) * u[k];
          u32x2 w = {cvtpk(a[0], a[1]), cvtpk(a[2], a[3])}; *(u32x2*)(act + (size_t)row * 1024 + col) = w;
        }
  }
}
__device__ void phase_moe_down(PRef p, int l, char* smem) {
  LAS unsigned char* lds = (LAS unsigned char*)smem;
  const bf16_t* act = (const bf16_t*)(p.ws + WS_ACT); const bf16_t* Wdn = (const bf16_t*)(p.ws + WS_WDN); bf16_t* oute = (bf16_t*)(p.ws + WS_OUTE); const float* GV = (const float*)(p.ws + WS_GV);
  const int tid = otid(), wid = tid >> 6, lane = tid & 63, wr = wid >> 2, wc = wid & 3, fr = lane & 15, fq = lane >> 4;
  g8::TileIter it; it.init(l == 0 ? 528 : 512, 4);
  int pm, pn;
  while (it.next(pm, pn)) {
    const int e = pm < 512 ? (pm >> 2) & 15 : pm - 512;
    unsigned voffA[2] = {g8::piece_off(0, 1024, 0), g8::piece_off(1, 1024, 0)};
    f32x4 acc[2][2][4][2];
    g8::gemm_tile<false>(lds, (const char*)(act + (size_t)pm * 256 * 1024), voffA, (size_t)128 * 1024 * 2, (const char*)(Wdn + ((size_t)e * 1024 + pn * 256) * 1024), 1024, acc);
    ACC_FOR(ai, bj, m, n) {
      const int row = pm * 256 + ai * 128 + wr * 64 + m * 16 + fr, col = pn * 256 + bj * 128 + wc * 32 + n * 16 + fq * 4;
      const f32x4 v = acc[ai][bj][m][n] * GV[row];
      u32x2 w = {cvtpk(v[0], v[1]), cvtpk(v[2], v[3])}; *(u32x2*)(oute + (size_t)row * 1024 + col) = w;
    }
  }
}

__device__ void phase_ln2(PRef p, int l) {
  const int lane = otid() & 63, gw = obid() * 8 + (otid() >> 6), nw = gridDim.x * 8;
  bf16_t* h = (bf16_t*)(p.ws + WS_H); float* ctxz = (float*)(p.ws + WS_CTXZ); const bf16_t* oute = (const bf16_t*)(p.ws + WS_OUTE); const int* TS = (const int*)(p.ws + WS_TS);
  const int nrows = l == 0 ? MT : MX;
  for (int row = gw; row < nrows; row += nw) {
    float* xr = row < MX ? p.out + (size_t)row * 1024 : ctxz + (size_t)(row - MX) * 1024;
    f32x4 mo[4];
#pragma unroll
    for (int i = 0; i < 4; ++i) mo[i] = (f32x4){0.f, 0.f, 0.f, 0.f};
    const int myR = lane < 16 ? (row < MX ? TS[((size_t)(row >> 13) * 16 + lane) * SEQ + (row & 8191)] : TS[(size_t)NB * 16 * SEQ + ((size_t)((row - MX) >> 8) * 16 + lane) * CTXL + ((row - MX) & 255)]) : -1;
    for (int e = 0; e < 16; ++e) { const int Rr = __shfl(myR, e);
      if (Rr >= 0) {
#pragma unroll
        for (int i = 0; i < 4; ++i) { const u32x2 w = *(const u32x2*)(oute + (size_t)Rr * 1024 + lane * 4 + 256 * i);
          mo[i][0] += bflo(w[0]); mo[i][1] += bfhi(w[0]); mo[i][2] += bflo(w[1]); mo[i][3] += bfhi(w[1]); } } }
    f32x4 v[4]; const float* m5 = mod_ptr(p, l, row, 5);
#pragma unroll
    for (int i = 0; i < 4; ++i) { const int c = lane * 4 + 256 * i; v[i] = *(const f32x4*)(xr + c) * ALPHA + *(const f32x4*)(m5 + c) * mo[i]; }
    ln_row(v, 1e-5f);
#pragma unroll
    for (int i = 0; i < 4; ++i) { const int c = lane * 4 + 256 * i; v[i] = v[i] * *(const f32x4*)(p.ln2_g + l * 1024 + c) + *(const f32x4*)(p.ln2_b + l * 1024 + c); *(f32x4*)(xr + c) = v[i]; }
    if (l + 1 < DEPTH) { ln_row(v, 1e-6f); store_mod_bf16(v, mod_ptr(p, l + 1, row, 0), mod_ptr(p, l + 1, row, 1), h + (size_t)row * 1024, lane, nullptr); }
  }
}

#if DBG_BAR
__device__ int g_phase_dummy;
#endif
__device__ __forceinline__ void gsync(cg::grid_group& grid, PRef p, int& phase) {
#if DBG_BAR
  int* flags = (int*)(p.ws + WS_END); int* err = flags + 1024;
  ++phase;
  if (otid() == 0) flags[obid()] = phase;
#endif
  asm volatile("s_waitcnt vmcnt(0) lgkmcnt(0)" ::: "memory");
  __builtin_amdgcn_fence(__ATOMIC_RELEASE, "agent");
  grid.sync();
  __builtin_amdgcn_fence(__ATOMIC_ACQUIRE, "agent");
#if DBG_BAR
  if (otid() < (int)gridDim.x) { if (flags[otid()] != phase) atomicAdd(err, 1); }
#endif
}
__device__ void dbg_dump_bf16(PRef p, size_t off) {
  const bf16_t* src = (const bf16_t*)(p.ws + off);
  for (size_t i = (size_t)obid() * 512 + otid(); i < (size_t)MX * 1024; i += (size_t)gridDim.x * 512) p.out[i] = bf2f(src[i]);
}
__global__ void __launch_bounds__(512) mega(Params p) {
  extern __shared__ __attribute__((aligned(16))) char smem[];
  cg::grid_group grid = cg::this_grid();
  int phase = 0;
#if DBG_BAR
  if (obid() == 0 && otid() == 0) ((int*)(kparams().ws + WS_END))[1024] = 0;
#endif
  phase_prep(kparams(), smem);
  gsync(grid, kparams(), phase);
  phase_h0(kparams());
  gsync(grid, kparams(), phase);
#pragma unroll 1
  for (int l = 0; l < DEPTH; ++l) {
#if DBG_STOP == 0
    dbg_dump_bf16(kparams(), WS_H); return;
#endif
    phase_inproj(kparams(), l, smem);
    gsync(grid, kparams(), phase);
#if DBG_STOP == 1
    dbg_dump_bf16(kparams(), WS_P); return;
#endif
#if DBG_STOP == 12
    dbg_dump_bf16(kparams(), WS_P + (size_t)23000 * PLD * 2); return;
#endif
#if DBG_STOP == 11
    { PRef q = kparams(); const float* gsrc = (const float*)(q.ws + WS_GATES); const bf16_t* ps = (const bf16_t*)(q.ws + WS_P);
      for (size_t i = (size_t)obid() * 512 + otid(); i < (size_t)MX * 1024; i += (size_t)gridDim.x * 512)
        q.out[i] = i < (size_t)MT * 16 ? gsrc[i] : bf2f(ps[(size_t)MT * PLD - 1 - (i - (size_t)MT * 16)]); }
    return;
#endif
#if DBG_STOP == 24
#pragma unroll 1
    for (int rep = 0; rep < 2; ++rep) { phase_mlstm(kparams(), l, smem, opaque_s(rep) ? WS_Q : WS_HB); gsync(grid, kparams(), phase); }
    { PRef q = kparams(); const bf16_t* a = (const bf16_t*)(q.ws + WS_HB); const bf16_t* b2 = (const bf16_t*)(q.ws + WS_Q);
      for (size_t i = (size_t)obid() * 512 + otid(); i < (size_t)MX * 1024; i += (size_t)gridDim.x * 512) q.out[i] = bf2f(a[i]) - bf2f(b2[i]); }
    return;
#else
    phase_mlstm(kparams(), l, smem);
    gsync(grid, kparams(), phase);
#endif
#if DBG_STOP == 2
    dbg_dump_bf16(kparams(), WS_HB); return;
#endif
#if DBG_STOP == 23
    return;
#endif
#if DBG_STOP == 22
    { PRef q = kparams(); const int nerr = ((const int*)(q.ws + WS_END))[1024];
      for (size_t i = (size_t)obid() * 512 + otid(); i < (size_t)MX * 1024; i += (size_t)gridDim.x * 512) q.out[i] = i < 1024 ? 1000.f * (float)nerr : 0.f; }
    return;
#endif
    phase_mla_prep(kparams(), l, smem);
    gsync(grid, kparams(), phase);
    phase_attn(kparams(), l, smem);
    gsync(grid, kparams(), phase);
#if DBG_STOP == 4
    dbg_dump_bf16(kparams(), WS_MIX); return;
#endif
    phase_outproj(kparams(), l, smem);
    gsync(grid, kparams(), phase);
    phase_ln1(kparams(), l, smem);
    __syncthreads();
    phase_cvt_experts(kparams(), l, smem);
    gsync(grid, kparams(), phase);
#if DBG_STOP == 6
    if (l == 0) return;
#endif
    phase_topk(kparams(), l, smem);
    gsync(grid, kparams(), phase);
    phase_moe_up(kparams(), l, smem);
    gsync(grid, kparams(), phase);
    phase_moe_down(kparams(), l, smem);
    gsync(grid, kparams(), phase);
    phase_ln2(kparams(), l);
    gsync(grid, kparams(), phase);
#if DBG_STOP == 10
    if (l == 0) return;
#endif
  }
}

extern "C" void kernel_launch(void* const* d_in, const int* in_sizes, int n_in, void* d_out, int out_size,
                              void* d_ws, size_t ws_size, hipStream_t stream) {
  constexpr size_t kDynLds = 160 * 1024;
  static int grid_blocks = 0;
  if (!grid_blocks) {
    int dev = 0, cus = 0, per_cu = 0;
    (void)hipGetDevice(&dev);
    (void)hipDeviceGetAttribute(&cus, hipDeviceAttributeMultiprocessorCount, dev);
    (void)hipFuncSetAttribute((const void*)mega, hipFuncAttributeMaxDynamicSharedMemorySize, (int)kDynLds);
    (void)hipOccupancyMaxActiveBlocksPerMultiprocessor(&per_cu, mega, 512, kDynLds);
    grid_blocks = per_cu > 0 ? cus : 0;
    if (grid_blocks > 256) grid_blocks = 256;
    grid_blocks &= ~7;
    if (ws_size < WS_END) { fprintf(stderr, "workspace too small: %zu < %zu\n", ws_size, (size_t)WS_END); grid_blocks = 0; }
  }
  if (grid_blocks <= 0) return;
  Params p{};
  const float** pp = (const float**)&p;
  for (int i = 0; i < 24; ++i) pp[i] = (const float*)d_in[i];
  p.out = (float*)d_out; p.ws = (char*)d_ws;
  void* args[] = {&p};
  hipError_t e = hipLaunchCooperativeKernel((void*)mega, dim3(grid_blocks), dim3(512), args, kDynLds, stream);
  if (e != hipSuccess) fprintf(stderr, "cooperative launch failed: %s (grid %d)\n", hipGetErrorString(e), grid_blocks);
}
```

```cpp
#include <hip/hip_runtime.h>
#include <hip/hip_cooperative_groups.h>
#include <cstdio>
#include <cstdint>
namespace cg = cooperative_groups;
#ifndef DBG_BAR
#define DBG_BAR 0
#endif
#ifndef DBG_REP_MLSTM
#define DBG_REP_MLSTM 1
#endif
#ifndef DBG_REP_ATTN
#define DBG_REP_ATTN 1
#endif
#ifndef DBG_REP_MOE
#define DBG_REP_MOE 1
#endif
#ifndef DBG_REP_INPROJ
#define DBG_REP_INPROJ 1
#endif
#ifndef DBG_REP_CVT
#define DBG_REP_CVT 1
#endif
#ifndef DBG_STOP
#define DBG_STOP 99
#endif

typedef unsigned short bf16_t;
typedef short bf16x8 __attribute__((ext_vector_type(8)));
typedef short s16x4 __attribute__((ext_vector_type(4)));
typedef float f32x4 __attribute__((ext_vector_type(4)));
typedef float f32x16 __attribute__((ext_vector_type(16)));
typedef unsigned u32x4 __attribute__((ext_vector_type(4)));
typedef unsigned u32x2 __attribute__((ext_vector_type(2)));
#define LAS __attribute__((address_space(3)))

constexpr int DM = 1024, NB = 8, SEQ = 8192, CTXL = 256, DEPTH = 2;
constexpr int MX = NB * SEQ, MC = NB * CTXL, MT = MX + MC;
constexpr int PLD = 2816;
constexpr int OFF_Q = 0, OFF_K = 512, OFF_V = 1024, OFF_O = 1536, OFF_G = 2048, OFF_CQ = 2064, OFF_CKV = 2448, OFF_KR = 2704, IN_COLS = 2768;
constexpr int SKV = SEQ + CTXL;
constexpr int NE = 16, CAPX = 1024, CAPC = 32;
constexpr int NSLOT = NB * NE * CAPX + NB * NE * CAPC;
constexpr float ALPHA = 1.4142135623730951f;
constexpr float A_SCALE = 0.07216878364870322f;

constexpr size_t al256(size_t v) { return (v + 255) / 256 * 256; }
constexpr size_t WS_H = 0;
constexpr size_t WS_P = WS_H + al256((size_t)MT * 1024 * 2);
constexpr size_t WS_Q = WS_P + al256((size_t)MT * PLD * 2);
constexpr size_t WS_KV = WS_Q + al256((size_t)MT * 768 * 2);
constexpr size_t WS_KR = WS_KV + al256((size_t)NB * SKV * 1024 * 2);
constexpr size_t WS_MIX = WS_KR + al256((size_t)NB * SKV * 64 * 2);
constexpr size_t WS_ACT = WS_P;
constexpr size_t WS_HB = WS_H;
constexpr size_t WS_OUTE = WS_P + al256((size_t)NSLOT * 1024 * 2);
constexpr size_t WS_WGU = WS_MIX;
constexpr size_t WS_WDN = WS_MIX + (size_t)NE * 2048 * 1024 * 2;
constexpr size_t WS_WIN = WS_MIX + al256((size_t)MT * 1024 * 2);
constexpr size_t WS_WUQ = WS_WIN + (size_t)2 * PLD * 1024 * 2;
constexpr size_t WS_WUKV = WS_WUQ + (size_t)2 * 768 * 384 * 2;
constexpr size_t WS_WOUT = WS_WUKV + (size_t)2 * 1024 * 256 * 2;
constexpr size_t WS_MOD = WS_WOUT + (size_t)2 * 1024 * 1024 * 2;
constexpr size_t WS_COS = WS_MOD + al256((size_t)2 * 9 * 6144 * 4);
constexpr size_t WS_SIN = WS_COS + (size_t)SEQ * 32 * 4;
constexpr size_t WS_GATES = WS_SIN + (size_t)SEQ * 32 * 4;
constexpr size_t WS_AFF = WS_GATES + (size_t)MT * 16 * 4;
constexpr size_t WS_IDX = WS_AFF + (size_t)MT * 16 * 4;
constexpr size_t WS_GV = WS_IDX + (size_t)NSLOT * 4;
constexpr size_t WS_TS = WS_GV + (size_t)NSLOT * 4;
constexpr size_t WS_CTXZ = WS_TS + (size_t)MT * 16 * 4;
constexpr size_t WS_END = WS_CTXZ + (size_t)MC * 1024 * 4;
static_assert(WS_OUTE + (size_t)NSLOT * 1024 * 2 <= WS_KR, "out_e overlay");
static_assert(WS_WDN + (size_t)NE * 1024 * 1024 * 2 <= WS_WIN, "expert weights overlay");

struct Params {
  const float *x, *c, *ctx, *c_ctx, *w_mod, *b_mod, *w_in, *b_gates, *conv_w, *conv_b, *m_norm_w, *q_norm_w, *kv_norm_w, *w_uq, *w_ukv, *w_out,
      *ln1_g, *ln1_b, *w_router, *w_gate, *w_up, *w_down, *ln2_g, *ln2_b;
  float* out; char* ws;
};

typedef const __attribute__((address_space(4))) Params& PRef;
__device__ __forceinline__ PRef kparams() { const __attribute__((address_space(4))) Params* kp = (const __attribute__((address_space(4))) Params*)__builtin_amdgcn_kernarg_segment_ptr(); asm volatile("" : "+s"(kp)); return *kp; }
__device__ __forceinline__ int otid() { int t = threadIdx.x; asm volatile("" : "+v"(t)); return t; }
__device__ __forceinline__ int obid() { int t = blockIdx.x; asm volatile("" : "+s"(t)); return t; }
__device__ __forceinline__ int opaque_s(int v) { asm volatile("" : "+s"(v)); return v; }
typedef __bf16 bf16v2_t __attribute__((ext_vector_type(2)));
typedef float f32x2_t __attribute__((ext_vector_type(2)));
__device__ __forceinline__ unsigned cvtpk(float lo, float hi) { const f32x2_t f = {lo, hi}; const bf16v2_t b = __builtin_convertvector(f, bf16v2_t); return __builtin_bit_cast(unsigned, b); }
__device__ __forceinline__ bf16_t f2bf(float v) { return (bf16_t)(cvtpk(v, v) & 0xffffu); }
__device__ __forceinline__ float bf2f(unsigned v) { return __uint_as_float(v << 16); }
__device__ __forceinline__ float bflo(unsigned w) { return __uint_as_float(w << 16); }
__device__ __forceinline__ float bfhi(unsigned w) { return __uint_as_float(w & 0xffff0000u); }
__device__ __forceinline__ float wave_sum(float v) { for (int o = 32; o > 0; o >>= 1) v += __shfl_xor(v, o); return v; }
__device__ __forceinline__ float wave_max(float v) { for (int o = 32; o > 0; o >>= 1) v = fmaxf(v, __shfl_xor(v, o)); return v; }
__device__ __forceinline__ float silu_f(float v) { return v / (1.f + __expf(-v)); }
__device__ __forceinline__ float sigmoid_f(float v) { return 1.f / (1.f + __expf(-v)); }

namespace g8 {
constexpr int BK = 64, HALF = 128, HTB = HALF * BK * 2, STAGE_BYTES = 8 * HTB;
__device__ __forceinline__ int lds_byte(int r, int c) { const int st = (r >> 4) * 2 + (c >> 5), rr = r & 15, cc = c & 31, ob = rr * 64 + cc * 2; return st * 1024 + (ob ^ (((ob >> 9) & 1) << 5)); }
__device__ __forceinline__ void stage_rc(int b, int& R, int& C) { const int st = b / 1024, sb = b % 1024, swz = sb ^ (((sb >> 9) & 1) << 5); R = (st >> 1) * 16 + swz / 64; C = (st & 1) * 32 + (swz % 64) / 2; }

template <bool GATHER>
__device__ __forceinline__ void gemm_tile(LAS unsigned char* lds, const char* __restrict__ Ab, const unsigned (&voffA)[GATHER ? 4 : 2], size_t hstepA, const char* __restrict__ Bb, int K,
                                          f32x4 (&acc)[2][2][4][2]) {
  const int tid = otid(), wid = __builtin_amdgcn_readfirstlane(tid >> 6), lane = tid & 63, wr = wid >> 2, wc = wid & 3, fr = lane & 15, fq = lane >> 4;
  const int nt = K / BK;
  unsigned voffB[2];
#pragma unroll
  for (int i = 0; i < 2; ++i) { int R, C; stage_rc(tid * 16 + i * 8192, R, C); voffB[i] = (unsigned)(R * K + C) * 2u; }
  const char* Bb1 = Bb + (size_t)HALF * K * 2; const char* Ab1 = GATHER ? Ab : Ab + hstepA;
  const unsigned* vA0 = &voffA[0]; const unsigned* vA1 = GATHER ? &voffA[2] : &voffA[0];
  const unsigned ldsw = (unsigned)wid * 1024u;
  const int aoff = lds_byte(wr * 64 + fr, fq * 8), boff = lds_byte(wc * 32 + fr, fq * 8);
#define G8_SA(b, h) (((b) * 2 + (h)) * HTB)
#define G8_SB(b, h) ((4 + (b) * 2 + (h)) * HTB)
#define G8_STAGE(bufoff, gbase, voff, kt) do { _Pragma("unroll") for (int _i = 0; _i < 2; ++_i) \
    __builtin_amdgcn_global_load_lds((const unsigned*)((gbase) + (size_t)(kt) * (BK * 2) + (voff)[_i]), (LAS unsigned*)(lds + (bufoff) + ldsw + _i * 8192), 16, 0, 0); } while (0)
#define G8_LDA(dst, b, h) do { _Pragma("unroll") for (int m = 0; m < 4; ++m) _Pragma("unroll") for (int k = 0; k < 2; ++k) dst[m][k] = *(const LAS bf16x8*)(lds + G8_SA(b, h) + aoff + m * 2048 + k * 1024); } while (0)
#define G8_LDB(dst, b, h) do { _Pragma("unroll") for (int n = 0; n < 2; ++n) _Pragma("unroll") for (int k = 0; k < 2; ++k) dst[n][k] = *(const LAS bf16x8*)(lds + G8_SB(b, h) + boff + n * 2048 + k * 1024); } while (0)
#define G8_MMA(ai, bj, At, Bt) do { __builtin_amdgcn_s_setprio(1); _Pragma("unroll") for (int m = 0; m < 4; ++m) _Pragma("unroll") for (int n = 0; n < 2; ++n) _Pragma("unroll") for (int k = 0; k < 2; ++k) \
    acc[ai][bj][m][n] = __builtin_amdgcn_mfma_f32_16x16x32_bf16(Bt[n][k], At[m][k], acc[ai][bj][m][n], 0, 0, 0); __builtin_amdgcn_s_setprio(0); } while (0)
#define G8_WAIT_V(n) asm volatile("s_waitcnt vmcnt(" #n ")" ::: "memory")
#define G8_WAIT_L(n) asm volatile("s_waitcnt lgkmcnt(" #n ")" ::: "memory")
#define G8_BAR __builtin_amdgcn_s_barrier()
#define G8_SCHED __builtin_amdgcn_sched_barrier(0)
#pragma unroll
  for (int a = 0; a < 2; ++a)
#pragma unroll
    for (int b = 0; b < 2; ++b)
#pragma unroll
      for (int m = 0; m < 4; ++m)
#pragma unroll
        for (int n = 0; n < 2; ++n) acc[a][b][m][n] = (f32x4){0.f, 0.f, 0.f, 0.f};
  bf16x8 At[4][2], B0[2][2], B1[2][2];
  G8_WAIT_V(0); __syncthreads();
  G8_STAGE(G8_SB(0, 0), Bb, voffB, 0); G8_STAGE(G8_SA(0, 0), Ab, vA0, 0); G8_STAGE(G8_SB(0, 1), Bb1, voffB, 0); G8_STAGE(G8_SA(0, 1), Ab1, vA1, 0);
  if (wr == 1) G8_BAR;
  G8_WAIT_V(4); G8_BAR;
  G8_STAGE(G8_SB(1, 0), Bb, voffB, 1); G8_STAGE(G8_SA(1, 0), Ab, vA0, 1); G8_STAGE(G8_SB(1, 1), Bb1, voffB, 1);
  G8_WAIT_V(6); G8_BAR;
  for (int t = 0; t < nt - 2; t += 2) {
    G8_LDB(B0, 0, 0); G8_SCHED; G8_LDA(At, 0, 0); G8_STAGE(G8_SA(1, 1), Ab1, vA1, t + 1);
    G8_WAIT_L(8); G8_BAR; G8_WAIT_L(0); G8_MMA(0, 0, At, B0); G8_BAR; G8_SCHED;
    G8_LDB(B1, 0, 1); G8_STAGE(G8_SB(0, 0), Bb, voffB, t + 2);
    G8_BAR; G8_WAIT_L(0); G8_MMA(0, 1, At, B1); G8_BAR;
    G8_LDA(At, 0, 1); G8_STAGE(G8_SA(0, 0), Ab, vA0, t + 2);
    G8_BAR; G8_WAIT_L(0); G8_MMA(1, 0, At, B0); G8_BAR; G8_SCHED;
    G8_STAGE(G8_SB(0, 1), Bb1, voffB, t + 2);
    G8_WAIT_V(6); G8_BAR; G8_MMA(1, 1, At, B1); G8_BAR;
    G8_LDB(B0, 1, 0); G8_SCHED; G8_LDA(At, 1, 0); G8_STAGE(G8_SA(0, 1), Ab1, vA1, t + 2);
    G8_WAIT_L(8); G8_BAR; G8_WAIT_L(0); G8_MMA(0, 0, At, B0); G8_BAR; G8_SCHED;
    G8_LDB(B1, 1, 1); G8_STAGE(G8_SB(1, 0), Bb, voffB, t + 3);
    G8_BAR; G8_WAIT_L(0); G8_MMA(0, 1, At, B1); G8_BAR;
    G8_LDA(At, 1, 1); G8_STAGE(G8_SA(1, 0), Ab, vA0, t + 3);
    G8_BAR; G8_WAIT_L(0); G8_MMA(1, 0, At, B0); G8_BAR; G8_SCHED;
    G8_STAGE(G8_SB(1, 1), Bb1, voffB, t + 3);
    G8_WAIT_V(6); G8_BAR; G8_MMA(1, 1, At, B1); G8_BAR;
  }
  { G8_LDB(B0, 0, 0); G8_LDA(At, 0, 0); G8_STAGE(G8_SA(1, 1), Ab1, vA1, nt - 1);
    G8_BAR; G8_WAIT_L(0); G8_MMA(0, 0, At, B0); G8_BAR;
    G8_LDB(B1, 0, 1); G8_BAR; G8_WAIT_L(0); G8_MMA(0, 1, At, B1); G8_BAR;
    G8_LDA(At, 0, 1); G8_WAIT_V(4); G8_BAR; G8_WAIT_L(0); G8_MMA(1, 0, At, B0); G8_MMA(1, 1, At, B1); G8_BAR; }
  { G8_LDB(B0, 1, 0); G8_LDA(At, 1, 0); G8_WAIT_V(2); G8_BAR; G8_WAIT_L(0); G8_MMA(0, 0, At, B0); G8_BAR;
    G8_LDB(B1, 1, 1); G8_WAIT_V(0); G8_BAR; G8_WAIT_L(0); G8_MMA(0, 1, At, B1); G8_BAR;
    G8_LDA(At, 1, 1); G8_BAR; G8_WAIT_L(0); G8_MMA(1, 0, At, B0); G8_MMA(1, 1, At, B1); G8_BAR; }
  if (wr == 0) G8_BAR;
}
__device__ __forceinline__ unsigned piece_off(int i, int ld, int c0) { int R, C; stage_rc((int)otid() * 16 + i * 8192, R, C); return (unsigned)(R * ld + c0 + C) * 2u; }
__device__ __forceinline__ void piece_rc(int i, int& R, int& C) { stage_rc((int)otid() * 16 + i * 8192, R, C); }
struct TileIter {
  int nM, nN, x, j, J, cnt, idx;
  __device__ __forceinline__ void init(int nM_, int nN_) { nM = nM_; nN = nN_; x = obid() & 7; j = obid() >> 3; J = gridDim.x >> 3; cnt = ((nM - x + 7) >> 3) * nN; idx = j; }
  __device__ __forceinline__ bool next(int& pm, int& pn) { if (idx >= cnt) return false; pm = x + 8 * (idx / nN); pn = idx % nN; idx += J; return true; }
};
struct MoeIter {
  int nN, x, jm, jn, j, step, nsteps, nb4; bool with_ctx, ctx_done;
  __device__ __forceinline__ void init(int nN_, bool with_ctx_) { nN = nN_; with_ctx = with_ctx_; x = obid() & 7; j = obid() >> 3; jm = j & 7; jn = j >> 3; nb4 = nN >> 2; nsteps = 2 * nb4 * 4; step = 0; ctx_done = false; }
  __device__ __forceinline__ bool next(int& pm, int& pn, int& e) {
    if (step < nsteps) { const int mb = step & 3, nb = (step >> 2) % nb4, el = (step >> 2) / nb4; e = 2 * x + el; const int m32 = mb * 8 + jm; pm = ((m32 >> 2) * 16 + e) * 4 + (m32 & 3); pn = nb * 4 + jn; ++step; return true; }
    if (with_ctx && !ctx_done) { ctx_done = true; if (j < 2 * nN) { e = 2 * x + j / nN; pm = 512 + e; pn = j % nN; return true; } }
    return false;
  }
};
}

#define ACC_FOR(ai, bj, m, n) _Pragma("unroll") for (int ai = 0; ai < 2; ++ai) _Pragma("unroll") for (int bj = 0; bj < 2; ++bj) _Pragma("unroll") for (int m = 0; m < 4; ++m) _Pragma("unroll") for (int n = 0; n < 2; ++n)

__device__ __forceinline__ void cvt_tile(const float* __restrict__ src, int N, int K, int k0, int n0, bf16_t* __restrict__ dst, long drow0, const float* __restrict__ kscale, float* lds) {
  const int tid = otid();
  { const int kr = tid >> 6, n = tid & 63;
#pragma unroll
    for (int i = 0; i < 8; ++i) { const int k = kr + 8 * i; float v = (n0 + n < N) ? src[(size_t)(k0 + k) * N + n0 + n] : 0.f; if (kscale) v *= kscale[k0 + k]; lds[k * 65 + n] = v; } }
  __syncthreads();
  { const int n = tid >> 3, k8 = (tid & 7) * 8; float v[8];
#pragma unroll
    for (int i = 0; i < 8; ++i) v[i] = lds[(k8 + i) * 65 + n];
    u32x4 w = {cvtpk(v[0], v[1]), cvtpk(v[2], v[3]), cvtpk(v[4], v[5]), cvtpk(v[6], v[7])};
    *(u32x4*)(dst + (size_t)(drow0 + n) * K + k0 + k8) = w; }
  __syncthreads();
}

__device__ void phase_prep(PRef p, char* smem) {
  float* lds = (float*)smem;
  bf16_t* Wt_in = (bf16_t*)(p.ws + WS_WIN); bf16_t* Wt_uq = (bf16_t*)(p.ws + WS_WUQ); bf16_t* Wt_ukv = (bf16_t*)(p.ws + WS_WUKV); bf16_t* Wt_out = (bf16_t*)(p.ws + WS_WOUT);
  float* mod = (float*)(p.ws + WS_MOD);
  constexpr int T_MOD = 192, T_IN = 2 * 16 * 44, T_UQ = 2 * 6 * 12, T_UKV = 2 * 4 * 16, T_OUT = 2 * 16 * 16, T_ROPE = 64;
  constexpr int E0 = T_MOD, E1 = E0 + T_IN, E2 = E1 + T_UQ, E3 = E2 + T_UKV, E4 = E3 + T_OUT, E5 = E4 + T_ROPE;
  const int tid = otid();
  for (int task = obid(); task < E5; task += gridDim.x) {
    if (task < E0) {
      const int l = task / 96, j0 = (task % 96) * 64;
      float* sc = lds;
      for (int i = tid; i < 9 * 1024; i += 512) { const int bb = i >> 10, d = i & 1023; const float v = bb < 8 ? p.c[bb * 1024 + d] : p.c_ctx[d]; sc[i] = v / (1.f + expf(-v)); }
      __syncthreads();
      const int col = tid & 63, ks = tid >> 6; float a[9];
#pragma unroll
      for (int bb = 0; bb < 9; ++bb) a[bb] = 0.f;
      const float* wm = p.w_mod + (size_t)l * 1024 * 6144 + j0 + col;
      for (int d = ks * 128; d < ks * 128 + 128; ++d) { const float w = wm[(size_t)d * 6144];
#pragma unroll
        for (int bb = 0; bb < 9; ++bb) a[bb] += sc[bb * 1024 + d] * w; }
      float* red = lds + 9 * 1024;
#pragma unroll
      for (int bb = 0; bb < 9; ++bb) red[(ks * 9 + bb) * 64 + col] = a[bb];
      __syncthreads();
      for (int i = tid; i < 9 * 64; i += 512) { const int bb = i >> 6, cc = i & 63; float s = 0.f;
        for (int k = 0; k < 8; ++k) s += red[(k * 9 + bb) * 64 + cc];
        mod[((size_t)l * 9 + bb) * 6144 + j0 + cc] = s + p.b_mod[l * 6144 + j0 + cc]; }
      __syncthreads();
    } else if (task < E1) { const int t = task - E0, l = t / 704, r = t % 704, kt = r / 44, nt = r % 44;
      cvt_tile(p.w_in + (size_t)l * 1024 * IN_COLS, IN_COLS, 1024, kt * 64, nt * 64, Wt_in + (size_t)l * PLD * 1024, nt * 64, nullptr, lds);
    } else if (task < E2) { const int t = task - E1, l = t / 72, r = t % 72, kt = r / 12, nt = r % 12;
      cvt_tile(p.w_uq + (size_t)l * 384 * 768, 768, 384, kt * 64, nt * 64, Wt_uq + (size_t)l * 768 * 384, nt * 64, p.q_norm_w + l * 384, lds);
    } else if (task < E3) { const int t = task - E2, l = t / 64, r = t % 64, kt = r / 16, nt = r % 16;
      cvt_tile(p.w_ukv + (size_t)l * 256 * 1024, 1024, 256, kt * 64, nt * 64, Wt_ukv + (size_t)l * 1024 * 256, nt * 64, p.kv_norm_w + l * 256, lds);
    } else if (task < E4) { const int t = task - E3, l = t / 256, r = t % 256, kt = r / 16, nt = r % 16;
      cvt_tile(p.w_out + (size_t)l * 1024 * 1024, 1024, 1024, kt * 64, nt * 64, Wt_out + (size_t)l * 1024 * 1024, nt * 64, nullptr, lds);
    } else {
      float* cs = (float*)(p.ws + WS_COS); float* sn = (float*)(p.ws + WS_SIN);
      for (int i = (task - E4) * 4096 + tid; i < (task - E4 + 1) * 4096; i += 512) { const int t = i >> 5, j = i & 31;
        const float inv = exp2f(-(float)(j & 15) * (13.287712379549449f / 16.f));
        const float pos = (float)(j < 16 ? (t >> 6) : (t & 63)); const float ang = pos * inv;
        const double a = (double)ang; const double k = rint(a * 0.15915494309189535); const float r = (float)(a - k * 6.283185307179586);
        cs[i] = __cosf(r); sn[i] = __sinf(r); }
    }
  }
}

__device__ void phase_cvt_experts(PRef p, int l, char* smem) {
  float* lds = (float*)smem;
  bf16_t* Wgu = (bf16_t*)(p.ws + WS_WGU); bf16_t* Wdn = (bf16_t*)(p.ws + WS_WDN);
  for (int task = obid(); task < NE * 768; task += gridDim.x) {
    const int e = task / 768, r = task % 768, which = r >> 8, kt = (r & 255) >> 4, nt = r & 15, n0 = nt * 64;
    const size_t eo = ((size_t)l * NE + e) * 1024 * 1024;
    if (which == 0) cvt_tile(p.w_gate + eo, 1024, 1024, kt * 64, n0, Wgu + (size_t)e * 2048 * 1024, (n0 >> 7) * 256 + (n0 & 127), nullptr, lds);
    else if (which == 1) cvt_tile(p.w_up + eo, 1024, 1024, kt * 64, n0, Wgu + (size_t)e * 2048 * 1024, (n0 >> 7) * 256 + 128 + (n0 & 127), nullptr, lds);
    else cvt_tile(p.w_down + eo, 1024, 1024, kt * 64, n0, Wdn + (size_t)e * 1024 * 1024, n0, nullptr, lds);
  }
}

__device__ __forceinline__ void ln_row(f32x4 (&v)[4], float eps) {
  float s = 0.f;
#pragma unroll
  for (int i = 0; i < 4; ++i) s += v[i][0] + v[i][1] + v[i][2] + v[i][3];
  const float mu = wave_sum(s) * (1.f / 1024.f);
  float q = 0.f;
#pragma unroll
  for (int i = 0; i < 4; ++i)
#pragma unroll
    for (int k = 0; k < 4; ++k) { v[i][k] -= mu; q += v[i][k] * v[i][k]; }
  const float rs = rsqrtf(wave_sum(q) * (1.f / 1024.f) + eps);
#pragma unroll
  for (int i = 0; i < 4; ++i) v[i] *= rs;
}
__device__ __forceinline__ void store_mod_bf16(const f32x4 (&v)[4], const float* __restrict__ shift, const float* __restrict__ scale, bf16_t* __restrict__ hrow, int lane, f32x4 (*keep)[4]) {
#pragma unroll
  for (int i = 0; i < 4; ++i) { const int c = lane * 4 + 256 * i; const f32x4 sh = *(const f32x4*)(shift + c), sc = *(const f32x4*)(scale + c);
    f32x4 o = v[i] * (sc + 1.f) + sh; if (keep) (*keep)[i] = o;
    u32x2 w = {cvtpk(o[0], o[1]), cvtpk(o[2], o[3])}; *(u32x2*)(hrow + c) = w; }
}
__device__ __forceinline__ const float* mod_ptr(PRef p, int l, int row, int which) {
  const int bb = row < MX ? (row >> 13) : 8;
  return (const float*)(p.ws + WS_MOD) + ((size_t)l * 9 + bb) * 6144 + which * 1024;
}

__device__ void phase_h0(PRef p) {
  const int lane = otid() & 63, gw = obid() * 8 + (otid() >> 6), nw = gridDim.x * 8;
  bf16_t* h = (bf16_t*)(p.ws + WS_H);
  for (int row = gw; row < MT; row += nw) {
    const float* src = row < MX ? p.x + (size_t)row * 1024 : p.ctx + (size_t)(row - MX) * 1024;
    f32x4 v[4];
#pragma unroll
    for (int i = 0; i < 4; ++i) v[i] = *(const f32x4*)(src + lane * 4 + 256 * i);
    ln_row(v, 1e-6f);
    store_mod_bf16(v, mod_ptr(p, 0, row, 0), mod_ptr(p, 0, row, 1), h + (size_t)row * 1024, lane, nullptr);
  }
}

__device__ void phase_inproj(PRef p, int l, char* smem) {
  LAS unsigned char* lds = (LAS unsigned char*)smem;
  const bf16_t* h = (const bf16_t*)(p.ws + WS_H); const bf16_t* Wt = (const bf16_t*)(p.ws + WS_WIN) + (size_t)l * PLD * 1024;
  bf16_t* P = (bf16_t*)(p.ws + WS_P); float* gates = (float*)(p.ws + WS_GATES);
  const int tid = otid(), wid = tid >> 6, lane = tid & 63, wr = wid >> 2, wc = wid & 3, fr = lane & 15, fq = lane >> 4;
  g8::TileIter it; it.init(MT / 256, PLD / 256);
  int pm, pn;
  while (it.next(pm, pn)) {
    unsigned voffA[2] = {g8::piece_off(0, 1024, 0), g8::piece_off(1, 1024, 0)};
    f32x4 acc[2][2][4][2];
    g8::gemm_tile<false>(lds, (const char*)(h + (size_t)pm * 256 * 1024), voffA, (size_t)128 * 1024 * 2, (const char*)(Wt + (size_t)pn * 256 * 1024), 1024, acc);
    ACC_FOR(ai, bj, m, n) {
      const int row = pm * 256 + ai * 128 + wr * 64 + m * 16 + fr, col = pn * 256 + bj * 128 + wc * 32 + n * 16 + fq * 4;
      const f32x4 v = acc[ai][bj][m][n];
      u32x2 w = {cvtpk(v[0], v[1]), cvtpk(v[2], v[3])}; *(u32x2*)(P + (size_t)row * PLD + col) = w;
      if (col >= OFF_G && col < OFF_G + 16) { const f32x4 bg = *(const f32x4*)(p.b_gates + l * 16 + (col - OFF_G)); *(f32x4*)(gates + (size_t)row * 16 + (col - OFF_G)) = v + bg; }
    }
  }
}


__device__ void phase_mlstm(PRef p, int l, char* smem, size_t hb_off = WS_HB) {
  bf16_t* RAWQ = (bf16_t*)(smem); bf16_t* RAWK = (bf16_t*)(smem + 17408);
  bf16_t* QB = (bf16_t*)(smem + 34816); bf16_t* KB = (bf16_t*)(smem + 52224);
  bf16_t* KT = (bf16_t*)(smem + 69632);
  bf16_t* VT = (bf16_t*)(smem + 88064); bf16_t* VWT = (bf16_t*)(smem + 94976);
  bf16_t* PB = (bf16_t*)(smem + 101888);
  bf16_t* CT = (bf16_t*)(smem + 111104);
  float* SC = (float*)(smem + 124160);
  const bf16_t* P = (const bf16_t*)(p.ws + WS_P); const float* gates = (const float*)(p.ws + WS_GATES);
  bf16_t* hbuf = (bf16_t*)(p.ws + hb_off);
  const int tid = otid(), wid = tid >> 6, lane = tid & 63, fr = lane & 15, fq = lane >> 4;
  for (int w = obid(); w < 256; w += gridDim.x) {
    const int slice = w & 3, dir = (w >> 2) & 1, hd = (w >> 3) & 3, b = w >> 5;
    const int c2 = (tid & 63) * 2;
    float wq0[5], wq1[5], wk0[5], wk1[5];
#pragma unroll
    for (int j = 0; j < 5; ++j) { const float* cw = p.conv_w + ((size_t)l * 5 + j) * 1024; wq0[j] = cw[hd * 128 + c2]; wq1[j] = cw[hd * 128 + c2 + 1]; wk0[j] = cw[512 + hd * 128 + c2]; wk1[j] = cw[512 + hd * 128 + c2 + 1]; }
    const float bq0 = p.conv_b[l * 1024 + hd * 128 + c2], bq1 = p.conv_b[l * 1024 + hd * 128 + c2 + 1], bk0 = p.conv_b[l * 1024 + 512 + hd * 128 + c2], bk1 = p.conv_b[l * 1024 + 512 + hd * 128 + c2 + 1];
    __syncthreads();
    for (int i = tid; i < 48 * 136 / 2; i += 512) ((unsigned*)CT)[i] = 0u;
    for (int i = tid; i < 48 * 72 / 2; i += 512) { ((unsigned*)VT)[i] = 0u; ((unsigned*)VWT)[i] = 0u; }
    f32x4 accC[3];
#pragma unroll
    for (int i = 0; i < 3; ++i) accC[i] = (f32x4){0.f, 0.f, 0.f, 0.f};
    float m_state = 0.f;
    __syncthreads();
    for (int ci = 0; ci < 132; ++ci) {
      const bool isctx = ci < 4; const int cc = isctx ? ci : ci - 4, T = isctx ? CTXL : SEQ, rowbase = isctx ? MX + b * CTXL : b * SEQ;
      const int tlo = dir ? T - 64 - cc * 64 : cc * 64;
      float* S = SC + (ci & 1) * 384;
      const bool need_out = !(l == DEPTH - 1 && isctx);
      if (wid == 0) {
        const int t = dir ? tlo + 63 - lane : tlo + lane;
        const float* g = gates + (size_t)(rowbase + t) * 16;
        const float ig = g[dir * 8 + hd], fg = g[dir * 8 + 4 + hd];
        const float lf = fminf(fg, 0.f) - log1pf(expf(-fabsf(fg)));
        float bc = lf;
#pragma unroll
        for (int o = 1; o < 64; o <<= 1) { const float u = __shfl_up(bc, o); if (lane >= o) bc += u; }
        const float a = ig - bc; float pmx = a;
#pragma unroll
        for (int o = 1; o < 64; o <<= 1) { const float u = __shfl_up(pmx, o); if (lane >= o) pmx = fmaxf(pmx, u); }
        const float Mx = fmaxf(pmx, m_state), M63 = __shfl(Mx, 63), b63 = __shfl(bc, 63);
        S[lane] = a; S[64 + lane] = Mx; S[128 + lane] = expf(m_state - Mx); S[192 + lane] = expf(-(bc + Mx)); S[256 + lane] = expf(a - M63);
        if (lane == 0) { S[320] = expf(m_state - M63); S[321] = b63 + M63; }
      }
      for (int pc = tid; pc < 2176; pc += 512) {
        const int tens = pc >= 1088, rem = tens ? pc - 1088 : pc, rr = rem >> 4, c16 = rem & 15, t = tlo - 2 + rr;
        u32x4 v = {0u, 0u, 0u, 0u};
        if (t >= 0 && t < T) v = *(const u32x4*)(P + (size_t)(rowbase + t) * PLD + (tens ? OFF_K : OFF_Q) + hd * 128 + c16 * 8);
        *(u32x4*)((tens ? RAWK : RAWQ) + rr * 128 + c16 * 8) = v;
      }
      const int vl = tid >> 3, ve4 = (tid & 7) * 4, vt = dir ? tlo + 63 - vl : tlo + vl;
      const u32x2 vraw = *(const u32x2*)(P + (size_t)(rowbase + vt) * PLD + OFF_V + hd * 128 + slice * 32 + ve4);
      __syncthreads();
      {
        const int rg = wid; unsigned rq[12], rk[12];
#pragma unroll
        for (int i = 0; i < 12; ++i) { rq[i] = *(const unsigned*)(RAWQ + (rg * 8 + i) * 128 + c2); rk[i] = *(const unsigned*)(RAWK + (rg * 8 + i) * 128 + c2); }
#pragma unroll
        for (int jj = 0; jj < 8; ++jj) {
          float yq0 = bq0, yq1 = bq1, yk0 = bk0, yk1 = bk1;
#pragma unroll
          for (int tp = 0; tp < 5; ++tp) { yq0 += wq0[tp] * bflo(rq[jj + tp]); yq1 += wq1[tp] * bfhi(rq[jj + tp]); yk0 += wk0[tp] * bflo(rk[jj + tp]); yk1 += wk1[tp] * bfhi(rk[jj + tp]); }
          const int j = rg * 8 + jj, lr = dir ? 63 - j : j;
          const float q0 = silu_f(yq0) * 0.08838834764831845f, q1 = silu_f(yq1) * 0.08838834764831845f, k0 = silu_f(yk0), k1 = silu_f(yk1);
          *(unsigned*)(QB + lr * 136 + c2) = cvtpk(q0, q1);
          const unsigned kw = cvtpk(k0, k1);
          *(unsigned*)(KB + lr * 136 + c2) = kw;
          KT[c2 * 72 + lr] = (bf16_t)(kw & 0xffffu); KT[(c2 + 1) * 72 + lr] = (bf16_t)(kw >> 16);
        }
        const float wsl = S[256 + vl];
        const float v0 = bflo(vraw[0]), v1 = bfhi(vraw[0]), v2 = bflo(vraw[1]), v3 = bfhi(vraw[1]);
        VT[(ve4 + 0) * 72 + vl] = (bf16_t)(vraw[0] & 0xffffu); VT[(ve4 + 1) * 72 + vl] = (bf16_t)(vraw[0] >> 16);
        VT[(ve4 + 2) * 72 + vl] = (bf16_t)(vraw[1] & 0xffffu); VT[(ve4 + 3) * 72 + vl] = (bf16_t)(vraw[1] >> 16);
        VWT[(ve4 + 0) * 72 + vl] = f2bf(v0 * wsl); VWT[(ve4 + 1) * 72 + vl] = f2bf(v1 * wsl); VWT[(ve4 + 2) * 72 + vl] = f2bf(v2 * wsl); VWT[(ve4 + 3) * 72 + vl] = f2bf(v3 * wsl);
        if (tid < 64) { VT[32 * 72 + tid] = (bf16_t)0x3F80u; VWT[32 * 72 + tid] = f2bf(S[256 + tid]); }
      }
      __syncthreads();
      if (need_out) {
        const int mt = wid >> 1;
#pragma unroll
        for (int u = 0; u < 2; ++u) {
          const int ntl = (wid & 1) * 2 + u;
          f32x4 s = {0.f, 0.f, 0.f, 0.f};
          if (ntl <= mt) {
#pragma unroll
            for (int kk = 0; kk < 4; ++kk) {
              const bf16x8 a = *(const bf16x8*)(QB + (mt * 16 + fr) * 136 + kk * 32 + fq * 8), bb = *(const bf16x8*)(KB + (ntl * 16 + fr) * 136 + kk * 32 + fq * 8);
              s = __builtin_amdgcn_mfma_f32_16x16x32_bf16(a, bb, s, 0, 0, 0); }
          }
          const int j = ntl * 16 + fr; const float aj = S[j];
#pragma unroll
          for (int jj = 0; jj < 4; ++jj) { const int lr = mt * 16 + fq * 4 + jj;
            const float pv = (j <= lr) ? s[jj] * __expf(fminf(aj - S[64 + lr], 0.f)) : 0.f;
            PB[lr * 72 + j] = f2bf(pv); }
        }
      }
      __syncthreads();
      if (need_out && wid < 4) {
        const int mt = wid; f32x4 num[3];
#pragma unroll
        for (int ntl = 0; ntl < 3; ++ntl) {
          f32x4 a1 = {0.f, 0.f, 0.f, 0.f}, a2 = {0.f, 0.f, 0.f, 0.f};
#pragma unroll
          for (int kk = 0; kk < 2; ++kk) { const bf16x8 a = *(const bf16x8*)(PB + (mt * 16 + fr) * 72 + kk * 32 + fq * 8), bb = *(const bf16x8*)(VT + (ntl * 16 + fr) * 72 + kk * 32 + fq * 8);
            a1 = __builtin_amdgcn_mfma_f32_16x16x32_bf16(a, bb, a1, 0, 0, 0); }
#pragma unroll
          for (int kk = 0; kk < 4; ++kk) { const bf16x8 a = *(const bf16x8*)(QB + (mt * 16 + fr) * 136 + kk * 32 + fq * 8), bb = *(const bf16x8*)(CT + (ntl * 16 + fr) * 136 + kk * 32 + fq * 8);
            a2 = __builtin_amdgcn_mfma_f32_16x16x32_bf16(a, bb, a2, 0, 0, 0); }
#pragma unroll
          for (int jj = 0; jj < 4; ++jj) num[ntl][jj] = a1[jj] + S[128 + mt * 16 + fq * 4 + jj] * a2[jj];
        }
#pragma unroll
        for (int jj = 0; jj < 4; ++jj) {
          const int lr = mt * 16 + fq * 4 + jj; const float den = __shfl(num[2][jj], lane & 48);
          const float rd = 1.f / fmaxf(fabsf(den), S[192 + lr]);
          const int t = dir ? tlo + 63 - lr : tlo + lr;
          bf16_t* hp = hbuf + ((size_t)((dir * 4 + hd) * 4 + slice) * MT + rowbase + t) * 32 + fr;
          hp[0] = f2bf(num[0][jj] * rd); hp[16] = f2bf(num[1][jj] * rd);
#if DBG_STOP == 23
          { const size_t di = (size_t)(hp - hbuf); if (di + 16 < (size_t)MX * 1024) { p.out[di] = num[0][jj] * rd; p.out[di + 16] = num[1][jj] * rd; } }
#endif
        }
      }
      __syncthreads();
      {
        const float decay = S[320];
#pragma unroll
        for (int mt = 0; mt < 3; ++mt) {
          accC[mt] *= decay;
#pragma unroll
          for (int kk = 0; kk < 2; ++kk) { const bf16x8 a = *(const bf16x8*)(VWT + (mt * 16 + fr) * 72 + kk * 32 + fq * 8), bb = *(const bf16x8*)(KT + (wid * 16 + fr) * 72 + kk * 32 + fq * 8);
            accC[mt] = __builtin_amdgcn_mfma_f32_16x16x32_bf16(a, bb, accC[mt], 0, 0, 0); }
#pragma unroll
          for (int jj = 0; jj < 4; ++jj) CT[(mt * 16 + fq * 4 + jj) * 136 + wid * 16 + fr] = f2bf(accC[mt][jj]);
        }
        m_state = S[321];
      }
    }
  }
}

template <int WHICH>
__device__ __forceinline__ void mla_gemm(PRef p, int l, char* smem) {
  LAS unsigned char* lds = (LAS unsigned char*)smem; float* rsb = (float*)(smem + g8::STAGE_BYTES);
  const bf16_t* P = (const bf16_t*)(p.ws + WS_P);
  const int tid = otid(), wid = tid >> 6, lane = tid & 63, wr = wid >> 2, wc = wid & 3, fr = lane & 15, fq = lane >> 4;
  constexpr int K = WHICH ? 256 : 384, OFFC = WHICH ? OFF_CKV : OFF_CQ, N = WHICH ? 1024 : 768;
  const bf16_t* Wt = WHICH ? (const bf16_t*)(p.ws + WS_WUKV) + (size_t)l * 1024 * 256 : (const bf16_t*)(p.ws + WS_WUQ) + (size_t)l * 768 * 384;
  bf16_t* O = (bf16_t*)(p.ws + (WHICH ? WS_KV : WS_Q));
  g8::TileIter it; it.init((WHICH || l == 0) ? MT / 256 : MX / 256, N / 256);
  int pm, pn;
  while (it.next(pm, pn)) {
    __syncthreads();
    { const int r = tid >> 1, hf = tid & 1; const bf16_t* src = P + (size_t)(pm * 256 + r) * PLD + OFFC + hf * (K / 2); float s = 0.f;
#pragma unroll 4
      for (int i = 0; i < K / 16; ++i) { const u32x4 v = *(const u32x4*)(src + i * 8);
#pragma unroll
        for (int k = 0; k < 4; ++k) { const float a = bflo(v[k]), bq = bfhi(v[k]); s += a * a + bq * bq; } }
      s += __shfl_xor(s, 1);
      if (hf == 0) rsb[r] = rsqrtf(s / (float)K + 1e-6f); }
    unsigned voffA[2] = {g8::piece_off(0, PLD, OFFC), g8::piece_off(1, PLD, OFFC)};
    f32x4 acc[2][2][4][2];
    g8::gemm_tile<false>(lds, (const char*)(P + (size_t)pm * 256 * PLD), voffA, (size_t)128 * PLD * 2, (const char*)(Wt + (size_t)pn * 256 * K), opaque_s(K), acc);
    ACC_FOR(ai, bj, m, n) {
      const int rl = ai * 128 + wr * 64 + m * 16 + fr, row = pm * 256 + rl, col = pn * 256 + bj * 128 + wc * 32 + n * 16 + fq * 4;
      const f32x4 v = acc[ai][bj][m][n] * rsb[rl];
      size_t orow = row;
      if (WHICH) orow = row < MX ? (size_t)(row >> 13) * SKV + CTXL + (row & 8191) : (size_t)((row - MX) >> 8) * SKV + ((row - MX) & 255);
      u32x2 w = {cvtpk(v[0], v[1]), cvtpk(v[2], v[3])}; *(u32x2*)(O + orow * N + col) = w;
    }
  }
}
__device__ void phase_mla_prep(PRef p, int l, char* smem) {
  mla_gemm<0>(p, l, smem);
  mla_gemm<1>(p, l, smem);
  const bf16_t* P = (const bf16_t*)(p.ws + WS_P);
  const int tid = otid(), wid = tid >> 6, lane = tid & 63;
  const bf16_t* hbuf = (const bf16_t*)(p.ws + WS_HB); bf16_t* mix = (bf16_t*)(p.ws + WS_MIX); bf16_t* KR = (bf16_t*)(p.ws + WS_KR);
  const float* cs = (const float*)(p.ws + WS_COS); const float* sn = (const float*)(p.ws + WS_SIN);
  const int gw = obid() * 8 + wid, nw = gridDim.x * 8;
  for (int row = gw; row < MT; row += nw) {
    if (row < MX || l == 0) {
      const size_t ho = ((size_t)(lane >> 2) * MT + row) * 32 + (lane & 3) * 8;
      const u32x4 hf = *(const u32x4*)(hbuf + ho), hb = *(const u32x4*)(hbuf + (size_t)16 * MT * 32 + ho);
      const u32x4 ov = *(const u32x4*)(P + (size_t)row * PLD + OFF_O + lane * 8);
      float v[8]; float s = 0.f;
#pragma unroll
      for (int k = 0; k < 4; ++k) { v[2 * k] = bflo(hf[k]) + bflo(hb[k]); v[2 * k + 1] = bfhi(hf[k]) + bfhi(hb[k]); s += v[2 * k] + v[2 * k + 1]; }
      s += __shfl_xor(s, 1); s += __shfl_xor(s, 2); s += __shfl_xor(s, 4); s += __shfl_xor(s, 8);
      const float mu = s * (1.f / 128.f); float q = 0.f;
#pragma unroll
      for (int k = 0; k < 8; ++k) { v[k] -= mu; q += v[k] * v[k]; }
      q += __shfl_xor(q, 1); q += __shfl_xor(q, 2); q += __shfl_xor(q, 4); q += __shfl_xor(q, 8);
      const float rs = rsqrtf(q * (1.f / 128.f) + 1e-6f);
      const float* nw_ = p.m_norm_w + l * 512 + lane * 8; float o[8];
#pragma unroll
      for (int k = 0; k < 4; ++k) { o[2 * k] = v[2 * k] * rs * nw_[2 * k] * sigmoid_f(bflo(ov[k])); o[2 * k + 1] = v[2 * k + 1] * rs * nw_[2 * k + 1] * sigmoid_f(bfhi(ov[k])); }
      u32x4 wv = {cvtpk(o[0], o[1]), cvtpk(o[2], o[3]), cvtpk(o[4], o[5]), cvtpk(o[6], o[7])};
      *(u32x4*)(mix + (size_t)row * 1024 + lane * 8) = wv;
    }
    {
      const int j = lane & 31;
      const float x1 = bf2f(P[(size_t)row * PLD + OFF_KR + j]), x2 = bf2f(P[(size_t)row * PLD + OFF_KR + 32 + j]);
      float o1 = x1, o2 = x2; size_t orow;
      if (row < MX) { const int t = row & 8191; const float c = cs[t * 32 + j], s_ = sn[t * 32 + j]; o1 = x1 * c - x2 * s_; o2 = x2 * c + x1 * s_; orow = (size_t)(row >> 13) * SKV + CTXL + t; }
      else orow = (size_t)((row - MX) >> 8) * SKV + ((row - MX) & 255);
      if (lane < 32) { KR[orow * 64 + j] = f2bf(o1); KR[orow * 64 + 32 + j] = f2bf(o2); }
    }
  }
}

namespace att {
constexpr int NW = 8, QBLK = 32, KVBLK = 64, LDQ = 768, LDK = 1024, LDKR = 64, LDO = 1024;
constexpr float SCALE = A_SCALE;
constexpr float THR = 8.f;
constexpr size_t SHM_V = KVBLK * 128 * 2, SHM_K = KVBLK * 128 * 2, SHM_R = KVBLK * 64 * 2;
typedef float f32x8 __attribute__((ext_vector_type(8)));
#define KSWZ(row, colB) ((row) * 256 + ((colB) ^ (((row) & 7) << 4)))
#define RSWZ(row, colB) ((row) * 128 + ((colB) ^ (((row) & 7) << 4)))
#define SBAR() __builtin_amdgcn_sched_barrier(0)
__device__ __forceinline__ int crow(int r, int hi) { return (r & 3) + 8 * (r >> 2) + 4 * hi; }
__device__ __forceinline__ void partialSM(f32x16& p0, f32x16& p1, float& m_reg, float& mn, float& alpha) {
  constexpr float C = SCALE * 1.4426950408889634f;
  float pmax = p0[0];
#pragma unroll
  for (int r = 1; r < 16; ++r) pmax = fmaxf(pmax, p0[r]);
#pragma unroll
  for (int r = 0; r < 16; ++r) pmax = fmaxf(pmax, p1[r]);
  { auto rr = __builtin_amdgcn_permlane32_swap(__float_as_uint(pmax), __float_as_uint(pmax), false, false);
    pmax = fmaxf(__uint_as_float(rr[0]), __uint_as_float(rr[1])); }
  if (__builtin_expect(__all(pmax - m_reg <= THR / SCALE), 1)) { mn = m_reg; alpha = 1.f; }
  else { mn = fmaxf(m_reg, pmax); alpha = __builtin_amdgcn_exp2f((m_reg - mn) * C); m_reg = mn; }
  const float mnC = -mn * C;
#pragma unroll
  for (int r = 0; r < 16; ++r) p0[r] = fmaf(p0[r], C, mnC);
#pragma unroll
  for (int r = 0; r < 16; ++r) p1[r] = fmaf(p1[r], C, mnC);
#pragma unroll
  for (int r = 0; r < 16; ++r) p0[r] = __builtin_amdgcn_exp2f(p0[r]);
}
__device__ __forceinline__ void finishSM(f32x16& p0, f32x16& p1, float alpha, float& l_reg, bf16x8& pa0, bf16x8& pa1, bf16x8& pa2, bf16x8& pa3) {
#pragma unroll
  for (int r = 0; r < 16; ++r) p1[r] = __builtin_amdgcn_exp2f(p1[r]);
  float ps = 0;
#pragma unroll
  for (int r = 0; r < 16; ++r) ps += p0[r];
#pragma unroll
  for (int r = 0; r < 16; ++r) ps += p1[r];
  { auto rr = __builtin_amdgcn_permlane32_swap(__float_as_uint(ps), __float_as_uint(ps), false, false);
    ps = __uint_as_float(rr[0]) + __uint_as_float(rr[1]); }
  l_reg = l_reg * alpha + ps;
#define PK4(P, BASE, OUT) do { unsigned a0 = cvtpk(P[BASE + 0], P[BASE + 1]), a1 = cvtpk(P[BASE + 2], P[BASE + 3]);   \
    unsigned b0 = cvtpk(P[BASE + 4], P[BASE + 5]), b1 = cvtpk(P[BASE + 6], P[BASE + 7]);                              \
    auto r0 = __builtin_amdgcn_permlane32_swap(a0, b0, false, false); auto r1 = __builtin_amdgcn_permlane32_swap(a1, b1, false, false); \
    u32x4 w = {r0[0], r1[0], r0[1], r1[1]}; OUT = *reinterpret_cast<bf16x8*>(&w); } while (0)
  PK4(p0, 0, pa0); PK4(p0, 8, pa1); PK4(p1, 0, pa2); PK4(p1, 8, pa3);
#undef PK4
}
__device__ __forceinline__ void qkt(f32x16& p0, f32x16& p1, const char* Ks, const char* Rs, const bf16x8* qr, const char* qrl, int r32, int hi) {
  p0 = f32x16{}; p1 = f32x16{};
#pragma unroll
  for (int d0 = 0; d0 < 8; ++d0) { const int cb = (d0 * 16 + hi * 8) * 2;
    const bf16x8 b0 = *reinterpret_cast<const bf16x8*>(Ks + KSWZ(r32, cb));
    const bf16x8 b1 = *reinterpret_cast<const bf16x8*>(Ks + KSWZ(32 + r32, cb));
    p0 = __builtin_amdgcn_mfma_f32_32x32x16_bf16(b0, qr[d0], p0, 0, 0, 0);
    p1 = __builtin_amdgcn_mfma_f32_32x32x16_bf16(b1, qr[d0], p1, 0, 0, 0); }
#pragma unroll
  for (int d0 = 0; d0 < 4; ++d0) { const int cb = (d0 * 16 + hi * 8) * 2;
    const bf16x8 b0 = *reinterpret_cast<const bf16x8*>(Rs + RSWZ(r32, cb));
    const bf16x8 b1 = *reinterpret_cast<const bf16x8*>(Rs + RSWZ(32 + r32, cb));
    const bf16x8 qv = *reinterpret_cast<const bf16x8*>(qrl + d0 * 1024);
    p0 = __builtin_amdgcn_mfma_f32_32x32x16_bf16(b0, qv, p0, 0, 0, 0);
    p1 = __builtin_amdgcn_mfma_f32_32x32x16_bf16(b1, qv, p1, 0, 0, 0); }
}
__device__ __forceinline__ int v_st(int k, int c) { const int kk = (k & ~0xC) | ((k & 4) << 1) | ((k & 8) >> 1); return ((kk >> 3) * 4 + (c >> 5)) * 512 + ((kk & 7) * 32 + (c & 31)) * 2; }
__device__ __forceinline__ int v_rd_base(int lane) { return ((lane & 3) << 3) | (((lane >> 2) & 3) << 6) | (((lane >> 4) & 1) << 5) | (((lane >> 5) & 1) << 8); }
constexpr int v_rd_off(int d0, int ks, int half) { return d0 * 512 + ks * 4096 + half * 2048; }
template <int OFF> __device__ __forceinline__ s16x4 tr_read(int vb) {
  s16x4 r; asm volatile("ds_read_b64_tr_b16 %0, %1 offset:%2" : "=&v"(r) : "v"(vb), "i"(OFF) : "memory"); return r;
}
template <int D0> __device__ __forceinline__ void pv_one(f32x16& od, int vb, bf16x8 pa0, bf16x8 pa1, bf16x8 pa2, bf16x8 pa3) {
  const s16x4 l0 = tr_read<v_rd_off(D0, 0, 0)>(vb), h0 = tr_read<v_rd_off(D0, 0, 1)>(vb), l1 = tr_read<v_rd_off(D0, 1, 0)>(vb), h1 = tr_read<v_rd_off(D0, 1, 1)>(vb);
  const s16x4 l2 = tr_read<v_rd_off(D0, 2, 0)>(vb), h2 = tr_read<v_rd_off(D0, 2, 1)>(vb), l3 = tr_read<v_rd_off(D0, 3, 0)>(vb), h3 = tr_read<v_rd_off(D0, 3, 1)>(vb);
  asm volatile("s_waitcnt lgkmcnt(0)" ::: "memory"); SBAR();
#define PK(L, H) (bf16x8){L[0], L[1], L[2], L[3], H[0], H[1], H[2], H[3]}
  od = __builtin_amdgcn_mfma_f32_32x32x16_bf16(pa0, PK(l0, h0), od, 0, 0, 0);
  od = __builtin_amdgcn_mfma_f32_32x32x16_bf16(pa1, PK(l1, h1), od, 0, 0, 0);
  od = __builtin_amdgcn_mfma_f32_32x32x16_bf16(pa2, PK(l2, h2), od, 0, 0, 0);
  od = __builtin_amdgcn_mfma_f32_32x32x16_bf16(pa3, PK(l3, h3), od, 0, 0, 0);
#undef PK
}
__device__ __forceinline__ void pv_d0(f32x16* o, int vb, bf16x8 pa0, bf16x8 pa1, bf16x8 pa2, bf16x8 pa3) {
  pv_one<0>(o[0], vb, pa0, pa1, pa2, pa3); pv_one<1>(o[1], vb, pa0, pa1, pa2, pa3); pv_one<2>(o[2], vb, pa0, pa1, pa2, pa3); pv_one<3>(o[3], vb, pa0, pa1, pa2, pa3);
}
__device__ __forceinline__ void attn_body(const bf16_t* __restrict__ Qb, const float* __restrict__ cs, const float* __restrict__ sn, const bf16_t* __restrict__ Kn,
                                          const bf16_t* __restrict__ Vh, const bf16_t* __restrict__ Kr, bf16_t* __restrict__ Ob, int seq, char* lds) {
  const int tid = otid(), wid = tid >> 6, lane = tid & 63, r32 = lane & 31, hi = lane >> 5;
  char* V_lds = lds; char* K_lds = lds + 2 * SHM_V; char* R_lds = lds + 2 * SHM_V + 2 * SHM_K;
  float* wsf = (float*)(lds + 2 * SHM_V + 2 * SHM_K + 2 * SHM_R) + wid * 64; float* li_l = wsf; float* al_l = wsf + 32;
  char* qrl = lds + 2 * SHM_V + 2 * SHM_K + 2 * SHM_R + 2048 + wid * 4096 + lane * 16;
  float m_reg = -1e30f, l_reg = 0; f32x16 o[4] = {}; bf16x8 qr[8];
  { const bf16_t* Qw = Qb + (size_t)(wid * QBLK + r32) * LDQ + hi * 8;
#pragma unroll
    for (int d0 = 0; d0 < 8; ++d0) qr[d0] = *(const bf16x8*)(Qw + d0 * 16);
#pragma unroll
    for (int d0 = 0; d0 < 2; ++d0) {
      const u32x4 a = *(const u32x4*)(Qw + 128 + d0 * 16), bq = *(const u32x4*)(Qw + 160 + d0 * 16);
      if (cs) {
        const float* cp = cs + (size_t)(wid * QBLK + r32) * 32 + d0 * 16 + hi * 8; const float* sp = sn + (size_t)(wid * QBLK + r32) * 32 + d0 * 16 + hi * 8;
        const f32x4 c0 = *(const f32x4*)cp, c1 = *(const f32x4*)(cp + 4), s0 = *(const f32x4*)sp, s1 = *(const f32x4*)(sp + 4);
        float x1[8], x2[8], y1[8], y2[8];
#pragma unroll
        for (int k = 0; k < 4; ++k) { x1[2 * k] = bflo(a[k]); x1[2 * k + 1] = bfhi(a[k]); x2[2 * k] = bflo(bq[k]); x2[2 * k + 1] = bfhi(bq[k]); }
#pragma unroll
        for (int k = 0; k < 8; ++k) { const float c = k < 4 ? c0[k & 3] : c1[k & 3], s = k < 4 ? s0[k & 3] : s1[k & 3]; y1[k] = x1[k] * c - x2[k] * s; y2[k] = x2[k] * c + x1[k] * s; }
        u32x4 w1 = {cvtpk(y1[0], y1[1]), cvtpk(y1[2], y1[3]), cvtpk(y1[4], y1[5]), cvtpk(y1[6], y1[7])}, w2 = {cvtpk(y2[0], y2[1]), cvtpk(y2[2], y2[3]), cvtpk(y2[4], y2[5]), cvtpk(y2[6], y2[7])};
        *(u32x4*)(qrl + d0 * 1024) = w1; *(u32x4*)(qrl + (2 + d0) * 1024) = w2;
      } else { *(u32x4*)(qrl + d0 * 1024) = a; *(u32x4*)(qrl + (2 + d0) * 1024) = bq; }
    } }
  const int sr = tid >> 4, sc = (tid & 15) * 8, vst0 = v_st(sr, sc), vst1 = v_st(32 + sr, sc);
  const int rr_ = tid >> 3, rc = (tid & 7) * 8;
  const int vb0 = (int)(uintptr_t)V_lds + v_rd_base(lane);
  bf16x8 vs0, vs1, ks0, ks1, rs0;
  const unsigned voffKV = (unsigned)(sr * LDK + sc) * 2u, voffR = (unsigned)(rr_ * LDKR + rc) * 2u;
#define SLOAD(k0) do { const char* kb_ = (const char*)Kn + (size_t)(k0) * (LDK * 2); const char* vb_ = (const char*)Vh + (size_t)(k0) * (LDK * 2); \
    vs0 = *(const bf16x8*)(vb_ + voffKV); vs1 = *(const bf16x8*)(vb_ + 32 * LDK * 2 + voffKV); \
    ks0 = *(const bf16x8*)(kb_ + voffKV); ks1 = *(const bf16x8*)(kb_ + 32 * LDK * 2 + voffKV); \
    rs0 = *(const bf16x8*)((const char*)Kr + (size_t)(k0) * (LDKR * 2) + voffR); } while (0)
#define SWRITE(b) do { *(bf16x8*)(V_lds + (b) * SHM_V + vst0) = vs0; *(bf16x8*)(V_lds + (b) * SHM_V + vst1) = vs1; const int kc = sc * 2;  \
    *(bf16x8*)(K_lds + (b) * SHM_K + KSWZ(sr, kc)) = ks0; *(bf16x8*)(K_lds + (b) * SHM_K + KSWZ(32 + sr, kc)) = ks1;                      \
    *(bf16x8*)(R_lds + (b) * SHM_R + RSWZ(rr_, rc * 2)) = rs0; } while (0)
#define RESC(a) do { if (__any((a) < 1.f)) { if (hi == 0) al_l[r32] = (a); asm volatile("s_waitcnt lgkmcnt(0)" ::: "memory"); \
    _Pragma("unroll") for (int d = 0; d < 4; ++d) _Pragma("unroll") for (int r = 0; r < 16; ++r) o[d][r] *= al_l[crow(r, hi)]; } } while (0)
  f32x16 pA0, pA1, pB0, pB1; float mnA, mnB, alA, alB; bf16x8 pa0, pa1, pa2, pa3; const int NT = seq / KVBLK;
  SLOAD(0); SWRITE(0); __syncthreads();
  qkt(pA0, pA1, K_lds, R_lds, qr, qrl, r32, hi); partialSM(pA0, pA1, m_reg, mnA, alA);
  SLOAD(KVBLK); SWRITE(1); __syncthreads();
  for (int j = 1; j + 1 < NT; j += 2) {
    SBAR(); qkt(pB0, pB1, K_lds + SHM_K, R_lds + SHM_R, qr, qrl, r32, hi);
    finishSM(pA0, pA1, alA, l_reg, pa0, pa1, pa2, pa3); SBAR();
    SLOAD((j + 1) * KVBLK); SBAR();
    pv_d0(o, vb0, pa0, pa1, pa2, pa3); partialSM(pB0, pB1, m_reg, mnB, alB);
    __syncthreads(); SWRITE(0);
    RESC(alB); __syncthreads();
    SBAR(); qkt(pA0, pA1, K_lds, R_lds, qr, qrl, r32, hi);
    finishSM(pB0, pB1, alB, l_reg, pa0, pa1, pa2, pa3); SBAR();
    SLOAD((j + 2) * KVBLK); SBAR();
    pv_d0(o, vb0 + (int)SHM_V, pa0, pa1, pa2, pa3); partialSM(pA0, pA1, m_reg, mnA, alA);
    __syncthreads(); SWRITE(1);
    RESC(alA); __syncthreads();
  }
  SBAR(); qkt(pB0, pB1, K_lds + SHM_K, R_lds + SHM_R, qr, qrl, r32, hi);
  finishSM(pA0, pA1, alA, l_reg, pa0, pa1, pa2, pa3); SBAR();
  pv_d0(o, vb0, pa0, pa1, pa2, pa3); partialSM(pB0, pB1, m_reg, mnB, alB);
  __syncthreads(); RESC(alB);
  finishSM(pB0, pB1, alB, l_reg, pa0, pa1, pa2, pa3); SBAR();
  pv_d0(o, vb0 + (int)SHM_V, pa0, pa1, pa2, pa3);
  if (hi == 0) li_l[r32] = l_reg; asm volatile("s_waitcnt lgkmcnt(0)" ::: "memory");
  float rli[16];
#pragma unroll
  for (int r = 0; r < 16; ++r) rli[r] = __builtin_amdgcn_rcpf(li_l[crow(r, hi)]);
  bf16_t* Ow = Ob + (size_t)(wid * QBLK) * LDO;
#pragma unroll
  for (int r = 0; r < 16; ++r) { const int orow = crow(r, hi);
#pragma unroll
    for (int d0 = 0; d0 < 4; ++d0) Ow[(size_t)orow * LDO + d0 * 32 + r32] = f2bf(o[d0][r] * rli[r]); }
  __syncthreads();
#undef SLOAD
#undef SWRITE
#undef RESC
}
}

__device__ void phase_attn(PRef p, int l, char* smem) {
  const bf16_t* Q = (const bf16_t*)(p.ws + WS_Q); const bf16_t* KV = (const bf16_t*)(p.ws + WS_KV); const bf16_t* KR = (const bf16_t*)(p.ws + WS_KR);
  bf16_t* mix = (bf16_t*)(p.ws + WS_MIX); const float* cs = (const float*)(p.ws + WS_COS); const float* sn = (const float*)(p.ws + WS_SIN);
  const int nunits = 1024 + (l == 0 ? 32 : 0);
  for (int u = obid(); u < nunits; u += gridDim.x) {
    if (u < 1024) {
      const int qb = u & 31, hd = (u >> 5) & 3, b = u >> 7; const size_t row0 = (size_t)b * SEQ + qb * 256;
      att::attn_body(Q + row0 * 768 + hd * 192, cs + (size_t)qb * 256 * 32, sn + (size_t)qb * 256 * 32, KV + (size_t)b * SKV * 1024 + hd * 256,
                     KV + (size_t)b * SKV * 1024 + hd * 256 + 128, KR + (size_t)b * SKV * 64, mix + row0 * 1024 + 512 + hd * 128, SKV, smem);
    } else {
      const int v = u - 1024, hd = v & 3, b = v >> 2; const size_t row0 = (size_t)MX + b * CTXL;
      att::attn_body(Q + row0 * 768 + hd * 192, nullptr, nullptr, KV + (size_t)b * SKV * 1024 + hd * 256,
                     KV + (size_t)b * SKV * 1024 + hd * 256 + 128, KR + (size_t)b * SKV * 64, mix + row0 * 1024 + 512 + hd * 128, CTXL, smem);
    }
  }
}

__device__ void phase_outproj(PRef p, int l, char* smem) {
  LAS unsigned char* lds = (LAS unsigned char*)smem;
  const bf16_t* mix = (const bf16_t*)(p.ws + WS_MIX); const bf16_t* Wt = (const bf16_t*)(p.ws + WS_WOUT) + (size_t)l * 1024 * 1024;
  float* ctxz = (float*)(p.ws + WS_CTXZ);
  const int tid = otid(), wid = tid >> 6, lane = tid & 63, wr = wid >> 2, wc = wid & 3, fr = lane & 15, fq = lane >> 4;
  g8::TileIter it; it.init(l == 0 ? MT / 256 : MX / 256, 4);
  int pm, pn;
  while (it.next(pm, pn)) {
    unsigned voffA[2] = {g8::piece_off(0, 1024, 0), g8::piece_off(1, 1024, 0)};
    f32x4 acc[2][2][4][2];
    g8::gemm_tile<false>(lds, (const char*)(mix + (size_t)pm * 256 * 1024), voffA, (size_t)128 * 1024 * 2, (const char*)(Wt + (size_t)pn * 256 * 1024), 1024, acc);
    ACC_FOR(ai, bj, m, n) {
      const int row = pm * 256 + ai * 128 + wr * 64 + m * 16 + fr, col = pn * 256 + bj * 128 + wc * 32 + n * 16 + fq * 4;
      const float* res = l == 0 ? (row < MX ? p.x + (size_t)row * 1024 : p.ctx + (size_t)(row - MX) * 1024) : p.out + (size_t)row * 1024;
      float* dst = row < MX ? p.out + (size_t)row * 1024 : ctxz + (size_t)(row - MX) * 1024;
      const f32x4 r = *(const f32x4*)(res + col), g = *(const f32x4*)(mod_ptr(p, l, row, 2) + col);
      *(f32x4*)(dst + col) = r * ALPHA + g * acc[ai][bj][m][n];
    }
  }
}

__device__ void phase_ln1(PRef p, int l, char* smem) {
  float* wrt = (float*)smem;
  for (int i = otid(); i < 16384; i += 512) wrt[(i & 15) * 1024 + (i >> 4)] = p.w_router[(size_t)l * 16384 + i];
  __syncthreads();
  const int lane = otid() & 63, gw = obid() * 8 + (otid() >> 6), nw = gridDim.x * 8;
  bf16_t* h = (bf16_t*)(p.ws + WS_H); float* ctxz = (float*)(p.ws + WS_CTXZ); float* aff = (float*)(p.ws + WS_AFF);
  const int nrows = l == 0 ? MT : MX;
  for (int row = gw; row < nrows; row += nw) {
    asm volatile("" ::: "memory");
    float* zr = row < MX ? p.out + (size_t)row * 1024 : ctxz + (size_t)(row - MX) * 1024;
    f32x4 v[4];
#pragma unroll
    for (int i = 0; i < 4; ++i) v[i] = *(const f32x4*)(zr + lane * 4 + 256 * i);
    ln_row(v, 1e-5f);
#pragma unroll
    for (int i = 0; i < 4; ++i) { const int c = lane * 4 + 256 * i; v[i] = v[i] * *(const f32x4*)(p.ln1_g + l * 1024 + c) + *(const f32x4*)(p.ln1_b + l * 1024 + c); *(f32x4*)(zr + c) = v[i]; }
    ln_row(v, 1e-6f);
    f32x4 hm[4];
    store_mod_bf16(v, mod_ptr(p, l, row, 3), mod_ptr(p, l, row, 4), h + (size_t)row * 1024, lane, &hm);
    float lg[16];
#pragma unroll
    for (int e = 0; e < 16; ++e) { float s = 0.f;
#pragma unroll
      for (int i = 0; i < 4; ++i) { const f32x4 w = *(const f32x4*)(wrt + e * 1024 + lane * 4 + 256 * i); s += hm[i][0] * w[0] + hm[i][1] * w[1] + hm[i][2] * w[2] + hm[i][3] * w[3]; }
      lg[e] = wave_sum(s); }
    float mx = lg[0];
#pragma unroll
    for (int e = 1; e < 16; ++e) mx = fmaxf(mx, lg[e]);
    float den = 0.f;
#pragma unroll
    for (int e = 0; e < 16; ++e) { lg[e] = expf(lg[e] - mx); den += lg[e]; }
    float mine = 0.f;
#pragma unroll
    for (int e = 0; e < 16; ++e) if (lane == e) mine = lg[e] / den;
    if (lane < 16) aff[(size_t)row * 16 + lane] = mine;
  }
}

template <int PER>
__device__ __forceinline__ void topk_item(const float* __restrict__ affp, int n, int kcap, int rowbase, int slotbase, int e, int* __restrict__ IDX, float* __restrict__ GV, int* __restrict__ TS, char* smem) {
  unsigned* hist = (unsigned*)smem; unsigned* sel = hist + 256; unsigned* wtot = hist + 272;
  const int tid = otid(), lane = tid & 63, wid = tid >> 6;
  const bool active = tid * PER < n;
  unsigned key[PER];
#pragma unroll
  for (int i = 0; i < PER; ++i) key[i] = active ? __float_as_uint(affp[(size_t)(tid * PER + i) * 16]) : 0u;
  unsigned prefix = 0u, mask = 0u; int kk = kcap;
#pragma unroll 1
  for (int shift = 24; shift >= 0; shift -= 8) {
    __syncthreads();
    if (tid < 256) hist[tid] = 0u;
    __syncthreads();
#pragma unroll
    for (int i = 0; i < PER; ++i) if (active && (key[i] & mask) == prefix) atomicAdd(&hist[(key[i] >> shift) & 255u], 1u);
    __syncthreads();
    if (wid == 0) {
      const unsigned h0 = hist[lane * 4], h1 = hist[lane * 4 + 1], h2 = hist[lane * 4 + 2], h3 = hist[lane * 4 + 3];
      const unsigned tot = h0 + h1 + h2 + h3; unsigned suf = tot;
#pragma unroll
      for (int o = 1; o < 64; o <<= 1) { const unsigned u = __shfl_down(suf, o); if (lane + o < 64) suf += u; }
      const unsigned above = suf - tot;
      if (above < (unsigned)kk && suf >= (unsigned)kk) {
        unsigned a = above; int bin;
        if (a + h3 >= (unsigned)kk) bin = 3; else { a += h3; if (a + h2 >= (unsigned)kk) bin = 2; else { a += h2; if (a + h1 >= (unsigned)kk) bin = 1; else { a += h1; bin = 0; } } }
        sel[0] = prefix | ((unsigned)(lane * 4 + bin) << shift); sel[1] = (unsigned)kk - a;
      }
    }
    __syncthreads();
    prefix = sel[0]; kk = (int)sel[1]; mask |= 0xffu << shift;
  }
  const unsigned Tk = prefix;
  unsigned cg_ = 0, ce = 0;
#pragma unroll
  for (int i = 0; i < PER; ++i) { cg_ += key[i] > Tk; ce += key[i] == Tk; }
  unsigned pk = active ? (cg_ | (ce << 16)) : 0u, inc = pk;
#pragma unroll
  for (int o = 1; o < 64; o <<= 1) { const unsigned u = __shfl_up(inc, o); if (lane >= o) inc += u; }
  __syncthreads();
  if (lane == 63) wtot[wid] = inc;
  __syncthreads();
  unsigned base = 0;
  for (int w2 = 0; w2 < wid; ++w2) base += wtot[w2];
  const unsigned exc = base + inc - pk; unsigned gt_before = exc & 0xffffu, eq_before = exc >> 16;
  if (active) {
#pragma unroll
    for (int i = 0; i < PER; ++i) {
      const int t = tid * PER + i; int R = -1;
      const bool isgt = key[i] > Tk, iseq = key[i] == Tk;
      if (isgt || (iseq && (int)eq_before < kk)) {
        const int slot = (int)gt_before + min((int)eq_before, kk);
        R = slotbase + slot; IDX[R] = rowbase + t; GV[R] = __uint_as_float(key[i]);
      }
      TS[t] = R;
      gt_before += isgt; eq_before += iseq;
    }
  }
}
__device__ void phase_topk(PRef p, int l, char* smem) {
  const float* aff = (const float*)(p.ws + WS_AFF); int* IDX = (int*)(p.ws + WS_IDX); float* GV = (float*)(p.ws + WS_GV); int* TS = (int*)(p.ws + WS_TS);
  const int nitems = l == 0 ? 256 : 128;
  for (int it = obid(); it < nitems; it += gridDim.x) {
    if (it < 128) { const int b = it >> 4, e = it & 15; topk_item<16>(aff + (size_t)b * SEQ * 16 + e, SEQ, CAPX, b * SEQ, it * CAPX, e, IDX, GV, TS + (size_t)it * SEQ, smem); }
    else { const int v = it - 128, b = v >> 4, e = v & 15; topk_item<1>(aff + ((size_t)MX + b * CTXL) * 16 + e, CTXL, CAPC, MX + b * CTXL, NB * NE * CAPX + e * 256 + b * CAPC, e, IDX, GV, TS + (size_t)NB * 16 * SEQ + (size_t)v * CTXL, smem); }
  }
  __syncthreads();
}

__device__ void phase_moe_up(PRef p, int l, char* smem) {
  LAS unsigned char* lds = (LAS unsigned char*)smem;
  const bf16_t* h = (const bf16_t*)(p.ws + WS_H); const bf16_t* Wgu = (const bf16_t*)(p.ws + WS_WGU); bf16_t* act = (bf16_t*)(p.ws + WS_ACT); const int* IDX = (const int*)(p.ws + WS_IDX);
  const int tid = otid(), wid = tid >> 6, lane = tid & 63, wr = wid >> 2, wc = wid & 3, fr = lane & 15, fq = lane >> 4;
  g8::MoeIter it; it.init(8, l == 0);
  int pm, pn, e;
  while (it.next(pm, pn, e)) {
    unsigned voffA[4];
#pragma unroll
    for (int hh = 0; hh < 2; ++hh)
#pragma unroll
      for (int i = 0; i < 2; ++i) { int R, C; g8::piece_rc(i, R, C); voffA[hh * 2 + i] = (unsigned)(IDX[pm * 256 + hh * 128 + R] * 1024 + C) * 2u; }
    f32x4 acc[2][2][4][2];
    g8::gemm_tile<true>(lds, (const char*)h, voffA, 0, (const char*)(Wgu + ((size_t)e * 2048 + pn * 256) * 1024), 1024, acc);
#pragma unroll
    for (int ai = 0; ai < 2; ++ai)
#pragma unroll
      for (int m = 0; m < 4; ++m)
#pragma unroll
        for (int n = 0; n < 2; ++n) {
          const int row = pm * 256 + ai * 128 + wr * 64 + m * 16 + fr, col = pn * 128 + wc * 32 + n * 16 + fq * 4;
          const f32x4 g = acc[ai][0][m][n], u = acc[ai][1][m][n]; float a[4];
#pragma unroll
          for (int k = 0; k < 4; ++k) a[k] = silu_f(g[k]) * u[k];
          u32x2 w = {cvtpk(a[0], a[1]), cvtpk(a[2], a[3])}; *(u32x2*)(act + (size_t)row * 1024 + col) = w;
        }
  }
}
__device__ void phase_moe_down(PRef p, int l, char* smem) {
  LAS unsigned char* lds = (LAS unsigned char*)smem;
  const bf16_t* act = (const bf16_t*)(p.ws + WS_ACT); const bf16_t* Wdn = (const bf16_t*)(p.ws + WS_WDN); bf16_t* oute = (bf16_t*)(p.ws + WS_OUTE); const float* GV = (const float*)(p.ws + WS_GV);
  const int tid = otid(), wid = tid >> 6, lane = tid & 63, wr = wid >> 2, wc = wid & 3, fr = lane & 15, fq = lane >> 4;
  g8::MoeIter it; it.init(4, l == 0);
  int pm, pn, e;
  while (it.next(pm, pn, e)) {
    unsigned voffA[2] = {g8::piece_off(0, 1024, 0), g8::piece_off(1, 1024, 0)};
    f32x4 acc[2][2][4][2];
    g8::gemm_tile<false>(lds, (const char*)(act + (size_t)pm * 256 * 1024), voffA, (size_t)128 * 1024 * 2, (const char*)(Wdn + ((size_t)e * 1024 + pn * 256) * 1024), 1024, acc);
    ACC_FOR(ai, bj, m, n) {
      const int row = pm * 256 + ai * 128 + wr * 64 + m * 16 + fr, col = pn * 256 + bj * 128 + wc * 32 + n * 16 + fq * 4;
      const f32x4 v = acc[ai][bj][m][n] * GV[row];
      u32x2 w = {cvtpk(v[0], v[1]), cvtpk(v[2], v[3])}; *(u32x2*)(oute + (size_t)row * 1024 + col) = w;
    }
  }
}

__device__ void phase_ln2(PRef p, int l) {
  const int lane = otid() & 63, gw = obid() * 8 + (otid() >> 6), nw = gridDim.x * 8;
  bf16_t* h = (bf16_t*)(p.ws + WS_H); float* ctxz = (float*)(p.ws + WS_CTXZ); const bf16_t* oute = (const bf16_t*)(p.ws + WS_OUTE); const int* TS = (const int*)(p.ws + WS_TS);
  const int nrows = l == 0 ? MT : MX;
  for (int row = gw; row < nrows; row += nw) {
    float* xr = row < MX ? p.out + (size_t)row * 1024 : ctxz + (size_t)(row - MX) * 1024;
    f32x4 mo[4];
#pragma unroll
    for (int i = 0; i < 4; ++i) mo[i] = (f32x4){0.f, 0.f, 0.f, 0.f};
    const int myR = lane < 16 ? (row < MX ? TS[((size_t)(row >> 13) * 16 + lane) * SEQ + (row & 8191)] : TS[(size_t)NB * 16 * SEQ + ((size_t)((row - MX) >> 8) * 16 + lane) * CTXL + ((row - MX) & 255)]) : -1;
    for (int e = 0; e < 16; ++e) { const int Rr = __shfl(myR, e);
      if (Rr >= 0) {
#pragma unroll
        for (int i = 0; i < 4; ++i) { const u32x2 w = *(const u32x2*)(oute + (size_t)Rr * 1024 + lane * 4 + 256 * i);
          mo[i][0] += bflo(w[0]); mo[i][1] += bfhi(w[0]); mo[i][2] += bflo(w[1]); mo[i][3] += bfhi(w[1]); } } }
    f32x4 v[4]; const float* m5 = mod_ptr(p, l, row, 5);
#pragma unroll
    for (int i = 0; i < 4; ++i) { const int c = lane * 4 + 256 * i; v[i] = *(const f32x4*)(xr + c) * ALPHA + *(const f32x4*)(m5 + c) * mo[i]; }
    ln_row(v, 1e-5f);
#pragma unroll
    for (int i = 0; i < 4; ++i) { const int c = lane * 4 + 256 * i; v[i] = v[i] * *(const f32x4*)(p.ln2_g + l * 1024 + c) + *(const f32x4*)(p.ln2_b + l * 1024 + c); *(f32x4*)(xr + c) = v[i]; }
    if (l + 1 < DEPTH) { ln_row(v, 1e-6f); store_mod_bf16(v, mod_ptr(p, l + 1, row, 0), mod_ptr(p, l + 1, row, 1), h + (size_t)row * 1024, lane, nullptr); }
  }
}

#if DBG_BAR
__device__ int g_phase_dummy;
#endif
__device__ __forceinline__ void gsync(cg::grid_group& grid, PRef p, int& phase) {
#if DBG_BAR
  int* flags = (int*)(p.ws + WS_END); int* err = flags + 1024;
  ++phase;
  if (otid() == 0) flags[obid()] = phase;
#endif
  asm volatile("s_waitcnt vmcnt(0) lgkmcnt(0)" ::: "memory");
  grid.sync();
#if DBG_BAR
  if (otid() < (int)gridDim.x) { if (flags[otid()] != phase) atomicAdd(err, 1); }
#endif
}
__device__ void dbg_dump_bf16(PRef p, size_t off) {
  const bf16_t* src = (const bf16_t*)(p.ws + off);
  for (size_t i = (size_t)obid() * 512 + otid(); i < (size_t)MX * 1024; i += (size_t)gridDim.x * 512) p.out[i] = bf2f(src[i]);
}
__global__ void __launch_bounds__(512) mega(Params p) {
  extern __shared__ __attribute__((aligned(16))) char smem[];
  cg::grid_group grid = cg::this_grid();
  int phase = 0;
#if DBG_BAR
  if (obid() == 0 && otid() == 0) ((int*)(kparams().ws + WS_END))[1024] = 0;
#endif
  phase_prep(kparams(), smem);
  gsync(grid, kparams(), phase);
  phase_h0(kparams());
  gsync(grid, kparams(), phase);
#pragma unroll 1
  for (int l = 0; l < DEPTH; ++l) {
#if DBG_STOP == 0
    dbg_dump_bf16(kparams(), WS_H); return;
#endif
#pragma unroll 1
    for (int rep = 0; rep < DBG_REP_INPROJ; ++rep) { phase_inproj(kparams(), l, smem); gsync(grid, kparams(), phase); }
#if DBG_STOP == 1
    dbg_dump_bf16(kparams(), WS_P); return;
#endif
#if DBG_STOP == 12
    dbg_dump_bf16(kparams(), WS_P + (size_t)23000 * PLD * 2); return;
#endif
#if DBG_STOP == 11
    { PRef q = kparams(); const float* gsrc = (const float*)(q.ws + WS_GATES); const bf16_t* ps = (const bf16_t*)(q.ws + WS_P);
      for (size_t i = (size_t)obid() * 512 + otid(); i < (size_t)MX * 1024; i += (size_t)gridDim.x * 512)
        q.out[i] = i < (size_t)MT * 16 ? gsrc[i] : bf2f(ps[(size_t)MT * PLD - 1 - (i - (size_t)MT * 16)]); }
    return;
#endif
#if DBG_STOP == 24
#pragma unroll 1
    for (int rep = 0; rep < 2; ++rep) { phase_mlstm(kparams(), l, smem, opaque_s(rep) ? WS_Q : WS_HB); gsync(grid, kparams(), phase); }
    { PRef q = kparams(); const bf16_t* a = (const bf16_t*)(q.ws + WS_HB); const bf16_t* b2 = (const bf16_t*)(q.ws + WS_Q);
      for (size_t i = (size_t)obid() * 512 + otid(); i < (size_t)MX * 1024; i += (size_t)gridDim.x * 512) q.out[i] = bf2f(a[i]) - bf2f(b2[i]); }
    return;
#else
#pragma unroll 1
    for (int rep = 0; rep < DBG_REP_MLSTM; ++rep) { phase_mlstm(kparams(), l, smem); gsync(grid, kparams(), phase); }
#endif
#if DBG_STOP == 2
    dbg_dump_bf16(kparams(), WS_HB); return;
#endif
#if DBG_STOP == 23
    return;
#endif
#if DBG_STOP == 22
    { PRef q = kparams(); const int nerr = ((const int*)(q.ws + WS_END))[1024];
      for (size_t i = (size_t)obid() * 512 + otid(); i < (size_t)MX * 1024; i += (size_t)gridDim.x * 512) q.out[i] = i < 1024 ? 1000.f * (float)nerr : 0.f; }
    return;
#endif
    phase_mla_prep(kparams(), l, smem);
    gsync(grid, kparams(), phase);
#pragma unroll 1
    for (int rep = 0; rep < DBG_REP_ATTN; ++rep) { phase_attn(kparams(), l, smem); gsync(grid, kparams(), phase); }
#if DBG_STOP == 4
    dbg_dump_bf16(kparams(), WS_MIX); return;
#endif
    phase_outproj(kparams(), l, smem);
    gsync(grid, kparams(), phase);
    phase_ln1(kparams(), l, smem);
    __syncthreads();
#pragma unroll 1
    for (int rep = 0; rep < DBG_REP_CVT; ++rep) phase_cvt_experts(kparams(), l, smem);
    gsync(grid, kparams(), phase);
#if DBG_STOP == 6
    if (l == 0) return;
#endif
    phase_topk(kparams(), l, smem);
    gsync(grid, kparams(), phase);
#pragma unroll 1
    for (int rep = 0; rep < DBG_REP_MOE; ++rep) {
    phase_moe_up(kparams(), l, smem);
    gsync(grid, kparams(), phase);
    phase_moe_down(kparams(), l, smem);
    gsync(grid, kparams(), phase);
    }
    phase_ln2(kparams(), l);
    gsync(grid, kparams(), phase);
#if DBG_STOP == 10
    if (l == 0) return;
#endif
  }
}

extern "C" void kernel_launch(void* const* d_in, const int* in_sizes, int n_in, void* d_out, int out_size,
                              void* d_ws, size_t ws_size, hipStream_t stream) {
  constexpr size_t kDynLds = 160 * 1024;
  static int grid_blocks = 0;
  if (!grid_blocks) {
    int dev = 0, cus = 0, per_cu = 0;
    (void)hipGetDevice(&dev);
    (void)hipDeviceGetAttribute(&cus, hipDeviceAttributeMultiprocessorCount, dev);
    (void)hipFuncSetAttribute((const void*)mega, hipFuncAttributeMaxDynamicSharedMemorySize, (int)kDynLds);
    (void)hipOccupancyMaxActiveBlocksPerMultiprocessor(&per_cu, mega, 512, kDynLds);
    grid_blocks = per_cu > 0 ? cus : 0;
    if (grid_blocks > 256) grid_blocks = 256;
    grid_blocks &= ~7;
    if (grid_blocks != 256) { fprintf(stderr, "this kernel needs 256 co-resident workgroups (got %d)\n", grid_blocks); grid_blocks = 0; }
    if (ws_size < WS_END) { fprintf(stderr, "workspace too small: %zu < %zu\n", ws_size, (size_t)WS_END); grid_blocks = 0; }
  }
  if (grid_blocks <= 0) return;
  Params p{};
  const float** pp = (const float**)&p;
  for (int i = 0; i < 24; ++i) pp[i] = (const float*)d_in[i];
  p.out = (float*)d_out; p.ws = (char*)d_ws;
  void* args[] = {&p};
  hipError_t e = hipLaunchCooperativeKernel((void*)mega, dim3(grid_blocks), dim3(512), args, kDynLds, stream);
  if (e != hipSuccess) fprintf(stderr, "cooperative launch failed: %s (grid %d)\n", hipGetErrorString(e), grid_blocks);
}
```

```cpp
#include <hip/hip_runtime.h>
#include <hip/hip_cooperative_groups.h>
#include <cstdio>
#include <cstdint>
namespace cg = cooperative_groups;
#ifndef DBG_BAR
#define DBG_BAR 0
#endif
#ifndef DBG_REP_MLSTM
#define DBG_REP_MLSTM 1
#endif
#ifndef DBG_REP_ATTN
#define DBG_REP_ATTN 1
#endif
#ifndef DBG_REP_MOE
#define DBG_REP_MOE 1
#endif
#ifndef DBG_REP_INPROJ
#define DBG_REP_INPROJ 1
#endif
#ifndef DBG_REP_CVT
#define DBG_REP_CVT 1
#endif
#ifndef DBG_STOP
#define DBG_STOP 99
#endif

typedef unsigned short bf16_t;
typedef short bf16x8 __attribute__((ext_vector_type(8)));
typedef short s16x4 __attribute__((ext_vector_type(4)));
typedef float f32x4 __attribute__((ext_vector_type(4)));
typedef float f32x16 __attribute__((ext_vector_type(16)));
typedef unsigned u32x4 __attribute__((ext_vector_type(4)));
typedef unsigned u32x2 __attribute__((ext_vector_type(2)));
#define LAS __attribute__((address_space(3)))

constexpr int DM = 1024, NB = 8, SEQ = 8192, CTXL = 256, DEPTH = 2;
constexpr int MX = NB * SEQ, MC = NB * CTXL, MT = MX + MC;
constexpr int PLD = 2816;
constexpr int OFF_Q = 0, OFF_K = 512, OFF_V = 1024, OFF_O = 1536, OFF_G = 2048, OFF_CQ = 2064, OFF_CKV = 2448, OFF_KR = 2704, IN_COLS = 2768;
constexpr int SKV = SEQ + CTXL;
constexpr int NE = 16, CAPX = 1024, CAPC = 32;
constexpr int NSLOT = NB * NE * CAPX + NB * NE * CAPC;
constexpr float ALPHA = 1.4142135623730951f;
constexpr float A_SCALE = 0.07216878364870322f;

constexpr size_t al256(size_t v) { return (v + 255) / 256 * 256; }
constexpr size_t WS_H = 0;
constexpr size_t WS_P = WS_H + al256((size_t)MT * 1024 * 2);
constexpr size_t WS_Q = WS_P + al256((size_t)MT * PLD * 2);
constexpr size_t WS_KV = WS_Q + al256((size_t)MT * 768 * 2);
constexpr size_t WS_KR = WS_KV + al256((size_t)NB * SKV * 1024 * 2);
constexpr size_t WS_MIX = WS_KR + al256((size_t)NB * SKV * 64 * 2);
constexpr size_t WS_ACT = WS_P;
constexpr size_t WS_HB = WS_H;
constexpr size_t WS_OUTE = WS_P + al256((size_t)NSLOT * 1024 * 2);
constexpr size_t WS_WGU = WS_MIX;
constexpr size_t WS_WDN = WS_MIX + (size_t)NE * 2048 * 1024 * 2;
constexpr size_t WS_WIN = WS_MIX + al256((size_t)MT * 1024 * 2);
constexpr size_t WS_WUQ = WS_WIN + (size_t)2 * PLD * 1024 * 2;
constexpr size_t WS_WUKV = WS_WUQ + (size_t)2 * 768 * 384 * 2;
constexpr size_t WS_WOUT = WS_WUKV + (size_t)2 * 1024 * 256 * 2;
constexpr size_t WS_MOD = WS_WOUT + (size_t)2 * 1024 * 1024 * 2;
constexpr size_t WS_COS = WS_MOD + al256((size_t)2 * 9 * 6144 * 4);
constexpr size_t WS_SIN = WS_COS + (size_t)SEQ * 32 * 4;
constexpr size_t WS_GATES = WS_SIN + (size_t)SEQ * 32 * 4;
constexpr size_t WS_AFF = WS_GATES + (size_t)MT * 16 * 4;
constexpr size_t WS_IDX = WS_AFF + (size_t)MT * 16 * 4;
constexpr size_t WS_GV = WS_IDX + (size_t)NSLOT * 4;
constexpr size_t WS_TS = WS_GV + (size_t)NSLOT * 4;
constexpr size_t WS_CTXZ = WS_TS + (size_t)MT * 16 * 4;
constexpr size_t WS_END = WS_CTXZ + (size_t)MC * 1024 * 4;
static_assert(WS_OUTE + (size_t)NSLOT * 1024 * 2 <= WS_KR, "out_e overlay");
static_assert(WS_WDN + (size_t)NE * 1024 * 1024 * 2 <= WS_WIN, "expert weights overlay");

struct Params {
  const float *x, *c, *ctx, *c_ctx, *w_mod, *b_mod, *w_in, *b_gates, *conv_w, *conv_b, *m_norm_w, *q_norm_w, *kv_norm_w, *w_uq, *w_ukv, *w_out,
      *ln1_g, *ln1_b, *w_router, *w_gate, *w_up, *w_down, *ln2_g, *ln2_b;
  float* out; char* ws;
};

typedef const __attribute__((address_space(4))) Params& PRef;
__device__ __forceinline__ PRef kparams() { const __attribute__((address_space(4))) Params* kp = (const __attribute__((address_space(4))) Params*)__builtin_amdgcn_kernarg_segment_ptr(); asm volatile("" : "+s"(kp)); return *kp; }
__device__ __forceinline__ int otid() { int t = threadIdx.x; asm volatile("" : "+v"(t)); return t; }
__device__ __forceinline__ int obid() { int t = blockIdx.x; asm volatile("" : "+s"(t)); return t; }
__device__ __forceinline__ int opaque_s(int v) { asm volatile("" : "+s"(v)); return v; }
typedef __bf16 bf16v2_t __attribute__((ext_vector_type(2)));
typedef float f32x2_t __attribute__((ext_vector_type(2)));
__device__ __forceinline__ unsigned cvtpk(float lo, float hi) { const f32x2_t f = {lo, hi}; const bf16v2_t b = __builtin_convertvector(f, bf16v2_t); return __builtin_bit_cast(unsigned, b); }
__device__ __forceinline__ bf16_t f2bf(float v) { return (bf16_t)(cvtpk(v, v) & 0xffffu); }
__device__ __forceinline__ float bf2f(unsigned v) { return __uint_as_float(v << 16); }
__device__ __forceinline__ float bflo(unsigned w) { return __uint_as_float(w << 16); }
__device__ __forceinline__ float bfhi(unsigned w) { return __uint_as_float(w & 0xffff0000u); }
__device__ __forceinline__ float wave_sum(float v) { for (int o = 32; o > 0; o >>= 1) v += __shfl_xor(v, o); return v; }
__device__ __forceinline__ float wave_max(float v) { for (int o = 32; o > 0; o >>= 1) v = fmaxf(v, __shfl_xor(v, o)); return v; }
__device__ __forceinline__ float silu_f(float v) { return v / (1.f + __expf(-v)); }
__device__ __forceinline__ float sigmoid_f(float v) { return 1.f / (1.f + __expf(-v)); }

namespace g8 {
constexpr int BK = 64, HALF = 128, HTB = HALF * BK * 2, STAGE_BYTES = 8 * HTB;
__device__ __forceinline__ int lds_byte(int r, int c) { const int st = (r >> 4) * 2 + (c >> 5), rr = r & 15, cc = c & 31, ob = rr * 64 + cc * 2; return st * 1024 + (ob ^ (((ob >> 9) & 1) << 5)); }
__device__ __forceinline__ void stage_rc(int b, int& R, int& C) { const int st = b / 1024, sb = b % 1024, swz = sb ^ (((sb >> 9) & 1) << 5); R = (st >> 1) * 16 + swz / 64; C = (st & 1) * 32 + (swz % 64) / 2; }

template <bool GATHER>
__device__ __forceinline__ void gemm_tile(LAS unsigned char* lds, const char* __restrict__ Ab, const unsigned (&voffA)[GATHER ? 4 : 2], size_t hstepA, const char* __restrict__ Bb, int K,
                                          f32x4 (&acc)[2][2][4][2]) {
  const int tid = otid(), wid = __builtin_amdgcn_readfirstlane(tid >> 6), lane = tid & 63, wr = wid >> 2, wc = wid & 3, fr = lane & 15, fq = lane >> 4;
  const int nt = K / BK;
  unsigned voffB[2];
#pragma unroll
  for (int i = 0; i < 2; ++i) { int R, C; stage_rc(tid * 16 + i * 8192, R, C); voffB[i] = (unsigned)(R * K + C) * 2u; }
  const char* Bb1 = Bb + (size_t)HALF * K * 2; const char* Ab1 = GATHER ? Ab : Ab + hstepA;
  const unsigned* vA0 = &voffA[0]; const unsigned* vA1 = GATHER ? &voffA[2] : &voffA[0];
  const unsigned ldsw = (unsigned)wid * 1024u;
  const int aoff = lds_byte(wr * 64 + fr, fq * 8), boff = lds_byte(wc * 32 + fr, fq * 8);
#define G8_SA(b, h) (((b) * 2 + (h)) * HTB)
#define G8_SB(b, h) ((4 + (b) * 2 + (h)) * HTB)
#define G8_STAGE(bufoff, gbase, voff, kt) do { _Pragma("unroll") for (int _i = 0; _i < 2; ++_i) \
    __builtin_amdgcn_global_load_lds((const unsigned*)((gbase) + (size_t)(kt) * (BK * 2) + (voff)[_i]), (LAS unsigned*)(lds + (bufoff) + ldsw + _i * 8192), 16, 0, 0); } while (0)
#define G8_LDA(dst, b, h) do { _Pragma("unroll") for (int m = 0; m < 4; ++m) _Pragma("unroll") for (int k = 0; k < 2; ++k) dst[m][k] = *(const LAS bf16x8*)(lds + G8_SA(b, h) + aoff + m * 2048 + k * 1024); } while (0)
#define G8_LDB(dst, b, h) do { _Pragma("unroll") for (int n = 0; n < 2; ++n) _Pragma("unroll") for (int k = 0; k < 2; ++k) dst[n][k] = *(const LAS bf16x8*)(lds + G8_SB(b, h) + boff + n * 2048 + k * 1024); } while (0)
#define G8_MMA(ai, bj, At, Bt) do { __builtin_amdgcn_s_setprio(1); _Pragma("unroll") for (int m = 0; m < 4; ++m) _Pragma("unroll") for (int n = 0; n < 2; ++n) _Pragma("unroll") for (int k = 0; k < 2; ++k) \
    acc[ai][bj][m][n] = __builtin_amdgcn_mfma_f32_16x16x32_bf16(Bt[n][k], At[m][k], acc[ai][bj][m][n], 0, 0, 0); __builtin_amdgcn_s_setprio(0); } while (0)
#define G8_WAIT_V(n) asm volatile("s_waitcnt vmcnt(" #n ")" ::: "memory")
#define G8_WAIT_L(n) asm volatile("s_waitcnt lgkmcnt(" #n ")" ::: "memory")
#define G8_BAR __builtin_amdgcn_s_barrier()
#define G8_SCHED __builtin_amdgcn_sched_barrier(0)
#pragma unroll
  for (int a = 0; a < 2; ++a)
#pragma unroll
    for (int b = 0; b < 2; ++b)
#pragma unroll
      for (int m = 0; m < 4; ++m)
#pragma unroll
        for (int n = 0; n < 2; ++n) acc[a][b][m][n] = (f32x4){0.f, 0.f, 0.f, 0.f};
  bf16x8 At[4][2], B0[2][2], B1[2][2];
  G8_WAIT_V(0); __syncthreads();
  G8_STAGE(G8_SB(0, 0), Bb, voffB, 0); G8_STAGE(G8_SA(0, 0), Ab, vA0, 0); G8_STAGE(G8_SB(0, 1), Bb1, voffB, 0); G8_STAGE(G8_SA(0, 1), Ab1, vA1, 0);
  if (wr == 1) G8_BAR;
  G8_WAIT_V(4); G8_BAR;
  G8_STAGE(G8_SB(1, 0), Bb, voffB, 1); G8_STAGE(G8_SA(1, 0), Ab, vA0, 1); G8_STAGE(G8_SB(1, 1), Bb1, voffB, 1);
  G8_WAIT_V(6); G8_BAR;
  for (int t = 0; t < nt - 2; t += 2) {
    G8_LDB(B0, 0, 0); G8_SCHED; G8_LDA(At, 0, 0); G8_STAGE(G8_SA(1, 1), Ab1, vA1, t + 1);
    G8_WAIT_L(8); G8_BAR; G8_WAIT_L(0); G8_MMA(0, 0, At, B0); G8_BAR; G8_SCHED;
    G8_LDB(B1, 0, 1); G8_STAGE(G8_SB(0, 0), Bb, voffB, t + 2);
    G8_BAR; G8_WAIT_L(0); G8_MMA(0, 1, At, B1); G8_BAR;
    G8_LDA(At, 0, 1); G8_STAGE(G8_SA(0, 0), Ab, vA0, t + 2);
    G8_BAR; G8_WAIT_L(0); G8_MMA(1, 0, At, B0); G8_BAR; G8_SCHED;
    G8_STAGE(G8_SB(0, 1), Bb1, voffB, t + 2);
    G8_WAIT_V(6); G8_BAR; G8_MMA(1, 1, At, B1); G8_BAR;
    G8_LDB(B0, 1, 0); G8_SCHED; G8_LDA(At, 1, 0); G8_STAGE(G8_SA(0, 1), Ab1, vA1, t + 2);
    G8_WAIT_L(8); G8_BAR; G8_WAIT_L(0); G8_MMA(0, 0, At, B0); G8_BAR; G8_SCHED;
    G8_LDB(B1, 1, 1); G8_STAGE(G8_SB(1, 0), Bb, voffB, t + 3);
    G8_BAR; G8_WAIT_L(0); G8_MMA(0, 1, At, B1); G8_BAR;
    G8_LDA(At, 1, 1); G8_STAGE(G8_SA(1, 0), Ab, vA0, t + 3);
    G8_BAR; G8_WAIT_L(0); G8_MMA(1, 0, At, B0); G8_BAR; G8_SCHED;
    G8_STAGE(G8_SB(1, 1), Bb1, voffB, t + 3);
    G8_WAIT_V(6); G8_BAR; G8_MMA(1, 1, At, B1); G8_BAR;
  }
  { G8_LDB(B0, 0, 0); G8_LDA(At, 0, 0); G8_STAGE(G8_SA(1, 1), Ab1, vA1, nt - 1);
    G8_BAR; G8_WAIT_L(0); G8_MMA(0, 0, At, B0); G8_BAR;
    G8_LDB(B1, 0, 1); G8_BAR; G8_WAIT_L(0); G8_MMA(0, 1, At, B1); G8_BAR;
    G8_LDA(At, 0, 1); G8_WAIT_V(4); G8_BAR; G8_WAIT_L(0); G8_MMA(1, 0, At, B0); G8_MMA(1, 1, At, B1); G8_BAR; }
  { G8_LDB(B0, 1, 0); G8_LDA(At, 1, 0); G8_WAIT_V(2); G8_BAR; G8_WAIT_L(0); G8_MMA(0, 0, At, B0); G8_BAR;
    G8_LDB(B1, 1, 1); G8_WAIT_V(0); G8_BAR; G8_WAIT_L(0); G8_MMA(0, 1, At, B1); G8_BAR;
    G8_LDA(At, 1, 1); G8_BAR; G8_WAIT_L(0); G8_MMA(1, 0, At, B0); G8_MMA(1, 1, At, B1); G8_BAR; }
  if (wr == 0) G8_BAR;
}
__device__ __forceinline__ unsigned piece_off(int i, int ld, int c0) { int R, C; stage_rc((int)otid() * 16 + i * 8192, R, C); return (unsigned)(R * ld + c0 + C) * 2u; }
__device__ __forceinline__ void piece_rc(int i, int& R, int& C) { stage_rc((int)otid() * 16 + i * 8192, R, C); }
struct TileIter {
  int nM, nN, x, j, J, cnt, idx;
  __device__ __forceinline__ void init(int nM_, int nN_) { nM = nM_; nN = nN_; x = obid() & 7; j = obid() >> 3; J = gridDim.x >> 3; cnt = ((nM - x + 7) >> 3) * nN; idx = j; }
  __device__ __forceinline__ bool next(int& pm, int& pn) { if (idx >= cnt) return false; pm = x + 8 * (idx / nN); pn = idx % nN; idx += J; return true; }
};
struct MoeIter {
  int nN, x, jm, jn, j, step, nsteps, nb4; bool with_ctx, ctx_done;
  __device__ __forceinline__ void init(int nN_, bool with_ctx_) { nN = nN_; with_ctx = with_ctx_; x = obid() & 7; j = obid() >> 3; jm = j & 7; jn = j >> 3; nb4 = nN >> 2; nsteps = 2 * nb4 * 4; step = 0; ctx_done = false; }
  __device__ __forceinline__ bool next(int& pm, int& pn, int& e) {
    if (step < nsteps) { const int mb = step & 3, nb = (step >> 2) % nb4, el = (step >> 2) / nb4; e = 2 * x + el; const int m32 = mb * 8 + jm; pm = ((m32 >> 2) * 16 + e) * 4 + (m32 & 3); pn = nb * 4 + jn; ++step; return true; }
    if (with_ctx && !ctx_done) { ctx_done = true; if (j < 2 * nN) { e = 2 * x + j / nN; pm = 512 + e; pn = j % nN; return true; } }
    return false;
  }
};
}

#define ACC_FOR(ai, bj, m, n) _Pragma("unroll") for (int ai = 0; ai < 2; ++ai) _Pragma("unroll") for (int bj = 0; bj < 2; ++bj) _Pragma("unroll") for (int m = 0; m < 4; ++m) _Pragma("unroll") for (int n = 0; n < 2; ++n)

__device__ __forceinline__ void cvt_tile(const float* __restrict__ src, int N, int K, int k0, int n0, bf16_t* __restrict__ dst, long drow0, const float* __restrict__ kscale, float* lds) {
  const int tid = otid();
  { const int kr = tid >> 6, n = tid & 63;
#pragma unroll
    for (int i = 0; i < 8; ++i) { const int k = kr + 8 * i; float v = (n0 + n < N) ? src[(size_t)(k0 + k) * N + n0 + n] : 0.f; if (kscale) v *= kscale[k0 + k]; lds[k * 65 + n] = v; } }
  __syncthreads();
  { const int n = tid >> 3, k8 = (tid & 7) * 8; float v[8];
#pragma unroll
    for (int i = 0; i < 8; ++i) v[i] = lds[(k8 + i) * 65 + n];
    u32x4 w = {cvtpk(v[0], v[1]), cvtpk(v[2], v[3]), cvtpk(v[4], v[5]), cvtpk(v[6], v[7])};
    *(u32x4*)(dst + (size_t)(drow0 + n) * K + k0 + k8) = w; }
  __syncthreads();
}

__device__ void phase_prep(PRef p, char* smem) {
  float* lds = (float*)smem;
  bf16_t* Wt_in = (bf16_t*)(p.ws + WS_WIN); bf16_t* Wt_uq = (bf16_t*)(p.ws + WS_WUQ); bf16_t* Wt_ukv = (bf16_t*)(p.ws + WS_WUKV); bf16_t* Wt_out = (bf16_t*)(p.ws + WS_WOUT);
  float* mod = (float*)(p.ws + WS_MOD);
  constexpr int T_MOD = 192, T_IN = 2 * 16 * 44, T_UQ = 2 * 6 * 12, T_UKV = 2 * 4 * 16, T_OUT = 2 * 16 * 16, T_ROPE = 64;
  constexpr int E0 = T_MOD, E1 = E0 + T_IN, E2 = E1 + T_UQ, E3 = E2 + T_UKV, E4 = E3 + T_OUT, E5 = E4 + T_ROPE;
  const int tid = otid();
  for (int task = obid(); task < E5; task += gridDim.x) {
    if (task < E0) {
      const int l = task / 96, j0 = (task % 96) * 64;
      float* sc = lds;
      for (int i = tid; i < 9 * 1024; i += 512) { const int bb = i >> 10, d = i & 1023; const float v = bb < 8 ? p.c[bb * 1024 + d] : p.c_ctx[d]; sc[i] = v / (1.f + expf(-v)); }
      __syncthreads();
      const int col = tid & 63, ks = tid >> 6; float a[9];
#pragma unroll
      for (int bb = 0; bb < 9; ++bb) a[bb] = 0.f;
      const float* wm = p.w_mod + (size_t)l * 1024 * 6144 + j0 + col;
      for (int d = ks * 128; d < ks * 128 + 128; ++d) { const float w = wm[(size_t)d * 6144];
#pragma unroll
        for (int bb = 0; bb < 9; ++bb) a[bb] += sc[bb * 1024 + d] * w; }
      float* red = lds + 9 * 1024;
#pragma unroll
      for (int bb = 0; bb < 9; ++bb) red[(ks * 9 + bb) * 64 + col] = a[bb];
      __syncthreads();
      for (int i = tid; i < 9 * 64; i += 512) { const int bb = i >> 6, cc = i & 63; float s = 0.f;
        for (int k = 0; k < 8; ++k) s += red[(k * 9 + bb) * 64 + cc];
        mod[((size_t)l * 9 + bb) * 6144 + j0 + cc] = s + p.b_mod[l * 6144 + j0 + cc]; }
      __syncthreads();
    } else if (task < E1) { const int t = task - E0, l = t / 704, r = t % 704, kt = r / 44, nt = r % 44;
      cvt_tile(p.w_in + (size_t)l * 1024 * IN_COLS, IN_COLS, 1024, kt * 64, nt * 64, Wt_in + (size_t)l * PLD * 1024, nt * 64, nullptr, lds);
    } else if (task < E2) { const int t = task - E1, l = t / 72, r = t % 72, kt = r / 12, nt = r % 12;
      cvt_tile(p.w_uq + (size_t)l * 384 * 768, 768, 384, kt * 64, nt * 64, Wt_uq + (size_t)l * 768 * 384, nt * 64, p.q_norm_w + l * 384, lds);
    } else if (task < E3) { const int t = task - E2, l = t / 64, r = t % 64, kt = r / 16, nt = r % 16;
      cvt_tile(p.w_ukv + (size_t)l * 256 * 1024, 1024, 256, kt * 64, nt * 64, Wt_ukv + (size_t)l * 1024 * 256, nt * 64, p.kv_norm_w + l * 256, lds);
    } else if (task < E4) { const int t = task - E3, l = t / 256, r = t % 256, kt = r / 16, nt = r % 16;
      cvt_tile(p.w_out + (size_t)l * 1024 * 1024, 1024, 1024, kt * 64, nt * 64, Wt_out + (size_t)l * 1024 * 1024, nt * 64, nullptr, lds);
    } else {
      float* cs = (float*)(p.ws + WS_COS); float* sn = (float*)(p.ws + WS_SIN);
      for (int i = (task - E4) * 4096 + tid; i < (task - E4 + 1) * 4096; i += 512) { const int t = i >> 5, j = i & 31;
        const float inv = exp2f(-(float)(j & 15) * (13.287712379549449f / 16.f));
        const float pos = (float)(j < 16 ? (t >> 6) : (t & 63)); const float ang = pos * inv;
        const double a = (double)ang; const double k = rint(a * 0.15915494309189535); const float r = (float)(a - k * 6.283185307179586);
        cs[i] = __cosf(r); sn[i] = __sinf(r); }
    }
  }
}

__device__ void phase_cvt_experts(PRef p, int l, char* smem) {
  float* lds = (float*)smem;
  bf16_t* Wgu = (bf16_t*)(p.ws + WS_WGU); bf16_t* Wdn = (bf16_t*)(p.ws + WS_WDN);
  for (int task = obid(); task < NE * 768; task += gridDim.x) {
    const int e = task / 768, r = task % 768, which = r >> 8, kt = (r & 255) >> 4, nt = r & 15, n0 = nt * 64;
    const size_t eo = ((size_t)l * NE + e) * 1024 * 1024;
    if (which == 0) cvt_tile(p.w_gate + eo, 1024, 1024, kt * 64, n0, Wgu + (size_t)e * 2048 * 1024, (n0 >> 7) * 256 + (n0 & 127), nullptr, lds);
    else if (which == 1) cvt_tile(p.w_up + eo, 1024, 1024, kt * 64, n0, Wgu + (size_t)e * 2048 * 1024, (n0 >> 7) * 256 + 128 + (n0 & 127), nullptr, lds);
    else cvt_tile(p.w_down + eo, 1024, 1024, kt * 64, n0, Wdn + (size_t)e * 1024 * 1024, n0, nullptr, lds);
  }
}

__device__ __forceinline__ void ln_row(f32x4 (&v)[4], float eps) {
  float s = 0.f;
#pragma unroll
  for (int i = 0; i < 4; ++i) s += v[i][0] + v[i][1] + v[i][2] + v[i][3];
  const float mu = wave_sum(s) * (1.f / 1024.f);
  float q = 0.f;
#pragma unroll
  for (int i = 0; i < 4; ++i)
#pragma unroll
    for (int k = 0; k < 4; ++k) { v[i][k] -= mu; q += v[i][k] * v[i][k]; }
  const float rs = rsqrtf(wave_sum(q) * (1.f / 1024.f) + eps);
#pragma unroll
  for (int i = 0; i < 4; ++i) v[i] *= rs;
}
__device__ __forceinline__ void store_mod_bf16(const f32x4 (&v)[4], const float* __restrict__ shift, const float* __restrict__ scale, bf16_t* __restrict__ hrow, int lane, f32x4 (*keep)[4]) {
#pragma unroll
  for (int i = 0; i < 4; ++i) { const int c = lane * 4 + 256 * i; const f32x4 sh = *(const f32x4*)(shift + c), sc = *(const f32x4*)(scale + c);
    f32x4 o = v[i] * (sc + 1.f) + sh; if (keep) (*keep)[i] = o;
    u32x2 w = {cvtpk(o[0], o[1]), cvtpk(o[2], o[3])}; *(u32x2*)(hrow + c) = w; }
}
__device__ __forceinline__ const float* mod_ptr(PRef p, int l, int row, int which) {
  const int bb = row < MX ? (row >> 13) : 8;
  return (const float*)(p.ws + WS_MOD) + ((size_t)l * 9 + bb) * 6144 + which * 1024;
}

__device__ void phase_h0(PRef p) {
  const int lane = otid() & 63, gw = obid() * 8 + (otid() >> 6), nw = gridDim.x * 8;
  bf16_t* h = (bf16_t*)(p.ws + WS_H);
  for (int row = gw; row < MT; row += nw) {
    const float* src = row < MX ? p.x + (size_t)row * 1024 : p.ctx + (size_t)(row - MX) * 1024;
    f32x4 v[4];
#pragma unroll
    for (int i = 0; i < 4; ++i) v[i] = *(const f32x4*)(src + lane * 4 + 256 * i);
    ln_row(v, 1e-6f);
    store_mod_bf16(v, mod_ptr(p, 0, row, 0), mod_ptr(p, 0, row, 1), h + (size_t)row * 1024, lane, nullptr);
  }
}

__device__ void phase_inproj(PRef p, int l, char* smem) {
  LAS unsigned char* lds = (LAS unsigned char*)smem;
  const bf16_t* h = (const bf16_t*)(p.ws + WS_H); const bf16_t* Wt = (const bf16_t*)(p.ws + WS_WIN) + (size_t)l * PLD * 1024;
  bf16_t* P = (bf16_t*)(p.ws + WS_P); float* gates = (float*)(p.ws + WS_GATES);
  const int tid = otid(), wid = tid >> 6, lane = tid & 63, wr = wid >> 2, wc = wid & 3, fr = lane & 15, fq = lane >> 4;
  g8::TileIter it; it.init(MT / 256, PLD / 256);
  int pm, pn;
  while (it.next(pm, pn)) {
    unsigned voffA[2] = {g8::piece_off(0, 1024, 0), g8::piece_off(1, 1024, 0)};
    f32x4 acc[2][2][4][2];
    g8::gemm_tile<false>(lds, (const char*)(h + (size_t)pm * 256 * 1024), voffA, (size_t)128 * 1024 * 2, (const char*)(Wt + (size_t)pn * 256 * 1024), 1024, acc);
    ACC_FOR(ai, bj, m, n) {
      const int row = pm * 256 + ai * 128 + wr * 64 + m * 16 + fr, col = pn * 256 + bj * 128 + wc * 32 + n * 16 + fq * 4;
      const f32x4 v = acc[ai][bj][m][n];
      u32x2 w = {cvtpk(v[0], v[1]), cvtpk(v[2], v[3])}; *(u32x2*)(P + (size_t)row * PLD + col) = w;
      if (col >= OFF_G && col < OFF_G + 16) { const f32x4 bg = *(const f32x4*)(p.b_gates + l * 16 + (col - OFF_G)); *(f32x4*)(gates + (size_t)row * 16 + (col - OFF_G)) = v + bg; }
    }
  }
}


__device__ void phase_mlstm(PRef p, int l, char* smem, size_t hb_off = WS_HB) {
  bf16_t* RAWQ = (bf16_t*)(smem); bf16_t* RAWK = (bf16_t*)(smem + 17408);
  bf16_t* QB = (bf16_t*)(smem + 34816); bf16_t* KB = (bf16_t*)(smem + 52224);
  bf16_t* KT = (bf16_t*)(smem + 69632);
  bf16_t* VT = (bf16_t*)(smem + 88064); bf16_t* VWT = (bf16_t*)(smem + 94976);
  bf16_t* PB = (bf16_t*)(smem + 101888);
  bf16_t* CT = (bf16_t*)(smem + 111104);
  float* SC = (float*)(smem + 124160);
  const bf16_t* P = (const bf16_t*)(p.ws + WS_P); const float* gates = (const float*)(p.ws + WS_GATES);
  bf16_t* hbuf = (bf16_t*)(p.ws + hb_off);
  const int tid = otid(), wid = tid >> 6, lane = tid & 63, fr = lane & 15, fq = lane >> 4;
  for (int w = obid(); w < 256; w += gridDim.x) {
    const int slice = w & 3, dir = (w >> 2) & 1, hd = (w >> 3) & 3, b = w >> 5;
    const int c2 = (tid & 63) * 2;
    float wq0[5], wq1[5], wk0[5], wk1[5];
#pragma unroll
    for (int j = 0; j < 5; ++j) { const float* cw = p.conv_w + ((size_t)l * 5 + j) * 1024; wq0[j] = cw[hd * 128 + c2]; wq1[j] = cw[hd * 128 + c2 + 1]; wk0[j] = cw[512 + hd * 128 + c2]; wk1[j] = cw[512 + hd * 128 + c2 + 1]; }
    const float bq0 = p.conv_b[l * 1024 + hd * 128 + c2], bq1 = p.conv_b[l * 1024 + hd * 128 + c2 + 1], bk0 = p.conv_b[l * 1024 + 512 + hd * 128 + c2], bk1 = p.conv_b[l * 1024 + 512 + hd * 128 + c2 + 1];
    __syncthreads();
    for (int i = tid; i < 48 * 136 / 2; i += 512) ((unsigned*)CT)[i] = 0u;
    for (int i = tid; i < 48 * 72 / 2; i += 512) { ((unsigned*)VT)[i] = 0u; ((unsigned*)VWT)[i] = 0u; }
    f32x4 accC[3];
#pragma unroll
    for (int i = 0; i < 3; ++i) accC[i] = (f32x4){0.f, 0.f, 0.f, 0.f};
    float m_state = 0.f;
    __syncthreads();
    u32x4 pre_raw[5]; u32x2 pre_v; float pre_ig = 0.f, pre_fg = 0.f;
    const int vl = tid >> 3, ve4 = (tid & 7) * 4;
#define MLSTM_PREFETCH(CI) do { const int ci_ = (CI); const bool ic_ = ci_ < 4; const int cc_ = ic_ ? ci_ : ci_ - 4, T_ = ic_ ? CTXL : SEQ, rb_ = ic_ ? MX + b * CTXL : b * SEQ; \
      const int tlo_ = dir ? T_ - 64 - cc_ * 64 : cc_ * 64; \
      _Pragma("unroll") for (int k_ = 0; k_ < 5; ++k_) { const int pc = tid + k_ * 512; pre_raw[k_] = (u32x4){0u, 0u, 0u, 0u}; \
        if (pc < 2176) { const int tens = pc >= 1088, rem = tens ? pc - 1088 : pc, rr = rem >> 4, c16 = rem & 15, t = tlo_ - 2 + rr; \
          if (t >= 0 && t < T_) pre_raw[k_] = *(const u32x4*)(P + (size_t)(rb_ + t) * PLD + (tens ? OFF_K : OFF_Q) + hd * 128 + c16 * 8); } } \
      { const int vt_ = dir ? tlo_ + 63 - vl : tlo_ + vl; pre_v = *(const u32x2*)(P + (size_t)(rb_ + vt_) * PLD + OFF_V + hd * 128 + slice * 32 + ve4); } \
      if (wid == 0) { const int t = dir ? tlo_ + 63 - lane : tlo_ + lane; const float* g = gates + (size_t)(rb_ + t) * 16; pre_ig = g[dir * 8 + hd]; pre_fg = g[dir * 8 + 4 + hd]; } } while (0)
    MLSTM_PREFETCH(0);
    for (int ci = 0; ci < 132; ++ci) {
      const bool isctx = ci < 4; const int cc = isctx ? ci : ci - 4, T = isctx ? CTXL : SEQ, rowbase = isctx ? MX + b * CTXL : b * SEQ;
      const int tlo = dir ? T - 64 - cc * 64 : cc * 64;
      float* S = SC + (ci & 1) * 384;
      const bool need_out = !(l == DEPTH - 1 && isctx);
      if (wid == 0) {
        const float ig = pre_ig, fg = pre_fg;
        const float lf = fminf(fg, 0.f) - log1pf(expf(-fabsf(fg)));
        float bc = lf;
#pragma unroll
        for (int o = 1; o < 64; o <<= 1) { const float u = __shfl_up(bc, o); if (lane >= o) bc += u; }
        const float a = ig - bc; float pmx = a;
#pragma unroll
        for (int o = 1; o < 64; o <<= 1) { const float u = __shfl_up(pmx, o); if (lane >= o) pmx = fmaxf(pmx, u); }
        const float Mx = fmaxf(pmx, m_state), M63 = __shfl(Mx, 63), b63 = __shfl(bc, 63);
        S[lane] = a; S[64 + lane] = Mx; S[128 + lane] = expf(m_state - Mx); S[192 + lane] = expf(-(bc + Mx)); S[256 + lane] = expf(a - M63);
        if (lane == 0) { S[320] = expf(m_state - M63); S[321] = b63 + M63; }
      }
#pragma unroll
      for (int k = 0; k < 5; ++k) { const int pc = tid + k * 512;
        if (pc < 2176) { const int tens = pc >= 1088, rem = tens ? pc - 1088 : pc, rr = rem >> 4, c16 = rem & 15; *(u32x4*)((tens ? RAWK : RAWQ) + rr * 128 + c16 * 8) = pre_raw[k]; } }
      const u32x2 vraw = pre_v;
      if (ci + 1 < 132) MLSTM_PREFETCH(ci + 1);
      __syncthreads();
      {
        const int rg = wid; unsigned rq[12], rk[12];
#pragma unroll
        for (int i = 0; i < 12; ++i) { rq[i] = *(const unsigned*)(RAWQ + (rg * 8 + i) * 128 + c2); rk[i] = *(const unsigned*)(RAWK + (rg * 8 + i) * 128 + c2); }
#pragma unroll
        for (int jj = 0; jj < 8; ++jj) {
          float yq0 = bq0, yq1 = bq1, yk0 = bk0, yk1 = bk1;
#pragma unroll
          for (int tp = 0; tp < 5; ++tp) { yq0 += wq0[tp] * bflo(rq[jj + tp]); yq1 += wq1[tp] * bfhi(rq[jj + tp]); yk0 += wk0[tp] * bflo(rk[jj + tp]); yk1 += wk1[tp] * bfhi(rk[jj + tp]); }
          const int j = rg * 8 + jj, lr = dir ? 63 - j : j;
          const float q0 = silu_f(yq0) * 0.08838834764831845f, q1 = silu_f(yq1) * 0.08838834764831845f, k0 = silu_f(yk0), k1 = silu_f(yk1);
          *(unsigned*)(QB + lr * 136 + c2) = cvtpk(q0, q1);
          const unsigned kw = cvtpk(k0, k1);
          *(unsigned*)(KB + lr * 136 + c2) = kw;
          KT[c2 * 72 + lr] = (bf16_t)(kw & 0xffffu); KT[(c2 + 1) * 72 + lr] = (bf16_t)(kw >> 16);
        }
        const float wsl = S[256 + vl];
        const float v0 = bflo(vraw[0]), v1 = bfhi(vraw[0]), v2 = bflo(vraw[1]), v3 = bfhi(vraw[1]);
        VT[(ve4 + 0) * 72 + vl] = (bf16_t)(vraw[0] & 0xffffu); VT[(ve4 + 1) * 72 + vl] = (bf16_t)(vraw[0] >> 16);
        VT[(ve4 + 2) * 72 + vl] = (bf16_t)(vraw[1] & 0xffffu); VT[(ve4 + 3) * 72 + vl] = (bf16_t)(vraw[1] >> 16);
        VWT[(ve4 + 0) * 72 + vl] = f2bf(v0 * wsl); VWT[(ve4 + 1) * 72 + vl] = f2bf(v1 * wsl); VWT[(ve4 + 2) * 72 + vl] = f2bf(v2 * wsl); VWT[(ve4 + 3) * 72 + vl] = f2bf(v3 * wsl);
        if (tid < 64) { VT[32 * 72 + tid] = (bf16_t)0x3F80u; VWT[32 * 72 + tid] = f2bf(S[256 + tid]); }
      }
      __syncthreads();
      if (need_out) {
        const int mt = wid >> 1;
#pragma unroll
        for (int u = 0; u < 2; ++u) {
          const int ntl = (wid & 1) * 2 + u;
          f32x4 s = {0.f, 0.f, 0.f, 0.f};
          if (ntl <= mt) {
#pragma unroll
            for (int kk = 0; kk < 4; ++kk) {
              const bf16x8 a = *(const bf16x8*)(QB + (mt * 16 + fr) * 136 + kk * 32 + fq * 8), bb = *(const bf16x8*)(KB + (ntl * 16 + fr) * 136 + kk * 32 + fq * 8);
              s = __builtin_amdgcn_mfma_f32_16x16x32_bf16(a, bb, s, 0, 0, 0); }
          }
          const int j = ntl * 16 + fr; const float aj = S[j];
#pragma unroll
          for (int jj = 0; jj < 4; ++jj) { const int lr = mt * 16 + fq * 4 + jj;
            const float pv = (j <= lr) ? s[jj] * __expf(fminf(aj - S[64 + lr], 0.f)) : 0.f;
            PB[lr * 72 + j] = f2bf(pv); }
        }
      }
      __syncthreads();
      if (need_out && wid < 4) {
        const int mt = wid; f32x4 num[3];
#pragma unroll
        for (int ntl = 0; ntl < 3; ++ntl) {
          f32x4 a1 = {0.f, 0.f, 0.f, 0.f}, a2 = {0.f, 0.f, 0.f, 0.f};
#pragma unroll
          for (int kk = 0; kk < 2; ++kk) { const bf16x8 a = *(const bf16x8*)(PB + (mt * 16 + fr) * 72 + kk * 32 + fq * 8), bb = *(const bf16x8*)(VT + (ntl * 16 + fr) * 72 + kk * 32 + fq * 8);
            a1 = __builtin_amdgcn_mfma_f32_16x16x32_bf16(a, bb, a1, 0, 0, 0); }
#pragma unroll
          for (int kk = 0; kk < 4; ++kk) { const bf16x8 a = *(const bf16x8*)(QB + (mt * 16 + fr) * 136 + kk * 32 + fq * 8), bb = *(const bf16x8*)(CT + (ntl * 16 + fr) * 136 + kk * 32 + fq * 8);
            a2 = __builtin_amdgcn_mfma_f32_16x16x32_bf16(a, bb, a2, 0, 0, 0); }
#pragma unroll
          for (int jj = 0; jj < 4; ++jj) num[ntl][jj] = a1[jj] + S[128 + mt * 16 + fq * 4 + jj] * a2[jj];
        }
#pragma unroll
        for (int jj = 0; jj < 4; ++jj) {
          const int lr = mt * 16 + fq * 4 + jj; const float den = __shfl(num[2][jj], lane & 48);
          const float rd = 1.f / fmaxf(fabsf(den), S[192 + lr]);
          const int t = dir ? tlo + 63 - lr : tlo + lr;
          bf16_t* hp = hbuf + ((size_t)((dir * 4 + hd) * 4 + slice) * MT + rowbase + t) * 32 + fr;
          hp[0] = f2bf(num[0][jj] * rd); hp[16] = f2bf(num[1][jj] * rd);
#if DBG_STOP == 23
          { const size_t di = (size_t)(hp - hbuf); if (di + 16 < (size_t)MX * 1024) { p.out[di] = num[0][jj] * rd; p.out[di + 16] = num[1][jj] * rd; } }
#endif
        }
      }
      __syncthreads();
      {
        const float decay = S[320];
#pragma unroll
        for (int mt = 0; mt < 3; ++mt) {
          accC[mt] *= decay;
#pragma unroll
          for (int kk = 0; kk < 2; ++kk) { const bf16x8 a = *(const bf16x8*)(VWT + (mt * 16 + fr) * 72 + kk * 32 + fq * 8), bb = *(const bf16x8*)(KT + (wid * 16 + fr) * 72 + kk * 32 + fq * 8);
            accC[mt] = __builtin_amdgcn_mfma_f32_16x16x32_bf16(a, bb, accC[mt], 0, 0, 0); }
#pragma unroll
          for (int jj = 0; jj < 4; ++jj) CT[(mt * 16 + fq * 4 + jj) * 136 + wid * 16 + fr] = f2bf(accC[mt][jj]);
        }
        m_state = S[321];
      }
    }
  }
}

template <int WHICH>
__device__ __forceinline__ void mla_gemm(PRef p, int l, char* smem) {
  LAS unsigned char* lds = (LAS unsigned char*)smem; float* rsb = (float*)(smem + g8::STAGE_BYTES);
  const bf16_t* P = (const bf16_t*)(p.ws + WS_P);
  const int tid = otid(), wid = tid >> 6, lane = tid & 63, wr = wid >> 2, wc = wid & 3, fr = lane & 15, fq = lane >> 4;
  constexpr int K = WHICH ? 256 : 384, OFFC = WHICH ? OFF_CKV : OFF_CQ, N = WHICH ? 1024 : 768;
  const bf16_t* Wt = WHICH ? (const bf16_t*)(p.ws + WS_WUKV) + (size_t)l * 1024 * 256 : (const bf16_t*)(p.ws + WS_WUQ) + (size_t)l * 768 * 384;
  bf16_t* O = (bf16_t*)(p.ws + (WHICH ? WS_KV : WS_Q));
  g8::TileIter it; it.init((WHICH || l == 0) ? MT / 256 : MX / 256, N / 256);
  int pm, pn;
  while (it.next(pm, pn)) {
    __syncthreads();
    { const int r = tid >> 1, hf = tid & 1; const bf16_t* src = P + (size_t)(pm * 256 + r) * PLD + OFFC + hf * (K / 2); float s = 0.f;
#pragma unroll 4
      for (int i = 0; i < K / 16; ++i) { const u32x4 v = *(const u32x4*)(src + i * 8);
#pragma unroll
        for (int k = 0; k < 4; ++k) { const float a = bflo(v[k]), bq = bfhi(v[k]); s += a * a + bq * bq; } }
      s += __shfl_xor(s, 1);
      if (hf == 0) rsb[r] = rsqrtf(s / (float)K + 1e-6f); }
    unsigned voffA[2] = {g8::piece_off(0, PLD, OFFC), g8::piece_off(1, PLD, OFFC)};
    f32x4 acc[2][2][4][2];
    g8::gemm_tile<false>(lds, (const char*)(P + (size_t)pm * 256 * PLD), voffA, (size_t)128 * PLD * 2, (const char*)(Wt + (size_t)pn * 256 * K), opaque_s(K), acc);
    ACC_FOR(ai, bj, m, n) {
      const int rl = ai * 128 + wr * 64 + m * 16 + fr, row = pm * 256 + rl, col = pn * 256 + bj * 128 + wc * 32 + n * 16 + fq * 4;
      const f32x4 v = acc[ai][bj][m][n] * rsb[rl];
      size_t orow = row;
      if (WHICH) orow = row < MX ? (size_t)(row >> 13) * SKV + CTXL + (row & 8191) : (size_t)((row - MX) >> 8) * SKV + ((row - MX) & 255);
      u32x2 w = {cvtpk(v[0], v[1]), cvtpk(v[2], v[3])}; *(u32x2*)(O + orow * N + col) = w;
    }
  }
}
__device__ void phase_mla_prep(PRef p, int l, char* smem) {
  mla_gemm<0>(p, l, smem);
  mla_gemm<1>(p, l, smem);
  const bf16_t* P = (const bf16_t*)(p.ws + WS_P);
  const int tid = otid(), wid = tid >> 6, lane = tid & 63;
  const bf16_t* hbuf = (const bf16_t*)(p.ws + WS_HB); bf16_t* mix = (bf16_t*)(p.ws + WS_MIX); bf16_t* KR = (bf16_t*)(p.ws + WS_KR);
  const float* cs = (const float*)(p.ws + WS_COS); const float* sn = (const float*)(p.ws + WS_SIN);
  const int gw = obid() * 8 + wid, nw = gridDim.x * 8;
  for (int row = gw; row < MT; row += nw) {
    if (row < MX || l == 0) {
      const size_t ho = ((size_t)(lane >> 2) * MT + row) * 32 + (lane & 3) * 8;
      const u32x4 hf = *(const u32x4*)(hbuf + ho), hb = *(const u32x4*)(hbuf + (size_t)16 * MT * 32 + ho);
      const u32x4 ov = *(const u32x4*)(P + (size_t)row * PLD + OFF_O + lane * 8);
      float v[8]; float s = 0.f;
#pragma unroll
      for (int k = 0; k < 4; ++k) { v[2 * k] = bflo(hf[k]) + bflo(hb[k]); v[2 * k + 1] = bfhi(hf[k]) + bfhi(hb[k]); s += v[2 * k] + v[2 * k + 1]; }
      s += __shfl_xor(s, 1); s += __shfl_xor(s, 2); s += __shfl_xor(s, 4); s += __shfl_xor(s, 8);
      const float mu = s * (1.f / 128.f); float q = 0.f;
#pragma unroll
      for (int k = 0; k < 8; ++k) { v[k] -= mu; q += v[k] * v[k]; }
      q += __shfl_xor(q, 1); q += __shfl_xor(q, 2); q += __shfl_xor(q, 4); q += __shfl_xor(q, 8);
      const float rs = rsqrtf(q * (1.f / 128.f) + 1e-6f);
      const float* nw_ = p.m_norm_w + l * 512 + lane * 8; float o[8];
#pragma unroll
      for (int k = 0; k < 4; ++k) { o[2 * k] = v[2 * k] * rs * nw_[2 * k] * sigmoid_f(bflo(ov[k])); o[2 * k + 1] = v[2 * k + 1] * rs * nw_[2 * k + 1] * sigmoid_f(bfhi(ov[k])); }
      u32x4 wv = {cvtpk(o[0], o[1]), cvtpk(o[2], o[3]), cvtpk(o[4], o[5]), cvtpk(o[6], o[7])};
      *(u32x4*)(mix + (size_t)row * 1024 + lane * 8) = wv;
    }
    {
      const int j = lane & 31;
      const float x1 = bf2f(P[(size_t)row * PLD + OFF_KR + j]), x2 = bf2f(P[(size_t)row * PLD + OFF_KR + 32 + j]);
      float o1 = x1, o2 = x2; size_t orow;
      if (row < MX) { const int t = row & 8191; const float c = cs[t * 32 + j], s_ = sn[t * 32 + j]; o1 = x1 * c - x2 * s_; o2 = x2 * c + x1 * s_; orow = (size_t)(row >> 13) * SKV + CTXL + t; }
      else orow = (size_t)((row - MX) >> 8) * SKV + ((row - MX) & 255);
      if (lane < 32) { KR[orow * 64 + j] = f2bf(o1); KR[orow * 64 + 32 + j] = f2bf(o2); }
    }
  }
}

namespace att {
constexpr int NW = 8, QBLK = 32, KVBLK = 64, LDQ = 768, LDK = 1024, LDKR = 64, LDO = 1024;
constexpr float SCALE = A_SCALE;
constexpr float THR = 8.f;
constexpr size_t SHM_V = KVBLK * 128 * 2, SHM_K = KVBLK * 128 * 2, SHM_R = KVBLK * 64 * 2;
typedef float f32x8 __attribute__((ext_vector_type(8)));
#define KSWZ(row, colB) ((row) * 256 + ((colB) ^ (((row) & 7) << 4)))
#define RSWZ(row, colB) ((row) * 128 + ((colB) ^ (((row) & 7) << 4)))
#define SBAR() __builtin_amdgcn_sched_barrier(0)
__device__ __forceinline__ int crow(int r, int hi) { return (r & 3) + 8 * (r >> 2) + 4 * hi; }
__device__ __forceinline__ void partialSM(f32x16& p0, f32x16& p1, float& m_reg, float& mn, float& alpha) {
  constexpr float C = SCALE * 1.4426950408889634f;
  float pmax = p0[0];
#pragma unroll
  for (int r = 1; r < 16; ++r) pmax = fmaxf(pmax, p0[r]);
#pragma unroll
  for (int r = 0; r < 16; ++r) pmax = fmaxf(pmax, p1[r]);
  { auto rr = __builtin_amdgcn_permlane32_swap(__float_as_uint(pmax), __float_as_uint(pmax), false, false);
    pmax = fmaxf(__uint_as_float(rr[0]), __uint_as_float(rr[1])); }
  if (__builtin_expect(__all(pmax - m_reg <= THR / SCALE), 1)) { mn = m_reg; alpha = 1.f; }
  else { mn = fmaxf(m_reg, pmax); alpha = __builtin_amdgcn_exp2f((m_reg - mn) * C); m_reg = mn; }
  const float mnC = -mn * C;
#pragma unroll
  for (int r = 0; r < 16; ++r) p0[r] = fmaf(p0[r], C, mnC);
#pragma unroll
  for (int r = 0; r < 16; ++r) p1[r] = fmaf(p1[r], C, mnC);
#pragma unroll
  for (int r = 0; r < 16; ++r) p0[r] = __builtin_amdgcn_exp2f(p0[r]);
}
__device__ __forceinline__ void finishSM(f32x16& p0, f32x16& p1, float alpha, float& l_reg, bf16x8& pa0, bf16x8& pa1, bf16x8& pa2, bf16x8& pa3) {
#pragma unroll
  for (int r = 0; r < 16; ++r) p1[r] = __builtin_amdgcn_exp2f(p1[r]);
  float ps = 0;
#pragma unroll
  for (int r = 0; r < 16; ++r) ps += p0[r];
#pragma unroll
  for (int r = 0; r < 16; ++r) ps += p1[r];
  { auto rr = __builtin_amdgcn_permlane32_swap(__float_as_uint(ps), __float_as_uint(ps), false, false);
    ps = __uint_as_float(rr[0]) + __uint_as_float(rr[1]); }
  l_reg = l_reg * alpha + ps;
#define PK4(P, BASE, OUT) do { unsigned a0 = cvtpk(P[BASE + 0], P[BASE + 1]), a1 = cvtpk(P[BASE + 2], P[BASE + 3]);   \
    unsigned b0 = cvtpk(P[BASE + 4], P[BASE + 5]), b1 = cvtpk(P[BASE + 6], P[BASE + 7]);                              \
    auto r0 = __builtin_amdgcn_permlane32_swap(a0, b0, false, false); auto r1 = __builtin_amdgcn_permlane32_swap(a1, b1, false, false); \
    u32x4 w = {r0[0], r1[0], r0[1], r1[1]}; OUT = *reinterpret_cast<bf16x8*>(&w); } while (0)
  PK4(p0, 0, pa0); PK4(p0, 8, pa1); PK4(p1, 0, pa2); PK4(p1, 8, pa3);
#undef PK4
}
__device__ __forceinline__ void qkt(f32x16& p0, f32x16& p1, const char* Ks, const char* Rs, const bf16x8* qr, const char* qrl, int r32, int hi) {
  p0 = f32x16{}; p1 = f32x16{};
#pragma unroll
  for (int d0 = 0; d0 < 8; ++d0) { const int cb = (d0 * 16 + hi * 8) * 2;
    const bf16x8 b0 = *reinterpret_cast<const bf16x8*>(Ks + KSWZ(r32, cb));
    const bf16x8 b1 = *reinterpret_cast<const bf16x8*>(Ks + KSWZ(32 + r32, cb));
    p0 = __builtin_amdgcn_mfma_f32_32x32x16_bf16(b0, qr[d0], p0, 0, 0, 0);
    p1 = __builtin_amdgcn_mfma_f32_32x32x16_bf16(b1, qr[d0], p1, 0, 0, 0); }
#pragma unroll
  for (int d0 = 0; d0 < 4; ++d0) { const int cb = (d0 * 16 + hi * 8) * 2;
    const bf16x8 b0 = *reinterpret_cast<const bf16x8*>(Rs + RSWZ(r32, cb));
    const bf16x8 b1 = *reinterpret_cast<const bf16x8*>(Rs + RSWZ(32 + r32, cb));
    const bf16x8 qv = *reinterpret_cast<const bf16x8*>(qrl + d0 * 1024);
    p0 = __builtin_amdgcn_mfma_f32_32x32x16_bf16(b0, qv, p0, 0, 0, 0);
    p1 = __builtin_amdgcn_mfma_f32_32x32x16_bf16(b1, qv, p1, 0, 0, 0); }
}
__device__ __forceinline__ int v_st(int k, int c) { const int kk = (k & ~0xC) | ((k & 4) << 1) | ((k & 8) >> 1); return ((kk >> 3) * 4 + (c >> 5)) * 512 + ((kk & 7) * 32 + (c & 31)) * 2; }
__device__ __forceinline__ int v_rd_base(int lane) { return ((lane & 3) << 3) | (((lane >> 2) & 3) << 6) | (((lane >> 4) & 1) << 5) | (((lane >> 5) & 1) << 8); }
constexpr int v_rd_off(int d0, int ks, int half) { return d0 * 512 + ks * 4096 + half * 2048; }
template <int OFF> __device__ __forceinline__ s16x4 tr_read(int vb) {
  s16x4 r; asm volatile("ds_read_b64_tr_b16 %0, %1 offset:%2" : "=&v"(r) : "v"(vb), "i"(OFF) : "memory"); return r;
}
template <int D0> __device__ __forceinline__ void pv_one(f32x16& od, int vb, bf16x8 pa0, bf16x8 pa1, bf16x8 pa2, bf16x8 pa3) {
  const s16x4 l0 = tr_read<v_rd_off(D0, 0, 0)>(vb), h0 = tr_read<v_rd_off(D0, 0, 1)>(vb), l1 = tr_read<v_rd_off(D0, 1, 0)>(vb), h1 = tr_read<v_rd_off(D0, 1, 1)>(vb);
  const s16x4 l2 = tr_read<v_rd_off(D0, 2, 0)>(vb), h2 = tr_read<v_rd_off(D0, 2, 1)>(vb), l3 = tr_read<v_rd_off(D0, 3, 0)>(vb), h3 = tr_read<v_rd_off(D0, 3, 1)>(vb);
  asm volatile("s_waitcnt lgkmcnt(0)" ::: "memory"); SBAR();
#define PK(L, H) (bf16x8){L[0], L[1], L[2], L[3], H[0], H[1], H[2], H[3]}
  od = __builtin_amdgcn_mfma_f32_32x32x16_bf16(pa0, PK(l0, h0), od, 0, 0, 0);
  od = __builtin_amdgcn_mfma_f32_32x32x16_bf16(pa1, PK(l1, h1), od, 0, 0, 0);
  od = __builtin_amdgcn_mfma_f32_32x32x16_bf16(pa2, PK(l2, h2), od, 0, 0, 0);
  od = __builtin_amdgcn_mfma_f32_32x32x16_bf16(pa3, PK(l3, h3), od, 0, 0, 0);
#undef PK
}
__device__ __forceinline__ void pv_d0(f32x16* o, int vb, bf16x8 pa0, bf16x8 pa1, bf16x8 pa2, bf16x8 pa3) {
  pv_one<0>(o[0], vb, pa0, pa1, pa2, pa3); pv_one<1>(o[1], vb, pa0, pa1, pa2, pa3); pv_one<2>(o[2], vb, pa0, pa1, pa2, pa3); pv_one<3>(o[3], vb, pa0, pa1, pa2, pa3);
}
__device__ __forceinline__ void attn_body(const bf16_t* __restrict__ Qb, const float* __restrict__ cs, const float* __restrict__ sn, const bf16_t* __restrict__ Kn,
                                          const bf16_t* __restrict__ Vh, const bf16_t* __restrict__ Kr, bf16_t* __restrict__ Ob, int seq, char* lds) {
  const int tid = otid(), wid = tid >> 6, lane = tid & 63, r32 = lane & 31, hi = lane >> 5;
  char* V_lds = lds; char* K_lds = lds + 2 * SHM_V; char* R_lds = lds + 2 * SHM_V + 2 * SHM_K;
  float* wsf = (float*)(lds + 2 * SHM_V + 2 * SHM_K + 2 * SHM_R) + wid * 64; float* li_l = wsf; float* al_l = wsf + 32;
  char* qrl = lds + 2 * SHM_V + 2 * SHM_K + 2 * SHM_R + 2048 + wid * 4096 + lane * 16;
  float m_reg = -1e30f, l_reg = 0; f32x16 o[4] = {}; bf16x8 qr[8];
  { const bf16_t* Qw = Qb + (size_t)(wid * QBLK + r32) * LDQ + hi * 8;
#pragma unroll
    for (int d0 = 0; d0 < 8; ++d0) qr[d0] = *(const bf16x8*)(Qw + d0 * 16);
#pragma unroll
    for (int d0 = 0; d0 < 2; ++d0) {
      const u32x4 a = *(const u32x4*)(Qw + 128 + d0 * 16), bq = *(const u32x4*)(Qw + 160 + d0 * 16);
      if (cs) {
        const float* cp = cs + (size_t)(wid * QBLK + r32) * 32 + d0 * 16 + hi * 8; const float* sp = sn + (size_t)(wid * QBLK + r32) * 32 + d0 * 16 + hi * 8;
        const f32x4 c0 = *(const f32x4*)cp, c1 = *(const f32x4*)(cp + 4), s0 = *(const f32x4*)sp, s1 = *(const f32x4*)(sp + 4);
        float x1[8], x2[8], y1[8], y2[8];
#pragma unroll
        for (int k = 0; k < 4; ++k) { x1[2 * k] = bflo(a[k]); x1[2 * k + 1] = bfhi(a[k]); x2[2 * k] = bflo(bq[k]); x2[2 * k + 1] = bfhi(bq[k]); }
#pragma unroll
        for (int k = 0; k < 8; ++k) { const float c = k < 4 ? c0[k & 3] : c1[k & 3], s = k < 4 ? s0[k & 3] : s1[k & 3]; y1[k] = x1[k] * c - x2[k] * s; y2[k] = x2[k] * c + x1[k] * s; }
        u32x4 w1 = {cvtpk(y1[0], y1[1]), cvtpk(y1[2], y1[3]), cvtpk(y1[4], y1[5]), cvtpk(y1[6], y1[7])}, w2 = {cvtpk(y2[0], y2[1]), cvtpk(y2[2], y2[3]), cvtpk(y2[4], y2[5]), cvtpk(y2[6], y2[7])};
        *(u32x4*)(qrl + d0 * 1024) = w1; *(u32x4*)(qrl + (2 + d0) * 1024) = w2;
      } else { *(u32x4*)(qrl + d0 * 1024) = a; *(u32x4*)(qrl + (2 + d0) * 1024) = bq; }
    } }
  const int sr = tid >> 4, sc = (tid & 15) * 8, vst0 = v_st(sr, sc), vst1 = v_st(32 + sr, sc);
  const int rr_ = tid >> 3, rc = (tid & 7) * 8;
  const int vb0 = (int)(uintptr_t)V_lds + v_rd_base(lane);
  bf16x8 vs0, vs1, ks0, ks1, rs0;
  const unsigned voffKV = (unsigned)(sr * LDK + sc) * 2u, voffR = (unsigned)(rr_ * LDKR + rc) * 2u;
#define SLOAD(k0) do { const char* kb_ = (const char*)Kn + (size_t)(k0) * (LDK * 2); const char* vb_ = (const char*)Vh + (size_t)(k0) * (LDK * 2); \
    vs0 = *(const bf16x8*)(vb_ + voffKV); vs1 = *(const bf16x8*)(vb_ + 32 * LDK * 2 + voffKV); \
    ks0 = *(const bf16x8*)(kb_ + voffKV); ks1 = *(const bf16x8*)(kb_ + 32 * LDK * 2 + voffKV); \
    rs0 = *(const bf16x8*)((const char*)Kr + (size_t)(k0) * (LDKR * 2) + voffR); } while (0)
#define SWRITE(b) do { *(bf16x8*)(V_lds + (b) * SHM_V + vst0) = vs0; *(bf16x8*)(V_lds + (b) * SHM_V + vst1) = vs1; const int kc = sc * 2;  \
    *(bf16x8*)(K_lds + (b) * SHM_K + KSWZ(sr, kc)) = ks0; *(bf16x8*)(K_lds + (b) * SHM_K + KSWZ(32 + sr, kc)) = ks1;                      \
    *(bf16x8*)(R_lds + (b) * SHM_R + RSWZ(rr_, rc * 2)) = rs0; } while (0)
#define RESC(a) do { if (__any((a) < 1.f)) { if (hi == 0) al_l[r32] = (a); asm volatile("s_waitcnt lgkmcnt(0)" ::: "memory"); \
    _Pragma("unroll") for (int d = 0; d < 4; ++d) _Pragma("unroll") for (int r = 0; r < 16; ++r) o[d][r] *= al_l[crow(r, hi)]; } } while (0)
  f32x16 pA0, pA1, pB0, pB1; float mnA, mnB, alA, alB; bf16x8 pa0, pa1, pa2, pa3; const int NT = seq / KVBLK;
  SLOAD(0); SWRITE(0); __syncthreads();
  qkt(pA0, pA1, K_lds, R_lds, qr, qrl, r32, hi); partialSM(pA0, pA1, m_reg, mnA, alA);
  SLOAD(KVBLK); SWRITE(1); __syncthreads();
  for (int j = 1; j + 1 < NT; j += 2) {
    SBAR(); qkt(pB0, pB1, K_lds + SHM_K, R_lds + SHM_R, qr, qrl, r32, hi);
    finishSM(pA0, pA1, alA, l_reg, pa0, pa1, pa2, pa3); SBAR();
    SLOAD((j + 1) * KVBLK); SBAR();
    pv_d0(o, vb0, pa0, pa1, pa2, pa3); partialSM(pB0, pB1, m_reg, mnB, alB);
    __syncthreads(); SWRITE(0);
    RESC(alB); __syncthreads();
    SBAR(); qkt(pA0, pA1, K_lds, R_lds, qr, qrl, r32, hi);
    finishSM(pB0, pB1, alB, l_reg, pa0, pa1, pa2, pa3); SBAR();
    SLOAD((j + 2) * KVBLK); SBAR();
    pv_d0(o, vb0 + (int)SHM_V, pa0, pa1, pa2, pa3); partialSM(pA0, pA1, m_reg, mnA, alA);
    __syncthreads(); SWRITE(1);
    RESC(alA); __syncthreads();
  }
  SBAR(); qkt(pB0, pB1, K_lds + SHM_K, R_lds + SHM_R, qr, qrl, r32, hi);
  finishSM(pA0, pA1, alA, l_reg, pa0, pa1, pa2, pa3); SBAR();
  pv_d0(o, vb0, pa0, pa1, pa2, pa3); partialSM(pB0, pB1, m_reg, mnB, alB);
  __syncthreads(); RESC(alB);
  finishSM(pB0, pB1, alB, l_reg, pa0, pa1, pa2, pa3); SBAR();
  pv_d0(o, vb0 + (int)SHM_V, pa0, pa1, pa2, pa3);
  if (hi == 0) li_l[r32] = l_reg; asm volatile("s_waitcnt lgkmcnt(0)" ::: "memory");
  float rli[16];
#pragma unroll
  for (int r = 0; r < 16; ++r) rli[r] = __builtin_amdgcn_rcpf(li_l[crow(r, hi)]);
  bf16_t* Ow = Ob + (size_t)(wid * QBLK) * LDO;
#pragma unroll
  for (int r = 0; r < 16; ++r) { const int orow = crow(r, hi);
#pragma unroll
    for (int d0 = 0; d0 < 4; ++d0) Ow[(size_t)orow * LDO + d0 * 32 + r32] = f2bf(o[d0][r] * rli[r]); }
  __syncthreads();
#undef SLOAD
#undef SWRITE
#undef RESC
}
}

__device__ void phase_attn(PRef p, int l, char* smem) {
  const bf16_t* Q = (const bf16_t*)(p.ws + WS_Q); const bf16_t* KV = (const bf16_t*)(p.ws + WS_KV); const bf16_t* KR = (const bf16_t*)(p.ws + WS_KR);
  bf16_t* mix = (bf16_t*)(p.ws + WS_MIX); const float* cs = (const float*)(p.ws + WS_COS); const float* sn = (const float*)(p.ws + WS_SIN);
  const int nunits = 1024 + (l == 0 ? 32 : 0);
  for (int u = obid(); u < nunits; u += gridDim.x) {
    if (u < 1024) {
      const int qb = u & 31, hd = (u >> 5) & 3, b = u >> 7; const size_t row0 = (size_t)b * SEQ + qb * 256;
      att::attn_body(Q + row0 * 768 + hd * 192, cs + (size_t)qb * 256 * 32, sn + (size_t)qb * 256 * 32, KV + (size_t)b * SKV * 1024 + hd * 256,
                     KV + (size_t)b * SKV * 1024 + hd * 256 + 128, KR + (size_t)b * SKV * 64, mix + row0 * 1024 + 512 + hd * 128, SKV, smem);
    } else {
      const int v = u - 1024, hd = v & 3, b = v >> 2; const size_t row0 = (size_t)MX + b * CTXL;
      att::attn_body(Q + row0 * 768 + hd * 192, nullptr, nullptr, KV + (size_t)b * SKV * 1024 + hd * 256,
                     KV + (size_t)b * SKV * 1024 + hd * 256 + 128, KR + (size_t)b * SKV * 64, mix + row0 * 1024 + 512 + hd * 128, CTXL, smem);
    }
  }
}

__device__ void phase_outproj(PRef p, int l, char* smem) {
  LAS unsigned char* lds = (LAS unsigned char*)smem;
  const bf16_t* mix = (const bf16_t*)(p.ws + WS_MIX); const bf16_t* Wt = (const bf16_t*)(p.ws + WS_WOUT) + (size_t)l * 1024 * 1024;
  float* ctxz = (float*)(p.ws + WS_CTXZ);
  const int tid = otid(), wid = tid >> 6, lane = tid & 63, wr = wid >> 2, wc = wid & 3, fr = lane & 15, fq = lane >> 4;
  g8::TileIter it; it.init(l == 0 ? MT / 256 : MX / 256, 4);
  int pm, pn;
  while (it.next(pm, pn)) {
    unsigned voffA[2] = {g8::piece_off(0, 1024, 0), g8::piece_off(1, 1024, 0)};
    f32x4 acc[2][2][4][2];
    g8::gemm_tile<false>(lds, (const char*)(mix + (size_t)pm * 256 * 1024), voffA, (size_t)128 * 1024 * 2, (const char*)(Wt + (size_t)pn * 256 * 1024), 1024, acc);
    ACC_FOR(ai, bj, m, n) {
      const int row = pm * 256 + ai * 128 + wr * 64 + m * 16 + fr, col = pn * 256 + bj * 128 + wc * 32 + n * 16 + fq * 4;
      const float* res = l == 0 ? (row < MX ? p.x + (size_t)row * 1024 : p.ctx + (size_t)(row - MX) * 1024) : p.out + (size_t)row * 1024;
      float* dst = row < MX ? p.out + (size_t)row * 1024 : ctxz + (size_t)(row - MX) * 1024;
      const f32x4 r = *(const f32x4*)(res + col), g = *(const f32x4*)(mod_ptr(p, l, row, 2) + col);
      *(f32x4*)(dst + col) = r * ALPHA + g * acc[ai][bj][m][n];
    }
  }
}

__device__ void phase_ln1(PRef p, int l, char* smem) {
  float* wrt = (float*)smem;
  for (int i = otid(); i < 16384; i += 512) wrt[(i & 15) * 1024 + (i >> 4)] = p.w_router[(size_t)l * 16384 + i];
  __syncthreads();
  const int lane = otid() & 63, gw = obid() * 8 + (otid() >> 6), nw = gridDim.x * 8;
  bf16_t* h = (bf16_t*)(p.ws + WS_H); float* ctxz = (float*)(p.ws + WS_CTXZ); float* aff = (float*)(p.ws + WS_AFF);
  const int nrows = l == 0 ? MT : MX;
  for (int row = gw; row < nrows; row += nw) {
    asm volatile("" ::: "memory");
    float* zr = row < MX ? p.out + (size_t)row * 1024 : ctxz + (size_t)(row - MX) * 1024;
    f32x4 v[4];
#pragma unroll
    for (int i = 0; i < 4; ++i) v[i] = *(const f32x4*)(zr + lane * 4 + 256 * i);
    ln_row(v, 1e-5f);
#pragma unroll
    for (int i = 0; i < 4; ++i) { const int c = lane * 4 + 256 * i; v[i] = v[i] * *(const f32x4*)(p.ln1_g + l * 1024 + c) + *(const f32x4*)(p.ln1_b + l * 1024 + c); *(f32x4*)(zr + c) = v[i]; }
    ln_row(v, 1e-6f);
    f32x4 hm[4];
    store_mod_bf16(v, mod_ptr(p, l, row, 3), mod_ptr(p, l, row, 4), h + (size_t)row * 1024, lane, &hm);
    float lg[16];
#pragma unroll
    for (int e = 0; e < 16; ++e) { float s = 0.f;
#pragma unroll
      for (int i = 0; i < 4; ++i) { const f32x4 w = *(const f32x4*)(wrt + e * 1024 + lane * 4 + 256 * i); s += hm[i][0] * w[0] + hm[i][1] * w[1] + hm[i][2] * w[2] + hm[i][3] * w[3]; }
      lg[e] = wave_sum(s); }
    float mx = lg[0];
#pragma unroll
    for (int e = 1; e < 16; ++e) mx = fmaxf(mx, lg[e]);
    float den = 0.f;
#pragma unroll
    for (int e = 0; e < 16; ++e) { lg[e] = expf(lg[e] - mx); den += lg[e]; }
    float mine = 0.f;
#pragma unroll
    for (int e = 0; e < 16; ++e) if (lane == e) mine = lg[e] / den;
    if (lane < 16) aff[(size_t)row * 16 + lane] = mine;
  }
}

template <int PER>
__device__ __forceinline__ void topk_item(const float* __restrict__ affp, int n, int kcap, int rowbase, int slotbase, int e, int* __restrict__ IDX, float* __restrict__ GV, int* __restrict__ TS, char* smem) {
  unsigned* hist = (unsigned*)smem; unsigned* sel = hist + 256; unsigned* wtot = hist + 272;
  const int tid = otid(), lane = tid & 63, wid = tid >> 6;
  const bool active = tid * PER < n;
  unsigned key[PER];
#pragma unroll
  for (int i = 0; i < PER; ++i) key[i] = active ? __float_as_uint(affp[(size_t)(tid * PER + i) * 16]) : 0u;
  unsigned prefix = 0u, mask = 0u; int kk = kcap;
#pragma unroll 1
  for (int shift = 24; shift >= 0; shift -= 8) {
    __syncthreads();
    if (tid < 256) hist[tid] = 0u;
    __syncthreads();
#pragma unroll
    for (int i = 0; i < PER; ++i) if (active && (key[i] & mask) == prefix) atomicAdd(&hist[(key[i] >> shift) & 255u], 1u);
    __syncthreads();
    if (wid == 0) {
      const unsigned h0 = hist[lane * 4], h1 = hist[lane * 4 + 1], h2 = hist[lane * 4 + 2], h3 = hist[lane * 4 + 3];
      const unsigned tot = h0 + h1 + h2 + h3; unsigned suf = tot;
#pragma unroll
      for (int o = 1; o < 64; o <<= 1) { const unsigned u = __shfl_down(suf, o); if (lane + o < 64) suf += u; }
      const unsigned above = suf - tot;
      if (above < (unsigned)kk && suf >= (unsigned)kk) {
        unsigned a = above; int bin;
        if (a + h3 >= (unsigned)kk) bin = 3; else { a += h3; if (a + h2 >= (unsigned)kk) bin = 2; else { a += h2; if (a + h1 >= (unsigned)kk) bin = 1; else { a += h1; bin = 0; } } }
        sel[0] = prefix | ((unsigned)(lane * 4 + bin) << shift); sel[1] = (unsigned)kk - a;
      }
    }
    __syncthreads();
    prefix = sel[0]; kk = (int)sel[1]; mask |= 0xffu << shift;
  }
  const unsigned Tk = prefix;
  unsigned cg_ = 0, ce = 0;
#pragma unroll
  for (int i = 0; i < PER; ++i) { cg_ += key[i] > Tk; ce += key[i] == Tk; }
  unsigned pk = active ? (cg_ | (ce << 16)) : 0u, inc = pk;
#pragma unroll
  for (int o = 1; o < 64; o <<= 1) { const unsigned u = __shfl_up(inc, o); if (lane >= o) inc += u; }
  __syncthreads();
  if (lane == 63) wtot[wid] = inc;
  __syncthreads();
  unsigned base = 0;
  for (int w2 = 0; w2 < wid; ++w2) base += wtot[w2];
  const unsigned exc = base + inc - pk; unsigned gt_before = exc & 0xffffu, eq_before = exc >> 16;
  if (active) {
#pragma unroll
    for (int i = 0; i < PER; ++i) {
      const int t = tid * PER + i; int R = -1;
      const bool isgt = key[i] > Tk, iseq = key[i] == Tk;
      if (isgt || (iseq && (int)eq_before < kk)) {
        const int slot = (int)gt_before + min((int)eq_before, kk);
        R = slotbase + slot; IDX[R] = rowbase + t; GV[R] = __uint_as_float(key[i]);
      }
      TS[t] = R;
      gt_before += isgt; eq_before += iseq;
    }
  }
}
__device__ void phase_topk(PRef p, int l, char* smem) {
  const float* aff = (const float*)(p.ws + WS_AFF); int* IDX = (int*)(p.ws + WS_IDX); float* GV = (float*)(p.ws + WS_GV); int* TS = (int*)(p.ws + WS_TS);
  const int nitems = l == 0 ? 256 : 128;
  for (int it = obid(); it < nitems; it += gridDim.x) {
    if (it < 128) { const int b = it >> 4, e = it & 15; topk_item<16>(aff + (size_t)b * SEQ * 16 + e, SEQ, CAPX, b * SEQ, it * CAPX, e, IDX, GV, TS + (size_t)it * SEQ, smem); }
    else { const int v = it - 128, b = v >> 4, e = v & 15; topk_item<1>(aff + ((size_t)MX + b * CTXL) * 16 + e, CTXL, CAPC, MX + b * CTXL, NB * NE * CAPX + e * 256 + b * CAPC, e, IDX, GV, TS + (size_t)NB * 16 * SEQ + (size_t)v * CTXL, smem); }
  }
  __syncthreads();
}

__device__ void phase_moe_up(PRef p, int l, char* smem) {
  LAS unsigned char* lds = (LAS unsigned char*)smem;
  const bf16_t* h = (const bf16_t*)(p.ws + WS_H); const bf16_t* Wgu = (const bf16_t*)(p.ws + WS_WGU); bf16_t* act = (bf16_t*)(p.ws + WS_ACT); const int* IDX = (const int*)(p.ws + WS_IDX);
  const int tid = otid(), wid = tid >> 6, lane = tid & 63, wr = wid >> 2, wc = wid & 3, fr = lane & 15, fq = lane >> 4;
  g8::MoeIter it; it.init(8, l == 0);
  int pm, pn, e;
  while (it.next(pm, pn, e)) {
    unsigned voffA[4];
#pragma unroll
    for (int hh = 0; hh < 2; ++hh)
#pragma unroll
      for (int i = 0; i < 2; ++i) { int R, C; g8::piece_rc(i, R, C); voffA[hh * 2 + i] = (unsigned)(IDX[pm * 256 + hh * 128 + R] * 1024 + C) * 2u; }
    f32x4 acc[2][2][4][2];
    g8::gemm_tile<true>(lds, (const char*)h, voffA, 0, (const char*)(Wgu + ((size_t)e * 2048 + pn * 256) * 1024), 1024, acc);
#pragma unroll
    for (int ai = 0; ai < 2; ++ai)
#pragma unroll
      for (int m = 0; m < 4; ++m)
#pragma unroll
        for (int n = 0; n < 2; ++n) {
          const int row = pm * 256 + ai * 128 + wr * 64 + m * 16 + fr, col = pn * 128 + wc * 32 + n * 16 + fq * 4;
          const f32x4 g = acc[ai][0][m][n], u = acc[ai][1][m][n]; float a[4];
#pragma unroll
          for (int k = 0; k < 4; ++k) a[k] = silu_f(g[k]) * u[k];
          u32x2 w = {cvtpk(a[0], a[1]), cvtpk(a[2], a[3])}; *(u32x2*)(act + (size_t)row * 1024 + col) = w;
        }
  }
}
__device__ void phase_moe_down(PRef p, int l, char* smem) {
  LAS unsigned char* lds = (LAS unsigned char*)smem;
  const bf16_t* act = (const bf16_t*)(p.ws + WS_ACT); const bf16_t* Wdn = (const bf16_t*)(p.ws + WS_WDN); bf16_t* oute = (bf16_t*)(p.ws + WS_OUTE); const float* GV = (const float*)(p.ws + WS_GV);
  const int tid = otid(), wid = tid >> 6, lane = tid & 63, wr = wid >> 2, wc = wid & 3, fr = lane & 15, fq = lane >> 4;
  g8::MoeIter it; it.init(4, l == 0);
  int pm, pn, e;
  while (it.next(pm, pn, e)) {
    unsigned voffA[2] = {g8::piece_off(0, 1024, 0), g8::piece_off(1, 1024, 0)};
    f32x4 acc[2][2][4][2];
    g8::gemm_tile<false>(lds, (const char*)(act + (size_t)pm * 256 * 1024), voffA, (size_t)128 * 1024 * 2, (const char*)(Wdn + ((size_t)e * 1024 + pn * 256) * 1024), 1024, acc);
    ACC_FOR(ai, bj, m, n) {
      const int row = pm * 256 + ai * 128 + wr * 64 + m * 16 + fr, col = pn * 256 + bj * 128 + wc * 32 + n * 16 + fq * 4;
      const f32x4 v = acc[ai][bj][m][n] * GV[row];
      u32x2 w = {cvtpk(v[0], v[1]), cvtpk(v[2], v[3])}; *(u32x2*)(oute + (size_t)row * 1024 + col) = w;
    }
  }
}

__device__ void phase_ln2(PRef p, int l) {
  const int lane = otid() & 63, gw = obid() * 8 + (otid() >> 6), nw = gridDim.x * 8;
  bf16_t* h = (bf16_t*)(p.ws + WS_H); float* ctxz = (float*)(p.ws + WS_CTXZ); const bf16_t* oute = (const bf16_t*)(p.ws + WS_OUTE); const int* TS = (const int*)(p.ws + WS_TS);
  const int nrows = l == 0 ? MT : MX;
  for (int row = gw; row < nrows; row += nw) {
    float* xr = row < MX ? p.out + (size_t)row * 1024 : ctxz + (size_t)(row - MX) * 1024;
    f32x4 mo[4];
#pragma unroll
    for (int i = 0; i < 4; ++i) mo[i] = (f32x4){0.f, 0.f, 0.f, 0.f};
    const int myR = lane < 16 ? (row < MX ? TS[((size_t)(row >> 13) * 16 + lane) * SEQ + (row & 8191)] : TS[(size_t)NB * 16 * SEQ + ((size_t)((row - MX) >> 8) * 16 + lane) * CTXL + ((row - MX) & 255)]) : -1;
    for (int e = 0; e < 16; ++e) { const int Rr = __shfl(myR, e);
      if (Rr >= 0) {
#pragma unroll
        for (int i = 0; i < 4; ++i) { const u32x2 w = *(const u32x2*)(oute + (size_t)Rr * 1024 + lane * 4 + 256 * i);
          mo[i][0] += bflo(w[0]); mo[i][1] += bfhi(w[0]); mo[i][2] += bflo(w[1]); mo[i][3] += bfhi(w[1]); } } }
    f32x4 v[4]; const float* m5 = mod_ptr(p, l, row, 5);
#pragma unroll
    for (int i = 0; i < 4; ++i) { const int c = lane * 4 + 256 * i; v[i] = *(const f32x4*)(xr + c) * ALPHA + *(const f32x4*)(m5 + c) * mo[i]; }
    ln_row(v, 1e-5f);
#pragma unroll
    for (int i = 0; i < 4; ++i) { const int c = lane * 4 + 256 * i; v[i] = v[i] * *(const f32x4*)(p.ln2_g + l * 1024 + c) + *(const f32x4*)(p.ln2_b + l * 1024 + c); *(f32x4*)(xr + c) = v[i]; }
    if (l + 1 < DEPTH) { ln_row(v, 1e-6f); store_mod_bf16(v, mod_ptr(p, l + 1, row, 0), mod_ptr(p, l + 1, row, 1), h + (size_t)row * 1024, lane, nullptr); }
  }
}

#if DBG_BAR
__device__ int g_phase_dummy;
#endif
__device__ __forceinline__ void gsync(cg::grid_group& grid, PRef p, int& phase) {
#if DBG_BAR
  int* flags = (int*)(p.ws + WS_END); int* err = flags + 1024;
  ++phase;
  if (otid() == 0) flags[obid()] = phase;
#endif
  asm volatile("s_waitcnt vmcnt(0) lgkmcnt(0)" ::: "memory");
  grid.sync();
#if DBG_BAR
  if (otid() < (int)gridDim.x) { if (flags[otid()] != phase) atomicAdd(err, 1); }
#endif
}
__device__ void dbg_dump_bf16(PRef p, size_t off) {
  const bf16_t* src = (const bf16_t*)(p.ws + off);
  for (size_t i = (size_t)obid() * 512 + otid(); i < (size_t)MX * 1024; i += (size_t)gridDim.x * 512) p.out[i] = bf2f(src[i]);
}
__global__ void __launch_bounds__(512) mega(Params p) {
  extern __shared__ __attribute__((aligned(16))) char smem[];
  cg::grid_group grid = cg::this_grid();
  int phase = 0;
#if DBG_BAR
  if (obid() == 0 && otid() == 0) ((int*)(kparams().ws + WS_END))[1024] = 0;
#endif
  phase_prep(kparams(), smem);
  gsync(grid, kparams(), phase);
  phase_h0(kparams());
  gsync(grid, kparams(), phase);
#pragma unroll 1
  for (int l = 0; l < DEPTH; ++l) {
#if DBG_STOP == 0
    dbg_dump_bf16(kparams(), WS_H); return;
#endif
#pragma unroll 1
    for (int rep = 0; rep < DBG_REP_INPROJ; ++rep) { phase_inproj(kparams(), l, smem); gsync(grid, kparams(), phase); }
#if DBG_STOP == 1
    dbg_dump_bf16(kparams(), WS_P); return;
#endif
#if DBG_STOP == 12
    dbg_dump_bf16(kparams(), WS_P + (size_t)23000 * PLD * 2); return;
#endif
#if DBG_STOP == 11
    { PRef q = kparams(); const float* gsrc = (const float*)(q.ws + WS_GATES); const bf16_t* ps = (const bf16_t*)(q.ws + WS_P);
      for (size_t i = (size_t)obid() * 512 + otid(); i < (size_t)MX * 1024; i += (size_t)gridDim.x * 512)
        q.out[i] = i < (size_t)MT * 16 ? gsrc[i] : bf2f(ps[(size_t)MT * PLD - 1 - (i - (size_t)MT * 16)]); }
    return;
#endif
#if DBG_STOP == 24
#pragma unroll 1
    for (int rep = 0; rep < 2; ++rep) { phase_mlstm(kparams(), l, smem, opaque_s(rep) ? WS_Q : WS_HB); gsync(grid, kparams(), phase); }
    { PRef q = kparams(); const bf16_t* a = (const bf16_t*)(q.ws + WS_HB); const bf16_t* b2 = (const bf16_t*)(q.ws + WS_Q);
      for (size_t i = (size_t)obid() * 512 + otid(); i < (size_t)MX * 1024; i += (size_t)gridDim.x * 512) q.out[i] = bf2f(a[i]) - bf2f(b2[i]); }
    return;
#else
#pragma unroll 1
    for (int rep = 0; rep < DBG_REP_MLSTM; ++rep) { phase_mlstm(kparams(), l, smem); gsync(grid, kparams(), phase); }
#endif
#if DBG_STOP == 2
    dbg_dump_bf16(kparams(), WS_HB); return;
#endif
#if DBG_STOP == 23
    return;
#endif
#if DBG_STOP == 22
    { PRef q = kparams(); const int nerr = ((const int*)(q.ws + WS_END))[1024];
      for (size_t i = (size_t)obid() * 512 + otid(); i < (size_t)MX * 1024; i += (size_t)gridDim.x * 512) q.out[i] = i < 1024 ? 1000.f * (float)nerr : 0.f; }
    return;
#endif
    phase_mla_prep(kparams(), l, smem);
    gsync(grid, kparams(), phase);
#pragma unroll 1
    for (int rep = 0; rep < DBG_REP_ATTN; ++rep) { phase_attn(kparams(), l, smem); gsync(grid, kparams(), phase); }
#if DBG_STOP == 4
    dbg_dump_bf16(kparams(), WS_MIX); return;
#endif
    phase_outproj(kparams(), l, smem);
    gsync(grid, kparams(), phase);
    phase_ln1(kparams(), l, smem);
    __syncthreads();
#pragma unroll 1
    for (int rep = 0; rep < DBG_REP_CVT; ++rep) phase_cvt_experts(kparams(), l, smem);
    gsync(grid, kparams(), phase);
#if DBG_STOP == 6
    if (l == 0) return;
#endif
    phase_topk(kparams(), l, smem);
    gsync(grid, kparams(), phase);
#pragma unroll 1
    for (int rep = 0; rep < DBG_REP_MOE; ++rep) {
    phase_moe_up(kparams(), l, smem);
    gsync(grid, kparams(), phase);
    phase_moe_down(kparams(), l, smem);
    gsync(grid, kparams(), phase);
    }
    phase_ln2(kparams(), l);
    gsync(grid, kparams(), phase);
#if DBG_STOP == 10
    if (l == 0) return;
#endif
  }
}

extern "C" void kernel_launch(void* const* d_in, const int* in_sizes, int n_in, void* d_out, int out_size,
                              void* d_ws, size_t ws_size, hipStream_t stream) {
  constexpr size_t kDynLds = 160 * 1024;
  static int grid_blocks = 0;
  if (!grid_blocks) {
    int dev = 0, cus = 0, per_cu = 0;
    (void)hipGetDevice(&dev);
    (void)hipDeviceGetAttribute(&cus, hipDeviceAttributeMultiprocessorCount, dev);
    (void)hipFuncSetAttribute((const void*)mega, hipFuncAttributeMaxDynamicSharedMemorySize, (int)kDynLds);
    (void)hipOccupancyMaxActiveBlocksPerMultiprocessor(&per_cu, mega, 512, kDynLds);
    grid_blocks = per_cu > 0 ? cus : 0;
    if (grid_blocks > 256) grid_blocks = 256;
    grid_blocks &= ~7;
    if (grid_blocks != 256) { fprintf(stderr, "this kernel needs 256 co-resident workgroups (got %d)\n", grid_blocks); grid_blocks = 0; }
    if (ws_size < WS_END) { fprintf(stderr, "workspace too small: %zu < %zu\n", ws_size, (size_t)WS_END); grid_blocks = 0; }
  }
  if (grid_blocks <= 0) return;
  Params p{};
  const float** pp = (const float**)&p;
  for (int i = 0; i < 24; ++i) pp[i] = (const float*)d_in[i];
  p.out = (float*)d_out; p.ws = (char*)d_ws;
  void* args[] = {&p};
  hipError_t e = hipLaunchCooperativeKernel((void*)mega, dim3(grid_blocks), dim3(512), args, kDynLds, stream);
  if (e != hipSuccess) fprintf(stderr, "cooperative launch failed: %s (grid %d)\n", hipGetErrorString(e), grid_blocks);
}
```

```cpp
#include <hip/hip_runtime.h>
#include <hip/hip_cooperative_groups.h>
#include <cstdio>
#include <cstdint>
namespace cg = cooperative_groups;
#ifndef DBG_BAR
#define DBG_BAR 0
#endif
#ifndef DBG_REP_MLSTM
#define DBG_REP_MLSTM 1
#endif
#ifndef DBG_REP_ATTN
#define DBG_REP_ATTN 1
#endif
#ifndef DBG_REP_MOE
#define DBG_REP_MOE 1
#endif
#ifndef DBG_REP_INPROJ
#define DBG_REP_INPROJ 1
#endif
#ifndef DBG_REP_CVT
#define DBG_REP_CVT 1
#endif
#ifndef DBG_STOP
#define DBG_STOP 99
#endif

typedef unsigned short bf16_t;
typedef short bf16x8 __attribute__((ext_vector_type(8)));
typedef short s16x4 __attribute__((ext_vector_type(4)));
typedef float f32x4 __attribute__((ext_vector_type(4)));
typedef float f32x16 __attribute__((ext_vector_type(16)));
typedef unsigned u32x4 __attribute__((ext_vector_type(4)));
typedef unsigned u32x2 __attribute__((ext_vector_type(2)));
#define LAS __attribute__((address_space(3)))

constexpr int DM = 1024, NB = 8, SEQ = 8192, CTXL = 256, DEPTH = 2;
constexpr int MX = NB * SEQ, MC = NB * CTXL, MT = MX + MC;
constexpr int PLD = 2816;
constexpr int OFF_Q = 0, OFF_K = 512, OFF_V = 1024, OFF_O = 1536, OFF_G = 2048, OFF_CQ = 2064, OFF_CKV = 2448, OFF_KR = 2704, IN_COLS = 2768;
constexpr int SKV = SEQ + CTXL;
constexpr int NE = 16, CAPX = 1024, CAPC = 32;
constexpr int NSLOT = NB * NE * CAPX + NB * NE * CAPC;
constexpr float ALPHA = 1.4142135623730951f;
constexpr float A_SCALE = 0.07216878364870322f;

constexpr size_t al256(size_t v) { return (v + 255) / 256 * 256; }
constexpr size_t WS_H = 0;
constexpr size_t WS_P = WS_H + al256((size_t)MT * 1024 * 2);
constexpr size_t WS_Q = WS_P + al256((size_t)MT * PLD * 2);
constexpr size_t WS_KV = WS_Q + al256((size_t)MT * 768 * 2);
constexpr size_t WS_KR = WS_KV + al256((size_t)NB * SKV * 1024 * 2);
constexpr size_t WS_MIX = WS_KR + al256((size_t)NB * SKV * 64 * 2);
constexpr size_t WS_ACT = WS_P;
constexpr size_t WS_HB = WS_H;
constexpr size_t WS_OUTE = WS_P + al256((size_t)NSLOT * 1024 * 2);
constexpr size_t WS_WGU = WS_MIX;
constexpr size_t WS_WDN = WS_MIX + (size_t)NE * 2048 * 1024 * 2;
constexpr size_t WS_WIN = WS_MIX + al256((size_t)MT * 1024 * 2);
constexpr size_t WS_WUQ = WS_WIN + (size_t)2 * PLD * 1024 * 2;
constexpr size_t WS_WUKV = WS_WUQ + (size_t)2 * 768 * 384 * 2;
constexpr size_t WS_WOUT = WS_WUKV + (size_t)2 * 1024 * 256 * 2;
constexpr size_t WS_MOD = WS_WOUT + (size_t)2 * 1024 * 1024 * 2;
constexpr size_t WS_COS = WS_MOD + al256((size_t)2 * 9 * 6144 * 4);
constexpr size_t WS_SIN = WS_COS + (size_t)SEQ * 32 * 4;
constexpr size_t WS_GATES = WS_SIN + (size_t)SEQ * 32 * 4;
constexpr size_t WS_AFF = WS_GATES + (size_t)MT * 16 * 4;
constexpr size_t WS_IDX = WS_AFF + (size_t)MT * 16 * 4;
constexpr size_t WS_GV = WS_IDX + (size_t)NSLOT * 4;
constexpr size_t WS_TS = WS_GV + (size_t)NSLOT * 4;
constexpr size_t WS_CTXZ = WS_TS + (size_t)MT * 16 * 4;
constexpr size_t WS_END = WS_CTXZ + (size_t)MC * 1024 * 4;
static_assert(WS_OUTE + (size_t)NSLOT * 1024 * 2 <= WS_KR, "out_e overlay");
static_assert(WS_WDN + (size_t)NE * 1024 * 1024 * 2 <= WS_WIN, "expert weights overlay");

struct Params {
  const float *x, *c, *ctx, *c_ctx, *w_mod, *b_mod, *w_in, *b_gates, *conv_w, *conv_b, *m_norm_w, *q_norm_w, *kv_norm_w, *w_uq, *w_ukv, *w_out,
      *ln1_g, *ln1_b, *w_router, *w_gate, *w_up, *w_down, *ln2_g, *ln2_b;
  float* out; char* ws;
};

typedef const __attribute__((address_space(4))) Params& PRef;
__device__ __forceinline__ PRef kparams() { const __attribute__((address_space(4))) Params* kp = (const __attribute__((address_space(4))) Params*)__builtin_amdgcn_kernarg_segment_ptr(); asm volatile("" : "+s"(kp)); return *kp; }
__device__ __forceinline__ int otid() { int t = threadIdx.x; asm volatile("" : "+v"(t)); return t; }
__device__ __forceinline__ int obid() { int t = blockIdx.x; asm volatile("" : "+s"(t)); return t; }
__device__ __forceinline__ int opaque_s(int v) { asm volatile("" : "+s"(v)); return v; }
typedef __bf16 bf16v2_t __attribute__((ext_vector_type(2)));
typedef float f32x2_t __attribute__((ext_vector_type(2)));
__device__ __forceinline__ unsigned cvtpk(float lo, float hi) { const f32x2_t f = {lo, hi}; const bf16v2_t b = __builtin_convertvector(f, bf16v2_t); return __builtin_bit_cast(unsigned, b); }
__device__ __forceinline__ bf16_t f2bf(float v) { return (bf16_t)(cvtpk(v, v) & 0xffffu); }
__device__ __forceinline__ float bf2f(unsigned v) { return __uint_as_float(v << 16); }
__device__ __forceinline__ float bflo(unsigned w) { return __uint_as_float(w << 16); }
__device__ __forceinline__ float bfhi(unsigned w) { return __uint_as_float(w & 0xffff0000u); }
__device__ __forceinline__ float wave_sum(float v) { for (int o = 32; o > 0; o >>= 1) v += __shfl_xor(v, o); return v; }
__device__ __forceinline__ float wave_max(float v) { for (int o = 32; o > 0; o >>= 1) v = fmaxf(v, __shfl_xor(v, o)); return v; }
__device__ __forceinline__ float silu_f(float v) { return v / (1.f + __expf(-v)); }
__device__ __forceinline__ float sigmoid_f(float v) { return 1.f / (1.f + __expf(-v)); }

namespace g8 {
constexpr int BK = 64, HALF = 128, HTB = HALF * BK * 2, STAGE_BYTES = 8 * HTB;
__device__ __forceinline__ int lds_byte(int r, int c) { const int st = (r >> 4) * 2 + (c >> 5), rr = r & 15, cc = c & 31, ob = rr * 64 + cc * 2; return st * 1024 + (ob ^ (((ob >> 9) & 1) << 5)); }
__device__ __forceinline__ int perm32(int rho) { const int n = rho >> 4, i = rho & 15; return 8 * (i >> 2) + 4 * n + (i & 3); }
__device__ __forceinline__ void stage_rc(int b, int& R, int& C) { const int st = b / 1024, sb = b % 1024, swz = sb ^ (((sb >> 9) & 1) << 5); R = (st >> 1) * 16 + swz / 64; C = (st & 1) * 32 + (swz % 64) / 2; }

template <bool GATHER>
__device__ __forceinline__ void gemm_tile(LAS unsigned char* lds, const char* __restrict__ Ab, const unsigned (&voffA)[GATHER ? 4 : 2], size_t hstepA, const char* __restrict__ Bb, int K,
                                          f32x4 (&acc)[2][2][4][2]) {
  const int tid = otid(), wid = __builtin_amdgcn_readfirstlane(tid >> 6), lane = tid & 63, wr = wid >> 2, wc = wid & 3, fr = lane & 15, fq = lane >> 4;
  const int nt = K / BK;
  unsigned voffB[2];
#pragma unroll
  for (int i = 0; i < 2; ++i) { int R, C; stage_rc(tid * 16 + i * 8192, R, C); const int Rb = (R & ~31) + perm32(R & 31); voffB[i] = (unsigned)(Rb * K + C) * 2u; }
  const char* Bb1 = Bb + (size_t)HALF * K * 2; const char* Ab1 = GATHER ? Ab : Ab + hstepA;
  const unsigned* vA0 = &voffA[0]; const unsigned* vA1 = GATHER ? &voffA[2] : &voffA[0];
  const unsigned ldsw = (unsigned)wid * 1024u;
  const int aoff = lds_byte(wr * 64 + fr, fq * 8), boff = lds_byte(wc * 32 + fr, fq * 8);
#define G8_SA(b, h) (((b) * 2 + (h)) * HTB)
#define G8_SB(b, h) ((4 + (b) * 2 + (h)) * HTB)
#define G8_STAGE(bufoff, gbase, voff, kt) do { _Pragma("unroll") for (int _i = 0; _i < 2; ++_i) \
    __builtin_amdgcn_global_load_lds((const unsigned*)((gbase) + (size_t)(kt) * (BK * 2) + (voff)[_i]), (LAS unsigned*)(lds + (bufoff) + ldsw + _i * 8192), 16, 0, 0); } while (0)
#define G8_LDA(dst, b, h) do { _Pragma("unroll") for (int m = 0; m < 4; ++m) _Pragma("unroll") for (int k = 0; k < 2; ++k) dst[m][k] = *(const LAS bf16x8*)(lds + G8_SA(b, h) + aoff + m * 2048 + k * 1024); } while (0)
#define G8_LDB(dst, b, h) do { _Pragma("unroll") for (int n = 0; n < 2; ++n) _Pragma("unroll") for (int k = 0; k < 2; ++k) dst[n][k] = *(const LAS bf16x8*)(lds + G8_SB(b, h) + boff + n * 2048 + k * 1024); } while (0)
#define G8_MMA(ai, bj, At, Bt) do { __builtin_amdgcn_s_setprio(1); _Pragma("unroll") for (int m = 0; m < 4; ++m) _Pragma("unroll") for (int n = 0; n < 2; ++n) _Pragma("unroll") for (int k = 0; k < 2; ++k) \
    acc[ai][bj][m][n] = __builtin_amdgcn_mfma_f32_16x16x32_bf16(Bt[n][k], At[m][k], acc[ai][bj][m][n], 0, 0, 0); __builtin_amdgcn_s_setprio(0); } while (0)
#define G8_WAIT_V(n) asm volatile("s_waitcnt vmcnt(" #n ")" ::: "memory")
#define G8_WAIT_L(n) asm volatile("s_waitcnt lgkmcnt(" #n ")" ::: "memory")
#define G8_BAR __builtin_amdgcn_s_barrier()
#define G8_SCHED __builtin_amdgcn_sched_barrier(0)
#pragma unroll
  for (int a = 0; a < 2; ++a)
#pragma unroll
    for (int b = 0; b < 2; ++b)
#pragma unroll
      for (int m = 0; m < 4; ++m)
#pragma unroll
        for (int n = 0; n < 2; ++n) acc[a][b][m][n] = (f32x4){0.f, 0.f, 0.f, 0.f};
  bf16x8 At[4][2], B0[2][2], B1[2][2];
  G8_WAIT_V(0); __syncthreads();
  G8_STAGE(G8_SB(0, 0), Bb, voffB, 0); G8_STAGE(G8_SA(0, 0), Ab, vA0, 0); G8_STAGE(G8_SB(0, 1), Bb1, voffB, 0); G8_STAGE(G8_SA(0, 1), Ab1, vA1, 0);
  if (wr == 1) G8_BAR;
  G8_WAIT_V(4); G8_BAR;
  G8_STAGE(G8_SB(1, 0), Bb, voffB, 1); G8_STAGE(G8_SA(1, 0), Ab, vA0, 1); G8_STAGE(G8_SB(1, 1), Bb1, voffB, 1);
  G8_WAIT_V(6); G8_BAR;
  for (int t = 0; t < nt - 2; t += 2) {
    G8_LDB(B0, 0, 0); G8_SCHED; G8_LDA(At, 0, 0); G8_STAGE(G8_SA(1, 1), Ab1, vA1, t + 1);
    G8_WAIT_L(8); G8_BAR; G8_WAIT_L(0); G8_MMA(0, 0, At, B0); G8_BAR; G8_SCHED;
    G8_LDB(B1, 0, 1); G8_STAGE(G8_SB(0, 0), Bb, voffB, t + 2);
    G8_BAR; G8_WAIT_L(0); G8_MMA(0, 1, At, B1); G8_BAR;
    G8_LDA(At, 0, 1); G8_STAGE(G8_SA(0, 0), Ab, vA0, t + 2);
    G8_BAR; G8_WAIT_L(0); G8_MMA(1, 0, At, B0); G8_BAR; G8_SCHED;
    G8_STAGE(G8_SB(0, 1), Bb1, voffB, t + 2);
    G8_WAIT_V(6); G8_BAR; G8_MMA(1, 1, At, B1); G8_BAR;
    G8_LDB(B0, 1, 0); G8_SCHED; G8_LDA(At, 1, 0); G8_STAGE(G8_SA(0, 1), Ab1, vA1, t + 2);
    G8_WAIT_L(8); G8_BAR; G8_WAIT_L(0); G8_MMA(0, 0, At, B0); G8_BAR; G8_SCHED;
    G8_LDB(B1, 1, 1); G8_STAGE(G8_SB(1, 0), Bb, voffB, t + 3);
    G8_BAR; G8_WAIT_L(0); G8_MMA(0, 1, At, B1); G8_BAR;
    G8_LDA(At, 1, 1); G8_STAGE(G8_SA(1, 0), Ab, vA0, t + 3);
    G8_BAR; G8_WAIT_L(0); G8_MMA(1, 0, At, B0); G8_BAR; G8_SCHED;
    G8_STAGE(G8_SB(1, 1), Bb1, voffB, t + 3);
    G8_WAIT_V(6); G8_BAR; G8_MMA(1, 1, At, B1); G8_BAR;
  }
  { G8_LDB(B0, 0, 0); G8_LDA(At, 0, 0); G8_STAGE(G8_SA(1, 1), Ab1, vA1, nt - 1);
    G8_BAR; G8_WAIT_L(0); G8_MMA(0, 0, At, B0); G8_BAR;
    G8_LDB(B1, 0, 1); G8_BAR; G8_WAIT_L(0); G8_MMA(0, 1, At, B1); G8_BAR;
    G8_LDA(At, 0, 1); G8_WAIT_V(4); G8_BAR; G8_WAIT_L(0); G8_MMA(1, 0, At, B0); G8_MMA(1, 1, At, B1); G8_BAR; }
  { G8_LDB(B0, 1, 0); G8_LDA(At, 1, 0); G8_WAIT_V(2); G8_BAR; G8_WAIT_L(0); G8_MMA(0, 0, At, B0); G8_BAR;
    G8_LDB(B1, 1, 1); G8_WAIT_V(0); G8_BAR; G8_WAIT_L(0); G8_MMA(0, 1, At, B1); G8_BAR;
    G8_LDA(At, 1, 1); G8_BAR; G8_WAIT_L(0); G8_MMA(1, 0, At, B0); G8_MMA(1, 1, At, B1); G8_BAR; }
  if (wr == 0) G8_BAR;
}
__device__ __forceinline__ unsigned piece_off(int i, int ld, int c0) { int R, C; stage_rc((int)otid() * 16 + i * 8192, R, C); return (unsigned)(R * ld + c0 + C) * 2u; }
__device__ __forceinline__ void piece_rc(int i, int& R, int& C) { stage_rc((int)otid() * 16 + i * 8192, R, C); }
struct TileIter {
  int nM, nN, x, j, J, cnt, idx;
  __device__ __forceinline__ void init(int nM_, int nN_) { nM = nM_; nN = nN_; x = obid() & 7; j = obid() >> 3; J = gridDim.x >> 3; cnt = ((nM - x + 7) >> 3) * nN; idx = j; }
  __device__ __forceinline__ bool next(int& pm, int& pn) { if (idx >= cnt) return false; pm = x + 8 * (idx / nN); pn = idx % nN; idx += J; return true; }
};
struct MoeIter {
  int nN, x, jm, jn, j, step, nsteps, nb4; bool with_ctx, ctx_done;
  __device__ __forceinline__ void init(int nN_, bool with_ctx_) { nN = nN_; with_ctx = with_ctx_; x = obid() & 7; j = obid() >> 3; jm = j & 7; jn = j >> 3; nb4 = nN >> 2; nsteps = 2 * nb4 * 4; step = 0; ctx_done = false; }
  __device__ __forceinline__ bool next(int& pm, int& pn, int& e) {
    if (step < nsteps) { const int mb = step & 3, nb = (step >> 2) % nb4, el = (step >> 2) / nb4; e = 2 * x + el; const int m32 = mb * 8 + jm; pm = ((m32 >> 2) * 16 + e) * 4 + (m32 & 3); pn = nb * 4 + jn; ++step; return true; }
    if (with_ctx && !ctx_done) { ctx_done = true; if (j < 2 * nN) { e = 2 * x + j / nN; pm = 512 + e; pn = j % nN; return true; } }
    return false;
  }
};
}

#define ACC_FOR3(ai, bj, m) _Pragma("unroll") for (int ai = 0; ai < 2; ++ai) _Pragma("unroll") for (int bj = 0; bj < 2; ++bj) _Pragma("unroll") for (int m = 0; m < 4; ++m)
#define ACC_FOR(ai, bj, m, n) _Pragma("unroll") for (int ai = 0; ai < 2; ++ai) _Pragma("unroll") for (int bj = 0; bj < 2; ++bj) _Pragma("unroll") for (int m = 0; m < 4; ++m) _Pragma("unroll") for (int n = 0; n < 2; ++n)

__device__ __forceinline__ void cvt_tile(const float* __restrict__ src, int N, int K, int k0, int n0, bf16_t* __restrict__ dst, long drow0, const float* __restrict__ kscale, float* lds) {
  const int tid = otid();
  { const int kr = tid >> 6, n = tid & 63;
#pragma unroll
    for (int i = 0; i < 8; ++i) { const int k = kr + 8 * i; float v = (n0 + n < N) ? src[(size_t)(k0 + k) * N + n0 + n] : 0.f; if (kscale) v *= kscale[k0 + k]; lds[k * 65 + n] = v; } }
  __syncthreads();
  { const int n = tid >> 3, k8 = (tid & 7) * 8; float v[8];
#pragma unroll
    for (int i = 0; i < 8; ++i) v[i] = lds[(k8 + i) * 65 + n];
    u32x4 w = {cvtpk(v[0], v[1]), cvtpk(v[2], v[3]), cvtpk(v[4], v[5]), cvtpk(v[6], v[7])};
    *(u32x4*)(dst + (size_t)(drow0 + n) * K + k0 + k8) = w; }
  __syncthreads();
}

__device__ void phase_prep(PRef p, char* smem) {
  float* lds = (float*)smem;
  bf16_t* Wt_in = (bf16_t*)(p.ws + WS_WIN); bf16_t* Wt_uq = (bf16_t*)(p.ws + WS_WUQ); bf16_t* Wt_ukv = (bf16_t*)(p.ws + WS_WUKV); bf16_t* Wt_out = (bf16_t*)(p.ws + WS_WOUT);
  float* mod = (float*)(p.ws + WS_MOD);
  constexpr int T_MOD = 192, T_IN = 2 * 16 * 44, T_UQ = 2 * 6 * 12, T_UKV = 2 * 4 * 16, T_OUT = 2 * 16 * 16, T_ROPE = 64;
  constexpr int E0 = T_MOD, E1 = E0 + T_IN, E2 = E1 + T_UQ, E3 = E2 + T_UKV, E4 = E3 + T_OUT, E5 = E4 + T_ROPE;
  const int tid = otid();
  for (int task = obid(); task < E5; task += gridDim.x) {
    if (task < E0) {
      const int l = task / 96, j0 = (task % 96) * 64;
      float* sc = lds;
      for (int i = tid; i < 9 * 1024; i += 512) { const int bb = i >> 10, d = i & 1023; const float v = bb < 8 ? p.c[bb * 1024 + d] : p.c_ctx[d]; sc[i] = v / (1.f + expf(-v)); }
      __syncthreads();
      const int col = tid & 63, ks = tid >> 6; float a[9];
#pragma unroll
      for (int bb = 0; bb < 9; ++bb) a[bb] = 0.f;
      const float* wm = p.w_mod + (size_t)l * 1024 * 6144 + j0 + col;
      for (int d = ks * 128; d < ks * 128 + 128; ++d) { const float w = wm[(size_t)d * 6144];
#pragma unroll
        for (int bb = 0; bb < 9; ++bb) a[bb] += sc[bb * 1024 + d] * w; }
      float* red = lds + 9 * 1024;
#pragma unroll
      for (int bb = 0; bb < 9; ++bb) red[(ks * 9 + bb) * 64 + col] = a[bb];
      __syncthreads();
      for (int i = tid; i < 9 * 64; i += 512) { const int bb = i >> 6, cc = i & 63; float s = 0.f;
        for (int k = 0; k < 8; ++k) s += red[(k * 9 + bb) * 64 + cc];
        mod[((size_t)l * 9 + bb) * 6144 + j0 + cc] = s + p.b_mod[l * 6144 + j0 + cc]; }
      __syncthreads();
    } else if (task < E1) { const int t = task - E0, l = t / 704, r = t % 704, kt = r / 44, nt = r % 44;
      cvt_tile(p.w_in + (size_t)l * 1024 * IN_COLS, IN_COLS, 1024, kt * 64, nt * 64, Wt_in + (size_t)l * PLD * 1024, nt * 64, nullptr, lds);
    } else if (task < E2) { const int t = task - E1, l = t / 72, r = t % 72, kt = r / 12, nt = r % 12;
      cvt_tile(p.w_uq + (size_t)l * 384 * 768, 768, 384, kt * 64, nt * 64, Wt_uq + (size_t)l * 768 * 384, nt * 64, p.q_norm_w + l * 384, lds);
    } else if (task < E3) { const int t = task - E2, l = t / 64, r = t % 64, kt = r / 16, nt = r % 16;
      cvt_tile(p.w_ukv + (size_t)l * 256 * 1024, 1024, 256, kt * 64, nt * 64, Wt_ukv + (size_t)l * 1024 * 256, nt * 64, p.kv_norm_w + l * 256, lds);
    } else if (task < E4) { const int t = task - E3, l = t / 256, r = t % 256, kt = r / 16, nt = r % 16;
      cvt_tile(p.w_out + (size_t)l * 1024 * 1024, 1024, 1024, kt * 64, nt * 64, Wt_out + (size_t)l * 1024 * 1024, nt * 64, nullptr, lds);
    } else {
      float* cs = (float*)(p.ws + WS_COS); float* sn = (float*)(p.ws + WS_SIN);
      for (int i = (task - E4) * 4096 + tid; i < (task - E4 + 1) * 4096; i += 512) { const int t = i >> 5, j = i & 31;
        const float inv = exp2f(-(float)(j & 15) * (13.287712379549449f / 16.f));
        const float pos = (float)(j < 16 ? (t >> 6) : (t & 63)); const float ang = pos * inv;
        const double a = (double)ang; const double k = rint(a * 0.15915494309189535); const float r = (float)(a - k * 6.283185307179586);
        cs[i] = __cosf(r); sn[i] = __sinf(r); }
    }
  }
}

__device__ void phase_cvt_experts(PRef p, int l, char* smem) {
  float* lds = (float*)smem;
  bf16_t* Wgu = (bf16_t*)(p.ws + WS_WGU); bf16_t* Wdn = (bf16_t*)(p.ws + WS_WDN);
  for (int task = obid(); task < NE * 768; task += gridDim.x) {
    const int e = task / 768, r = task % 768, which = r >> 8, kt = (r & 255) >> 4, nt = r & 15, n0 = nt * 64;
    const size_t eo = ((size_t)l * NE + e) * 1024 * 1024;
    if (which == 0) cvt_tile(p.w_gate + eo, 1024, 1024, kt * 64, n0, Wgu + (size_t)e * 2048 * 1024, (n0 >> 7) * 256 + (n0 & 127), nullptr, lds);
    else if (which == 1) cvt_tile(p.w_up + eo, 1024, 1024, kt * 64, n0, Wgu + (size_t)e * 2048 * 1024, (n0 >> 7) * 256 + 128 + (n0 & 127), nullptr, lds);
    else cvt_tile(p.w_down + eo, 1024, 1024, kt * 64, n0, Wdn + (size_t)e * 1024 * 1024, n0, nullptr, lds);
  }
}

__device__ __forceinline__ void ln_row(f32x4 (&v)[4], float eps) {
  float s = 0.f;
#pragma unroll
  for (int i = 0; i < 4; ++i) s += v[i][0] + v[i][1] + v[i][2] + v[i][3];
  const float mu = wave_sum(s) * (1.f / 1024.f);
  float q = 0.f;
#pragma unroll
  for (int i = 0; i < 4; ++i)
#pragma unroll
    for (int k = 0; k < 4; ++k) { v[i][k] -= mu; q += v[i][k] * v[i][k]; }
  const float rs = rsqrtf(wave_sum(q) * (1.f / 1024.f) + eps);
#pragma unroll
  for (int i = 0; i < 4; ++i) v[i] *= rs;
}
__device__ __forceinline__ void store_mod_bf16(const f32x4 (&v)[4], const float* __restrict__ shift, const float* __restrict__ scale, bf16_t* __restrict__ hrow, int lane, f32x4 (*keep)[4]) {
#pragma unroll
  for (int i = 0; i < 4; ++i) { const int c = lane * 4 + 256 * i; const f32x4 sh = *(const f32x4*)(shift + c), sc = *(const f32x4*)(scale + c);
    f32x4 o = v[i] * (sc + 1.f) + sh; if (keep) (*keep)[i] = o;
    u32x2 w = {cvtpk(o[0], o[1]), cvtpk(o[2], o[3])}; *(u32x2*)(hrow + c) = w; }
}
__device__ __forceinline__ const float* mod_ptr(PRef p, int l, int row, int which) {
  const int bb = row < MX ? (row >> 13) : 8;
  return (const float*)(p.ws + WS_MOD) + ((size_t)l * 9 + bb) * 6144 + which * 1024;
}

__device__ void phase_h0(PRef p) {
  const int lane = otid() & 63, gw = obid() * 8 + (otid() >> 6), nw = gridDim.x * 8;
  bf16_t* h = (bf16_t*)(p.ws + WS_H);
  for (int row = gw; row < MT; row += nw) {
    const float* src = row < MX ? p.x + (size_t)row * 1024 : p.ctx + (size_t)(row - MX) * 1024;
    f32x4 v[4];
#pragma unroll
    for (int i = 0; i < 4; ++i) v[i] = *(const f32x4*)(src + lane * 4 + 256 * i);
    ln_row(v, 1e-6f);
    store_mod_bf16(v, mod_ptr(p, 0, row, 0), mod_ptr(p, 0, row, 1), h + (size_t)row * 1024, lane, nullptr);
  }
}

__device__ void phase_inproj(PRef p, int l, char* smem) {
  LAS unsigned char* lds = (LAS unsigned char*)smem;
  const bf16_t* h = (const bf16_t*)(p.ws + WS_H); const bf16_t* Wt = (const bf16_t*)(p.ws + WS_WIN) + (size_t)l * PLD * 1024;
  bf16_t* P = (bf16_t*)(p.ws + WS_P); float* gates = (float*)(p.ws + WS_GATES);
  const int tid = otid(), wid = tid >> 6, lane = tid & 63, wr = wid >> 2, wc = wid & 3, fr = lane & 15, fq = lane >> 4;
  g8::TileIter it; it.init(MT / 256, PLD / 256);
  int pm, pn;
  while (it.next(pm, pn)) {
    unsigned voffA[2] = {g8::piece_off(0, 1024, 0), g8::piece_off(1, 1024, 0)};
    f32x4 acc[2][2][4][2];
    g8::gemm_tile<false>(lds, (const char*)(h + (size_t)pm * 256 * 1024), voffA, (size_t)128 * 1024 * 2, (const char*)(Wt + (size_t)pn * 256 * 1024), 1024, acc);
    ACC_FOR3(ai, bj, m) {
      const int row = pm * 256 + ai * 128 + wr * 64 + m * 16 + fr, col = pn * 256 + bj * 128 + wc * 32 + fq * 8;
      const f32x4 v0 = acc[ai][bj][m][0], v1 = acc[ai][bj][m][1];
      u32x4 w = {cvtpk(v0[0], v0[1]), cvtpk(v0[2], v0[3]), cvtpk(v1[0], v1[1]), cvtpk(v1[2], v1[3])}; *(u32x4*)(P + (size_t)row * PLD + col) = w;
      if (col >= OFF_G && col < OFF_G + 16) { const f32x4 bg0 = *(const f32x4*)(p.b_gates + l * 16 + (col - OFF_G)), bg1 = *(const f32x4*)(p.b_gates + l * 16 + (col - OFF_G) + 4);
        *(f32x4*)(gates + (size_t)row * 16 + (col - OFF_G)) = v0 + bg0; *(f32x4*)(gates + (size_t)row * 16 + (col - OFF_G) + 4) = v1 + bg1; }
    }
  }
}


__device__ void phase_mlstm(PRef p, int l, char* smem, size_t hb_off = WS_HB) {
  bf16_t* RAWQ = (bf16_t*)(smem); bf16_t* RAWK = (bf16_t*)(smem + 17408);
  bf16_t* QB = (bf16_t*)(smem + 34816); bf16_t* KB = (bf16_t*)(smem + 52224);
  bf16_t* KT = (bf16_t*)(smem + 69632);
  bf16_t* VT = (bf16_t*)(smem + 88064); bf16_t* VWT = (bf16_t*)(smem + 94976);
  bf16_t* PB = (bf16_t*)(smem + 101888);
  bf16_t* CT = (bf16_t*)(smem + 111104);
  float* SC = (float*)(smem + 124160);
  const bf16_t* P = (const bf16_t*)(p.ws + WS_P); const float* gates = (const float*)(p.ws + WS_GATES);
  bf16_t* hbuf = (bf16_t*)(p.ws + hb_off);
  const int tid = otid(), wid = tid >> 6, lane = tid & 63, fr = lane & 15, fq = lane >> 4;
  for (int w = obid(); w < 256; w += gridDim.x) {
    const int slice = w & 3, dir = (w >> 2) & 1, hd = (w >> 3) & 3, b = w >> 5;
    const int c2 = (tid & 63) * 2;
    float wq0[5], wq1[5], wk0[5], wk1[5];
#pragma unroll
    for (int j = 0; j < 5; ++j) { const float* cw = p.conv_w + ((size_t)l * 5 + j) * 1024; wq0[j] = cw[hd * 128 + c2]; wq1[j] = cw[hd * 128 + c2 + 1]; wk0[j] = cw[512 + hd * 128 + c2]; wk1[j] = cw[512 + hd * 128 + c2 + 1]; }
    const float bq0 = p.conv_b[l * 1024 + hd * 128 + c2], bq1 = p.conv_b[l * 1024 + hd * 128 + c2 + 1], bk0 = p.conv_b[l * 1024 + 512 + hd * 128 + c2], bk1 = p.conv_b[l * 1024 + 512 + hd * 128 + c2 + 1];
    __syncthreads();
    for (int i = tid; i < 48 * 136 / 2; i += 512) ((unsigned*)CT)[i] = 0u;
    for (int i = tid; i < 48 * 72 / 2; i += 512) { ((unsigned*)VT)[i] = 0u; ((unsigned*)VWT)[i] = 0u; }
    f32x4 accC[3];
#pragma unroll
    for (int i = 0; i < 3; ++i) accC[i] = (f32x4){0.f, 0.f, 0.f, 0.f};
    float m_state = 0.f;
    __syncthreads();
    u32x4 pre_raw[5]; u32x2 pre_v; float pre_ig = 0.f, pre_fg = 0.f;
    const int vl = tid >> 3, ve4 = (tid & 7) * 4;
#define MLSTM_PREFETCH(CI) do { const int ci_ = (CI); const bool ic_ = ci_ < 4; const int cc_ = ic_ ? ci_ : ci_ - 4, T_ = ic_ ? CTXL : SEQ, rb_ = ic_ ? MX + b * CTXL : b * SEQ; \
      const int tlo_ = dir ? T_ - 64 - cc_ * 64 : cc_ * 64; \
      _Pragma("unroll") for (int k_ = 0; k_ < 5; ++k_) { const int pc = tid + k_ * 512; pre_raw[k_] = (u32x4){0u, 0u, 0u, 0u}; \
        if (pc < 2176) { const int tens = pc >= 1088, rem = tens ? pc - 1088 : pc, rr = rem >> 4, c16 = rem & 15, t = tlo_ - 2 + rr; \
          if (t >= 0 && t < T_) pre_raw[k_] = *(const u32x4*)(P + (size_t)(rb_ + t) * PLD + (tens ? OFF_K : OFF_Q) + hd * 128 + c16 * 8); } } \
      { const int vt_ = dir ? tlo_ + 63 - vl : tlo_ + vl; pre_v = *(const u32x2*)(P + (size_t)(rb_ + vt_) * PLD + OFF_V + hd * 128 + slice * 32 + ve4); } \
      if (wid == 0) { const int t = dir ? tlo_ + 63 - lane : tlo_ + lane; const float* g = gates + (size_t)(rb_ + t) * 16; pre_ig = g[dir * 8 + hd]; pre_fg = g[dir * 8 + 4 + hd]; } } while (0)
    MLSTM_PREFETCH(0);
    for (int ci = 0; ci < 132; ++ci) {
      const bool isctx = ci < 4; const int cc = isctx ? ci : ci - 4, T = isctx ? CTXL : SEQ, rowbase = isctx ? MX + b * CTXL : b * SEQ;
      const int tlo = dir ? T - 64 - cc * 64 : cc * 64;
      float* S = SC + (ci & 1) * 384;
      const bool need_out = !(l == DEPTH - 1 && isctx);
      if (wid == 0) {
        const float ig = pre_ig, fg = pre_fg;
        const float lf = fminf(fg, 0.f) - log1pf(expf(-fabsf(fg)));
        float bc = lf;
#pragma unroll
        for (int o = 1; o < 64; o <<= 1) { const float u = __shfl_up(bc, o); if (lane >= o) bc += u; }
        const float a = ig - bc; float pmx = a;
#pragma unroll
        for (int o = 1; o < 64; o <<= 1) { const float u = __shfl_up(pmx, o); if (lane >= o) pmx = fmaxf(pmx, u); }
        const float Mx = fmaxf(pmx, m_state), M63 = __shfl(Mx, 63), b63 = __shfl(bc, 63);
        S[lane] = a; S[64 + lane] = Mx; S[128 + lane] = expf(m_state - Mx); S[192 + lane] = expf(-(bc + Mx)); S[256 + lane] = expf(a - M63);
        if (lane == 0) { S[320] = expf(m_state - M63); S[321] = b63 + M63; }
      }
#pragma unroll
      for (int k = 0; k < 5; ++k) { const int pc = tid + k * 512;
        if (pc < 2176) { const int tens = pc >= 1088, rem = tens ? pc - 1088 : pc, rr = rem >> 4, c16 = rem & 15; *(u32x4*)((tens ? RAWK : RAWQ) + rr * 128 + c16 * 8) = pre_raw[k]; } }
      const u32x2 vraw = pre_v;
      if (ci + 1 < 132) MLSTM_PREFETCH(ci + 1);
      __syncthreads();
      {
        const int rg = wid; unsigned rq[12], rk[12];
#pragma unroll
        for (int i = 0; i < 12; ++i) { rq[i] = *(const unsigned*)(RAWQ + (rg * 8 + i) * 128 + c2); rk[i] = *(const unsigned*)(RAWK + (rg * 8 + i) * 128 + c2); }
#pragma unroll
        for (int jj = 0; jj < 8; ++jj) {
          float yq0 = bq0, yq1 = bq1, yk0 = bk0, yk1 = bk1;
#pragma unroll
          for (int tp = 0; tp < 5; ++tp) { yq0 += wq0[tp] * bflo(rq[jj + tp]); yq1 += wq1[tp] * bfhi(rq[jj + tp]); yk0 += wk0[tp] * bflo(rk[jj + tp]); yk1 += wk1[tp] * bfhi(rk[jj + tp]); }
          const int j = rg * 8 + jj, lr = dir ? 63 - j : j;
          const float q0 = silu_f(yq0) * 0.08838834764831845f, q1 = silu_f(yq1) * 0.08838834764831845f, k0 = silu_f(yk0), k1 = silu_f(yk1);
          *(unsigned*)(QB + lr * 136 + c2) = cvtpk(q0, q1);
          const unsigned kw = cvtpk(k0, k1);
          *(unsigned*)(KB + lr * 136 + c2) = kw;
          KT[c2 * 72 + lr] = (bf16_t)(kw & 0xffffu); KT[(c2 + 1) * 72 + lr] = (bf16_t)(kw >> 16);
        }
        const float wsl = S[256 + vl];
        const float v0 = bflo(vraw[0]), v1 = bfhi(vraw[0]), v2 = bflo(vraw[1]), v3 = bfhi(vraw[1]);
        VT[(ve4 + 0) * 72 + vl] = (bf16_t)(vraw[0] & 0xffffu); VT[(ve4 + 1) * 72 + vl] = (bf16_t)(vraw[0] >> 16);
        VT[(ve4 + 2) * 72 + vl] = (bf16_t)(vraw[1] & 0xffffu); VT[(ve4 + 3) * 72 + vl] = (bf16_t)(vraw[1] >> 16);
        VWT[(ve4 + 0) * 72 + vl] = f2bf(v0 * wsl); VWT[(ve4 + 1) * 72 + vl] = f2bf(v1 * wsl); VWT[(ve4 + 2) * 72 + vl] = f2bf(v2 * wsl); VWT[(ve4 + 3) * 72 + vl] = f2bf(v3 * wsl);
        if (tid < 64) { VT[32 * 72 + tid] = (bf16_t)0x3F80u; VWT[32 * 72 + tid] = f2bf(S[256 + tid]); }
      }
      __syncthreads();
      if (need_out) {
        const int mt = wid >> 1;
#pragma unroll
        for (int u = 0; u < 2; ++u) {
          const int ntl = (wid & 1) * 2 + u;
          f32x4 s = {0.f, 0.f, 0.f, 0.f};
          if (ntl <= mt) {
#pragma unroll
            for (int kk = 0; kk < 4; ++kk) {
              const bf16x8 a = *(const bf16x8*)(QB + (mt * 16 + fr) * 136 + kk * 32 + fq * 8), bb = *(const bf16x8*)(KB + (ntl * 16 + fr) * 136 + kk * 32 + fq * 8);
              s = __builtin_amdgcn_mfma_f32_16x16x32_bf16(a, bb, s, 0, 0, 0); }
          }
          const int j = ntl * 16 + fr; const float aj = S[j];
#pragma unroll
          for (int jj = 0; jj < 4; ++jj) { const int lr = mt * 16 + fq * 4 + jj;
            const float pv = (j <= lr) ? s[jj] * __expf(fminf(aj - S[64 + lr], 0.f)) : 0.f;
            PB[lr * 72 + j] = f2bf(pv); }
        }
      }
      __syncthreads();
      if (need_out && wid < 4) {
        const int mt = wid; f32x4 num[3];
#pragma unroll
        for (int ntl = 0; ntl < 3; ++ntl) {
          f32x4 a1 = {0.f, 0.f, 0.f, 0.f}, a2 = {0.f, 0.f, 0.f, 0.f};
#pragma unroll
          for (int kk = 0; kk < 2; ++kk) { const bf16x8 a = *(const bf16x8*)(PB + (mt * 16 + fr) * 72 + kk * 32 + fq * 8), bb = *(const bf16x8*)(VT + (ntl * 16 + fr) * 72 + kk * 32 + fq * 8);
            a1 = __builtin_amdgcn_mfma_f32_16x16x32_bf16(a, bb, a1, 0, 0, 0); }
#pragma unroll
          for (int kk = 0; kk < 4; ++kk) { const bf16x8 a = *(const bf16x8*)(QB + (mt * 16 + fr) * 136 + kk * 32 + fq * 8), bb = *(const bf16x8*)(CT + (ntl * 16 + fr) * 136 + kk * 32 + fq * 8);
            a2 = __builtin_amdgcn_mfma_f32_16x16x32_bf16(a, bb, a2, 0, 0, 0); }
#pragma unroll
          for (int jj = 0; jj < 4; ++jj) num[ntl][jj] = a1[jj] + S[128 + mt * 16 + fq * 4 + jj] * a2[jj];
        }
#pragma unroll
        for (int jj = 0; jj < 4; ++jj) {
          const int lr = mt * 16 + fq * 4 + jj; const float den = __shfl(num[2][jj], lane & 48);
          const float rd = 1.f / fmaxf(fabsf(den), S[192 + lr]);
          const int t = dir ? tlo + 63 - lr : tlo + lr;
          bf16_t* hp = hbuf + ((size_t)((dir * 4 + hd) * 4 + slice) * MT + rowbase + t) * 32 + fr;
          hp[0] = f2bf(num[0][jj] * rd); hp[16] = f2bf(num[1][jj] * rd);
#if DBG_STOP == 23
          { const size_t di = (size_t)(hp - hbuf); if (di + 16 < (size_t)MX * 1024) { p.out[di] = num[0][jj] * rd; p.out[di + 16] = num[1][jj] * rd; } }
#endif
        }
      }
      __syncthreads();
      {
        const float decay = S[320];
#pragma unroll
        for (int mt = 0; mt < 3; ++mt) {
          accC[mt] *= decay;
#pragma unroll
          for (int kk = 0; kk < 2; ++kk) { const bf16x8 a = *(const bf16x8*)(VWT + (mt * 16 + fr) * 72 + kk * 32 + fq * 8), bb = *(const bf16x8*)(KT + (wid * 16 + fr) * 72 + kk * 32 + fq * 8);
            accC[mt] = __builtin_amdgcn_mfma_f32_16x16x32_bf16(a, bb, accC[mt], 0, 0, 0); }
#pragma unroll
          for (int jj = 0; jj < 4; ++jj) CT[(mt * 16 + fq * 4 + jj) * 136 + wid * 16 + fr] = f2bf(accC[mt][jj]);
        }
        m_state = S[321];
      }
    }
  }
}

template <int WHICH>
__device__ __forceinline__ void mla_gemm(PRef p, int l, char* smem) {
  LAS unsigned char* lds = (LAS unsigned char*)smem; float* rsb = (float*)(smem + g8::STAGE_BYTES);
  const bf16_t* P = (const bf16_t*)(p.ws + WS_P);
  const int tid = otid(), wid = tid >> 6, lane = tid & 63, wr = wid >> 2, wc = wid & 3, fr = lane & 15, fq = lane >> 4;
  constexpr int K = WHICH ? 256 : 384, OFFC = WHICH ? OFF_CKV : OFF_CQ, N = WHICH ? 1024 : 768;
  const bf16_t* Wt = WHICH ? (const bf16_t*)(p.ws + WS_WUKV) + (size_t)l * 1024 * 256 : (const bf16_t*)(p.ws + WS_WUQ) + (size_t)l * 768 * 384;
  bf16_t* O = (bf16_t*)(p.ws + (WHICH ? WS_KV : WS_Q));
  g8::TileIter it; it.init((WHICH || l == 0) ? MT / 256 : MX / 256, N / 256);
  int pm, pn;
  while (it.next(pm, pn)) {
    __syncthreads();
    { const int r = tid >> 1, hf = tid & 1; const bf16_t* src = P + (size_t)(pm * 256 + r) * PLD + OFFC + hf * (K / 2); float s = 0.f;
#pragma unroll 4
      for (int i = 0; i < K / 16; ++i) { const u32x4 v = *(const u32x4*)(src + i * 8);
#pragma unroll
        for (int k = 0; k < 4; ++k) { const float a = bflo(v[k]), bq = bfhi(v[k]); s += a * a + bq * bq; } }
      s += __shfl_xor(s, 1);
      if (hf == 0) rsb[r] = rsqrtf(s / (float)K + 1e-6f); }
    unsigned voffA[2] = {g8::piece_off(0, PLD, OFFC), g8::piece_off(1, PLD, OFFC)};
    f32x4 acc[2][2][4][2];
    g8::gemm_tile<false>(lds, (const char*)(P + (size_t)pm * 256 * PLD), voffA, (size_t)128 * PLD * 2, (const char*)(Wt + (size_t)pn * 256 * K), opaque_s(K), acc);
    ACC_FOR3(ai, bj, m) {
      const int rl = ai * 128 + wr * 64 + m * 16 + fr, row = pm * 256 + rl, col = pn * 256 + bj * 128 + wc * 32 + fq * 8;
      const float rs = rsb[rl]; const f32x4 v0 = acc[ai][bj][m][0] * rs, v1 = acc[ai][bj][m][1] * rs;
      size_t orow = row;
      if (WHICH) orow = row < MX ? (size_t)(row >> 13) * SKV + CTXL + (row & 8191) : (size_t)((row - MX) >> 8) * SKV + ((row - MX) & 255);
      u32x4 w = {cvtpk(v0[0], v0[1]), cvtpk(v0[2], v0[3]), cvtpk(v1[0], v1[1]), cvtpk(v1[2], v1[3])}; *(u32x4*)(O + orow * N + col) = w;
    }
  }
}
__device__ void phase_mla_prep(PRef p, int l, char* smem) {
  mla_gemm<0>(p, l, smem);
  mla_gemm<1>(p, l, smem);
  const bf16_t* P = (const bf16_t*)(p.ws + WS_P);
  const int tid = otid(), wid = tid >> 6, lane = tid & 63;
  const bf16_t* hbuf = (const bf16_t*)(p.ws + WS_HB); bf16_t* mix = (bf16_t*)(p.ws + WS_MIX); bf16_t* KR = (bf16_t*)(p.ws + WS_KR);
  const float* cs = (const float*)(p.ws + WS_COS); const float* sn = (const float*)(p.ws + WS_SIN);
  const int gw = obid() * 8 + wid, nw = gridDim.x * 8;
  for (int row = gw; row < MT; row += nw) {
    if (row < MX || l == 0) {
      const size_t ho = ((size_t)(lane >> 2) * MT + row) * 32 + (lane & 3) * 8;
      const u32x4 hf = *(const u32x4*)(hbuf + ho), hb = *(const u32x4*)(hbuf + (size_t)16 * MT * 32 + ho);
      const u32x4 ov = *(const u32x4*)(P + (size_t)row * PLD + OFF_O + lane * 8);
      float v[8]; float s = 0.f;
#pragma unroll
      for (int k = 0; k < 4; ++k) { v[2 * k] = bflo(hf[k]) + bflo(hb[k]); v[2 * k + 1] = bfhi(hf[k]) + bfhi(hb[k]); s += v[2 * k] + v[2 * k + 1]; }
      s += __shfl_xor(s, 1); s += __shfl_xor(s, 2); s += __shfl_xor(s, 4); s += __shfl_xor(s, 8);
      const float mu = s * (1.f / 128.f); float q = 0.f;
#pragma unroll
      for (int k = 0; k < 8; ++k) { v[k] -= mu; q += v[k] * v[k]; }
      q += __shfl_xor(q, 1); q += __shfl_xor(q, 2); q += __shfl_xor(q, 4); q += __shfl_xor(q, 8);
      const float rs = rsqrtf(q * (1.f / 128.f) + 1e-6f);
      const float* nw_ = p.m_norm_w + l * 512 + lane * 8; float o[8];
#pragma unroll
      for (int k = 0; k < 4; ++k) { o[2 * k] = v[2 * k] * rs * nw_[2 * k] * sigmoid_f(bflo(ov[k])); o[2 * k + 1] = v[2 * k + 1] * rs * nw_[2 * k + 1] * sigmoid_f(bfhi(ov[k])); }
      u32x4 wv = {cvtpk(o[0], o[1]), cvtpk(o[2], o[3]), cvtpk(o[4], o[5]), cvtpk(o[6], o[7])};
      *(u32x4*)(mix + (size_t)row * 1024 + lane * 8) = wv;
    }
    {
      const int j = lane & 31;
      const float x1 = bf2f(P[(size_t)row * PLD + OFF_KR + j]), x2 = bf2f(P[(size_t)row * PLD + OFF_KR + 32 + j]);
      float o1 = x1, o2 = x2; size_t orow;
      if (row < MX) { const int t = row & 8191; const float c = cs[t * 32 + j], s_ = sn[t * 32 + j]; o1 = x1 * c - x2 * s_; o2 = x2 * c + x1 * s_; orow = (size_t)(row >> 13) * SKV + CTXL + t; }
      else orow = (size_t)((row - MX) >> 8) * SKV + ((row - MX) & 255);
      if (lane < 32) { KR[orow * 64 + j] = f2bf(o1); KR[orow * 64 + 32 + j] = f2bf(o2); }
    }
  }
}

namespace att {
constexpr int NW = 8, QBLK = 32, KVBLK = 64, LDQ = 768, LDK = 1024, LDKR = 64, LDO = 1024;
constexpr float SCALE = A_SCALE;
constexpr float THR = 8.f;
constexpr size_t SHM_V = KVBLK * 128 * 2, SHM_K = KVBLK * 128 * 2, SHM_R = KVBLK * 64 * 2;
typedef float f32x8 __attribute__((ext_vector_type(8)));
#define KSWZ(row, colB) ((row) * 256 + ((colB) ^ (((row) & 7) << 4)))
#define RSWZ(row, colB) ((row) * 128 + ((colB) ^ (((row) & 7) << 4)))
#define SBAR() __builtin_amdgcn_sched_barrier(0)
__device__ __forceinline__ int crow(int r, int hi) { return (r & 3) + 8 * (r >> 2) + 4 * hi; }
__device__ __forceinline__ void partialSM(f32x16& p0, f32x16& p1, float& m_reg, float& mn, float& alpha) {
  constexpr float C = SCALE * 1.4426950408889634f;
  float pmax = p0[0];
#pragma unroll
  for (int r = 1; r < 16; ++r) pmax = fmaxf(pmax, p0[r]);
#pragma unroll
  for (int r = 0; r < 16; ++r) pmax = fmaxf(pmax, p1[r]);
  { auto rr = __builtin_amdgcn_permlane32_swap(__float_as_uint(pmax), __float_as_uint(pmax), false, false);
    pmax = fmaxf(__uint_as_float(rr[0]), __uint_as_float(rr[1])); }
  if (__builtin_expect(__all(pmax - m_reg <= THR / SCALE), 1)) { mn = m_reg; alpha = 1.f; }
  else { mn = fmaxf(m_reg, pmax); alpha = __builtin_amdgcn_exp2f((m_reg - mn) * C); m_reg = mn; }
  const float mnC = -mn * C;
#pragma unroll
  for (int r = 0; r < 16; ++r) p0[r] = fmaf(p0[r], C, mnC);
#pragma unroll
  for (int r = 0; r < 16; ++r) p1[r] = fmaf(p1[r], C, mnC);
#pragma unroll
  for (int r = 0; r < 16; ++r) p0[r] = __builtin_amdgcn_exp2f(p0[r]);
}
__device__ __forceinline__ void finishSM(f32x16& p0, f32x16& p1, float alpha, float& l_reg, bf16x8& pa0, bf16x8& pa1, bf16x8& pa2, bf16x8& pa3) {
#pragma unroll
  for (int r = 0; r < 16; ++r) p1[r] = __builtin_amdgcn_exp2f(p1[r]);
  float ps = 0;
#pragma unroll
  for (int r = 0; r < 16; ++r) ps += p0[r];
#pragma unroll
  for (int r = 0; r < 16; ++r) ps += p1[r];
  { auto rr = __builtin_amdgcn_permlane32_swap(__float_as_uint(ps), __float_as_uint(ps), false, false);
    ps = __uint_as_float(rr[0]) + __uint_as_float(rr[1]); }
  l_reg = l_reg * alpha + ps;
#define PK4(P, BASE, OUT) do { unsigned a0 = cvtpk(P[BASE + 0], P[BASE + 1]), a1 = cvtpk(P[BASE + 2], P[BASE + 3]);   \
    unsigned b0 = cvtpk(P[BASE + 4], P[BASE + 5]), b1 = cvtpk(P[BASE + 6], P[BASE + 7]);                              \
    auto r0 = __builtin_amdgcn_permlane32_swap(a0, b0, false, false); auto r1 = __builtin_amdgcn_permlane32_swap(a1, b1, false, false); \
    u32x4 w = {r0[0], r1[0], r0[1], r1[1]}; OUT = *reinterpret_cast<bf16x8*>(&w); } while (0)
  PK4(p0, 0, pa0); PK4(p0, 8, pa1); PK4(p1, 0, pa2); PK4(p1, 8, pa3);
#undef PK4
}
__device__ __forceinline__ void qkt(f32x16& p0, f32x16& p1, const char* Ks, const char* Rs, const bf16x8* qr, const char* qrl, int r32, int hi) {
  p0 = f32x16{}; p1 = f32x16{};
#pragma unroll
  for (int d0 = 0; d0 < 8; ++d0) { const int cb = (d0 * 16 + hi * 8) * 2;
    const bf16x8 b0 = *reinterpret_cast<const bf16x8*>(Ks + KSWZ(r32, cb));
    const bf16x8 b1 = *reinterpret_cast<const bf16x8*>(Ks + KSWZ(32 + r32, cb));
    p0 = __builtin_amdgcn_mfma_f32_32x32x16_bf16(b0, qr[d0], p0, 0, 0, 0);
    p1 = __builtin_amdgcn_mfma_f32_32x32x16_bf16(b1, qr[d0], p1, 0, 0, 0); }
#pragma unroll
  for (int d0 = 0; d0 < 4; ++d0) { const int cb = (d0 * 16 + hi * 8) * 2;
    const bf16x8 b0 = *reinterpret_cast<const bf16x8*>(Rs + RSWZ(r32, cb));
    const bf16x8 b1 = *reinterpret_cast<const bf16x8*>(Rs + RSWZ(32 + r32, cb));
    const bf16x8 qv = *reinterpret_cast<const bf16x8*>(qrl + d0 * 1024);
    p0 = __builtin_amdgcn_mfma_f32_32x32x16_bf16(b0, qv, p0, 0, 0, 0);
    p1 = __builtin_amdgcn_mfma_f32_32x32x16_bf16(b1, qv, p1, 0, 0, 0); }
}
__device__ __forceinline__ int v_st(int k, int c) { const int kk = (k & ~0xC) | ((k & 4) << 1) | ((k & 8) >> 1); return ((kk >> 3) * 4 + (c >> 5)) * 512 + ((kk & 7) * 32 + (c & 31)) * 2; }
__device__ __forceinline__ int v_rd_base(int lane) { return ((lane & 3) << 3) | (((lane >> 2) & 3) << 6) | (((lane >> 4) & 1) << 5) | (((lane >> 5) & 1) << 8); }
constexpr int v_rd_off(int d0, int ks, int half) { return d0 * 512 + ks * 4096 + half * 2048; }
template <int OFF> __device__ __forceinline__ s16x4 tr_read(int vb) {
  s16x4 r; asm volatile("ds_read_b64_tr_b16 %0, %1 offset:%2" : "=&v"(r) : "v"(vb), "i"(OFF) : "memory"); return r;
}
template <int D0> __device__ __forceinline__ void pv_one(f32x16& od, int vb, bf16x8 pa0, bf16x8 pa1, bf16x8 pa2, bf16x8 pa3) {
  const s16x4 l0 = tr_read<v_rd_off(D0, 0, 0)>(vb), h0 = tr_read<v_rd_off(D0, 0, 1)>(vb), l1 = tr_read<v_rd_off(D0, 1, 0)>(vb), h1 = tr_read<v_rd_off(D0, 1, 1)>(vb);
  const s16x4 l2 = tr_read<v_rd_off(D0, 2, 0)>(vb), h2 = tr_read<v_rd_off(D0, 2, 1)>(vb), l3 = tr_read<v_rd_off(D0, 3, 0)>(vb), h3 = tr_read<v_rd_off(D0, 3, 1)>(vb);
  asm volatile("s_waitcnt lgkmcnt(0)" ::: "memory"); SBAR();
#define PK(L, H) (bf16x8){L[0], L[1], L[2], L[3], H[0], H[1], H[2], H[3]}
  od = __builtin_amdgcn_mfma_f32_32x32x16_bf16(pa0, PK(l0, h0), od, 0, 0, 0);
  od = __builtin_amdgcn_mfma_f32_32x32x16_bf16(pa1, PK(l1, h1), od, 0, 0, 0);
  od = __builtin_amdgcn_mfma_f32_32x32x16_bf16(pa2, PK(l2, h2), od, 0, 0, 0);
  od = __builtin_amdgcn_mfma_f32_32x32x16_bf16(pa3, PK(l3, h3), od, 0, 0, 0);
#undef PK
}
__device__ __forceinline__ void pv_d0(f32x16* o, int vb, bf16x8 pa0, bf16x8 pa1, bf16x8 pa2, bf16x8 pa3) {
  pv_one<0>(o[0], vb, pa0, pa1, pa2, pa3); pv_one<1>(o[1], vb, pa0, pa1, pa2, pa3); pv_one<2>(o[2], vb, pa0, pa1, pa2, pa3); pv_one<3>(o[3], vb, pa0, pa1, pa2, pa3);
}
__device__ __forceinline__ void attn_body(const bf16_t* __restrict__ Qb, const float* __restrict__ cs, const float* __restrict__ sn, const bf16_t* __restrict__ Kn,
                                          const bf16_t* __restrict__ Vh, const bf16_t* __restrict__ Kr, bf16_t* __restrict__ Ob, int seq, char* lds) {
  const int tid = otid(), wid = tid >> 6, lane = tid & 63, r32 = lane & 31, hi = lane >> 5;
  char* V_lds = lds; char* K_lds = lds + 2 * SHM_V; char* R_lds = lds + 2 * SHM_V + 2 * SHM_K;
  float* wsf = (float*)(lds + 2 * SHM_V + 2 * SHM_K + 2 * SHM_R) + wid * 64; float* li_l = wsf; float* al_l = wsf + 32;
  char* qrl = lds + 2 * SHM_V + 2 * SHM_K + 2 * SHM_R + 2048 + wid * 4096 + lane * 16;
  float m_reg = -1e30f, l_reg = 0; f32x16 o[4] = {}; bf16x8 qr[8];
  { const bf16_t* Qw = Qb + (size_t)(wid * QBLK + r32) * LDQ + hi * 8;
#pragma unroll
    for (int d0 = 0; d0 < 8; ++d0) qr[d0] = *(const bf16x8*)(Qw + d0 * 16);
#pragma unroll
    for (int d0 = 0; d0 < 2; ++d0) {
      const u32x4 a = *(const u32x4*)(Qw + 128 + d0 * 16), bq = *(const u32x4*)(Qw + 160 + d0 * 16);
      if (cs) {
        const float* cp = cs + (size_t)(wid * QBLK + r32) * 32 + d0 * 16 + hi * 8; const float* sp = sn + (size_t)(wid * QBLK + r32) * 32 + d0 * 16 + hi * 8;
        const f32x4 c0 = *(const f32x4*)cp, c1 = *(const f32x4*)(cp + 4), s0 = *(const f32x4*)sp, s1 = *(const f32x4*)(sp + 4);
        float x1[8], x2[8], y1[8], y2[8];
#pragma unroll
        for (int k = 0; k < 4; ++k) { x1[2 * k] = bflo(a[k]); x1[2 * k + 1] = bfhi(a[k]); x2[2 * k] = bflo(bq[k]); x2[2 * k + 1] = bfhi(bq[k]); }
#pragma unroll
        for (int k = 0; k < 8; ++k) { const float c = k < 4 ? c0[k & 3] : c1[k & 3], s = k < 4 ? s0[k & 3] : s1[k & 3]; y1[k] = x1[k] * c - x2[k] * s; y2[k] = x2[k] * c + x1[k] * s; }
        u32x4 w1 = {cvtpk(y1[0], y1[1]), cvtpk(y1[2], y1[3]), cvtpk(y1[4], y1[5]), cvtpk(y1[6], y1[7])}, w2 = {cvtpk(y2[0], y2[1]), cvtpk(y2[2], y2[3]), cvtpk(y2[4], y2[5]), cvtpk(y2[6], y2[7])};
        *(u32x4*)(qrl + d0 * 1024) = w1; *(u32x4*)(qrl + (2 + d0) * 1024) = w2;
      } else { *(u32x4*)(qrl + d0 * 1024) = a; *(u32x4*)(qrl + (2 + d0) * 1024) = bq; }
    } }
  const int sr = tid >> 4, sc = (tid & 15) * 8, vst0 = v_st(sr, sc), vst1 = v_st(32 + sr, sc);
  const int rr_ = tid >> 3, rc = (tid & 7) * 8;
  const int vb0 = (int)(uintptr_t)V_lds + v_rd_base(lane);
  bf16x8 vs0, vs1, ks0, ks1, rs0;
  const unsigned voffKV = (unsigned)(sr * LDK + sc) * 2u, voffR = (unsigned)(rr_ * LDKR + rc) * 2u;
#define SLOAD(k0) do { const char* kb_ = (const char*)Kn + (size_t)(k0) * (LDK * 2); const char* vb_ = (const char*)Vh + (size_t)(k0) * (LDK * 2); \
    vs0 = *(const bf16x8*)(vb_ + voffKV); vs1 = *(const bf16x8*)(vb_ + 32 * LDK * 2 + voffKV); \
    ks0 = *(const bf16x8*)(kb_ + voffKV); ks1 = *(const bf16x8*)(kb_ + 32 * LDK * 2 + voffKV); \
    rs0 = *(const bf16x8*)((const char*)Kr + (size_t)(k0) * (LDKR * 2) + voffR); } while (0)
#define SWRITE(b) do { *(bf16x8*)(V_lds + (b) * SHM_V + vst0) = vs0; *(bf16x8*)(V_lds + (b) * SHM_V + vst1) = vs1; const int kc = sc * 2;  \
    *(bf16x8*)(K_lds + (b) * SHM_K + KSWZ(sr, kc)) = ks0; *(bf16x8*)(K_lds + (b) * SHM_K + KSWZ(32 + sr, kc)) = ks1;                      \
    *(bf16x8*)(R_lds + (b) * SHM_R + RSWZ(rr_, rc * 2)) = rs0; } while (0)
#define RESC(a) do { if (__any((a) < 1.f)) { if (hi == 0) al_l[r32] = (a); asm volatile("s_waitcnt lgkmcnt(0)" ::: "memory"); \
    _Pragma("unroll") for (int d = 0; d < 4; ++d) _Pragma("unroll") for (int r = 0; r < 16; ++r) o[d][r] *= al_l[crow(r, hi)]; } } while (0)
  f32x16 pA0, pA1, pB0, pB1; float mnA, mnB, alA, alB; bf16x8 pa0, pa1, pa2, pa3; const int NT = seq / KVBLK;
  SLOAD(0); SWRITE(0); __syncthreads();
  qkt(pA0, pA1, K_lds, R_lds, qr, qrl, r32, hi); partialSM(pA0, pA1, m_reg, mnA, alA);
  SLOAD(KVBLK); SWRITE(1); __syncthreads();
  for (int j = 1; j + 1 < NT; j += 2) {
    SBAR(); qkt(pB0, pB1, K_lds + SHM_K, R_lds + SHM_R, qr, qrl, r32, hi);
    finishSM(pA0, pA1, alA, l_reg, pa0, pa1, pa2, pa3); SBAR();
    SLOAD((j + 1) * KVBLK); SBAR();
    pv_d0(o, vb0, pa0, pa1, pa2, pa3); partialSM(pB0, pB1, m_reg, mnB, alB);
    __syncthreads(); SWRITE(0);
    RESC(alB); __syncthreads();
    SBAR(); qkt(pA0, pA1, K_lds, R_lds, qr, qrl, r32, hi);
    finishSM(pB0, pB1, alB, l_reg, pa0, pa1, pa2, pa3); SBAR();
    SLOAD((j + 2) * KVBLK); SBAR();
    pv_d0(o, vb0 + (int)SHM_V, pa0, pa1, pa2, pa3); partialSM(pA0, pA1, m_reg, mnA, alA);
    __syncthreads(); SWRITE(1);
    RESC(alA); __syncthreads();
  }
  SBAR(); qkt(pB0, pB1, K_lds + SHM_K, R_lds + SHM_R, qr, qrl, r32, hi);
  finishSM(pA0, pA1, alA, l_reg, pa0, pa1, pa2, pa3); SBAR();
  pv_d0(o, vb0, pa0, pa1, pa2, pa3); partialSM(pB0, pB1, m_reg, mnB, alB);
  __syncthreads(); RESC(alB);
  finishSM(pB0, pB1, alB, l_reg, pa0, pa1, pa2, pa3); SBAR();
  pv_d0(o, vb0 + (int)SHM_V, pa0, pa1, pa2, pa3);
  if (hi == 0) li_l[r32] = l_reg; asm volatile("s_waitcnt lgkmcnt(0)" ::: "memory");
  float rli[16];
#pragma unroll
  for (int r = 0; r < 16; ++r) rli[r] = __builtin_amdgcn_rcpf(li_l[crow(r, hi)]);
  bf16_t* Ow = Ob + (size_t)(wid * QBLK) * LDO;
#pragma unroll
  for (int r = 0; r < 16; ++r) { const int orow = crow(r, hi);
#pragma unroll
    for (int d0 = 0; d0 < 4; ++d0) Ow[(size_t)orow * LDO + d0 * 32 + r32] = f2bf(o[d0][r] * rli[r]); }
  __syncthreads();
#undef SLOAD
#undef SWRITE
#undef RESC
}
}

__device__ void phase_attn(PRef p, int l, char* smem) {
  const bf16_t* Q = (const bf16_t*)(p.ws + WS_Q); const bf16_t* KV = (const bf16_t*)(p.ws + WS_KV); const bf16_t* KR = (const bf16_t*)(p.ws + WS_KR);
  bf16_t* mix = (bf16_t*)(p.ws + WS_MIX); const float* cs = (const float*)(p.ws + WS_COS); const float* sn = (const float*)(p.ws + WS_SIN);
  const int nunits = 1024 + (l == 0 ? 32 : 0);
  for (int u = obid(); u < nunits; u += gridDim.x) {
    if (u < 1024) {
      const int qb = u & 31, hd = (u >> 5) & 3, b = u >> 7; const size_t row0 = (size_t)b * SEQ + qb * 256;
      att::attn_body(Q + row0 * 768 + hd * 192, cs + (size_t)qb * 256 * 32, sn + (size_t)qb * 256 * 32, KV + (size_t)b * SKV * 1024 + hd * 256,
                     KV + (size_t)b * SKV * 1024 + hd * 256 + 128, KR + (size_t)b * SKV * 64, mix + row0 * 1024 + 512 + hd * 128, SKV, smem);
    } else {
      const int v = u - 1024, hd = v & 3, b = v >> 2; const size_t row0 = (size_t)MX + b * CTXL;
      att::attn_body(Q + row0 * 768 + hd * 192, nullptr, nullptr, KV + (size_t)b * SKV * 1024 + hd * 256,
                     KV + (size_t)b * SKV * 1024 + hd * 256 + 128, KR + (size_t)b * SKV * 64, mix + row0 * 1024 + 512 + hd * 128, CTXL, smem);
    }
  }
}

__device__ void phase_outproj(PRef p, int l, char* smem) {
  LAS unsigned char* lds = (LAS unsigned char*)smem;
  const bf16_t* mix = (const bf16_t*)(p.ws + WS_MIX); const bf16_t* Wt = (const bf16_t*)(p.ws + WS_WOUT) + (size_t)l * 1024 * 1024;
  float* ctxz = (float*)(p.ws + WS_CTXZ);
  const int tid = otid(), wid = tid >> 6, lane = tid & 63, wr = wid >> 2, wc = wid & 3, fr = lane & 15, fq = lane >> 4;
  g8::TileIter it; it.init(l == 0 ? MT / 256 : MX / 256, 4);
  int pm, pn;
  while (it.next(pm, pn)) {
    unsigned voffA[2] = {g8::piece_off(0, 1024, 0), g8::piece_off(1, 1024, 0)};
    f32x4 acc[2][2][4][2];
    g8::gemm_tile<false>(lds, (const char*)(mix + (size_t)pm * 256 * 1024), voffA, (size_t)128 * 1024 * 2, (const char*)(Wt + (size_t)pn * 256 * 1024), 1024, acc);
    ACC_FOR(ai, bj, m, n) {
      const int row = pm * 256 + ai * 128 + wr * 64 + m * 16 + fr, col = pn * 256 + bj * 128 + wc * 32 + fq * 8 + n * 4;
      const float* res = l == 0 ? (row < MX ? p.x + (size_t)row * 1024 : p.ctx + (size_t)(row - MX) * 1024) : p.out + (size_t)row * 1024;
      float* dst = row < MX ? p.out + (size_t)row * 1024 : ctxz + (size_t)(row - MX) * 1024;
      const f32x4 r = *(const f32x4*)(res + col), g = *(const f32x4*)(mod_ptr(p, l, row, 2) + col);
      *(f32x4*)(dst + col) = r * ALPHA + g * acc[ai][bj][m][n];
    }
  }
}

__device__ void phase_ln1(PRef p, int l, char* smem) {
  float* wrt = (float*)smem;
  for (int i = otid(); i < 16384; i += 512) wrt[(i & 15) * 1024 + (i >> 4)] = p.w_router[(size_t)l * 16384 + i];
  __syncthreads();
  const int lane = otid() & 63, gw = obid() * 8 + (otid() >> 6), nw = gridDim.x * 8;
  bf16_t* h = (bf16_t*)(p.ws + WS_H); float* ctxz = (float*)(p.ws + WS_CTXZ); float* aff = (float*)(p.ws + WS_AFF);
  const int nrows = l == 0 ? MT : MX;
  for (int row = gw; row < nrows; row += nw) {
    asm volatile("" ::: "memory");
    float* zr = row < MX ? p.out + (size_t)row * 1024 : ctxz + (size_t)(row - MX) * 1024;
    f32x4 v[4];
#pragma unroll
    for (int i = 0; i < 4; ++i) v[i] = *(const f32x4*)(zr + lane * 4 + 256 * i);
    ln_row(v, 1e-5f);
#pragma unroll
    for (int i = 0; i < 4; ++i) { const int c = lane * 4 + 256 * i; v[i] = v[i] * *(const f32x4*)(p.ln1_g + l * 1024 + c) + *(const f32x4*)(p.ln1_b + l * 1024 + c); *(f32x4*)(zr + c) = v[i]; }
    ln_row(v, 1e-6f);
    f32x4 hm[4];
    store_mod_bf16(v, mod_ptr(p, l, row, 3), mod_ptr(p, l, row, 4), h + (size_t)row * 1024, lane, &hm);
    float lg[16];
#pragma unroll
    for (int e = 0; e < 16; ++e) { float s = 0.f;
#pragma unroll
      for (int i = 0; i < 4; ++i) { const f32x4 w = *(const f32x4*)(wrt + e * 1024 + lane * 4 + 256 * i); s += hm[i][0] * w[0] + hm[i][1] * w[1] + hm[i][2] * w[2] + hm[i][3] * w[3]; }
      lg[e] = wave_sum(s); }
    float mx = lg[0];
#pragma unroll
    for (int e = 1; e < 16; ++e) mx = fmaxf(mx, lg[e]);
    float den = 0.f;
#pragma unroll
    for (int e = 0; e < 16; ++e) { lg[e] = expf(lg[e] - mx); den += lg[e]; }
    float mine = 0.f;
#pragma unroll
    for (int e = 0; e < 16; ++e) if (lane == e) mine = lg[e] / den;
    if (lane < 16) aff[(size_t)row * 16 + lane] = mine;
  }
}

template <int PER>
__device__ __forceinline__ void topk_item(const float* __restrict__ affp, int n, int kcap, int rowbase, int slotbase, int e, int* __restrict__ IDX, float* __restrict__ GV, int* __restrict__ TS, char* smem) {
  unsigned* hist = (unsigned*)smem; unsigned* sel = hist + 256; unsigned* wtot = hist + 272;
  const int tid = otid(), lane = tid & 63, wid = tid >> 6;
  const bool active = tid * PER < n;
  unsigned key[PER];
#pragma unroll
  for (int i = 0; i < PER; ++i) key[i] = active ? __float_as_uint(affp[(size_t)(tid * PER + i) * 16]) : 0u;
  unsigned prefix = 0u, mask = 0u; int kk = kcap;
#pragma unroll 1
  for (int shift = 24; shift >= 0; shift -= 8) {
    __syncthreads();
    if (tid < 256) hist[tid] = 0u;
    __syncthreads();
#pragma unroll
    for (int i = 0; i < PER; ++i) if (active && (key[i] & mask) == prefix) atomicAdd(&hist[(key[i] >> shift) & 255u], 1u);
    __syncthreads();
    if (wid == 0) {
      const unsigned h0 = hist[lane * 4], h1 = hist[lane * 4 + 1], h2 = hist[lane * 4 + 2], h3 = hist[lane * 4 + 3];
      const unsigned tot = h0 + h1 + h2 + h3; unsigned suf = tot;
#pragma unroll
      for (int o = 1; o < 64; o <<= 1) { const unsigned u = __shfl_down(suf, o); if (lane + o < 64) suf += u; }
      const unsigned above = suf - tot;
      if (above < (unsigned)kk && suf >= (unsigned)kk) {
        unsigned a = above; int bin;
        if (a + h3 >= (unsigned)kk) bin = 3; else { a += h3; if (a + h2 >= (unsigned)kk) bin = 2; else { a += h2; if (a + h1 >= (unsigned)kk) bin = 1; else { a += h1; bin = 0; } } }
        sel[0] = prefix | ((unsigned)(lane * 4 + bin) << shift); sel[1] = (unsigned)kk - a;
      }
    }
    __syncthreads();
    prefix = sel[0]; kk = (int)sel[1]; mask |= 0xffu << shift;
  }
  const unsigned Tk = prefix;
  unsigned cg_ = 0, ce = 0;
#pragma unroll
  for (int i = 0; i < PER; ++i) { cg_ += key[i] > Tk; ce += key[i] == Tk; }
  unsigned pk = active ? (cg_ | (ce << 16)) : 0u, inc = pk;
#pragma unroll
  for (int o = 1; o < 64; o <<= 1) { const unsigned u = __shfl_up(inc, o); if (lane >= o) inc += u; }
  __syncthreads();
  if (lane == 63) wtot[wid] = inc;
  __syncthreads();
  unsigned base = 0;
  for (int w2 = 0; w2 < wid; ++w2) base += wtot[w2];
  const unsigned exc = base + inc - pk; unsigned gt_before = exc & 0xffffu, eq_before = exc >> 16;
  if (active) {
#pragma unroll
    for (int i = 0; i < PER; ++i) {
      const int t = tid * PER + i; int R = -1;
      const bool isgt = key[i] > Tk, iseq = key[i] == Tk;
      if (isgt || (iseq && (int)eq_before < kk)) {
        const int slot = (int)gt_before + min((int)eq_before, kk);
        R = slotbase + slot; IDX[R] = rowbase + t; GV[R] = __uint_as_float(key[i]);
      }
      TS[t] = R;
      gt_before += isgt; eq_before += iseq;
    }
  }
}
__device__ void phase_topk(PRef p, int l, char* smem) {
  const float* aff = (const float*)(p.ws + WS_AFF); int* IDX = (int*)(p.ws + WS_IDX); float* GV = (float*)(p.ws + WS_GV); int* TS = (int*)(p.ws + WS_TS);
  const int nitems = l == 0 ? 256 : 128;
  for (int it = obid(); it < nitems; it += gridDim.x) {
    if (it < 128) { const int b = it >> 4, e = it & 15; topk_item<16>(aff + (size_t)b * SEQ * 16 + e, SEQ, CAPX, b * SEQ, it * CAPX, e, IDX, GV, TS + (size_t)it * SEQ, smem); }
    else { const int v = it - 128, b = v >> 4, e = v & 15; topk_item<1>(aff + ((size_t)MX + b * CTXL) * 16 + e, CTXL, CAPC, MX + b * CTXL, NB * NE * CAPX + e * 256 + b * CAPC, e, IDX, GV, TS + (size_t)NB * 16 * SEQ + (size_t)v * CTXL, smem); }
  }
  __syncthreads();
}

__device__ void phase_moe_up(PRef p, int l, char* smem) {
  LAS unsigned char* lds = (LAS unsigned char*)smem;
  const bf16_t* h = (const bf16_t*)(p.ws + WS_H); const bf16_t* Wgu = (const bf16_t*)(p.ws + WS_WGU); bf16_t* act = (bf16_t*)(p.ws + WS_ACT); const int* IDX = (const int*)(p.ws + WS_IDX);
  const int tid = otid(), wid = tid >> 6, lane = tid & 63, wr = wid >> 2, wc = wid & 3, fr = lane & 15, fq = lane >> 4;
  g8::MoeIter it; it.init(8, l == 0);
  int pm, pn, e;
  while (it.next(pm, pn, e)) {
    unsigned voffA[4];
#pragma unroll
    for (int hh = 0; hh < 2; ++hh)
#pragma unroll
      for (int i = 0; i < 2; ++i) { int R, C; g8::piece_rc(i, R, C); voffA[hh * 2 + i] = (unsigned)(IDX[pm * 256 + hh * 128 + R] * 1024 + C) * 2u; }
    f32x4 acc[2][2][4][2];
    g8::gemm_tile<true>(lds, (const char*)h, voffA, 0, (const char*)(Wgu + ((size_t)e * 2048 + pn * 256) * 1024), 1024, acc);
#pragma unroll
    for (int ai = 0; ai < 2; ++ai)
#pragma unroll
      for (int m = 0; m < 4; ++m) {
          const int row = pm * 256 + ai * 128 + wr * 64 + m * 16 + fr, col = pn * 128 + wc * 32 + fq * 8;
          float a[8];
#pragma unroll
          for (int n = 0; n < 2; ++n) { const f32x4 g = acc[ai][0][m][n], u = acc[ai][1][m][n];
#pragma unroll
            for (int k = 0; k < 4; ++k) a[n * 4 + k] = silu_f(g[k]) * u[k]; }
          u32x4 w = {cvtpk(a[0], a[1]), cvtpk(a[2], a[3]), cvtpk(a[4], a[5]), cvtpk(a[6], a[7])}; *(u32x4*)(act + (size_t)row * 1024 + col) = w;
        }
  }
}
__device__ void phase_moe_down(PRef p, int l, char* smem) {
  LAS unsigned char* lds = (LAS unsigned char*)smem;
  const bf16_t* act = (const bf16_t*)(p.ws + WS_ACT); const bf16_t* Wdn = (const bf16_t*)(p.ws + WS_WDN); bf16_t* oute = (bf16_t*)(p.ws + WS_OUTE); const float* GV = (const float*)(p.ws + WS_GV);
  const int tid = otid(), wid = tid >> 6, lane = tid & 63, wr = wid >> 2, wc = wid & 3, fr = lane & 15, fq = lane >> 4;
  g8::MoeIter it; it.init(4, l == 0);
  int pm, pn, e;
  while (it.next(pm, pn, e)) {
    unsigned voffA[2] = {g8::piece_off(0, 1024, 0), g8::piece_off(1, 1024, 0)};
    f32x4 acc[2][2][4][2];
    g8::gemm_tile<false>(lds, (const char*)(act + (size_t)pm * 256 * 1024), voffA, (size_t)128 * 1024 * 2, (const char*)(Wdn + ((size_t)e * 1024 + pn * 256) * 1024), 1024, acc);
    ACC_FOR3(ai, bj, m) {
      const int row = pm * 256 + ai * 128 + wr * 64 + m * 16 + fr, col = pn * 256 + bj * 128 + wc * 32 + fq * 8;
      const float gv = GV[row]; const f32x4 v0 = acc[ai][bj][m][0] * gv, v1 = acc[ai][bj][m][1] * gv;
      u32x4 w = {cvtpk(v0[0], v0[1]), cvtpk(v0[2], v0[3]), cvtpk(v1[0], v1[1]), cvtpk(v1[2], v1[3])}; *(u32x4*)(oute + (size_t)row * 1024 + col) = w;
    }
  }
}

__device__ void phase_ln2(PRef p, int l) {
  const int lane = otid() & 63, gw = obid() * 8 + (otid() >> 6), nw = gridDim.x * 8;
  bf16_t* h = (bf16_t*)(p.ws + WS_H); float* ctxz = (float*)(p.ws + WS_CTXZ); const bf16_t* oute = (const bf16_t*)(p.ws + WS_OUTE); const int* TS = (const int*)(p.ws + WS_TS);
  const int nrows = l == 0 ? MT : MX;
  for (int row = gw; row < nrows; row += nw) {
    float* xr = row < MX ? p.out + (size_t)row * 1024 : ctxz + (size_t)(row - MX) * 1024;
    f32x4 mo[4];
#pragma unroll
    for (int i = 0; i < 4; ++i) mo[i] = (f32x4){0.f, 0.f, 0.f, 0.f};
    const int myR = lane < 16 ? (row < MX ? TS[((size_t)(row >> 13) * 16 + lane) * SEQ + (row & 8191)] : TS[(size_t)NB * 16 * SEQ + ((size_t)((row - MX) >> 8) * 16 + lane) * CTXL + ((row - MX) & 255)]) : -1;
    for (int e = 0; e < 16; ++e) { const int Rr = __shfl(myR, e);
      if (Rr >= 0) {
#pragma unroll
        for (int i = 0; i < 4; ++i) { const u32x2 w = *(const u32x2*)(oute + (size_t)Rr * 1024 + lane * 4 + 256 * i);
          mo[i][0] += bflo(w[0]); mo[i][1] += bfhi(w[0]); mo[i][2] += bflo(w[1]); mo[i][3] += bfhi(w[1]); } } }
    f32x4 v[4]; const float* m5 = mod_ptr(p, l, row, 5);
#pragma unroll
    for (int i = 0; i < 4; ++i) { const int c = lane * 4 + 256 * i; v[i] = *(const f32x4*)(xr + c) * ALPHA + *(const f32x4*)(m5 + c) * mo[i]; }
    ln_row(v, 1e-5f);
#pragma unroll
    for (int i = 0; i < 4; ++i) { const int c = lane * 4 + 256 * i; v[i] = v[i] * *(const f32x4*)(p.ln2_g + l * 1024 + c) + *(const f32x4*)(p.ln2_b + l * 1024 + c); *(f32x4*)(xr + c) = v[i]; }
    if (l + 1 < DEPTH) { ln_row(v, 1e-6f); store_mod_bf16(v, mod_ptr(p, l + 1, row, 0), mod_ptr(p, l + 1, row, 1), h + (size_t)row * 1024, lane, nullptr); }
  }
}

#if DBG_BAR
__device__ int g_phase_dummy;
#endif
__device__ __forceinline__ void gsync(cg::grid_group& grid, PRef p, int& phase) {
#if DBG_BAR
  int* flags = (int*)(p.ws + WS_END); int* err = flags + 1024;
  ++phase;
  if (otid() == 0) flags[obid()] = phase;
#endif
  asm volatile("s_waitcnt vmcnt(0) lgkmcnt(0)" ::: "memory");
  grid.sync();
#if DBG_BAR
  if (otid() < (int)gridDim.x) { if (flags[otid()] != phase) atomicAdd(err, 1); }
#endif
}
__device__ void dbg_dump_bf16(PRef p, size_t off) {
  const bf16_t* src = (const bf16_t*)(p.ws + off);
  for (size_t i = (size_t)obid() * 512 + otid(); i < (size_t)MX * 1024; i += (size_t)gridDim.x * 512) p.out[i] = bf2f(src[i]);
}
__global__ void __launch_bounds__(512) mega(Params p) {
  extern __shared__ __attribute__((aligned(16))) char smem[];
  cg::grid_group grid = cg::this_grid();
  int phase = 0;
#if DBG_BAR
  if (obid() == 0 && otid() == 0) ((int*)(kparams().ws + WS_END))[1024] = 0;
#endif
  phase_prep(kparams(), smem);
  gsync(grid, kparams(), phase);
  phase_h0(kparams());
  gsync(grid, kparams(), phase);
#pragma unroll 1
  for (int l = 0; l < DEPTH; ++l) {
#if DBG_STOP == 0
    dbg_dump_bf16(kparams(), WS_H); return;
#endif
#pragma unroll 1
    for (int rep = 0; rep < DBG_REP_INPROJ; ++rep) { phase_inproj(kparams(), l, smem); gsync(grid, kparams(), phase); }
#if DBG_STOP == 1
    dbg_dump_bf16(kparams(), WS_P); return;
#endif
#if DBG_STOP == 12
    dbg_dump_bf16(kparams(), WS_P + (size_t)23000 * PLD * 2); return;
#endif
#if DBG_STOP == 11
    { PRef q = kparams(); const float* gsrc = (const float*)(q.ws + WS_GATES); const bf16_t* ps = (const bf16_t*)(q.ws + WS_P);
      for (size_t i = (size_t)obid() * 512 + otid(); i < (size_t)MX * 1024; i += (size_t)gridDim.x * 512)
        q.out[i] = i < (size_t)MT * 16 ? gsrc[i] : bf2f(ps[(size_t)MT * PLD - 1 - (i - (size_t)MT * 16)]); }
    return;
#endif
#if DBG_STOP == 24
#pragma unroll 1
    for (int rep = 0; rep < 2; ++rep) { phase_mlstm(kparams(), l, smem, opaque_s(rep) ? WS_Q : WS_HB); gsync(grid, kparams(), phase); }
    { PRef q = kparams(); const bf16_t* a = (const bf16_t*)(q.ws + WS_HB); const bf16_t* b2 = (const bf16_t*)(q.ws + WS_Q);
      for (size_t i = (size_t)obid() * 512 + otid(); i < (size_t)MX * 1024; i += (size_t)gridDim.x * 512) q.out[i] = bf2f(a[i]) - bf2f(b2[i]); }
    return;
#else
#pragma unroll 1
    for (int rep = 0; rep < DBG_REP_MLSTM; ++rep) { phase_mlstm(kparams(), l, smem); gsync(grid, kparams(), phase); }
#endif
#if DBG_STOP == 2
    dbg_dump_bf16(kparams(), WS_HB); return;
#endif
#if DBG_STOP == 23
    return;
#endif
#if DBG_STOP == 22
    { PRef q = kparams(); const int nerr = ((const int*)(q.ws + WS_END))[1024];
      for (size_t i = (size_t)obid() * 512 + otid(); i < (size_t)MX * 1024; i += (size_t)gridDim.x * 512) q.out[i] = i < 1024 ? 1000.f * (float)nerr : 0.f; }
    return;
#endif
    phase_mla_prep(kparams(), l, smem);
    gsync(grid, kparams(), phase);
#pragma unroll 1
    for (int rep = 0; rep < DBG_REP_ATTN; ++rep) { phase_attn(kparams(), l, smem); gsync(grid, kparams(), phase); }
#if DBG_STOP == 4
    dbg_dump_bf16(kparams(), WS_MIX); return;
#endif
    phase_outproj(kparams(), l, smem);
    gsync(grid, kparams(), phase);
    phase_ln1(kparams(), l, smem);
    __syncthreads();
#pragma unroll 1
    for (int rep = 0; rep < DBG_REP_CVT; ++rep) phase_cvt_experts(kparams(), l, smem);
    gsync(grid, kparams(), phase);
#if DBG_STOP == 6
    if (l == 0) return;
#endif
    phase_topk(kparams(), l, smem);
    gsync(grid, kparams(), phase);
#pragma unroll 1
    for (int rep = 0; rep < DBG_REP_MOE; ++rep) {
    phase_moe_up(kparams(), l, smem);
    gsync(grid, kparams(), phase);
    phase_moe_down(kparams(), l, smem);
    gsync(grid, kparams(), phase);
    }
    phase_ln2(kparams(), l);
    gsync(grid, kparams(), phase);
#if DBG_STOP == 10
    if (l == 0) return;
#endif
  }
}

extern "C" void kernel_launch(void* const* d_in, const int* in_sizes, int n_in, void* d_out, int out_size,
                              void* d_ws, size_t ws_size, hipStream_t stream) {
  constexpr size_t kDynLds = 160 * 1024;
  static int grid_blocks = 0;
  if (!grid_blocks) {
    int dev = 0, cus = 0, per_cu = 0;
    (void)hipGetDevice(&dev);
    (void)hipDeviceGetAttribute(&cus, hipDeviceAttributeMultiprocessorCount, dev);
    (void)hipFuncSetAttribute((const void*)mega, hipFuncAttributeMaxDynamicSharedMemorySize, (int)kDynLds);
    (void)hipOccupancyMaxActiveBlocksPerMultiprocessor(&per_cu, mega, 512, kDynLds);
    grid_blocks = per_cu > 0 ? cus : 0;
    if (grid_blocks > 256) grid_blocks = 256;
    grid_blocks &= ~7;
    if (grid_blocks != 256) { fprintf(stderr, "this kernel needs 256 co-resident workgroups (got %d)\n", grid_blocks); grid_blocks = 0; }
    if (ws_size < WS_END) { fprintf(stderr, "workspace too small: %zu < %zu\n", ws_size, (size_t)WS_END); grid_blocks = 0; }
  }
  if (grid_blocks <= 0) return;
  Params p{};
  const float** pp = (const float**)&p;
  for (int i = 0; i < 24; ++i) pp[i] = (const float*)d_in[i];
  p.out = (float*)d_out; p.ws = (char*)d_ws;
  void* args[] = {&p};
  hipError_t e = hipLaunchCooperativeKernel((void*)mega, dim3(grid_blocks), dim3(512), args, kDynLds, stream);
  if (e != hipSuccess) fprintf(stderr, "cooperative launch failed: %s (grid %d)\n", hipGetErrorString(e), grid_blocks);
}
```

```cpp
#include <hip/hip_runtime.h>
#include <hip/hip_cooperative_groups.h>
#include <cstdio>
#include <cstdint>
namespace cg = cooperative_groups;
#ifndef DBG_BAR
#define DBG_BAR 0
#endif
#ifndef DBG_REP_MLSTM
#define DBG_REP_MLSTM 1
#endif
#ifndef DBG_REP_ATTN
#define DBG_REP_ATTN 1
#endif
#ifndef DBG_REP_MOE
#define DBG_REP_MOE 1
#endif
#ifndef DBG_REP_INPROJ
#define DBG_REP_INPROJ 1
#endif
#ifndef DBG_REP_CVT
#define DBG_REP_CVT 1
#endif
#ifndef DBG_STOP
#define DBG_STOP 99
#endif

typedef unsigned short bf16_t;
typedef short bf16x8 __attribute__((ext_vector_type(8)));
typedef short s16x4 __attribute__((ext_vector_type(4)));
typedef float f32x4 __attribute__((ext_vector_type(4)));
typedef float f32x16 __attribute__((ext_vector_type(16)));
typedef unsigned u32x4 __attribute__((ext_vector_type(4)));
typedef unsigned u32x2 __attribute__((ext_vector_type(2)));
#define LAS __attribute__((address_space(3)))

constexpr int DM = 1024, NB = 8, SEQ = 8192, CTXL = 256, DEPTH = 2;
constexpr int MX = NB * SEQ, MC = NB * CTXL, MT = MX + MC;
constexpr int PLD = 2816;
constexpr int OFF_Q = 0, OFF_K = 512, OFF_V = 1024, OFF_O = 1536, OFF_G = 2048, OFF_CQ = 2064, OFF_CKV = 2448, OFF_KR = 2704, IN_COLS = 2768;
constexpr int SKV = SEQ + CTXL;
constexpr int NE = 16, CAPX = 1024, CAPC = 32;
constexpr int NSLOT = NB * NE * CAPX + NB * NE * CAPC;
constexpr float ALPHA = 1.4142135623730951f;
constexpr float A_SCALE = 0.07216878364870322f;

constexpr size_t al256(size_t v) { return (v + 255) / 256 * 256; }
constexpr size_t WS_H = 0;
constexpr size_t WS_P = WS_H + al256((size_t)MT * 1024 * 2);
constexpr size_t WS_Q = WS_P + al256((size_t)MT * PLD * 2);
constexpr size_t WS_KV = WS_Q + al256((size_t)MT * 768 * 2);
constexpr size_t WS_KR = WS_KV + al256((size_t)NB * SKV * 1024 * 2);
constexpr size_t WS_MIX = WS_KR + al256((size_t)NB * SKV * 64 * 2);
constexpr size_t WS_ACT = WS_P;
constexpr size_t WS_HB = WS_H;
constexpr size_t WS_OUTE = WS_P + al256((size_t)NSLOT * 1024 * 2);
constexpr size_t WS_WGU = WS_MIX;
constexpr size_t WS_WDN = WS_MIX + (size_t)NE * 2048 * 1024 * 2;
constexpr size_t WS_WIN = WS_MIX + al256((size_t)MT * 1024 * 2);
constexpr size_t WS_WUQ = WS_WIN + (size_t)2 * PLD * 1024 * 2;
constexpr size_t WS_WUKV = WS_WUQ + (size_t)2 * 768 * 384 * 2;
constexpr size_t WS_WOUT = WS_WUKV + (size_t)2 * 1024 * 256 * 2;
constexpr size_t WS_MOD = WS_WOUT + (size_t)2 * 1024 * 1024 * 2;
constexpr size_t WS_COS = WS_MOD + al256((size_t)2 * 9 * 6144 * 4);
constexpr size_t WS_SIN = WS_COS + (size_t)SEQ * 32 * 4;
constexpr size_t WS_GATES = WS_SIN + (size_t)SEQ * 32 * 4;
constexpr size_t WS_AFF = WS_GATES + (size_t)MT * 16 * 4;
constexpr size_t WS_IDX = WS_AFF + (size_t)MT * 16 * 4;
constexpr size_t WS_GV = WS_IDX + (size_t)NSLOT * 4;
constexpr size_t WS_TS = WS_GV + (size_t)NSLOT * 4;
constexpr size_t WS_CTXZ = WS_TS + (size_t)MT * 16 * 4;
constexpr size_t WS_END = WS_CTXZ + (size_t)MC * 1024 * 4;
static_assert(WS_OUTE + (size_t)NSLOT * 1024 * 2 <= WS_KR, "out_e overlay");
static_assert(WS_WDN + (size_t)NE * 1024 * 1024 * 2 <= WS_WIN, "expert weights overlay");

struct Params {
  const float *x, *c, *ctx, *c_ctx, *w_mod, *b_mod, *w_in, *b_gates, *conv_w, *conv_b, *m_norm_w, *q_norm_w, *kv_norm_w, *w_uq, *w_ukv, *w_out,
      *ln1_g, *ln1_b, *w_router, *w_gate, *w_up, *w_down, *ln2_g, *ln2_b;
  float* out; char* ws;
};

typedef const __attribute__((address_space(4))) Params& PRef;
__device__ __forceinline__ PRef kparams() { const __attribute__((address_space(4))) Params* kp = (const __attribute__((address_space(4))) Params*)__builtin_amdgcn_kernarg_segment_ptr(); asm volatile("" : "+s"(kp)); return *kp; }
__device__ __forceinline__ int otid() { int t = threadIdx.x; asm volatile("" : "+v"(t)); return t; }
__device__ __forceinline__ int obid() { int t = blockIdx.x; asm volatile("" : "+s"(t)); return t; }
__device__ __forceinline__ int opaque_s(int v) { asm volatile("" : "+s"(v)); return v; }
typedef __bf16 bf16v2_t __attribute__((ext_vector_type(2)));
typedef float f32x2_t __attribute__((ext_vector_type(2)));
__device__ __forceinline__ unsigned cvtpk(float lo, float hi) { const f32x2_t f = {lo, hi}; const bf16v2_t b = __builtin_convertvector(f, bf16v2_t); return __builtin_bit_cast(unsigned, b); }
__device__ __forceinline__ bf16_t f2bf(float v) { return (bf16_t)(cvtpk(v, v) & 0xffffu); }
__device__ __forceinline__ float bf2f(unsigned v) { return __uint_as_float(v << 16); }
__device__ __forceinline__ float bflo(unsigned w) { return __uint_as_float(w << 16); }
__device__ __forceinline__ float bfhi(unsigned w) { return __uint_as_float(w & 0xffff0000u); }
__device__ __forceinline__ float wave_sum(float v) { for (int o = 32; o > 0; o >>= 1) v += __shfl_xor(v, o); return v; }
__device__ __forceinline__ float wave_max(float v) { for (int o = 32; o > 0; o >>= 1) v = fmaxf(v, __shfl_xor(v, o)); return v; }
__device__ __forceinline__ float sigmoid_f(float v) { return __builtin_amdgcn_rcpf(1.f + __expf(-v)); }
__device__ __forceinline__ float silu_f(float v) { return v * sigmoid_f(v); }

namespace g8 {
constexpr int BK = 64, HALF = 128, HTB = HALF * BK * 2, STAGE_BYTES = 8 * HTB;
__device__ __forceinline__ int lds_byte(int r, int c) { const int st = (r >> 4) * 2 + (c >> 5), rr = r & 15, cc = c & 31, ob = rr * 64 + cc * 2; return st * 1024 + (ob ^ (((ob >> 9) & 1) << 5)); }
__device__ __forceinline__ int perm32(int rho) { const int n = rho >> 4, i = rho & 15; return 8 * (i >> 2) + 4 * n + (i & 3); }
__device__ __forceinline__ void stage_rc(int b, int& R, int& C) { const int st = b / 1024, sb = b % 1024, swz = sb ^ (((sb >> 9) & 1) << 5); R = (st >> 1) * 16 + swz / 64; C = (st & 1) * 32 + (swz % 64) / 2; }

template <bool GATHER>
__device__ __forceinline__ void gemm_tile(LAS unsigned char* lds, const char* __restrict__ Ab, const unsigned (&voffA)[GATHER ? 4 : 2], size_t hstepA, const char* __restrict__ Bb, int K,
                                          f32x4 (&acc)[2][2][4][2]) {
  const int tid = otid(), wid = __builtin_amdgcn_readfirstlane(tid >> 6), lane = tid & 63, wr = wid >> 2, wc = wid & 3, fr = lane & 15, fq = lane >> 4;
  const int nt = K / BK;
  unsigned voffB[2];
#pragma unroll
  for (int i = 0; i < 2; ++i) { int R, C; stage_rc(tid * 16 + i * 8192, R, C); const int Rb = (R & ~31) + perm32(R & 31); voffB[i] = (unsigned)(Rb * K + C) * 2u; }
  const char* Bb1 = Bb + (size_t)HALF * K * 2; const char* Ab1 = GATHER ? Ab : Ab + hstepA;
  const unsigned* vA0 = &voffA[0]; const unsigned* vA1 = GATHER ? &voffA[2] : &voffA[0];
  const unsigned ldsw = (unsigned)wid * 1024u;
  const int aoff = lds_byte(wr * 64 + fr, fq * 8), boff = lds_byte(wc * 32 + fr, fq * 8);
#define G8_SA(b, h) (((b) * 2 + (h)) * HTB)
#define G8_SB(b, h) ((4 + (b) * 2 + (h)) * HTB)
#define G8_STAGE(bufoff, gbase, voff, kt) do { _Pragma("unroll") for (int _i = 0; _i < 2; ++_i) \
    __builtin_amdgcn_global_load_lds((const unsigned*)((gbase) + (size_t)(kt) * (BK * 2) + (voff)[_i]), (LAS unsigned*)(lds + (bufoff) + ldsw + _i * 8192), 16, 0, 0); } while (0)
#define G8_LDA(dst, b, h) do { _Pragma("unroll") for (int m = 0; m < 4; ++m) _Pragma("unroll") for (int k = 0; k < 2; ++k) dst[m][k] = *(const LAS bf16x8*)(lds + G8_SA(b, h) + aoff + m * 2048 + k * 1024); } while (0)
#define G8_LDB(dst, b, h) do { _Pragma("unroll") for (int n = 0; n < 2; ++n) _Pragma("unroll") for (int k = 0; k < 2; ++k) dst[n][k] = *(const LAS bf16x8*)(lds + G8_SB(b, h) + boff + n * 2048 + k * 1024); } while (0)
#define G8_MMA(ai, bj, At, Bt) do { __builtin_amdgcn_s_setprio(1); _Pragma("unroll") for (int m = 0; m < 4; ++m) _Pragma("unroll") for (int n = 0; n < 2; ++n) _Pragma("unroll") for (int k = 0; k < 2; ++k) \
    acc[ai][bj][m][n] = __builtin_amdgcn_mfma_f32_16x16x32_bf16(Bt[n][k], At[m][k], acc[ai][bj][m][n], 0, 0, 0); __builtin_amdgcn_s_setprio(0); } while (0)
#define G8_WAIT_V(n) asm volatile("s_waitcnt vmcnt(" #n ")" ::: "memory")
#define G8_WAIT_L(n) asm volatile("s_waitcnt lgkmcnt(" #n ")" ::: "memory")
#define G8_BAR __builtin_amdgcn_s_barrier()
#define G8_SCHED __builtin_amdgcn_sched_barrier(0)
#pragma unroll
  for (int a = 0; a < 2; ++a)
#pragma unroll
    for (int b = 0; b < 2; ++b)
#pragma unroll
      for (int m = 0; m < 4; ++m)
#pragma unroll
        for (int n = 0; n < 2; ++n) acc[a][b][m][n] = (f32x4){0.f, 0.f, 0.f, 0.f};
  bf16x8 At[4][2], B0[2][2], B1[2][2];
  G8_WAIT_V(0); __syncthreads();
  G8_STAGE(G8_SB(0, 0), Bb, voffB, 0); G8_STAGE(G8_SA(0, 0), Ab, vA0, 0); G8_STAGE(G8_SB(0, 1), Bb1, voffB, 0); G8_STAGE(G8_SA(0, 1), Ab1, vA1, 0);
  if (wr == 1) G8_BAR;
  G8_WAIT_V(4); G8_BAR;
  G8_STAGE(G8_SB(1, 0), Bb, voffB, 1); G8_STAGE(G8_SA(1, 0), Ab, vA0, 1); G8_STAGE(G8_SB(1, 1), Bb1, voffB, 1);
  G8_WAIT_V(6); G8_BAR;
  for (int t = 0; t < nt - 2; t += 2) {
    G8_LDB(B0, 0, 0); G8_SCHED; G8_LDA(At, 0, 0); G8_STAGE(G8_SA(1, 1), Ab1, vA1, t + 1);
    G8_WAIT_L(8); G8_BAR; G8_WAIT_L(0); G8_MMA(0, 0, At, B0); G8_BAR; G8_SCHED;
    G8_LDB(B1, 0, 1); G8_STAGE(G8_SB(0, 0), Bb, voffB, t + 2);
    G8_BAR; G8_WAIT_L(0); G8_MMA(0, 1, At, B1); G8_BAR;
    G8_LDA(At, 0, 1); G8_STAGE(G8_SA(0, 0), Ab, vA0, t + 2);
    G8_BAR; G8_WAIT_L(0); G8_MMA(1, 0, At, B0); G8_BAR; G8_SCHED;
    G8_STAGE(G8_SB(0, 1), Bb1, voffB, t + 2);
    G8_WAIT_V(6); G8_BAR; G8_MMA(1, 1, At, B1); G8_BAR;
    G8_LDB(B0, 1, 0); G8_SCHED; G8_LDA(At, 1, 0); G8_STAGE(G8_SA(0, 1), Ab1, vA1, t + 2);
    G8_WAIT_L(8); G8_BAR; G8_WAIT_L(0); G8_MMA(0, 0, At, B0); G8_BAR; G8_SCHED;
    G8_LDB(B1, 1, 1); G8_STAGE(G8_SB(1, 0), Bb, voffB, t + 3);
    G8_BAR; G8_WAIT_L(0); G8_MMA(0, 1, At, B1); G8_BAR;
    G8_LDA(At, 1, 1); G8_STAGE(G8_SA(1, 0), Ab, vA0, t + 3);
    G8_BAR; G8_WAIT_L(0); G8_MMA(1, 0, At, B0); G8_BAR; G8_SCHED;
    G8_STAGE(G8_SB(1, 1), Bb1, voffB, t + 3);
    G8_WAIT_V(6); G8_BAR; G8_MMA(1, 1, At, B1); G8_BAR;
  }
  { G8_LDB(B0, 0, 0); G8_LDA(At, 0, 0); G8_STAGE(G8_SA(1, 1), Ab1, vA1, nt - 1);
    G8_BAR; G8_WAIT_L(0); G8_MMA(0, 0, At, B0); G8_BAR;
    G8_LDB(B1, 0, 1); G8_BAR; G8_WAIT_L(0); G8_MMA(0, 1, At, B1); G8_BAR;
    G8_LDA(At, 0, 1); G8_WAIT_V(4); G8_BAR; G8_WAIT_L(0); G8_MMA(1, 0, At, B0); G8_MMA(1, 1, At, B1); G8_BAR; }
  { G8_LDB(B0, 1, 0); G8_LDA(At, 1, 0); G8_WAIT_V(2); G8_BAR; G8_WAIT_L(0); G8_MMA(0, 0, At, B0); G8_BAR;
    G8_LDB(B1, 1, 1); G8_WAIT_V(0); G8_BAR; G8_WAIT_L(0); G8_MMA(0, 1, At, B1); G8_BAR;
    G8_LDA(At, 1, 1); G8_BAR; G8_WAIT_L(0); G8_MMA(1, 0, At, B0); G8_MMA(1, 1, At, B1); G8_BAR; }
  if (wr == 0) G8_BAR;
}
__device__ __forceinline__ unsigned piece_off(int i, int ld, int c0) { int R, C; stage_rc((int)otid() * 16 + i * 8192, R, C); return (unsigned)(R * ld + c0 + C) * 2u; }
__device__ __forceinline__ void piece_rc(int i, int& R, int& C) { stage_rc((int)otid() * 16 + i * 8192, R, C); }
struct TileIter {
  int nM, nN, x, j, J, cnt, idx;
  __device__ __forceinline__ void init(int nM_, int nN_) { nM = nM_; nN = nN_; x = obid() & 7; j = obid() >> 3; J = gridDim.x >> 3; cnt = ((nM - x + 7) >> 3) * nN; idx = j; }
  __device__ __forceinline__ bool next(int& pm, int& pn) { if (idx >= cnt) return false; pm = x + 8 * (idx / nN); pn = idx % nN; idx += J; return true; }
};
struct MoeIter {
  int nN, x, jm, jn, j, step, nsteps, nb4; bool with_ctx, ctx_done;
  __device__ __forceinline__ void init(int nN_, bool with_ctx_) { nN = nN_; with_ctx = with_ctx_; x = obid() & 7; j = obid() >> 3; jm = j & 7; jn = j >> 3; nb4 = nN >> 2; nsteps = 2 * nb4 * 4; step = 0; ctx_done = false; }
  __device__ __forceinline__ bool next(int& pm, int& pn, int& e) {
    if (step < nsteps) { const int mb = step & 3, nb = (step >> 2) % nb4, el = (step >> 2) / nb4; e = 2 * x + el; const int m32 = mb * 8 + jm; pm = ((m32 >> 2) * 16 + e) * 4 + (m32 & 3); pn = nb * 4 + jn; ++step; return true; }
    if (with_ctx && !ctx_done) { ctx_done = true; if (j < 2 * nN) { e = 2 * x + j / nN; pm = 512 + e; pn = j % nN; return true; } }
    return false;
  }
};
}

#define ACC_FOR3(ai, bj, m) _Pragma("unroll") for (int ai = 0; ai < 2; ++ai) _Pragma("unroll") for (int bj = 0; bj < 2; ++bj) _Pragma("unroll") for (int m = 0; m < 4; ++m)
#define ACC_FOR(ai, bj, m, n) _Pragma("unroll") for (int ai = 0; ai < 2; ++ai) _Pragma("unroll") for (int bj = 0; bj < 2; ++bj) _Pragma("unroll") for (int m = 0; m < 4; ++m) _Pragma("unroll") for (int n = 0; n < 2; ++n)

__device__ __forceinline__ void cvt_tile(const float* __restrict__ src, int N, int K, int k0, int n0, bf16_t* __restrict__ dst, long drow0, const float* __restrict__ kscale, float* lds) {
  const int tid = otid();
  { const int kr = tid >> 6, n = tid & 63;
#pragma unroll
    for (int i = 0; i < 8; ++i) { const int k = kr + 8 * i; float v = (n0 + n < N) ? src[(size_t)(k0 + k) * N + n0 + n] : 0.f; if (kscale) v *= kscale[k0 + k]; lds[k * 65 + n] = v; } }
  __syncthreads();
  { const int n = tid >> 3, k8 = (tid & 7) * 8; float v[8];
#pragma unroll
    for (int i = 0; i < 8; ++i) v[i] = lds[(k8 + i) * 65 + n];
    u32x4 w = {cvtpk(v[0], v[1]), cvtpk(v[2], v[3]), cvtpk(v[4], v[5]), cvtpk(v[6], v[7])};
    *(u32x4*)(dst + (size_t)(drow0 + n) * K + k0 + k8) = w; }
  __syncthreads();
}

__device__ void phase_prep(PRef p, char* smem) {
  float* lds = (float*)smem;
  bf16_t* Wt_in = (bf16_t*)(p.ws + WS_WIN); bf16_t* Wt_uq = (bf16_t*)(p.ws + WS_WUQ); bf16_t* Wt_ukv = (bf16_t*)(p.ws + WS_WUKV); bf16_t* Wt_out = (bf16_t*)(p.ws + WS_WOUT);
  float* mod = (float*)(p.ws + WS_MOD);
  constexpr int T_MOD = 192, T_IN = 2 * 16 * 44, T_UQ = 2 * 6 * 12, T_UKV = 2 * 4 * 16, T_OUT = 2 * 16 * 16, T_ROPE = 64;
  constexpr int E0 = T_MOD, E1 = E0 + T_IN, E2 = E1 + T_UQ, E3 = E2 + T_UKV, E4 = E3 + T_OUT, E5 = E4 + T_ROPE;
  const int tid = otid();
  for (int task = obid(); task < E5; task += gridDim.x) {
    if (task < E0) {
      const int l = task / 96, j0 = (task % 96) * 64;
      float* sc = lds;
      for (int i = tid; i < 9 * 1024; i += 512) { const int bb = i >> 10, d = i & 1023; const float v = bb < 8 ? p.c[bb * 1024 + d] : p.c_ctx[d]; sc[i] = v / (1.f + expf(-v)); }
      __syncthreads();
      const int col = tid & 63, ks = tid >> 6; float a[9];
#pragma unroll
      for (int bb = 0; bb < 9; ++bb) a[bb] = 0.f;
      const float* wm = p.w_mod + (size_t)l * 1024 * 6144 + j0 + col;
      for (int d = ks * 128; d < ks * 128 + 128; ++d) { const float w = wm[(size_t)d * 6144];
#pragma unroll
        for (int bb = 0; bb < 9; ++bb) a[bb] += sc[bb * 1024 + d] * w; }
      float* red = lds + 9 * 1024;
#pragma unroll
      for (int bb = 0; bb < 9; ++bb) red[(ks * 9 + bb) * 64 + col] = a[bb];
      __syncthreads();
      for (int i = tid; i < 9 * 64; i += 512) { const int bb = i >> 6, cc = i & 63; float s = 0.f;
        for (int k = 0; k < 8; ++k) s += red[(k * 9 + bb) * 64 + cc];
        mod[((size_t)l * 9 + bb) * 6144 + j0 + cc] = s + p.b_mod[l * 6144 + j0 + cc]; }
      __syncthreads();
    } else if (task < E1) { const int t = task - E0, l = t / 704, r = t % 704, kt = r / 44, nt = r % 44;
      cvt_tile(p.w_in + (size_t)l * 1024 * IN_COLS, IN_COLS, 1024, kt * 64, nt * 64, Wt_in + (size_t)l * PLD * 1024, nt * 64, nullptr, lds);
    } else if (task < E2) { const int t = task - E1, l = t / 72, r = t % 72, kt = r / 12, nt = r % 12;
      cvt_tile(p.w_uq + (size_t)l * 384 * 768, 768, 384, kt * 64, nt * 64, Wt_uq + (size_t)l * 768 * 384, nt * 64, p.q_norm_w + l * 384, lds);
    } else if (task < E3) { const int t = task - E2, l = t / 64, r = t % 64, kt = r / 16, nt = r % 16;
      cvt_tile(p.w_ukv + (size_t)l * 256 * 1024, 1024, 256, kt * 64, nt * 64, Wt_ukv + (size_t)l * 1024 * 256, nt * 64, p.kv_norm_w + l * 256, lds);
    } else if (task < E4) { const int t = task - E3, l = t / 256, r = t % 256, kt = r / 16, nt = r % 16;
      cvt_tile(p.w_out + (size_t)l * 1024 * 1024, 1024, 1024, kt * 64, nt * 64, Wt_out + (size_t)l * 1024 * 1024, nt * 64, nullptr, lds);
    } else {
      float* cs = (float*)(p.ws + WS_COS); float* sn = (float*)(p.ws + WS_SIN);
      for (int i = (task - E4) * 4096 + tid; i < (task - E4 + 1) * 4096; i += 512) { const int t = i >> 5, j = i & 31;
        const float inv = exp2f(-(float)(j & 15) * (13.287712379549449f / 16.f));
        const float pos = (float)(j < 16 ? (t >> 6) : (t & 63)); const float ang = pos * inv;
        const double a = (double)ang; const double k = rint(a * 0.15915494309189535); const float r = (float)(a - k * 6.283185307179586);
        cs[i] = __cosf(r); sn[i] = __sinf(r); }
    }
  }
}

__device__ void phase_cvt_experts(PRef p, int l, char* smem) {
  float* lds = (float*)smem;
  bf16_t* Wgu = (bf16_t*)(p.ws + WS_WGU); bf16_t* Wdn = (bf16_t*)(p.ws + WS_WDN);
  for (int task = obid(); task < NE * 768; task += gridDim.x) {
    const int e = task / 768, r = task % 768, which = r >> 8, kt = (r & 255) >> 4, nt = r & 15, n0 = nt * 64;
    const size_t eo = ((size_t)l * NE + e) * 1024 * 1024;
    if (which == 0) cvt_tile(p.w_gate + eo, 1024, 1024, kt * 64, n0, Wgu + (size_t)e * 2048 * 1024, (n0 >> 7) * 256 + (n0 & 127), nullptr, lds);
    else if (which == 1) cvt_tile(p.w_up + eo, 1024, 1024, kt * 64, n0, Wgu + (size_t)e * 2048 * 1024, (n0 >> 7) * 256 + 128 + (n0 & 127), nullptr, lds);
    else cvt_tile(p.w_down + eo, 1024, 1024, kt * 64, n0, Wdn + (size_t)e * 1024 * 1024, n0, nullptr, lds);
  }
}

__device__ __forceinline__ void ln_row(f32x4 (&v)[4], float eps) {
  float s = 0.f;
#pragma unroll
  for (int i = 0; i < 4; ++i) s += v[i][0] + v[i][1] + v[i][2] + v[i][3];
  const float mu = wave_sum(s) * (1.f / 1024.f);
  float q = 0.f;
#pragma unroll
  for (int i = 0; i < 4; ++i)
#pragma unroll
    for (int k = 0; k < 4; ++k) { v[i][k] -= mu; q += v[i][k] * v[i][k]; }
  const float rs = rsqrtf(wave_sum(q) * (1.f / 1024.f) + eps);
#pragma unroll
  for (int i = 0; i < 4; ++i) v[i] *= rs;
}
__device__ __forceinline__ void store_mod_bf16(const f32x4 (&v)[4], const float* __restrict__ shift, const float* __restrict__ scale, bf16_t* __restrict__ hrow, int lane, f32x4 (*keep)[4]) {
#pragma unroll
  for (int i = 0; i < 4; ++i) { const int c = lane * 4 + 256 * i; const f32x4 sh = *(const f32x4*)(shift + c), sc = *(const f32x4*)(scale + c);
    f32x4 o = v[i] * (sc + 1.f) + sh; if (keep) (*keep)[i] = o;
    u32x2 w = {cvtpk(o[0], o[1]), cvtpk(o[2], o[3])}; *(u32x2*)(hrow + c) = w; }
}
__device__ __forceinline__ const float* mod_ptr(PRef p, int l, int row, int which) {
  const int bb = row < MX ? (row >> 13) : 8;
  return (const float*)(p.ws + WS_MOD) + ((size_t)l * 9 + bb) * 6144 + which * 1024;
}

__device__ void phase_h0(PRef p) {
  const int lane = otid() & 63, gw = obid() * 8 + (otid() >> 6), nw = gridDim.x * 8;
  bf16_t* h = (bf16_t*)(p.ws + WS_H);
  for (int row = gw; row < MT; row += nw) {
    const float* src = row < MX ? p.x + (size_t)row * 1024 : p.ctx + (size_t)(row - MX) * 1024;
    f32x4 v[4];
#pragma unroll
    for (int i = 0; i < 4; ++i) v[i] = *(const f32x4*)(src + lane * 4 + 256 * i);
    ln_row(v, 1e-6f);
    store_mod_bf16(v, mod_ptr(p, 0, row, 0), mod_ptr(p, 0, row, 1), h + (size_t)row * 1024, lane, nullptr);
  }
}

__device__ void phase_inproj(PRef p, int l, char* smem) {
  LAS unsigned char* lds = (LAS unsigned char*)smem;
  const bf16_t* h = (const bf16_t*)(p.ws + WS_H); const bf16_t* Wt = (const bf16_t*)(p.ws + WS_WIN) + (size_t)l * PLD * 1024;
  bf16_t* P = (bf16_t*)(p.ws + WS_P); float* gates = (float*)(p.ws + WS_GATES);
  const int tid = otid(), wid = tid >> 6, lane = tid & 63, wr = wid >> 2, wc = wid & 3, fr = lane & 15, fq = lane >> 4;
  g8::TileIter it; it.init(MT / 256, PLD / 256);
  int pm, pn;
  while (it.next(pm, pn)) {
    unsigned voffA[2] = {g8::piece_off(0, 1024, 0), g8::piece_off(1, 1024, 0)};
    f32x4 acc[2][2][4][2];
    g8::gemm_tile<false>(lds, (const char*)(h + (size_t)pm * 256 * 1024), voffA, (size_t)128 * 1024 * 2, (const char*)(Wt + (size_t)pn * 256 * 1024), 1024, acc);
    ACC_FOR3(ai, bj, m) {
      const int row = pm * 256 + ai * 128 + wr * 64 + m * 16 + fr, col = pn * 256 + bj * 128 + wc * 32 + fq * 8;
      const f32x4 v0 = acc[ai][bj][m][0], v1 = acc[ai][bj][m][1];
      u32x4 w = {cvtpk(v0[0], v0[1]), cvtpk(v0[2], v0[3]), cvtpk(v1[0], v1[1]), cvtpk(v1[2], v1[3])}; *(u32x4*)(P + (size_t)row * PLD + col) = w;
      if (col >= OFF_G && col < OFF_G + 16) { const f32x4 bg0 = *(const f32x4*)(p.b_gates + l * 16 + (col - OFF_G)), bg1 = *(const f32x4*)(p.b_gates + l * 16 + (col - OFF_G) + 4);
        *(f32x4*)(gates + (size_t)row * 16 + (col - OFF_G)) = v0 + bg0; *(f32x4*)(gates + (size_t)row * 16 + (col - OFF_G) + 4) = v1 + bg1; }
    }
  }
}


__device__ void phase_mlstm(PRef p, int l, char* smem, size_t hb_off = WS_HB) {
  bf16_t* RAWQ = (bf16_t*)(smem); bf16_t* RAWK = (bf16_t*)(smem + 17408);
  bf16_t* QB = (bf16_t*)(smem + 34816); bf16_t* KB = (bf16_t*)(smem + 52224);
  bf16_t* KT = (bf16_t*)(smem + 69632);
  bf16_t* VT = (bf16_t*)(smem + 88064); bf16_t* VWT = (bf16_t*)(smem + 94976);
  bf16_t* PB = (bf16_t*)(smem + 101888);
  bf16_t* CT = (bf16_t*)(smem + 111104);
  float* SC = (float*)(smem + 124160);
  const bf16_t* P = (const bf16_t*)(p.ws + WS_P); const float* gates = (const float*)(p.ws + WS_GATES);
  bf16_t* hbuf = (bf16_t*)(p.ws + hb_off);
  const int tid = otid(), wid = tid >> 6, lane = tid & 63, fr = lane & 15, fq = lane >> 4;
  for (int w = obid(); w < 256; w += gridDim.x) {
    const int slice = w & 3, dir = (w >> 2) & 1, hd = (w >> 3) & 3, b = w >> 5;
    const int c2 = (tid & 63) * 2;
    float wq0[5], wq1[5], wk0[5], wk1[5];
#pragma unroll
    for (int j = 0; j < 5; ++j) { const float* cw = p.conv_w + ((size_t)l * 5 + j) * 1024; wq0[j] = cw[hd * 128 + c2]; wq1[j] = cw[hd * 128 + c2 + 1]; wk0[j] = cw[512 + hd * 128 + c2]; wk1[j] = cw[512 + hd * 128 + c2 + 1]; }
    const float bq0 = p.conv_b[l * 1024 + hd * 128 + c2], bq1 = p.conv_b[l * 1024 + hd * 128 + c2 + 1], bk0 = p.conv_b[l * 1024 + 512 + hd * 128 + c2], bk1 = p.conv_b[l * 1024 + 512 + hd * 128 + c2 + 1];
    __syncthreads();
    for (int i = tid; i < 48 * 136 / 2; i += 512) ((unsigned*)CT)[i] = 0u;
    for (int i = tid; i < 48 * 72 / 2; i += 512) { ((unsigned*)VT)[i] = 0u; ((unsigned*)VWT)[i] = 0u; }
    f32x4 accC[3];
#pragma unroll
    for (int i = 0; i < 3; ++i) accC[i] = (f32x4){0.f, 0.f, 0.f, 0.f};
    float m_state = 0.f;
    __syncthreads();
    u32x4 pre_raw[5]; u32x2 pre_v; float pre_ig = 0.f, pre_fg = 0.f;
    const int vl = tid >> 3, ve4 = (tid & 7) * 4;
#define MLSTM_PREFETCH(CI) do { const int ci_ = (CI); const bool ic_ = ci_ < 4; const int cc_ = ic_ ? ci_ : ci_ - 4, T_ = ic_ ? CTXL : SEQ, rb_ = ic_ ? MX + b * CTXL : b * SEQ; \
      const int tlo_ = dir ? T_ - 64 - cc_ * 64 : cc_ * 64; \
      _Pragma("unroll") for (int k_ = 0; k_ < 5; ++k_) { const int pc = tid + k_ * 512; pre_raw[k_] = (u32x4){0u, 0u, 0u, 0u}; \
        if (pc < 2176) { const int tens = pc >= 1088, rem = tens ? pc - 1088 : pc, rr = rem >> 4, c16 = rem & 15, t = tlo_ - 2 + rr; \
          if (t >= 0 && t < T_) pre_raw[k_] = *(const u32x4*)(P + (size_t)(rb_ + t) * PLD + (tens ? OFF_K : OFF_Q) + hd * 128 + c16 * 8); } } \
      { const int vt_ = dir ? tlo_ + 63 - vl : tlo_ + vl; pre_v = *(const u32x2*)(P + (size_t)(rb_ + vt_) * PLD + OFF_V + hd * 128 + slice * 32 + ve4); } \
      if (wid == 0) { const int t = dir ? tlo_ + 63 - lane : tlo_ + lane; const float* g = gates + (size_t)(rb_ + t) * 16; pre_ig = g[dir * 8 + hd]; pre_fg = g[dir * 8 + 4 + hd]; } } while (0)
    MLSTM_PREFETCH(0);
    for (int ci = 0; ci < 132; ++ci) {
      const bool isctx = ci < 4; const int cc = isctx ? ci : ci - 4, T = isctx ? CTXL : SEQ, rowbase = isctx ? MX + b * CTXL : b * SEQ;
      const int tlo = dir ? T - 64 - cc * 64 : cc * 64;
      float* S = SC + (ci & 1) * 384;
      const bool need_out = !(l == DEPTH - 1 && isctx);
      if (wid == 0) {
        const float ig = pre_ig, fg = pre_fg;
        const float lf = fminf(fg, 0.f) - log1pf(expf(-fabsf(fg)));
        float bc = lf;
#pragma unroll
        for (int o = 1; o < 64; o <<= 1) { const float u = __shfl_up(bc, o); if (lane >= o) bc += u; }
        const float a = ig - bc; float pmx = a;
#pragma unroll
        for (int o = 1; o < 64; o <<= 1) { const float u = __shfl_up(pmx, o); if (lane >= o) pmx = fmaxf(pmx, u); }
        const float Mx = fmaxf(pmx, m_state), M63 = __shfl(Mx, 63), b63 = __shfl(bc, 63);
        S[lane] = a; S[64 + lane] = Mx; S[128 + lane] = expf(m_state - Mx); S[192 + lane] = expf(-(bc + Mx)); S[256 + lane] = expf(a - M63);
        if (lane == 0) { S[320] = expf(m_state - M63); S[321] = b63 + M63; }
      }
#pragma unroll
      for (int k = 0; k < 5; ++k) { const int pc = tid + k * 512;
        if (pc < 2176) { const int tens = pc >= 1088, rem = tens ? pc - 1088 : pc, rr = rem >> 4, c16 = rem & 15; *(u32x4*)((tens ? RAWK : RAWQ) + rr * 128 + c16 * 8) = pre_raw[k]; } }
      const u32x2 vraw = pre_v;
      if (ci + 1 < 132) MLSTM_PREFETCH(ci + 1);
      __syncthreads();
      {
        const int rg = wid; unsigned rq[12], rk[12];
#pragma unroll
        for (int i = 0; i < 12; ++i) { rq[i] = *(const unsigned*)(RAWQ + (rg * 8 + i) * 128 + c2); rk[i] = *(const unsigned*)(RAWK + (rg * 8 + i) * 128 + c2); }
#pragma unroll
        for (int jj = 0; jj < 8; ++jj) {
          float yq0 = bq0, yq1 = bq1, yk0 = bk0, yk1 = bk1;
#pragma unroll
          for (int tp = 0; tp < 5; ++tp) { yq0 += wq0[tp] * bflo(rq[jj + tp]); yq1 += wq1[tp] * bfhi(rq[jj + tp]); yk0 += wk0[tp] * bflo(rk[jj + tp]); yk1 += wk1[tp] * bfhi(rk[jj + tp]); }
          const int j = rg * 8 + jj, lr = dir ? 63 - j : j;
          const float q0 = silu_f(yq0) * 0.08838834764831845f, q1 = silu_f(yq1) * 0.08838834764831845f, k0 = silu_f(yk0), k1 = silu_f(yk1);
          *(unsigned*)(QB + lr * 136 + c2) = cvtpk(q0, q1);
          const unsigned kw = cvtpk(k0, k1);
          *(unsigned*)(KB + lr * 136 + c2) = kw;
          KT[c2 * 72 + lr] = (bf16_t)(kw & 0xffffu); KT[(c2 + 1) * 72 + lr] = (bf16_t)(kw >> 16);
        }
        const float wsl = S[256 + vl];
        const float v0 = bflo(vraw[0]), v1 = bfhi(vraw[0]), v2 = bflo(vraw[1]), v3 = bfhi(vraw[1]);
        VT[(ve4 + 0) * 72 + vl] = (bf16_t)(vraw[0] & 0xffffu); VT[(ve4 + 1) * 72 + vl] = (bf16_t)(vraw[0] >> 16);
        VT[(ve4 + 2) * 72 + vl] = (bf16_t)(vraw[1] & 0xffffu); VT[(ve4 + 3) * 72 + vl] = (bf16_t)(vraw[1] >> 16);
        VWT[(ve4 + 0) * 72 + vl] = f2bf(v0 * wsl); VWT[(ve4 + 1) * 72 + vl] = f2bf(v1 * wsl); VWT[(ve4 + 2) * 72 + vl] = f2bf(v2 * wsl); VWT[(ve4 + 3) * 72 + vl] = f2bf(v3 * wsl);
        if (tid < 64) { VT[32 * 72 + tid] = (bf16_t)0x3F80u; VWT[32 * 72 + tid] = f2bf(S[256 + tid]); }
      }
      __syncthreads();
      if (need_out) {
        const int mt = wid >> 1;
#pragma unroll
        for (int u = 0; u < 2; ++u) {
          const int ntl = (wid & 1) * 2 + u;
          f32x4 s = {0.f, 0.f, 0.f, 0.f};
          if (ntl <= mt) {
#pragma unroll
            for (int kk = 0; kk < 4; ++kk) {
              const bf16x8 a = *(const bf16x8*)(QB + (mt * 16 + fr) * 136 + kk * 32 + fq * 8), bb = *(const bf16x8*)(KB + (ntl * 16 + fr) * 136 + kk * 32 + fq * 8);
              s = __builtin_amdgcn_mfma_f32_16x16x32_bf16(a, bb, s, 0, 0, 0); }
          }
          const int j = ntl * 16 + fr; const float aj = S[j];
#pragma unroll
          for (int jj = 0; jj < 4; ++jj) { const int lr = mt * 16 + fq * 4 + jj;
            const float pv = (j <= lr) ? s[jj] * __expf(fminf(aj - S[64 + lr], 0.f)) : 0.f;
            PB[lr * 72 + j] = f2bf(pv); }
        }
      }
      __syncthreads();
      if (need_out && wid < 4) {
        const int mt = wid; f32x4 num[3];
#pragma unroll
        for (int ntl = 0; ntl < 3; ++ntl) {
          f32x4 a1 = {0.f, 0.f, 0.f, 0.f}, a2 = {0.f, 0.f, 0.f, 0.f};
#pragma unroll
          for (int kk = 0; kk < 2; ++kk) { const bf16x8 a = *(const bf16x8*)(PB + (mt * 16 + fr) * 72 + kk * 32 + fq * 8), bb = *(const bf16x8*)(VT + (ntl * 16 + fr) * 72 + kk * 32 + fq * 8);
            a1 = __builtin_amdgcn_mfma_f32_16x16x32_bf16(a, bb, a1, 0, 0, 0); }
#pragma unroll
          for (int kk = 0; kk < 4; ++kk) { const bf16x8 a = *(const bf16x8*)(QB + (mt * 16 + fr) * 136 + kk * 32 + fq * 8), bb = *(const bf16x8*)(CT + (ntl * 16 + fr) * 136 + kk * 32 + fq * 8);
            a2 = __builtin_amdgcn_mfma_f32_16x16x32_bf16(a, bb, a2, 0, 0, 0); }
#pragma unroll
          for (int jj = 0; jj < 4; ++jj) num[ntl][jj] = a1[jj] + S[128 + mt * 16 + fq * 4 + jj] * a2[jj];
        }
#pragma unroll
        for (int jj = 0; jj < 4; ++jj) {
          const int lr = mt * 16 + fq * 4 + jj; const float den = __shfl(num[2][jj], lane & 48);
          const float rd = 1.f / fmaxf(fabsf(den), S[192 + lr]);
          const int t = dir ? tlo + 63 - lr : tlo + lr;
          bf16_t* hp = hbuf + ((size_t)((dir * 4 + hd) * 4 + slice) * MT + rowbase + t) * 32 + fr;
          hp[0] = f2bf(num[0][jj] * rd); hp[16] = f2bf(num[1][jj] * rd);
#if DBG_STOP == 23
          { const size_t di = (size_t)(hp - hbuf); if (di + 16 < (size_t)MX * 1024) { p.out[di] = num[0][jj] * rd; p.out[di + 16] = num[1][jj] * rd; } }
#endif
        }
      }
      __syncthreads();
      {
        const float decay = S[320];
#pragma unroll
        for (int mt = 0; mt < 3; ++mt) {
          accC[mt] *= decay;
#pragma unroll
          for (int kk = 0; kk < 2; ++kk) { const bf16x8 a = *(const bf16x8*)(VWT + (mt * 16 + fr) * 72 + kk * 32 + fq * 8), bb = *(const bf16x8*)(KT + (wid * 16 + fr) * 72 + kk * 32 + fq * 8);
            accC[mt] = __builtin_amdgcn_mfma_f32_16x16x32_bf16(a, bb, accC[mt], 0, 0, 0); }
#pragma unroll
          for (int jj = 0; jj < 4; ++jj) CT[(mt * 16 + fq * 4 + jj) * 136 + wid * 16 + fr] = f2bf(accC[mt][jj]);
        }
        m_state = S[321];
      }
    }
  }
}

template <int WHICH>
__device__ __forceinline__ void mla_gemm(PRef p, int l, char* smem) {
  LAS unsigned char* lds = (LAS unsigned char*)smem; float* rsb = (float*)(smem + g8::STAGE_BYTES);
  const bf16_t* P = (const bf16_t*)(p.ws + WS_P);
  const int tid = otid(), wid = tid >> 6, lane = tid & 63, wr = wid >> 2, wc = wid & 3, fr = lane & 15, fq = lane >> 4;
  constexpr int K = WHICH ? 256 : 384, OFFC = WHICH ? OFF_CKV : OFF_CQ, N = WHICH ? 1024 : 768;
  const bf16_t* Wt = WHICH ? (const bf16_t*)(p.ws + WS_WUKV) + (size_t)l * 1024 * 256 : (const bf16_t*)(p.ws + WS_WUQ) + (size_t)l * 768 * 384;
  bf16_t* O = (bf16_t*)(p.ws + (WHICH ? WS_KV : WS_Q));
  g8::TileIter it; it.init((WHICH || l == 0) ? MT / 256 : MX / 256, N / 256);
  int pm, pn;
  while (it.next(pm, pn)) {
    __syncthreads();
    { const int r = tid >> 1, hf = tid & 1; const bf16_t* src = P + (size_t)(pm * 256 + r) * PLD + OFFC + hf * (K / 2); float s = 0.f;
#pragma unroll 4
      for (int i = 0; i < K / 16; ++i) { const u32x4 v = *(const u32x4*)(src + i * 8);
#pragma unroll
        for (int k = 0; k < 4; ++k) { const float a = bflo(v[k]), bq = bfhi(v[k]); s += a * a + bq * bq; } }
      s += __shfl_xor(s, 1);
      if (hf == 0) rsb[r] = rsqrtf(s / (float)K + 1e-6f); }
    unsigned voffA[2] = {g8::piece_off(0, PLD, OFFC), g8::piece_off(1, PLD, OFFC)};
    f32x4 acc[2][2][4][2];
    g8::gemm_tile<false>(lds, (const char*)(P + (size_t)pm * 256 * PLD), voffA, (size_t)128 * PLD * 2, (const char*)(Wt + (size_t)pn * 256 * K), opaque_s(K), acc);
    ACC_FOR3(ai, bj, m) {
      const int rl = ai * 128 + wr * 64 + m * 16 + fr, row = pm * 256 + rl, col = pn * 256 + bj * 128 + wc * 32 + fq * 8;
      const float rs = rsb[rl]; const f32x4 v0 = acc[ai][bj][m][0] * rs, v1 = acc[ai][bj][m][1] * rs;
      size_t orow = row;
      if (WHICH) orow = row < MX ? (size_t)(row >> 13) * SKV + CTXL + (row & 8191) : (size_t)((row - MX) >> 8) * SKV + ((row - MX) & 255);
      u32x4 w = {cvtpk(v0[0], v0[1]), cvtpk(v0[2], v0[3]), cvtpk(v1[0], v1[1]), cvtpk(v1[2], v1[3])}; *(u32x4*)(O + orow * N + col) = w;
    }
  }
}
__device__ void phase_mla_prep(PRef p, int l, char* smem) {
  mla_gemm<0>(p, l, smem);
  mla_gemm<1>(p, l, smem);
  const bf16_t* P = (const bf16_t*)(p.ws + WS_P);
  const int tid = otid(), wid = tid >> 6, lane = tid & 63;
  const bf16_t* hbuf = (const bf16_t*)(p.ws + WS_HB); bf16_t* mix = (bf16_t*)(p.ws + WS_MIX); bf16_t* KR = (bf16_t*)(p.ws + WS_KR);
  const float* cs = (const float*)(p.ws + WS_COS); const float* sn = (const float*)(p.ws + WS_SIN);
  const int gw = obid() * 8 + wid, nw = gridDim.x * 8;
  for (int row = gw; row < MT; row += nw) {
    if (row < MX || l == 0) {
      const size_t ho = ((size_t)(lane >> 2) * MT + row) * 32 + (lane & 3) * 8;
      const u32x4 hf = *(const u32x4*)(hbuf + ho), hb = *(const u32x4*)(hbuf + (size_t)16 * MT * 32 + ho);
      const u32x4 ov = *(const u32x4*)(P + (size_t)row * PLD + OFF_O + lane * 8);
      float v[8]; float s = 0.f;
#pragma unroll
      for (int k = 0; k < 4; ++k) { v[2 * k] = bflo(hf[k]) + bflo(hb[k]); v[2 * k + 1] = bfhi(hf[k]) + bfhi(hb[k]); s += v[2 * k] + v[2 * k + 1]; }
      s += __shfl_xor(s, 1); s += __shfl_xor(s, 2); s += __shfl_xor(s, 4); s += __shfl_xor(s, 8);
      const float mu = s * (1.f / 128.f); float q = 0.f;
#pragma unroll
      for (int k = 0; k < 8; ++k) { v[k] -= mu; q += v[k] * v[k]; }
      q += __shfl_xor(q, 1); q += __shfl_xor(q, 2); q += __shfl_xor(q, 4); q += __shfl_xor(q, 8);
      const float rs = rsqrtf(q * (1.f / 128.f) + 1e-6f);
      const float* nw_ = p.m_norm_w + l * 512 + lane * 8; float o[8];
#pragma unroll
      for (int k = 0; k < 4; ++k) { o[2 * k] = v[2 * k] * rs * nw_[2 * k] * sigmoid_f(bflo(ov[k])); o[2 * k + 1] = v[2 * k + 1] * rs * nw_[2 * k + 1] * sigmoid_f(bfhi(ov[k])); }
      u32x4 wv = {cvtpk(o[0], o[1]), cvtpk(o[2], o[3]), cvtpk(o[4], o[5]), cvtpk(o[6], o[7])};
      *(u32x4*)(mix + (size_t)row * 1024 + lane * 8) = wv;
    }
    {
      const int j = lane & 31;
      const float x1 = bf2f(P[(size_t)row * PLD + OFF_KR + j]), x2 = bf2f(P[(size_t)row * PLD + OFF_KR + 32 + j]);
      float o1 = x1, o2 = x2; size_t orow;
      if (row < MX) { const int t = row & 8191; const float c = cs[t * 32 + j], s_ = sn[t * 32 + j]; o1 = x1 * c - x2 * s_; o2 = x2 * c + x1 * s_; orow = (size_t)(row >> 13) * SKV + CTXL + t; }
      else orow = (size_t)((row - MX) >> 8) * SKV + ((row - MX) & 255);
      if (lane < 32) { KR[orow * 64 + j] = f2bf(o1); KR[orow * 64 + 32 + j] = f2bf(o2); }
    }
  }
}

namespace att {
constexpr int NW = 8, QBLK = 32, KVBLK = 64, LDQ = 768, LDK = 1024, LDKR = 64, LDO = 1024;
constexpr float SCALE = A_SCALE;
constexpr float THR = 8.f;
constexpr size_t SHM_V = KVBLK * 128 * 2, SHM_K = KVBLK * 128 * 2, SHM_R = KVBLK * 64 * 2;
typedef float f32x8 __attribute__((ext_vector_type(8)));
#define KSWZ(row, colB) ((row) * 256 + ((colB) ^ (((row) & 7) << 4)))
#define RSWZ(row, colB) ((row) * 128 + ((colB) ^ (((row) & 7) << 4)))
#define SBAR() __builtin_amdgcn_sched_barrier(0)
__device__ __forceinline__ int crow(int r, int hi) { return (r & 3) + 8 * (r >> 2) + 4 * hi; }
__device__ __forceinline__ void partialSM(f32x16& p0, f32x16& p1, float& m_reg, float& mn, float& alpha) {
  constexpr float C = SCALE * 1.4426950408889634f;
  float pmax = p0[0];
#pragma unroll
  for (int r = 1; r < 16; ++r) pmax = fmaxf(pmax, p0[r]);
#pragma unroll
  for (int r = 0; r < 16; ++r) pmax = fmaxf(pmax, p1[r]);
  { auto rr = __builtin_amdgcn_permlane32_swap(__float_as_uint(pmax), __float_as_uint(pmax), false, false);
    pmax = fmaxf(__uint_as_float(rr[0]), __uint_as_float(rr[1])); }
  if (__builtin_expect(__all(pmax - m_reg <= THR / SCALE), 1)) { mn = m_reg; alpha = 1.f; }
  else { mn = fmaxf(m_reg, pmax); alpha = __builtin_amdgcn_exp2f((m_reg - mn) * C); m_reg = mn; }
  const float mnC = -mn * C;
#pragma unroll
  for (int r = 0; r < 16; ++r) p0[r] = fmaf(p0[r], C, mnC);
#pragma unroll
  for (int r = 0; r < 16; ++r) p1[r] = fmaf(p1[r], C, mnC);
#pragma unroll
  for (int r = 0; r < 16; ++r) p0[r] = __builtin_amdgcn_exp2f(p0[r]);
}
__device__ __forceinline__ void finishSM(f32x16& p0, f32x16& p1, float alpha, float& l_reg, bf16x8& pa0, bf16x8& pa1, bf16x8& pa2, bf16x8& pa3) {
#pragma unroll
  for (int r = 0; r < 16; ++r) p1[r] = __builtin_amdgcn_exp2f(p1[r]);
  float ps = 0;
#pragma unroll
  for (int r = 0; r < 16; ++r) ps += p0[r];
#pragma unroll
  for (int r = 0; r < 16; ++r) ps += p1[r];
  { auto rr = __builtin_amdgcn_permlane32_swap(__float_as_uint(ps), __float_as_uint(ps), false, false);
    ps = __uint_as_float(rr[0]) + __uint_as_float(rr[1]); }
  l_reg = l_reg * alpha + ps;
#define PK4(P, BASE, OUT) do { unsigned a0 = cvtpk(P[BASE + 0], P[BASE + 1]), a1 = cvtpk(P[BASE + 2], P[BASE + 3]);   \
    unsigned b0 = cvtpk(P[BASE + 4], P[BASE + 5]), b1 = cvtpk(P[BASE + 6], P[BASE + 7]);                              \
    auto r0 = __builtin_amdgcn_permlane32_swap(a0, b0, false, false); auto r1 = __builtin_amdgcn_permlane32_swap(a1, b1, false, false); \
    u32x4 w = {r0[0], r1[0], r0[1], r1[1]}; OUT = *reinterpret_cast<bf16x8*>(&w); } while (0)
  PK4(p0, 0, pa0); PK4(p0, 8, pa1); PK4(p1, 0, pa2); PK4(p1, 8, pa3);
#undef PK4
}
__device__ __forceinline__ void qkt(f32x16& p0, f32x16& p1, const char* Ks, const char* Rs, const bf16x8* qr, const char* qrl, int r32, int hi) {
  p0 = f32x16{}; p1 = f32x16{};
#pragma unroll
  for (int d0 = 0; d0 < 8; ++d0) { const int cb = (d0 * 16 + hi * 8) * 2;
    const bf16x8 b0 = *reinterpret_cast<const bf16x8*>(Ks + KSWZ(r32, cb));
    const bf16x8 b1 = *reinterpret_cast<const bf16x8*>(Ks + KSWZ(32 + r32, cb));
    p0 = __builtin_amdgcn_mfma_f32_32x32x16_bf16(b0, qr[d0], p0, 0, 0, 0);
    p1 = __builtin_amdgcn_mfma_f32_32x32x16_bf16(b1, qr[d0], p1, 0, 0, 0); }
#pragma unroll
  for (int d0 = 0; d0 < 4; ++d0) { const int cb = (d0 * 16 + hi * 8) * 2;
    const bf16x8 b0 = *reinterpret_cast<const bf16x8*>(Rs + RSWZ(r32, cb));
    const bf16x8 b1 = *reinterpret_cast<const bf16x8*>(Rs + RSWZ(32 + r32, cb));
    const bf16x8 qv = *reinterpret_cast<const bf16x8*>(qrl + d0 * 1024);
    p0 = __builtin_amdgcn_mfma_f32_32x32x16_bf16(b0, qv, p0, 0, 0, 0);
    p1 = __builtin_amdgcn_mfma_f32_32x32x16_bf16(b1, qv, p1, 0, 0, 0); }
}
__device__ __forceinline__ int v_st(int k, int c) { const int kk = (k & ~0xC) | ((k & 4) << 1) | ((k & 8) >> 1); return ((kk >> 3) * 4 + (c >> 5)) * 512 + ((kk & 7) * 32 + (c & 31)) * 2; }
__device__ __forceinline__ int v_rd_base(int lane) { return ((lane & 3) << 3) | (((lane >> 2) & 3) << 6) | (((lane >> 4) & 1) << 5) | (((lane >> 5) & 1) << 8); }
constexpr int v_rd_off(int d0, int ks, int half) { return d0 * 512 + ks * 4096 + half * 2048; }
template <int OFF> __device__ __forceinline__ s16x4 tr_read(int vb) {
  s16x4 r; asm volatile("ds_read_b64_tr_b16 %0, %1 offset:%2" : "=&v"(r) : "v"(vb), "i"(OFF) : "memory"); return r;
}
template <int D0> __device__ __forceinline__ void pv_one(f32x16& od, int vb, bf16x8 pa0, bf16x8 pa1, bf16x8 pa2, bf16x8 pa3) {
  const s16x4 l0 = tr_read<v_rd_off(D0, 0, 0)>(vb), h0 = tr_read<v_rd_off(D0, 0, 1)>(vb), l1 = tr_read<v_rd_off(D0, 1, 0)>(vb), h1 = tr_read<v_rd_off(D0, 1, 1)>(vb);
  const s16x4 l2 = tr_read<v_rd_off(D0, 2, 0)>(vb), h2 = tr_read<v_rd_off(D0, 2, 1)>(vb), l3 = tr_read<v_rd_off(D0, 3, 0)>(vb), h3 = tr_read<v_rd_off(D0, 3, 1)>(vb);
  asm volatile("s_waitcnt lgkmcnt(0)" ::: "memory"); SBAR();
#define PK(L, H) (bf16x8){L[0], L[1], L[2], L[3], H[0], H[1], H[2], H[3]}
  od = __builtin_amdgcn_mfma_f32_32x32x16_bf16(pa0, PK(l0, h0), od, 0, 0, 0);
  od = __builtin_amdgcn_mfma_f32_32x32x16_bf16(pa1, PK(l1, h1), od, 0, 0, 0);
  od = __builtin_amdgcn_mfma_f32_32x32x16_bf16(pa2, PK(l2, h2), od, 0, 0, 0);
  od = __builtin_amdgcn_mfma_f32_32x32x16_bf16(pa3, PK(l3, h3), od, 0, 0, 0);
#undef PK
}
__device__ __forceinline__ void pv_d0(f32x16* o, int vb, bf16x8 pa0, bf16x8 pa1, bf16x8 pa2, bf16x8 pa3) {
  pv_one<0>(o[0], vb, pa0, pa1, pa2, pa3); pv_one<1>(o[1], vb, pa0, pa1, pa2, pa3); pv_one<2>(o[2], vb, pa0, pa1, pa2, pa3); pv_one<3>(o[3], vb, pa0, pa1, pa2, pa3);
}
__device__ __forceinline__ void attn_body(const bf16_t* __restrict__ Qb, const float* __restrict__ cs, const float* __restrict__ sn, const bf16_t* __restrict__ Kn,
                                          const bf16_t* __restrict__ Vh, const bf16_t* __restrict__ Kr, bf16_t* __restrict__ Ob, int seq, char* lds) {
  const int tid = otid(), wid = tid >> 6, lane = tid & 63, r32 = lane & 31, hi = lane >> 5;
  char* V_lds = lds; char* K_lds = lds + 2 * SHM_V; char* R_lds = lds + 2 * SHM_V + 2 * SHM_K;
  float* wsf = (float*)(lds + 2 * SHM_V + 2 * SHM_K + 2 * SHM_R) + wid * 64; float* li_l = wsf; float* al_l = wsf + 32;
  char* qrl = lds + 2 * SHM_V + 2 * SHM_K + 2 * SHM_R + 2048 + wid * 4096 + lane * 16;
  float m_reg = -1e30f, l_reg = 0; f32x16 o[4] = {}; bf16x8 qr[8];
  { const bf16_t* Qw = Qb + (size_t)(wid * QBLK + r32) * LDQ + hi * 8;
#pragma unroll
    for (int d0 = 0; d0 < 8; ++d0) qr[d0] = *(const bf16x8*)(Qw + d0 * 16);
#pragma unroll
    for (int d0 = 0; d0 < 2; ++d0) {
      const u32x4 a = *(const u32x4*)(Qw + 128 + d0 * 16), bq = *(const u32x4*)(Qw + 160 + d0 * 16);
      if (cs) {
        const float* cp = cs + (size_t)(wid * QBLK + r32) * 32 + d0 * 16 + hi * 8; const float* sp = sn + (size_t)(wid * QBLK + r32) * 32 + d0 * 16 + hi * 8;
        const f32x4 c0 = *(const f32x4*)cp, c1 = *(const f32x4*)(cp + 4), s0 = *(const f32x4*)sp, s1 = *(const f32x4*)(sp + 4);
        float x1[8], x2[8], y1[8], y2[8];
#pragma unroll
        for (int k = 0; k < 4; ++k) { x1[2 * k] = bflo(a[k]); x1[2 * k + 1] = bfhi(a[k]); x2[2 * k] = bflo(bq[k]); x2[2 * k + 1] = bfhi(bq[k]); }
#pragma unroll
        for (int k = 0; k < 8; ++k) { const float c = k < 4 ? c0[k & 3] : c1[k & 3], s = k < 4 ? s0[k & 3] : s1[k & 3]; y1[k] = x1[k] * c - x2[k] * s; y2[k] = x2[k] * c + x1[k] * s; }
        u32x4 w1 = {cvtpk(y1[0], y1[1]), cvtpk(y1[2], y1[3]), cvtpk(y1[4], y1[5]), cvtpk(y1[6], y1[7])}, w2 = {cvtpk(y2[0], y2[1]), cvtpk(y2[2], y2[3]), cvtpk(y2[4], y2[5]), cvtpk(y2[6], y2[7])};
        *(u32x4*)(qrl + d0 * 1024) = w1; *(u32x4*)(qrl + (2 + d0) * 1024) = w2;
      } else { *(u32x4*)(qrl + d0 * 1024) = a; *(u32x4*)(qrl + (2 + d0) * 1024) = bq; }
    } }
  const int sr = tid >> 4, sc = (tid & 15) * 8, vst0 = v_st(sr, sc), vst1 = v_st(32 + sr, sc);
  const int rr_ = tid >> 3, rc = (tid & 7) * 8;
  const int vb0 = (int)(uintptr_t)V_lds + v_rd_base(lane);
  bf16x8 vs0, vs1, ks0, ks1, rs0;
  const unsigned voffKV = (unsigned)(sr * LDK + sc) * 2u, voffR = (unsigned)(rr_ * LDKR + rc) * 2u;
#define SLOAD(k0) do { const char* kb_ = (const char*)Kn + (size_t)(k0) * (LDK * 2); const char* vb_ = (const char*)Vh + (size_t)(k0) * (LDK * 2); \
    vs0 = *(const bf16x8*)(vb_ + voffKV); vs1 = *(const bf16x8*)(vb_ + 32 * LDK * 2 + voffKV); \
    ks0 = *(const bf16x8*)(kb_ + voffKV); ks1 = *(const bf16x8*)(kb_ + 32 * LDK * 2 + voffKV); \
    rs0 = *(const bf16x8*)((const char*)Kr + (size_t)(k0) * (LDKR * 2) + voffR); } while (0)
#define SWRITE(b) do { *(bf16x8*)(V_lds + (b) * SHM_V + vst0) = vs0; *(bf16x8*)(V_lds + (b) * SHM_V + vst1) = vs1; const int kc = sc * 2;  \
    *(bf16x8*)(K_lds + (b) * SHM_K + KSWZ(sr, kc)) = ks0; *(bf16x8*)(K_lds + (b) * SHM_K + KSWZ(32 + sr, kc)) = ks1;                      \
    *(bf16x8*)(R_lds + (b) * SHM_R + RSWZ(rr_, rc * 2)) = rs0; } while (0)
#define RESC(a) do { if (__any((a) < 1.f)) { if (hi == 0) al_l[r32] = (a); asm volatile("s_waitcnt lgkmcnt(0)" ::: "memory"); \
    _Pragma("unroll") for (int d = 0; d < 4; ++d) _Pragma("unroll") for (int r = 0; r < 16; ++r) o[d][r] *= al_l[crow(r, hi)]; } } while (0)
  f32x16 pA0, pA1, pB0, pB1; float mnA, mnB, alA, alB; bf16x8 pa0, pa1, pa2, pa3; const int NT = seq / KVBLK;
  SLOAD(0); SWRITE(0); __syncthreads();
  qkt(pA0, pA1, K_lds, R_lds, qr, qrl, r32, hi); partialSM(pA0, pA1, m_reg, mnA, alA);
  SLOAD(KVBLK); SWRITE(1); __syncthreads();
  for (int j = 1; j + 1 < NT; j += 2) {
    SBAR(); qkt(pB0, pB1, K_lds + SHM_K, R_lds + SHM_R, qr, qrl, r32, hi);
    finishSM(pA0, pA1, alA, l_reg, pa0, pa1, pa2, pa3); SBAR();
    SLOAD((j + 1) * KVBLK); SBAR();
    pv_d0(o, vb0, pa0, pa1, pa2, pa3); partialSM(pB0, pB1, m_reg, mnB, alB);
    __syncthreads(); SWRITE(0);
    RESC(alB); __syncthreads();
    SBAR(); qkt(pA0, pA1, K_lds, R_lds, qr, qrl, r32, hi);
    finishSM(pB0, pB1, alB, l_reg, pa0, pa1, pa2, pa3); SBAR();
    SLOAD((j + 2) * KVBLK); SBAR();
    pv_d0(o, vb0 + (int)SHM_V, pa0, pa1, pa2, pa3); partialSM(pA0, pA1, m_reg, mnA, alA);
    __syncthreads(); SWRITE(1);
    RESC(alA); __syncthreads();
  }
  SBAR(); qkt(pB0, pB1, K_lds + SHM_K, R_lds + SHM_R, qr, qrl, r32, hi);
  finishSM(pA0, pA1, alA, l_reg, pa0, pa1, pa2, pa3); SBAR();
  pv_d0(o, vb0, pa0, pa1, pa2, pa3); partialSM(pB0, pB1, m_reg, mnB, alB);
  __syncthreads(); RESC(alB);
  finishSM(pB0, pB1, alB, l_reg, pa0, pa1, pa2, pa3); SBAR();
  pv_d0(o, vb0 + (int)SHM_V, pa0, pa1, pa2, pa3);
  if (hi == 0) li_l[r32] = l_reg; asm volatile("s_waitcnt lgkmcnt(0)" ::: "memory");
  float rli[16];
#pragma unroll
  for (int r = 0; r < 16; ++r) rli[r] = __builtin_amdgcn_rcpf(li_l[crow(r, hi)]);
  bf16_t* Ow = Ob + (size_t)(wid * QBLK) * LDO;
#pragma unroll
  for (int r = 0; r < 16; ++r) { const int orow = crow(r, hi);
#pragma unroll
    for (int d0 = 0; d0 < 4; ++d0) Ow[(size_t)orow * LDO + d0 * 32 + r32] = f2bf(o[d0][r] * rli[r]); }
  __syncthreads();
#undef SLOAD
#undef SWRITE
#undef RESC
}
}

__device__ void phase_attn(PRef p, int l, char* smem) {
  const bf16_t* Q = (const bf16_t*)(p.ws + WS_Q); const bf16_t* KV = (const bf16_t*)(p.ws + WS_KV); const bf16_t* KR = (const bf16_t*)(p.ws + WS_KR);
  bf16_t* mix = (bf16_t*)(p.ws + WS_MIX); const float* cs = (const float*)(p.ws + WS_COS); const float* sn = (const float*)(p.ws + WS_SIN);
  const int nunits = 1024 + (l == 0 ? 32 : 0);
  for (int u = obid(); u < nunits; u += gridDim.x) {
    if (u < 1024) {
      const int bh = (u >> 8) * 8 + (u & 7), qb = (u & 255) >> 3, hd = bh & 3, b = bh >> 2; const size_t row0 = (size_t)b * SEQ + qb * 256;
      att::attn_body(Q + row0 * 768 + hd * 192, cs + (size_t)qb * 256 * 32, sn + (size_t)qb * 256 * 32, KV + (size_t)b * SKV * 1024 + hd * 256,
                     KV + (size_t)b * SKV * 1024 + hd * 256 + 128, KR + (size_t)b * SKV * 64, mix + row0 * 1024 + 512 + hd * 128, SKV, smem);
    } else {
      const int v = u - 1024, hd = v & 3, b = v >> 2; const size_t row0 = (size_t)MX + b * CTXL;
      att::attn_body(Q + row0 * 768 + hd * 192, nullptr, nullptr, KV + (size_t)b * SKV * 1024 + hd * 256,
                     KV + (size_t)b * SKV * 1024 + hd * 256 + 128, KR + (size_t)b * SKV * 64, mix + row0 * 1024 + 512 + hd * 128, CTXL, smem);
    }
  }
}

__device__ void phase_outproj(PRef p, int l, char* smem) {
  LAS unsigned char* lds = (LAS unsigned char*)smem;
  const bf16_t* mix = (const bf16_t*)(p.ws + WS_MIX); const bf16_t* Wt = (const bf16_t*)(p.ws + WS_WOUT) + (size_t)l * 1024 * 1024;
  float* ctxz = (float*)(p.ws + WS_CTXZ);
  const int tid = otid(), wid = tid >> 6, lane = tid & 63, wr = wid >> 2, wc = wid & 3, fr = lane & 15, fq = lane >> 4;
  g8::TileIter it; it.init(l == 0 ? MT / 256 : MX / 256, 4);
  int pm, pn;
  while (it.next(pm, pn)) {
    unsigned voffA[2] = {g8::piece_off(0, 1024, 0), g8::piece_off(1, 1024, 0)};
    f32x4 acc[2][2][4][2];
    g8::gemm_tile<false>(lds, (const char*)(mix + (size_t)pm * 256 * 1024), voffA, (size_t)128 * 1024 * 2, (const char*)(Wt + (size_t)pn * 256 * 1024), 1024, acc);
    ACC_FOR(ai, bj, m, n) {
      const int row = pm * 256 + ai * 128 + wr * 64 + m * 16 + fr, col = pn * 256 + bj * 128 + wc * 32 + fq * 8 + n * 4;
      const float* res = l == 0 ? (row < MX ? p.x + (size_t)row * 1024 : p.ctx + (size_t)(row - MX) * 1024) : p.out + (size_t)row * 1024;
      float* dst = row < MX ? p.out + (size_t)row * 1024 : ctxz + (size_t)(row - MX) * 1024;
      const f32x4 r = *(const f32x4*)(res + col), g = *(const f32x4*)(mod_ptr(p, l, row, 2) + col);
      *(f32x4*)(dst + col) = r * ALPHA + g * acc[ai][bj][m][n];
    }
  }
}

__device__ void phase_ln1(PRef p, int l, char* smem) {
  float* wrt = (float*)smem;
  for (int i = otid(); i < 16384; i += 512) wrt[(i & 15) * 1024 + (i >> 4)] = p.w_router[(size_t)l * 16384 + i];
  __syncthreads();
  const int lane = otid() & 63, gw = obid() * 8 + (otid() >> 6), nw = gridDim.x * 8;
  bf16_t* h = (bf16_t*)(p.ws + WS_H); float* ctxz = (float*)(p.ws + WS_CTXZ); float* aff = (float*)(p.ws + WS_AFF);
  const int nrows = l == 0 ? MT : MX;
  for (int row = gw; row < nrows; row += nw) {
    asm volatile("" ::: "memory");
    float* zr = row < MX ? p.out + (size_t)row * 1024 : ctxz + (size_t)(row - MX) * 1024;
    f32x4 v[4];
#pragma unroll
    for (int i = 0; i < 4; ++i) v[i] = *(const f32x4*)(zr + lane * 4 + 256 * i);
    ln_row(v, 1e-5f);
#pragma unroll
    for (int i = 0; i < 4; ++i) { const int c = lane * 4 + 256 * i; v[i] = v[i] * *(const f32x4*)(p.ln1_g + l * 1024 + c) + *(const f32x4*)(p.ln1_b + l * 1024 + c); *(f32x4*)(zr + c) = v[i]; }
    ln_row(v, 1e-6f);
    f32x4 hm[4];
    store_mod_bf16(v, mod_ptr(p, l, row, 3), mod_ptr(p, l, row, 4), h + (size_t)row * 1024, lane, &hm);
    float lg[16];
#pragma unroll
    for (int e = 0; e < 16; ++e) { float s = 0.f;
#pragma unroll
      for (int i = 0; i < 4; ++i) { const f32x4 w = *(const f32x4*)(wrt + e * 1024 + lane * 4 + 256 * i); s += hm[i][0] * w[0] + hm[i][1] * w[1] + hm[i][2] * w[2] + hm[i][3] * w[3]; }
      lg[e] = wave_sum(s); }
    float mx = lg[0];
#pragma unroll
    for (int e = 1; e < 16; ++e) mx = fmaxf(mx, lg[e]);
    float den = 0.f;
#pragma unroll
    for (int e = 0; e < 16; ++e) { lg[e] = expf(lg[e] - mx); den += lg[e]; }
    float mine = 0.f;
#pragma unroll
    for (int e = 0; e < 16; ++e) if (lane == e) mine = lg[e] / den;
    if (lane < 16) aff[(size_t)row * 16 + lane] = mine;
  }
}

template <int PER>
__device__ __forceinline__ void topk_item(const float* __restrict__ affp, int n, int kcap, int rowbase, int slotbase, int e, int* __restrict__ IDX, float* __restrict__ GV, int* __restrict__ TS, char* smem) {
  unsigned* hist = (unsigned*)smem; unsigned* sel = hist + 256; unsigned* wtot = hist + 272;
  const int tid = otid(), lane = tid & 63, wid = tid >> 6;
  const bool active = tid * PER < n;
  unsigned key[PER];
#pragma unroll
  for (int i = 0; i < PER; ++i) key[i] = active ? __float_as_uint(affp[(size_t)(tid * PER + i) * 16]) : 0u;
  unsigned prefix = 0u, mask = 0u; int kk = kcap;
#pragma unroll 1
  for (int shift = 24; shift >= 0; shift -= 8) {
    __syncthreads();
    if (tid < 256) hist[tid] = 0u;
    __syncthreads();
#pragma unroll
    for (int i = 0; i < PER; ++i) if (active && (key[i] & mask) == prefix) atomicAdd(&hist[(key[i] >> shift) & 255u], 1u);
    __syncthreads();
    if (wid == 0) {
      const unsigned h0 = hist[lane * 4], h1 = hist[lane * 4 + 1], h2 = hist[lane * 4 + 2], h3 = hist[lane * 4 + 3];
      const unsigned tot = h0 + h1 + h2 + h3; unsigned suf = tot;
#pragma unroll
      for (int o = 1; o < 64; o <<= 1) { const unsigned u = __shfl_down(suf, o); if (lane + o < 64) suf += u; }
      const unsigned above = suf - tot;
      if (above < (unsigned)kk && suf >= (unsigned)kk) {
        unsigned a = above; int bin;
        if (a + h3 >= (unsigned)kk) bin = 3; else { a += h3; if (a + h2 >= (unsigned)kk) bin = 2; else { a += h2; if (a + h1 >= (unsigned)kk) bin = 1; else { a += h1; bin = 0; } } }
        sel[0] = prefix | ((unsigned)(lane * 4 + bin) << shift); sel[1] = (unsigned)kk - a;
      }
    }
    __syncthreads();
    prefix = sel[0]; kk = (int)sel[1]; mask |= 0xffu << shift;
  }
  const unsigned Tk = prefix;
  unsigned cg_ = 0, ce = 0;
#pragma unroll
  for (int i = 0; i < PER; ++i) { cg_ += key[i] > Tk; ce += key[i] == Tk; }
  unsigned pk = active ? (cg_ | (ce << 16)) : 0u, inc = pk;
#pragma unroll
  for (int o = 1; o < 64; o <<= 1) { const unsigned u = __shfl_up(inc, o); if (lane >= o) inc += u; }
  __syncthreads();
  if (lane == 63) wtot[wid] = inc;
  __syncthreads();
  unsigned base = 0;
  for (int w2 = 0; w2 < wid; ++w2) base += wtot[w2];
  const unsigned exc = base + inc - pk; unsigned gt_before = exc & 0xffffu, eq_before = exc >> 16;
  if (active) {
#pragma unroll
    for (int i = 0; i < PER; ++i) {
      const int t = tid * PER + i; int R = -1;
      const bool isgt = key[i] > Tk, iseq = key[i] == Tk;
      if (isgt || (iseq && (int)eq_before < kk)) {
        const int slot = (int)gt_before + min((int)eq_before, kk);
        R = slotbase + slot; IDX[R] = rowbase + t; GV[R] = __uint_as_float(key[i]);
      }
      TS[t] = R;
      gt_before += isgt; eq_before += iseq;
    }
  }
}
__device__ void phase_topk(PRef p, int l, char* smem) {
  const float* aff = (const float*)(p.ws + WS_AFF); int* IDX = (int*)(p.ws + WS_IDX); float* GV = (float*)(p.ws + WS_GV); int* TS = (int*)(p.ws + WS_TS);
  const int nitems = l == 0 ? 256 : 128;
  for (int it = obid(); it < nitems; it += gridDim.x) {
    if (it < 128) { const int b = it >> 4, e = it & 15; topk_item<16>(aff + (size_t)b * SEQ * 16 + e, SEQ, CAPX, b * SEQ, it * CAPX, e, IDX, GV, TS + (size_t)it * SEQ, smem); }
    else { const int v = it - 128, b = v >> 4, e = v & 15; topk_item<1>(aff + ((size_t)MX + b * CTXL) * 16 + e, CTXL, CAPC, MX + b * CTXL, NB * NE * CAPX + e * 256 + b * CAPC, e, IDX, GV, TS + (size_t)NB * 16 * SEQ + (size_t)v * CTXL, smem); }
  }
  __syncthreads();
}

__device__ void phase_moe_up(PRef p, int l, char* smem) {
  LAS unsigned char* lds = (LAS unsigned char*)smem;
  const bf16_t* h = (const bf16_t*)(p.ws + WS_H); const bf16_t* Wgu = (const bf16_t*)(p.ws + WS_WGU); bf16_t* act = (bf16_t*)(p.ws + WS_ACT); const int* IDX = (const int*)(p.ws + WS_IDX);
  const int tid = otid(), wid = tid >> 6, lane = tid & 63, wr = wid >> 2, wc = wid & 3, fr = lane & 15, fq = lane >> 4;
  g8::MoeIter it; it.init(8, l == 0);
  int pm, pn, e;
  while (it.next(pm, pn, e)) {
    unsigned voffA[4];
#pragma unroll
    for (int hh = 0; hh < 2; ++hh)
#pragma unroll
      for (int i = 0; i < 2; ++i) { int R, C; g8::piece_rc(i, R, C); voffA[hh * 2 + i] = (unsigned)(IDX[pm * 256 + hh * 128 + R] * 1024 + C) * 2u; }
    f32x4 acc[2][2][4][2];
    g8::gemm_tile<true>(lds, (const char*)h, voffA, 0, (const char*)(Wgu + ((size_t)e * 2048 + pn * 256) * 1024), 1024, acc);
#pragma unroll
    for (int ai = 0; ai < 2; ++ai)
#pragma unroll
      for (int m = 0; m < 4; ++m) {
          const int row = pm * 256 + ai * 128 + wr * 64 + m * 16 + fr, col = pn * 128 + wc * 32 + fq * 8;
          float a[8];
#pragma unroll
          for (int n = 0; n < 2; ++n) { const f32x4 g = acc[ai][0][m][n], u = acc[ai][1][m][n];
#pragma unroll
            for (int k = 0; k < 4; ++k) a[n * 4 + k] = silu_f(g[k]) * u[k]; }
          u32x4 w = {cvtpk(a[0], a[1]), cvtpk(a[2], a[3]), cvtpk(a[4], a[5]), cvtpk(a[6], a[7])}; *(u32x4*)(act + (size_t)row * 1024 + col) = w;
        }
  }
}
__device__ void phase_moe_down(PRef p, int l, char* smem) {
  LAS unsigned char* lds = (LAS unsigned char*)smem;
  const bf16_t* act = (const bf16_t*)(p.ws + WS_ACT); const bf16_t* Wdn = (const bf16_t*)(p.ws + WS_WDN); bf16_t* oute = (bf16_t*)(p.ws + WS_OUTE); const float* GV = (const float*)(p.ws + WS_GV);
  const int tid = otid(), wid = tid >> 6, lane = tid & 63, wr = wid >> 2, wc = wid & 3, fr = lane & 15, fq = lane >> 4;
  g8::MoeIter it; it.init(4, l == 0);
  int pm, pn, e;
  while (it.next(pm, pn, e)) {
    unsigned voffA[2] = {g8::piece_off(0, 1024, 0), g8::piece_off(1, 1024, 0)};
    f32x4 acc[2][2][4][2];
    g8::gemm_tile<false>(lds, (const char*)(act + (size_t)pm * 256 * 1024), voffA, (size_t)128 * 1024 * 2, (const char*)(Wdn + ((size_t)e * 1024 + pn * 256) * 1024), 1024, acc);
    ACC_FOR3(ai, bj, m) {
      const int row = pm * 256 + ai * 128 + wr * 64 + m * 16 + fr, col = pn * 256 + bj * 128 + wc * 32 + fq * 8;
      const float gv = GV[row]; const f32x4 v0 = acc[ai][bj][m][0] * gv, v1 = acc[ai][bj][m][1] * gv;
      u32x4 w = {cvtpk(v0[0], v0[1]), cvtpk(v0[2], v0[3]), cvtpk(v1[0], v1[1]), cvtpk(v1[2], v1[3])}; *(u32x4*)(oute + (size_t)row * 1024 + col) = w;
    }
  }
}

__device__ void phase_ln2(PRef p, int l) {
  const int lane = otid() & 63, gw = obid() * 8 + (otid() >> 6), nw = gridDim.x * 8;
  bf16_t* h = (bf16_t*)(p.ws + WS_H); float* ctxz = (float*)(p.ws + WS_CTXZ); const bf16_t* oute = (const bf16_t*)(p.ws + WS_OUTE); const int* TS = (const int*)(p.ws + WS_TS);
  const int nrows = l == 0 ? MT : MX;
  for (int row = gw; row < nrows; row += nw) {
    float* xr = row < MX ? p.out + (size_t)row * 1024 : ctxz + (size_t)(row - MX) * 1024;
    f32x4 mo[4];
#pragma unroll
    for (int i = 0; i < 4; ++i) mo[i] = (f32x4){0.f, 0.f, 0.f, 0.f};
    const int myR = lane < 16 ? (row < MX ? TS[((size_t)(row >> 13) * 16 + lane) * SEQ + (row & 8191)] : TS[(size_t)NB * 16 * SEQ + ((size_t)((row - MX) >> 8) * 16 + lane) * CTXL + ((row - MX) & 255)]) : -1;
    for (int e = 0; e < 16; ++e) { const int Rr = __shfl(myR, e);
      if (Rr >= 0) {
#pragma unroll
        for (int i = 0; i < 4; ++i) { const u32x2 w = *(const u32x2*)(oute + (size_t)Rr * 1024 + lane * 4 + 256 * i);
          mo[i][0] += bflo(w[0]); mo[i][1] += bfhi(w[0]); mo[i][2] += bflo(w[1]); mo[i][3] += bfhi(w[1]); } } }
    f32x4 v[4]; const float* m5 = mod_ptr(p, l, row, 5);
#pragma unroll
    for (int i = 0; i < 4; ++i) { const int c = lane * 4 + 256 * i; v[i] = *(const f32x4*)(xr + c) * ALPHA + *(const f32x4*)(m5 + c) * mo[i]; }
    ln_row(v, 1e-5f);
#pragma unroll
    for (int i = 0; i < 4; ++i) { const int c = lane * 4 + 256 * i; v[i] = v[i] * *(const f32x4*)(p.ln2_g + l * 1024 + c) + *(const f32x4*)(p.ln2_b + l * 1024 + c); *(f32x4*)(xr + c) = v[i]; }
    if (l + 1 < DEPTH) { ln_row(v, 1e-6f); store_mod_bf16(v, mod_ptr(p, l + 1, row, 0), mod_ptr(p, l + 1, row, 1), h + (size_t)row * 1024, lane, nullptr); }
  }
}

#if DBG_BAR
__device__ int g_phase_dummy;
#endif
__device__ __forceinline__ void gsync(cg::grid_group& grid, PRef p, int& phase) {
#if DBG_BAR
  int* flags = (int*)(p.ws + WS_END); int* err = flags + 1024;
  ++phase;
  if (otid() == 0) flags[obid()] = phase;
#endif
  asm volatile("s_waitcnt vmcnt(0) lgkmcnt(0)" ::: "memory");
  grid.sync();
#if DBG_BAR
  if (otid() < (int)gridDim.x) { if (flags[otid()] != phase) atomicAdd(err, 1); }
#endif
}
__device__ void dbg_dump_bf16(PRef p, size_t off) {
  const bf16_t* src = (const bf16_t*)(p.ws + off);
  for (size_t i = (size_t)obid() * 512 + otid(); i < (size_t)MX * 1024; i += (size_t)gridDim.x * 512) p.out[i] = bf2f(src[i]);
}
__global__ void __launch_bounds__(512) mega(Params p) {
  extern __shared__ __attribute__((aligned(16))) char smem[];
  cg::grid_group grid = cg::this_grid();
  int phase = 0;
#if DBG_BAR
  if (obid() == 0 && otid() == 0) ((int*)(kparams().ws + WS_END))[1024] = 0;
#endif
  phase_prep(kparams(), smem);
  gsync(grid, kparams(), phase);
  phase_h0(kparams());
  gsync(grid, kparams(), phase);
#pragma unroll 1
  for (int l = 0; l < DEPTH; ++l) {
#if DBG_STOP == 0
    dbg_dump_bf16(kparams(), WS_H); return;
#endif
#pragma unroll 1
    for (int rep = 0; rep < DBG_REP_INPROJ; ++rep) { phase_inproj(kparams(), l, smem); gsync(grid, kparams(), phase); }
#if DBG_STOP == 1
    dbg_dump_bf16(kparams(), WS_P); return;
#endif
#if DBG_STOP == 12
    dbg_dump_bf16(kparams(), WS_P + (size_t)23000 * PLD * 2); return;
#endif
#if DBG_STOP == 11
    { PRef q = kparams(); const float* gsrc = (const float*)(q.ws + WS_GATES); const bf16_t* ps = (const bf16_t*)(q.ws + WS_P);
      for (size_t i = (size_t)obid() * 512 + otid(); i < (size_t)MX * 1024; i += (size_t)gridDim.x * 512)
        q.out[i] = i < (size_t)MT * 16 ? gsrc[i] : bf2f(ps[(size_t)MT * PLD - 1 - (i - (size_t)MT * 16)]); }
    return;
#endif
#if DBG_STOP == 24
#pragma unroll 1
    for (int rep = 0; rep < 2; ++rep) { phase_mlstm(kparams(), l, smem, opaque_s(rep) ? WS_Q : WS_HB); gsync(grid, kparams(), phase); }
    { PRef q = kparams(); const bf16_t* a = (const bf16_t*)(q.ws + WS_HB); const bf16_t* b2 = (const bf16_t*)(q.ws + WS_Q);
      for (size_t i = (size_t)obid() * 512 + otid(); i < (size_t)MX * 1024; i += (size_t)gridDim.x * 512) q.out[i] = bf2f(a[i]) - bf2f(b2[i]); }
    return;
#else
#pragma unroll 1
    for (int rep = 0; rep < DBG_REP_MLSTM; ++rep) { phase_mlstm(kparams(), l, smem); gsync(grid, kparams(), phase); }
#endif
#if DBG_STOP == 2
    dbg_dump_bf16(kparams(), WS_HB); return;
#endif
#if DBG_STOP == 23
    return;
#endif
#if DBG_STOP == 22
    { PRef q = kparams(); const int nerr = ((const int*)(q.ws + WS_END))[1024];
      for (size_t i = (size_t)obid() * 512 + otid(); i < (size_t)MX * 1024; i += (size_t)gridDim.x * 512) q.out[i] = i < 1024 ? 1000.f * (float)nerr : 0.f; }
    return;
#endif
    phase_mla_prep(kparams(), l, smem);
    gsync(grid, kparams(), phase);
#pragma unroll 1
    for (int rep = 0; rep < DBG_REP_ATTN; ++rep) { phase_attn(kparams(), l, smem); gsync(grid, kparams(), phase); }
#if DBG_STOP == 4
    dbg_dump_bf16(kparams(), WS_MIX); return;
#endif
    phase_outproj(kparams(), l, smem);
    gsync(grid, kparams(), phase);
    phase_ln1(kparams(), l, smem);
    __syncthreads();
#pragma unroll 1
    for (int rep = 0; rep < DBG_REP_CVT; ++rep) phase_cvt_experts(kparams(), l, smem);
    gsync(grid, kparams(), phase);
#if DBG_STOP == 6
    if (l == 0) return;
#endif
    phase_topk(kparams(), l, smem);
    gsync(grid, kparams(), phase);
#pragma unroll 1
    for (int rep = 0; rep < DBG_REP_MOE; ++rep) {
    phase_moe_up(kparams(), l, smem);
    gsync(grid, kparams(), phase);
    phase_moe_down(kparams(), l, smem);
    gsync(grid, kparams(), phase);
    }
    phase_ln2(kparams(), l);
    gsync(grid, kparams(), phase);
#if DBG_STOP == 10
    if (l == 0) return;
#endif
  }
}

extern "C" void kernel_launch(void* const* d_in, const int* in_sizes, int n_in, void* d_out, int out_size,
                              void* d_ws, size_t ws_size, hipStream_t stream) {
  constexpr size_t kDynLds = 160 * 1024;
  static int grid_blocks = 0;
  if (!grid_blocks) {
    int dev = 0, cus = 0, per_cu = 0;
    (void)hipGetDevice(&dev);
    (void)hipDeviceGetAttribute(&cus, hipDeviceAttributeMultiprocessorCount, dev);
    (void)hipFuncSetAttribute((const void*)mega, hipFuncAttributeMaxDynamicSharedMemorySize, (int)kDynLds);
    (void)hipOccupancyMaxActiveBlocksPerMultiprocessor(&per_cu, mega, 512, kDynLds);
    grid_blocks = per_cu > 0 ? cus : 0;
    if (grid_blocks > 256) grid_blocks = 256;
    grid_blocks &= ~7;
    if (grid_blocks != 256) { fprintf(stderr, "this kernel needs 256 co-resident workgroups (got %d)\n", grid_blocks); grid_blocks = 0; }
    if (ws_size < WS_END) { fprintf(stderr, "workspace too small: %zu < %zu\n", ws_size, (size_t)WS_END); grid_blocks = 0; }
  }
  if (grid_blocks <= 0) return;
  Params p{};
  const float** pp = (const float**)&p;
  for (int i = 0; i < 24; ++i) pp[i] = (const float*)d_in[i];
  p.out = (float*)d_out; p.ws = (char*)d_ws;
  void* args[] = {&p};
  hipError_t e = hipLaunchCooperativeKernel((void*)mega, dim3(grid_blocks), dim3(512), args, kDynLds, stream);
  if (e != hipSuccess) fprintf(stderr, "cooperative launch failed: %s (grid %d)\n", hipGetErrorString(e), grid_blocks);
}
```

```cpp
#include <hip/hip_runtime.h>
#include <hip/hip_cooperative_groups.h>
#include <cstdio>
#include <cstdint>
namespace cg = cooperative_groups;

typedef unsigned short bf16_t;
typedef short bf16x8 __attribute__((ext_vector_type(8)));
typedef short s16x4 __attribute__((ext_vector_type(4)));
typedef float f32x4 __attribute__((ext_vector_type(4)));
typedef float f32x16 __attribute__((ext_vector_type(16)));
typedef unsigned u32x4 __attribute__((ext_vector_type(4)));
typedef unsigned u32x2 __attribute__((ext_vector_type(2)));
#define LAS __attribute__((address_space(3)))

constexpr int DM = 1024, NB = 8, SEQ = 8192, CTXL = 256, DEPTH = 2;
constexpr int MX = NB * SEQ, MC = NB * CTXL, MT = MX + MC;
constexpr int PLD = 2816;
constexpr int OFF_Q = 0, OFF_K = 512, OFF_V = 1024, OFF_O = 1536, OFF_G = 2048, OFF_CQ = 2064, OFF_CKV = 2448, OFF_KR = 2704, IN_COLS = 2768;
constexpr int SKV = SEQ + CTXL;
constexpr int NE = 16, CAPX = 1024, CAPC = 32;
constexpr int NSLOT = NB * NE * CAPX + NB * NE * CAPC;
constexpr float ALPHA = 1.4142135623730951f;
constexpr float A_SCALE = 0.07216878364870322f;

constexpr size_t al256(size_t v) { return (v + 255) / 256 * 256; }
constexpr size_t WS_H = 0;
constexpr size_t WS_P = WS_H + al256((size_t)MT * 1024 * 2);
constexpr size_t WS_Q = WS_P + al256((size_t)MT * PLD * 2);
constexpr size_t WS_KV = WS_Q + al256((size_t)MT * 768 * 2);
constexpr size_t WS_KR = WS_KV + al256((size_t)NB * SKV * 1024 * 2);
constexpr size_t WS_MIX = WS_KR + al256((size_t)NB * SKV * 64 * 2);
constexpr size_t WS_ACT = WS_P;
constexpr size_t WS_HB = WS_H;
constexpr size_t WS_OUTE = WS_P + al256((size_t)NSLOT * 1024 * 2);
constexpr size_t WS_WGU = WS_MIX;
constexpr size_t WS_WDN = WS_MIX + (size_t)NE * 2048 * 1024 * 2;
constexpr size_t WS_WIN = WS_MIX + al256((size_t)MT * 1024 * 2);
constexpr size_t WS_WUQ = WS_WIN + (size_t)2 * PLD * 1024 * 2;
constexpr size_t WS_WUKV = WS_WUQ + (size_t)2 * 768 * 384 * 2;
constexpr size_t WS_WOUT = WS_WUKV + (size_t)2 * 1024 * 256 * 2;
constexpr size_t WS_MOD = WS_WOUT + (size_t)2 * 1024 * 1024 * 2;
constexpr size_t WS_COS = WS_MOD + al256((size_t)2 * 9 * 6144 * 4);
constexpr size_t WS_SIN = WS_COS + (size_t)SEQ * 32 * 4;
constexpr size_t WS_GATES = WS_SIN + (size_t)SEQ * 32 * 4;
constexpr size_t WS_AFF = WS_GATES + (size_t)MT * 16 * 4;
constexpr size_t WS_IDX = WS_AFF + (size_t)MT * 16 * 4;
constexpr size_t WS_GV = WS_IDX + (size_t)NSLOT * 4;
constexpr size_t WS_TS = WS_GV + (size_t)NSLOT * 4;
constexpr size_t WS_CTXZ = WS_TS + (size_t)MT * 16 * 4;
constexpr size_t WS_END = WS_CTXZ + (size_t)MC * 1024 * 4;
static_assert(WS_OUTE + (size_t)NSLOT * 1024 * 2 <= WS_KR, "out_e overlay");
static_assert(WS_WDN + (size_t)NE * 1024 * 1024 * 2 <= WS_WIN, "expert weights overlay");

struct Params {
  const float *x, *c, *ctx, *c_ctx, *w_mod, *b_mod, *w_in, *b_gates, *conv_w, *conv_b, *m_norm_w, *q_norm_w, *kv_norm_w, *w_uq, *w_ukv, *w_out,
      *ln1_g, *ln1_b, *w_router, *w_gate, *w_up, *w_down, *ln2_g, *ln2_b;
  float* out; char* ws;
};

typedef const __attribute__((address_space(4))) Params& PRef;
__device__ __forceinline__ PRef kparams() { const __attribute__((address_space(4))) Params* kp = (const __attribute__((address_space(4))) Params*)__builtin_amdgcn_kernarg_segment_ptr(); asm volatile("" : "+s"(kp)); return *kp; }
__device__ __forceinline__ int otid() { int t = threadIdx.x; asm volatile("" : "+v"(t)); return t; }
__device__ __forceinline__ int obid() { int t = blockIdx.x; asm volatile("" : "+s"(t)); return t; }
__device__ __forceinline__ int opaque_s(int v) { asm volatile("" : "+s"(v)); return v; }
typedef __bf16 bf16v2_t __attribute__((ext_vector_type(2)));
typedef float f32x2_t __attribute__((ext_vector_type(2)));
__device__ __forceinline__ unsigned cvtpk(float lo, float hi) { const f32x2_t f = {lo, hi}; const bf16v2_t b = __builtin_convertvector(f, bf16v2_t); return __builtin_bit_cast(unsigned, b); }
__device__ __forceinline__ bf16_t f2bf(float v) { return (bf16_t)(cvtpk(v, v) & 0xffffu); }
__device__ __forceinline__ float bf2f(unsigned v) { return __uint_as_float(v << 16); }
__device__ __forceinline__ float bflo(unsigned w) { return __uint_as_float(w << 16); }
__device__ __forceinline__ float bfhi(unsigned w) { return __uint_as_float(w & 0xffff0000u); }
__device__ __forceinline__ float wave_sum(float v) { for (int o = 32; o > 0; o >>= 1) v += __shfl_xor(v, o); return v; }
__device__ __forceinline__ float wave_max(float v) { for (int o = 32; o > 0; o >>= 1) v = fmaxf(v, __shfl_xor(v, o)); return v; }
__device__ __forceinline__ float sigmoid_f(float v) { return __builtin_amdgcn_rcpf(1.f + __expf(-v)); }
__device__ __forceinline__ float silu_f(float v) { return v * sigmoid_f(v); }

namespace g8 {
constexpr int BK = 64, HALF = 128, HTB = HALF * BK * 2, STAGE_BYTES = 8 * HTB;
__device__ __forceinline__ int lds_byte(int r, int c) { const int st = (r >> 4) * 2 + (c >> 5), rr = r & 15, cc = c & 31, ob = rr * 64 + cc * 2; return st * 1024 + (ob ^ (((ob >> 9) & 1) << 5)); }
__device__ __forceinline__ int perm32(int rho) { const int n = rho >> 4, i = rho & 15; return 8 * (i >> 2) + 4 * n + (i & 3); }
__device__ __forceinline__ void stage_rc(int b, int& R, int& C) { const int st = b / 1024, sb = b % 1024, swz = sb ^ (((sb >> 9) & 1) << 5); R = (st >> 1) * 16 + swz / 64; C = (st & 1) * 32 + (swz % 64) / 2; }

template <bool GATHER>
__device__ __forceinline__ void gemm_tile(LAS unsigned char* lds, const char* __restrict__ Ab, const unsigned (&voffA)[GATHER ? 4 : 2], size_t hstepA, const char* __restrict__ Bb, int K,
                                          f32x4 (&acc)[2][2][4][2]) {
  const int tid = otid(), wid = __builtin_amdgcn_readfirstlane(tid >> 6), lane = tid & 63, wr = wid >> 2, wc = wid & 3, fr = lane & 15, fq = lane >> 4;
  const int nt = K / BK;
  unsigned voffB[2];
#pragma unroll
  for (int i = 0; i < 2; ++i) { int R, C; stage_rc(tid * 16 + i * 8192, R, C); const int Rb = (R & ~31) + perm32(R & 31); voffB[i] = (unsigned)(Rb * K + C) * 2u; }
  const char* Bb1 = Bb + (size_t)HALF * K * 2; const char* Ab1 = GATHER ? Ab : Ab + hstepA;
  const unsigned* vA0 = &voffA[0]; const unsigned* vA1 = GATHER ? &voffA[2] : &voffA[0];
  const unsigned ldsw = (unsigned)wid * 1024u;
  const int aoff = lds_byte(wr * 64 + fr, fq * 8), boff = lds_byte(wc * 32 + fr, fq * 8);
#define G8_SA(b, h) (((b) * 2 + (h)) * HTB)
#define G8_SB(b, h) ((4 + (b) * 2 + (h)) * HTB)
#define G8_STAGE(bufoff, gbase, voff, kt) do { _Pragma("unroll") for (int _i = 0; _i < 2; ++_i) \
    __builtin_amdgcn_global_load_lds((const unsigned*)((gbase) + (size_t)(kt) * (BK * 2) + (voff)[_i]), (LAS unsigned*)(lds + (bufoff) + ldsw + _i * 8192), 16, 0, 0); } while (0)
#define G8_LDA(dst, b, h) do { _Pragma("unroll") for (int m = 0; m < 4; ++m) _Pragma("unroll") for (int k = 0; k < 2; ++k) dst[m][k] = *(const LAS bf16x8*)(lds + G8_SA(b, h) + aoff + m * 2048 + k * 1024); } while (0)
#define G8_LDB(dst, b, h) do { _Pragma("unroll") for (int n = 0; n < 2; ++n) _Pragma("unroll") for (int k = 0; k < 2; ++k) dst[n][k] = *(const LAS bf16x8*)(lds + G8_SB(b, h) + boff + n * 2048 + k * 1024); } while (0)
#define G8_MMA(ai, bj, At, Bt) do { __builtin_amdgcn_s_setprio(1); _Pragma("unroll") for (int m = 0; m < 4; ++m) _Pragma("unroll") for (int n = 0; n < 2; ++n) _Pragma("unroll") for (int k = 0; k < 2; ++k) \
    acc[ai][bj][m][n] = __builtin_amdgcn_mfma_f32_16x16x32_bf16(Bt[n][k], At[m][k], acc[ai][bj][m][n], 0, 0, 0); __builtin_amdgcn_s_setprio(0); } while (0)
#define G8_WAIT_V(n) asm volatile("s_waitcnt vmcnt(" #n ")" ::: "memory")
#define G8_WAIT_L(n) asm volatile("s_waitcnt lgkmcnt(" #n ")" ::: "memory")
#define G8_BAR __builtin_amdgcn_s_barrier()
#define G8_SCHED __builtin_amdgcn_sched_barrier(0)
#pragma unroll
  for (int a = 0; a < 2; ++a)
#pragma unroll
    for (int b = 0; b < 2; ++b)
#pragma unroll
      for (int m = 0; m < 4; ++m)
#pragma unroll
        for (int n = 0; n < 2; ++n) acc[a][b][m][n] = (f32x4){0.f, 0.f, 0.f, 0.f};
  bf16x8 At[4][2], B0[2][2], B1[2][2];
  G8_WAIT_V(0); __syncthreads();
  G8_STAGE(G8_SB(0, 0), Bb, voffB, 0); G8_STAGE(G8_SA(0, 0), Ab, vA0, 0); G8_STAGE(G8_SB(0, 1), Bb1, voffB, 0); G8_STAGE(G8_SA(0, 1), Ab1, vA1, 0);
  if (wr == 1) G8_BAR;
  G8_WAIT_V(4); G8_BAR;
  G8_STAGE(G8_SB(1, 0), Bb, voffB, 1); G8_STAGE(G8_SA(1, 0), Ab, vA0, 1); G8_STAGE(G8_SB(1, 1), Bb1, voffB, 1);
  G8_WAIT_V(6); G8_BAR;
  for (int t = 0; t < nt - 2; t += 2) {
    G8_LDB(B0, 0, 0); G8_SCHED; G8_LDA(At, 0, 0); G8_STAGE(G8_SA(1, 1), Ab1, vA1, t + 1);
    G8_WAIT_L(8); G8_BAR; G8_WAIT_L(0); G8_MMA(0, 0, At, B0); G8_BAR; G8_SCHED;
    G8_LDB(B1, 0, 1); G8_STAGE(G8_SB(0, 0), Bb, voffB, t + 2);
    G8_BAR; G8_WAIT_L(0); G8_MMA(0, 1, At, B1); G8_BAR;
    G8_LDA(At, 0, 1); G8_STAGE(G8_SA(0, 0), Ab, vA0, t + 2);
    G8_BAR; G8_WAIT_L(0); G8_MMA(1, 0, At, B0); G8_BAR; G8_SCHED;
    G8_STAGE(G8_SB(0, 1), Bb1, voffB, t + 2);
    G8_WAIT_V(6); G8_BAR; G8_MMA(1, 1, At, B1); G8_BAR;
    G8_LDB(B0, 1, 0); G8_SCHED; G8_LDA(At, 1, 0); G8_STAGE(G8_SA(0, 1), Ab1, vA1, t + 2);
    G8_WAIT_L(8); G8_BAR; G8_WAIT_L(0); G8_MMA(0, 0, At, B0); G8_BAR; G8_SCHED;
    G8_LDB(B1, 1, 1); G8_STAGE(G8_SB(1, 0), Bb, voffB, t + 3);
    G8_BAR; G8_WAIT_L(0); G8_MMA(0, 1, At, B1); G8_BAR;
    G8_LDA(At, 1, 1); G8_STAGE(G8_SA(1, 0), Ab, vA0, t + 3);
    G8_BAR; G8_WAIT_L(0); G8_MMA(1, 0, At, B0); G8_BAR; G8_SCHED;
    G8_STAGE(G8_SB(1, 1), Bb1, voffB, t + 3);
    G8_WAIT_V(6); G8_BAR; G8_MMA(1, 1, At, B1); G8_BAR;
  }
  { G8_LDB(B0, 0, 0); G8_LDA(At, 0, 0); G8_STAGE(G8_SA(1, 1), Ab1, vA1, nt - 1);
    G8_BAR; G8_WAIT_L(0); G8_MMA(0, 0, At, B0); G8_BAR;
    G8_LDB(B1, 0, 1); G8_BAR; G8_WAIT_L(0); G8_MMA(0, 1, At, B1); G8_BAR;
    G8_LDA(At, 0, 1); G8_WAIT_V(4); G8_BAR; G8_WAIT_L(0); G8_MMA(1, 0, At, B0); G8_MMA(1, 1, At, B1); G8_BAR; }
  { G8_LDB(B0, 1, 0); G8_LDA(At, 1, 0); G8_WAIT_V(2); G8_BAR; G8_WAIT_L(0); G8_MMA(0, 0, At, B0); G8_BAR;
    G8_LDB(B1, 1, 1); G8_WAIT_V(0); G8_BAR; G8_WAIT_L(0); G8_MMA(0, 1, At, B1); G8_BAR;
    G8_LDA(At, 1, 1); G8_BAR; G8_WAIT_L(0); G8_MMA(1, 0, At, B0); G8_MMA(1, 1, At, B1); G8_BAR; }
  if (wr == 0) G8_BAR;
}
__device__ __forceinline__ unsigned piece_off(int i, int ld, int c0) { int R, C; stage_rc((int)otid() * 16 + i * 8192, R, C); return (unsigned)(R * ld + c0 + C) * 2u; }
__device__ __forceinline__ void piece_rc(int i, int& R, int& C) { stage_rc((int)otid() * 16 + i * 8192, R, C); }
struct TileIter {
  int nM, nN, x, j, J, cnt, idx;
  __device__ __forceinline__ void init(int nM_, int nN_) { nM = nM_; nN = nN_; x = obid() & 7; j = obid() >> 3; J = gridDim.x >> 3; cnt = ((nM - x + 7) >> 3) * nN; idx = j; }
  __device__ __forceinline__ bool next(int& pm, int& pn) { if (idx >= cnt) return false; pm = x + 8 * (idx / nN); pn = idx % nN; idx += J; return true; }
};
struct MoeIter {
  int nN, x, jm, jn, j, step, nsteps, nb4; bool with_ctx, ctx_done;
  __device__ __forceinline__ void init(int nN_, bool with_ctx_) { nN = nN_; with_ctx = with_ctx_; x = obid() & 7; j = obid() >> 3; jm = j & 7; jn = j >> 3; nb4 = nN >> 2; nsteps = 2 * nb4 * 4; step = 0; ctx_done = false; }
  __device__ __forceinline__ bool next(int& pm, int& pn, int& e) {
    if (step < nsteps) { const int mb = step & 3, nb = (step >> 2) % nb4, el = (step >> 2) / nb4; e = 2 * x + el; const int m32 = mb * 8 + jm; pm = ((m32 >> 2) * 16 + e) * 4 + (m32 & 3); pn = nb * 4 + jn; ++step; return true; }
    if (with_ctx && !ctx_done) { ctx_done = true; if (j < 2 * nN) { e = 2 * x + j / nN; pm = 512 + e; pn = j % nN; return true; } }
    return false;
  }
};
}

#define ACC_FOR3(ai, bj, m) _Pragma("unroll") for (int ai = 0; ai < 2; ++ai) _Pragma("unroll") for (int bj = 0; bj < 2; ++bj) _Pragma("unroll") for (int m = 0; m < 4; ++m)
#define ACC_FOR(ai, bj, m, n) _Pragma("unroll") for (int ai = 0; ai < 2; ++ai) _Pragma("unroll") for (int bj = 0; bj < 2; ++bj) _Pragma("unroll") for (int m = 0; m < 4; ++m) _Pragma("unroll") for (int n = 0; n < 2; ++n)

__device__ __forceinline__ void cvt_tile(const float* __restrict__ src, int N, int K, int k0, int n0, bf16_t* __restrict__ dst, long drow0, const float* __restrict__ kscale, float* lds) {
  const int tid = otid();
  { const int kr = tid >> 6, n = tid & 63;
#pragma unroll
    for (int i = 0; i < 8; ++i) { const int k = kr + 8 * i; float v = (n0 + n < N) ? src[(size_t)(k0 + k) * N + n0 + n] : 0.f; if (kscale) v *= kscale[k0 + k]; lds[k * 65 + n] = v; } }
  __syncthreads();
  { const int n = tid >> 3, k8 = (tid & 7) * 8; float v[8];
#pragma unroll
    for (int i = 0; i < 8; ++i) v[i] = lds[(k8 + i) * 65 + n];
    u32x4 w = {cvtpk(v[0], v[1]), cvtpk(v[2], v[3]), cvtpk(v[4], v[5]), cvtpk(v[6], v[7])};
    *(u32x4*)(dst + (size_t)(drow0 + n) * K + k0 + k8) = w; }
  __syncthreads();
}

__device__ void phase_prep(PRef p, char* smem) {
  float* lds = (float*)smem;
  bf16_t* Wt_in = (bf16_t*)(p.ws + WS_WIN); bf16_t* Wt_uq = (bf16_t*)(p.ws + WS_WUQ); bf16_t* Wt_ukv = (bf16_t*)(p.ws + WS_WUKV); bf16_t* Wt_out = (bf16_t*)(p.ws + WS_WOUT);
  float* mod = (float*)(p.ws + WS_MOD);
  constexpr int T_MOD = 192, T_IN = 2 * 16 * 44, T_UQ = 2 * 6 * 12, T_UKV = 2 * 4 * 16, T_OUT = 2 * 16 * 16, T_ROPE = 64;
  constexpr int E0 = T_MOD, E1 = E0 + T_IN, E2 = E1 + T_UQ, E3 = E2 + T_UKV, E4 = E3 + T_OUT, E5 = E4 + T_ROPE;
  const int tid = otid();
  for (int task = obid(); task < E5; task += gridDim.x) {
    if (task < E0) {
      const int l = task / 96, j0 = (task % 96) * 64;
      float* sc = lds;
      for (int i = tid; i < 9 * 1024; i += 512) { const int bb = i >> 10, d = i & 1023; const float v = bb < 8 ? p.c[bb * 1024 + d] : p.c_ctx[d]; sc[i] = v / (1.f + expf(-v)); }
      __syncthreads();
      const int col = tid & 63, ks = tid >> 6; float a[9];
#pragma unroll
      for (int bb = 0; bb < 9; ++bb) a[bb] = 0.f;
      const float* wm = p.w_mod + (size_t)l * 1024 * 6144 + j0 + col;
      for (int d = ks * 128; d < ks * 128 + 128; ++d) { const float w = wm[(size_t)d * 6144];
#pragma unroll
        for (int bb = 0; bb < 9; ++bb) a[bb] += sc[bb * 1024 + d] * w; }
      float* red = lds + 9 * 1024;
#pragma unroll
      for (int bb = 0; bb < 9; ++bb) red[(ks * 9 + bb) * 64 + col] = a[bb];
      __syncthreads();
      for (int i = tid; i < 9 * 64; i += 512) { const int bb = i >> 6, cc = i & 63; float s = 0.f;
        for (int k = 0; k < 8; ++k) s += red[(k * 9 + bb) * 64 + cc];
        mod[((size_t)l * 9 + bb) * 6144 + j0 + cc] = s + p.b_mod[l * 6144 + j0 + cc]; }
      __syncthreads();
    } else if (task < E1) { const int t = task - E0, l = t / 704, r = t % 704, kt = r / 44, nt = r % 44;
      cvt_tile(p.w_in + (size_t)l * 1024 * IN_COLS, IN_COLS, 1024, kt * 64, nt * 64, Wt_in + (size_t)l * PLD * 1024, nt * 64, nullptr, lds);
    } else if (task < E2) { const int t = task - E1, l = t / 72, r = t % 72, kt = r / 12, nt = r % 12;
      cvt_tile(p.w_uq + (size_t)l * 384 * 768, 768, 384, kt * 64, nt * 64, Wt_uq + (size_t)l * 768 * 384, nt * 64, p.q_norm_w + l * 384, lds);
    } else if (task < E3) { const int t = task - E2, l = t / 64, r = t % 64, kt = r / 16, nt = r % 16;
      cvt_tile(p.w_ukv + (size_t)l * 256 * 1024, 1024, 256, kt * 64, nt * 64, Wt_ukv + (size_t)l * 1024 * 256, nt * 64, p.kv_norm_w + l * 256, lds);
    } else if (task < E4) { const int t = task - E3, l = t / 256, r = t % 256, kt = r / 16, nt = r % 16;
      cvt_tile(p.w_out + (size_t)l * 1024 * 1024, 1024, 1024, kt * 64, nt * 64, Wt_out + (size_t)l * 1024 * 1024, nt * 64, nullptr, lds);
    } else {
      float* cs = (float*)(p.ws + WS_COS); float* sn = (float*)(p.ws + WS_SIN);
      for (int i = (task - E4) * 4096 + tid; i < (task - E4 + 1) * 4096; i += 512) { const int t = i >> 5, j = i & 31;
        const float inv = exp2f(-(float)(j & 15) * (13.287712379549449f / 16.f));
        const float pos = (float)(j < 16 ? (t >> 6) : (t & 63)); const float ang = pos * inv;
        const double a = (double)ang; const double k = rint(a * 0.15915494309189535); const float r = (float)(a - k * 6.283185307179586);
        cs[i] = __cosf(r); sn[i] = __sinf(r); }
    }
  }
}

__device__ void phase_cvt_experts(PRef p, int l, char* smem) {
  float* lds = (float*)smem;
  bf16_t* Wgu = (bf16_t*)(p.ws + WS_WGU); bf16_t* Wdn = (bf16_t*)(p.ws + WS_WDN);
  for (int task = obid(); task < NE * 768; task += gridDim.x) {
    const int e = task / 768, r = task % 768, which = r >> 8, kt = (r & 255) >> 4, nt = r & 15, n0 = nt * 64;
    const size_t eo = ((size_t)l * NE + e) * 1024 * 1024;
    if (which == 0) cvt_tile(p.w_gate + eo, 1024, 1024, kt * 64, n0, Wgu + (size_t)e * 2048 * 1024, (n0 >> 7) * 256 + (n0 & 127), nullptr, lds);
    else if (which == 1) cvt_tile(p.w_up + eo, 1024, 1024, kt * 64, n0, Wgu + (size_t)e * 2048 * 1024, (n0 >> 7) * 256 + 128 + (n0 & 127), nullptr, lds);
    else cvt_tile(p.w_down + eo, 1024, 1024, kt * 64, n0, Wdn + (size_t)e * 1024 * 1024, n0, nullptr, lds);
  }
}

__device__ __forceinline__ void ln_row(f32x4 (&v)[4], float eps) {
  float s = 0.f;
#pragma unroll
  for (int i = 0; i < 4; ++i) s += v[i][0] + v[i][1] + v[i][2] + v[i][3];
  const float mu = wave_sum(s) * (1.f / 1024.f);
  float q = 0.f;
#pragma unroll
  for (int i = 0; i < 4; ++i)
#pragma unroll
    for (int k = 0; k < 4; ++k) { v[i][k] -= mu; q += v[i][k] * v[i][k]; }
  const float rs = rsqrtf(wave_sum(q) * (1.f / 1024.f) + eps);
#pragma unroll
  for (int i = 0; i < 4; ++i) v[i] *= rs;
}
__device__ __forceinline__ void store_mod_bf16(const f32x4 (&v)[4], const float* __restrict__ shift, const float* __restrict__ scale, bf16_t* __restrict__ hrow, int lane, f32x4 (*keep)[4]) {
#pragma unroll
  for (int i = 0; i < 4; ++i) { const int c = lane * 4 + 256 * i; const f32x4 sh = *(const f32x4*)(shift + c), sc = *(const f32x4*)(scale + c);
    f32x4 o = v[i] * (sc + 1.f) + sh; if (keep) (*keep)[i] = o;
    u32x2 w = {cvtpk(o[0], o[1]), cvtpk(o[2], o[3])}; *(u32x2*)(hrow + c) = w; }
}
__device__ __forceinline__ const float* mod_ptr(PRef p, int l, int row, int which) {
  const int bb = row < MX ? (row >> 13) : 8;
  return (const float*)(p.ws + WS_MOD) + ((size_t)l * 9 + bb) * 6144 + which * 1024;
}

__device__ void phase_h0(PRef p) {
  const int lane = otid() & 63, gw = obid() * 8 + (otid() >> 6), nw = gridDim.x * 8;
  bf16_t* h = (bf16_t*)(p.ws + WS_H);
  for (int row = gw; row < MT; row += nw) {
    const float* src = row < MX ? p.x + (size_t)row * 1024 : p.ctx + (size_t)(row - MX) * 1024;
    f32x4 v[4];
#pragma unroll
    for (int i = 0; i < 4; ++i) v[i] = *(const f32x4*)(src + lane * 4 + 256 * i);
    ln_row(v, 1e-6f);
    store_mod_bf16(v, mod_ptr(p, 0, row, 0), mod_ptr(p, 0, row, 1), h + (size_t)row * 1024, lane, nullptr);
  }
}

__device__ void phase_inproj(PRef p, int l, char* smem) {
  LAS unsigned char* lds = (LAS unsigned char*)smem;
  const bf16_t* h = (const bf16_t*)(p.ws + WS_H); const bf16_t* Wt = (const bf16_t*)(p.ws + WS_WIN) + (size_t)l * PLD * 1024;
  bf16_t* P = (bf16_t*)(p.ws + WS_P); float* gates = (float*)(p.ws + WS_GATES);
  const int tid = otid(), wid = tid >> 6, lane = tid & 63, wr = wid >> 2, wc = wid & 3, fr = lane & 15, fq = lane >> 4;
  g8::TileIter it; it.init(MT / 256, PLD / 256);
  int pm, pn;
  while (it.next(pm, pn)) {
    unsigned voffA[2] = {g8::piece_off(0, 1024, 0), g8::piece_off(1, 1024, 0)};
    f32x4 acc[2][2][4][2];
    g8::gemm_tile<false>(lds, (const char*)(h + (size_t)pm * 256 * 1024), voffA, (size_t)128 * 1024 * 2, (const char*)(Wt + (size_t)pn * 256 * 1024), 1024, acc);
    ACC_FOR3(ai, bj, m) {
      const int row = pm * 256 + ai * 128 + wr * 64 + m * 16 + fr, col = pn * 256 + bj * 128 + wc * 32 + fq * 8;
      const f32x4 v0 = acc[ai][bj][m][0], v1 = acc[ai][bj][m][1];
      u32x4 w = {cvtpk(v0[0], v0[1]), cvtpk(v0[2], v0[3]), cvtpk(v1[0], v1[1]), cvtpk(v1[2], v1[3])}; *(u32x4*)(P + (size_t)row * PLD + col) = w;
      if (col >= OFF_G && col < OFF_G + 16) { const f32x4 bg0 = *(const f32x4*)(p.b_gates + l * 16 + (col - OFF_G)), bg1 = *(const f32x4*)(p.b_gates + l * 16 + (col - OFF_G) + 4);
        *(f32x4*)(gates + (size_t)row * 16 + (col - OFF_G)) = v0 + bg0; *(f32x4*)(gates + (size_t)row * 16 + (col - OFF_G) + 4) = v1 + bg1; }
    }
  }
}


__device__ void phase_mlstm(PRef p, int l, char* smem) {
  bf16_t* RAWQ = (bf16_t*)(smem); bf16_t* RAWK = (bf16_t*)(smem + 17408);
  bf16_t* QB = (bf16_t*)(smem + 34816); bf16_t* KB = (bf16_t*)(smem + 52224);
  bf16_t* KT = (bf16_t*)(smem + 69632);
  bf16_t* VT = (bf16_t*)(smem + 88064); bf16_t* VWT = (bf16_t*)(smem + 94976);
  bf16_t* PB = (bf16_t*)(smem + 101888);
  bf16_t* CT = (bf16_t*)(smem + 111104);
  float* SC = (float*)(smem + 124160);
  const bf16_t* P = (const bf16_t*)(p.ws + WS_P); const float* gates = (const float*)(p.ws + WS_GATES);
  bf16_t* hbuf = (bf16_t*)(p.ws + WS_HB);
  const int tid = otid(), wid = tid >> 6, lane = tid & 63, fr = lane & 15, fq = lane >> 4;
  for (int w = obid(); w < 256; w += gridDim.x) {
    const int slice = w & 3, dir = (w >> 2) & 1, hd = (w >> 3) & 3, b = w >> 5;
    const int c2 = (tid & 63) * 2;
    float wq0[5], wq1[5], wk0[5], wk1[5];
#pragma unroll
    for (int j = 0; j < 5; ++j) { const float* cw = p.conv_w + ((size_t)l * 5 + j) * 1024; wq0[j] = cw[hd * 128 + c2]; wq1[j] = cw[hd * 128 + c2 + 1]; wk0[j] = cw[512 + hd * 128 + c2]; wk1[j] = cw[512 + hd * 128 + c2 + 1]; }
    const float bq0 = p.conv_b[l * 1024 + hd * 128 + c2], bq1 = p.conv_b[l * 1024 + hd * 128 + c2 + 1], bk0 = p.conv_b[l * 1024 + 512 + hd * 128 + c2], bk1 = p.conv_b[l * 1024 + 512 + hd * 128 + c2 + 1];
    __syncthreads();
    for (int i = tid; i < 48 * 136 / 2; i += 512) ((unsigned*)CT)[i] = 0u;
    for (int i = tid; i < 48 * 72 / 2; i += 512) { ((unsigned*)VT)[i] = 0u; ((unsigned*)VWT)[i] = 0u; }
    f32x4 accC[3];
#pragma unroll
    for (int i = 0; i < 3; ++i) accC[i] = (f32x4){0.f, 0.f, 0.f, 0.f};
    float m_state = 0.f;
    __syncthreads();
    u32x4 pre_raw[5]; u32x2 pre_v; float pre_ig = 0.f, pre_fg = 0.f;
    const int vl = tid >> 3, ve4 = (tid & 7) * 4;
#define MLSTM_PREFETCH(CI) do { const int ci_ = (CI); const bool ic_ = ci_ < 4; const int cc_ = ic_ ? ci_ : ci_ - 4, T_ = ic_ ? CTXL : SEQ, rb_ = ic_ ? MX + b * CTXL : b * SEQ; \
      const int tlo_ = dir ? T_ - 64 - cc_ * 64 : cc_ * 64; \
      _Pragma("unroll") for (int k_ = 0; k_ < 5; ++k_) { const int pc = tid + k_ * 512; pre_raw[k_] = (u32x4){0u, 0u, 0u, 0u}; \
        if (pc < 2176) { const int tens = pc >= 1088, rem = tens ? pc - 1088 : pc, rr = rem >> 4, c16 = rem & 15, t = tlo_ - 2 + rr; \
          if (t >= 0 && t < T_) pre_raw[k_] = *(const u32x4*)(P + (size_t)(rb_ + t) * PLD + (tens ? OFF_K : OFF_Q) + hd * 128 + c16 * 8); } } \
      { const int vt_ = dir ? tlo_ + 63 - vl : tlo_ + vl; pre_v = *(const u32x2*)(P + (size_t)(rb_ + vt_) * PLD + OFF_V + hd * 128 + slice * 32 + ve4); } \
      if (wid == 0) { const int t = dir ? tlo_ + 63 - lane : tlo_ + lane; const float* g = gates + (size_t)(rb_ + t) * 16; pre_ig = g[dir * 8 + hd]; pre_fg = g[dir * 8 + 4 + hd]; } } while (0)
    MLSTM_PREFETCH(0);
    for (int ci = 0; ci < 132; ++ci) {
      const bool isctx = ci < 4; const int cc = isctx ? ci : ci - 4, T = isctx ? CTXL : SEQ, rowbase = isctx ? MX + b * CTXL : b * SEQ;
      const int tlo = dir ? T - 64 - cc * 64 : cc * 64;
      float* S = SC + (ci & 1) * 384;
      const bool need_out = !(l == DEPTH - 1 && isctx);
      if (wid == 0) {
        const float ig = pre_ig, fg = pre_fg;
        const float lf = fminf(fg, 0.f) - log1pf(expf(-fabsf(fg)));
        float bc = lf;
#pragma unroll
        for (int o = 1; o < 64; o <<= 1) { const float u = __shfl_up(bc, o); if (lane >= o) bc += u; }
        const float a = ig - bc; float pmx = a;
#pragma unroll
        for (int o = 1; o < 64; o <<= 1) { const float u = __shfl_up(pmx, o); if (lane >= o) pmx = fmaxf(pmx, u); }
        const float Mx = fmaxf(pmx, m_state), M63 = __shfl(Mx, 63), b63 = __shfl(bc, 63);
        S[lane] = a; S[64 + lane] = Mx; S[128 + lane] = __expf(m_state - Mx); S[192 + lane] = __expf(-(bc + Mx)); S[256 + lane] = __expf(a - M63);
        if (lane == 0) { S[320] = __expf(m_state - M63); S[321] = b63 + M63; }
      }
#pragma unroll
      for (int k = 0; k < 5; ++k) { const int pc = tid + k * 512;
        if (pc < 2176) { const int tens = pc >= 1088, rem = tens ? pc - 1088 : pc, rr = rem >> 4, c16 = rem & 15; *(u32x4*)((tens ? RAWK : RAWQ) + rr * 128 + c16 * 8) = pre_raw[k]; } }
      const u32x2 vraw = pre_v;
      if (ci + 1 < 132) MLSTM_PREFETCH(ci + 1);
      __syncthreads();
      {
        const int rg = wid; unsigned rq[12], rk[12];
#pragma unroll
        for (int i = 0; i < 12; ++i) { rq[i] = *(const unsigned*)(RAWQ + (rg * 8 + i) * 128 + c2); rk[i] = *(const unsigned*)(RAWK + (rg * 8 + i) * 128 + c2); }
#pragma unroll
        for (int jj = 0; jj < 8; ++jj) {
          float yq0 = bq0, yq1 = bq1, yk0 = bk0, yk1 = bk1;
#pragma unroll
          for (int tp = 0; tp < 5; ++tp) { yq0 += wq0[tp] * bflo(rq[jj + tp]); yq1 += wq1[tp] * bfhi(rq[jj + tp]); yk0 += wk0[tp] * bflo(rk[jj + tp]); yk1 += wk1[tp] * bfhi(rk[jj + tp]); }
          const int j = rg * 8 + jj, lr = dir ? 63 - j : j;
          const float q0 = silu_f(yq0) * 0.08838834764831845f, q1 = silu_f(yq1) * 0.08838834764831845f, k0 = silu_f(yk0), k1 = silu_f(yk1);
          *(unsigned*)(QB + lr * 136 + c2) = cvtpk(q0, q1);
          const unsigned kw = cvtpk(k0, k1);
          *(unsigned*)(KB + lr * 136 + c2) = kw;
          KT[c2 * 72 + lr] = (bf16_t)(kw & 0xffffu); KT[(c2 + 1) * 72 + lr] = (bf16_t)(kw >> 16);
        }
        const float wsl = S[256 + vl];
        const float v0 = bflo(vraw[0]), v1 = bfhi(vraw[0]), v2 = bflo(vraw[1]), v3 = bfhi(vraw[1]);
        VT[(ve4 + 0) * 72 + vl] = (bf16_t)(vraw[0] & 0xffffu); VT[(ve4 + 1) * 72 + vl] = (bf16_t)(vraw[0] >> 16);
        VT[(ve4 + 2) * 72 + vl] = (bf16_t)(vraw[1] & 0xffffu); VT[(ve4 + 3) * 72 + vl] = (bf16_t)(vraw[1] >> 16);
        VWT[(ve4 + 0) * 72 + vl] = f2bf(v0 * wsl); VWT[(ve4 + 1) * 72 + vl] = f2bf(v1 * wsl); VWT[(ve4 + 2) * 72 + vl] = f2bf(v2 * wsl); VWT[(ve4 + 3) * 72 + vl] = f2bf(v3 * wsl);
        if (tid < 64) { VT[32 * 72 + tid] = (bf16_t)0x3F80u; VWT[32 * 72 + tid] = f2bf(S[256 + tid]); }
      }
      __syncthreads();
      if (need_out) {
        const int mt = wid >> 1;
#pragma unroll
        for (int u = 0; u < 2; ++u) {
          const int ntl = (wid & 1) * 2 + u;
          f32x4 s = {0.f, 0.f, 0.f, 0.f};
          if (ntl <= mt) {
#pragma unroll
            for (int kk = 0; kk < 4; ++kk) {
              const bf16x8 a = *(const bf16x8*)(QB + (mt * 16 + fr) * 136 + kk * 32 + fq * 8), bb = *(const bf16x8*)(KB + (ntl * 16 + fr) * 136 + kk * 32 + fq * 8);
              s = __builtin_amdgcn_mfma_f32_16x16x32_bf16(a, bb, s, 0, 0, 0); }
          }
          const int j = ntl * 16 + fr; const float aj = S[j];
#pragma unroll
          for (int jj = 0; jj < 4; ++jj) { const int lr = mt * 16 + fq * 4 + jj;
            const float pv = (j <= lr) ? s[jj] * __expf(fminf(aj - S[64 + lr], 0.f)) : 0.f;
            PB[lr * 72 + j] = f2bf(pv); }
        }
      }
      __syncthreads();
      if (need_out && wid < 4) {
        const int mt = wid; f32x4 num[3];
#pragma unroll
        for (int ntl = 0; ntl < 3; ++ntl) {
          f32x4 a1 = {0.f, 0.f, 0.f, 0.f}, a2 = {0.f, 0.f, 0.f, 0.f};
#pragma unroll
          for (int kk = 0; kk < 2; ++kk) { const bf16x8 a = *(const bf16x8*)(PB + (mt * 16 + fr) * 72 + kk * 32 + fq * 8), bb = *(const bf16x8*)(VT + (ntl * 16 + fr) * 72 + kk * 32 + fq * 8);
            a1 = __builtin_amdgcn_mfma_f32_16x16x32_bf16(a, bb, a1, 0, 0, 0); }
#pragma unroll
          for (int kk = 0; kk < 4; ++kk) { const bf16x8 a = *(const bf16x8*)(QB + (mt * 16 + fr) * 136 + kk * 32 + fq * 8), bb = *(const bf16x8*)(CT + (ntl * 16 + fr) * 136 + kk * 32 + fq * 8);
            a2 = __builtin_amdgcn_mfma_f32_16x16x32_bf16(a, bb, a2, 0, 0, 0); }
#pragma unroll
          for (int jj = 0; jj < 4; ++jj) num[ntl][jj] = a1[jj] + S[128 + mt * 16 + fq * 4 + jj] * a2[jj];
        }
#pragma unroll
        for (int jj = 0; jj < 4; ++jj) {
          const int lr = mt * 16 + fq * 4 + jj; const float den = __shfl(num[2][jj], lane & 48);
          const float rd = __builtin_amdgcn_rcpf(fmaxf(fabsf(den), S[192 + lr]));
          const int t = dir ? tlo + 63 - lr : tlo + lr;
          bf16_t* hp = hbuf + ((size_t)((dir * 4 + hd) * 4 + slice) * MT + rowbase + t) * 32 + fr;
          hp[0] = f2bf(num[0][jj] * rd); hp[16] = f2bf(num[1][jj] * rd);
        }
      }
      __syncthreads();
      {
        const float decay = S[320];
#pragma unroll
        for (int mt = 0; mt < 3; ++mt) {
          accC[mt] *= decay;
#pragma unroll
          for (int kk = 0; kk < 2; ++kk) { const bf16x8 a = *(const bf16x8*)(VWT + (mt * 16 + fr) * 72 + kk * 32 + fq * 8), bb = *(const bf16x8*)(KT + (wid * 16 + fr) * 72 + kk * 32 + fq * 8);
            accC[mt] = __builtin_amdgcn_mfma_f32_16x16x32_bf16(a, bb, accC[mt], 0, 0, 0); }
#pragma unroll
          for (int jj = 0; jj < 4; ++jj) CT[(mt * 16 + fq * 4 + jj) * 136 + wid * 16 + fr] = f2bf(accC[mt][jj]);
        }
        m_state = S[321];
      }
    }
  }
}

template <int WHICH>
__device__ __forceinline__ void mla_gemm(PRef p, int l, char* smem) {
  LAS unsigned char* lds = (LAS unsigned char*)smem; float* rsb = (float*)(smem + g8::STAGE_BYTES);
  const bf16_t* P = (const bf16_t*)(p.ws + WS_P);
  const int tid = otid(), wid = tid >> 6, lane = tid & 63, wr = wid >> 2, wc = wid & 3, fr = lane & 15, fq = lane >> 4;
  constexpr int K = WHICH ? 256 : 384, OFFC = WHICH ? OFF_CKV : OFF_CQ, N = WHICH ? 1024 : 768;
  const bf16_t* Wt = WHICH ? (const bf16_t*)(p.ws + WS_WUKV) + (size_t)l * 1024 * 256 : (const bf16_t*)(p.ws + WS_WUQ) + (size_t)l * 768 * 384;
  bf16_t* O = (bf16_t*)(p.ws + (WHICH ? WS_KV : WS_Q));
  g8::TileIter it; it.init((WHICH || l == 0) ? MT / 256 : MX / 256, N / 256);
  int pm, pn;
  while (it.next(pm, pn)) {
    __syncthreads();
    { const int r = tid >> 1, hf = tid & 1; const bf16_t* src = P + (size_t)(pm * 256 + r) * PLD + OFFC + hf * (K / 2); float s = 0.f;
#pragma unroll 4
      for (int i = 0; i < K / 16; ++i) { const u32x4 v = *(const u32x4*)(src + i * 8);
#pragma unroll
        for (int k = 0; k < 4; ++k) { const float a = bflo(v[k]), bq = bfhi(v[k]); s += a * a + bq * bq; } }
      s += __shfl_xor(s, 1);
      if (hf == 0) rsb[r] = rsqrtf(s / (float)K + 1e-6f); }
    unsigned voffA[2] = {g8::piece_off(0, PLD, OFFC), g8::piece_off(1, PLD, OFFC)};
    f32x4 acc[2][2][4][2];
    g8::gemm_tile<false>(lds, (const char*)(P + (size_t)pm * 256 * PLD), voffA, (size_t)128 * PLD * 2, (const char*)(Wt + (size_t)pn * 256 * K), opaque_s(K), acc);
    ACC_FOR3(ai, bj, m) {
      const int rl = ai * 128 + wr * 64 + m * 16 + fr, row = pm * 256 + rl, col = pn * 256 + bj * 128 + wc * 32 + fq * 8;
      const float rs = rsb[rl]; const f32x4 v0 = acc[ai][bj][m][0] * rs, v1 = acc[ai][bj][m][1] * rs;
      size_t orow = row;
      if (WHICH) orow = row < MX ? (size_t)(row >> 13) * SKV + CTXL + (row & 8191) : (size_t)((row - MX) >> 8) * SKV + ((row - MX) & 255);
      u32x4 w = {cvtpk(v0[0], v0[1]), cvtpk(v0[2], v0[3]), cvtpk(v1[0], v1[1]), cvtpk(v1[2], v1[3])}; *(u32x4*)(O + orow * N + col) = w;
    }
  }
}
__device__ void phase_mla_prep(PRef p, int l, char* smem) {
  mla_gemm<0>(p, l, smem);
  mla_gemm<1>(p, l, smem);
  const bf16_t* P = (const bf16_t*)(p.ws + WS_P);
  const int tid = otid(), wid = tid >> 6, lane = tid & 63;
  const bf16_t* hbuf = (const bf16_t*)(p.ws + WS_HB); bf16_t* mix = (bf16_t*)(p.ws + WS_MIX); bf16_t* KR = (bf16_t*)(p.ws + WS_KR);
  const float* cs = (const float*)(p.ws + WS_COS); const float* sn = (const float*)(p.ws + WS_SIN);
  const int gw = obid() * 8 + wid, nw = gridDim.x * 8;
  for (int row = gw; row < MT; row += nw) {
    if (row < MX || l == 0) {
      const size_t ho = ((size_t)(lane >> 2) * MT + row) * 32 + (lane & 3) * 8;
      const u32x4 hf = *(const u32x4*)(hbuf + ho), hb = *(const u32x4*)(hbuf + (size_t)16 * MT * 32 + ho);
      const u32x4 ov = *(const u32x4*)(P + (size_t)row * PLD + OFF_O + lane * 8);
      float v[8]; float s = 0.f;
#pragma unroll
      for (int k = 0; k < 4; ++k) { v[2 * k] = bflo(hf[k]) + bflo(hb[k]); v[2 * k + 1] = bfhi(hf[k]) + bfhi(hb[k]); s += v[2 * k] + v[2 * k + 1]; }
      s += __shfl_xor(s, 1); s += __shfl_xor(s, 2); s += __shfl_xor(s, 4); s += __shfl_xor(s, 8);
      const float mu = s * (1.f / 128.f); float q = 0.f;
#pragma unroll
      for (int k = 0; k < 8; ++k) { v[k] -= mu; q += v[k] * v[k]; }
      q += __shfl_xor(q, 1); q += __shfl_xor(q, 2); q += __shfl_xor(q, 4); q += __shfl_xor(q, 8);
      const float rs = rsqrtf(q * (1.f / 128.f) + 1e-6f);
      const float* nw_ = p.m_norm_w + l * 512 + lane * 8; float o[8];
#pragma unroll
      for (int k = 0; k < 4; ++k) { o[2 * k] = v[2 * k] * rs * nw_[2 * k] * sigmoid_f(bflo(ov[k])); o[2 * k + 1] = v[2 * k + 1] * rs * nw_[2 * k + 1] * sigmoid_f(bfhi(ov[k])); }
      u32x4 wv = {cvtpk(o[0], o[1]), cvtpk(o[2], o[3]), cvtpk(o[4], o[5]), cvtpk(o[6], o[7])};
      *(u32x4*)(mix + (size_t)row * 1024 + lane * 8) = wv;
    }
    {
      const int j = lane & 31;
      const float x1 = bf2f(P[(size_t)row * PLD + OFF_KR + j]), x2 = bf2f(P[(size_t)row * PLD + OFF_KR + 32 + j]);
      float o1 = x1, o2 = x2; size_t orow;
      if (row < MX) { const int t = row & 8191; const float c = cs[t * 32 + j], s_ = sn[t * 32 + j]; o1 = x1 * c - x2 * s_; o2 = x2 * c + x1 * s_; orow = (size_t)(row >> 13) * SKV + CTXL + t; }
      else orow = (size_t)((row - MX) >> 8) * SKV + ((row - MX) & 255);
      if (lane < 32) { KR[orow * 64 + j] = f2bf(o1); KR[orow * 64 + 32 + j] = f2bf(o2); }
    }
  }
}

namespace att {
constexpr int NW = 8, QBLK = 32, KVBLK = 64, LDQ = 768, LDK = 1024, LDKR = 64, LDO = 1024;
constexpr float SCALE = A_SCALE;
constexpr float THR = 8.f;
constexpr size_t SHM_V = KVBLK * 128 * 2, SHM_K = KVBLK * 128 * 2, SHM_R = KVBLK * 64 * 2;
typedef float f32x8 __attribute__((ext_vector_type(8)));
#define KSWZ(row, colB) ((row) * 256 + ((colB) ^ (((row) & 7) << 4)))
#define RSWZ(row, colB) ((row) * 128 + ((colB) ^ (((row) & 7) << 4)))
#define SBAR() __builtin_amdgcn_sched_barrier(0)
__device__ __forceinline__ int crow(int r, int hi) { return (r & 3) + 8 * (r >> 2) + 4 * hi; }
__device__ __forceinline__ void partialSM(f32x16& p0, f32x16& p1, float& m_reg, float& mn, float& alpha) {
  constexpr float C = SCALE * 1.4426950408889634f;
  float pmax = p0[0];
#pragma unroll
  for (int r = 1; r < 16; ++r) pmax = fmaxf(pmax, p0[r]);
#pragma unroll
  for (int r = 0; r < 16; ++r) pmax = fmaxf(pmax, p1[r]);
  { auto rr = __builtin_amdgcn_permlane32_swap(__float_as_uint(pmax), __float_as_uint(pmax), false, false);
    pmax = fmaxf(__uint_as_float(rr[0]), __uint_as_float(rr[1])); }
  if (__builtin_expect(__all(pmax - m_reg <= THR / SCALE), 1)) { mn = m_reg; alpha = 1.f; }
  else { mn = fmaxf(m_reg, pmax); alpha = __builtin_amdgcn_exp2f((m_reg - mn) * C); m_reg = mn; }
  const float mnC = -mn * C;
#pragma unroll
  for (int r = 0; r < 16; ++r) p0[r] = fmaf(p0[r], C, mnC);
#pragma unroll
  for (int r = 0; r < 16; ++r) p1[r] = fmaf(p1[r], C, mnC);
#pragma unroll
  for (int r = 0; r < 16; ++r) p0[r] = __builtin_amdgcn_exp2f(p0[r]);
}
__device__ __forceinline__ void finishSM(f32x16& p0, f32x16& p1, float alpha, float& l_reg, bf16x8& pa0, bf16x8& pa1, bf16x8& pa2, bf16x8& pa3) {
#pragma unroll
  for (int r = 0; r < 16; ++r) p1[r] = __builtin_amdgcn_exp2f(p1[r]);
  float ps = 0;
#pragma unroll
  for (int r = 0; r < 16; ++r) ps += p0[r];
#pragma unroll
  for (int r = 0; r < 16; ++r) ps += p1[r];
  { auto rr = __builtin_amdgcn_permlane32_swap(__float_as_uint(ps), __float_as_uint(ps), false, false);
    ps = __uint_as_float(rr[0]) + __uint_as_float(rr[1]); }
  l_reg = l_reg * alpha + ps;
#define PK4(P, BASE, OUT) do { unsigned a0 = cvtpk(P[BASE + 0], P[BASE + 1]), a1 = cvtpk(P[BASE + 2], P[BASE + 3]);   \
    unsigned b0 = cvtpk(P[BASE + 4], P[BASE + 5]), b1 = cvtpk(P[BASE + 6], P[BASE + 7]);                              \
    auto r0 = __builtin_amdgcn_permlane32_swap(a0, b0, false, false); auto r1 = __builtin_amdgcn_permlane32_swap(a1, b1, false, false); \
    u32x4 w = {r0[0], r1[0], r0[1], r1[1]}; OUT = *reinterpret_cast<bf16x8*>(&w); } while (0)
  PK4(p0, 0, pa0); PK4(p0, 8, pa1); PK4(p1, 0, pa2); PK4(p1, 8, pa3);
#undef PK4
}
__device__ __forceinline__ void qkt(f32x16& p0, f32x16& p1, const char* Ks, const char* Rs, const bf16x8* qr, const char* qrl, int r32, int hi) {
  p0 = f32x16{}; p1 = f32x16{};
#pragma unroll
  for (int d0 = 0; d0 < 8; ++d0) { const int cb = (d0 * 16 + hi * 8) * 2;
    const bf16x8 b0 = *reinterpret_cast<const bf16x8*>(Ks + KSWZ(r32, cb));
    const bf16x8 b1 = *reinterpret_cast<const bf16x8*>(Ks + KSWZ(32 + r32, cb));
    p0 = __builtin_amdgcn_mfma_f32_32x32x16_bf16(b0, qr[d0], p0, 0, 0, 0);
    p1 = __builtin_amdgcn_mfma_f32_32x32x16_bf16(b1, qr[d0], p1, 0, 0, 0); }
#pragma unroll
  for (int d0 = 0; d0 < 4; ++d0) { const int cb = (d0 * 16 + hi * 8) * 2;
    const bf16x8 b0 = *reinterpret_cast<const bf16x8*>(Rs + RSWZ(r32, cb));
    const bf16x8 b1 = *reinterpret_cast<const bf16x8*>(Rs + RSWZ(32 + r32, cb));
    const bf16x8 qv = *reinterpret_cast<const bf16x8*>(qrl + d0 * 1024);
    p0 = __builtin_amdgcn_mfma_f32_32x32x16_bf16(b0, qv, p0, 0, 0, 0);
    p1 = __builtin_amdgcn_mfma_f32_32x32x16_bf16(b1, qv, p1, 0, 0, 0); }
}
__device__ __forceinline__ int v_st(int k, int c) { const int kk = (k & ~0xC) | ((k & 4) << 1) | ((k & 8) >> 1); return ((kk >> 3) * 4 + (c >> 5)) * 512 + ((kk & 7) * 32 + (c & 31)) * 2; }
__device__ __forceinline__ int v_rd_base(int lane) { return ((lane & 3) << 3) | (((lane >> 2) & 3) << 6) | (((lane >> 4) & 1) << 5) | (((lane >> 5) & 1) << 8); }
constexpr int v_rd_off(int d0, int ks, int half) { return d0 * 512 + ks * 4096 + half * 2048; }
template <int OFF> __device__ __forceinline__ s16x4 tr_read(int vb) {
  s16x4 r; asm volatile("ds_read_b64_tr_b16 %0, %1 offset:%2" : "=&v"(r) : "v"(vb), "i"(OFF) : "memory"); return r;
}
template <int D0> __device__ __forceinline__ void pv_one(f32x16& od, int vb, bf16x8 pa0, bf16x8 pa1, bf16x8 pa2, bf16x8 pa3) {
  const s16x4 l0 = tr_read<v_rd_off(D0, 0, 0)>(vb), h0 = tr_read<v_rd_off(D0, 0, 1)>(vb), l1 = tr_read<v_rd_off(D0, 1, 0)>(vb), h1 = tr_read<v_rd_off(D0, 1, 1)>(vb);
  const s16x4 l2 = tr_read<v_rd_off(D0, 2, 0)>(vb), h2 = tr_read<v_rd_off(D0, 2, 1)>(vb), l3 = tr_read<v_rd_off(D0, 3, 0)>(vb), h3 = tr_read<v_rd_off(D0, 3, 1)>(vb);
  asm volatile("s_waitcnt lgkmcnt(0)" ::: "memory"); SBAR();
#define PK(L, H) (bf16x8){L[0], L[1], L[2], L[3], H[0], H[1], H[2], H[3]}
  od = __builtin_amdgcn_mfma_f32_32x32x16_bf16(pa0, PK(l0, h0), od, 0, 0, 0);
  od = __builtin_amdgcn_mfma_f32_32x32x16_bf16(pa1, PK(l1, h1), od, 0, 0, 0);
  od = __builtin_amdgcn_mfma_f32_32x32x16_bf16(pa2, PK(l2, h2), od, 0, 0, 0);
  od = __builtin_amdgcn_mfma_f32_32x32x16_bf16(pa3, PK(l3, h3), od, 0, 0, 0);
#undef PK
}
__device__ __forceinline__ void pv_d0(f32x16* o, int vb, bf16x8 pa0, bf16x8 pa1, bf16x8 pa2, bf16x8 pa3) {
  pv_one<0>(o[0], vb, pa0, pa1, pa2, pa3); pv_one<1>(o[1], vb, pa0, pa1, pa2, pa3); pv_one<2>(o[2], vb, pa0, pa1, pa2, pa3); pv_one<3>(o[3], vb, pa0, pa1, pa2, pa3);
}
__device__ __forceinline__ void attn_body(const bf16_t* __restrict__ Qb, const float* __restrict__ cs, const float* __restrict__ sn, const bf16_t* __restrict__ Kn,
                                          const bf16_t* __restrict__ Vh, const bf16_t* __restrict__ Kr, bf16_t* __restrict__ Ob, int seq, char* lds) {
  const int tid = otid(), wid = tid >> 6, lane = tid & 63, r32 = lane & 31, hi = lane >> 5;
  char* V_lds = lds; char* K_lds = lds + 2 * SHM_V; char* R_lds = lds + 2 * SHM_V + 2 * SHM_K;
  float* wsf = (float*)(lds + 2 * SHM_V + 2 * SHM_K + 2 * SHM_R) + wid * 64; float* li_l = wsf; float* al_l = wsf + 32;
  char* qrl = lds + 2 * SHM_V + 2 * SHM_K + 2 * SHM_R + 2048 + wid * 4096 + lane * 16;
  float m_reg = -1e30f, l_reg = 0; f32x16 o[4] = {}; bf16x8 qr[8];
  { const bf16_t* Qw = Qb + (size_t)(wid * QBLK + r32) * LDQ + hi * 8;
#pragma unroll
    for (int d0 = 0; d0 < 8; ++d0) qr[d0] = *(const bf16x8*)(Qw + d0 * 16);
#pragma unroll
    for (int d0 = 0; d0 < 2; ++d0) {
      const u32x4 a = *(const u32x4*)(Qw + 128 + d0 * 16), bq = *(const u32x4*)(Qw + 160 + d0 * 16);
      if (cs) {
        const float* cp = cs + (size_t)(wid * QBLK + r32) * 32 + d0 * 16 + hi * 8; const float* sp = sn + (size_t)(wid * QBLK + r32) * 32 + d0 * 16 + hi * 8;
        const f32x4 c0 = *(const f32x4*)cp, c1 = *(const f32x4*)(cp + 4), s0 = *(const f32x4*)sp, s1 = *(const f32x4*)(sp + 4);
        float x1[8], x2[8], y1[8], y2[8];
#pragma unroll
        for (int k = 0; k < 4; ++k) { x1[2 * k] = bflo(a[k]); x1[2 * k + 1] = bfhi(a[k]); x2[2 * k] = bflo(bq[k]); x2[2 * k + 1] = bfhi(bq[k]); }
#pragma unroll
        for (int k = 0; k < 8; ++k) { const float c = k < 4 ? c0[k & 3] : c1[k & 3], s = k < 4 ? s0[k & 3] : s1[k & 3]; y1[k] = x1[k] * c - x2[k] * s; y2[k] = x2[k] * c + x1[k] * s; }
        u32x4 w1 = {cvtpk(y1[0], y1[1]), cvtpk(y1[2], y1[3]), cvtpk(y1[4], y1[5]), cvtpk(y1[6], y1[7])}, w2 = {cvtpk(y2[0], y2[1]), cvtpk(y2[2], y2[3]), cvtpk(y2[4], y2[5]), cvtpk(y2[6], y2[7])};
        *(u32x4*)(qrl + d0 * 1024) = w1; *(u32x4*)(qrl + (2 + d0) * 1024) = w2;
      } else { *(u32x4*)(qrl + d0 * 1024) = a; *(u32x4*)(qrl + (2 + d0) * 1024) = bq; }
    } }
  const int sr = tid >> 4, sc = (tid & 15) * 8, vst0 = v_st(sr, sc), vst1 = v_st(32 + sr, sc);
  const int rr_ = tid >> 3, rc = (tid & 7) * 8;
  const int vb0 = (int)(uintptr_t)V_lds + v_rd_base(lane);
  bf16x8 vs0, vs1, ks0, ks1, rs0;
  const unsigned voffKV = (unsigned)(sr * LDK + sc) * 2u, voffR = (unsigned)(rr_ * LDKR + rc) * 2u;
#define SLOAD(k0) do { const char* kb_ = (const char*)Kn + (size_t)(k0) * (LDK * 2); const char* vb_ = (const char*)Vh + (size_t)(k0) * (LDK * 2); \
    vs0 = *(const bf16x8*)(vb_ + voffKV); vs1 = *(const bf16x8*)(vb_ + 32 * LDK * 2 + voffKV); \
    ks0 = *(const bf16x8*)(kb_ + voffKV); ks1 = *(const bf16x8*)(kb_ + 32 * LDK * 2 + voffKV); \
    rs0 = *(const bf16x8*)((const char*)Kr + (size_t)(k0) * (LDKR * 2) + voffR); } while (0)
#define SWRITE(b) do { *(bf16x8*)(V_lds + (b) * SHM_V + vst0) = vs0; *(bf16x8*)(V_lds + (b) * SHM_V + vst1) = vs1; const int kc = sc * 2;  \
    *(bf16x8*)(K_lds + (b) * SHM_K + KSWZ(sr, kc)) = ks0; *(bf16x8*)(K_lds + (b) * SHM_K + KSWZ(32 + sr, kc)) = ks1;                      \
    *(bf16x8*)(R_lds + (b) * SHM_R + RSWZ(rr_, rc * 2)) = rs0; } while (0)
#define RESC(a) do { if (__any((a) < 1.f)) { if (hi == 0) al_l[r32] = (a); asm volatile("s_waitcnt lgkmcnt(0)" ::: "memory"); \
    _Pragma("unroll") for (int d = 0; d < 4; ++d) _Pragma("unroll") for (int r = 0; r < 16; ++r) o[d][r] *= al_l[crow(r, hi)]; } } while (0)
  f32x16 pA0, pA1, pB0, pB1; float mnA, mnB, alA, alB; bf16x8 pa0, pa1, pa2, pa3; const int NT = seq / KVBLK;
  SLOAD(0); SWRITE(0); __syncthreads();
  qkt(pA0, pA1, K_lds, R_lds, qr, qrl, r32, hi); partialSM(pA0, pA1, m_reg, mnA, alA);
  SLOAD(KVBLK); SWRITE(1); __syncthreads();
  for (int j = 1; j + 1 < NT; j += 2) {
    SBAR(); qkt(pB0, pB1, K_lds + SHM_K, R_lds + SHM_R, qr, qrl, r32, hi);
    finishSM(pA0, pA1, alA, l_reg, pa0, pa1, pa2, pa3); SBAR();
    SLOAD((j + 1) * KVBLK); SBAR();
    pv_d0(o, vb0, pa0, pa1, pa2, pa3); partialSM(pB0, pB1, m_reg, mnB, alB);
    __syncthreads(); SWRITE(0);
    RESC(alB); __syncthreads();
    SBAR(); qkt(pA0, pA1, K_lds, R_lds, qr, qrl, r32, hi);
    finishSM(pB0, pB1, alB, l_reg, pa0, pa1, pa2, pa3); SBAR();
    SLOAD((j + 2) * KVBLK); SBAR();
    pv_d0(o, vb0 + (int)SHM_V, pa0, pa1, pa2, pa3); partialSM(pA0, pA1, m_reg, mnA, alA);
    __syncthreads(); SWRITE(1);
    RESC(alA); __syncthreads();
  }
  SBAR(); qkt(pB0, pB1, K_lds + SHM_K, R_lds + SHM_R, qr, qrl, r32, hi);
  finishSM(pA0, pA1, alA, l_reg, pa0, pa1, pa2, pa3); SBAR();
  pv_d0(o, vb0, pa0, pa1, pa2, pa3); partialSM(pB0, pB1, m_reg, mnB, alB);
  __syncthreads(); RESC(alB);
  finishSM(pB0, pB1, alB, l_reg, pa0, pa1, pa2, pa3); SBAR();
  pv_d0(o, vb0 + (int)SHM_V, pa0, pa1, pa2, pa3);
  if (hi == 0) li_l[r32] = l_reg; asm volatile("s_waitcnt lgkmcnt(0)" ::: "memory");
  float rli[16];
#pragma unroll
  for (int r = 0; r < 16; ++r) rli[r] = __builtin_amdgcn_rcpf(li_l[crow(r, hi)]);
  bf16_t* Ow = Ob + (size_t)(wid * QBLK) * LDO;
#pragma unroll
  for (int r = 0; r < 16; ++r) { const int orow = crow(r, hi);
#pragma unroll
    for (int d0 = 0; d0 < 4; ++d0) Ow[(size_t)orow * LDO + d0 * 32 + r32] = f2bf(o[d0][r] * rli[r]); }
  __syncthreads();
#undef SLOAD
#undef SWRITE
#undef RESC
}
}

__device__ void phase_attn(PRef p, int l, char* smem) {
  const bf16_t* Q = (const bf16_t*)(p.ws + WS_Q); const bf16_t* KV = (const bf16_t*)(p.ws + WS_KV); const bf16_t* KR = (const bf16_t*)(p.ws + WS_KR);
  bf16_t* mix = (bf16_t*)(p.ws + WS_MIX); const float* cs = (const float*)(p.ws + WS_COS); const float* sn = (const float*)(p.ws + WS_SIN);
  const int nunits = 1024 + (l == 0 ? 32 : 0);
  for (int u = obid(); u < nunits; u += gridDim.x) {
    if (u < 1024) {
      const int bh = (u >> 8) * 8 + (u & 7), qb = (u & 255) >> 3, hd = bh & 3, b = bh >> 2; const size_t row0 = (size_t)b * SEQ + qb * 256;
      att::attn_body(Q + row0 * 768 + hd * 192, cs + (size_t)qb * 256 * 32, sn + (size_t)qb * 256 * 32, KV + (size_t)b * SKV * 1024 + hd * 256,
                     KV + (size_t)b * SKV * 1024 + hd * 256 + 128, KR + (size_t)b * SKV * 64, mix + row0 * 1024 + 512 + hd * 128, SKV, smem);
    } else {
      const int v = u - 1024, hd = v & 3, b = v >> 2; const size_t row0 = (size_t)MX + b * CTXL;
      att::attn_body(Q + row0 * 768 + hd * 192, nullptr, nullptr, KV + (size_t)b * SKV * 1024 + hd * 256,
                     KV + (size_t)b * SKV * 1024 + hd * 256 + 128, KR + (size_t)b * SKV * 64, mix + row0 * 1024 + 512 + hd * 128, CTXL, smem);
    }
  }
}

__device__ void phase_outproj(PRef p, int l, char* smem) {
  LAS unsigned char* lds = (LAS unsigned char*)smem;
  const bf16_t* mix = (const bf16_t*)(p.ws + WS_MIX); const bf16_t* Wt = (const bf16_t*)(p.ws + WS_WOUT) + (size_t)l * 1024 * 1024;
  float* ctxz = (float*)(p.ws + WS_CTXZ);
  const int tid = otid(), wid = tid >> 6, lane = tid & 63, wr = wid >> 2, wc = wid & 3, fr = lane & 15, fq = lane >> 4;
  g8::TileIter it; it.init(l == 0 ? MT / 256 : MX / 256, 4);
  int pm, pn;
  while (it.next(pm, pn)) {
    unsigned voffA[2] = {g8::piece_off(0, 1024, 0), g8::piece_off(1, 1024, 0)};
    f32x4 acc[2][2][4][2];
    g8::gemm_tile<false>(lds, (const char*)(mix + (size_t)pm * 256 * 1024), voffA, (size_t)128 * 1024 * 2, (const char*)(Wt + (size_t)pn * 256 * 1024), 1024, acc);
    ACC_FOR(ai, bj, m, n) {
      const int row = pm * 256 + ai * 128 + wr * 64 + m * 16 + fr, col = pn * 256 + bj * 128 + wc * 32 + fq * 8 + n * 4;
      const float* res = l == 0 ? (row < MX ? p.x + (size_t)row * 1024 : p.ctx + (size_t)(row - MX) * 1024) : p.out + (size_t)row * 1024;
      float* dst = row < MX ? p.out + (size_t)row * 1024 : ctxz + (size_t)(row - MX) * 1024;
      const f32x4 r = *(const f32x4*)(res + col), g = *(const f32x4*)(mod_ptr(p, l, row, 2) + col);
      *(f32x4*)(dst + col) = r * ALPHA + g * acc[ai][bj][m][n];
    }
  }
}

__device__ void phase_ln1(PRef p, int l, char* smem) {
  float* wrt = (float*)smem;
  for (int i = otid(); i < 16384; i += 512) wrt[(i & 15) * 1024 + (i >> 4)] = p.w_router[(size_t)l * 16384 + i];
  __syncthreads();
  const int lane = otid() & 63, gw = obid() * 8 + (otid() >> 6), nw = gridDim.x * 8;
  bf16_t* h = (bf16_t*)(p.ws + WS_H); float* ctxz = (float*)(p.ws + WS_CTXZ); float* aff = (float*)(p.ws + WS_AFF);
  const int nrows = l == 0 ? MT : MX;
  for (int row = gw; row < nrows; row += nw) {
    asm volatile("" ::: "memory");
    float* zr = row < MX ? p.out + (size_t)row * 1024 : ctxz + (size_t)(row - MX) * 1024;
    f32x4 v[4];
#pragma unroll
    for (int i = 0; i < 4; ++i) v[i] = *(const f32x4*)(zr + lane * 4 + 256 * i);
    ln_row(v, 1e-5f);
#pragma unroll
    for (int i = 0; i < 4; ++i) { const int c = lane * 4 + 256 * i; v[i] = v[i] * *(const f32x4*)(p.ln1_g + l * 1024 + c) + *(const f32x4*)(p.ln1_b + l * 1024 + c); *(f32x4*)(zr + c) = v[i]; }
    ln_row(v, 1e-6f);
    f32x4 hm[4];
    store_mod_bf16(v, mod_ptr(p, l, row, 3), mod_ptr(p, l, row, 4), h + (size_t)row * 1024, lane, &hm);
    float lg[16];
#pragma unroll
    for (int e = 0; e < 16; ++e) { float s = 0.f;
#pragma unroll
      for (int i = 0; i < 4; ++i) { const f32x4 w = *(const f32x4*)(wrt + e * 1024 + lane * 4 + 256 * i); s += hm[i][0] * w[0] + hm[i][1] * w[1] + hm[i][2] * w[2] + hm[i][3] * w[3]; }
      lg[e] = wave_sum(s); }
    float mx = lg[0];
#pragma unroll
    for (int e = 1; e < 16; ++e) mx = fmaxf(mx, lg[e]);
    float den = 0.f;
#pragma unroll
    for (int e = 0; e < 16; ++e) { lg[e] = expf(lg[e] - mx); den += lg[e]; }
    float mine = 0.f;
#pragma unroll
    for (int e = 0; e < 16; ++e) if (lane == e) mine = lg[e] / den;
    if (lane < 16) aff[(size_t)row * 16 + lane] = mine;
  }
}

template <int PER>
__device__ __forceinline__ void topk_item(const float* __restrict__ affp, int n, int kcap, int rowbase, int slotbase, int e, int* __restrict__ IDX, float* __restrict__ GV, int* __restrict__ TS, char* smem) {
  unsigned* hist = (unsigned*)smem; unsigned* sel = hist + 256; unsigned* wtot = hist + 272;
  const int tid = otid(), lane = tid & 63, wid = tid >> 6;
  const bool active = tid * PER < n;
  unsigned key[PER];
#pragma unroll
  for (int i = 0; i < PER; ++i) key[i] = active ? __float_as_uint(affp[(size_t)(tid * PER + i) * 16]) : 0u;
  unsigned prefix = 0u, mask = 0u; int kk = kcap;
#pragma unroll 1
  for (int shift = 24; shift >= 0; shift -= 8) {
    __syncthreads();
    if (tid < 256) hist[tid] = 0u;
    __syncthreads();
#pragma unroll
    for (int i = 0; i < PER; ++i) if (active && (key[i] & mask) == prefix) atomicAdd(&hist[(key[i] >> shift) & 255u], 1u);
    __syncthreads();
    if (wid == 0) {
      const unsigned h0 = hist[lane * 4], h1 = hist[lane * 4 + 1], h2 = hist[lane * 4 + 2], h3 = hist[lane * 4 + 3];
      const unsigned tot = h0 + h1 + h2 + h3; unsigned suf = tot;
#pragma unroll
      for (int o = 1; o < 64; o <<= 1) { const unsigned u = __shfl_down(suf, o); if (lane + o < 64) suf += u; }
      const unsigned above = suf - tot;
      if (above < (unsigned)kk && suf >= (unsigned)kk) {
        unsigned a = above; int bin;
        if (a + h3 >= (unsigned)kk) bin = 3; else { a += h3; if (a + h2 >= (unsigned)kk) bin = 2; else { a += h2; if (a + h1 >= (unsigned)kk) bin = 1; else { a += h1; bin = 0; } } }
        sel[0] = prefix | ((unsigned)(lane * 4 + bin) << shift); sel[1] = (unsigned)kk - a;
      }
    }
    __syncthreads();
    prefix = sel[0]; kk = (int)sel[1]; mask |= 0xffu << shift;
  }
  const unsigned Tk = prefix;
  unsigned cg_ = 0, ce = 0;
#pragma unroll
  for (int i = 0; i < PER; ++i) { cg_ += key[i] > Tk; ce += key[i] == Tk; }
  unsigned pk = active ? (cg_ | (ce << 16)) : 0u, inc = pk;
#pragma unroll
  for (int o = 1; o < 64; o <<= 1) { const unsigned u = __shfl_up(inc, o); if (lane >= o) inc += u; }
  __syncthreads();
  if (lane == 63) wtot[wid] = inc;
  __syncthreads();
  unsigned base = 0;
  for (int w2 = 0; w2 < wid; ++w2) base += wtot[w2];
  const unsigned exc = base + inc - pk; unsigned gt_before = exc & 0xffffu, eq_before = exc >> 16;
  if (active) {
#pragma unroll
    for (int i = 0; i < PER; ++i) {
      const int t = tid * PER + i; int R = -1;
      const bool isgt = key[i] > Tk, iseq = key[i] == Tk;
      if (isgt || (iseq && (int)eq_before < kk)) {
        const int slot = (int)gt_before + min((int)eq_before, kk);
        R = slotbase + slot; IDX[R] = rowbase + t; GV[R] = __uint_as_float(key[i]);
      }
      TS[t] = R;
      gt_before += isgt; eq_before += iseq;
    }
  }
}
__device__ void phase_topk(PRef p, int l, char* smem) {
  const float* aff = (const float*)(p.ws + WS_AFF); int* IDX = (int*)(p.ws + WS_IDX); float* GV = (float*)(p.ws + WS_GV); int* TS = (int*)(p.ws + WS_TS);
  const int nitems = l == 0 ? 256 : 128;
  for (int it = obid(); it < nitems; it += gridDim.x) {
    if (it < 128) { const int b = it >> 4, e = it & 15; topk_item<16>(aff + (size_t)b * SEQ * 16 + e, SEQ, CAPX, b * SEQ, it * CAPX, e, IDX, GV, TS + (size_t)it * SEQ, smem); }
    else { const int v = it - 128, b = v >> 4, e = v & 15; topk_item<1>(aff + ((size_t)MX + b * CTXL) * 16 + e, CTXL, CAPC, MX + b * CTXL, NB * NE * CAPX + e * 256 + b * CAPC, e, IDX, GV, TS + (size_t)NB * 16 * SEQ + (size_t)v * CTXL, smem); }
  }
  __syncthreads();
}

__device__ void phase_moe_up(PRef p, int l, char* smem) {
  LAS unsigned char* lds = (LAS unsigned char*)smem;
  const bf16_t* h = (const bf16_t*)(p.ws + WS_H); const bf16_t* Wgu = (const bf16_t*)(p.ws + WS_WGU); bf16_t* act = (bf16_t*)(p.ws + WS_ACT); const int* IDX = (const int*)(p.ws + WS_IDX);
  const int tid = otid(), wid = tid >> 6, lane = tid & 63, wr = wid >> 2, wc = wid & 3, fr = lane & 15, fq = lane >> 4;
  g8::MoeIter it; it.init(8, l == 0);
  int pm, pn, e;
  while (it.next(pm, pn, e)) {
    unsigned voffA[4];
#pragma unroll
    for (int hh = 0; hh < 2; ++hh)
#pragma unroll
      for (int i = 0; i < 2; ++i) { int R, C; g8::piece_rc(i, R, C); voffA[hh * 2 + i] = (unsigned)(IDX[pm * 256 + hh * 128 + R] * 1024 + C) * 2u; }
    f32x4 acc[2][2][4][2];
    g8::gemm_tile<true>(lds, (const char*)h, voffA, 0, (const char*)(Wgu + ((size_t)e * 2048 + pn * 256) * 1024), 1024, acc);
#pragma unroll
    for (int ai = 0; ai < 2; ++ai)
#pragma unroll
      for (int m = 0; m < 4; ++m) {
          const int row = pm * 256 + ai * 128 + wr * 64 + m * 16 + fr, col = pn * 128 + wc * 32 + fq * 8;
          float a[8];
#pragma unroll
          for (int n = 0; n < 2; ++n) { const f32x4 g = acc[ai][0][m][n], u = acc[ai][1][m][n];
#pragma unroll
            for (int k = 0; k < 4; ++k) a[n * 4 + k] = silu_f(g[k]) * u[k]; }
          u32x4 w = {cvtpk(a[0], a[1]), cvtpk(a[2], a[3]), cvtpk(a[4], a[5]), cvtpk(a[6], a[7])}; *(u32x4*)(act + (size_t)row * 1024 + col) = w;
        }
  }
}
__device__ void phase_moe_down(PRef p, int l, char* smem) {
  LAS unsigned char* lds = (LAS unsigned char*)smem;
  const bf16_t* act = (const bf16_t*)(p.ws + WS_ACT); const bf16_t* Wdn = (const bf16_t*)(p.ws + WS_WDN); bf16_t* oute = (bf16_t*)(p.ws + WS_OUTE); const float* GV = (const float*)(p.ws + WS_GV);
  const int tid = otid(), wid = tid >> 6, lane = tid & 63, wr = wid >> 2, wc = wid & 3, fr = lane & 15, fq = lane >> 4;
  g8::MoeIter it; it.init(4, l == 0);
  int pm, pn, e;
  while (it.next(pm, pn, e)) {
    unsigned voffA[2] = {g8::piece_off(0, 1024, 0), g8::piece_off(1, 1024, 0)};
    f32x4 acc[2][2][4][2];
    g8::gemm_tile<false>(lds, (const char*)(act + (size_t)pm * 256 * 1024), voffA, (size_t)128 * 1024 * 2, (const char*)(Wdn + ((size_t)e * 1024 + pn * 256) * 1024), 1024, acc);
    ACC_FOR3(ai, bj, m) {
      const int row = pm * 256 + ai * 128 + wr * 64 + m * 16 + fr, col = pn * 256 + bj * 128 + wc * 32 + fq * 8;
      const float gv = GV[row]; const f32x4 v0 = acc[ai][bj][m][0] * gv, v1 = acc[ai][bj][m][1] * gv;
      u32x4 w = {cvtpk(v0[0], v0[1]), cvtpk(v0[2], v0[3]), cvtpk(v1[0], v1[1]), cvtpk(v1[2], v1[3])}; *(u32x4*)(oute + (size_t)row * 1024 + col) = w;
    }
  }
}

__device__ void phase_ln2(PRef p, int l) {
  const int lane = otid() & 63, gw = obid() * 8 + (otid() >> 6), nw = gridDim.x * 8;
  bf16_t* h = (bf16_t*)(p.ws + WS_H); float* ctxz = (float*)(p.ws + WS_CTXZ); const bf16_t* oute = (const bf16_t*)(p.ws + WS_OUTE); const int* TS = (const int*)(p.ws + WS_TS);
  const int nrows = l == 0 ? MT : MX;
  for (int row = gw; row < nrows; row += nw) {
    float* xr = row < MX ? p.out + (size_t)row * 1024 : ctxz + (size_t)(row - MX) * 1024;
    f32x4 mo[4];
#pragma unroll
    for (int i = 0; i < 4; ++i) mo[i] = (f32x4){0.f, 0.f, 0.f, 0.f};
    const int myR = lane < 16 ? (row < MX ? TS[((size_t)(row >> 13) * 16 + lane) * SEQ + (row & 8191)] : TS[(size_t)NB * 16 * SEQ + ((size_t)((row - MX) >> 8) * 16 + lane) * CTXL + ((row - MX) & 255)]) : -1;
    for (int e = 0; e < 16; ++e) { const int Rr = __shfl(myR, e);
      if (Rr >= 0) {
#pragma unroll
        for (int i = 0; i < 4; ++i) { const u32x2 w = *(const u32x2*)(oute + (size_t)Rr * 1024 + lane * 4 + 256 * i);
          mo[i][0] += bflo(w[0]); mo[i][1] += bfhi(w[0]); mo[i][2] += bflo(w[1]); mo[i][3] += bfhi(w[1]); } } }
    f32x4 v[4]; const float* m5 = mod_ptr(p, l, row, 5);
#pragma unroll
    for (int i = 0; i < 4; ++i) { const int c = lane * 4 + 256 * i; v[i] = *(const f32x4*)(xr + c) * ALPHA + *(const f32x4*)(m5 + c) * mo[i]; }
    ln_row(v, 1e-5f);
#pragma unroll
    for (int i = 0; i < 4; ++i) { const int c = lane * 4 + 256 * i; v[i] = v[i] * *(const f32x4*)(p.ln2_g + l * 1024 + c) + *(const f32x4*)(p.ln2_b + l * 1024 + c); *(f32x4*)(xr + c) = v[i]; }
    if (l + 1 < DEPTH) { ln_row(v, 1e-6f); store_mod_bf16(v, mod_ptr(p, l + 1, row, 0), mod_ptr(p, l + 1, row, 1), h + (size_t)row * 1024, lane, nullptr); }
  }
}

__device__ __forceinline__ void gsync(cg::grid_group& grid) {
  asm volatile("s_waitcnt vmcnt(0) lgkmcnt(0)" ::: "memory");
  grid.sync();
}
__global__ void __launch_bounds__(512) mega(Params p) {
  extern __shared__ __attribute__((aligned(16))) char smem[];
  cg::grid_group grid = cg::this_grid();
  phase_prep(kparams(), smem);
  gsync(grid);
  phase_h0(kparams());
  gsync(grid);
#pragma unroll 1
  for (int l = 0; l < DEPTH; ++l) {
    phase_inproj(kparams(), l, smem);
    gsync(grid);
    phase_mlstm(kparams(), l, smem);
    gsync(grid);
    phase_mla_prep(kparams(), l, smem);
    gsync(grid);
    phase_attn(kparams(), l, smem);
    gsync(grid);
    phase_outproj(kparams(), l, smem);
    gsync(grid);
    phase_ln1(kparams(), l, smem);
    __syncthreads();
    phase_cvt_experts(kparams(), l, smem);
    gsync(grid);
    phase_topk(kparams(), l, smem);
    gsync(grid);
    phase_moe_up(kparams(), l, smem);
    gsync(grid);
    phase_moe_down(kparams(), l, smem);
    gsync(grid);
    phase_ln2(kparams(), l);
    gsync(grid);
  }
}

extern "C" void kernel_launch(void* const* d_in, const int* in_sizes, int n_in, void* d_out, int out_size,
                              void* d_ws, size_t ws_size, hipStream_t stream) {
  constexpr size_t kDynLds = 160 * 1024;
  static int grid_blocks = 0;
  if (!grid_blocks) {
    int dev = 0, cus = 0, per_cu = 0;
    (void)hipGetDevice(&dev);
    (void)hipDeviceGetAttribute(&cus, hipDeviceAttributeMultiprocessorCount, dev);
    (void)hipFuncSetAttribute((const void*)mega, hipFuncAttributeMaxDynamicSharedMemorySize, (int)kDynLds);
    (void)hipOccupancyMaxActiveBlocksPerMultiprocessor(&per_cu, mega, 512, kDynLds);
    grid_blocks = per_cu > 0 ? cus : 0;
    if (grid_blocks > 256) grid_blocks = 256;
    grid_blocks &= ~7;
    if (grid_blocks != 256) { fprintf(stderr, "this kernel needs 256 co-resident workgroups (got %d)\n", grid_blocks); grid_blocks = 0; }
    if (ws_size < WS_END) { fprintf(stderr, "workspace too small: %zu < %zu\n", ws_size, (size_t)WS_END); grid_blocks = 0; }
  }
  if (grid_blocks <= 0) return;
  Params p{};
  const float** pp = (const float**)&p;
  for (int i = 0; i < 24; ++i) pp[i] = (const float*)d_in[i];
  p.out = (float*)d_out; p.ws = (char*)d_ws;
  void* args[] = {&p};
  hipError_t e = hipLaunchCooperativeKernel((void*)mega, dim3(grid_blocks), dim3(512), args, kDynLds, stream);
  if (e != hipSuccess) fprintf(stderr, "cooperative launch failed: %s (grid %d)\n", hipGetErrorString(e), grid_blocks);
}
```

```cpp
#include <hip/hip_runtime.h>
#include <hip/hip_cooperative_groups.h>
#include <cstdio>
#include <cstdint>
namespace cg = cooperative_groups;

typedef unsigned short bf16_t;
typedef short bf16x8 __attribute__((ext_vector_type(8)));
typedef short s16x4 __attribute__((ext_vector_type(4)));
typedef float f32x4 __attribute__((ext_vector_type(4)));
typedef float f32x16 __attribute__((ext_vector_type(16)));
typedef unsigned u32x4 __attribute__((ext_vector_type(4)));
typedef unsigned u32x2 __attribute__((ext_vector_type(2)));
#define LAS __attribute__((address_space(3)))

constexpr int DM = 1024, NB = 8, SEQ = 8192, CTXL = 256, DEPTH = 2;
constexpr int MX = NB * SEQ, MC = NB * CTXL, MT = MX + MC;
constexpr int PLD = 2816;
constexpr int OFF_Q = 0, OFF_K = 512, OFF_V = 1024, OFF_O = 1536, OFF_G = 2048, OFF_CQ = 2064, OFF_CKV = 2448, OFF_KR = 2704, IN_COLS = 2768;
constexpr int SKV = SEQ + CTXL;
constexpr int NE = 16, CAPX = 1024, CAPC = 32;
constexpr int NSLOT = NB * NE * CAPX + NB * NE * CAPC;
constexpr float ALPHA = 1.4142135623730951f;
constexpr float A_SCALE = 0.07216878364870322f;

constexpr size_t al256(size_t v) { return (v + 255) / 256 * 256; }
constexpr size_t WS_H = 0;
constexpr size_t WS_P = WS_H + al256((size_t)MT * 1024 * 2);
constexpr size_t WS_Q = WS_P + al256((size_t)MT * PLD * 2);
constexpr size_t WS_KV = WS_Q + al256((size_t)MT * 768 * 2);
constexpr size_t WS_KR = WS_KV + al256((size_t)NB * SKV * 1024 * 2);
constexpr size_t WS_MIX = WS_KR + al256((size_t)NB * SKV * 64 * 2);
constexpr size_t WS_ACT = WS_P;
constexpr size_t WS_HB = WS_H;
constexpr size_t WS_OUTE = WS_P + al256((size_t)NSLOT * 1024 * 2);
constexpr size_t WS_WGU = WS_MIX;
constexpr size_t WS_WDN = WS_MIX + (size_t)NE * 2048 * 1024 * 2;
constexpr size_t WS_WIN = WS_MIX + al256((size_t)MT * 1024 * 2);
constexpr size_t WS_WUQ = WS_WIN + (size_t)2 * PLD * 1024 * 2;
constexpr size_t WS_WUKV = WS_WUQ + (size_t)2 * 768 * 384 * 2;
constexpr size_t WS_WOUT = WS_WUKV + (size_t)2 * 1024 * 256 * 2;
constexpr size_t WS_MOD = WS_WOUT + (size_t)2 * 1024 * 1024 * 2;
constexpr size_t WS_COS = WS_MOD + al256((size_t)2 * 9 * 6144 * 4);
constexpr size_t WS_SIN = WS_COS + (size_t)SEQ * 32 * 4;
constexpr size_t WS_GATES = WS_SIN + (size_t)SEQ * 32 * 4;
constexpr size_t WS_AFF = WS_GATES + (size_t)MT * 16 * 4;
constexpr size_t WS_IDX = WS_AFF + (size_t)MT * 16 * 4;
constexpr size_t WS_GV = WS_IDX + (size_t)NSLOT * 4;
constexpr size_t WS_TS = WS_GV + (size_t)NSLOT * 4;
constexpr size_t WS_CTXZ = WS_TS + (size_t)MT * 16 * 4;
constexpr size_t WS_END = WS_CTXZ + (size_t)MC * 1024 * 4;
static_assert(WS_OUTE + (size_t)NSLOT * 1024 * 2 <= WS_KR, "out_e overlay");
static_assert(WS_WDN + (size_t)NE * 1024 * 1024 * 2 <= WS_WIN, "expert weights overlay");

struct Params {
  const float *x, *c, *ctx, *c_ctx, *w_mod, *b_mod, *w_in, *b_gates, *conv_w, *conv_b, *m_norm_w, *q_norm_w, *kv_norm_w, *w_uq, *w_ukv, *w_out,
      *ln1_g, *ln1_b, *w_router, *w_gate, *w_up, *w_down, *ln2_g, *ln2_b;
  float* out; char* ws;
};

typedef const __attribute__((address_space(4))) Params& PRef;
__device__ __forceinline__ PRef kparams() { const __attribute__((address_space(4))) Params* kp = (const __attribute__((address_space(4))) Params*)__builtin_amdgcn_kernarg_segment_ptr(); asm volatile("" : "+s"(kp)); return *kp; }
__device__ __forceinline__ int otid() { int t = threadIdx.x; asm volatile("" : "+v"(t)); return t; }
__device__ __forceinline__ int obid() { int t = blockIdx.x; asm volatile("" : "+s"(t)); return t; }
__device__ __forceinline__ int opaque_s(int v) { asm volatile("" : "+s"(v)); return v; }
typedef __bf16 bf16v2_t __attribute__((ext_vector_type(2)));
typedef float f32x2_t __attribute__((ext_vector_type(2)));
__device__ __forceinline__ unsigned cvtpk(float lo, float hi) { const f32x2_t f = {lo, hi}; const bf16v2_t b = __builtin_convertvector(f, bf16v2_t); return __builtin_bit_cast(unsigned, b); }
__device__ __forceinline__ bf16_t f2bf(float v) { return (bf16_t)(cvtpk(v, v) & 0xffffu); }
__device__ __forceinline__ float bf2f(unsigned v) { return __uint_as_float(v << 16); }
__device__ __forceinline__ float bflo(unsigned w) { return __uint_as_float(w << 16); }
__device__ __forceinline__ float bfhi(unsigned w) { return __uint_as_float(w & 0xffff0000u); }
__device__ __forceinline__ float wave_sum(float v) { for (int o = 32; o > 0; o >>= 1) v += __shfl_xor(v, o); return v; }
__device__ __forceinline__ float wave_max(float v) { for (int o = 32; o > 0; o >>= 1) v = fmaxf(v, __shfl_xor(v, o)); return v; }
__device__ __forceinline__ float sigmoid_f(float v) { return __builtin_amdgcn_rcpf(1.f + __expf(-v)); }
__device__ __forceinline__ float silu_f(float v) { return v * sigmoid_f(v); }

namespace g8 {
constexpr int BK = 64, HALF = 128, HTB = HALF * BK * 2, STAGE_BYTES = 8 * HTB;
__device__ __forceinline__ int lds_byte(int r, int c) { const int st = (r >> 4) * 2 + (c >> 5), rr = r & 15, cc = c & 31, ob = rr * 64 + cc * 2; return st * 1024 + (ob ^ (((ob >> 9) & 1) << 5)); }
__device__ __forceinline__ int perm32(int rho) { const int n = rho >> 4, i = rho & 15; return 8 * (i >> 2) + 4 * n + (i & 3); }
__device__ __forceinline__ void stage_rc(int b, int& R, int& C) { const int st = b / 1024, sb = b % 1024, swz = sb ^ (((sb >> 9) & 1) << 5); R = (st >> 1) * 16 + swz / 64; C = (st & 1) * 32 + (swz % 64) / 2; }

template <bool GATHER>
__device__ __forceinline__ void gemm_tile(LAS unsigned char* lds, const char* __restrict__ Ab, const unsigned (&voffA)[GATHER ? 4 : 2], size_t hstepA, const char* __restrict__ Bb, int K,
                                          f32x4 (&acc)[2][2][4][2]) {
  const int tid = otid(), wid = __builtin_amdgcn_readfirstlane(tid >> 6), lane = tid & 63, wr = wid >> 2, wc = wid & 3, fr = lane & 15, fq = lane >> 4;
  const int nt = K / BK;
  unsigned voffB[2];
#pragma unroll
  for (int i = 0; i < 2; ++i) { int R, C; stage_rc(tid * 16 + i * 8192, R, C); const int Rb = (R & ~31) + perm32(R & 31); voffB[i] = (unsigned)(Rb * K + C) * 2u; }
  const char* Bb1 = Bb + (size_t)HALF * K * 2; const char* Ab1 = GATHER ? Ab : Ab + hstepA;
  const unsigned* vA0 = &voffA[0]; const unsigned* vA1 = GATHER ? &voffA[2] : &voffA[0];
  const unsigned ldsw = (unsigned)wid * 1024u;
  const int aoff = lds_byte(wr * 64 + fr, fq * 8), boff = lds_byte(wc * 32 + fr, fq * 8);
#define G8_SA(b, h) (((b) * 2 + (h)) * HTB)
#define G8_SB(b, h) ((4 + (b) * 2 + (h)) * HTB)
#define G8_STAGE(bufoff, gbase, voff, kt) do { _Pragma("unroll") for (int _i = 0; _i < 2; ++_i) \
    __builtin_amdgcn_global_load_lds((const unsigned*)((gbase) + (size_t)(kt) * (BK * 2) + (voff)[_i]), (LAS unsigned*)(lds + (bufoff) + ldsw + _i * 8192), 16, 0, 0); } while (0)
#define G8_LDA(dst, b, h) do { _Pragma("unroll") for (int m = 0; m < 4; ++m) _Pragma("unroll") for (int k = 0; k < 2; ++k) dst[m][k] = *(const LAS bf16x8*)(lds + G8_SA(b, h) + aoff + m * 2048 + k * 1024); } while (0)
#define G8_LDB(dst, b, h) do { _Pragma("unroll") for (int n = 0; n < 2; ++n) _Pragma("unroll") for (int k = 0; k < 2; ++k) dst[n][k] = *(const LAS bf16x8*)(lds + G8_SB(b, h) + boff + n * 2048 + k * 1024); } while (0)
#define G8_MMA(ai, bj, At, Bt) do { __builtin_amdgcn_s_setprio(1); _Pragma("unroll") for (int m = 0; m < 4; ++m) _Pragma("unroll") for (int n = 0; n < 2; ++n) _Pragma("unroll") for (int k = 0; k < 2; ++k) \
    acc[ai][bj][m][n] = __builtin_amdgcn_mfma_f32_16x16x32_bf16(Bt[n][k], At[m][k], acc[ai][bj][m][n], 0, 0, 0); __builtin_amdgcn_s_setprio(0); } while (0)
#define G8_WAIT_V(n) asm volatile("s_waitcnt vmcnt(" #n ")" ::: "memory")
#define G8_WAIT_L(n) asm volatile("s_waitcnt lgkmcnt(" #n ")" ::: "memory")
#define G8_BAR __builtin_amdgcn_s_barrier()
#define G8_SCHED __builtin_amdgcn_sched_barrier(0)
#pragma unroll
  for (int a = 0; a < 2; ++a)
#pragma unroll
    for (int b = 0; b < 2; ++b)
#pragma unroll
      for (int m = 0; m < 4; ++m)
#pragma unroll
        for (int n = 0; n < 2; ++n) acc[a][b][m][n] = (f32x4){0.f, 0.f, 0.f, 0.f};
  bf16x8 At[4][2], B0[2][2], B1[2][2];
  G8_WAIT_V(0); __syncthreads();
  G8_STAGE(G8_SB(0, 0), Bb, voffB, 0); G8_STAGE(G8_SA(0, 0), Ab, vA0, 0); G8_STAGE(G8_SB(0, 1), Bb1, voffB, 0); G8_STAGE(G8_SA(0, 1), Ab1, vA1, 0);
  if (wr == 1) G8_BAR;
  G8_WAIT_V(4); G8_BAR;
  G8_STAGE(G8_SB(1, 0), Bb, voffB, 1); G8_STAGE(G8_SA(1, 0), Ab, vA0, 1); G8_STAGE(G8_SB(1, 1), Bb1, voffB, 1);
  G8_WAIT_V(6); G8_BAR;
  for (int t = 0; t < nt - 2; t += 2) {
    G8_LDB(B0, 0, 0); G8_SCHED; G8_LDA(At, 0, 0); G8_STAGE(G8_SA(1, 1), Ab1, vA1, t + 1);
    G8_WAIT_L(8); G8_BAR; G8_WAIT_L(0); G8_MMA(0, 0, At, B0); G8_BAR; G8_SCHED;
    G8_LDB(B1, 0, 1); G8_STAGE(G8_SB(0, 0), Bb, voffB, t + 2);
    G8_BAR; G8_WAIT_L(0); G8_MMA(0, 1, At, B1); G8_BAR;
    G8_LDA(At, 0, 1); G8_STAGE(G8_SA(0, 0), Ab, vA0, t + 2);
    G8_BAR; G8_WAIT_L(0); G8_MMA(1, 0, At, B0); G8_BAR; G8_SCHED;
    G8_STAGE(G8_SB(0, 1), Bb1, voffB, t + 2);
    G8_WAIT_V(6); G8_BAR; G8_MMA(1, 1, At, B1); G8_BAR;
    G8_LDB(B0, 1, 0); G8_SCHED; G8_LDA(At, 1, 0); G8_STAGE(G8_SA(0, 1), Ab1, vA1, t + 2);
    G8_WAIT_L(8); G8_BAR; G8_WAIT_L(0); G8_MMA(0, 0, At, B0); G8_BAR; G8_SCHED;
    G8_LDB(B1, 1, 1); G8_STAGE(G8_SB(1, 0), Bb, voffB, t + 3);
    G8_BAR; G8_WAIT_L(0); G8_MMA(0, 1, At, B1); G8_BAR;
    G8_LDA(At, 1, 1); G8_STAGE(G8_SA(1, 0), Ab, vA0, t + 3);
    G8_BAR; G8_WAIT_L(0); G8_MMA(1, 0, At, B0); G8_BAR; G8_SCHED;
    G8_STAGE(G8_SB(1, 1), Bb1, voffB, t + 3);
    G8_WAIT_V(6); G8_BAR; G8_MMA(1, 1, At, B1); G8_BAR;
  }
  { G8_LDB(B0, 0, 0); G8_LDA(At, 0, 0); G8_STAGE(G8_SA(1, 1), Ab1, vA1, nt - 1);
    G8_BAR; G8_WAIT_L(0); G8_MMA(0, 0, At, B0); G8_BAR;
    G8_LDB(B1, 0, 1); G8_BAR; G8_WAIT_L(0); G8_MMA(0, 1, At, B1); G8_BAR;
    G8_LDA(At, 0, 1); G8_WAIT_V(4); G8_BAR; G8_WAIT_L(0); G8_MMA(1, 0, At, B0); G8_MMA(1, 1, At, B1); G8_BAR; }
  { G8_LDB(B0, 1, 0); G8_LDA(At, 1, 0); G8_WAIT_V(2); G8_BAR; G8_WAIT_L(0); G8_MMA(0, 0, At, B0); G8_BAR;
    G8_LDB(B1, 1, 1); G8_WAIT_V(0); G8_BAR; G8_WAIT_L(0); G8_MMA(0, 1, At, B1); G8_BAR;
    G8_LDA(At, 1, 1); G8_BAR; G8_WAIT_L(0); G8_MMA(1, 0, At, B0); G8_MMA(1, 1, At, B1); G8_BAR; }
  if (wr == 0) G8_BAR;
}
__device__ __forceinline__ unsigned piece_off(int i, int ld, int c0) { int R, C; stage_rc((int)otid() * 16 + i * 8192, R, C); return (unsigned)(R * ld + c0 + C) * 2u; }
__device__ __forceinline__ void piece_rc(int i, int& R, int& C) { stage_rc((int)otid() * 16 + i * 8192, R, C); }
struct TileIter {
  int nM, nN, x, j, J, cnt, idx;
  __device__ __forceinline__ void init(int nM_, int nN_) { nM = nM_; nN = nN_; x = obid() & 7; j = obid() >> 3; J = gridDim.x >> 3; cnt = ((nM - x + 7) >> 3) * nN; idx = j; }
  __device__ __forceinline__ bool next(int& pm, int& pn) { if (idx >= cnt) return false; pm = x + 8 * (idx / nN); pn = idx % nN; idx += J; return true; }
};
struct MoeIter {
  int nN, x, jm, jn, j, step, nsteps, nb4; bool with_ctx, ctx_done;
  __device__ __forceinline__ void init(int nN_, bool with_ctx_) { nN = nN_; with_ctx = with_ctx_; x = obid() & 7; j = obid() >> 3; jm = j & 7; jn = j >> 3; nb4 = nN >> 2; nsteps = 2 * nb4 * 4; step = 0; ctx_done = false; }
  __device__ __forceinline__ bool next(int& pm, int& pn, int& e) {
    if (step < nsteps) { const int mb = step & 3, nb = (step >> 2) % nb4, el = (step >> 2) / nb4; e = 2 * x + el; const int m32 = mb * 8 + jm; pm = ((m32 >> 2) * 16 + e) * 4 + (m32 & 3); pn = nb * 4 + jn; ++step; return true; }
    if (with_ctx && !ctx_done) { ctx_done = true; if (j < 2 * nN) { e = 2 * x + j / nN; pm = 512 + e; pn = j % nN; return true; } }
    return false;
  }
};
}

#define ACC_FOR3(ai, bj, m) _Pragma("unroll") for (int ai = 0; ai < 2; ++ai) _Pragma("unroll") for (int bj = 0; bj < 2; ++bj) _Pragma("unroll") for (int m = 0; m < 4; ++m)
#define ACC_FOR(ai, bj, m, n) _Pragma("unroll") for (int ai = 0; ai < 2; ++ai) _Pragma("unroll") for (int bj = 0; bj < 2; ++bj) _Pragma("unroll") for (int m = 0; m < 4; ++m) _Pragma("unroll") for (int n = 0; n < 2; ++n)

__device__ __forceinline__ void cvt_tile(const float* __restrict__ src, int N, int K, int k0, int n0, bf16_t* __restrict__ dst, long drow0, const float* __restrict__ kscale, float* lds) {
  const int tid = otid();
  { const int kr = tid >> 6, n = tid & 63;
#pragma unroll
    for (int i = 0; i < 8; ++i) { const int k = kr + 8 * i; float v = (n0 + n < N) ? src[(size_t)(k0 + k) * N + n0 + n] : 0.f; if (kscale) v *= kscale[k0 + k]; lds[k * 65 + n] = v; } }
  __syncthreads();
  { const int n = tid >> 3, k8 = (tid & 7) * 8; float v[8];
#pragma unroll
    for (int i = 0; i < 8; ++i) v[i] = lds[(k8 + i) * 65 + n];
    u32x4 w = {cvtpk(v[0], v[1]), cvtpk(v[2], v[3]), cvtpk(v[4], v[5]), cvtpk(v[6], v[7])};
    *(u32x4*)(dst + (size_t)(drow0 + n) * K + k0 + k8) = w; }
  __syncthreads();
}

__device__ void phase_prep(PRef p, char* smem) {
  float* lds = (float*)smem;
  bf16_t* Wt_in = (bf16_t*)(p.ws + WS_WIN); bf16_t* Wt_uq = (bf16_t*)(p.ws + WS_WUQ); bf16_t* Wt_ukv = (bf16_t*)(p.ws + WS_WUKV); bf16_t* Wt_out = (bf16_t*)(p.ws + WS_WOUT);
  float* mod = (float*)(p.ws + WS_MOD);
  constexpr int T_MOD = 192, T_IN = 2 * 16 * 44, T_UQ = 2 * 6 * 12, T_UKV = 2 * 4 * 16, T_OUT = 2 * 16 * 16, T_ROPE = 64;
  constexpr int E0 = T_MOD, E1 = E0 + T_IN, E2 = E1 + T_UQ, E3 = E2 + T_UKV, E4 = E3 + T_OUT, E5 = E4 + T_ROPE;
  const int tid = otid();
  for (int task = obid(); task < E5; task += gridDim.x) {
    if (task < E0) {
      const int l = task / 96, j0 = (task % 96) * 64;
      float* sc = lds;
      for (int i = tid; i < 9 * 1024; i += 512) { const int bb = i >> 10, d = i & 1023; const float v = bb < 8 ? p.c[bb * 1024 + d] : p.c_ctx[d]; sc[i] = v / (1.f + expf(-v)); }
      __syncthreads();
      const int col = tid & 63, ks = tid >> 6; float a[9];
#pragma unroll
      for (int bb = 0; bb < 9; ++bb) a[bb] = 0.f;
      const float* wm = p.w_mod + (size_t)l * 1024 * 6144 + j0 + col;
      for (int d = ks * 128; d < ks * 128 + 128; ++d) { const float w = wm[(size_t)d * 6144];
#pragma unroll
        for (int bb = 0; bb < 9; ++bb) a[bb] += sc[bb * 1024 + d] * w; }
      float* red = lds + 9 * 1024;
#pragma unroll
      for (int bb = 0; bb < 9; ++bb) red[(ks * 9 + bb) * 64 + col] = a[bb];
      __syncthreads();
      for (int i = tid; i < 9 * 64; i += 512) { const int bb = i >> 6, cc = i & 63; float s = 0.f;
        for (int k = 0; k < 8; ++k) s += red[(k * 9 + bb) * 64 + cc];
        mod[((size_t)l * 9 + bb) * 6144 + j0 + cc] = s + p.b_mod[l * 6144 + j0 + cc]; }
      __syncthreads();
    } else if (task < E1) { const int t = task - E0, l = t / 704, r = t % 704, kt = r / 44, nt = r % 44;
      cvt_tile(p.w_in + (size_t)l * 1024 * IN_COLS, IN_COLS, 1024, kt * 64, nt * 64, Wt_in + (size_t)l * PLD * 1024, nt * 64, nullptr, lds);
    } else if (task < E2) { const int t = task - E1, l = t / 72, r = t % 72, kt = r / 12, nt = r % 12;
      cvt_tile(p.w_uq + (size_t)l * 384 * 768, 768, 384, kt * 64, nt * 64, Wt_uq + (size_t)l * 768 * 384, nt * 64, p.q_norm_w + l * 384, lds);
    } else if (task < E3) { const int t = task - E2, l = t / 64, r = t % 64, kt = r / 16, nt = r % 16;
      cvt_tile(p.w_ukv + (size_t)l * 256 * 1024, 1024, 256, kt * 64, nt * 64, Wt_ukv + (size_t)l * 1024 * 256, nt * 64, p.kv_norm_w + l * 256, lds);
    } else if (task < E4) { const int t = task - E3, l = t / 256, r = t % 256, kt = r / 16, nt = r % 16;
      cvt_tile(p.w_out + (size_t)l * 1024 * 1024, 1024, 1024, kt * 64, nt * 64, Wt_out + (size_t)l * 1024 * 1024, nt * 64, nullptr, lds);
    } else {
      float* cs = (float*)(p.ws + WS_COS); float* sn = (float*)(p.ws + WS_SIN);
      for (int i = (task - E4) * 4096 + tid; i < (task - E4 + 1) * 4096; i += 512) { const int t = i >> 5, j = i & 31;
        const float inv = exp2f(-(float)(j & 15) * (13.287712379549449f / 16.f));
        const float pos = (float)(j < 16 ? (t >> 6) : (t & 63)); const float ang = pos * inv;
        const double a = (double)ang; const double k = rint(a * 0.15915494309189535); const float r = (float)(a - k * 6.283185307179586);
        cs[i] = __cosf(r); sn[i] = __sinf(r); }
    }
  }
}

__device__ void phase_cvt_experts(PRef p, int l, char* smem) {
  float* lds = (float*)smem;
  bf16_t* Wgu = (bf16_t*)(p.ws + WS_WGU); bf16_t* Wdn = (bf16_t*)(p.ws + WS_WDN);
  const int tid = otid();
  for (int task = obid(); task < NE * 192; task += gridDim.x) {
    const int e = task / 192, r = task % 192, which = r >> 6, kt = (r & 63) >> 2, nt = r & 3, k0 = kt * 64, n0 = nt * 256;
    const float* src = (which == 0 ? p.w_gate : which == 1 ? p.w_up : p.w_down) + ((size_t)l * NE + e) * 1024 * 1024;
    { const int kr = tid >> 6, n4 = (tid & 63) * 4;
#pragma unroll
      for (int i = 0; i < 8; ++i) { const int k = kr + 8 * i; *(f32x4*)(lds + k * 260 + n4) = *(const f32x4*)(src + (size_t)(k0 + k) * 1024 + n0 + n4); } }
    __syncthreads();
    { const int nl = tid >> 1, k32 = (tid & 1) * 32, n = n0 + nl;
      const size_t drow = which == 2 ? (size_t)n : (size_t)((n >> 7) * 256 + which * 128 + (n & 127));
      bf16_t* dst = (which == 2 ? Wdn + (size_t)e * 1024 * 1024 : Wgu + (size_t)e * 2048 * 1024) + drow * 1024 + k0 + k32;
#pragma unroll
      for (int q = 0; q < 4; ++q) { float v[8];
#pragma unroll
        for (int i = 0; i < 8; ++i) v[i] = lds[(k32 + q * 8 + i) * 260 + nl];
        u32x4 w = {cvtpk(v[0], v[1]), cvtpk(v[2], v[3]), cvtpk(v[4], v[5]), cvtpk(v[6], v[7])};
        *(u32x4*)(dst + q * 8) = w; } }
    __syncthreads();
  }
}

__device__ __forceinline__ void ln_row(f32x4 (&v)[4], float eps) {
  float s = 0.f;
#pragma unroll
  for (int i = 0; i < 4; ++i) s += v[i][0] + v[i][1] + v[i][2] + v[i][3];
  const float mu = wave_sum(s) * (1.f / 1024.f);
  float q = 0.f;
#pragma unroll
  for (int i = 0; i < 4; ++i)
#pragma unroll
    for (int k = 0; k < 4; ++k) { v[i][k] -= mu; q += v[i][k] * v[i][k]; }
  const float rs = rsqrtf(wave_sum(q) * (1.f / 1024.f) + eps);
#pragma unroll
  for (int i = 0; i < 4; ++i) v[i] *= rs;
}
__device__ __forceinline__ void store_mod_bf16(const f32x4 (&v)[4], const float* __restrict__ shift, const float* __restrict__ scale, bf16_t* __restrict__ hrow, int lane, f32x4 (*keep)[4]) {
#pragma unroll
  for (int i = 0; i < 4; ++i) { const int c = lane * 4 + 256 * i; const f32x4 sh = *(const f32x4*)(shift + c), sc = *(const f32x4*)(scale + c);
    f32x4 o = v[i] * (sc + 1.f) + sh; if (keep) (*keep)[i] = o;
    u32x2 w = {cvtpk(o[0], o[1]), cvtpk(o[2], o[3])}; *(u32x2*)(hrow + c) = w; }
}
__device__ __forceinline__ const float* mod_ptr(PRef p, int l, int row, int which) {
  const int bb = row < MX ? (row >> 13) : 8;
  return (const float*)(p.ws + WS_MOD) + ((size_t)l * 9 + bb) * 6144 + which * 1024;
}

__device__ void phase_h0(PRef p) {
  const int lane = otid() & 63, gw = obid() * 8 + (otid() >> 6), nw = gridDim.x * 8;
  bf16_t* h = (bf16_t*)(p.ws + WS_H);
  for (int row = gw; row < MT; row += nw) {
    const float* src = row < MX ? p.x + (size_t)row * 1024 : p.ctx + (size_t)(row - MX) * 1024;
    f32x4 v[4];
#pragma unroll
    for (int i = 0; i < 4; ++i) v[i] = *(const f32x4*)(src + lane * 4 + 256 * i);
    ln_row(v, 1e-6f);
    store_mod_bf16(v, mod_ptr(p, 0, row, 0), mod_ptr(p, 0, row, 1), h + (size_t)row * 1024, lane, nullptr);
  }
}

__device__ void phase_inproj(PRef p, int l, char* smem) {
  LAS unsigned char* lds = (LAS unsigned char*)smem;
  const bf16_t* h = (const bf16_t*)(p.ws + WS_H); const bf16_t* Wt = (const bf16_t*)(p.ws + WS_WIN) + (size_t)l * PLD * 1024;
  bf16_t* P = (bf16_t*)(p.ws + WS_P); float* gates = (float*)(p.ws + WS_GATES);
  const int tid = otid(), wid = tid >> 6, lane = tid & 63, wr = wid >> 2, wc = wid & 3, fr = lane & 15, fq = lane >> 4;
  g8::TileIter it; it.init(MT / 256, PLD / 256);
  int pm, pn;
  while (it.next(pm, pn)) {
    unsigned voffA[2] = {g8::piece_off(0, 1024, 0), g8::piece_off(1, 1024, 0)};
    f32x4 acc[2][2][4][2];
    g8::gemm_tile<false>(lds, (const char*)(h + (size_t)pm * 256 * 1024), voffA, (size_t)128 * 1024 * 2, (const char*)(Wt + (size_t)pn * 256 * 1024), 1024, acc);
    ACC_FOR3(ai, bj, m) {
      const int row = pm * 256 + ai * 128 + wr * 64 + m * 16 + fr, col = pn * 256 + bj * 128 + wc * 32 + fq * 8;
      const f32x4 v0 = acc[ai][bj][m][0], v1 = acc[ai][bj][m][1];
      u32x4 w = {cvtpk(v0[0], v0[1]), cvtpk(v0[2], v0[3]), cvtpk(v1[0], v1[1]), cvtpk(v1[2], v1[3])}; *(u32x4*)(P + (size_t)row * PLD + col) = w;
      if (col >= OFF_G && col < OFF_G + 16) { const f32x4 bg0 = *(const f32x4*)(p.b_gates + l * 16 + (col - OFF_G)), bg1 = *(const f32x4*)(p.b_gates + l * 16 + (col - OFF_G) + 4);
        *(f32x4*)(gates + (size_t)row * 16 + (col - OFF_G)) = v0 + bg0; *(f32x4*)(gates + (size_t)row * 16 + (col - OFF_G) + 4) = v1 + bg1; }
    }
  }
}


__device__ void phase_mlstm(PRef p, int l, char* smem) {
  bf16_t* RAWQ = (bf16_t*)(smem); bf16_t* RAWK = (bf16_t*)(smem + 17408);
  bf16_t* QB = (bf16_t*)(smem + 34816); bf16_t* KB = (bf16_t*)(smem + 52224);
  bf16_t* KT = (bf16_t*)(smem + 69632);
  bf16_t* VT = (bf16_t*)(smem + 88064); bf16_t* VWT = (bf16_t*)(smem + 94976);
  bf16_t* PB = (bf16_t*)(smem + 101888);
  bf16_t* CT = (bf16_t*)(smem + 111104);
  float* SC = (float*)(smem + 124160);
  const bf16_t* P = (const bf16_t*)(p.ws + WS_P); const float* gates = (const float*)(p.ws + WS_GATES);
  bf16_t* hbuf = (bf16_t*)(p.ws + WS_HB);
  const int tid = otid(), wid = tid >> 6, lane = tid & 63, fr = lane & 15, fq = lane >> 4;
  for (int w = obid(); w < 256; w += gridDim.x) {
    const int slice = w & 3, dir = (w >> 2) & 1, hd = (w >> 3) & 3, b = w >> 5;
    const int c2 = (tid & 63) * 2;
    float wq0[5], wq1[5], wk0[5], wk1[5];
#pragma unroll
    for (int j = 0; j < 5; ++j) { const float* cw = p.conv_w + ((size_t)l * 5 + j) * 1024; wq0[j] = cw[hd * 128 + c2]; wq1[j] = cw[hd * 128 + c2 + 1]; wk0[j] = cw[512 + hd * 128 + c2]; wk1[j] = cw[512 + hd * 128 + c2 + 1]; }
    const float bq0 = p.conv_b[l * 1024 + hd * 128 + c2], bq1 = p.conv_b[l * 1024 + hd * 128 + c2 + 1], bk0 = p.conv_b[l * 1024 + 512 + hd * 128 + c2], bk1 = p.conv_b[l * 1024 + 512 + hd * 128 + c2 + 1];
    __syncthreads();
    for (int i = tid; i < 48 * 136 / 2; i += 512) ((unsigned*)CT)[i] = 0u;
    for (int i = tid; i < 48 * 72 / 2; i += 512) { ((unsigned*)VT)[i] = 0u; ((unsigned*)VWT)[i] = 0u; }
    f32x4 accC[3];
#pragma unroll
    for (int i = 0; i < 3; ++i) accC[i] = (f32x4){0.f, 0.f, 0.f, 0.f};
    float m_state = 0.f;
    __syncthreads();
    u32x4 pre_raw[5]; u32x2 pre_v; float pre_ig = 0.f, pre_fg = 0.f;
    const int vl = tid >> 3, ve4 = (tid & 7) * 4;
#define MLSTM_PREFETCH(CI) do { const int ci_ = (CI); const bool ic_ = ci_ < 4; const int cc_ = ic_ ? ci_ : ci_ - 4, T_ = ic_ ? CTXL : SEQ, rb_ = ic_ ? MX + b * CTXL : b * SEQ; \
      const int tlo_ = dir ? T_ - 64 - cc_ * 64 : cc_ * 64; \
      _Pragma("unroll") for (int k_ = 0; k_ < 5; ++k_) { const int pc = tid + k_ * 512; pre_raw[k_] = (u32x4){0u, 0u, 0u, 0u}; \
        if (pc < 2176) { const int tens = pc >= 1088, rem = tens ? pc - 1088 : pc, rr = rem >> 4, c16 = rem & 15, t = tlo_ - 2 + rr; \
          if (t >= 0 && t < T_) pre_raw[k_] = *(const u32x4*)(P + (size_t)(rb_ + t) * PLD + (tens ? OFF_K : OFF_Q) + hd * 128 + c16 * 8); } } \
      { const int vt_ = dir ? tlo_ + 63 - vl : tlo_ + vl; pre_v = *(const u32x2*)(P + (size_t)(rb_ + vt_) * PLD + OFF_V + hd * 128 + slice * 32 + ve4); } \
      if (wid == 0) { const int t = dir ? tlo_ + 63 - lane : tlo_ + lane; const float* g = gates + (size_t)(rb_ + t) * 16; pre_ig = g[dir * 8 + hd]; pre_fg = g[dir * 8 + 4 + hd]; } } while (0)
    MLSTM_PREFETCH(0);
    for (int ci = 0; ci < 132; ++ci) {
      const bool isctx = ci < 4; const int cc = isctx ? ci : ci - 4, T = isctx ? CTXL : SEQ, rowbase = isctx ? MX + b * CTXL : b * SEQ;
      const int tlo = dir ? T - 64 - cc * 64 : cc * 64;
      float* S = SC + (ci & 1) * 384;
      const bool need_out = !(l == DEPTH - 1 && isctx);
      if (wid == 0) {
        const float ig = pre_ig, fg = pre_fg;
        const float lf = fminf(fg, 0.f) - log1pf(expf(-fabsf(fg)));
        float bc = lf;
#pragma unroll
        for (int o = 1; o < 64; o <<= 1) { const float u = __shfl_up(bc, o); if (lane >= o) bc += u; }
        const float a = ig - bc; float pmx = a;
#pragma unroll
        for (int o = 1; o < 64; o <<= 1) { const float u = __shfl_up(pmx, o); if (lane >= o) pmx = fmaxf(pmx, u); }
        const float Mx = fmaxf(pmx, m_state), M63 = __shfl(Mx, 63), b63 = __shfl(bc, 63);
        S[lane] = a; S[64 + lane] = Mx; S[128 + lane] = __expf(m_state - Mx); S[192 + lane] = __expf(-(bc + Mx)); S[256 + lane] = __expf(a - M63);
        if (lane == 0) { S[320] = __expf(m_state - M63); S[321] = b63 + M63; }
      }
#pragma unroll
      for (int k = 0; k < 5; ++k) { const int pc = tid + k * 512;
        if (pc < 2176) { const int tens = pc >= 1088, rem = tens ? pc - 1088 : pc, rr = rem >> 4, c16 = rem & 15; *(u32x4*)((tens ? RAWK : RAWQ) + rr * 128 + c16 * 8) = pre_raw[k]; } }
      const u32x2 vraw = pre_v;
      if (ci + 1 < 132) MLSTM_PREFETCH(ci + 1);
      __syncthreads();
      {
        const int rg = wid; unsigned rq[12], rk[12];
#pragma unroll
        for (int i = 0; i < 12; ++i) { rq[i] = *(const unsigned*)(RAWQ + (rg * 8 + i) * 128 + c2); rk[i] = *(const unsigned*)(RAWK + (rg * 8 + i) * 128 + c2); }
#pragma unroll
        for (int jj = 0; jj < 8; ++jj) {
          float yq0 = bq0, yq1 = bq1, yk0 = bk0, yk1 = bk1;
#pragma unroll
          for (int tp = 0; tp < 5; ++tp) { yq0 += wq0[tp] * bflo(rq[jj + tp]); yq1 += wq1[tp] * bfhi(rq[jj + tp]); yk0 += wk0[tp] * bflo(rk[jj + tp]); yk1 += wk1[tp] * bfhi(rk[jj + tp]); }
          const int j = rg * 8 + jj, lr = dir ? 63 - j : j;
          const float q0 = silu_f(yq0) * 0.08838834764831845f, q1 = silu_f(yq1) * 0.08838834764831845f, k0 = silu_f(yk0), k1 = silu_f(yk1);
          *(unsigned*)(QB + lr * 136 + c2) = cvtpk(q0, q1);
          const unsigned kw = cvtpk(k0, k1);
          *(unsigned*)(KB + lr * 136 + c2) = kw;
          KT[c2 * 72 + lr] = (bf16_t)(kw & 0xffffu); KT[(c2 + 1) * 72 + lr] = (bf16_t)(kw >> 16);
        }
        const float wsl = S[256 + vl];
        const float v0 = bflo(vraw[0]), v1 = bfhi(vraw[0]), v2 = bflo(vraw[1]), v3 = bfhi(vraw[1]);
        VT[(ve4 + 0) * 72 + vl] = (bf16_t)(vraw[0] & 0xffffu); VT[(ve4 + 1) * 72 + vl] = (bf16_t)(vraw[0] >> 16);
        VT[(ve4 + 2) * 72 + vl] = (bf16_t)(vraw[1] & 0xffffu); VT[(ve4 + 3) * 72 + vl] = (bf16_t)(vraw[1] >> 16);
        VWT[(ve4 + 0) * 72 + vl] = f2bf(v0 * wsl); VWT[(ve4 + 1) * 72 + vl] = f2bf(v1 * wsl); VWT[(ve4 + 2) * 72 + vl] = f2bf(v2 * wsl); VWT[(ve4 + 3) * 72 + vl] = f2bf(v3 * wsl);
        if (tid < 64) { VT[32 * 72 + tid] = (bf16_t)0x3F80u; VWT[32 * 72 + tid] = f2bf(S[256 + tid]); }
      }
      __syncthreads();
      if (need_out) {
        const int mt = wid >> 1;
#pragma unroll
        for (int u = 0; u < 2; ++u) {
          const int ntl = (wid & 1) * 2 + u;
          f32x4 s = {0.f, 0.f, 0.f, 0.f};
          if (ntl <= mt) {
#pragma unroll
            for (int kk = 0; kk < 4; ++kk) {
              const bf16x8 a = *(const bf16x8*)(QB + (mt * 16 + fr) * 136 + kk * 32 + fq * 8), bb = *(const bf16x8*)(KB + (ntl * 16 + fr) * 136 + kk * 32 + fq * 8);
              s = __builtin_amdgcn_mfma_f32_16x16x32_bf16(a, bb, s, 0, 0, 0); }
          }
          const int j = ntl * 16 + fr; const float aj = S[j];
#pragma unroll
          for (int jj = 0; jj < 4; ++jj) { const int lr = mt * 16 + fq * 4 + jj;
            const float pv = (j <= lr) ? s[jj] * __expf(fminf(aj - S[64 + lr], 0.f)) : 0.f;
            PB[lr * 72 + j] = f2bf(pv); }
        }
      }
      __syncthreads();
      if (need_out && wid < 4) {
        const int mt = wid; f32x4 num[3];
#pragma unroll
        for (int ntl = 0; ntl < 3; ++ntl) {
          f32x4 a1 = {0.f, 0.f, 0.f, 0.f}, a2 = {0.f, 0.f, 0.f, 0.f};
#pragma unroll
          for (int kk = 0; kk < 2; ++kk) { const bf16x8 a = *(const bf16x8*)(PB + (mt * 16 + fr) * 72 + kk * 32 + fq * 8), bb = *(const bf16x8*)(VT + (ntl * 16 + fr) * 72 + kk * 32 + fq * 8);
            a1 = __builtin_amdgcn_mfma_f32_16x16x32_bf16(a, bb, a1, 0, 0, 0); }
#pragma unroll
          for (int kk = 0; kk < 4; ++kk) { const bf16x8 a = *(const bf16x8*)(QB + (mt * 16 + fr) * 136 + kk * 32 + fq * 8), bb = *(const bf16x8*)(CT + (ntl * 16 + fr) * 136 + kk * 32 + fq * 8);
            a2 = __builtin_amdgcn_mfma_f32_16x16x32_bf16(a, bb, a2, 0, 0, 0); }
#pragma unroll
          for (int jj = 0; jj < 4; ++jj) num[ntl][jj] = a1[jj] + S[128 + mt * 16 + fq * 4 + jj] * a2[jj];
        }
#pragma unroll
        for (int jj = 0; jj < 4; ++jj) {
          const int lr = mt * 16 + fq * 4 + jj; const float den = __shfl(num[2][jj], lane & 48);
          const float rd = __builtin_amdgcn_rcpf(fmaxf(fabsf(den), S[192 + lr]));
          const int t = dir ? tlo + 63 - lr : tlo + lr;
          bf16_t* hp = hbuf + ((size_t)((dir * 4 + hd) * 4 + slice) * MT + rowbase + t) * 32 + fr;
          hp[0] = f2bf(num[0][jj] * rd); hp[16] = f2bf(num[1][jj] * rd);
        }
      }
      __syncthreads();
      {
        const float decay = S[320];
#pragma unroll
        for (int mt = 0; mt < 3; ++mt) {
          accC[mt] *= decay;
#pragma unroll
          for (int kk = 0; kk < 2; ++kk) { const bf16x8 a = *(const bf16x8*)(VWT + (mt * 16 + fr) * 72 + kk * 32 + fq * 8), bb = *(const bf16x8*)(KT + (wid * 16 + fr) * 72 + kk * 32 + fq * 8);
            accC[mt] = __builtin_amdgcn_mfma_f32_16x16x32_bf16(a, bb, accC[mt], 0, 0, 0); }
#pragma unroll
          for (int jj = 0; jj < 4; ++jj) CT[(mt * 16 + fq * 4 + jj) * 136 + wid * 16 + fr] = f2bf(accC[mt][jj]);
        }
        m_state = S[321];
      }
    }
  }
}

template <int WHICH>
__device__ __forceinline__ void mla_gemm(PRef p, int l, char* smem) {
  LAS unsigned char* lds = (LAS unsigned char*)smem; float* rsb = (float*)(smem + g8::STAGE_BYTES);
  const bf16_t* P = (const bf16_t*)(p.ws + WS_P);
  const int tid = otid(), wid = tid >> 6, lane = tid & 63, wr = wid >> 2, wc = wid & 3, fr = lane & 15, fq = lane >> 4;
  constexpr int K = WHICH ? 256 : 384, OFFC = WHICH ? OFF_CKV : OFF_CQ, N = WHICH ? 1024 : 768;
  const bf16_t* Wt = WHICH ? (const bf16_t*)(p.ws + WS_WUKV) + (size_t)l * 1024 * 256 : (const bf16_t*)(p.ws + WS_WUQ) + (size_t)l * 768 * 384;
  bf16_t* O = (bf16_t*)(p.ws + (WHICH ? WS_KV : WS_Q));
  g8::TileIter it; it.init((WHICH || l == 0) ? MT / 256 : MX / 256, N / 256);
  int pm, pn;
  while (it.next(pm, pn)) {
    __syncthreads();
    { const int r = tid >> 1, hf = tid & 1; const bf16_t* src = P + (size_t)(pm * 256 + r) * PLD + OFFC + hf * (K / 2); float s = 0.f;
#pragma unroll 4
      for (int i = 0; i < K / 16; ++i) { const u32x4 v = *(const u32x4*)(src + i * 8);
#pragma unroll
        for (int k = 0; k < 4; ++k) { const float a = bflo(v[k]), bq = bfhi(v[k]); s += a * a + bq * bq; } }
      s += __shfl_xor(s, 1);
      if (hf == 0) rsb[r] = rsqrtf(s / (float)K + 1e-6f); }
    unsigned voffA[2] = {g8::piece_off(0, PLD, OFFC), g8::piece_off(1, PLD, OFFC)};
    f32x4 acc[2][2][4][2];
    g8::gemm_tile<false>(lds, (const char*)(P + (size_t)pm * 256 * PLD), voffA, (size_t)128 * PLD * 2, (const char*)(Wt + (size_t)pn * 256 * K), opaque_s(K), acc);
    ACC_FOR3(ai, bj, m) {
      const int rl = ai * 128 + wr * 64 + m * 16 + fr, row = pm * 256 + rl, col = pn * 256 + bj * 128 + wc * 32 + fq * 8;
      const float rs = rsb[rl]; const f32x4 v0 = acc[ai][bj][m][0] * rs, v1 = acc[ai][bj][m][1] * rs;
      size_t orow = row;
      if (WHICH) orow = row < MX ? (size_t)(row >> 13) * SKV + CTXL + (row & 8191) : (size_t)((row - MX) >> 8) * SKV + ((row - MX) & 255);
      u32x4 w = {cvtpk(v0[0], v0[1]), cvtpk(v0[2], v0[3]), cvtpk(v1[0], v1[1]), cvtpk(v1[2], v1[3])}; *(u32x4*)(O + orow * N + col) = w;
    }
  }
}
__device__ void phase_mla_prep(PRef p, int l, char* smem) {
  mla_gemm<0>(p, l, smem);
  mla_gemm<1>(p, l, smem);
  const bf16_t* P = (const bf16_t*)(p.ws + WS_P);
  const int tid = otid(), wid = tid >> 6, lane = tid & 63;
  const bf16_t* hbuf = (const bf16_t*)(p.ws + WS_HB); bf16_t* mix = (bf16_t*)(p.ws + WS_MIX); bf16_t* KR = (bf16_t*)(p.ws + WS_KR);
  const float* cs = (const float*)(p.ws + WS_COS); const float* sn = (const float*)(p.ws + WS_SIN);
  const int gw = obid() * 8 + wid, nw = gridDim.x * 8;
  for (int row = gw; row < MT; row += nw) {
    if (row < MX || l == 0) {
      const size_t ho = ((size_t)(lane >> 2) * MT + row) * 32 + (lane & 3) * 8;
      const u32x4 hf = *(const u32x4*)(hbuf + ho), hb = *(const u32x4*)(hbuf + (size_t)16 * MT * 32 + ho);
      const u32x4 ov = *(const u32x4*)(P + (size_t)row * PLD + OFF_O + lane * 8);
      float v[8]; float s = 0.f;
#pragma unroll
      for (int k = 0; k < 4; ++k) { v[2 * k] = bflo(hf[k]) + bflo(hb[k]); v[2 * k + 1] = bfhi(hf[k]) + bfhi(hb[k]); s += v[2 * k] + v[2 * k + 1]; }
      s += __shfl_xor(s, 1); s += __shfl_xor(s, 2); s += __shfl_xor(s, 4); s += __shfl_xor(s, 8);
      const float mu = s * (1.f / 128.f); float q = 0.f;
#pragma unroll
      for (int k = 0; k < 8; ++k) { v[k] -= mu; q += v[k] * v[k]; }
      q += __shfl_xor(q, 1); q += __shfl_xor(q, 2); q += __shfl_xor(q, 4); q += __shfl_xor(q, 8);
      const float rs = rsqrtf(q * (1.f / 128.f) + 1e-6f);
      const float* nw_ = p.m_norm_w + l * 512 + lane * 8; float o[8];
#pragma unroll
      for (int k = 0; k < 4; ++k) { o[2 * k] = v[2 * k] * rs * nw_[2 * k] * sigmoid_f(bflo(ov[k])); o[2 * k + 1] = v[2 * k + 1] * rs * nw_[2 * k + 1] * sigmoid_f(bfhi(ov[k])); }
      u32x4 wv = {cvtpk(o[0], o[1]), cvtpk(o[2], o[3]), cvtpk(o[4], o[5]), cvtpk(o[6], o[7])};
      *(u32x4*)(mix + (size_t)row * 1024 + lane * 8) = wv;
    }
    {
      const int j = lane & 31;
      const float x1 = bf2f(P[(size_t)row * PLD + OFF_KR + j]), x2 = bf2f(P[(size_t)row * PLD + OFF_KR + 32 + j]);
      float o1 = x1, o2 = x2; size_t orow;
      if (row < MX) { const int t = row & 8191; const float c = cs[t * 32 + j], s_ = sn[t * 32 + j]; o1 = x1 * c - x2 * s_; o2 = x2 * c + x1 * s_; orow = (size_t)(row >> 13) * SKV + CTXL + t; }
      else orow = (size_t)((row - MX) >> 8) * SKV + ((row - MX) & 255);
      if (lane < 32) { KR[orow * 64 + j] = f2bf(o1); KR[orow * 64 + 32 + j] = f2bf(o2); }
    }
  }
}

namespace att {
constexpr int NW = 8, QBLK = 32, KVBLK = 64, LDQ = 768, LDK = 1024, LDKR = 64, LDO = 1024;
constexpr float SCALE = A_SCALE;
constexpr float THR = 8.f;
constexpr size_t SHM_V = KVBLK * 128 * 2, SHM_K = KVBLK * 128 * 2, SHM_R = KVBLK * 64 * 2;
typedef float f32x8 __attribute__((ext_vector_type(8)));
#define KSWZ(row, colB) ((row) * 256 + ((colB) ^ (((row) & 7) << 4)))
#define RSWZ(row, colB) ((row) * 128 + ((colB) ^ (((row) & 7) << 4)))
#define SBAR() __builtin_amdgcn_sched_barrier(0)
__device__ __forceinline__ int crow(int r, int hi) { return (r & 3) + 8 * (r >> 2) + 4 * hi; }
__device__ __forceinline__ void partialSM(f32x16& p0, f32x16& p1, float& m_reg, float& mn, float& alpha) {
  constexpr float C = SCALE * 1.4426950408889634f;
  float pmax = p0[0];
#pragma unroll
  for (int r = 1; r < 16; ++r) pmax = fmaxf(pmax, p0[r]);
#pragma unroll
  for (int r = 0; r < 16; ++r) pmax = fmaxf(pmax, p1[r]);
  { auto rr = __builtin_amdgcn_permlane32_swap(__float_as_uint(pmax), __float_as_uint(pmax), false, false);
    pmax = fmaxf(__uint_as_float(rr[0]), __uint_as_float(rr[1])); }
  if (__builtin_expect(__all(pmax - m_reg <= THR / SCALE), 1)) { mn = m_reg; alpha = 1.f; }
  else { mn = fmaxf(m_reg, pmax); alpha = __builtin_amdgcn_exp2f((m_reg - mn) * C); m_reg = mn; }
  const float mnC = -mn * C;
#pragma unroll
  for (int r = 0; r < 16; ++r) p0[r] = fmaf(p0[r], C, mnC);
#pragma unroll
  for (int r = 0; r < 16; ++r) p1[r] = fmaf(p1[r], C, mnC);
#pragma unroll
  for (int r = 0; r < 16; ++r) p0[r] = __builtin_amdgcn_exp2f(p0[r]);
}
__device__ __forceinline__ void finishSM(f32x16& p0, f32x16& p1, float alpha, float& l_reg, bf16x8& pa0, bf16x8& pa1, bf16x8& pa2, bf16x8& pa3) {
#pragma unroll
  for (int r = 0; r < 16; ++r) p1[r] = __builtin_amdgcn_exp2f(p1[r]);
  float ps = 0;
#pragma unroll
  for (int r = 0; r < 16; ++r) ps += p0[r];
#pragma unroll
  for (int r = 0; r < 16; ++r) ps += p1[r];
  { auto rr = __builtin_amdgcn_permlane32_swap(__float_as_uint(ps), __float_as_uint(ps), false, false);
    ps = __uint_as_float(rr[0]) + __uint_as_float(rr[1]); }
  l_reg = l_reg * alpha + ps;
#define PK4(P, BASE, OUT) do { unsigned a0 = cvtpk(P[BASE + 0], P[BASE + 1]), a1 = cvtpk(P[BASE + 2], P[BASE + 3]);   \
    unsigned b0 = cvtpk(P[BASE + 4], P[BASE + 5]), b1 = cvtpk(P[BASE + 6], P[BASE + 7]);                              \
    auto r0 = __builtin_amdgcn_permlane32_swap(a0, b0, false, false); auto r1 = __builtin_amdgcn_permlane32_swap(a1, b1, false, false); \
    u32x4 w = {r0[0], r1[0], r0[1], r1[1]}; OUT = *reinterpret_cast<bf16x8*>(&w); } while (0)
  PK4(p0, 0, pa0); PK4(p0, 8, pa1); PK4(p1, 0, pa2); PK4(p1, 8, pa3);
#undef PK4
}
__device__ __forceinline__ void qkt(f32x16& p0, f32x16& p1, const char* Ks, const char* Rs, const bf16x8* qr, const char* qrl, int r32, int hi) {
  p0 = f32x16{}; p1 = f32x16{};
#pragma unroll
  for (int d0 = 0; d0 < 8; ++d0) { const int cb = (d0 * 16 + hi * 8) * 2;
    const bf16x8 b0 = *reinterpret_cast<const bf16x8*>(Ks + KSWZ(r32, cb));
    const bf16x8 b1 = *reinterpret_cast<const bf16x8*>(Ks + KSWZ(32 + r32, cb));
    p0 = __builtin_amdgcn_mfma_f32_32x32x16_bf16(b0, qr[d0], p0, 0, 0, 0);
    p1 = __builtin_amdgcn_mfma_f32_32x32x16_bf16(b1, qr[d0], p1, 0, 0, 0); }
#pragma unroll
  for (int d0 = 0; d0 < 4; ++d0) { const int cb = (d0 * 16 + hi * 8) * 2;
    const bf16x8 b0 = *reinterpret_cast<const bf16x8*>(Rs + RSWZ(r32, cb));
    const bf16x8 b1 = *reinterpret_cast<const bf16x8*>(Rs + RSWZ(32 + r32, cb));
    const bf16x8 qv = *reinterpret_cast<const bf16x8*>(qrl + d0 * 1024);
    p0 = __builtin_amdgcn_mfma_f32_32x32x16_bf16(b0, qv, p0, 0, 0, 0);
    p1 = __builtin_amdgcn_mfma_f32_32x32x16_bf16(b1, qv, p1, 0, 0, 0); }
}
__device__ __forceinline__ int v_st(int k, int c) { const int kk = (k & ~0xC) | ((k & 4) << 1) | ((k & 8) >> 1); return ((kk >> 3) * 4 + (c >> 5)) * 512 + ((kk & 7) * 32 + (c & 31)) * 2; }
__device__ __forceinline__ int v_rd_base(int lane) { return ((lane & 3) << 3) | (((lane >> 2) & 3) << 6) | (((lane >> 4) & 1) << 5) | (((lane >> 5) & 1) << 8); }
constexpr int v_rd_off(int d0, int ks, int half) { return d0 * 512 + ks * 4096 + half * 2048; }
template <int OFF> __device__ __forceinline__ s16x4 tr_read(int vb) {
  s16x4 r; asm volatile("ds_read_b64_tr_b16 %0, %1 offset:%2" : "=&v"(r) : "v"(vb), "i"(OFF) : "memory"); return r;
}
template <int D0> __device__ __forceinline__ void pv_one(f32x16& od, int vb, bf16x8 pa0, bf16x8 pa1, bf16x8 pa2, bf16x8 pa3) {
  const s16x4 l0 = tr_read<v_rd_off(D0, 0, 0)>(vb), h0 = tr_read<v_rd_off(D0, 0, 1)>(vb), l1 = tr_read<v_rd_off(D0, 1, 0)>(vb), h1 = tr_read<v_rd_off(D0, 1, 1)>(vb);
  const s16x4 l2 = tr_read<v_rd_off(D0, 2, 0)>(vb), h2 = tr_read<v_rd_off(D0, 2, 1)>(vb), l3 = tr_read<v_rd_off(D0, 3, 0)>(vb), h3 = tr_read<v_rd_off(D0, 3, 1)>(vb);
  asm volatile("s_waitcnt lgkmcnt(0)" ::: "memory"); SBAR();
#define PK(L, H) (bf16x8){L[0], L[1], L[2], L[3], H[0], H[1], H[2], H[3]}
  od = __builtin_amdgcn_mfma_f32_32x32x16_bf16(pa0, PK(l0, h0), od, 0, 0, 0);
  od = __builtin_amdgcn_mfma_f32_32x32x16_bf16(pa1, PK(l1, h1), od, 0, 0, 0);
  od = __builtin_amdgcn_mfma_f32_32x32x16_bf16(pa2, PK(l2, h2), od, 0, 0, 0);
  od = __builtin_amdgcn_mfma_f32_32x32x16_bf16(pa3, PK(l3, h3), od, 0, 0, 0);
#undef PK
}
__device__ __forceinline__ void pv_d0(f32x16* o, int vb, bf16x8 pa0, bf16x8 pa1, bf16x8 pa2, bf16x8 pa3) {
  pv_one<0>(o[0], vb, pa0, pa1, pa2, pa3); pv_one<1>(o[1], vb, pa0, pa1, pa2, pa3); pv_one<2>(o[2], vb, pa0, pa1, pa2, pa3); pv_one<3>(o[3], vb, pa0, pa1, pa2, pa3);
}
__device__ __forceinline__ void attn_body(const bf16_t* __restrict__ Qb, const float* __restrict__ cs, const float* __restrict__ sn, const bf16_t* __restrict__ Kn,
                                          const bf16_t* __restrict__ Vh, const bf16_t* __restrict__ Kr, bf16_t* __restrict__ Ob, int seq, char* lds) {
  const int tid = otid(), wid = tid >> 6, lane = tid & 63, r32 = lane & 31, hi = lane >> 5;
  char* V_lds = lds; char* K_lds = lds + 2 * SHM_V; char* R_lds = lds + 2 * SHM_V + 2 * SHM_K;
  float* wsf = (float*)(lds + 2 * SHM_V + 2 * SHM_K + 2 * SHM_R) + wid * 64; float* li_l = wsf; float* al_l = wsf + 32;
  char* qrl = lds + 2 * SHM_V + 2 * SHM_K + 2 * SHM_R + 2048 + wid * 4096 + lane * 16;
  float m_reg = -1e30f, l_reg = 0; f32x16 o[4] = {}; bf16x8 qr[8];
  { const bf16_t* Qw = Qb + (size_t)(wid * QBLK + r32) * LDQ + hi * 8;
#pragma unroll
    for (int d0 = 0; d0 < 8; ++d0) qr[d0] = *(const bf16x8*)(Qw + d0 * 16);
#pragma unroll
    for (int d0 = 0; d0 < 2; ++d0) {
      const u32x4 a = *(const u32x4*)(Qw + 128 + d0 * 16), bq = *(const u32x4*)(Qw + 160 + d0 * 16);
      if (cs) {
        const float* cp = cs + (size_t)(wid * QBLK + r32) * 32 + d0 * 16 + hi * 8; const float* sp = sn + (size_t)(wid * QBLK + r32) * 32 + d0 * 16 + hi * 8;
        const f32x4 c0 = *(const f32x4*)cp, c1 = *(const f32x4*)(cp + 4), s0 = *(const f32x4*)sp, s1 = *(const f32x4*)(sp + 4);
        float x1[8], x2[8], y1[8], y2[8];
#pragma unroll
        for (int k = 0; k < 4; ++k) { x1[2 * k] = bflo(a[k]); x1[2 * k + 1] = bfhi(a[k]); x2[2 * k] = bflo(bq[k]); x2[2 * k + 1] = bfhi(bq[k]); }
#pragma unroll
        for (int k = 0; k < 8; ++k) { const float c = k < 4 ? c0[k & 3] : c1[k & 3], s = k < 4 ? s0[k & 3] : s1[k & 3]; y1[k] = x1[k] * c - x2[k] * s; y2[k] = x2[k] * c + x1[k] * s; }
        u32x4 w1 = {cvtpk(y1[0], y1[1]), cvtpk(y1[2], y1[3]), cvtpk(y1[4], y1[5]), cvtpk(y1[6], y1[7])}, w2 = {cvtpk(y2[0], y2[1]), cvtpk(y2[2], y2[3]), cvtpk(y2[4], y2[5]), cvtpk(y2[6], y2[7])};
        *(u32x4*)(qrl + d0 * 1024) = w1; *(u32x4*)(qrl + (2 + d0) * 1024) = w2;
      } else { *(u32x4*)(qrl + d0 * 1024) = a; *(u32x4*)(qrl + (2 + d0) * 1024) = bq; }
    } }
  const int sr = tid >> 4, sc = (tid & 15) * 8, vst0 = v_st(sr, sc), vst1 = v_st(32 + sr, sc);
  const int rr_ = tid >> 3, rc = (tid & 7) * 8;
  const int vb0 = (int)(uintptr_t)V_lds + v_rd_base(lane);
  bf16x8 vs0, vs1, ks0, ks1, rs0;
  const unsigned voffKV = (unsigned)(sr * LDK + sc) * 2u, voffR = (unsigned)(rr_ * LDKR + rc) * 2u;
#define SLOAD(k0) do { const char* kb_ = (const char*)Kn + (size_t)(k0) * (LDK * 2); const char* vb_ = (const char*)Vh + (size_t)(k0) * (LDK * 2); \
    vs0 = *(const bf16x8*)(vb_ + voffKV); vs1 = *(const bf16x8*)(vb_ + 32 * LDK * 2 + voffKV); \
    ks0 = *(const bf16x8*)(kb_ + voffKV); ks1 = *(const bf16x8*)(kb_ + 32 * LDK * 2 + voffKV); \
    rs0 = *(const bf16x8*)((const char*)Kr + (size_t)(k0) * (LDKR * 2) + voffR); } while (0)
#define SWRITE(b) do { *(bf16x8*)(V_lds + (b) * SHM_V + vst0) = vs0; *(bf16x8*)(V_lds + (b) * SHM_V + vst1) = vs1; const int kc = sc * 2;  \
    *(bf16x8*)(K_lds + (b) * SHM_K + KSWZ(sr, kc)) = ks0; *(bf16x8*)(K_lds + (b) * SHM_K + KSWZ(32 + sr, kc)) = ks1;                      \
    *(bf16x8*)(R_lds + (b) * SHM_R + RSWZ(rr_, rc * 2)) = rs0; } while (0)
#define RESC(a) do { if (__any((a) < 1.f)) { if (hi == 0) al_l[r32] = (a); asm volatile("s_waitcnt lgkmcnt(0)" ::: "memory"); \
    _Pragma("unroll") for (int d = 0; d < 4; ++d) _Pragma("unroll") for (int r = 0; r < 16; ++r) o[d][r] *= al_l[crow(r, hi)]; } } while (0)
  f32x16 pA0, pA1, pB0, pB1; float mnA, mnB, alA, alB; bf16x8 pa0, pa1, pa2, pa3; const int NT = seq / KVBLK;
  SLOAD(0); SWRITE(0); __syncthreads();
  qkt(pA0, pA1, K_lds, R_lds, qr, qrl, r32, hi); partialSM(pA0, pA1, m_reg, mnA, alA);
  SLOAD(KVBLK); SWRITE(1); __syncthreads();
  for (int j = 1; j + 1 < NT; j += 2) {
    SBAR(); qkt(pB0, pB1, K_lds + SHM_K, R_lds + SHM_R, qr, qrl, r32, hi);
    finishSM(pA0, pA1, alA, l_reg, pa0, pa1, pa2, pa3); SBAR();
    SLOAD((j + 1) * KVBLK); SBAR();
    pv_d0(o, vb0, pa0, pa1, pa2, pa3); partialSM(pB0, pB1, m_reg, mnB, alB);
    __syncthreads(); SWRITE(0);
    RESC(alB); __syncthreads();
    SBAR(); qkt(pA0, pA1, K_lds, R_lds, qr, qrl, r32, hi);
    finishSM(pB0, pB1, alB, l_reg, pa0, pa1, pa2, pa3); SBAR();
    SLOAD((j + 2) * KVBLK); SBAR();
    pv_d0(o, vb0 + (int)SHM_V, pa0, pa1, pa2, pa3); partialSM(pA0, pA1, m_reg, mnA, alA);
    __syncthreads(); SWRITE(1);
    RESC(alA); __syncthreads();
  }
  SBAR(); qkt(pB0, pB1, K_lds + SHM_K, R_lds + SHM_R, qr, qrl, r32, hi);
  finishSM(pA0, pA1, alA, l_reg, pa0, pa1, pa2, pa3); SBAR();
  pv_d0(o, vb0, pa0, pa1, pa2, pa3); partialSM(pB0, pB1, m_reg, mnB, alB);
  __syncthreads(); RESC(alB);
  finishSM(pB0, pB1, alB, l_reg, pa0, pa1, pa2, pa3); SBAR();
  pv_d0(o, vb0 + (int)SHM_V, pa0, pa1, pa2, pa3);
  if (hi == 0) li_l[r32] = l_reg; asm volatile("s_waitcnt lgkmcnt(0)" ::: "memory");
  float rli[16];
#pragma unroll
  for (int r = 0; r < 16; ++r) rli[r] = __builtin_amdgcn_rcpf(li_l[crow(r, hi)]);
  bf16_t* Ow = Ob + (size_t)(wid * QBLK) * LDO;
#pragma unroll
  for (int r = 0; r < 16; ++r) { const int orow = crow(r, hi);
#pragma unroll
    for (int d0 = 0; d0 < 4; ++d0) Ow[(size_t)orow * LDO + d0 * 32 + r32] = f2bf(o[d0][r] * rli[r]); }
  __syncthreads();
#undef SLOAD
#undef SWRITE
#undef RESC
}
}

__device__ void phase_attn(PRef p, int l, char* smem) {
  const bf16_t* Q = (const bf16_t*)(p.ws + WS_Q); const bf16_t* KV = (const bf16_t*)(p.ws + WS_KV); const bf16_t* KR = (const bf16_t*)(p.ws + WS_KR);
  bf16_t* mix = (bf16_t*)(p.ws + WS_MIX); const float* cs = (const float*)(p.ws + WS_COS); const float* sn = (const float*)(p.ws + WS_SIN);
  const int nunits = 1024 + (l == 0 ? 32 : 0);
  for (int u = obid(); u < nunits; u += gridDim.x) {
    if (u < 1024) {
      const int bh = (u >> 8) * 8 + (u & 7), qb = (u & 255) >> 3, hd = bh & 3, b = bh >> 2; const size_t row0 = (size_t)b * SEQ + qb * 256;
      att::attn_body(Q + row0 * 768 + hd * 192, cs + (size_t)qb * 256 * 32, sn + (size_t)qb * 256 * 32, KV + (size_t)b * SKV * 1024 + hd * 256,
                     KV + (size_t)b * SKV * 1024 + hd * 256 + 128, KR + (size_t)b * SKV * 64, mix + row0 * 1024 + 512 + hd * 128, SKV, smem);
    } else {
      const int v = u - 1024, hd = v & 3, b = v >> 2; const size_t row0 = (size_t)MX + b * CTXL;
      att::attn_body(Q + row0 * 768 + hd * 192, nullptr, nullptr, KV + (size_t)b * SKV * 1024 + hd * 256,
                     KV + (size_t)b * SKV * 1024 + hd * 256 + 128, KR + (size_t)b * SKV * 64, mix + row0 * 1024 + 512 + hd * 128, CTXL, smem);
    }
  }
}

__device__ void phase_outproj(PRef p, int l, char* smem) {
  LAS unsigned char* lds = (LAS unsigned char*)smem;
  const bf16_t* mix = (const bf16_t*)(p.ws + WS_MIX); const bf16_t* Wt = (const bf16_t*)(p.ws + WS_WOUT) + (size_t)l * 1024 * 1024;
  float* ctxz = (float*)(p.ws + WS_CTXZ);
  const int tid = otid(), wid = tid >> 6, lane = tid & 63, wr = wid >> 2, wc = wid & 3, fr = lane & 15, fq = lane >> 4;
  g8::TileIter it; it.init(l == 0 ? MT / 256 : MX / 256, 4);
  int pm, pn;
  while (it.next(pm, pn)) {
    unsigned voffA[2] = {g8::piece_off(0, 1024, 0), g8::piece_off(1, 1024, 0)};
    f32x4 acc[2][2][4][2];
    g8::gemm_tile<false>(lds, (const char*)(mix + (size_t)pm * 256 * 1024), voffA, (size_t)128 * 1024 * 2, (const char*)(Wt + (size_t)pn * 256 * 1024), 1024, acc);
    ACC_FOR(ai, bj, m, n) {
      const int row = pm * 256 + ai * 128 + wr * 64 + m * 16 + fr, col = pn * 256 + bj * 128 + wc * 32 + fq * 8 + n * 4;
      const float* res = l == 0 ? (row < MX ? p.x + (size_t)row * 1024 : p.ctx + (size_t)(row - MX) * 1024) : p.out + (size_t)row * 1024;
      float* dst = row < MX ? p.out + (size_t)row * 1024 : ctxz + (size_t)(row - MX) * 1024;
      const f32x4 r = *(const f32x4*)(res + col), g = *(const f32x4*)(mod_ptr(p, l, row, 2) + col);
      *(f32x4*)(dst + col) = r * ALPHA + g * acc[ai][bj][m][n];
    }
  }
}

__device__ void phase_ln1(PRef p, int l, char* smem) {
  float* wrt = (float*)smem;
  for (int i = otid(); i < 16384; i += 512) wrt[(i & 15) * 1024 + (i >> 4)] = p.w_router[(size_t)l * 16384 + i];
  __syncthreads();
  const int lane = otid() & 63, gw = obid() * 8 + (otid() >> 6), nw = gridDim.x * 8;
  bf16_t* h = (bf16_t*)(p.ws + WS_H); float* ctxz = (float*)(p.ws + WS_CTXZ); float* aff = (float*)(p.ws + WS_AFF);
  const int nrows = l == 0 ? MT : MX;
  for (int row = gw; row < nrows; row += nw) {
    asm volatile("" ::: "memory");
    float* zr = row < MX ? p.out + (size_t)row * 1024 : ctxz + (size_t)(row - MX) * 1024;
    f32x4 v[4];
#pragma unroll
    for (int i = 0; i < 4; ++i) v[i] = *(const f32x4*)(zr + lane * 4 + 256 * i);
    ln_row(v, 1e-5f);
#pragma unroll
    for (int i = 0; i < 4; ++i) { const int c = lane * 4 + 256 * i; v[i] = v[i] * *(const f32x4*)(p.ln1_g + l * 1024 + c) + *(const f32x4*)(p.ln1_b + l * 1024 + c); *(f32x4*)(zr + c) = v[i]; }
    ln_row(v, 1e-6f);
    f32x4 hm[4];
    store_mod_bf16(v, mod_ptr(p, l, row, 3), mod_ptr(p, l, row, 4), h + (size_t)row * 1024, lane, &hm);
    float lg[16];
#pragma unroll
    for (int e = 0; e < 16; ++e) { float s = 0.f;
#pragma unroll
      for (int i = 0; i < 4; ++i) { const f32x4 w = *(const f32x4*)(wrt + e * 1024 + lane * 4 + 256 * i); s += hm[i][0] * w[0] + hm[i][1] * w[1] + hm[i][2] * w[2] + hm[i][3] * w[3]; }
      lg[e] = wave_sum(s); }
    float mx = lg[0];
#pragma unroll
    for (int e = 1; e < 16; ++e) mx = fmaxf(mx, lg[e]);
    float den = 0.f;
#pragma unroll
    for (int e = 0; e < 16; ++e) { lg[e] = expf(lg[e] - mx); den += lg[e]; }
    float mine = 0.f;
#pragma unroll
    for (int e = 0; e < 16; ++e) if (lane == e) mine = lg[e] / den;
    if (lane < 16) aff[(size_t)row * 16 + lane] = mine;
  }
}

template <int PER>
__device__ __forceinline__ void topk_item(const float* __restrict__ affp, int n, int kcap, int rowbase, int slotbase, int e, int* __restrict__ IDX, float* __restrict__ GV, int* __restrict__ TS, char* smem) {
  unsigned* hist = (unsigned*)smem; unsigned* sel = hist + 256; unsigned* wtot = hist + 272;
  const int tid = otid(), lane = tid & 63, wid = tid >> 6;
  const bool active = tid * PER < n;
  unsigned key[PER];
#pragma unroll
  for (int i = 0; i < PER; ++i) key[i] = active ? __float_as_uint(affp[(size_t)(tid * PER + i) * 16]) : 0u;
  unsigned prefix = 0u, mask = 0u; int kk = kcap;
#pragma unroll 1
  for (int shift = 24; shift >= 0; shift -= 8) {
    __syncthreads();
    if (tid < 256) hist[tid] = 0u;
    __syncthreads();
#pragma unroll
    for (int i = 0; i < PER; ++i) if (active && (key[i] & mask) == prefix) atomicAdd(&hist[(key[i] >> shift) & 255u], 1u);
    __syncthreads();
    if (wid == 0) {
      const unsigned h0 = hist[lane * 4], h1 = hist[lane * 4 + 1], h2 = hist[lane * 4 + 2], h3 = hist[lane * 4 + 3];
      const unsigned tot = h0 + h1 + h2 + h3; unsigned suf = tot;
#pragma unroll
      for (int o = 1; o < 64; o <<= 1) { const unsigned u = __shfl_down(suf, o); if (lane + o < 64) suf += u; }
      const unsigned above = suf - tot;
      if (above < (unsigned)kk && suf >= (unsigned)kk) {
        unsigned a = above; int bin;
        if (a + h3 >= (unsigned)kk) bin = 3; else { a += h3; if (a + h2 >= (unsigned)kk) bin = 2; else { a += h2; if (a + h1 >= (unsigned)kk) bin = 1; else { a += h1; bin = 0; } } }
        sel[0] = prefix | ((unsigned)(lane * 4 + bin) << shift); sel[1] = (unsigned)kk - a;
      }
    }
    __syncthreads();
    prefix = sel[0]; kk = (int)sel[1]; mask |= 0xffu << shift;
  }
  const unsigned Tk = prefix;
  unsigned cg_ = 0, ce = 0;
#pragma unroll
  for (int i = 0; i < PER; ++i) { cg_ += key[i] > Tk; ce += key[i] == Tk; }
  unsigned pk = active ? (cg_ | (ce << 16)) : 0u, inc = pk;
#pragma unroll
  for (int o = 1; o < 64; o <<= 1) { const unsigned u = __shfl_up(inc, o); if (lane >= o) inc += u; }
  __syncthreads();
  if (lane == 63) wtot[wid] = inc;
  __syncthreads();
  unsigned base = 0;
  for (int w2 = 0; w2 < wid; ++w2) base += wtot[w2];
  const unsigned exc = base + inc - pk; unsigned gt_before = exc & 0xffffu, eq_before = exc >> 16;
  if (active) {
#pragma unroll
    for (int i = 0; i < PER; ++i) {
      const int t = tid * PER + i; int R = -1;
      const bool isgt = key[i] > Tk, iseq = key[i] == Tk;
      if (isgt || (iseq && (int)eq_before < kk)) {
        const int slot = (int)gt_before + min((int)eq_before, kk);
        R = slotbase + slot; IDX[R] = rowbase + t; GV[R] = __uint_as_float(key[i]);
      }
      TS[t] = R;
      gt_before += isgt; eq_before += iseq;
    }
  }
}
__device__ void phase_topk(PRef p, int l, char* smem) {
  const float* aff = (const float*)(p.ws + WS_AFF); int* IDX = (int*)(p.ws + WS_IDX); float* GV = (float*)(p.ws + WS_GV); int* TS = (int*)(p.ws + WS_TS);
  const int nitems = l == 0 ? 256 : 128;
  for (int it = obid(); it < nitems; it += gridDim.x) {
    if (it < 128) { const int b = it >> 4, e = it & 15; topk_item<16>(aff + (size_t)b * SEQ * 16 + e, SEQ, CAPX, b * SEQ, it * CAPX, e, IDX, GV, TS + (size_t)it * SEQ, smem); }
    else { const int v = it - 128, b = v >> 4, e = v & 15; topk_item<1>(aff + ((size_t)MX + b * CTXL) * 16 + e, CTXL, CAPC, MX + b * CTXL, NB * NE * CAPX + e * 256 + b * CAPC, e, IDX, GV, TS + (size_t)NB * 16 * SEQ + (size_t)v * CTXL, smem); }
  }
  __syncthreads();
}

__device__ void phase_moe_up(PRef p, int l, char* smem) {
  LAS unsigned char* lds = (LAS unsigned char*)smem;
  const bf16_t* h = (const bf16_t*)(p.ws + WS_H); const bf16_t* Wgu = (const bf16_t*)(p.ws + WS_WGU); bf16_t* act = (bf16_t*)(p.ws + WS_ACT); const int* IDX = (const int*)(p.ws + WS_IDX);
  const int tid = otid(), wid = tid >> 6, lane = tid & 63, wr = wid >> 2, wc = wid & 3, fr = lane & 15, fq = lane >> 4;
  g8::MoeIter it; it.init(8, l == 0);
  int pm, pn, e;
  while (it.next(pm, pn, e)) {
    unsigned voffA[4];
#pragma unroll
    for (int hh = 0; hh < 2; ++hh)
#pragma unroll
      for (int i = 0; i < 2; ++i) { int R, C; g8::piece_rc(i, R, C); voffA[hh * 2 + i] = (unsigned)(IDX[pm * 256 + hh * 128 + R] * 1024 + C) * 2u; }
    f32x4 acc[2][2][4][2];
    g8::gemm_tile<true>(lds, (const char*)h, voffA, 0, (const char*)(Wgu + ((size_t)e * 2048 + pn * 256) * 1024), 1024, acc);
#pragma unroll
    for (int ai = 0; ai < 2; ++ai)
#pragma unroll
      for (int m = 0; m < 4; ++m) {
          const int row = pm * 256 + ai * 128 + wr * 64 + m * 16 + fr, col = pn * 128 + wc * 32 + fq * 8;
          float a[8];
#pragma unroll
          for (int n = 0; n < 2; ++n) { const f32x4 g = acc[ai][0][m][n], u = acc[ai][1][m][n];
#pragma unroll
            for (int k = 0; k < 4; ++k) a[n * 4 + k] = silu_f(g[k]) * u[k]; }
          u32x4 w = {cvtpk(a[0], a[1]), cvtpk(a[2], a[3]), cvtpk(a[4], a[5]), cvtpk(a[6], a[7])}; *(u32x4*)(act + (size_t)row * 1024 + col) = w;
        }
  }
}
__device__ void phase_moe_down(PRef p, int l, char* smem) {
  LAS unsigned char* lds = (LAS unsigned char*)smem;
  const bf16_t* act = (const bf16_t*)(p.ws + WS_ACT); const bf16_t* Wdn = (const bf16_t*)(p.ws + WS_WDN); bf16_t* oute = (bf16_t*)(p.ws + WS_OUTE); const float* GV = (const float*)(p.ws + WS_GV);
  const int tid = otid(), wid = tid >> 6, lane = tid & 63, wr = wid >> 2, wc = wid & 3, fr = lane & 15, fq = lane >> 4;
  g8::MoeIter it; it.init(4, l == 0);
  int pm, pn, e;
  while (it.next(pm, pn, e)) {
    unsigned voffA[2] = {g8::piece_off(0, 1024, 0), g8::piece_off(1, 1024, 0)};
    f32x4 acc[2][2][4][2];
    g8::gemm_tile<false>(lds, (const char*)(act + (size_t)pm * 256 * 1024), voffA, (size_t)128 * 1024 * 2, (const char*)(Wdn + ((size_t)e * 1024 + pn * 256) * 1024), 1024, acc);
    ACC_FOR3(ai, bj, m) {
      const int row = pm * 256 + ai * 128 + wr * 64 + m * 16 + fr, col = pn * 256 + bj * 128 + wc * 32 + fq * 8;
      const float gv = GV[row]; const f32x4 v0 = acc[ai][bj][m][0] * gv, v1 = acc[ai][bj][m][1] * gv;
      u32x4 w = {cvtpk(v0[0], v0[1]), cvtpk(v0[2], v0[3]), cvtpk(v1[0], v1[1]), cvtpk(v1[2], v1[3])}; *(u32x4*)(oute + (size_t)row * 1024 + col) = w;
    }
  }
}

__device__ void phase_ln2(PRef p, int l) {
  const int lane = otid() & 63, gw = obid() * 8 + (otid() >> 6), nw = gridDim.x * 8;
  bf16_t* h = (bf16_t*)(p.ws + WS_H); float* ctxz = (float*)(p.ws + WS_CTXZ); const bf16_t* oute = (const bf16_t*)(p.ws + WS_OUTE); const int* TS = (const int*)(p.ws + WS_TS);
  const int nrows = l == 0 ? MT : MX;
  for (int row = gw; row < nrows; row += nw) {
    float* xr = row < MX ? p.out + (size_t)row * 1024 : ctxz + (size_t)(row - MX) * 1024;
    f32x4 mo[4];
#pragma unroll
    for (int i = 0; i < 4; ++i) mo[i] = (f32x4){0.f, 0.f, 0.f, 0.f};
    const int myR = lane < 16 ? (row < MX ? TS[((size_t)(row >> 13) * 16 + lane) * SEQ + (row & 8191)] : TS[(size_t)NB * 16 * SEQ + ((size_t)((row - MX) >> 8) * 16 + lane) * CTXL + ((row - MX) & 255)]) : -1;
    for (int e = 0; e < 16; ++e) { const int Rr = __shfl(myR, e);
      if (Rr >= 0) {
#pragma unroll
        for (int i = 0; i < 4; ++i) { const u32x2 w = *(const u32x2*)(oute + (size_t)Rr * 1024 + lane * 4 + 256 * i);
          mo[i][0] += bflo(w[0]); mo[i][1] += bfhi(w[0]); mo[i][2] += bflo(w[1]); mo[i][3] += bfhi(w[1]); } } }
    f32x4 v[4]; const float* m5 = mod_ptr(p, l, row, 5);
#pragma unroll
    for (int i = 0; i < 4; ++i) { const int c = lane * 4 + 256 * i; v[i] = *(const f32x4*)(xr + c) * ALPHA + *(const f32x4*)(m5 + c) * mo[i]; }
    ln_row(v, 1e-5f);
#pragma unroll
    for (int i = 0; i < 4; ++i) { const int c = lane * 4 + 256 * i; v[i] = v[i] * *(const f32x4*)(p.ln2_g + l * 1024 + c) + *(const f32x4*)(p.ln2_b + l * 1024 + c); *(f32x4*)(xr + c) = v[i]; }
    if (l + 1 < DEPTH) { ln_row(v, 1e-6f); store_mod_bf16(v, mod_ptr(p, l + 1, row, 0), mod_ptr(p, l + 1, row, 1), h + (size_t)row * 1024, lane, nullptr); }
  }
}

__device__ __forceinline__ void gsync(cg::grid_group& grid) {
  asm volatile("s_waitcnt vmcnt(0) lgkmcnt(0)" ::: "memory");
  grid.sync();
}
__global__ void __launch_bounds__(512) mega(Params p) {
  extern __shared__ __attribute__((aligned(16))) char smem[];
  cg::grid_group grid = cg::this_grid();
  phase_prep(kparams(), smem);
  gsync(grid);
  phase_h0(kparams());
  gsync(grid);
#pragma unroll 1
  for (int l = 0; l < DEPTH; ++l) {
    phase_inproj(kparams(), l, smem);
    gsync(grid);
    phase_mlstm(kparams(), l, smem);
    gsync(grid);
    phase_mla_prep(kparams(), l, smem);
    gsync(grid);
    phase_attn(kparams(), l, smem);
    gsync(grid);
    phase_outproj(kparams(), l, smem);
    gsync(grid);
    phase_ln1(kparams(), l, smem);
    __syncthreads();
    phase_cvt_experts(kparams(), l, smem);
    gsync(grid);
    phase_topk(kparams(), l, smem);
    gsync(grid);
    phase_moe_up(kparams(), l, smem);
    gsync(grid);
    phase_moe_down(kparams(), l, smem);
    gsync(grid);
    phase_ln2(kparams(), l);
    gsync(grid);
  }
}

extern "C" void kernel_launch(void* const* d_in, const int* in_sizes, int n_in, void* d_out, int out_size,
                              void* d_ws, size_t ws_size, hipStream_t stream) {
  constexpr size_t kDynLds = 160 * 1024;
  static int grid_blocks = 0;
  if (!grid_blocks) {
    int dev = 0, cus = 0, per_cu = 0;
    (void)hipGetDevice(&dev);
    (void)hipDeviceGetAttribute(&cus, hipDeviceAttributeMultiprocessorCount, dev);
    (void)hipFuncSetAttribute((const void*)mega, hipFuncAttributeMaxDynamicSharedMemorySize, (int)kDynLds);
    (void)hipOccupancyMaxActiveBlocksPerMultiprocessor(&per_cu, mega, 512, kDynLds);
    grid_blocks = per_cu > 0 ? cus : 0;
    if (grid_blocks > 256) grid_blocks = 256;
    grid_blocks &= ~7;
    if (grid_blocks != 256) { fprintf(stderr, "this kernel needs 256 co-resident workgroups (got %d)\n", grid_blocks); grid_blocks = 0; }
    if (ws_size < WS_END) { fprintf(stderr, "workspace too small: %zu < %zu\n", ws_size, (size_t)WS_END); grid_blocks = 0; }
  }
  if (grid_blocks <= 0) return;
  Params p{};
  const float** pp = (const float**)&p;
  for (int i = 0; i < 24; ++i) pp[i] = (const float*)d_in[i];
  p.out = (float*)d_out; p.ws = (char*)d_ws;
  void* args[] = {&p};
  hipError_t e = hipLaunchCooperativeKernel((void*)mega, dim3(grid_blocks), dim3(512), args, kDynLds, stream);
  if (e != hipSuccess) fprintf(stderr, "cooperative launch failed: %s (grid %d)\n", hipGetErrorString(e), grid_blocks);
}
```

```cpp
#include <hip/hip_runtime.h>
#include <hip/hip_cooperative_groups.h>
#include <cstdio>
#include <cstdint>
namespace cg = cooperative_groups;

typedef unsigned short bf16_t;
typedef short bf16x8 __attribute__((ext_vector_type(8)));
typedef short s16x4 __attribute__((ext_vector_type(4)));
typedef float f32x4 __attribute__((ext_vector_type(4)));
typedef float f32x16 __attribute__((ext_vector_type(16)));
typedef unsigned u32x4 __attribute__((ext_vector_type(4)));
typedef unsigned u32x2 __attribute__((ext_vector_type(2)));
#define LAS __attribute__((address_space(3)))

constexpr int DM = 1024, NB = 8, SEQ = 8192, CTXL = 256, DEPTH = 2;
constexpr int MX = NB * SEQ, MC = NB * CTXL, MT = MX + MC;
constexpr int PLD = 2816;
constexpr int OFF_Q = 0, OFF_K = 512, OFF_V = 1024, OFF_O = 1536, OFF_G = 2048, OFF_CQ = 2064, OFF_CKV = 2448, OFF_KR = 2704, IN_COLS = 2768;
constexpr int SKV = SEQ + CTXL;
constexpr int NE = 16, CAPX = 1024, CAPC = 32;
constexpr int NSLOT = NB * NE * CAPX + NB * NE * CAPC;
constexpr float ALPHA = 1.4142135623730951f;
constexpr float A_SCALE = 0.07216878364870322f;

constexpr size_t al256(size_t v) { return (v + 255) / 256 * 256; }
constexpr size_t WS_H = 0;
constexpr size_t WS_P = WS_H + al256((size_t)MT * 1024 * 2);
constexpr size_t WS_Q = WS_P + al256((size_t)MT * PLD * 2);
constexpr size_t WS_KV = WS_Q + al256((size_t)MT * 768 * 2);
constexpr size_t WS_KR = WS_KV + al256((size_t)NB * SKV * 1024 * 2);
constexpr size_t WS_MIX = WS_KR + al256((size_t)NB * SKV * 64 * 2);
constexpr size_t WS_ACT = WS_P;
constexpr size_t WS_HB = WS_H;
constexpr size_t WS_OUTE = WS_P + al256((size_t)NSLOT * 1024 * 2);
constexpr size_t WS_WGU = WS_MIX;
constexpr size_t WS_WDN = WS_MIX + (size_t)NE * 2048 * 1024 * 2;
constexpr size_t WS_WIN = WS_MIX + al256((size_t)MT * 1024 * 2);
constexpr size_t WS_WUQ = WS_WIN + (size_t)2 * PLD * 1024 * 2;
constexpr size_t WS_WUKV = WS_WUQ + (size_t)2 * 768 * 384 * 2;
constexpr size_t WS_WOUT = WS_WUKV + (size_t)2 * 1024 * 256 * 2;
constexpr size_t WS_MOD = WS_WOUT + (size_t)2 * 1024 * 1024 * 2;
constexpr size_t WS_COS = WS_MOD + al256((size_t)2 * 9 * 6144 * 4);
constexpr size_t WS_SIN = WS_COS + (size_t)SEQ * 32 * 4;
constexpr size_t WS_GATES = WS_SIN + (size_t)SEQ * 32 * 4;
constexpr size_t WS_AFF = WS_GATES + (size_t)MT * 16 * 4;
constexpr size_t WS_IDX = WS_AFF + (size_t)MT * 16 * 4;
constexpr size_t WS_GV = WS_IDX + (size_t)NSLOT * 4;
constexpr size_t WS_TS = WS_GV + (size_t)NSLOT * 4;
constexpr size_t WS_CTXZ = WS_TS + (size_t)MT * 16 * 4;
constexpr size_t WS_END = WS_CTXZ + (size_t)MC * 1024 * 4;
static_assert(WS_OUTE + (size_t)NSLOT * 1024 * 2 <= WS_KR, "out_e overlay");
static_assert(WS_WDN + (size_t)NE * 1024 * 1024 * 2 <= WS_WIN, "expert weights overlay");

struct Params {
  const float *x, *c, *ctx, *c_ctx, *w_mod, *b_mod, *w_in, *b_gates, *conv_w, *conv_b, *m_norm_w, *q_norm_w, *kv_norm_w, *w_uq, *w_ukv, *w_out,
      *ln1_g, *ln1_b, *w_router, *w_gate, *w_up, *w_down, *ln2_g, *ln2_b;
  float* out; char* ws;
};

typedef const __attribute__((address_space(4))) Params& PRef;
__device__ __forceinline__ PRef kparams() { const __attribute__((address_space(4))) Params* kp = (const __attribute__((address_space(4))) Params*)__builtin_amdgcn_kernarg_segment_ptr(); asm volatile("" : "+s"(kp)); return *kp; }
__device__ __forceinline__ int otid() { int t = threadIdx.x; asm volatile("" : "+v"(t)); return t; }
__device__ __forceinline__ int obid() { int t = blockIdx.x; asm volatile("" : "+s"(t)); return t; }
__device__ __forceinline__ int opaque_s(int v) { asm volatile("" : "+s"(v)); return v; }
typedef __bf16 bf16v2_t __attribute__((ext_vector_type(2)));
typedef float f32x2_t __attribute__((ext_vector_type(2)));
__device__ __forceinline__ unsigned cvtpk(float lo, float hi) { const f32x2_t f = {lo, hi}; const bf16v2_t b = __builtin_convertvector(f, bf16v2_t); return __builtin_bit_cast(unsigned, b); }
__device__ __forceinline__ bf16_t f2bf(float v) { return (bf16_t)(cvtpk(v, v) & 0xffffu); }
__device__ __forceinline__ float bf2f(unsigned v) { return __uint_as_float(v << 16); }
__device__ __forceinline__ float bflo(unsigned w) { return __uint_as_float(w << 16); }
__device__ __forceinline__ float bfhi(unsigned w) { return __uint_as_float(w & 0xffff0000u); }
__device__ __forceinline__ float wave_sum(float v) { for (int o = 32; o > 0; o >>= 1) v += __shfl_xor(v, o); return v; }
__device__ __forceinline__ float wave_max(float v) { for (int o = 32; o > 0; o >>= 1) v = fmaxf(v, __shfl_xor(v, o)); return v; }
__device__ __forceinline__ float sigmoid_f(float v) { return __builtin_amdgcn_rcpf(1.f + __expf(-v)); }
__device__ __forceinline__ float silu_f(float v) { return v * sigmoid_f(v); }

namespace g8 {
constexpr int BK = 64, HALF = 128, HTB = HALF * BK * 2, STAGE_BYTES = 8 * HTB;
__device__ __forceinline__ int lds_byte(int r, int c) { const int st = (r >> 4) * 2 + (c >> 5), rr = r & 15, cc = c & 31, ob = rr * 64 + cc * 2; return st * 1024 + (ob ^ (((ob >> 9) & 1) << 5)); }
__device__ __forceinline__ int perm32(int rho) { const int n = rho >> 4, i = rho & 15; return 8 * (i >> 2) + 4 * n + (i & 3); }
__device__ __forceinline__ void stage_rc(int b, int& R, int& C) { const int st = b / 1024, sb = b % 1024, swz = sb ^ (((sb >> 9) & 1) << 5); R = (st >> 1) * 16 + swz / 64; C = (st & 1) * 32 + (swz % 64) / 2; }

template <bool GATHER>
__device__ __forceinline__ void gemm_tile(LAS unsigned char* lds, const char* __restrict__ Ab, const unsigned (&voffA)[GATHER ? 4 : 2], size_t hstepA, const char* __restrict__ Bb, int K,
                                          f32x4 (&acc)[2][2][4][2]) {
  const int tid = otid(), wid = __builtin_amdgcn_readfirstlane(tid >> 6), lane = tid & 63, wr = wid >> 2, wc = wid & 3, fr = lane & 15, fq = lane >> 4;
  const int nt = K / BK;
  unsigned voffB[2];
#pragma unroll
  for (int i = 0; i < 2; ++i) { int R, C; stage_rc(tid * 16 + i * 8192, R, C); const int Rb = (R & ~31) + perm32(R & 31); voffB[i] = (unsigned)(Rb * K + C) * 2u; }
  const char* Bb1 = Bb + (size_t)HALF * K * 2; const char* Ab1 = GATHER ? Ab : Ab + hstepA;
  const unsigned* vA0 = &voffA[0]; const unsigned* vA1 = GATHER ? &voffA[2] : &voffA[0];
  const unsigned ldsw = (unsigned)wid * 1024u;
  const int aoff = lds_byte(wr * 64 + fr, fq * 8), boff = lds_byte(wc * 32 + fr, fq * 8);
#define G8_SA(b, h) (((b) * 2 + (h)) * HTB)
#define G8_SB(b, h) ((4 + (b) * 2 + (h)) * HTB)
#define G8_STAGE(bufoff, gbase, voff, kt) do { _Pragma("unroll") for (int _i = 0; _i < 2; ++_i) \
    __builtin_amdgcn_global_load_lds((const unsigned*)((gbase) + (size_t)(kt) * (BK * 2) + (voff)[_i]), (LAS unsigned*)(lds + (bufoff) + ldsw + _i * 8192), 16, 0, 0); } while (0)
#define G8_LDA(dst, b, h) do { _Pragma("unroll") for (int m = 0; m < 4; ++m) _Pragma("unroll") for (int k = 0; k < 2; ++k) dst[m][k] = *(const LAS bf16x8*)(lds + G8_SA(b, h) + aoff + m * 2048 + k * 1024); } while (0)
#define G8_LDB(dst, b, h) do { _Pragma("unroll") for (int n = 0; n < 2; ++n) _Pragma("unroll") for (int k = 0; k < 2; ++k) dst[n][k] = *(const LAS bf16x8*)(lds + G8_SB(b, h) + boff + n * 2048 + k * 1024); } while (0)
#define G8_MMA(ai, bj, At, Bt) do { __builtin_amdgcn_s_setprio(1); _Pragma("unroll") for (int m = 0; m < 4; ++m) _Pragma("unroll") for (int n = 0; n < 2; ++n) _Pragma("unroll") for (int k = 0; k < 2; ++k) \
    acc[ai][bj][m][n] = __builtin_amdgcn_mfma_f32_16x16x32_bf16(Bt[n][k], At[m][k], acc[ai][bj][m][n], 0, 0, 0); __builtin_amdgcn_s_setprio(0); } while (0)
#define G8_WAIT_V(n) asm volatile("s_waitcnt vmcnt(" #n ")" ::: "memory")
#define G8_WAIT_L(n) asm volatile("s_waitcnt lgkmcnt(" #n ")" ::: "memory")
#define G8_BAR __builtin_amdgcn_s_barrier()
#define G8_SCHED __builtin_amdgcn_sched_barrier(0)
#pragma unroll
  for (int a = 0; a < 2; ++a)
#pragma unroll
    for (int b = 0; b < 2; ++b)
#pragma unroll
      for (int m = 0; m < 4; ++m)
#pragma unroll
        for (int n = 0; n < 2; ++n) acc[a][b][m][n] = (f32x4){0.f, 0.f, 0.f, 0.f};
  bf16x8 At[4][2], B0[2][2], B1[2][2];
  G8_WAIT_V(0); __syncthreads();
  G8_STAGE(G8_SB(0, 0), Bb, voffB, 0); G8_STAGE(G8_SA(0, 0), Ab, vA0, 0); G8_STAGE(G8_SB(0, 1), Bb1, voffB, 0); G8_STAGE(G8_SA(0, 1), Ab1, vA1, 0);
  if (wr == 1) G8_BAR;
  G8_WAIT_V(4); G8_BAR;
  G8_STAGE(G8_SB(1, 0), Bb, voffB, 1); G8_STAGE(G8_SA(1, 0), Ab, vA0, 1); G8_STAGE(G8_SB(1, 1), Bb1, voffB, 1);
  G8_WAIT_V(6); G8_BAR;
  for (int t = 0; t < nt - 2; t += 2) {
    G8_LDB(B0, 0, 0); G8_SCHED; G8_LDA(At, 0, 0); G8_STAGE(G8_SA(1, 1), Ab1, vA1, t + 1);
    G8_WAIT_L(8); G8_BAR; G8_WAIT_L(0); G8_MMA(0, 0, At, B0); G8_BAR; G8_SCHED;
    G8_LDB(B1, 0, 1); G8_STAGE(G8_SB(0, 0), Bb, voffB, t + 2);
    G8_BAR; G8_WAIT_L(0); G8_MMA(0, 1, At, B1); G8_BAR;
    G8_LDA(At, 0, 1); G8_STAGE(G8_SA(0, 0), Ab, vA0, t + 2);
    G8_BAR; G8_WAIT_L(0); G8_MMA(1, 0, At, B0); G8_BAR; G8_SCHED;
    G8_STAGE(G8_SB(0, 1), Bb1, voffB, t + 2);
    G8_WAIT_V(6); G8_BAR; G8_MMA(1, 1, At, B1); G8_BAR;
    G8_LDB(B0, 1, 0); G8_SCHED; G8_LDA(At, 1, 0); G8_STAGE(G8_SA(0, 1), Ab1, vA1, t + 2);
    G8_WAIT_L(8); G8_BAR; G8_WAIT_L(0); G8_MMA(0, 0, At, B0); G8_BAR; G8_SCHED;
    G8_LDB(B1, 1, 1); G8_STAGE(G8_SB(1, 0), Bb, voffB, t + 3);
    G8_BAR; G8_WAIT_L(0); G8_MMA(0, 1, At, B1); G8_BAR;
    G8_LDA(At, 1, 1); G8_STAGE(G8_SA(1, 0), Ab, vA0, t + 3);
    G8_BAR; G8_WAIT_L(0); G8_MMA(1, 0, At, B0); G8_BAR; G8_SCHED;
    G8_STAGE(G8_SB(1, 1), Bb1, voffB, t + 3);
    G8_WAIT_V(6); G8_BAR; G8_MMA(1, 1, At, B1); G8_BAR;
  }
  { G8_LDB(B0, 0, 0); G8_LDA(At, 0, 0); G8_STAGE(G8_SA(1, 1), Ab1, vA1, nt - 1);
    G8_BAR; G8_WAIT_L(0); G8_MMA(0, 0, At, B0); G8_BAR;
    G8_LDB(B1, 0, 1); G8_BAR; G8_WAIT_L(0); G8_MMA(0, 1, At, B1); G8_BAR;
    G8_LDA(At, 0, 1); G8_WAIT_V(4); G8_BAR; G8_WAIT_L(0); G8_MMA(1, 0, At, B0); G8_MMA(1, 1, At, B1); G8_BAR; }
  { G8_LDB(B0, 1, 0); G8_LDA(At, 1, 0); G8_WAIT_V(2); G8_BAR; G8_WAIT_L(0); G8_MMA(0, 0, At, B0); G8_BAR;
    G8_LDB(B1, 1, 1); G8_WAIT_V(0); G8_BAR; G8_WAIT_L(0); G8_MMA(0, 1, At, B1); G8_BAR;
    G8_LDA(At, 1, 1); G8_BAR; G8_WAIT_L(0); G8_MMA(1, 0, At, B0); G8_MMA(1, 1, At, B1); G8_BAR; }
  if (wr == 0) G8_BAR;
}
__device__ __forceinline__ unsigned piece_off(int i, int ld, int c0) { int R, C; stage_rc((int)otid() * 16 + i * 8192, R, C); return (unsigned)(R * ld + c0 + C) * 2u; }
__device__ __forceinline__ void piece_rc(int i, int& R, int& C) { stage_rc((int)otid() * 16 + i * 8192, R, C); }
struct TileIter {
  int nM, nN, x, j, J, cnt, idx;
  __device__ __forceinline__ void init(int nM_, int nN_) { nM = nM_; nN = nN_; x = obid() & 7; j = obid() >> 3; J = gridDim.x >> 3; cnt = ((nM - x + 7) >> 3) * nN; idx = j; }
  __device__ __forceinline__ bool next(int& pm, int& pn) { if (idx >= cnt) return false; pm = x + 8 * (idx / nN); pn = idx % nN; idx += J; return true; }
};
struct MoeIter {
  int nN, x, jm, jn, j, step, nsteps, nb4; bool with_ctx, ctx_done, wide;
  __device__ __forceinline__ void init(int nN_, bool with_ctx_) { nN = nN_; with_ctx = with_ctx_; wide = nN_ == 8; x = obid() & 7; j = obid() >> 3;
    if (wide) { jm = j & 3; jn = j >> 2; nsteps = 16; } else { jm = j & 7; jn = j >> 3; nsteps = 2 * (nN >> 2) * 4; }
    nb4 = nN >> 2; step = 0; ctx_done = false; }
  __device__ __forceinline__ bool next(int& pm, int& pn, int& e) {
    if (step < nsteps) {
      int m32;
      if (wide) { const int mb = step & 7, el = step >> 3; e = 2 * x + el; m32 = mb * 4 + jm; pn = jn; }
      else { const int mb = step & 3, nb = (step >> 2) % nb4, el = (step >> 2) / nb4; e = 2 * x + el; m32 = mb * 8 + jm; pn = nb * 4 + jn; }
      pm = ((m32 >> 2) * 16 + e) * 4 + (m32 & 3); ++step; return true; }
    if (with_ctx && !ctx_done) { ctx_done = true; if (j < 2 * nN) { e = 2 * x + j / nN; pm = 512 + e; pn = j % nN; return true; } }
    return false;
  }
};
}

#define ACC_FOR3(ai, bj, m) _Pragma("unroll") for (int ai = 0; ai < 2; ++ai) _Pragma("unroll") for (int bj = 0; bj < 2; ++bj) _Pragma("unroll") for (int m = 0; m < 4; ++m)
#define ACC_FOR(ai, bj, m, n) _Pragma("unroll") for (int ai = 0; ai < 2; ++ai) _Pragma("unroll") for (int bj = 0; bj < 2; ++bj) _Pragma("unroll") for (int m = 0; m < 4; ++m) _Pragma("unroll") for (int n = 0; n < 2; ++n)

__device__ __forceinline__ void cvt_tile(const float* __restrict__ src, int N, int K, int k0, int n0, bf16_t* __restrict__ dst, long drow0, const float* __restrict__ kscale, float* lds) {
  const int tid = otid();
  { const int kr = tid >> 6, n = tid & 63;
#pragma unroll
    for (int i = 0; i < 8; ++i) { const int k = kr + 8 * i; float v = (n0 + n < N) ? src[(size_t)(k0 + k) * N + n0 + n] : 0.f; if (kscale) v *= kscale[k0 + k]; lds[k * 65 + n] = v; } }
  __syncthreads();
  { const int n = tid >> 3, k8 = (tid & 7) * 8; float v[8];
#pragma unroll
    for (int i = 0; i < 8; ++i) v[i] = lds[(k8 + i) * 65 + n];
    u32x4 w = {cvtpk(v[0], v[1]), cvtpk(v[2], v[3]), cvtpk(v[4], v[5]), cvtpk(v[6], v[7])};
    *(u32x4*)(dst + (size_t)(drow0 + n) * K + k0 + k8) = w; }
  __syncthreads();
}

__device__ void phase_prep(PRef p, char* smem) {
  float* lds = (float*)smem;
  bf16_t* Wt_in = (bf16_t*)(p.ws + WS_WIN); bf16_t* Wt_uq = (bf16_t*)(p.ws + WS_WUQ); bf16_t* Wt_ukv = (bf16_t*)(p.ws + WS_WUKV); bf16_t* Wt_out = (bf16_t*)(p.ws + WS_WOUT);
  float* mod = (float*)(p.ws + WS_MOD);
  constexpr int T_MOD = 192, T_IN = 2 * 16 * 44, T_UQ = 2 * 6 * 12, T_UKV = 2 * 4 * 16, T_OUT = 2 * 16 * 16, T_ROPE = 64;
  constexpr int E0 = T_MOD, E1 = E0 + T_IN, E2 = E1 + T_UQ, E3 = E2 + T_UKV, E4 = E3 + T_OUT, E5 = E4 + T_ROPE;
  const int tid = otid();
  for (int task = obid(); task < E5; task += gridDim.x) {
    if (task < E0) {
      const int l = task / 96, j0 = (task % 96) * 64;
      float* sc = lds;
      for (int i = tid; i < 9 * 1024; i += 512) { const int bb = i >> 10, d = i & 1023; const float v = bb < 8 ? p.c[bb * 1024 + d] : p.c_ctx[d]; sc[i] = v / (1.f + expf(-v)); }
      __syncthreads();
      const int col = tid & 63, ks = tid >> 6; float a[9];
#pragma unroll
      for (int bb = 0; bb < 9; ++bb) a[bb] = 0.f;
      const float* wm = p.w_mod + (size_t)l * 1024 * 6144 + j0 + col;
      for (int d = ks * 128; d < ks * 128 + 128; ++d) { const float w = wm[(size_t)d * 6144];
#pragma unroll
        for (int bb = 0; bb < 9; ++bb) a[bb] += sc[bb * 1024 + d] * w; }
      float* red = lds + 9 * 1024;
#pragma unroll
      for (int bb = 0; bb < 9; ++bb) red[(ks * 9 + bb) * 64 + col] = a[bb];
      __syncthreads();
      for (int i = tid; i < 9 * 64; i += 512) { const int bb = i >> 6, cc = i & 63; float s = 0.f;
        for (int k = 0; k < 8; ++k) s += red[(k * 9 + bb) * 64 + cc];
        mod[((size_t)l * 9 + bb) * 6144 + j0 + cc] = s + p.b_mod[l * 6144 + j0 + cc]; }
      __syncthreads();
    } else if (task < E1) { const int t = task - E0, l = t / 704, r = t % 704, kt = r / 44, nt = r % 44;
      cvt_tile(p.w_in + (size_t)l * 1024 * IN_COLS, IN_COLS, 1024, kt * 64, nt * 64, Wt_in + (size_t)l * PLD * 1024, nt * 64, nullptr, lds);
    } else if (task < E2) { const int t = task - E1, l = t / 72, r = t % 72, kt = r / 12, nt = r % 12;
      cvt_tile(p.w_uq + (size_t)l * 384 * 768, 768, 384, kt * 64, nt * 64, Wt_uq + (size_t)l * 768 * 384, nt * 64, p.q_norm_w + l * 384, lds);
    } else if (task < E3) { const int t = task - E2, l = t / 64, r = t % 64, kt = r / 16, nt = r % 16;
      cvt_tile(p.w_ukv + (size_t)l * 256 * 1024, 1024, 256, kt * 64, nt * 64, Wt_ukv + (size_t)l * 1024 * 256, nt * 64, p.kv_norm_w + l * 256, lds);
    } else if (task < E4) { const int t = task - E3, l = t / 256, r = t % 256, kt = r / 16, nt = r % 16;
      cvt_tile(p.w_out + (size_t)l * 1024 * 1024, 1024, 1024, kt * 64, nt * 64, Wt_out + (size_t)l * 1024 * 1024, nt * 64, nullptr, lds);
    } else {
      float* cs = (float*)(p.ws + WS_COS); float* sn = (float*)(p.ws + WS_SIN);
      for (int i = (task - E4) * 4096 + tid; i < (task - E4 + 1) * 4096; i += 512) { const int t = i >> 5, j = i & 31;
        const float inv = exp2f(-(float)(j & 15) * (13.287712379549449f / 16.f));
        const float pos = (float)(j < 16 ? (t >> 6) : (t & 63)); const float ang = pos * inv;
        const double a = (double)ang; const double k = rint(a * 0.15915494309189535); const float r = (float)(a - k * 6.283185307179586);
        cs[i] = __cosf(r); sn[i] = __sinf(r); }
    }
  }
}

__device__ void phase_cvt_experts(PRef p, int l, char* smem) {
  float* lds = (float*)smem;
  bf16_t* Wgu = (bf16_t*)(p.ws + WS_WGU); bf16_t* Wdn = (bf16_t*)(p.ws + WS_WDN);
  const int tid = otid();
  for (int task = obid(); task < NE * 192; task += gridDim.x) {
    const int e = task / 192, r = task % 192, which = r >> 6, kt = (r & 63) >> 2, nt = r & 3, k0 = kt * 64, n0 = nt * 256;
    const float* src = (which == 0 ? p.w_gate : which == 1 ? p.w_up : p.w_down) + ((size_t)l * NE + e) * 1024 * 1024;
    { const int kr = tid >> 6, n4 = (tid & 63) * 4;
#pragma unroll
      for (int i = 0; i < 8; ++i) { const int k = kr + 8 * i; *(f32x4*)(lds + k * 260 + n4) = *(const f32x4*)(src + (size_t)(k0 + k) * 1024 + n0 + n4); } }
    __syncthreads();
    { const int nl = tid >> 1, k32 = (tid & 1) * 32, n = n0 + nl;
      const size_t drow = which == 2 ? (size_t)n : (size_t)((n >> 7) * 256 + which * 128 + (n & 127));
      bf16_t* dst = (which == 2 ? Wdn + (size_t)e * 1024 * 1024 : Wgu + (size_t)e * 2048 * 1024) + drow * 1024 + k0 + k32;
#pragma unroll
      for (int q = 0; q < 4; ++q) { float v[8];
#pragma unroll
        for (int i = 0; i < 8; ++i) v[i] = lds[(k32 + q * 8 + i) * 260 + nl];
        u32x4 w = {cvtpk(v[0], v[1]), cvtpk(v[2], v[3]), cvtpk(v[4], v[5]), cvtpk(v[6], v[7])};
        *(u32x4*)(dst + q * 8) = w; } }
    __syncthreads();
  }
}

__device__ __forceinline__ void ln_row(f32x4 (&v)[4], float eps) {
  float s = 0.f;
#pragma unroll
  for (int i = 0; i < 4; ++i) s += v[i][0] + v[i][1] + v[i][2] + v[i][3];
  const float mu = wave_sum(s) * (1.f / 1024.f);
  float q = 0.f;
#pragma unroll
  for (int i = 0; i < 4; ++i)
#pragma unroll
    for (int k = 0; k < 4; ++k) { v[i][k] -= mu; q += v[i][k] * v[i][k]; }
  const float rs = rsqrtf(wave_sum(q) * (1.f / 1024.f) + eps);
#pragma unroll
  for (int i = 0; i < 4; ++i) v[i] *= rs;
}
__device__ __forceinline__ void store_mod_bf16(const f32x4 (&v)[4], const float* __restrict__ shift, const float* __restrict__ scale, bf16_t* __restrict__ hrow, int lane, f32x4 (*keep)[4]) {
#pragma unroll
  for (int i = 0; i < 4; ++i) { const int c = lane * 4 + 256 * i; const f32x4 sh = *(const f32x4*)(shift + c), sc = *(const f32x4*)(scale + c);
    f32x4 o = v[i] * (sc + 1.f) + sh; if (keep) (*keep)[i] = o;
    u32x2 w = {cvtpk(o[0], o[1]), cvtpk(o[2], o[3])}; *(u32x2*)(hrow + c) = w; }
}
__device__ __forceinline__ const float* mod_ptr(PRef p, int l, int row, int which) {
  const int bb = row < MX ? (row >> 13) : 8;
  return (const float*)(p.ws + WS_MOD) + ((size_t)l * 9 + bb) * 6144 + which * 1024;
}

__device__ void phase_h0(PRef p) {
  const int lane = otid() & 63, gw = obid() * 8 + (otid() >> 6), nw = gridDim.x * 8;
  bf16_t* h = (bf16_t*)(p.ws + WS_H);
  for (int row = gw; row < MT; row += nw) {
    const float* src = row < MX ? p.x + (size_t)row * 1024 : p.ctx + (size_t)(row - MX) * 1024;
    f32x4 v[4];
#pragma unroll
    for (int i = 0; i < 4; ++i) v[i] = *(const f32x4*)(src + lane * 4 + 256 * i);
    ln_row(v, 1e-6f);
    store_mod_bf16(v, mod_ptr(p, 0, row, 0), mod_ptr(p, 0, row, 1), h + (size_t)row * 1024, lane, nullptr);
  }
}

__device__ void phase_inproj(PRef p, int l, char* smem) {
  LAS unsigned char* lds = (LAS unsigned char*)smem;
  const bf16_t* h = (const bf16_t*)(p.ws + WS_H); const bf16_t* Wt = (const bf16_t*)(p.ws + WS_WIN) + (size_t)l * PLD * 1024;
  bf16_t* P = (bf16_t*)(p.ws + WS_P); float* gates = (float*)(p.ws + WS_GATES);
  const int tid = otid(), wid = tid >> 6, lane = tid & 63, wr = wid >> 2, wc = wid & 3, fr = lane & 15, fq = lane >> 4;
  g8::TileIter it; it.init(MT / 256, PLD / 256);
  int pm, pn;
  while (it.next(pm, pn)) {
    unsigned voffA[2] = {g8::piece_off(0, 1024, 0), g8::piece_off(1, 1024, 0)};
    f32x4 acc[2][2][4][2];
    g8::gemm_tile<false>(lds, (const char*)(h + (size_t)pm * 256 * 1024), voffA, (size_t)128 * 1024 * 2, (const char*)(Wt + (size_t)pn * 256 * 1024), 1024, acc);
    ACC_FOR3(ai, bj, m) {
      const int row = pm * 256 + ai * 128 + wr * 64 + m * 16 + fr, col = pn * 256 + bj * 128 + wc * 32 + fq * 8;
      const f32x4 v0 = acc[ai][bj][m][0], v1 = acc[ai][bj][m][1];
      u32x4 w = {cvtpk(v0[0], v0[1]), cvtpk(v0[2], v0[3]), cvtpk(v1[0], v1[1]), cvtpk(v1[2], v1[3])}; *(u32x4*)(P + (size_t)row * PLD + col) = w;
      if (col >= OFF_G && col < OFF_G + 16) { const f32x4 bg0 = *(const f32x4*)(p.b_gates + l * 16 + (col - OFF_G)), bg1 = *(const f32x4*)(p.b_gates + l * 16 + (col - OFF_G) + 4);
        *(f32x4*)(gates + (size_t)row * 16 + (col - OFF_G)) = v0 + bg0; *(f32x4*)(gates + (size_t)row * 16 + (col - OFF_G) + 4) = v1 + bg1; }
    }
  }
}


__device__ void phase_mlstm(PRef p, int l, char* smem) {
  bf16_t* RAWQ = (bf16_t*)(smem); bf16_t* RAWK = (bf16_t*)(smem + 17408);
  bf16_t* QB = (bf16_t*)(smem + 34816); bf16_t* KB = (bf16_t*)(smem + 52224);
  bf16_t* KT = (bf16_t*)(smem + 69632);
  bf16_t* VT = (bf16_t*)(smem + 88064); bf16_t* VWT = (bf16_t*)(smem + 94976);
  bf16_t* PB = (bf16_t*)(smem + 101888);
  bf16_t* CT = (bf16_t*)(smem + 111104);
  float* SC = (float*)(smem + 124160);
  const bf16_t* P = (const bf16_t*)(p.ws + WS_P); const float* gates = (const float*)(p.ws + WS_GATES);
  bf16_t* hbuf = (bf16_t*)(p.ws + WS_HB);
  const int tid = otid(), wid = tid >> 6, lane = tid & 63, fr = lane & 15, fq = lane >> 4;
  for (int w = obid(); w < 256; w += gridDim.x) {
    const int slice = (w >> 3) & 3, chain = (w & 7) * 8 + (w >> 5), dir = chain & 1, hd = (chain >> 1) & 3, b = chain >> 3;
    const int c2 = (tid & 63) * 2;
    float wq0[5], wq1[5], wk0[5], wk1[5];
#pragma unroll
    for (int j = 0; j < 5; ++j) { const float* cw = p.conv_w + ((size_t)l * 5 + j) * 1024; wq0[j] = cw[hd * 128 + c2]; wq1[j] = cw[hd * 128 + c2 + 1]; wk0[j] = cw[512 + hd * 128 + c2]; wk1[j] = cw[512 + hd * 128 + c2 + 1]; }
    const float bq0 = p.conv_b[l * 1024 + hd * 128 + c2], bq1 = p.conv_b[l * 1024 + hd * 128 + c2 + 1], bk0 = p.conv_b[l * 1024 + 512 + hd * 128 + c2], bk1 = p.conv_b[l * 1024 + 512 + hd * 128 + c2 + 1];
    __syncthreads();
    for (int i = tid; i < 48 * 136 / 2; i += 512) ((unsigned*)CT)[i] = 0u;
    for (int i = tid; i < 48 * 72 / 2; i += 512) { ((unsigned*)VT)[i] = 0u; ((unsigned*)VWT)[i] = 0u; }
    f32x4 accC[3];
#pragma unroll
    for (int i = 0; i < 3; ++i) accC[i] = (f32x4){0.f, 0.f, 0.f, 0.f};
    float m_state = 0.f;
    __syncthreads();
    u32x4 pre_raw[5]; u32x2 pre_v; float pre_ig = 0.f, pre_fg = 0.f;
    const int vl = tid >> 3, ve4 = (tid & 7) * 4;
#define MLSTM_PREFETCH(CI) do { const int ci_ = (CI); const bool ic_ = ci_ < 4; const int cc_ = ic_ ? ci_ : ci_ - 4, T_ = ic_ ? CTXL : SEQ, rb_ = ic_ ? MX + b * CTXL : b * SEQ; \
      const int tlo_ = dir ? T_ - 64 - cc_ * 64 : cc_ * 64; \
      _Pragma("unroll") for (int k_ = 0; k_ < 5; ++k_) { const int pc = tid + k_ * 512; pre_raw[k_] = (u32x4){0u, 0u, 0u, 0u}; \
        if (pc < 2176) { const int tens = pc >= 1088, rem = tens ? pc - 1088 : pc, rr = rem >> 4, c16 = rem & 15, t = tlo_ - 2 + rr; \
          if (t >= 0 && t < T_) pre_raw[k_] = *(const u32x4*)(P + (size_t)(rb_ + t) * PLD + (tens ? OFF_K : OFF_Q) + hd * 128 + c16 * 8); } } \
      { const int vt_ = dir ? tlo_ + 63 - vl : tlo_ + vl; pre_v = *(const u32x2*)(P + (size_t)(rb_ + vt_) * PLD + OFF_V + hd * 128 + slice * 32 + ve4); } \
      if (wid == 0) { const int t = dir ? tlo_ + 63 - lane : tlo_ + lane; const float* g = gates + (size_t)(rb_ + t) * 16; pre_ig = g[dir * 8 + hd]; pre_fg = g[dir * 8 + 4 + hd]; } } while (0)
    MLSTM_PREFETCH(0);
    for (int ci = 0; ci < 132; ++ci) {
      const bool isctx = ci < 4; const int cc = isctx ? ci : ci - 4, T = isctx ? CTXL : SEQ, rowbase = isctx ? MX + b * CTXL : b * SEQ;
      const int tlo = dir ? T - 64 - cc * 64 : cc * 64;
      float* S = SC + (ci & 1) * 384;
      const bool need_out = !(l == DEPTH - 1 && isctx);
      if (wid == 0) {
        const float ig = pre_ig, fg = pre_fg;
        const float lf = fminf(fg, 0.f) - log1pf(expf(-fabsf(fg)));
        float bc = lf;
#pragma unroll
        for (int o = 1; o < 64; o <<= 1) { const float u = __shfl_up(bc, o); if (lane >= o) bc += u; }
        const float a = ig - bc; float pmx = a;
#pragma unroll
        for (int o = 1; o < 64; o <<= 1) { const float u = __shfl_up(pmx, o); if (lane >= o) pmx = fmaxf(pmx, u); }
        const float Mx = fmaxf(pmx, m_state), M63 = __shfl(Mx, 63), b63 = __shfl(bc, 63);
        S[lane] = a; S[64 + lane] = Mx; S[128 + lane] = __expf(m_state - Mx); S[192 + lane] = __expf(-(bc + Mx)); S[256 + lane] = __expf(a - M63);
        if (lane == 0) { S[320] = __expf(m_state - M63); S[321] = b63 + M63; }
      }
#pragma unroll
      for (int k = 0; k < 5; ++k) { const int pc = tid + k * 512;
        if (pc < 2176) { const int tens = pc >= 1088, rem = tens ? pc - 1088 : pc, rr = rem >> 4, c16 = rem & 15; *(u32x4*)((tens ? RAWK : RAWQ) + rr * 128 + c16 * 8) = pre_raw[k]; } }
      const u32x2 vraw = pre_v;
      if (ci + 1 < 132) MLSTM_PREFETCH(ci + 1);
      __syncthreads();
      {
        const int rg = wid; unsigned rq[12], rk[12];
#pragma unroll
        for (int i = 0; i < 12; ++i) { rq[i] = *(const unsigned*)(RAWQ + (rg * 8 + i) * 128 + c2); rk[i] = *(const unsigned*)(RAWK + (rg * 8 + i) * 128 + c2); }
#pragma unroll
        for (int jj = 0; jj < 8; ++jj) {
          float yq0 = bq0, yq1 = bq1, yk0 = bk0, yk1 = bk1;
#pragma unroll
          for (int tp = 0; tp < 5; ++tp) { yq0 += wq0[tp] * bflo(rq[jj + tp]); yq1 += wq1[tp] * bfhi(rq[jj + tp]); yk0 += wk0[tp] * bflo(rk[jj + tp]); yk1 += wk1[tp] * bfhi(rk[jj + tp]); }
          const int j = rg * 8 + jj, lr = dir ? 63 - j : j;
          const float q0 = silu_f(yq0) * 0.08838834764831845f, q1 = silu_f(yq1) * 0.08838834764831845f, k0 = silu_f(yk0), k1 = silu_f(yk1);
          *(unsigned*)(QB + lr * 136 + c2) = cvtpk(q0, q1);
          const unsigned kw = cvtpk(k0, k1);
          *(unsigned*)(KB + lr * 136 + c2) = kw;
          KT[c2 * 72 + lr] = (bf16_t)(kw & 0xffffu); KT[(c2 + 1) * 72 + lr] = (bf16_t)(kw >> 16);
        }
        const float wsl = S[256 + vl];
        const float v0 = bflo(vraw[0]), v1 = bfhi(vraw[0]), v2 = bflo(vraw[1]), v3 = bfhi(vraw[1]);
        VT[(ve4 + 0) * 72 + vl] = (bf16_t)(vraw[0] & 0xffffu); VT[(ve4 + 1) * 72 + vl] = (bf16_t)(vraw[0] >> 16);
        VT[(ve4 + 2) * 72 + vl] = (bf16_t)(vraw[1] & 0xffffu); VT[(ve4 + 3) * 72 + vl] = (bf16_t)(vraw[1] >> 16);
        VWT[(ve4 + 0) * 72 + vl] = f2bf(v0 * wsl); VWT[(ve4 + 1) * 72 + vl] = f2bf(v1 * wsl); VWT[(ve4 + 2) * 72 + vl] = f2bf(v2 * wsl); VWT[(ve4 + 3) * 72 + vl] = f2bf(v3 * wsl);
        if (tid < 64) { VT[32 * 72 + tid] = (bf16_t)0x3F80u; VWT[32 * 72 + tid] = f2bf(S[256 + tid]); }
      }
      __syncthreads();
      if (need_out) {
        const int mt = wid >> 1;
#pragma unroll
        for (int u = 0; u < 2; ++u) {
          const int ntl = (wid & 1) * 2 + u;
          f32x4 s = {0.f, 0.f, 0.f, 0.f};
          if (ntl <= mt) {
#pragma unroll
            for (int kk = 0; kk < 4; ++kk) {
              const bf16x8 a = *(const bf16x8*)(QB + (mt * 16 + fr) * 136 + kk * 32 + fq * 8), bb = *(const bf16x8*)(KB + (ntl * 16 + fr) * 136 + kk * 32 + fq * 8);
              s = __builtin_amdgcn_mfma_f32_16x16x32_bf16(a, bb, s, 0, 0, 0); }
          }
          const int j = ntl * 16 + fr; const float aj = S[j];
#pragma unroll
          for (int jj = 0; jj < 4; ++jj) { const int lr = mt * 16 + fq * 4 + jj;
            const float pv = (j <= lr) ? s[jj] * __expf(fminf(aj - S[64 + lr], 0.f)) : 0.f;
            PB[lr * 72 + j] = f2bf(pv); }
        }
      }
      __syncthreads();
      if (need_out && wid < 4) {
        const int mt = wid; f32x4 num[3];
#pragma unroll
        for (int ntl = 0; ntl < 3; ++ntl) {
          f32x4 a1 = {0.f, 0.f, 0.f, 0.f}, a2 = {0.f, 0.f, 0.f, 0.f};
#pragma unroll
          for (int kk = 0; kk < 2; ++kk) { const bf16x8 a = *(const bf16x8*)(PB + (mt * 16 + fr) * 72 + kk * 32 + fq * 8), bb = *(const bf16x8*)(VT + (ntl * 16 + fr) * 72 + kk * 32 + fq * 8);
            a1 = __builtin_amdgcn_mfma_f32_16x16x32_bf16(a, bb, a1, 0, 0, 0); }
#pragma unroll
          for (int kk = 0; kk < 4; ++kk) { const bf16x8 a = *(const bf16x8*)(QB + (mt * 16 + fr) * 136 + kk * 32 + fq * 8), bb = *(const bf16x8*)(CT + (ntl * 16 + fr) * 136 + kk * 32 + fq * 8);
            a2 = __builtin_amdgcn_mfma_f32_16x16x32_bf16(a, bb, a2, 0, 0, 0); }
#pragma unroll
          for (int jj = 0; jj < 4; ++jj) num[ntl][jj] = a1[jj] + S[128 + mt * 16 + fq * 4 + jj] * a2[jj];
        }
#pragma unroll
        for (int jj = 0; jj < 4; ++jj) {
          const int lr = mt * 16 + fq * 4 + jj; const float den = __shfl(num[2][jj], lane & 48);
          const float rd = __builtin_amdgcn_rcpf(fmaxf(fabsf(den), S[192 + lr]));
          const int t = dir ? tlo + 63 - lr : tlo + lr;
          bf16_t* hp = hbuf + ((size_t)((dir * 4 + hd) * 4 + slice) * MT + rowbase + t) * 32 + fr;
          hp[0] = f2bf(num[0][jj] * rd); hp[16] = f2bf(num[1][jj] * rd);
        }
      }
      __syncthreads();
      {
        const float decay = S[320];
#pragma unroll
        for (int mt = 0; mt < 3; ++mt) {
          accC[mt] *= decay;
#pragma unroll
          for (int kk = 0; kk < 2; ++kk) { const bf16x8 a = *(const bf16x8*)(VWT + (mt * 16 + fr) * 72 + kk * 32 + fq * 8), bb = *(const bf16x8*)(KT + (wid * 16 + fr) * 72 + kk * 32 + fq * 8);
            accC[mt] = __builtin_amdgcn_mfma_f32_16x16x32_bf16(a, bb, accC[mt], 0, 0, 0); }
#pragma unroll
          for (int jj = 0; jj < 4; ++jj) CT[(mt * 16 + fq * 4 + jj) * 136 + wid * 16 + fr] = f2bf(accC[mt][jj]);
        }
        m_state = S[321];
      }
    }
  }
}

template <int WHICH>
__device__ __forceinline__ void mla_gemm(PRef p, int l, char* smem) {
  LAS unsigned char* lds = (LAS unsigned char*)smem; float* rsb = (float*)(smem + g8::STAGE_BYTES);
  const bf16_t* P = (const bf16_t*)(p.ws + WS_P);
  const int tid = otid(), wid = tid >> 6, lane = tid & 63, wr = wid >> 2, wc = wid & 3, fr = lane & 15, fq = lane >> 4;
  constexpr int K = WHICH ? 256 : 384, OFFC = WHICH ? OFF_CKV : OFF_CQ, N = WHICH ? 1024 : 768;
  const bf16_t* Wt = WHICH ? (const bf16_t*)(p.ws + WS_WUKV) + (size_t)l * 1024 * 256 : (const bf16_t*)(p.ws + WS_WUQ) + (size_t)l * 768 * 384;
  bf16_t* O = (bf16_t*)(p.ws + (WHICH ? WS_KV : WS_Q));
  g8::TileIter it; it.init((WHICH || l == 0) ? MT / 256 : MX / 256, N / 256);
  int pm, pn;
  while (it.next(pm, pn)) {
    __syncthreads();
    { const int r = tid >> 1, hf = tid & 1; const bf16_t* src = P + (size_t)(pm * 256 + r) * PLD + OFFC + hf * (K / 2); float s = 0.f;
#pragma unroll 4
      for (int i = 0; i < K / 16; ++i) { const u32x4 v = *(const u32x4*)(src + i * 8);
#pragma unroll
        for (int k = 0; k < 4; ++k) { const float a = bflo(v[k]), bq = bfhi(v[k]); s += a * a + bq * bq; } }
      s += __shfl_xor(s, 1);
      if (hf == 0) rsb[r] = rsqrtf(s / (float)K + 1e-6f); }
    unsigned voffA[2] = {g8::piece_off(0, PLD, OFFC), g8::piece_off(1, PLD, OFFC)};
    f32x4 acc[2][2][4][2];
    g8::gemm_tile<false>(lds, (const char*)(P + (size_t)pm * 256 * PLD), voffA, (size_t)128 * PLD * 2, (const char*)(Wt + (size_t)pn * 256 * K), opaque_s(K), acc);
    ACC_FOR3(ai, bj, m) {
      const int rl = ai * 128 + wr * 64 + m * 16 + fr, row = pm * 256 + rl, col = pn * 256 + bj * 128 + wc * 32 + fq * 8;
      const float rs = rsb[rl]; const f32x4 v0 = acc[ai][bj][m][0] * rs, v1 = acc[ai][bj][m][1] * rs;
      size_t orow = row;
      if (WHICH) orow = row < MX ? (size_t)(row >> 13) * SKV + CTXL + (row & 8191) : (size_t)((row - MX) >> 8) * SKV + ((row - MX) & 255);
      u32x4 w = {cvtpk(v0[0], v0[1]), cvtpk(v0[2], v0[3]), cvtpk(v1[0], v1[1]), cvtpk(v1[2], v1[3])}; *(u32x4*)(O + orow * N + col) = w;
    }
  }
}
__device__ void phase_mla_prep(PRef p, int l, char* smem) {
  mla_gemm<0>(p, l, smem);
  mla_gemm<1>(p, l, smem);
  const bf16_t* P = (const bf16_t*)(p.ws + WS_P);
  const int tid = otid(), wid = tid >> 6, lane = tid & 63;
  const bf16_t* hbuf = (const bf16_t*)(p.ws + WS_HB); bf16_t* mix = (bf16_t*)(p.ws + WS_MIX); bf16_t* KR = (bf16_t*)(p.ws + WS_KR);
  const float* cs = (const float*)(p.ws + WS_COS); const float* sn = (const float*)(p.ws + WS_SIN);
  const int gw = obid() * 8 + wid, nw = gridDim.x * 8;
  for (int row = gw; row < MT; row += nw) {
    if (row < MX || l == 0) {
      const size_t ho = ((size_t)(lane >> 2) * MT + row) * 32 + (lane & 3) * 8;
      const u32x4 hf = *(const u32x4*)(hbuf + ho), hb = *(const u32x4*)(hbuf + (size_t)16 * MT * 32 + ho);
      const u32x4 ov = *(const u32x4*)(P + (size_t)row * PLD + OFF_O + lane * 8);
      float v[8]; float s = 0.f;
#pragma unroll
      for (int k = 0; k < 4; ++k) { v[2 * k] = bflo(hf[k]) + bflo(hb[k]); v[2 * k + 1] = bfhi(hf[k]) + bfhi(hb[k]); s += v[2 * k] + v[2 * k + 1]; }
      s += __shfl_xor(s, 1); s += __shfl_xor(s, 2); s += __shfl_xor(s, 4); s += __shfl_xor(s, 8);
      const float mu = s * (1.f / 128.f); float q = 0.f;
#pragma unroll
      for (int k = 0; k < 8; ++k) { v[k] -= mu; q += v[k] * v[k]; }
      q += __shfl_xor(q, 1); q += __shfl_xor(q, 2); q += __shfl_xor(q, 4); q += __shfl_xor(q, 8);
      const float rs = rsqrtf(q * (1.f / 128.f) + 1e-6f);
      const float* nw_ = p.m_norm_w + l * 512 + lane * 8; float o[8];
#pragma unroll
      for (int k = 0; k < 4; ++k) { o[2 * k] = v[2 * k] * rs * nw_[2 * k] * sigmoid_f(bflo(ov[k])); o[2 * k + 1] = v[2 * k + 1] * rs * nw_[2 * k + 1] * sigmoid_f(bfhi(ov[k])); }
      u32x4 wv = {cvtpk(o[0], o[1]), cvtpk(o[2], o[3]), cvtpk(o[4], o[5]), cvtpk(o[6], o[7])};
      *(u32x4*)(mix + (size_t)row * 1024 + lane * 8) = wv;
    }
    {
      const int j = lane & 31;
      const float x1 = bf2f(P[(size_t)row * PLD + OFF_KR + j]), x2 = bf2f(P[(size_t)row * PLD + OFF_KR + 32 + j]);
      float o1 = x1, o2 = x2; size_t orow;
      if (row < MX) { const int t = row & 8191; const float c = cs[t * 32 + j], s_ = sn[t * 32 + j]; o1 = x1 * c - x2 * s_; o2 = x2 * c + x1 * s_; orow = (size_t)(row >> 13) * SKV + CTXL + t; }
      else orow = (size_t)((row - MX) >> 8) * SKV + ((row - MX) & 255);
      if (lane < 32) { KR[orow * 64 + j] = f2bf(o1); KR[orow * 64 + 32 + j] = f2bf(o2); }
    }
  }
}

namespace att {
constexpr int NW = 8, QBLK = 32, KVBLK = 64, LDQ = 768, LDK = 1024, LDKR = 64, LDO = 1024;
constexpr float SCALE = A_SCALE;
constexpr float THR = 8.f;
constexpr size_t SHM_V = KVBLK * 128 * 2, SHM_K = KVBLK * 128 * 2, SHM_R = KVBLK * 64 * 2;
typedef float f32x8 __attribute__((ext_vector_type(8)));
#define KSWZ(row, colB) ((row) * 256 + ((colB) ^ (((row) & 7) << 4)))
#define RSWZ(row, colB) ((row) * 128 + ((colB) ^ (((row) & 7) << 4)))
#define SBAR() __builtin_amdgcn_sched_barrier(0)
__device__ __forceinline__ int crow(int r, int hi) { return (r & 3) + 8 * (r >> 2) + 4 * hi; }
__device__ __forceinline__ void partialSM(f32x16& p0, f32x16& p1, float& m_reg, float& mn, float& alpha) {
  constexpr float C = SCALE * 1.4426950408889634f;
  float pmax = p0[0];
#pragma unroll
  for (int r = 1; r < 16; ++r) pmax = fmaxf(pmax, p0[r]);
#pragma unroll
  for (int r = 0; r < 16; ++r) pmax = fmaxf(pmax, p1[r]);
  { auto rr = __builtin_amdgcn_permlane32_swap(__float_as_uint(pmax), __float_as_uint(pmax), false, false);
    pmax = fmaxf(__uint_as_float(rr[0]), __uint_as_float(rr[1])); }
  if (__builtin_expect(__all(pmax - m_reg <= THR / SCALE), 1)) { mn = m_reg; alpha = 1.f; }
  else { mn = fmaxf(m_reg, pmax); alpha = __builtin_amdgcn_exp2f((m_reg - mn) * C); m_reg = mn; }
  const float mnC = -mn * C;
#pragma unroll
  for (int r = 0; r < 16; ++r) p0[r] = fmaf(p0[r], C, mnC);
#pragma unroll
  for (int r = 0; r < 16; ++r) p1[r] = fmaf(p1[r], C, mnC);
#pragma unroll
  for (int r = 0; r < 16; ++r) p0[r] = __builtin_amdgcn_exp2f(p0[r]);
}
__device__ __forceinline__ void finishSM(f32x16& p0, f32x16& p1, float alpha, float& l_reg, bf16x8& pa0, bf16x8& pa1, bf16x8& pa2, bf16x8& pa3) {
#pragma unroll
  for (int r = 0; r < 16; ++r) p1[r] = __builtin_amdgcn_exp2f(p1[r]);
  float ps = 0;
#pragma unroll
  for (int r = 0; r < 16; ++r) ps += p0[r];
#pragma unroll
  for (int r = 0; r < 16; ++r) ps += p1[r];
  { auto rr = __builtin_amdgcn_permlane32_swap(__float_as_uint(ps), __float_as_uint(ps), false, false);
    ps = __uint_as_float(rr[0]) + __uint_as_float(rr[1]); }
  l_reg = l_reg * alpha + ps;
#define PK4(P, BASE, OUT) do { unsigned a0 = cvtpk(P[BASE + 0], P[BASE + 1]), a1 = cvtpk(P[BASE + 2], P[BASE + 3]);   \
    unsigned b0 = cvtpk(P[BASE + 4], P[BASE + 5]), b1 = cvtpk(P[BASE + 6], P[BASE + 7]);                              \
    auto r0 = __builtin_amdgcn_permlane32_swap(a0, b0, false, false); auto r1 = __builtin_amdgcn_permlane32_swap(a1, b1, false, false); \
    u32x4 w = {r0[0], r1[0], r0[1], r1[1]}; OUT = *reinterpret_cast<bf16x8*>(&w); } while (0)
  PK4(p0, 0, pa0); PK4(p0, 8, pa1); PK4(p1, 0, pa2); PK4(p1, 8, pa3);
#undef PK4
}
__device__ __forceinline__ void qkt(f32x16& p0, f32x16& p1, const char* Ks, const char* Rs, const bf16x8* qr, const char* qrl, int r32, int hi) {
  p0 = f32x16{}; p1 = f32x16{};
#pragma unroll
  for (int d0 = 0; d0 < 8; ++d0) { const int cb = (d0 * 16 + hi * 8) * 2;
    const bf16x8 b0 = *reinterpret_cast<const bf16x8*>(Ks + KSWZ(r32, cb));
    const bf16x8 b1 = *reinterpret_cast<const bf16x8*>(Ks + KSWZ(32 + r32, cb));
    p0 = __builtin_amdgcn_mfma_f32_32x32x16_bf16(b0, qr[d0], p0, 0, 0, 0);
    p1 = __builtin_amdgcn_mfma_f32_32x32x16_bf16(b1, qr[d0], p1, 0, 0, 0); }
#pragma unroll
  for (int d0 = 0; d0 < 4; ++d0) { const int cb = (d0 * 16 + hi * 8) * 2;
    const bf16x8 b0 = *reinterpret_cast<const bf16x8*>(Rs + RSWZ(r32, cb));
    const bf16x8 b1 = *reinterpret_cast<const bf16x8*>(Rs + RSWZ(32 + r32, cb));
    const bf16x8 qv = *reinterpret_cast<const bf16x8*>(qrl + d0 * 1024);
    p0 = __builtin_amdgcn_mfma_f32_32x32x16_bf16(b0, qv, p0, 0, 0, 0);
    p1 = __builtin_amdgcn_mfma_f32_32x32x16_bf16(b1, qv, p1, 0, 0, 0); }
}
__device__ __forceinline__ int v_st(int k, int c) { const int kk = (k & ~0xC) | ((k & 4) << 1) | ((k & 8) >> 1); return ((kk >> 3) * 4 + (c >> 5)) * 512 + ((kk & 7) * 32 + (c & 31)) * 2; }
__device__ __forceinline__ int v_rd_base(int lane) { return ((lane & 3) << 3) | (((lane >> 2) & 3) << 6) | (((lane >> 4) & 1) << 5) | (((lane >> 5) & 1) << 8); }
constexpr int v_rd_off(int d0, int ks, int half) { return d0 * 512 + ks * 4096 + half * 2048; }
template <int OFF> __device__ __forceinline__ s16x4 tr_read(int vb) {
  s16x4 r; asm volatile("ds_read_b64_tr_b16 %0, %1 offset:%2" : "=&v"(r) : "v"(vb), "i"(OFF) : "memory"); return r;
}
template <int D0> __device__ __forceinline__ void pv_one(f32x16& od, int vb, bf16x8 pa0, bf16x8 pa1, bf16x8 pa2, bf16x8 pa3) {
  const s16x4 l0 = tr_read<v_rd_off(D0, 0, 0)>(vb), h0 = tr_read<v_rd_off(D0, 0, 1)>(vb), l1 = tr_read<v_rd_off(D0, 1, 0)>(vb), h1 = tr_read<v_rd_off(D0, 1, 1)>(vb);
  const s16x4 l2 = tr_read<v_rd_off(D0, 2, 0)>(vb), h2 = tr_read<v_rd_off(D0, 2, 1)>(vb), l3 = tr_read<v_rd_off(D0, 3, 0)>(vb), h3 = tr_read<v_rd_off(D0, 3, 1)>(vb);
  asm volatile("s_waitcnt lgkmcnt(0)" ::: "memory"); SBAR();
#define PK(L, H) (bf16x8){L[0], L[1], L[2], L[3], H[0], H[1], H[2], H[3]}
  od = __builtin_amdgcn_mfma_f32_32x32x16_bf16(pa0, PK(l0, h0), od, 0, 0, 0);
  od = __builtin_amdgcn_mfma_f32_32x32x16_bf16(pa1, PK(l1, h1), od, 0, 0, 0);
  od = __builtin_amdgcn_mfma_f32_32x32x16_bf16(pa2, PK(l2, h2), od, 0, 0, 0);
  od = __builtin_amdgcn_mfma_f32_32x32x16_bf16(pa3, PK(l3, h3), od, 0, 0, 0);
#undef PK
}
__device__ __forceinline__ void pv_d0(f32x16* o, int vb, bf16x8 pa0, bf16x8 pa1, bf16x8 pa2, bf16x8 pa3) {
  pv_one<0>(o[0], vb, pa0, pa1, pa2, pa3); pv_one<1>(o[1], vb, pa0, pa1, pa2, pa3); pv_one<2>(o[2], vb, pa0, pa1, pa2, pa3); pv_one<3>(o[3], vb, pa0, pa1, pa2, pa3);
}
__device__ __forceinline__ void attn_body(const bf16_t* __restrict__ Qb, const float* __restrict__ cs, const float* __restrict__ sn, const bf16_t* __restrict__ Kn,
                                          const bf16_t* __restrict__ Vh, const bf16_t* __restrict__ Kr, bf16_t* __restrict__ Ob, int seq, char* lds) {
  const int tid = otid(), wid = tid >> 6, lane = tid & 63, r32 = lane & 31, hi = lane >> 5;
  char* V_lds = lds; char* K_lds = lds + 2 * SHM_V; char* R_lds = lds + 2 * SHM_V + 2 * SHM_K;
  float* wsf = (float*)(lds + 2 * SHM_V + 2 * SHM_K + 2 * SHM_R) + wid * 64; float* li_l = wsf; float* al_l = wsf + 32;
  char* qrl = lds + 2 * SHM_V + 2 * SHM_K + 2 * SHM_R + 2048 + wid * 4096 + lane * 16;
  float m_reg = -1e30f, l_reg = 0; f32x16 o[4] = {}; bf16x8 qr[8];
  { const bf16_t* Qw = Qb + (size_t)(wid * QBLK + r32) * LDQ + hi * 8;
#pragma unroll
    for (int d0 = 0; d0 < 8; ++d0) qr[d0] = *(const bf16x8*)(Qw + d0 * 16);
#pragma unroll
    for (int d0 = 0; d0 < 2; ++d0) {
      const u32x4 a = *(const u32x4*)(Qw + 128 + d0 * 16), bq = *(const u32x4*)(Qw + 160 + d0 * 16);
      if (cs) {
        const float* cp = cs + (size_t)(wid * QBLK + r32) * 32 + d0 * 16 + hi * 8; const float* sp = sn + (size_t)(wid * QBLK + r32) * 32 + d0 * 16 + hi * 8;
        const f32x4 c0 = *(const f32x4*)cp, c1 = *(const f32x4*)(cp + 4), s0 = *(const f32x4*)sp, s1 = *(const f32x4*)(sp + 4);
        float x1[8], x2[8], y1[8], y2[8];
#pragma unroll
        for (int k = 0; k < 4; ++k) { x1[2 * k] = bflo(a[k]); x1[2 * k + 1] = bfhi(a[k]); x2[2 * k] = bflo(bq[k]); x2[2 * k + 1] = bfhi(bq[k]); }
#pragma unroll
        for (int k = 0; k < 8; ++k) { const float c = k < 4 ? c0[k & 3] : c1[k & 3], s = k < 4 ? s0[k & 3] : s1[k & 3]; y1[k] = x1[k] * c - x2[k] * s; y2[k] = x2[k] * c + x1[k] * s; }
        u32x4 w1 = {cvtpk(y1[0], y1[1]), cvtpk(y1[2], y1[3]), cvtpk(y1[4], y1[5]), cvtpk(y1[6], y1[7])}, w2 = {cvtpk(y2[0], y2[1]), cvtpk(y2[2], y2[3]), cvtpk(y2[4], y2[5]), cvtpk(y2[6], y2[7])};
        *(u32x4*)(qrl + d0 * 1024) = w1; *(u32x4*)(qrl + (2 + d0) * 1024) = w2;
      } else { *(u32x4*)(qrl + d0 * 1024) = a; *(u32x4*)(qrl + (2 + d0) * 1024) = bq; }
    } }
  const int sr = tid >> 4, sc = (tid & 15) * 8, vst0 = v_st(sr, sc), vst1 = v_st(32 + sr, sc);
  const int rr_ = tid >> 3, rc = (tid & 7) * 8;
  const int vb0 = (int)(uintptr_t)V_lds + v_rd_base(lane);
  bf16x8 vs0, vs1, ks0, ks1, rs0;
  const unsigned voffKV = (unsigned)(sr * LDK + sc) * 2u, voffR = (unsigned)(rr_ * LDKR + rc) * 2u;
#define SLOAD(k0) do { const char* kb_ = (const char*)Kn + (size_t)(k0) * (LDK * 2); const char* vb_ = (const char*)Vh + (size_t)(k0) * (LDK * 2); \
    vs0 = *(const bf16x8*)(vb_ + voffKV); vs1 = *(const bf16x8*)(vb_ + 32 * LDK * 2 + voffKV); \
    ks0 = *(const bf16x8*)(kb_ + voffKV); ks1 = *(const bf16x8*)(kb_ + 32 * LDK * 2 + voffKV); \
    rs0 = *(const bf16x8*)((const char*)Kr + (size_t)(k0) * (LDKR * 2) + voffR); } while (0)
#define SWRITE(b) do { *(bf16x8*)(V_lds + (b) * SHM_V + vst0) = vs0; *(bf16x8*)(V_lds + (b) * SHM_V + vst1) = vs1; const int kc = sc * 2;  \
    *(bf16x8*)(K_lds + (b) * SHM_K + KSWZ(sr, kc)) = ks0; *(bf16x8*)(K_lds + (b) * SHM_K + KSWZ(32 + sr, kc)) = ks1;                      \
    *(bf16x8*)(R_lds + (b) * SHM_R + RSWZ(rr_, rc * 2)) = rs0; } while (0)
#define RESC(a) do { if (__any((a) < 1.f)) { if (hi == 0) al_l[r32] = (a); asm volatile("s_waitcnt lgkmcnt(0)" ::: "memory"); \
    _Pragma("unroll") for (int d = 0; d < 4; ++d) _Pragma("unroll") for (int r = 0; r < 16; ++r) o[d][r] *= al_l[crow(r, hi)]; } } while (0)
  f32x16 pA0, pA1, pB0, pB1; float mnA, mnB, alA, alB; bf16x8 pa0, pa1, pa2, pa3; const int NT = seq / KVBLK;
  SLOAD(0); SWRITE(0); __syncthreads();
  qkt(pA0, pA1, K_lds, R_lds, qr, qrl, r32, hi); partialSM(pA0, pA1, m_reg, mnA, alA);
  SLOAD(KVBLK); SWRITE(1); __syncthreads();
  for (int j = 1; j + 1 < NT; j += 2) {
    SBAR(); qkt(pB0, pB1, K_lds + SHM_K, R_lds + SHM_R, qr, qrl, r32, hi);
    finishSM(pA0, pA1, alA, l_reg, pa0, pa1, pa2, pa3); SBAR();
    SLOAD((j + 1) * KVBLK); SBAR();
    pv_d0(o, vb0, pa0, pa1, pa2, pa3); partialSM(pB0, pB1, m_reg, mnB, alB);
    __syncthreads(); SWRITE(0);
    RESC(alB); __syncthreads();
    SBAR(); qkt(pA0, pA1, K_lds, R_lds, qr, qrl, r32, hi);
    finishSM(pB0, pB1, alB, l_reg, pa0, pa1, pa2, pa3); SBAR();
    SLOAD((j + 2) * KVBLK); SBAR();
    pv_d0(o, vb0 + (int)SHM_V, pa0, pa1, pa2, pa3); partialSM(pA0, pA1, m_reg, mnA, alA);
    __syncthreads(); SWRITE(1);
    RESC(alA); __syncthreads();
  }
  SBAR(); qkt(pB0, pB1, K_lds + SHM_K, R_lds + SHM_R, qr, qrl, r32, hi);
  finishSM(pA0, pA1, alA, l_reg, pa0, pa1, pa2, pa3); SBAR();
  pv_d0(o, vb0, pa0, pa1, pa2, pa3); partialSM(pB0, pB1, m_reg, mnB, alB);
  __syncthreads(); RESC(alB);
  finishSM(pB0, pB1, alB, l_reg, pa0, pa1, pa2, pa3); SBAR();
  pv_d0(o, vb0 + (int)SHM_V, pa0, pa1, pa2, pa3);
  if (hi == 0) li_l[r32] = l_reg; asm volatile("s_waitcnt lgkmcnt(0)" ::: "memory");
  float rli[16];
#pragma unroll
  for (int r = 0; r < 16; ++r) rli[r] = __builtin_amdgcn_rcpf(li_l[crow(r, hi)]);
  bf16_t* Ow = Ob + (size_t)(wid * QBLK) * LDO;
#pragma unroll
  for (int r = 0; r < 16; ++r) { const int orow = crow(r, hi);
#pragma unroll
    for (int d0 = 0; d0 < 4; ++d0) Ow[(size_t)orow * LDO + d0 * 32 + r32] = f2bf(o[d0][r] * rli[r]); }
  __syncthreads();
#undef SLOAD
#undef SWRITE
#undef RESC
}
}

__device__ void phase_attn(PRef p, int l, char* smem) {
  const bf16_t* Q = (const bf16_t*)(p.ws + WS_Q); const bf16_t* KV = (const bf16_t*)(p.ws + WS_KV); const bf16_t* KR = (const bf16_t*)(p.ws + WS_KR);
  bf16_t* mix = (bf16_t*)(p.ws + WS_MIX); const float* cs = (const float*)(p.ws + WS_COS); const float* sn = (const float*)(p.ws + WS_SIN);
  const int nunits = 1024 + (l == 0 ? 32 : 0);
  for (int u = obid(); u < nunits; u += gridDim.x) {
    if (u < 1024) {
      const int bh = (u >> 8) * 8 + (u & 7), qb = (u & 255) >> 3, hd = bh & 3, b = bh >> 2; const size_t row0 = (size_t)b * SEQ + qb * 256;
      att::attn_body(Q + row0 * 768 + hd * 192, cs + (size_t)qb * 256 * 32, sn + (size_t)qb * 256 * 32, KV + (size_t)b * SKV * 1024 + hd * 256,
                     KV + (size_t)b * SKV * 1024 + hd * 256 + 128, KR + (size_t)b * SKV * 64, mix + row0 * 1024 + 512 + hd * 128, SKV, smem);
    } else {
      const int v = u - 1024, hd = v & 3, b = v >> 2; const size_t row0 = (size_t)MX + b * CTXL;
      att::attn_body(Q + row0 * 768 + hd * 192, nullptr, nullptr, KV + (size_t)b * SKV * 1024 + hd * 256,
                     KV + (size_t)b * SKV * 1024 + hd * 256 + 128, KR + (size_t)b * SKV * 64, mix + row0 * 1024 + 512 + hd * 128, CTXL, smem);
    }
  }
}

__device__ void phase_outproj(PRef p, int l, char* smem) {
  LAS unsigned char* lds = (LAS unsigned char*)smem;
  const bf16_t* mix = (const bf16_t*)(p.ws + WS_MIX); const bf16_t* Wt = (const bf16_t*)(p.ws + WS_WOUT) + (size_t)l * 1024 * 1024;
  float* ctxz = (float*)(p.ws + WS_CTXZ);
  const int tid = otid(), wid = tid >> 6, lane = tid & 63, wr = wid >> 2, wc = wid & 3, fr = lane & 15, fq = lane >> 4;
  g8::TileIter it; it.init(l == 0 ? MT / 256 : MX / 256, 4);
  int pm, pn;
  while (it.next(pm, pn)) {
    unsigned voffA[2] = {g8::piece_off(0, 1024, 0), g8::piece_off(1, 1024, 0)};
    f32x4 acc[2][2][4][2];
    g8::gemm_tile<false>(lds, (const char*)(mix + (size_t)pm * 256 * 1024), voffA, (size_t)128 * 1024 * 2, (const char*)(Wt + (size_t)pn * 256 * 1024), 1024, acc);
    ACC_FOR(ai, bj, m, n) {
      const int row = pm * 256 + ai * 128 + wr * 64 + m * 16 + fr, col = pn * 256 + bj * 128 + wc * 32 + fq * 8 + n * 4;
      const float* res = l == 0 ? (row < MX ? p.x + (size_t)row * 1024 : p.ctx + (size_t)(row - MX) * 1024) : p.out + (size_t)row * 1024;
      float* dst = row < MX ? p.out + (size_t)row * 1024 : ctxz + (size_t)(row - MX) * 1024;
      const f32x4 r = *(const f32x4*)(res + col), g = *(const f32x4*)(mod_ptr(p, l, row, 2) + col);
      *(f32x4*)(dst + col) = r * ALPHA + g * acc[ai][bj][m][n];
    }
  }
}

__device__ void phase_ln1(PRef p, int l, char* smem) {
  float* wrt = (float*)smem;
  for (int i = otid(); i < 16384; i += 512) wrt[(i & 15) * 1024 + (i >> 4)] = p.w_router[(size_t)l * 16384 + i];
  __syncthreads();
  const int lane = otid() & 63, gw = obid() * 8 + (otid() >> 6), nw = gridDim.x * 8;
  bf16_t* h = (bf16_t*)(p.ws + WS_H); float* ctxz = (float*)(p.ws + WS_CTXZ); float* aff = (float*)(p.ws + WS_AFF);
  const int nrows = l == 0 ? MT : MX;
  for (int row = gw; row < nrows; row += nw) {
    asm volatile("" ::: "memory");
    float* zr = row < MX ? p.out + (size_t)row * 1024 : ctxz + (size_t)(row - MX) * 1024;
    f32x4 v[4];
#pragma unroll
    for (int i = 0; i < 4; ++i) v[i] = *(const f32x4*)(zr + lane * 4 + 256 * i);
    ln_row(v, 1e-5f);
#pragma unroll
    for (int i = 0; i < 4; ++i) { const int c = lane * 4 + 256 * i; v[i] = v[i] * *(const f32x4*)(p.ln1_g + l * 1024 + c) + *(const f32x4*)(p.ln1_b + l * 1024 + c); *(f32x4*)(zr + c) = v[i]; }
    ln_row(v, 1e-6f);
    f32x4 hm[4];
    store_mod_bf16(v, mod_ptr(p, l, row, 3), mod_ptr(p, l, row, 4), h + (size_t)row * 1024, lane, &hm);
    float lg[16];
#pragma unroll
    for (int e = 0; e < 16; ++e) { float s = 0.f;
#pragma unroll
      for (int i = 0; i < 4; ++i) { const f32x4 w = *(const f32x4*)(wrt + e * 1024 + lane * 4 + 256 * i); s += hm[i][0] * w[0] + hm[i][1] * w[1] + hm[i][2] * w[2] + hm[i][3] * w[3]; }
      lg[e] = wave_sum(s); }
    float mx = lg[0];
#pragma unroll
    for (int e = 1; e < 16; ++e) mx = fmaxf(mx, lg[e]);
    float den = 0.f;
#pragma unroll
    for (int e = 0; e < 16; ++e) { lg[e] = expf(lg[e] - mx); den += lg[e]; }
    float mine = 0.f;
#pragma unroll
    for (int e = 0; e < 16; ++e) if (lane == e) mine = lg[e] / den;
    if (lane < 16) aff[(size_t)row * 16 + lane] = mine;
  }
}

template <int PER>
__device__ __forceinline__ void topk_item(const float* __restrict__ affp, int n, int kcap, int rowbase, int slotbase, int e, int* __restrict__ IDX, float* __restrict__ GV, int* __restrict__ TS, char* smem) {
  unsigned* hist = (unsigned*)smem; unsigned* sel = hist + 256; unsigned* wtot = hist + 272;
  const int tid = otid(), lane = tid & 63, wid = tid >> 6;
  const bool active = tid * PER < n;
  unsigned key[PER];
#pragma unroll
  for (int i = 0; i < PER; ++i) key[i] = active ? __float_as_uint(affp[(size_t)(tid * PER + i) * 16]) : 0u;
  unsigned prefix = 0u, mask = 0u; int kk = kcap;
#pragma unroll 1
  for (int shift = 24; shift >= 0; shift -= 8) {
    __syncthreads();
    if (tid < 256) hist[tid] = 0u;
    __syncthreads();
#pragma unroll
    for (int i = 0; i < PER; ++i) if (active && (key[i] & mask) == prefix) atomicAdd(&hist[(key[i] >> shift) & 255u], 1u);
    __syncthreads();
    if (wid == 0) {
      const unsigned h0 = hist[lane * 4], h1 = hist[lane * 4 + 1], h2 = hist[lane * 4 + 2], h3 = hist[lane * 4 + 3];
      const unsigned tot = h0 + h1 + h2 + h3; unsigned suf = tot;
#pragma unroll
      for (int o = 1; o < 64; o <<= 1) { const unsigned u = __shfl_down(suf, o); if (lane + o < 64) suf += u; }
      const unsigned above = suf - tot;
      if (above < (unsigned)kk && suf >= (unsigned)kk) {
        unsigned a = above; int bin;
        if (a + h3 >= (unsigned)kk) bin = 3; else { a += h3; if (a + h2 >= (unsigned)kk) bin = 2; else { a += h2; if (a + h1 >= (unsigned)kk) bin = 1; else { a += h1; bin = 0; } } }
        sel[0] = prefix | ((unsigned)(lane * 4 + bin) << shift); sel[1] = (unsigned)kk - a;
      }
    }
    __syncthreads();
    prefix = sel[0]; kk = (int)sel[1]; mask |= 0xffu << shift;
  }
  const unsigned Tk = prefix;
  unsigned cg_ = 0, ce = 0;
#pragma unroll
  for (int i = 0; i < PER; ++i) { cg_ += key[i] > Tk; ce += key[i] == Tk; }
  unsigned pk = active ? (cg_ | (ce << 16)) : 0u, inc = pk;
#pragma unroll
  for (int o = 1; o < 64; o <<= 1) { const unsigned u = __shfl_up(inc, o); if (lane >= o) inc += u; }
  __syncthreads();
  if (lane == 63) wtot[wid] = inc;
  __syncthreads();
  unsigned base = 0;
  for (int w2 = 0; w2 < wid; ++w2) base += wtot[w2];
  const unsigned exc = base + inc - pk; unsigned gt_before = exc & 0xffffu, eq_before = exc >> 16;
  if (active) {
#pragma unroll
    for (int i = 0; i < PER; ++i) {
      const int t = tid * PER + i; int R = -1;
      const bool isgt = key[i] > Tk, iseq = key[i] == Tk;
      if (isgt || (iseq && (int)eq_before < kk)) {
        const int slot = (int)gt_before + min((int)eq_before, kk);
        R = slotbase + slot; IDX[R] = rowbase + t; GV[R] = __uint_as_float(key[i]);
      }
      TS[t] = R;
      gt_before += isgt; eq_before += iseq;
    }
  }
}
__device__ void phase_topk(PRef p, int l, char* smem) {
  const float* aff = (const float*)(p.ws + WS_AFF); int* IDX = (int*)(p.ws + WS_IDX); float* GV = (float*)(p.ws + WS_GV); int* TS = (int*)(p.ws + WS_TS);
  const int nitems = l == 0 ? 256 : 128;
  for (int it = obid(); it < nitems; it += gridDim.x) {
    if (it < 128) { const int b = it >> 4, e = it & 15; topk_item<16>(aff + (size_t)b * SEQ * 16 + e, SEQ, CAPX, b * SEQ, it * CAPX, e, IDX, GV, TS + (size_t)it * SEQ, smem); }
    else { const int v = it - 128, b = v >> 4, e = v & 15; topk_item<1>(aff + ((size_t)MX + b * CTXL) * 16 + e, CTXL, CAPC, MX + b * CTXL, NB * NE * CAPX + e * 256 + b * CAPC, e, IDX, GV, TS + (size_t)NB * 16 * SEQ + (size_t)v * CTXL, smem); }
  }
  __syncthreads();
}

__device__ void phase_moe_up(PRef p, int l, char* smem) {
  LAS unsigned char* lds = (LAS unsigned char*)smem;
  const bf16_t* h = (const bf16_t*)(p.ws + WS_H); const bf16_t* Wgu = (const bf16_t*)(p.ws + WS_WGU); bf16_t* act = (bf16_t*)(p.ws + WS_ACT); const int* IDX = (const int*)(p.ws + WS_IDX);
  const int tid = otid(), wid = tid >> 6, lane = tid & 63, wr = wid >> 2, wc = wid & 3, fr = lane & 15, fq = lane >> 4;
  g8::MoeIter it; it.init(8, l == 0);
  int pm, pn, e;
  while (it.next(pm, pn, e)) {
    unsigned voffA[4];
#pragma unroll
    for (int hh = 0; hh < 2; ++hh)
#pragma unroll
      for (int i = 0; i < 2; ++i) { int R, C; g8::piece_rc(i, R, C); voffA[hh * 2 + i] = (unsigned)(IDX[pm * 256 + hh * 128 + R] * 1024 + C) * 2u; }
    f32x4 acc[2][2][4][2];
    g8::gemm_tile<true>(lds, (const char*)h, voffA, 0, (const char*)(Wgu + ((size_t)e * 2048 + pn * 256) * 1024), 1024, acc);
#pragma unroll
    for (int ai = 0; ai < 2; ++ai)
#pragma unroll
      for (int m = 0; m < 4; ++m) {
          const int row = pm * 256 + ai * 128 + wr * 64 + m * 16 + fr, col = pn * 128 + wc * 32 + fq * 8;
          float a[8];
#pragma unroll
          for (int n = 0; n < 2; ++n) { const f32x4 g = acc[ai][0][m][n], u = acc[ai][1][m][n];
#pragma unroll
            for (int k = 0; k < 4; ++k) a[n * 4 + k] = silu_f(g[k]) * u[k]; }
          u32x4 w = {cvtpk(a[0], a[1]), cvtpk(a[2], a[3]), cvtpk(a[4], a[5]), cvtpk(a[6], a[7])}; *(u32x4*)(act + (size_t)row * 1024 + col) = w;
        }
  }
}
__device__ void phase_moe_down(PRef p, int l, char* smem) {
  LAS unsigned char* lds = (LAS unsigned char*)smem;
  const bf16_t* act = (const bf16_t*)(p.ws + WS_ACT); const bf16_t* Wdn = (const bf16_t*)(p.ws + WS_WDN); bf16_t* oute = (bf16_t*)(p.ws + WS_OUTE); const float* GV = (const float*)(p.ws + WS_GV);
  const int tid = otid(), wid = tid >> 6, lane = tid & 63, wr = wid >> 2, wc = wid & 3, fr = lane & 15, fq = lane >> 4;
  g8::MoeIter it; it.init(4, l == 0);
  int pm, pn, e;
  while (it.next(pm, pn, e)) {
    unsigned voffA[2] = {g8::piece_off(0, 1024, 0), g8::piece_off(1, 1024, 0)};
    f32x4 acc[2][2][4][2];
    g8::gemm_tile<false>(lds, (const char*)(act + (size_t)pm * 256 * 1024), voffA, (size_t)128 * 1024 * 2, (const char*)(Wdn + ((size_t)e * 1024 + pn * 256) * 1024), 1024, acc);
    ACC_FOR3(ai, bj, m) {
      const int row = pm * 256 + ai * 128 + wr * 64 + m * 16 + fr, col = pn * 256 + bj * 128 + wc * 32 + fq * 8;
      const float gv = GV[row]; const f32x4 v0 = acc[ai][bj][m][0] * gv, v1 = acc[ai][bj][m][1] * gv;
      u32x4 w = {cvtpk(v0[0], v0[1]), cvtpk(v0[2], v0[3]), cvtpk(v1[0], v1[1]), cvtpk(v1[2], v1[3])}; *(u32x4*)(oute + (size_t)row * 1024 + col) = w;
    }
  }
}

__device__ void phase_ln2(PRef p, int l) {
  const int lane = otid() & 63, gw = obid() * 8 + (otid() >> 6), nw = gridDim.x * 8;
  bf16_t* h = (bf16_t*)(p.ws + WS_H); float* ctxz = (float*)(p.ws + WS_CTXZ); const bf16_t* oute = (const bf16_t*)(p.ws + WS_OUTE); const int* TS = (const int*)(p.ws + WS_TS);
  const int nrows = l == 0 ? MT : MX;
  for (int row = gw; row < nrows; row += nw) {
    float* xr = row < MX ? p.out + (size_t)row * 1024 : ctxz + (size_t)(row - MX) * 1024;
    f32x4 mo[4];
#pragma unroll
    for (int i = 0; i < 4; ++i) mo[i] = (f32x4){0.f, 0.f, 0.f, 0.f};
    const int myR = lane < 16 ? (row < MX ? TS[((size_t)(row >> 13) * 16 + lane) * SEQ + (row & 8191)] : TS[(size_t)NB * 16 * SEQ + ((size_t)((row - MX) >> 8) * 16 + lane) * CTXL + ((row - MX) & 255)]) : -1;
    for (int e = 0; e < 16; ++e) { const int Rr = __shfl(myR, e);
      if (Rr >= 0) {
#pragma unroll
        for (int i = 0; i < 4; ++i) { const u32x2 w = *(const u32x2*)(oute + (size_t)Rr * 1024 + lane * 4 + 256 * i);
          mo[i][0] += bflo(w[0]); mo[i][1] += bfhi(w[0]); mo[i][2] += bflo(w[1]); mo[i][3] += bfhi(w[1]); } } }
    f32x4 v[4]; const float* m5 = mod_ptr(p, l, row, 5);
#pragma unroll
    for (int i = 0; i < 4; ++i) { const int c = lane * 4 + 256 * i; v[i] = *(const f32x4*)(xr + c) * ALPHA + *(const f32x4*)(m5 + c) * mo[i]; }
    ln_row(v, 1e-5f);
#pragma unroll
    for (int i = 0; i < 4; ++i) { const int c = lane * 4 + 256 * i; v[i] = v[i] * *(const f32x4*)(p.ln2_g + l * 1024 + c) + *(const f32x4*)(p.ln2_b + l * 1024 + c); *(f32x4*)(xr + c) = v[i]; }
    if (l + 1 < DEPTH) { ln_row(v, 1e-6f); store_mod_bf16(v, mod_ptr(p, l + 1, row, 0), mod_ptr(p, l + 1, row, 1), h + (size_t)row * 1024, lane, nullptr); }
  }
}

__device__ __forceinline__ void gsync(cg::grid_group& grid) {
  asm volatile("s_waitcnt vmcnt(0) lgkmcnt(0)" ::: "memory");
  grid.sync();
}
__global__ void __launch_bounds__(512) mega(Params p) {
  extern __shared__ __attribute__((aligned(16))) char smem[];
  cg::grid_group grid = cg::this_grid();
  phase_prep(kparams(), smem);
  gsync(grid);
  phase_h0(kparams());
  gsync(grid);
#pragma unroll 1
  for (int l = 0; l < DEPTH; ++l) {
    phase_inproj(kparams(), l, smem);
    gsync(grid);
    phase_mlstm(kparams(), l, smem);
    gsync(grid);
    phase_mla_prep(kparams(), l, smem);
    gsync(grid);
    phase_attn(kparams(), l, smem);
    gsync(grid);
    phase_outproj(kparams(), l, smem);
    gsync(grid);
    phase_ln1(kparams(), l, smem);
    __syncthreads();
    phase_cvt_experts(kparams(), l, smem);
    gsync(grid);
    phase_topk(kparams(), l, smem);
    gsync(grid);
    phase_moe_up(kparams(), l, smem);
    gsync(grid);
    phase_moe_down(kparams(), l, smem);
    gsync(grid);
    phase_ln2(kparams(), l);
    gsync(grid);
  }
}

extern "C" void kernel_launch(void* const* d_in, const int* in_sizes, int n_in, void* d_out, int out_size,
                              void* d_ws, size_t ws_size, hipStream_t stream) {
  constexpr size_t kDynLds = 160 * 1024;
  static int grid_blocks = 0;
  if (!grid_blocks) {
    int dev = 0, cus = 0, per_cu = 0;
    (void)hipGetDevice(&dev);
    (void)hipDeviceGetAttribute(&cus, hipDeviceAttributeMultiprocessorCount, dev);
    (void)hipFuncSetAttribute((const void*)mega, hipFuncAttributeMaxDynamicSharedMemorySize, (int)kDynLds);
    (void)hipOccupancyMaxActiveBlocksPerMultiprocessor(&per_cu, mega, 512, kDynLds);
    grid_blocks = per_cu > 0 ? cus : 0;
    if (grid_blocks > 256) grid_blocks = 256;
    grid_blocks &= ~7;
    if (grid_blocks != 256) { fprintf(stderr, "this kernel needs 256 co-resident workgroups (got %d)\n", grid_blocks); grid_blocks = 0; }
    if (ws_size < WS_END) { fprintf(stderr, "workspace too small: %zu < %zu\n", ws_size, (size_t)WS_END); grid_blocks = 0; }
  }
  if (grid_blocks <= 0) return;
  Params p{};
  const float** pp = (const float**)&p;
  for (int i = 0; i < 24; ++i) pp[i] = (const float*)d_in[i];
  p.out = (float*)d_out; p.ws = (char*)d_ws;
  void* args[] = {&p};
  hipError_t e = hipLaunchCooperativeKernel((void*)mega, dim3(grid_blocks), dim3(512), args, kDynLds, stream);
  if (e != hipSuccess) fprintf(stderr, "cooperative launch failed: %s (grid %d)\n", hipGetErrorString(e), grid_blocks);
}
```

```cpp
#include <hip/hip_runtime.h>
#include <hip/hip_cooperative_groups.h>
#include <cstdio>
#include <cstdint>
namespace cg = cooperative_groups;

typedef unsigned short bf16_t;
typedef short bf16x8 __attribute__((ext_vector_type(8)));
typedef short s16x4 __attribute__((ext_vector_type(4)));
typedef float f32x4 __attribute__((ext_vector_type(4)));
typedef float f32x16 __attribute__((ext_vector_type(16)));
typedef unsigned u32x4 __attribute__((ext_vector_type(4)));
typedef unsigned u32x2 __attribute__((ext_vector_type(2)));
#define LAS __attribute__((address_space(3)))

constexpr int DM = 1024, NB = 8, SEQ = 8192, CTXL = 256, DEPTH = 2;
constexpr int MX = NB * SEQ, MC = NB * CTXL, MT = MX + MC;
constexpr int PLD = 2816;
constexpr int OFF_Q = 0, OFF_K = 512, OFF_V = 1024, OFF_O = 1536, OFF_G = 2048, OFF_CQ = 2064, OFF_CKV = 2448, OFF_KR = 2704, IN_COLS = 2768;
constexpr int SKV = SEQ + CTXL;
constexpr int NE = 16, CAPX = 1024, CAPC = 32;
constexpr int NSLOT = NB * NE * CAPX + NB * NE * CAPC;
constexpr float ALPHA = 1.4142135623730951f;
constexpr float A_SCALE = 0.07216878364870322f;

constexpr size_t al256(size_t v) { return (v + 255) / 256 * 256; }
constexpr size_t WS_H = 0;
constexpr size_t WS_P = WS_H + al256((size_t)MT * 1024 * 2);
constexpr size_t WS_Q = WS_P + al256((size_t)MT * PLD * 2);
constexpr size_t WS_KV = WS_Q + al256((size_t)MT * 768 * 2);
constexpr size_t WS_KR = WS_KV + al256((size_t)NB * SKV * 1024 * 2);
constexpr size_t WS_MIX = WS_KR + al256((size_t)NB * SKV * 64 * 2);
constexpr size_t WS_ACT = WS_P;
constexpr size_t WS_HB = WS_H;
constexpr size_t WS_OUTE = WS_P + al256((size_t)NSLOT * 1024 * 2);
constexpr size_t WS_WGU = WS_MIX;
constexpr size_t WS_WDN = WS_MIX + (size_t)NE * 2048 * 1024 * 2;
constexpr size_t WS_WIN = WS_MIX + al256((size_t)MT * 1024 * 2);
constexpr size_t WS_WUQ = WS_WIN + (size_t)2 * PLD * 1024 * 2;
constexpr size_t WS_WUKV = WS_WUQ + (size_t)2 * 768 * 384 * 2;
constexpr size_t WS_WOUT = WS_WUKV + (size_t)2 * 1024 * 256 * 2;
constexpr size_t WS_MOD = WS_WOUT + (size_t)2 * 1024 * 1024 * 2;
constexpr size_t WS_COS = WS_MOD + al256((size_t)2 * 9 * 6144 * 4);
constexpr size_t WS_SIN = WS_COS + (size_t)SEQ * 32 * 4;
constexpr size_t WS_GATES = WS_SIN + (size_t)SEQ * 32 * 4;
constexpr size_t WS_AFF = WS_GATES + (size_t)MT * 16 * 4;
constexpr size_t WS_IDX = WS_AFF + (size_t)MT * 16 * 4;
constexpr size_t WS_GV = WS_IDX + (size_t)NSLOT * 4;
constexpr size_t WS_TS = WS_GV + (size_t)NSLOT * 4;
constexpr size_t WS_CTXZ = WS_TS + (size_t)MT * 16 * 4;
constexpr size_t WS_END = WS_CTXZ + (size_t)MC * 1024 * 4;
static_assert(WS_OUTE + (size_t)NSLOT * 1024 * 2 <= WS_KR, "out_e overlay");
static_assert(WS_WDN + (size_t)NE * 1024 * 1024 * 2 <= WS_WIN, "expert weights overlay");

struct Params {
  const float *x, *c, *ctx, *c_ctx, *w_mod, *b_mod, *w_in, *b_gates, *conv_w, *conv_b, *m_norm_w, *q_norm_w, *kv_norm_w, *w_uq, *w_ukv, *w_out,
      *ln1_g, *ln1_b, *w_router, *w_gate, *w_up, *w_down, *ln2_g, *ln2_b;
  float* out; char* ws;
};

typedef const __attribute__((address_space(4))) Params& PRef;
__device__ __forceinline__ PRef kparams() { const __attribute__((address_space(4))) Params* kp = (const __attribute__((address_space(4))) Params*)__builtin_amdgcn_kernarg_segment_ptr(); asm volatile("" : "+s"(kp)); return *kp; }
__device__ __forceinline__ int otid() { int t = threadIdx.x; asm volatile("" : "+v"(t)); return t; }
__device__ __forceinline__ int obid() { int t = blockIdx.x; asm volatile("" : "+s"(t)); return t; }
__device__ __forceinline__ int opaque_s(int v) { asm volatile("" : "+s"(v)); return v; }
typedef __bf16 bf16v2_t __attribute__((ext_vector_type(2)));
typedef float f32x2_t __attribute__((ext_vector_type(2)));
__device__ __forceinline__ unsigned cvtpk(float lo, float hi) { const f32x2_t f = {lo, hi}; const bf16v2_t b = __builtin_convertvector(f, bf16v2_t); return __builtin_bit_cast(unsigned, b); }
__device__ __forceinline__ bf16_t f2bf(float v) { return (bf16_t)(cvtpk(v, v) & 0xffffu); }
__device__ __forceinline__ float bf2f(unsigned v) { return __uint_as_float(v << 16); }
__device__ __forceinline__ float bflo(unsigned w) { return __uint_as_float(w << 16); }
__device__ __forceinline__ float bfhi(unsigned w) { return __uint_as_float(w & 0xffff0000u); }
__device__ __forceinline__ float wave_sum(float v) { for (int o = 32; o > 0; o >>= 1) v += __shfl_xor(v, o); return v; }
__device__ __forceinline__ float wave_max(float v) { for (int o = 32; o > 0; o >>= 1) v = fmaxf(v, __shfl_xor(v, o)); return v; }
__device__ __forceinline__ float sigmoid_f(float v) { return __builtin_amdgcn_rcpf(1.f + __expf(-v)); }
__device__ __forceinline__ float silu_f(float v) { return v * sigmoid_f(v); }

namespace g8 {
constexpr int BK = 64, HALF = 128, HTB = HALF * BK * 2, STAGE_BYTES = 8 * HTB;
__device__ __forceinline__ int lds_byte(int r, int c) { const int st = (r >> 4) * 2 + (c >> 5), rr = r & 15, cc = c & 31, ob = rr * 64 + cc * 2; return st * 1024 + (ob ^ (((ob >> 9) & 1) << 5)); }
__device__ __forceinline__ int perm32(int rho) { const int n = rho >> 4, i = rho & 15; return 8 * (i >> 2) + 4 * n + (i & 3); }
__device__ __forceinline__ void stage_rc(int b, int& R, int& C) { const int st = b / 1024, sb = b % 1024, swz = sb ^ (((sb >> 9) & 1) << 5); R = (st >> 1) * 16 + swz / 64; C = (st & 1) * 32 + (swz % 64) / 2; }

template <bool GATHER>
__device__ __forceinline__ void gemm_tile(LAS unsigned char* lds, const char* __restrict__ Ab, const unsigned (&voffA)[GATHER ? 4 : 2], size_t hstepA, const char* __restrict__ Bb, int K,
                                          f32x4 (&acc)[2][2][4][2]) {
  const int tid = otid(), wid = __builtin_amdgcn_readfirstlane(tid >> 6), lane = tid & 63, wr = wid >> 2, wc = wid & 3, fr = lane & 15, fq = lane >> 4;
  const int nt = K / BK;
  unsigned voffB[2];
#pragma unroll
  for (int i = 0; i < 2; ++i) { int R, C; stage_rc(tid * 16 + i * 8192, R, C); const int Rb = (R & ~31) + perm32(R & 31); voffB[i] = (unsigned)(Rb * K + C) * 2u; }
  const char* Bb1 = Bb + (size_t)HALF * K * 2; const char* Ab1 = GATHER ? Ab : Ab + hstepA;
  const unsigned* vA0 = &voffA[0]; const unsigned* vA1 = GATHER ? &voffA[2] : &voffA[0];
  const unsigned ldsw = (unsigned)wid * 1024u;
  const int aoff = lds_byte(wr * 64 + fr, fq * 8), boff = lds_byte(wc * 32 + fr, fq * 8);
#define G8_SA(b, h) (((b) * 2 + (h)) * HTB)
#define G8_SB(b, h) ((4 + (b) * 2 + (h)) * HTB)
#define G8_STAGE(bufoff, gbase, voff, kt) do { _Pragma("unroll") for (int _i = 0; _i < 2; ++_i) \
    __builtin_amdgcn_global_load_lds((const unsigned*)((gbase) + (size_t)(kt) * (BK * 2) + (voff)[_i]), (LAS unsigned*)(lds + (bufoff) + ldsw + _i * 8192), 16, 0, 0); } while (0)
#define G8_LDA(dst, b, h) do { _Pragma("unroll") for (int m = 0; m < 4; ++m) _Pragma("unroll") for (int k = 0; k < 2; ++k) dst[m][k] = *(const LAS bf16x8*)(lds + G8_SA(b, h) + aoff + m * 2048 + k * 1024); } while (0)
#define G8_LDB(dst, b, h) do { _Pragma("unroll") for (int n = 0; n < 2; ++n) _Pragma("unroll") for (int k = 0; k < 2; ++k) dst[n][k] = *(const LAS bf16x8*)(lds + G8_SB(b, h) + boff + n * 2048 + k * 1024); } while (0)
#define G8_MMA(ai, bj, At, Bt) do { __builtin_amdgcn_s_setprio(1); _Pragma("unroll") for (int m = 0; m < 4; ++m) _Pragma("unroll") for (int n = 0; n < 2; ++n) _Pragma("unroll") for (int k = 0; k < 2; ++k) \
    acc[ai][bj][m][n] = __builtin_amdgcn_mfma_f32_16x16x32_bf16(Bt[n][k], At[m][k], acc[ai][bj][m][n], 0, 0, 0); __builtin_amdgcn_s_setprio(0); } while (0)
#define G8_WAIT_V(n) asm volatile("s_waitcnt vmcnt(" #n ")" ::: "memory")
#define G8_WAIT_L(n) asm volatile("s_waitcnt lgkmcnt(" #n ")" ::: "memory")
#define G8_BAR __builtin_amdgcn_s_barrier()
#define G8_SCHED __builtin_amdgcn_sched_barrier(0)
#pragma unroll
  for (int a = 0; a < 2; ++a)
#pragma unroll
    for (int b = 0; b < 2; ++b)
#pragma unroll
      for (int m = 0; m < 4; ++m)
#pragma unroll
        for (int n = 0; n < 2; ++n) acc[a][b][m][n] = (f32x4){0.f, 0.f, 0.f, 0.f};
  bf16x8 At[4][2], B0[2][2], B1[2][2];
  G8_WAIT_V(0); __syncthreads();
  G8_STAGE(G8_SB(0, 0), Bb, voffB, 0); G8_STAGE(G8_SA(0, 0), Ab, vA0, 0); G8_STAGE(G8_SB(0, 1), Bb1, voffB, 0); G8_STAGE(G8_SA(0, 1), Ab1, vA1, 0);
  if (wr == 1) G8_BAR;
  G8_WAIT_V(4); G8_BAR;
  G8_STAGE(G8_SB(1, 0), Bb, voffB, 1); G8_STAGE(G8_SA(1, 0), Ab, vA0, 1); G8_STAGE(G8_SB(1, 1), Bb1, voffB, 1);
  G8_WAIT_V(6); G8_BAR;
  for (int t = 0; t < nt - 2; t += 2) {
    G8_LDB(B0, 0, 0); G8_SCHED; G8_LDA(At, 0, 0); G8_STAGE(G8_SA(1, 1), Ab1, vA1, t + 1);
    G8_WAIT_L(8); G8_BAR; G8_WAIT_L(0); G8_MMA(0, 0, At, B0); G8_BAR; G8_SCHED;
    G8_LDB(B1, 0, 1); G8_STAGE(G8_SB(0, 0), Bb, voffB, t + 2);
    G8_BAR; G8_WAIT_L(0); G8_MMA(0, 1, At, B1); G8_BAR;
    G8_LDA(At, 0, 1); G8_STAGE(G8_SA(0, 0), Ab, vA0, t + 2);
    G8_BAR; G8_WAIT_L(0); G8_MMA(1, 0, At, B0); G8_BAR; G8_SCHED;
    G8_STAGE(G8_SB(0, 1), Bb1, voffB, t + 2);
    G8_WAIT_V(6); G8_BAR; G8_MMA(1, 1, At, B1); G8_BAR;
    G8_LDB(B0, 1, 0); G8_SCHED; G8_LDA(At, 1, 0); G8_STAGE(G8_SA(0, 1), Ab1, vA1, t + 2);
    G8_WAIT_L(8); G8_BAR; G8_WAIT_L(0); G8_MMA(0, 0, At, B0); G8_BAR; G8_SCHED;
    G8_LDB(B1, 1, 1); G8_STAGE(G8_SB(1, 0), Bb, voffB, t + 3);
    G8_BAR; G8_WAIT_L(0); G8_MMA(0, 1, At, B1); G8_BAR;
    G8_LDA(At, 1, 1); G8_STAGE(G8_SA(1, 0), Ab, vA0, t + 3);
    G8_BAR; G8_WAIT_L(0); G8_MMA(1, 0, At, B0); G8_BAR; G8_SCHED;
    G8_STAGE(G8_SB(1, 1), Bb1, voffB, t + 3);
    G8_WAIT_V(6); G8_BAR; G8_MMA(1, 1, At, B1); G8_BAR;
  }
  { G8_LDB(B0, 0, 0); G8_LDA(At, 0, 0); G8_STAGE(G8_SA(1, 1), Ab1, vA1, nt - 1);
    G8_BAR; G8_WAIT_L(0); G8_MMA(0, 0, At, B0); G8_BAR;
    G8_LDB(B1, 0, 1); G8_BAR; G8_WAIT_L(0); G8_MMA(0, 1, At, B1); G8_BAR;
    G8_LDA(At, 0, 1); G8_WAIT_V(4); G8_BAR; G8_WAIT_L(0); G8_MMA(1, 0, At, B0); G8_MMA(1, 1, At, B1); G8_BAR; }
  { G8_LDB(B0, 1, 0); G8_LDA(At, 1, 0); G8_WAIT_V(2); G8_BAR; G8_WAIT_L(0); G8_MMA(0, 0, At, B0); G8_BAR;
    G8_LDB(B1, 1, 1); G8_WAIT_V(0); G8_BAR; G8_WAIT_L(0); G8_MMA(0, 1, At, B1); G8_BAR;
    G8_LDA(At, 1, 1); G8_BAR; G8_WAIT_L(0); G8_MMA(1, 0, At, B0); G8_MMA(1, 1, At, B1); G8_BAR; }
  if (wr == 0) G8_BAR;
}
__device__ __forceinline__ unsigned piece_off(int i, int ld, int c0) { int R, C; stage_rc((int)otid() * 16 + i * 8192, R, C); return (unsigned)(R * ld + c0 + C) * 2u; }
__device__ __forceinline__ void piece_rc(int i, int& R, int& C) { stage_rc((int)otid() * 16 + i * 8192, R, C); }
struct TileIter {
  int nM, nN, x, j, J, cnt, idx;
  __device__ __forceinline__ void init(int nM_, int nN_) { nM = nM_; nN = nN_; x = obid() & 7; j = obid() >> 3; J = gridDim.x >> 3; cnt = ((nM - x + 7) >> 3) * nN; idx = j; }
  __device__ __forceinline__ bool next(int& pm, int& pn) { if (idx >= cnt) return false; pm = x + 8 * (idx / nN); pn = idx % nN; idx += J; return true; }
};
struct MoeIter {
  int nN, x, jm, jn, j, step, nsteps, nb4; bool with_ctx, ctx_done, wide;
  __device__ __forceinline__ void init(int nN_, bool with_ctx_) { nN = nN_; with_ctx = with_ctx_; wide = nN_ == 8; x = obid() & 7; j = obid() >> 3;
    if (wide) { jm = j & 3; jn = j >> 2; nsteps = 16; } else { jm = j & 7; jn = j >> 3; nsteps = 2 * (nN >> 2) * 4; }
    nb4 = nN >> 2; step = 0; ctx_done = false; }
  __device__ __forceinline__ bool next(int& pm, int& pn, int& e) {
    if (step < nsteps) {
      int m32;
      if (wide) { const int mb = step & 7, el = step >> 3; e = 2 * x + el; m32 = mb * 4 + jm; pn = jn; }
      else { const int mb = step & 3, nb = (step >> 2) % nb4, el = (step >> 2) / nb4; e = 2 * x + el; m32 = mb * 8 + jm; pn = nb * 4 + jn; }
      pm = ((m32 >> 2) * 16 + e) * 4 + (m32 & 3); ++step; return true; }
    if (with_ctx && !ctx_done) { ctx_done = true; if (j < 2 * nN) { e = 2 * x + j / nN; pm = 512 + e; pn = j % nN; return true; } }
    return false;
  }
};
}

#define ACC_FOR3(ai, bj, m) _Pragma("unroll") for (int ai = 0; ai < 2; ++ai) _Pragma("unroll") for (int bj = 0; bj < 2; ++bj) _Pragma("unroll") for (int m = 0; m < 4; ++m)
#define ACC_FOR(ai, bj, m, n) _Pragma("unroll") for (int ai = 0; ai < 2; ++ai) _Pragma("unroll") for (int bj = 0; bj < 2; ++bj) _Pragma("unroll") for (int m = 0; m < 4; ++m) _Pragma("unroll") for (int n = 0; n < 2; ++n)

__device__ __forceinline__ void cvt_tile(const float* __restrict__ src, int N, int K, int k0, int n0, bf16_t* __restrict__ dst, long drow0, const float* __restrict__ kscale, float* lds) {
  const int tid = otid();
  { const int kr = tid >> 6, n = tid & 63;
#pragma unroll
    for (int i = 0; i < 8; ++i) { const int k = kr + 8 * i; float v = (n0 + n < N) ? src[(size_t)(k0 + k) * N + n0 + n] : 0.f; if (kscale) v *= kscale[k0 + k]; lds[k * 65 + n] = v; } }
  __syncthreads();
  { const int n = tid >> 3, k8 = (tid & 7) * 8; float v[8];
#pragma unroll
    for (int i = 0; i < 8; ++i) v[i] = lds[(k8 + i) * 65 + n];
    u32x4 w = {cvtpk(v[0], v[1]), cvtpk(v[2], v[3]), cvtpk(v[4], v[5]), cvtpk(v[6], v[7])};
    *(u32x4*)(dst + (size_t)(drow0 + n) * K + k0 + k8) = w; }
  __syncthreads();
}

__device__ void phase_prep(PRef p, char* smem) {
  float* lds = (float*)smem;
  bf16_t* Wt_in = (bf16_t*)(p.ws + WS_WIN); bf16_t* Wt_uq = (bf16_t*)(p.ws + WS_WUQ); bf16_t* Wt_ukv = (bf16_t*)(p.ws + WS_WUKV); bf16_t* Wt_out = (bf16_t*)(p.ws + WS_WOUT);
  float* mod = (float*)(p.ws + WS_MOD);
  constexpr int T_MOD = 192, T_IN = 2 * 16 * 44, T_UQ = 2 * 6 * 12, T_UKV = 2 * 4 * 16, T_OUT = 2 * 16 * 16, T_ROPE = 64;
  constexpr int E0 = T_MOD, E1 = E0 + T_IN, E2 = E1 + T_UQ, E3 = E2 + T_UKV, E4 = E3 + T_OUT, E5 = E4 + T_ROPE;
  const int tid = otid();
  for (int task = obid(); task < E5; task += gridDim.x) {
    if (task < E0) {
      const int l = task / 96, j0 = (task % 96) * 64;
      float* sc = lds;
      for (int i = tid; i < 9 * 1024; i += 512) { const int bb = i >> 10, d = i & 1023; const float v = bb < 8 ? p.c[bb * 1024 + d] : p.c_ctx[d]; sc[i] = v / (1.f + expf(-v)); }
      __syncthreads();
      const int col = tid & 63, ks = tid >> 6; float a[9];
#pragma unroll
      for (int bb = 0; bb < 9; ++bb) a[bb] = 0.f;
      const float* wm = p.w_mod + (size_t)l * 1024 * 6144 + j0 + col;
      for (int d = ks * 128; d < ks * 128 + 128; ++d) { const float w = wm[(size_t)d * 6144];
#pragma unroll
        for (int bb = 0; bb < 9; ++bb) a[bb] += sc[bb * 1024 + d] * w; }
      float* red = lds + 9 * 1024;
#pragma unroll
      for (int bb = 0; bb < 9; ++bb) red[(ks * 9 + bb) * 64 + col] = a[bb];
      __syncthreads();
      for (int i = tid; i < 9 * 64; i += 512) { const int bb = i >> 6, cc = i & 63; float s = 0.f;
        for (int k = 0; k < 8; ++k) s += red[(k * 9 + bb) * 64 + cc];
        mod[((size_t)l * 9 + bb) * 6144 + j0 + cc] = s + p.b_mod[l * 6144 + j0 + cc]; }
      __syncthreads();
    } else if (task < E1) { const int t = task - E0, l = t / 704, r = t % 704, kt = r / 44, nt = r % 44;
      cvt_tile(p.w_in + (size_t)l * 1024 * IN_COLS, IN_COLS, 1024, kt * 64, nt * 64, Wt_in + (size_t)l * PLD * 1024, nt * 64, nullptr, lds);
    } else if (task < E2) { const int t = task - E1, l = t / 72, r = t % 72, kt = r / 12, nt = r % 12;
      cvt_tile(p.w_uq + (size_t)l * 384 * 768, 768, 384, kt * 64, nt * 64, Wt_uq + (size_t)l * 768 * 384, nt * 64, p.q_norm_w + l * 384, lds);
    } else if (task < E3) { const int t = task - E2, l = t / 64, r = t % 64, kt = r / 16, nt = r % 16;
      cvt_tile(p.w_ukv + (size_t)l * 256 * 1024, 1024, 256, kt * 64, nt * 64, Wt_ukv + (size_t)l * 1024 * 256, nt * 64, p.kv_norm_w + l * 256, lds);
    } else if (task < E4) { const int t = task - E3, l = t / 256, r = t % 256, kt = r / 16, nt = r % 16;
      cvt_tile(p.w_out + (size_t)l * 1024 * 1024, 1024, 1024, kt * 64, nt * 64, Wt_out + (size_t)l * 1024 * 1024, nt * 64, nullptr, lds);
    } else {
      float* cs = (float*)(p.ws + WS_COS); float* sn = (float*)(p.ws + WS_SIN);
      for (int i = (task - E4) * 4096 + tid; i < (task - E4 + 1) * 4096; i += 512) { const int t = i >> 5, j = i & 31;
        const float inv = exp2f(-(float)(j & 15) * (13.287712379549449f / 16.f));
        const float pos = (float)(j < 16 ? (t >> 6) : (t & 63)); const float ang = pos * inv;
        const double a = (double)ang; const double k = rint(a * 0.15915494309189535); const float r = (float)(a - k * 6.283185307179586);
        cs[i] = __cosf(r); sn[i] = __sinf(r); }
    }
  }
}

__device__ void phase_cvt_experts(PRef p, int l, char* smem) {
  float* lds = (float*)smem;
  bf16_t* Wgu = (bf16_t*)(p.ws + WS_WGU); bf16_t* Wdn = (bf16_t*)(p.ws + WS_WDN);
  const int tid = otid();
  for (int task = obid(); task < NE * 192; task += gridDim.x) {
    const int e = task / 192, r = task % 192, which = r >> 6, kt = (r & 63) >> 2, nt = r & 3, k0 = kt * 64, n0 = nt * 256;
    const float* src = (which == 0 ? p.w_gate : which == 1 ? p.w_up : p.w_down) + ((size_t)l * NE + e) * 1024 * 1024;
    { const int kr = tid >> 6, n4 = (tid & 63) * 4;
#pragma unroll
      for (int i = 0; i < 8; ++i) { const int k = kr + 8 * i; *(f32x4*)(lds + k * 260 + n4) = *(const f32x4*)(src + (size_t)(k0 + k) * 1024 + n0 + n4); } }
    __syncthreads();
    { const int nl = tid >> 1, k32 = (tid & 1) * 32, n = n0 + nl;
      const size_t drow = which == 2 ? (size_t)n : (size_t)((n >> 7) * 256 + which * 128 + (n & 127));
      bf16_t* dst = (which == 2 ? Wdn + (size_t)e * 1024 * 1024 : Wgu + (size_t)e * 2048 * 1024) + drow * 1024 + k0 + k32;
#pragma unroll
      for (int q = 0; q < 4; ++q) { float v[8];
#pragma unroll
        for (int i = 0; i < 8; ++i) v[i] = lds[(k32 + q * 8 + i) * 260 + nl];
        u32x4 w = {cvtpk(v[0], v[1]), cvtpk(v[2], v[3]), cvtpk(v[4], v[5]), cvtpk(v[6], v[7])};
        *(u32x4*)(dst + q * 8) = w; } }
    __syncthreads();
  }
}

__device__ __forceinline__ void ln_row(f32x4 (&v)[4], float eps) {
  float s = 0.f;
#pragma unroll
  for (int i = 0; i < 4; ++i) s += v[i][0] + v[i][1] + v[i][2] + v[i][3];
  const float mu = wave_sum(s) * (1.f / 1024.f);
  float q = 0.f;
#pragma unroll
  for (int i = 0; i < 4; ++i)
#pragma unroll
    for (int k = 0; k < 4; ++k) { v[i][k] -= mu; q += v[i][k] * v[i][k]; }
  const float rs = rsqrtf(wave_sum(q) * (1.f / 1024.f) + eps);
#pragma unroll
  for (int i = 0; i < 4; ++i) v[i] *= rs;
}
__device__ __forceinline__ void store_mod_bf16(const f32x4 (&v)[4], const float* __restrict__ shift, const float* __restrict__ scale, bf16_t* __restrict__ hrow, int lane, f32x4 (*keep)[4]) {
#pragma unroll
  for (int i = 0; i < 4; ++i) { const int c = lane * 4 + 256 * i; const f32x4 sh = *(const f32x4*)(shift + c), sc = *(const f32x4*)(scale + c);
    f32x4 o = v[i] * (sc + 1.f) + sh; if (keep) (*keep)[i] = o;
    u32x2 w = {cvtpk(o[0], o[1]), cvtpk(o[2], o[3])}; *(u32x2*)(hrow + c) = w; }
}
__device__ __forceinline__ const float* mod_ptr(PRef p, int l, int row, int which) {
  const int bb = row < MX ? (row >> 13) : 8;
  return (const float*)(p.ws + WS_MOD) + ((size_t)l * 9 + bb) * 6144 + which * 1024;
}

__device__ void phase_h0(PRef p) {
  const int lane = otid() & 63, gw = obid() * 8 + (otid() >> 6), nw = gridDim.x * 8;
  bf16_t* h = (bf16_t*)(p.ws + WS_H);
  for (int row = gw; row < MT; row += nw) {
    const float* src = row < MX ? p.x + (size_t)row * 1024 : p.ctx + (size_t)(row - MX) * 1024;
    f32x4 v[4];
#pragma unroll
    for (int i = 0; i < 4; ++i) v[i] = *(const f32x4*)(src + lane * 4 + 256 * i);
    ln_row(v, 1e-6f);
    store_mod_bf16(v, mod_ptr(p, 0, row, 0), mod_ptr(p, 0, row, 1), h + (size_t)row * 1024, lane, nullptr);
  }
}

__device__ void phase_inproj(PRef p, int l, char* smem) {
  LAS unsigned char* lds = (LAS unsigned char*)smem;
  const bf16_t* h = (const bf16_t*)(p.ws + WS_H); const bf16_t* Wt = (const bf16_t*)(p.ws + WS_WIN) + (size_t)l * PLD * 1024;
  bf16_t* P = (bf16_t*)(p.ws + WS_P); float* gates = (float*)(p.ws + WS_GATES);
  const int tid = otid(), wid = tid >> 6, lane = tid & 63, wr = wid >> 2, wc = wid & 3, fr = lane & 15, fq = lane >> 4;
  g8::TileIter it; it.init(MT / 256, PLD / 256);
  int pm, pn;
  while (it.next(pm, pn)) {
    unsigned voffA[2] = {g8::piece_off(0, 1024, 0), g8::piece_off(1, 1024, 0)};
    f32x4 acc[2][2][4][2];
    g8::gemm_tile<false>(lds, (const char*)(h + (size_t)pm * 256 * 1024), voffA, (size_t)128 * 1024 * 2, (const char*)(Wt + (size_t)pn * 256 * 1024), 1024, acc);
    ACC_FOR3(ai, bj, m) {
      const int row = pm * 256 + ai * 128 + wr * 64 + m * 16 + fr, col = pn * 256 + bj * 128 + wc * 32 + fq * 8;
      const f32x4 v0 = acc[ai][bj][m][0], v1 = acc[ai][bj][m][1];
      u32x4 w = {cvtpk(v0[0], v0[1]), cvtpk(v0[2], v0[3]), cvtpk(v1[0], v1[1]), cvtpk(v1[2], v1[3])}; *(u32x4*)(P + (size_t)row * PLD + col) = w;
      if (col >= OFF_G && col < OFF_G + 16) { const f32x4 bg0 = *(const f32x4*)(p.b_gates + l * 16 + (col - OFF_G)), bg1 = *(const f32x4*)(p.b_gates + l * 16 + (col - OFF_G) + 4);
        *(f32x4*)(gates + (size_t)row * 16 + (col - OFF_G)) = v0 + bg0; *(f32x4*)(gates + (size_t)row * 16 + (col - OFF_G) + 4) = v1 + bg1; }
    }
  }
}


constexpr size_t WS_QKC = WS_KV;
constexpr size_t WS_SCAL = WS_Q;
__device__ void phase_mlstm_pre(PRef p, int l, char* smem) {
  const bf16_t* P = (const bf16_t*)(p.ws + WS_P); const float* gates = (const float*)(p.ws + WS_GATES);
  bf16_t* QKC = (bf16_t*)(p.ws + WS_QKC); float* SCAL = (float*)(p.ws + WS_SCAL);
  const int tid = otid(), wid = tid >> 6, lane = tid & 63;
  if (obid() < 64) {
    const int chain = obid(), dir = chain & 1, hd = (chain >> 1) & 3, b = chain >> 3;
    float* LA = (float*)smem; float* LB = LA + 132 * 64; float* LP = LB + 132 * 64; float* b63s = LP + 132 * 64; float* pm63s = b63s + 132; float* mbs = pm63s + 132;
    for (int ci = wid; ci < 132; ci += 8) {
      const bool ic = ci < 4; const int cc = ic ? ci : ci - 4, T = ic ? CTXL : SEQ, rb = ic ? MX + b * CTXL : b * SEQ, tlo = dir ? T - 64 - cc * 64 : cc * 64;
      const int t = dir ? tlo + 63 - lane : tlo + lane; const float* g = gates + (size_t)(rb + t) * 16;
      const float ig = g[dir * 8 + hd], fg = g[dir * 8 + 4 + hd];
      const float lf = fminf(fg, 0.f) - log1pf(expf(-fabsf(fg)));
      float bc = lf;
#pragma unroll
      for (int o = 1; o < 64; o <<= 1) { const float u = __shfl_up(bc, o); if (lane >= o) bc += u; }
      const float a = ig - bc; float pmx = a;
#pragma unroll
      for (int o = 1; o < 64; o <<= 1) { const float u = __shfl_up(pmx, o); if (lane >= o) pmx = fmaxf(pmx, u); }
      LA[ci * 64 + lane] = a; LB[ci * 64 + lane] = bc; LP[ci * 64 + lane] = pmx;
      if (lane == 63) { b63s[ci] = bc; pm63s[ci] = pmx; }
    }
    __syncthreads();
    if (tid == 0) { float m = 0.f; for (int ci = 0; ci < 132; ++ci) { mbs[ci] = m; m = b63s[ci] + fmaxf(pm63s[ci], m); } }
    __syncthreads();
    for (int ci = wid; ci < 132; ci += 8) {
      const float m = mbs[ci], a = LA[ci * 64 + lane], bc = LB[ci * 64 + lane], pmx = LP[ci * 64 + lane];
      const float Mx = fmaxf(pmx, m), M63 = fmaxf(pm63s[ci], m);
      float* S = SCAL + ((size_t)chain * 132 + ci) * 384;
      S[lane] = a; S[64 + lane] = Mx; S[128 + lane] = __expf(m - Mx); S[192 + lane] = __expf(-(bc + Mx)); S[256 + lane] = __expf(a - M63);
      S[320 + lane] = lane == 0 ? __expf(m - M63) : 0.f;
    }
    return;
  }
  const int col8 = (tid & 127) * 8, rg = tid >> 7;
  float w[5][8], bia[8];
#pragma unroll
  for (int j = 0; j < 5; ++j) { const f32x4 w0 = *(const f32x4*)(p.conv_w + ((size_t)l * 5 + j) * 1024 + col8), w1 = *(const f32x4*)(p.conv_w + ((size_t)l * 5 + j) * 1024 + col8 + 4);
#pragma unroll
    for (int k = 0; k < 4; ++k) { w[j][k] = w0[k]; w[j][4 + k] = w1[k]; } }
  { const f32x4 b0 = *(const f32x4*)(p.conv_b + l * 1024 + col8), b1 = *(const f32x4*)(p.conv_b + l * 1024 + col8 + 4);
#pragma unroll
    for (int k = 0; k < 4; ++k) { bia[k] = b0[k]; bia[4 + k] = b1[k]; } }
  const float osc = col8 < 512 ? 0.08838834764831845f : 1.f;
#pragma unroll 1
  for (int rb = obid() - 64; rb < MT / 64; rb += gridDim.x - 64) {
    const int R0 = rb * 64, seg_lo = R0 < MX ? (R0 & ~8191) : MX + ((R0 - MX) & ~255), seg_hi = seg_lo + (R0 < MX ? SEQ : CTXL);
    const int r0 = R0 + rg * 16;
    u32x4 raw[20];
#pragma unroll
    for (int i = 0; i < 20; ++i) { const int r = r0 - 2 + i; raw[i] = (u32x4){0u, 0u, 0u, 0u}; if (r >= seg_lo && r < seg_hi) raw[i] = *(const u32x4*)(P + (size_t)r * PLD + col8); }
#pragma unroll
    for (int i = 0; i < 16; ++i) {
      float y[8];
#pragma unroll
      for (int k = 0; k < 8; ++k) y[k] = bia[k];
#pragma unroll
      for (int tp = 0; tp < 5; ++tp) {
#pragma unroll
        for (int k = 0; k < 4; ++k) { y[2 * k] += w[tp][2 * k] * bflo(raw[i + tp][k]); y[2 * k + 1] += w[tp][2 * k + 1] * bfhi(raw[i + tp][k]); } }
#pragma unroll
      for (int k = 0; k < 8; ++k) y[k] = silu_f(y[k]) * osc;
      u32x4 o = {cvtpk(y[0], y[1]), cvtpk(y[2], y[3]), cvtpk(y[4], y[5]), cvtpk(y[6], y[7])};
      *(u32x4*)(QKC + (size_t)(r0 + i) * 1024 + col8) = o;
    }
  }
}

__device__ void phase_mlstm(PRef p, int l, char* smem) {
  bf16_t* QBb[2] = {(bf16_t*)(smem), (bf16_t*)(smem + 17408)};
  bf16_t* KB = (bf16_t*)(smem + 34816);
  bf16_t* KT = (bf16_t*)(smem + 52224);
  bf16_t* VTb[2] = {(bf16_t*)(smem + 70656), (bf16_t*)(smem + 77568)};
  bf16_t* VWT = (bf16_t*)(smem + 84480);
  bf16_t* PB = (bf16_t*)(smem + 91392);
  bf16_t* CTb[2] = {(bf16_t*)(smem + 100608), (bf16_t*)(smem + 113664)};
  float* SC = (float*)(smem + 126720);
  const bf16_t* P = (const bf16_t*)(p.ws + WS_P); const bf16_t* QKC = (const bf16_t*)(p.ws + WS_QKC); const float* SCAL = (const float*)(p.ws + WS_SCAL);
  bf16_t* hbuf = (bf16_t*)(p.ws + WS_HB);
  for (int w = obid(); w < 256; w += gridDim.x) {
    const int slice = (w >> 3) & 3, chain = (w & 7) * 8 + (w >> 5), dir = chain & 1, hd = (chain >> 1) & 3, b = chain >> 3;
    const float* SCc = SCAL + (size_t)chain * 132 * 384;
    __syncthreads();
    { const int tid = otid();
      for (int i = tid; i < 48 * 136 / 2; i += 512) { ((unsigned*)CTb[0])[i] = 0u; ((unsigned*)CTb[1])[i] = 0u; }
      for (int i = tid; i < 48 * 72 / 2; i += 512) { ((unsigned*)VTb[0])[i] = 0u; ((unsigned*)VTb[1])[i] = 0u; ((unsigned*)VWT)[i] = 0u; } }
    f32x4 accC[3];
#pragma unroll
    for (int i = 0; i < 3; ++i) accC[i] = (f32x4){0.f, 0.f, 0.f, 0.f};
    struct Pre { u32x4 qk[4]; u32x2 v; f32x4 s; float ws, ws1; };
    Pre preA, preB;
    preA.s = (f32x4){0.f, 0.f, 0.f, 0.f}; preB.s = preA.s;
#define MLSTM_PREFETCH(PR, CI) do { const int tid_ = otid(); const int ci_ = (CI); const bool ic_ = ci_ < 4; const int cc_ = ic_ ? ci_ : ci_ - 4, T_ = ic_ ? CTXL : SEQ, rb_ = ic_ ? MX + b * CTXL : b * SEQ; \
      const int tlo_ = dir ? T_ - 64 - cc_ * 64 : cc_ * 64; \
      _Pragma("unroll") for (int k_ = 0; k_ < 4; ++k_) { const int pc = tid_ + k_ * 512, tens = pc >> 10, rem = pc & 1023, lr = rem >> 4, c16 = rem & 15, t = dir ? tlo_ + 63 - lr : tlo_ + lr; \
        PR.qk[k_] = *(const u32x4*)(QKC + (size_t)(rb_ + t) * 1024 + tens * 512 + hd * 128 + c16 * 8); } \
      { const int vl_ = tid_ >> 3, vt_ = dir ? tlo_ + 63 - vl_ : tlo_ + vl_; PR.v = *(const u32x2*)(P + (size_t)(rb_ + vt_) * PLD + OFF_V + hd * 128 + slice * 32 + (tid_ & 7) * 4); \
        PR.ws = SCc[(size_t)ci_ * 384 + 256 + vl_]; PR.ws1 = SCc[(size_t)ci_ * 384 + 256 + (tid_ & 63)]; } \
      if (tid_ < 96) PR.s = *(const f32x4*)(SCc + (size_t)ci_ * 384 + tid_ * 4); } while (0)
    MLSTM_PREFETCH(preA, 0);
    MLSTM_PREFETCH(preB, 1);
    __syncthreads();
    auto step = [&](const int ci, Pre& pre) __attribute__((always_inline)) {
      const int tid = otid(), wid = tid >> 6, lane = tid & 63, fr = lane & 15, fq = lane >> 4;
      const bool isctx = ci < 4; const int cc = isctx ? ci : ci - 4, T = isctx ? CTXL : SEQ, rowbase = isctx ? MX + b * CTXL : b * SEQ;
      const int tlo = dir ? T - 64 - cc * 64 : cc * 64;
      const int par = ci & 1;
      bf16_t* QB = QBb[par]; bf16_t* VT = VTb[par]; float* S = SC + par * 384; bf16_t* CTc = CTb[par]; bf16_t* CTn = CTb[par ^ 1];
      const bool need_out = !(l == DEPTH - 1 && isctx);
#pragma unroll
      for (int k = 0; k < 4; ++k) { const int pc = tid + k * 512, tens = pc >> 10, rem = pc & 1023, lr = rem >> 4, c16 = rem & 15;
        if (tens == 0) *(u32x4*)(QB + lr * 136 + c16 * 8) = pre.qk[k];
        else { *(u32x4*)(KB + lr * 136 + c16 * 8) = pre.qk[k];
#pragma unroll
          for (int i = 0; i < 4; ++i) { KT[(c16 * 8 + 2 * i) * 72 + lr] = (bf16_t)(pre.qk[k][i] & 0xffffu); KT[(c16 * 8 + 2 * i + 1) * 72 + lr] = (bf16_t)(pre.qk[k][i] >> 16); } } }
      { const int vl = tid >> 3, ve4 = (tid & 7) * 4; const float wsl = pre.ws;
        VT[(ve4 + 0) * 72 + vl] = (bf16_t)(pre.v[0] & 0xffffu); VT[(ve4 + 1) * 72 + vl] = (bf16_t)(pre.v[0] >> 16);
        VT[(ve4 + 2) * 72 + vl] = (bf16_t)(pre.v[1] & 0xffffu); VT[(ve4 + 3) * 72 + vl] = (bf16_t)(pre.v[1] >> 16);
        VWT[(ve4 + 0) * 72 + vl] = f2bf(bflo(pre.v[0]) * wsl); VWT[(ve4 + 1) * 72 + vl] = f2bf(bfhi(pre.v[0]) * wsl);
        VWT[(ve4 + 2) * 72 + vl] = f2bf(bflo(pre.v[1]) * wsl); VWT[(ve4 + 3) * 72 + vl] = f2bf(bfhi(pre.v[1]) * wsl);
        if (tid < 64) { VT[32 * 72 + tid] = (bf16_t)0x3F80u; VWT[32 * 72 + tid] = f2bf(pre.ws1); }
        if (tid < 96) *(f32x4*)(S + tid * 4) = pre.s; }
      if (ci + 2 < 132) MLSTM_PREFETCH(pre, ci + 2);
      __syncthreads();
      if (need_out) {
        const int mt = wid >> 1;
#pragma unroll
        for (int u = 0; u < 2; ++u) {
          const int ntl = (wid & 1) * 2 + u;
          f32x4 sacc = {0.f, 0.f, 0.f, 0.f};
          if (ntl <= mt) {
#pragma unroll
            for (int kk = 0; kk < 4; ++kk) {
              const bf16x8 a = *(const bf16x8*)(QB + (mt * 16 + fr) * 136 + kk * 32 + fq * 8), bb = *(const bf16x8*)(KB + (ntl * 16 + fr) * 136 + kk * 32 + fq * 8);
              sacc = __builtin_amdgcn_mfma_f32_16x16x32_bf16(a, bb, sacc, 0, 0, 0); }
          }
          const int j = ntl * 16 + fr; const float aj = S[j];
#pragma unroll
          for (int jj = 0; jj < 4; ++jj) { const int lr = mt * 16 + fq * 4 + jj;
            const float pv = (j <= lr) ? sacc[jj] * __expf(fminf(aj - S[64 + lr], 0.f)) : 0.f;
            PB[lr * 72 + j] = f2bf(pv); }
        }
      }
      {
        const float decay = S[320];
#pragma unroll
        for (int mt = 0; mt < 3; ++mt) {
          accC[mt] *= decay;
#pragma unroll
          for (int kk = 0; kk < 2; ++kk) { const bf16x8 a = *(const bf16x8*)(VWT + (mt * 16 + fr) * 72 + kk * 32 + fq * 8), bb = *(const bf16x8*)(KT + (wid * 16 + fr) * 72 + kk * 32 + fq * 8);
            accC[mt] = __builtin_amdgcn_mfma_f32_16x16x32_bf16(a, bb, accC[mt], 0, 0, 0); }
#pragma unroll
          for (int jj = 0; jj < 4; ++jj) CTn[(mt * 16 + fq * 4 + jj) * 136 + wid * 16 + fr] = f2bf(accC[mt][jj]);
        }
      }
      __syncthreads();
      if (need_out && wid < 4) {
        const int mt = wid; f32x4 num[3];
#pragma unroll
        for (int ntl = 0; ntl < 3; ++ntl) {
          f32x4 a1 = {0.f, 0.f, 0.f, 0.f}, a2 = {0.f, 0.f, 0.f, 0.f};
#pragma unroll
          for (int kk = 0; kk < 2; ++kk) { const bf16x8 a = *(const bf16x8*)(PB + (mt * 16 + fr) * 72 + kk * 32 + fq * 8), bb = *(const bf16x8*)(VT + (ntl * 16 + fr) * 72 + kk * 32 + fq * 8);
            a1 = __builtin_amdgcn_mfma_f32_16x16x32_bf16(a, bb, a1, 0, 0, 0); }
#pragma unroll
          for (int kk = 0; kk < 4; ++kk) { const bf16x8 a = *(const bf16x8*)(QB + (mt * 16 + fr) * 136 + kk * 32 + fq * 8), bb = *(const bf16x8*)(CTc + (ntl * 16 + fr) * 136 + kk * 32 + fq * 8);
            a2 = __builtin_amdgcn_mfma_f32_16x16x32_bf16(a, bb, a2, 0, 0, 0); }
#pragma unroll
          for (int jj = 0; jj < 4; ++jj) num[ntl][jj] = a1[jj] + S[128 + mt * 16 + fq * 4 + jj] * a2[jj];
        }
#pragma unroll
        for (int jj = 0; jj < 4; ++jj) {
          const int lr = mt * 16 + fq * 4 + jj; const float den = __shfl(num[2][jj], lane & 48);
          const float rd = __builtin_amdgcn_rcpf(fmaxf(fabsf(den), S[192 + lr]));
          const int t = dir ? tlo + 63 - lr : tlo + lr;
          bf16_t* hp = hbuf + ((size_t)((dir * 4 + hd) * 4 + slice) * MT + rowbase + t) * 32 + fr;
          hp[0] = f2bf(num[0][jj] * rd); hp[16] = f2bf(num[1][jj] * rd);
        }
      }
    };
#pragma unroll 1
    for (int ci = 0; ci < 132; ci += 2) { step(ci, preA); step(ci + 1, preB); }
    __syncthreads();
  }
#undef MLSTM_PREFETCH
}

template <int WHICH>
__device__ __forceinline__ void mla_gemm(PRef p, int l, char* smem) {
  LAS unsigned char* lds = (LAS unsigned char*)smem; float* rsb = (float*)(smem + g8::STAGE_BYTES);
  const bf16_t* P = (const bf16_t*)(p.ws + WS_P);
  const int tid = otid(), wid = tid >> 6, lane = tid & 63, wr = wid >> 2, wc = wid & 3, fr = lane & 15, fq = lane >> 4;
  constexpr int K = WHICH ? 256 : 384, OFFC = WHICH ? OFF_CKV : OFF_CQ, N = WHICH ? 1024 : 768;
  const bf16_t* Wt = WHICH ? (const bf16_t*)(p.ws + WS_WUKV) + (size_t)l * 1024 * 256 : (const bf16_t*)(p.ws + WS_WUQ) + (size_t)l * 768 * 384;
  bf16_t* O = (bf16_t*)(p.ws + (WHICH ? WS_KV : WS_Q));
  g8::TileIter it; it.init((WHICH || l == 0) ? MT / 256 : MX / 256, N / 256);
  int pm, pn;
  while (it.next(pm, pn)) {
    __syncthreads();
    { const int r = tid >> 1, hf = tid & 1; const bf16_t* src = P + (size_t)(pm * 256 + r) * PLD + OFFC + hf * (K / 2); float s = 0.f;
#pragma unroll 4
      for (int i = 0; i < K / 16; ++i) { const u32x4 v = *(const u32x4*)(src + i * 8);
#pragma unroll
        for (int k = 0; k < 4; ++k) { const float a = bflo(v[k]), bq = bfhi(v[k]); s += a * a + bq * bq; } }
      s += __shfl_xor(s, 1);
      if (hf == 0) rsb[r] = rsqrtf(s / (float)K + 1e-6f); }
    unsigned voffA[2] = {g8::piece_off(0, PLD, OFFC), g8::piece_off(1, PLD, OFFC)};
    f32x4 acc[2][2][4][2];
    g8::gemm_tile<false>(lds, (const char*)(P + (size_t)pm * 256 * PLD), voffA, (size_t)128 * PLD * 2, (const char*)(Wt + (size_t)pn * 256 * K), opaque_s(K), acc);
    ACC_FOR3(ai, bj, m) {
      const int rl = ai * 128 + wr * 64 + m * 16 + fr, row = pm * 256 + rl, col = pn * 256 + bj * 128 + wc * 32 + fq * 8;
      const float rs = rsb[rl]; const f32x4 v0 = acc[ai][bj][m][0] * rs, v1 = acc[ai][bj][m][1] * rs;
      size_t orow = row;
      if (WHICH) orow = row < MX ? (size_t)(row >> 13) * SKV + CTXL + (row & 8191) : (size_t)((row - MX) >> 8) * SKV + ((row - MX) & 255);
      u32x4 w = {cvtpk(v0[0], v0[1]), cvtpk(v0[2], v0[3]), cvtpk(v1[0], v1[1]), cvtpk(v1[2], v1[3])}; *(u32x4*)(O + orow * N + col) = w;
    }
  }
}
__device__ void phase_mla_prep(PRef p, int l, char* smem) {
  mla_gemm<0>(p, l, smem);
  mla_gemm<1>(p, l, smem);
  const bf16_t* P = (const bf16_t*)(p.ws + WS_P);
  const int tid = otid(), wid = tid >> 6, lane = tid & 63;
  const bf16_t* hbuf = (const bf16_t*)(p.ws + WS_HB); bf16_t* mix = (bf16_t*)(p.ws + WS_MIX); bf16_t* KR = (bf16_t*)(p.ws + WS_KR);
  const float* cs = (const float*)(p.ws + WS_COS); const float* sn = (const float*)(p.ws + WS_SIN);
  const int gw = obid() * 8 + wid, nw = gridDim.x * 8;
  for (int row = gw; row < MT; row += nw) {
    if (row < MX || l == 0) {
      const size_t ho = ((size_t)(lane >> 2) * MT + row) * 32 + (lane & 3) * 8;
      const u32x4 hf = *(const u32x4*)(hbuf + ho), hb = *(const u32x4*)(hbuf + (size_t)16 * MT * 32 + ho);
      const u32x4 ov = *(const u32x4*)(P + (size_t)row * PLD + OFF_O + lane * 8);
      float v[8]; float s = 0.f;
#pragma unroll
      for (int k = 0; k < 4; ++k) { v[2 * k] = bflo(hf[k]) + bflo(hb[k]); v[2 * k + 1] = bfhi(hf[k]) + bfhi(hb[k]); s += v[2 * k] + v[2 * k + 1]; }
      s += __shfl_xor(s, 1); s += __shfl_xor(s, 2); s += __shfl_xor(s, 4); s += __shfl_xor(s, 8);
      const float mu = s * (1.f / 128.f); float q = 0.f;
#pragma unroll
      for (int k = 0; k < 8; ++k) { v[k] -= mu; q += v[k] * v[k]; }
      q += __shfl_xor(q, 1); q += __shfl_xor(q, 2); q += __shfl_xor(q, 4); q += __shfl_xor(q, 8);
      const float rs = rsqrtf(q * (1.f / 128.f) + 1e-6f);
      const float* nw_ = p.m_norm_w + l * 512 + lane * 8; float o[8];
#pragma unroll
      for (int k = 0; k < 4; ++k) { o[2 * k] = v[2 * k] * rs * nw_[2 * k] * sigmoid_f(bflo(ov[k])); o[2 * k + 1] = v[2 * k + 1] * rs * nw_[2 * k + 1] * sigmoid_f(bfhi(ov[k])); }
      u32x4 wv = {cvtpk(o[0], o[1]), cvtpk(o[2], o[3]), cvtpk(o[4], o[5]), cvtpk(o[6], o[7])};
      *(u32x4*)(mix + (size_t)row * 1024 + lane * 8) = wv;
    }
    {
      const int j = lane & 31;
      const float x1 = bf2f(P[(size_t)row * PLD + OFF_KR + j]), x2 = bf2f(P[(size_t)row * PLD + OFF_KR + 32 + j]);
      float o1 = x1, o2 = x2; size_t orow;
      if (row < MX) { const int t = row & 8191; const float c = cs[t * 32 + j], s_ = sn[t * 32 + j]; o1 = x1 * c - x2 * s_; o2 = x2 * c + x1 * s_; orow = (size_t)(row >> 13) * SKV + CTXL + t; }
      else orow = (size_t)((row - MX) >> 8) * SKV + ((row - MX) & 255);
      if (lane < 32) { KR[orow * 64 + j] = f2bf(o1); KR[orow * 64 + 32 + j] = f2bf(o2); }
    }
  }
}

namespace att {
constexpr int NW = 8, QBLK = 32, KVBLK = 64, LDQ = 768, LDK = 1024, LDKR = 64, LDO = 1024;
constexpr float SCALE = A_SCALE;
constexpr float THR = 8.f;
constexpr size_t SHM_V = KVBLK * 128 * 2, SHM_K = KVBLK * 128 * 2, SHM_R = KVBLK * 64 * 2;
typedef float f32x8 __attribute__((ext_vector_type(8)));
#define KSWZ(row, colB) ((row) * 256 + ((colB) ^ (((row) & 7) << 4)))
#define RSWZ(row, colB) ((row) * 128 + ((colB) ^ (((row) & 7) << 4)))
#define SBAR() __builtin_amdgcn_sched_barrier(0)
__device__ __forceinline__ int crow(int r, int hi) { return (r & 3) + 8 * (r >> 2) + 4 * hi; }
__device__ __forceinline__ void partialSM(f32x16& p0, f32x16& p1, float& m_reg, float& mn, float& alpha) {
  constexpr float C = SCALE * 1.4426950408889634f;
  float pmax = p0[0];
#pragma unroll
  for (int r = 1; r < 16; ++r) pmax = fmaxf(pmax, p0[r]);
#pragma unroll
  for (int r = 0; r < 16; ++r) pmax = fmaxf(pmax, p1[r]);
  { auto rr = __builtin_amdgcn_permlane32_swap(__float_as_uint(pmax), __float_as_uint(pmax), false, false);
    pmax = fmaxf(__uint_as_float(rr[0]), __uint_as_float(rr[1])); }
  if (__builtin_expect(__all(pmax - m_reg <= THR / SCALE), 1)) { mn = m_reg; alpha = 1.f; }
  else { mn = fmaxf(m_reg, pmax); alpha = __builtin_amdgcn_exp2f((m_reg - mn) * C); m_reg = mn; }
  const float mnC = -mn * C;
#pragma unroll
  for (int r = 0; r < 16; ++r) p0[r] = fmaf(p0[r], C, mnC);
#pragma unroll
  for (int r = 0; r < 16; ++r) p1[r] = fmaf(p1[r], C, mnC);
#pragma unroll
  for (int r = 0; r < 16; ++r) p0[r] = __builtin_amdgcn_exp2f(p0[r]);
}
__device__ __forceinline__ void finishSM(f32x16& p0, f32x16& p1, float alpha, float& l_reg, bf16x8& pa0, bf16x8& pa1, bf16x8& pa2, bf16x8& pa3) {
#pragma unroll
  for (int r = 0; r < 16; ++r) p1[r] = __builtin_amdgcn_exp2f(p1[r]);
  float ps = 0;
#pragma unroll
  for (int r = 0; r < 16; ++r) ps += p0[r];
#pragma unroll
  for (int r = 0; r < 16; ++r) ps += p1[r];
  { auto rr = __builtin_amdgcn_permlane32_swap(__float_as_uint(ps), __float_as_uint(ps), false, false);
    ps = __uint_as_float(rr[0]) + __uint_as_float(rr[1]); }
  l_reg = l_reg * alpha + ps;
#define PK4(P, BASE, OUT) do { unsigned a0 = cvtpk(P[BASE + 0], P[BASE + 1]), a1 = cvtpk(P[BASE + 2], P[BASE + 3]);   \
    unsigned b0 = cvtpk(P[BASE + 4], P[BASE + 5]), b1 = cvtpk(P[BASE + 6], P[BASE + 7]);                              \
    auto r0 = __builtin_amdgcn_permlane32_swap(a0, b0, false, false); auto r1 = __builtin_amdgcn_permlane32_swap(a1, b1, false, false); \
    u32x4 w = {r0[0], r1[0], r0[1], r1[1]}; OUT = *reinterpret_cast<bf16x8*>(&w); } while (0)
  PK4(p0, 0, pa0); PK4(p0, 8, pa1); PK4(p1, 0, pa2); PK4(p1, 8, pa3);
#undef PK4
}
__device__ __forceinline__ void qkt(f32x16& p0, f32x16& p1, const char* Ks, const char* Rs, const bf16x8* qr, const char* qrl, int r32, int hi) {
  p0 = f32x16{}; p1 = f32x16{};
#pragma unroll
  for (int d0 = 0; d0 < 8; ++d0) { const int cb = (d0 * 16 + hi * 8) * 2;
    const bf16x8 b0 = *reinterpret_cast<const bf16x8*>(Ks + KSWZ(r32, cb));
    const bf16x8 b1 = *reinterpret_cast<const bf16x8*>(Ks + KSWZ(32 + r32, cb));
    p0 = __builtin_amdgcn_mfma_f32_32x32x16_bf16(b0, qr[d0], p0, 0, 0, 0);
    p1 = __builtin_amdgcn_mfma_f32_32x32x16_bf16(b1, qr[d0], p1, 0, 0, 0); }
#pragma unroll
  for (int d0 = 0; d0 < 4; ++d0) { const int cb = (d0 * 16 + hi * 8) * 2;
    const bf16x8 b0 = *reinterpret_cast<const bf16x8*>(Rs + RSWZ(r32, cb));
    const bf16x8 b1 = *reinterpret_cast<const bf16x8*>(Rs + RSWZ(32 + r32, cb));
    const bf16x8 qv = *reinterpret_cast<const bf16x8*>(qrl + d0 * 1024);
    p0 = __builtin_amdgcn_mfma_f32_32x32x16_bf16(b0, qv, p0, 0, 0, 0);
    p1 = __builtin_amdgcn_mfma_f32_32x32x16_bf16(b1, qv, p1, 0, 0, 0); }
}
__device__ __forceinline__ int v_st(int k, int c) { const int kk = (k & ~0xC) | ((k & 4) << 1) | ((k & 8) >> 1); return ((kk >> 3) * 4 + (c >> 5)) * 512 + ((kk & 7) * 32 + (c & 31)) * 2; }
__device__ __forceinline__ int v_rd_base(int lane) { return ((lane & 3) << 3) | (((lane >> 2) & 3) << 6) | (((lane >> 4) & 1) << 5) | (((lane >> 5) & 1) << 8); }
constexpr int v_rd_off(int d0, int ks, int half) { return d0 * 512 + ks * 4096 + half * 2048; }
template <int OFF> __device__ __forceinline__ s16x4 tr_read(int vb) {
  s16x4 r; asm volatile("ds_read_b64_tr_b16 %0, %1 offset:%2" : "=&v"(r) : "v"(vb), "i"(OFF) : "memory"); return r;
}
template <int D0> __device__ __forceinline__ void pv_one(f32x16& od, int vb, bf16x8 pa0, bf16x8 pa1, bf16x8 pa2, bf16x8 pa3) {
  const s16x4 l0 = tr_read<v_rd_off(D0, 0, 0)>(vb), h0 = tr_read<v_rd_off(D0, 0, 1)>(vb), l1 = tr_read<v_rd_off(D0, 1, 0)>(vb), h1 = tr_read<v_rd_off(D0, 1, 1)>(vb);
  const s16x4 l2 = tr_read<v_rd_off(D0, 2, 0)>(vb), h2 = tr_read<v_rd_off(D0, 2, 1)>(vb), l3 = tr_read<v_rd_off(D0, 3, 0)>(vb), h3 = tr_read<v_rd_off(D0, 3, 1)>(vb);
  asm volatile("s_waitcnt lgkmcnt(0)" ::: "memory"); SBAR();
#define PK(L, H) (bf16x8){L[0], L[1], L[2], L[3], H[0], H[1], H[2], H[3]}
  od = __builtin_amdgcn_mfma_f32_32x32x16_bf16(pa0, PK(l0, h0), od, 0, 0, 0);
  od = __builtin_amdgcn_mfma_f32_32x32x16_bf16(pa1, PK(l1, h1), od, 0, 0, 0);
  od = __builtin_amdgcn_mfma_f32_32x32x16_bf16(pa2, PK(l2, h2), od, 0, 0, 0);
  od = __builtin_amdgcn_mfma_f32_32x32x16_bf16(pa3, PK(l3, h3), od, 0, 0, 0);
#undef PK
}
__device__ __forceinline__ void pv_d0(f32x16* o, int vb, bf16x8 pa0, bf16x8 pa1, bf16x8 pa2, bf16x8 pa3) {
  pv_one<0>(o[0], vb, pa0, pa1, pa2, pa3); pv_one<1>(o[1], vb, pa0, pa1, pa2, pa3); pv_one<2>(o[2], vb, pa0, pa1, pa2, pa3); pv_one<3>(o[3], vb, pa0, pa1, pa2, pa3);
}
__device__ __forceinline__ void attn_body(const bf16_t* __restrict__ Qb, const float* __restrict__ cs, const float* __restrict__ sn, const bf16_t* __restrict__ Kn,
                                          const bf16_t* __restrict__ Vh, const bf16_t* __restrict__ Kr, bf16_t* __restrict__ Ob, int seq, char* lds) {
  const int tid = otid(), wid = tid >> 6, lane = tid & 63, r32 = lane & 31, hi = lane >> 5;
  char* V_lds = lds; char* K_lds = lds + 2 * SHM_V; char* R_lds = lds + 2 * SHM_V + 2 * SHM_K;
  float* wsf = (float*)(lds + 2 * SHM_V + 2 * SHM_K + 2 * SHM_R) + wid * 64; float* li_l = wsf; float* al_l = wsf + 32;
  char* qrl = lds + 2 * SHM_V + 2 * SHM_K + 2 * SHM_R + 2048 + wid * 4096 + lane * 16;
  float m_reg = -1e30f, l_reg = 0; f32x16 o[4] = {}; bf16x8 qr[8];
  { const bf16_t* Qw = Qb + (size_t)(wid * QBLK + r32) * LDQ + hi * 8;
#pragma unroll
    for (int d0 = 0; d0 < 8; ++d0) qr[d0] = *(const bf16x8*)(Qw + d0 * 16);
#pragma unroll
    for (int d0 = 0; d0 < 2; ++d0) {
      const u32x4 a = *(const u32x4*)(Qw + 128 + d0 * 16), bq = *(const u32x4*)(Qw + 160 + d0 * 16);
      if (cs) {
        const float* cp = cs + (size_t)(wid * QBLK + r32) * 32 + d0 * 16 + hi * 8; const float* sp = sn + (size_t)(wid * QBLK + r32) * 32 + d0 * 16 + hi * 8;
        const f32x4 c0 = *(const f32x4*)cp, c1 = *(const f32x4*)(cp + 4), s0 = *(const f32x4*)sp, s1 = *(const f32x4*)(sp + 4);
        float x1[8], x2[8], y1[8], y2[8];
#pragma unroll
        for (int k = 0; k < 4; ++k) { x1[2 * k] = bflo(a[k]); x1[2 * k + 1] = bfhi(a[k]); x2[2 * k] = bflo(bq[k]); x2[2 * k + 1] = bfhi(bq[k]); }
#pragma unroll
        for (int k = 0; k < 8; ++k) { const float c = k < 4 ? c0[k & 3] : c1[k & 3], s = k < 4 ? s0[k & 3] : s1[k & 3]; y1[k] = x1[k] * c - x2[k] * s; y2[k] = x2[k] * c + x1[k] * s; }
        u32x4 w1 = {cvtpk(y1[0], y1[1]), cvtpk(y1[2], y1[3]), cvtpk(y1[4], y1[5]), cvtpk(y1[6], y1[7])}, w2 = {cvtpk(y2[0], y2[1]), cvtpk(y2[2], y2[3]), cvtpk(y2[4], y2[5]), cvtpk(y2[6], y2[7])};
        *(u32x4*)(qrl + d0 * 1024) = w1; *(u32x4*)(qrl + (2 + d0) * 1024) = w2;
      } else { *(u32x4*)(qrl + d0 * 1024) = a; *(u32x4*)(qrl + (2 + d0) * 1024) = bq; }
    } }
  const int sr = tid >> 4, sc = (tid & 15) * 8, vst0 = v_st(sr, sc), vst1 = v_st(32 + sr, sc);
  const int rr_ = tid >> 3, rc = (tid & 7) * 8;
  const int vb0 = (int)(uintptr_t)V_lds + v_rd_base(lane);
  bf16x8 vs0, vs1, ks0, ks1, rs0;
  const unsigned voffKV = (unsigned)(sr * LDK + sc) * 2u, voffR = (unsigned)(rr_ * LDKR + rc) * 2u;
#define SLOAD(k0) do { const char* kb_ = (const char*)Kn + (size_t)(k0) * (LDK * 2); const char* vb_ = (const char*)Vh + (size_t)(k0) * (LDK * 2); \
    vs0 = *(const bf16x8*)(vb_ + voffKV); vs1 = *(const bf16x8*)(vb_ + 32 * LDK * 2 + voffKV); \
    ks0 = *(const bf16x8*)(kb_ + voffKV); ks1 = *(const bf16x8*)(kb_ + 32 * LDK * 2 + voffKV); \
    rs0 = *(const bf16x8*)((const char*)Kr + (size_t)(k0) * (LDKR * 2) + voffR); } while (0)
#define SWRITE(b) do { *(bf16x8*)(V_lds + (b) * SHM_V + vst0) = vs0; *(bf16x8*)(V_lds + (b) * SHM_V + vst1) = vs1; const int kc = sc * 2;  \
    *(bf16x8*)(K_lds + (b) * SHM_K + KSWZ(sr, kc)) = ks0; *(bf16x8*)(K_lds + (b) * SHM_K + KSWZ(32 + sr, kc)) = ks1;                      \
    *(bf16x8*)(R_lds + (b) * SHM_R + RSWZ(rr_, rc * 2)) = rs0; } while (0)
#define RESC(a) do { if (__any((a) < 1.f)) { if (hi == 0) al_l[r32] = (a); asm volatile("s_waitcnt lgkmcnt(0)" ::: "memory"); \
    _Pragma("unroll") for (int d = 0; d < 4; ++d) _Pragma("unroll") for (int r = 0; r < 16; ++r) o[d][r] *= al_l[crow(r, hi)]; } } while (0)
  f32x16 pA0, pA1, pB0, pB1; float mnA, mnB, alA, alB; bf16x8 pa0, pa1, pa2, pa3; const int NT = seq / KVBLK;
  SLOAD(0); SWRITE(0); __syncthreads();
  qkt(pA0, pA1, K_lds, R_lds, qr, qrl, r32, hi); partialSM(pA0, pA1, m_reg, mnA, alA);
  SLOAD(KVBLK); SWRITE(1); __syncthreads();
  for (int j = 1; j + 1 < NT; j += 2) {
    SBAR(); qkt(pB0, pB1, K_lds + SHM_K, R_lds + SHM_R, qr, qrl, r32, hi);
    finishSM(pA0, pA1, alA, l_reg, pa0, pa1, pa2, pa3); SBAR();
    SLOAD((j + 1) * KVBLK); SBAR();
    pv_d0(o, vb0, pa0, pa1, pa2, pa3); partialSM(pB0, pB1, m_reg, mnB, alB);
    __syncthreads(); SWRITE(0);
    RESC(alB); __syncthreads();
    SBAR(); qkt(pA0, pA1, K_lds, R_lds, qr, qrl, r32, hi);
    finishSM(pB0, pB1, alB, l_reg, pa0, pa1, pa2, pa3); SBAR();
    SLOAD((j + 2) * KVBLK); SBAR();
    pv_d0(o, vb0 + (int)SHM_V, pa0, pa1, pa2, pa3); partialSM(pA0, pA1, m_reg, mnA, alA);
    __syncthreads(); SWRITE(1);
    RESC(alA); __syncthreads();
  }
  SBAR(); qkt(pB0, pB1, K_lds + SHM_K, R_lds + SHM_R, qr, qrl, r32, hi);
  finishSM(pA0, pA1, alA, l_reg, pa0, pa1, pa2, pa3); SBAR();
  pv_d0(o, vb0, pa0, pa1, pa2, pa3); partialSM(pB0, pB1, m_reg, mnB, alB);
  __syncthreads(); RESC(alB);
  finishSM(pB0, pB1, alB, l_reg, pa0, pa1, pa2, pa3); SBAR();
  pv_d0(o, vb0 + (int)SHM_V, pa0, pa1, pa2, pa3);
  if (hi == 0) li_l[r32] = l_reg; asm volatile("s_waitcnt lgkmcnt(0)" ::: "memory");
  float rli[16];
#pragma unroll
  for (int r = 0; r < 16; ++r) rli[r] = __builtin_amdgcn_rcpf(li_l[crow(r, hi)]);
  bf16_t* Ow = Ob + (size_t)(wid * QBLK) * LDO;
#pragma unroll
  for (int r = 0; r < 16; ++r) { const int orow = crow(r, hi);
#pragma unroll
    for (int d0 = 0; d0 < 4; ++d0) Ow[(size_t)orow * LDO + d0 * 32 + r32] = f2bf(o[d0][r] * rli[r]); }
  __syncthreads();
#undef SLOAD
#undef SWRITE
#undef RESC
}
}

__device__ void phase_attn(PRef p, int l, char* smem) {
  const bf16_t* Q = (const bf16_t*)(p.ws + WS_Q); const bf16_t* KV = (const bf16_t*)(p.ws + WS_KV); const bf16_t* KR = (const bf16_t*)(p.ws + WS_KR);
  bf16_t* mix = (bf16_t*)(p.ws + WS_MIX); const float* cs = (const float*)(p.ws + WS_COS); const float* sn = (const float*)(p.ws + WS_SIN);
  const int nunits = 1024 + (l == 0 ? 32 : 0);
  for (int u = obid(); u < nunits; u += gridDim.x) {
    if (u < 1024) {
      const int bh = (u >> 8) * 8 + (u & 7), qb = (u & 255) >> 3, hd = bh & 3, b = bh >> 2; const size_t row0 = (size_t)b * SEQ + qb * 256;
      att::attn_body(Q + row0 * 768 + hd * 192, cs + (size_t)qb * 256 * 32, sn + (size_t)qb * 256 * 32, KV + (size_t)b * SKV * 1024 + hd * 256,
                     KV + (size_t)b * SKV * 1024 + hd * 256 + 128, KR + (size_t)b * SKV * 64, mix + row0 * 1024 + 512 + hd * 128, SKV, smem);
    } else {
      const int v = u - 1024, hd = v & 3, b = v >> 2; const size_t row0 = (size_t)MX + b * CTXL;
      att::attn_body(Q + row0 * 768 + hd * 192, nullptr, nullptr, KV + (size_t)b * SKV * 1024 + hd * 256,
                     KV + (size_t)b * SKV * 1024 + hd * 256 + 128, KR + (size_t)b * SKV * 64, mix + row0 * 1024 + 512 + hd * 128, CTXL, smem);
    }
  }
}

__device__ void phase_outproj(PRef p, int l, char* smem) {
  LAS unsigned char* lds = (LAS unsigned char*)smem;
  const bf16_t* mix = (const bf16_t*)(p.ws + WS_MIX); const bf16_t* Wt = (const bf16_t*)(p.ws + WS_WOUT) + (size_t)l * 1024 * 1024;
  float* ctxz = (float*)(p.ws + WS_CTXZ);
  const int tid = otid(), wid = tid >> 6, lane = tid & 63, wr = wid >> 2, wc = wid & 3, fr = lane & 15, fq = lane >> 4;
  g8::TileIter it; it.init(l == 0 ? MT / 256 : MX / 256, 4);
  int pm, pn;
  while (it.next(pm, pn)) {
    unsigned voffA[2] = {g8::piece_off(0, 1024, 0), g8::piece_off(1, 1024, 0)};
    f32x4 acc[2][2][4][2];
    g8::gemm_tile<false>(lds, (const char*)(mix + (size_t)pm * 256 * 1024), voffA, (size_t)128 * 1024 * 2, (const char*)(Wt + (size_t)pn * 256 * 1024), 1024, acc);
    ACC_FOR(ai, bj, m, n) {
      const int row = pm * 256 + ai * 128 + wr * 64 + m * 16 + fr, col = pn * 256 + bj * 128 + wc * 32 + fq * 8 + n * 4;
      const float* res = l == 0 ? (row < MX ? p.x + (size_t)row * 1024 : p.ctx + (size_t)(row - MX) * 1024) : p.out + (size_t)row * 1024;
      float* dst = row < MX ? p.out + (size_t)row * 1024 : ctxz + (size_t)(row - MX) * 1024;
      const f32x4 r = *(const f32x4*)(res + col), g = *(const f32x4*)(mod_ptr(p, l, row, 2) + col);
      *(f32x4*)(dst + col) = r * ALPHA + g * acc[ai][bj][m][n];
    }
  }
}

__device__ void phase_ln1(PRef p, int l, char* smem) {
  float* wrt = (float*)smem;
  for (int i = otid(); i < 16384; i += 512) wrt[(i & 15) * 1024 + (i >> 4)] = p.w_router[(size_t)l * 16384 + i];
  __syncthreads();
  const int lane = otid() & 63, gw = obid() * 8 + (otid() >> 6), nw = gridDim.x * 8;
  bf16_t* h = (bf16_t*)(p.ws + WS_H); float* ctxz = (float*)(p.ws + WS_CTXZ); float* aff = (float*)(p.ws + WS_AFF);
  const int nrows = l == 0 ? MT : MX;
  for (int row = gw; row < nrows; row += nw) {
    asm volatile("" ::: "memory");
    float* zr = row < MX ? p.out + (size_t)row * 1024 : ctxz + (size_t)(row - MX) * 1024;
    f32x4 v[4];
#pragma unroll
    for (int i = 0; i < 4; ++i) v[i] = *(const f32x4*)(zr + lane * 4 + 256 * i);
    ln_row(v, 1e-5f);
#pragma unroll
    for (int i = 0; i < 4; ++i) { const int c = lane * 4 + 256 * i; v[i] = v[i] * *(const f32x4*)(p.ln1_g + l * 1024 + c) + *(const f32x4*)(p.ln1_b + l * 1024 + c); *(f32x4*)(zr + c) = v[i]; }
    ln_row(v, 1e-6f);
    f32x4 hm[4];
    store_mod_bf16(v, mod_ptr(p, l, row, 3), mod_ptr(p, l, row, 4), h + (size_t)row * 1024, lane, &hm);
    float lg[16];
#pragma unroll
    for (int e = 0; e < 16; ++e) { float s = 0.f;
#pragma unroll
      for (int i = 0; i < 4; ++i) { const f32x4 w = *(const f32x4*)(wrt + e * 1024 + lane * 4 + 256 * i); s += hm[i][0] * w[0] + hm[i][1] * w[1] + hm[i][2] * w[2] + hm[i][3] * w[3]; }
      lg[e] = wave_sum(s); }
    float mx = lg[0];
#pragma unroll
    for (int e = 1; e < 16; ++e) mx = fmaxf(mx, lg[e]);
    float den = 0.f;
#pragma unroll
    for (int e = 0; e < 16; ++e) { lg[e] = expf(lg[e] - mx); den += lg[e]; }
    float mine = 0.f;
#pragma unroll
    for (int e = 0; e < 16; ++e) if (lane == e) mine = lg[e] / den;
    if (lane < 16) aff[(size_t)row * 16 + lane] = mine;
  }
}

template <int PER>
__device__ __forceinline__ void topk_item(const float* __restrict__ affp, int n, int kcap, int rowbase, int slotbase, int e, int* __restrict__ IDX, float* __restrict__ GV, int* __restrict__ TS, char* smem) {
  unsigned* hist = (unsigned*)smem; unsigned* sel = hist + 256; unsigned* wtot = hist + 272;
  const int tid = otid(), lane = tid & 63, wid = tid >> 6;
  const bool active = tid * PER < n;
  unsigned key[PER];
#pragma unroll
  for (int i = 0; i < PER; ++i) key[i] = active ? __float_as_uint(affp[(size_t)(tid * PER + i) * 16]) : 0u;
  unsigned prefix = 0u, mask = 0u; int kk = kcap;
#pragma unroll 1
  for (int shift = 24; shift >= 0; shift -= 8) {
    __syncthreads();
    if (tid < 256) hist[tid] = 0u;
    __syncthreads();
#pragma unroll
    for (int i = 0; i < PER; ++i) if (active && (key[i] & mask) == prefix) atomicAdd(&hist[(key[i] >> shift) & 255u], 1u);
    __syncthreads();
    if (wid == 0) {
      const unsigned h0 = hist[lane * 4], h1 = hist[lane * 4 + 1], h2 = hist[lane * 4 + 2], h3 = hist[lane * 4 + 3];
      const unsigned tot = h0 + h1 + h2 + h3; unsigned suf = tot;
#pragma unroll
      for (int o = 1; o < 64; o <<= 1) { const unsigned u = __shfl_down(suf, o); if (lane + o < 64) suf += u; }
      const unsigned above = suf - tot;
      if (above < (unsigned)kk && suf >= (unsigned)kk) {
        unsigned a = above; int bin;
        if (a + h3 >= (unsigned)kk) bin = 3; else { a += h3; if (a + h2 >= (unsigned)kk) bin = 2; else { a += h2; if (a + h1 >= (unsigned)kk) bin = 1; else { a += h1; bin = 0; } } }
        sel[0] = prefix | ((unsigned)(lane * 4 + bin) << shift); sel[1] = (unsigned)kk - a;
      }
    }
    __syncthreads();
    prefix = sel[0]; kk = (int)sel[1]; mask |= 0xffu << shift;
  }
  const unsigned Tk = prefix;
  unsigned cg_ = 0, ce = 0;
#pragma unroll
  for (int i = 0; i < PER; ++i) { cg_ += key[i] > Tk; ce += key[i] == Tk; }
  unsigned pk = active ? (cg_ | (ce << 16)) : 0u, inc = pk;
#pragma unroll
  for (int o = 1; o < 64; o <<= 1) { const unsigned u = __shfl_up(inc, o); if (lane >= o) inc += u; }
  __syncthreads();
  if (lane == 63) wtot[wid] = inc;
  __syncthreads();
  unsigned base = 0;
  for (int w2 = 0; w2 < wid; ++w2) base += wtot[w2];
  const unsigned exc = base + inc - pk; unsigned gt_before = exc & 0xffffu, eq_before = exc >> 16;
  if (active) {
#pragma unroll
    for (int i = 0; i < PER; ++i) {
      const int t = tid * PER + i; int R = -1;
      const bool isgt = key[i] > Tk, iseq = key[i] == Tk;
      if (isgt || (iseq && (int)eq_before < kk)) {
        const int slot = (int)gt_before + min((int)eq_before, kk);
        R = slotbase + slot; IDX[R] = rowbase + t; GV[R] = __uint_as_float(key[i]);
      }
      TS[t] = R;
      gt_before += isgt; eq_before += iseq;
    }
  }
}
__device__ void phase_topk(PRef p, int l, char* smem) {
  const float* aff = (const float*)(p.ws + WS_AFF); int* IDX = (int*)(p.ws + WS_IDX); float* GV = (float*)(p.ws + WS_GV); int* TS = (int*)(p.ws + WS_TS);
  const int nitems = l == 0 ? 256 : 128;
  for (int it = obid(); it < nitems; it += gridDim.x) {
    if (it < 128) { const int b = it >> 4, e = it & 15; topk_item<16>(aff + (size_t)b * SEQ * 16 + e, SEQ, CAPX, b * SEQ, it * CAPX, e, IDX, GV, TS + (size_t)it * SEQ, smem); }
    else { const int v = it - 128, b = v >> 4, e = v & 15; topk_item<1>(aff + ((size_t)MX + b * CTXL) * 16 + e, CTXL, CAPC, MX + b * CTXL, NB * NE * CAPX + e * 256 + b * CAPC, e, IDX, GV, TS + (size_t)NB * 16 * SEQ + (size_t)v * CTXL, smem); }
  }
  __syncthreads();
}

__device__ void phase_moe_up(PRef p, int l, char* smem) {
  LAS unsigned char* lds = (LAS unsigned char*)smem;
  const bf16_t* h = (const bf16_t*)(p.ws + WS_H); const bf16_t* Wgu = (const bf16_t*)(p.ws + WS_WGU); bf16_t* act = (bf16_t*)(p.ws + WS_ACT); const int* IDX = (const int*)(p.ws + WS_IDX);
  const int tid = otid(), wid = tid >> 6, lane = tid & 63, wr = wid >> 2, wc = wid & 3, fr = lane & 15, fq = lane >> 4;
  g8::MoeIter it; it.init(8, l == 0);
  int pm, pn, e;
  while (it.next(pm, pn, e)) {
    unsigned voffA[4];
#pragma unroll
    for (int hh = 0; hh < 2; ++hh)
#pragma unroll
      for (int i = 0; i < 2; ++i) { int R, C; g8::piece_rc(i, R, C); voffA[hh * 2 + i] = (unsigned)(IDX[pm * 256 + hh * 128 + R] * 1024 + C) * 2u; }
    f32x4 acc[2][2][4][2];
    g8::gemm_tile<true>(lds, (const char*)h, voffA, 0, (const char*)(Wgu + ((size_t)e * 2048 + pn * 256) * 1024), 1024, acc);
#pragma unroll
    for (int ai = 0; ai < 2; ++ai)
#pragma unroll
      for (int m = 0; m < 4; ++m) {
          const int row = pm * 256 + ai * 128 + wr * 64 + m * 16 + fr, col = pn * 128 + wc * 32 + fq * 8;
          float a[8];
#pragma unroll
          for (int n = 0; n < 2; ++n) { const f32x4 g = acc[ai][0][m][n], u = acc[ai][1][m][n];
#pragma unroll
            for (int k = 0; k < 4; ++k) a[n * 4 + k] = silu_f(g[k]) * u[k]; }
          u32x4 w = {cvtpk(a[0], a[1]), cvtpk(a[2], a[3]), cvtpk(a[4], a[5]), cvtpk(a[6], a[7])}; *(u32x4*)(act + (size_t)row * 1024 + col) = w;
        }
  }
}
__device__ void phase_moe_down(PRef p, int l, char* smem) {
  LAS unsigned char* lds = (LAS unsigned char*)smem;
  const bf16_t* act = (const bf16_t*)(p.ws + WS_ACT); const bf16_t* Wdn = (const bf16_t*)(p.ws + WS_WDN); bf16_t* oute = (bf16_t*)(p.ws + WS_OUTE); const float* GV = (const float*)(p.ws + WS_GV);
  const int tid = otid(), wid = tid >> 6, lane = tid & 63, wr = wid >> 2, wc = wid & 3, fr = lane & 15, fq = lane >> 4;
  g8::MoeIter it; it.init(4, l == 0);
  int pm, pn, e;
  while (it.next(pm, pn, e)) {
    unsigned voffA[2] = {g8::piece_off(0, 1024, 0), g8::piece_off(1, 1024, 0)};
    f32x4 acc[2][2][4][2];
    g8::gemm_tile<false>(lds, (const char*)(act + (size_t)pm * 256 * 1024), voffA, (size_t)128 * 1024 * 2, (const char*)(Wdn + ((size_t)e * 1024 + pn * 256) * 1024), 1024, acc);
    ACC_FOR3(ai, bj, m) {
      const int row = pm * 256 + ai * 128 + wr * 64 + m * 16 + fr, col = pn * 256 + bj * 128 + wc * 32 + fq * 8;
      const float gv = GV[row]; const f32x4 v0 = acc[ai][bj][m][0] * gv, v1 = acc[ai][bj][m][1] * gv;
      u32x4 w = {cvtpk(v0[0], v0[1]), cvtpk(v0[2], v0[3]), cvtpk(v1[0], v1[1]), cvtpk(v1[2], v1[3])}; *(u32x4*)(oute + (size_t)row * 1024 + col) = w;
    }
  }
}

__device__ void phase_ln2(PRef p, int l) {
  const int lane = otid() & 63, gw = obid() * 8 + (otid() >> 6), nw = gridDim.x * 8;
  bf16_t* h = (bf16_t*)(p.ws + WS_H); float* ctxz = (float*)(p.ws + WS_CTXZ); const bf16_t* oute = (const bf16_t*)(p.ws + WS_OUTE); const int* TS = (const int*)(p.ws + WS_TS);
  const int nrows = l == 0 ? MT : MX;
  for (int row = gw; row < nrows; row += nw) {
    float* xr = row < MX ? p.out + (size_t)row * 1024 : ctxz + (size_t)(row - MX) * 1024;
    f32x4 mo[4];
#pragma unroll
    for (int i = 0; i < 4; ++i) mo[i] = (f32x4){0.f, 0.f, 0.f, 0.f};
    const int myR = lane < 16 ? (row < MX ? TS[((size_t)(row >> 13) * 16 + lane) * SEQ + (row & 8191)] : TS[(size_t)NB * 16 * SEQ + ((size_t)((row - MX) >> 8) * 16 + lane) * CTXL + ((row - MX) & 255)]) : -1;
    for (int e = 0; e < 16; ++e) { const int Rr = __shfl(myR, e);
      if (Rr >= 0) {
#pragma unroll
        for (int i = 0; i < 4; ++i) { const u32x2 w = *(const u32x2*)(oute + (size_t)Rr * 1024 + lane * 4 + 256 * i);
          mo[i][0] += bflo(w[0]); mo[i][1] += bfhi(w[0]); mo[i][2] += bflo(w[1]); mo[i][3] += bfhi(w[1]); } } }
    f32x4 v[4]; const float* m5 = mod_ptr(p, l, row, 5);
#pragma unroll
    for (int i = 0; i < 4; ++i) { const int c = lane * 4 + 256 * i; v[i] = *(const f32x4*)(xr + c) * ALPHA + *(const f32x4*)(m5 + c) * mo[i]; }
    ln_row(v, 1e-5f);
#pragma unroll
    for (int i = 0; i < 4; ++i) { const int c = lane * 4 + 256 * i; v[i] = v[i] * *(const f32x4*)(p.ln2_g + l * 1024 + c) + *(const f32x4*)(p.ln2_b + l * 1024 + c); *(f32x4*)(xr + c) = v[i]; }
    if (l + 1 < DEPTH) { ln_row(v, 1e-6f); store_mod_bf16(v, mod_ptr(p, l + 1, row, 0), mod_ptr(p, l + 1, row, 1), h + (size_t)row * 1024, lane, nullptr); }
  }
}

__device__ __forceinline__ void gsync(cg::grid_group& grid) {
  asm volatile("s_waitcnt vmcnt(0) lgkmcnt(0)" ::: "memory");
  grid.sync();
}
__global__ void __launch_bounds__(512) mega(Params p) {
  extern __shared__ __attribute__((aligned(16))) char smem[];
  cg::grid_group grid = cg::this_grid();
  phase_prep(kparams(), smem);
  gsync(grid);
  phase_h0(kparams());
  gsync(grid);
#pragma unroll 1
  for (int l = 0; l < DEPTH; ++l) {
    phase_inproj(kparams(), l, smem);
    gsync(grid);
    phase_mlstm_pre(kparams(), l, smem);
    gsync(grid);
    phase_mlstm(kparams(), l, smem);
    gsync(grid);
    phase_mla_prep(kparams(), l, smem);
    gsync(grid);
    phase_attn(kparams(), l, smem);
    gsync(grid);
    phase_outproj(kparams(), l, smem);
    gsync(grid);
    phase_ln1(kparams(), l, smem);
    __syncthreads();
    phase_cvt_experts(kparams(), l, smem);
    gsync(grid);
    phase_topk(kparams(), l, smem);
    gsync(grid);
    phase_moe_up(kparams(), l, smem);
    gsync(grid);
    phase_moe_down(kparams(), l, smem);
    gsync(grid);
    phase_ln2(kparams(), l);
    gsync(grid);
  }
}

extern "C" void kernel_launch(void* const* d_in, const int* in_sizes, int n_in, void* d_out, int out_size,
                              void* d_ws, size_t ws_size, hipStream_t stream) {
  constexpr size_t kDynLds = 160 * 1024;
  static int grid_blocks = 0;
  if (!grid_blocks) {
    int dev = 0, cus = 0, per_cu = 0;
    (void)hipGetDevice(&dev);
    (void)hipDeviceGetAttribute(&cus, hipDeviceAttributeMultiprocessorCount, dev);
    (void)hipFuncSetAttribute((const void*)mega, hipFuncAttributeMaxDynamicSharedMemorySize, (int)kDynLds);
    (void)hipOccupancyMaxActiveBlocksPerMultiprocessor(&per_cu, mega, 512, kDynLds);
    grid_blocks = per_cu > 0 ? cus : 0;
    if (grid_blocks > 256) grid_blocks = 256;
    grid_blocks &= ~7;
    if (grid_blocks != 256) { fprintf(stderr, "this kernel needs 256 co-resident workgroups (got %d)\n", grid_blocks); grid_blocks = 0; }
    if (ws_size < WS_END) { fprintf(stderr, "workspace too small: %zu < %zu\n", ws_size, (size_t)WS_END); grid_blocks = 0; }
  }
  if (grid_blocks <= 0) return;
  Params p{};
  const float** pp = (const float**)&p;
  for (int i = 0; i < 24; ++i) pp[i] = (const float*)d_in[i];
  p.out = (float*)d_out; p.ws = (char*)d_ws;
  void* args[] = {&p};
  hipError_t e = hipLaunchCooperativeKernel((void*)mega, dim3(grid_blocks), dim3(512), args, kDynLds, stream);
  if (e != hipSuccess) fprintf(stderr, "cooperative launch failed: %s (grid %d)\n", hipGetErrorString(e), grid_blocks);
}
```

```cpp
#include <hip/hip_runtime.h>
#include <hip/hip_cooperative_groups.h>
#include <cstdio>
#include <cstdint>
namespace cg = cooperative_groups;

typedef unsigned short bf16_t;
typedef short bf16x8 __attribute__((ext_vector_type(8)));
typedef short s16x4 __attribute__((ext_vector_type(4)));
typedef float f32x4 __attribute__((ext_vector_type(4)));
typedef float f32x16 __attribute__((ext_vector_type(16)));
typedef unsigned u32x4 __attribute__((ext_vector_type(4)));
typedef unsigned u32x2 __attribute__((ext_vector_type(2)));
#define LAS __attribute__((address_space(3)))

constexpr int DM = 1024, NB = 8, SEQ = 8192, CTXL = 256, DEPTH = 2;
constexpr int MX = NB * SEQ, MC = NB * CTXL, MT = MX + MC;
constexpr int PLD = 2816;
constexpr int OFF_Q = 0, OFF_K = 512, OFF_V = 1024, OFF_O = 1536, OFF_G = 2048, OFF_CQ = 2064, OFF_CKV = 2448, OFF_KR = 2704, IN_COLS = 2768;
constexpr int SKV = SEQ + CTXL;
constexpr int NE = 16, CAPX = 1024, CAPC = 32;
constexpr int NSLOT = NB * NE * CAPX + NB * NE * CAPC;
constexpr float ALPHA = 1.4142135623730951f;
constexpr float A_SCALE = 0.07216878364870322f;

constexpr size_t al256(size_t v) { return (v + 255) / 256 * 256; }
constexpr size_t WS_H = 0;
constexpr size_t WS_P = WS_H + al256((size_t)MT * 1024 * 2);
constexpr size_t WS_Q = WS_P + al256((size_t)MT * PLD * 2);
constexpr size_t WS_KV = WS_Q + al256((size_t)MT * 768 * 2);
constexpr size_t WS_KR = WS_KV + al256((size_t)NB * SKV * 1024 * 2);
constexpr size_t WS_MIX = WS_KR + al256((size_t)NB * SKV * 64 * 2);
constexpr size_t WS_ACT = WS_P;
constexpr size_t WS_HB = WS_H;
constexpr size_t WS_OUTE = WS_P + al256((size_t)NSLOT * 1024 * 2);
constexpr size_t WS_WGU = WS_MIX;
constexpr size_t WS_WDN = WS_MIX + (size_t)NE * 2048 * 1024 * 2;
constexpr size_t WS_WIN = WS_MIX + al256((size_t)MT * 1024 * 2);
constexpr size_t WS_WUQ = WS_WIN + (size_t)2 * PLD * 1024 * 2;
constexpr size_t WS_WUKV = WS_WUQ + (size_t)2 * 768 * 384 * 2;
constexpr size_t WS_WOUT = WS_WUKV + (size_t)2 * 1024 * 256 * 2;
constexpr size_t WS_MOD = WS_WOUT + (size_t)2 * 1024 * 1024 * 2;
constexpr size_t WS_COS = WS_MOD + al256((size_t)2 * 9 * 6144 * 4);
constexpr size_t WS_SIN = WS_COS + (size_t)SEQ * 32 * 4;
constexpr size_t WS_GATES = WS_SIN + (size_t)SEQ * 32 * 4;
constexpr size_t WS_AFF = WS_GATES + (size_t)MT * 16 * 4;
constexpr size_t WS_IDX = WS_AFF + (size_t)MT * 16 * 4;
constexpr size_t WS_GV = WS_IDX + (size_t)NSLOT * 4;
constexpr size_t WS_TS = WS_GV + (size_t)NSLOT * 4;
constexpr size_t WS_CTXZ = WS_TS + (size_t)MT * 16 * 4;
constexpr size_t WS_END = WS_CTXZ + (size_t)MC * 1024 * 4;
static_assert(WS_OUTE + (size_t)NSLOT * 1024 * 2 <= WS_KR, "out_e overlay");
static_assert(WS_WDN + (size_t)NE * 1024 * 1024 * 2 <= WS_WIN, "expert weights overlay");

struct Params {
  const float *x, *c, *ctx, *c_ctx, *w_mod, *b_mod, *w_in, *b_gates, *conv_w, *conv_b, *m_norm_w, *q_norm_w, *kv_norm_w, *w_uq, *w_ukv, *w_out,
      *ln1_g, *ln1_b, *w_router, *w_gate, *w_up, *w_down, *ln2_g, *ln2_b;
  float* out; char* ws;
};

typedef const __attribute__((address_space(4))) Params& PRef;
__device__ __forceinline__ PRef kparams() { const __attribute__((address_space(4))) Params* kp = (const __attribute__((address_space(4))) Params*)__builtin_amdgcn_kernarg_segment_ptr(); asm volatile("" : "+s"(kp)); return *kp; }
__device__ __forceinline__ int otid() { int t = threadIdx.x; asm volatile("" : "+v"(t)); return t; }
__device__ __forceinline__ int obid() { int t = blockIdx.x; asm volatile("" : "+s"(t)); return t; }
__device__ __forceinline__ int opaque_s(int v) { asm volatile("" : "+s"(v)); return v; }
typedef __bf16 bf16v2_t __attribute__((ext_vector_type(2)));
typedef float f32x2_t __attribute__((ext_vector_type(2)));
__device__ __forceinline__ unsigned cvtpk(float lo, float hi) { const f32x2_t f = {lo, hi}; const bf16v2_t b = __builtin_convertvector(f, bf16v2_t); return __builtin_bit_cast(unsigned, b); }
__device__ __forceinline__ bf16_t f2bf(float v) { return (bf16_t)(cvtpk(v, v) & 0xffffu); }
__device__ __forceinline__ float bf2f(unsigned v) { return __uint_as_float(v << 16); }
__device__ __forceinline__ float bflo(unsigned w) { return __uint_as_float(w << 16); }
__device__ __forceinline__ float bfhi(unsigned w) { return __uint_as_float(w & 0xffff0000u); }
__device__ __forceinline__ float wave_sum(float v) { for (int o = 32; o > 0; o >>= 1) v += __shfl_xor(v, o); return v; }
__device__ __forceinline__ float wave_max(float v) { for (int o = 32; o > 0; o >>= 1) v = fmaxf(v, __shfl_xor(v, o)); return v; }
__device__ __forceinline__ float sigmoid_f(float v) { return __builtin_amdgcn_rcpf(1.f + __expf(-v)); }
__device__ __forceinline__ float silu_f(float v) { return v * sigmoid_f(v); }

namespace g8 {
constexpr int BK = 64, HALF = 128, HTB = HALF * BK * 2, STAGE_BYTES = 8 * HTB;
__device__ __forceinline__ int lds_byte(int r, int c) { const int st = (r >> 4) * 2 + (c >> 5), rr = r & 15, cc = c & 31, ob = rr * 64 + cc * 2; return st * 1024 + (ob ^ (((ob >> 9) & 1) << 5)); }
__device__ __forceinline__ int perm32(int rho) { const int n = rho >> 4, i = rho & 15; return 8 * (i >> 2) + 4 * n + (i & 3); }
__device__ __forceinline__ void stage_rc(int b, int& R, int& C) { const int st = b / 1024, sb = b % 1024, swz = sb ^ (((sb >> 9) & 1) << 5); R = (st >> 1) * 16 + swz / 64; C = (st & 1) * 32 + (swz % 64) / 2; }

template <bool GATHER>
__device__ __forceinline__ void gemm_tile(LAS unsigned char* lds, const char* __restrict__ Ab, const unsigned (&voffA)[GATHER ? 4 : 2], size_t hstepA, const char* __restrict__ Bb, int K,
                                          f32x4 (&acc)[2][2][4][2]) {
  const int tid = otid(), wid = __builtin_amdgcn_readfirstlane(tid >> 6), lane = tid & 63, wr = wid >> 2, wc = wid & 3, fr = lane & 15, fq = lane >> 4;
  const int nt = K / BK;
  unsigned voffB[2];
#pragma unroll
  for (int i = 0; i < 2; ++i) { int R, C; stage_rc(tid * 16 + i * 8192, R, C); const int Rb = (R & ~31) + perm32(R & 31); voffB[i] = (unsigned)(Rb * K + C) * 2u; }
  const char* Bb1 = Bb + (size_t)HALF * K * 2; const char* Ab1 = GATHER ? Ab : Ab + hstepA;
  const unsigned* vA0 = &voffA[0]; const unsigned* vA1 = GATHER ? &voffA[2] : &voffA[0];
  const unsigned ldsw = (unsigned)wid * 1024u;
  const int aoff = lds_byte(wr * 64 + fr, fq * 8), boff = lds_byte(wc * 32 + fr, fq * 8);
#define G8_SA(b, h) (((b) * 2 + (h)) * HTB)
#define G8_SB(b, h) ((4 + (b) * 2 + (h)) * HTB)
#define G8_STAGE(bufoff, gbase, voff, kt) do { _Pragma("unroll") for (int _i = 0; _i < 2; ++_i) \
    __builtin_amdgcn_global_load_lds((const unsigned*)((gbase) + (size_t)(kt) * (BK * 2) + (voff)[_i]), (LAS unsigned*)(lds + (bufoff) + ldsw + _i * 8192), 16, 0, 0); } while (0)
#define G8_LDA(dst, b, h) do { _Pragma("unroll") for (int m = 0; m < 4; ++m) _Pragma("unroll") for (int k = 0; k < 2; ++k) dst[m][k] = *(const LAS bf16x8*)(lds + G8_SA(b, h) + aoff + m * 2048 + k * 1024); } while (0)
#define G8_LDB(dst, b, h) do { _Pragma("unroll") for (int n = 0; n < 2; ++n) _Pragma("unroll") for (int k = 0; k < 2; ++k) dst[n][k] = *(const LAS bf16x8*)(lds + G8_SB(b, h) + boff + n * 2048 + k * 1024); } while (0)
#define G8_MMA(ai, bj, At, Bt) do { __builtin_amdgcn_s_setprio(1); _Pragma("unroll") for (int m = 0; m < 4; ++m) _Pragma("unroll") for (int n = 0; n < 2; ++n) _Pragma("unroll") for (int k = 0; k < 2; ++k) \
    acc[ai][bj][m][n] = __builtin_amdgcn_mfma_f32_16x16x32_bf16(Bt[n][k], At[m][k], acc[ai][bj][m][n], 0, 0, 0); __builtin_amdgcn_s_setprio(0); } while (0)
#define G8_WAIT_V(n) asm volatile("s_waitcnt vmcnt(" #n ")" ::: "memory")
#define G8_WAIT_L(n) asm volatile("s_waitcnt lgkmcnt(" #n ")" ::: "memory")
#define G8_BAR __builtin_amdgcn_s_barrier()
#define G8_SCHED __builtin_amdgcn_sched_barrier(0)
#pragma unroll
  for (int a = 0; a < 2; ++a)
#pragma unroll
    for (int b = 0; b < 2; ++b)
#pragma unroll
      for (int m = 0; m < 4; ++m)
#pragma unroll
        for (int n = 0; n < 2; ++n) acc[a][b][m][n] = (f32x4){0.f, 0.f, 0.f, 0.f};
  bf16x8 At[4][2], B0[2][2], B1[2][2];
  G8_WAIT_V(0); __syncthreads();
  G8_STAGE(G8_SB(0, 0), Bb, voffB, 0); G8_STAGE(G8_SA(0, 0), Ab, vA0, 0); G8_STAGE(G8_SB(0, 1), Bb1, voffB, 0); G8_STAGE(G8_SA(0, 1), Ab1, vA1, 0);
  if (wr == 1) G8_BAR;
  G8_WAIT_V(4); G8_BAR;
  G8_STAGE(G8_SB(1, 0), Bb, voffB, 1); G8_STAGE(G8_SA(1, 0), Ab, vA0, 1); G8_STAGE(G8_SB(1, 1), Bb1, voffB, 1);
  G8_WAIT_V(6); G8_BAR;
  for (int t = 0; t < nt - 2; t += 2) {
    G8_LDB(B0, 0, 0); G8_SCHED; G8_LDA(At, 0, 0); G8_STAGE(G8_SA(1, 1), Ab1, vA1, t + 1);
    G8_WAIT_L(8); G8_BAR; G8_WAIT_L(0); G8_MMA(0, 0, At, B0); G8_BAR; G8_SCHED;
    G8_LDB(B1, 0, 1); G8_STAGE(G8_SB(0, 0), Bb, voffB, t + 2);
    G8_BAR; G8_WAIT_L(0); G8_MMA(0, 1, At, B1); G8_BAR;
    G8_LDA(At, 0, 1); G8_STAGE(G8_SA(0, 0), Ab, vA0, t + 2);
    G8_BAR; G8_WAIT_L(0); G8_MMA(1, 0, At, B0); G8_BAR; G8_SCHED;
    G8_STAGE(G8_SB(0, 1), Bb1, voffB, t + 2);
    G8_WAIT_V(6); G8_BAR; G8_MMA(1, 1, At, B1); G8_BAR;
    G8_LDB(B0, 1, 0); G8_SCHED; G8_LDA(At, 1, 0); G8_STAGE(G8_SA(0, 1), Ab1, vA1, t + 2);
    G8_WAIT_L(8); G8_BAR; G8_WAIT_L(0); G8_MMA(0, 0, At, B0); G8_BAR; G8_SCHED;
    G8_LDB(B1, 1, 1); G8_STAGE(G8_SB(1, 0), Bb, voffB, t + 3);
    G8_BAR; G8_WAIT_L(0); G8_MMA(0, 1, At, B1); G8_BAR;
    G8_LDA(At, 1, 1); G8_STAGE(G8_SA(1, 0), Ab, vA0, t + 3);
    G8_BAR; G8_WAIT_L(0); G8_MMA(1, 0, At, B0); G8_BAR; G8_SCHED;
    G8_STAGE(G8_SB(1, 1), Bb1, voffB, t + 3);
    G8_WAIT_V(6); G8_BAR; G8_MMA(1, 1, At, B1); G8_BAR;
  }
  { G8_LDB(B0, 0, 0); G8_LDA(At, 0, 0); G8_STAGE(G8_SA(1, 1), Ab1, vA1, nt - 1);
    G8_BAR; G8_WAIT_L(0); G8_MMA(0, 0, At, B0); G8_BAR;
    G8_LDB(B1, 0, 1); G8_BAR; G8_WAIT_L(0); G8_MMA(0, 1, At, B1); G8_BAR;
    G8_LDA(At, 0, 1); G8_WAIT_V(4); G8_BAR; G8_WAIT_L(0); G8_MMA(1, 0, At, B0); G8_MMA(1, 1, At, B1); G8_BAR; }
  { G8_LDB(B0, 1, 0); G8_LDA(At, 1, 0); G8_WAIT_V(2); G8_BAR; G8_WAIT_L(0); G8_MMA(0, 0, At, B0); G8_BAR;
    G8_LDB(B1, 1, 1); G8_WAIT_V(0); G8_BAR; G8_WAIT_L(0); G8_MMA(0, 1, At, B1); G8_BAR;
    G8_LDA(At, 1, 1); G8_BAR; G8_WAIT_L(0); G8_MMA(1, 0, At, B0); G8_MMA(1, 1, At, B1); G8_BAR; }
  if (wr == 0) G8_BAR;
}
__device__ __forceinline__ unsigned piece_off(int i, int ld, int c0) { int R, C; stage_rc((int)otid() * 16 + i * 8192, R, C); return (unsigned)(R * ld + c0 + C) * 2u; }
__device__ __forceinline__ void piece_rc(int i, int& R, int& C) { stage_rc((int)otid() * 16 + i * 8192, R, C); }
struct TileIter {
  int nM, nN, x, j, J, cnt, idx;
  __device__ __forceinline__ void init(int nM_, int nN_) { nM = nM_; nN = nN_; x = obid() & 7; j = obid() >> 3; J = gridDim.x >> 3; cnt = ((nM - x + 7) >> 3) * nN; idx = j; }
  __device__ __forceinline__ bool next(int& pm, int& pn) { if (idx >= cnt) return false; pm = x + 8 * (idx / nN); pn = idx % nN; idx += J; return true; }
};
struct MoeIter {
  int nN, x, jm, jn, j, step, nsteps, nb4; bool with_ctx, ctx_done, wide;
  __device__ __forceinline__ void init(int nN_, bool with_ctx_) { nN = nN_; with_ctx = with_ctx_; wide = nN_ == 8; x = obid() & 7; j = obid() >> 3;
    if (wide) { jm = j & 3; jn = j >> 2; nsteps = 16; } else { jm = j & 7; jn = j >> 3; nsteps = 2 * (nN >> 2) * 4; }
    nb4 = nN >> 2; step = 0; ctx_done = false; }
  __device__ __forceinline__ bool next(int& pm, int& pn, int& e) {
    if (step < nsteps) {
      int m32;
      if (wide) { const int mb = step & 7, el = step >> 3; e = 2 * x + el; m32 = mb * 4 + jm; pn = jn; }
      else { const int mb = step & 3, nb = (step >> 2) % nb4, el = (step >> 2) / nb4; e = 2 * x + el; m32 = mb * 8 + jm; pn = nb * 4 + jn; }
      pm = ((m32 >> 2) * 16 + e) * 4 + (m32 & 3); ++step; return true; }
    if (with_ctx && !ctx_done) { ctx_done = true; if (j < 2 * nN) { e = 2 * x + j / nN; pm = 512 + e; pn = j % nN; return true; } }
    return false;
  }
};
}

#define ACC_FOR3(ai, bj, m) _Pragma("unroll") for (int ai = 0; ai < 2; ++ai) _Pragma("unroll") for (int bj = 0; bj < 2; ++bj) _Pragma("unroll") for (int m = 0; m < 4; ++m)
#define ACC_FOR(ai, bj, m, n) _Pragma("unroll") for (int ai = 0; ai < 2; ++ai) _Pragma("unroll") for (int bj = 0; bj < 2; ++bj) _Pragma("unroll") for (int m = 0; m < 4; ++m) _Pragma("unroll") for (int n = 0; n < 2; ++n)

__device__ __forceinline__ void cvt_tile(const float* __restrict__ src, int N, int K, int k0, int n0, bf16_t* __restrict__ dst, long drow0, const float* __restrict__ kscale, float* lds) {
  const int tid = otid();
  { const int kr = tid >> 6, n = tid & 63;
#pragma unroll
    for (int i = 0; i < 8; ++i) { const int k = kr + 8 * i; float v = (n0 + n < N) ? src[(size_t)(k0 + k) * N + n0 + n] : 0.f; if (kscale) v *= kscale[k0 + k]; lds[k * 65 + n] = v; } }
  __syncthreads();
  { const int n = tid >> 3, k8 = (tid & 7) * 8; float v[8];
#pragma unroll
    for (int i = 0; i < 8; ++i) v[i] = lds[(k8 + i) * 65 + n];
    u32x4 w = {cvtpk(v[0], v[1]), cvtpk(v[2], v[3]), cvtpk(v[4], v[5]), cvtpk(v[6], v[7])};
    *(u32x4*)(dst + (size_t)(drow0 + n) * K + k0 + k8) = w; }
  __syncthreads();
}

__device__ void phase_prep(PRef p, char* smem) {
  float* lds = (float*)smem;
  bf16_t* Wt_in = (bf16_t*)(p.ws + WS_WIN); bf16_t* Wt_uq = (bf16_t*)(p.ws + WS_WUQ); bf16_t* Wt_ukv = (bf16_t*)(p.ws + WS_WUKV); bf16_t* Wt_out = (bf16_t*)(p.ws + WS_WOUT);
  float* mod = (float*)(p.ws + WS_MOD);
  constexpr int T_MOD = 192, T_IN = 2 * 16 * 44, T_UQ = 2 * 6 * 12, T_UKV = 2 * 4 * 16, T_OUT = 2 * 16 * 16, T_ROPE = 64;
  constexpr int E0 = T_MOD, E1 = E0 + T_IN, E2 = E1 + T_UQ, E3 = E2 + T_UKV, E4 = E3 + T_OUT, E5 = E4 + T_ROPE;
  const int tid = otid();
  for (int task = obid(); task < E5; task += gridDim.x) {
    if (task < E0) {
      const int l = task / 96, j0 = (task % 96) * 64;
      float* sc = lds;
      for (int i = tid; i < 9 * 1024; i += 512) { const int bb = i >> 10, d = i & 1023; const float v = bb < 8 ? p.c[bb * 1024 + d] : p.c_ctx[d]; sc[i] = v / (1.f + expf(-v)); }
      __syncthreads();
      const int col = tid & 63, ks = tid >> 6; float a[9];
#pragma unroll
      for (int bb = 0; bb < 9; ++bb) a[bb] = 0.f;
      const float* wm = p.w_mod + (size_t)l * 1024 * 6144 + j0 + col;
      for (int d = ks * 128; d < ks * 128 + 128; ++d) { const float w = wm[(size_t)d * 6144];
#pragma unroll
        for (int bb = 0; bb < 9; ++bb) a[bb] += sc[bb * 1024 + d] * w; }
      float* red = lds + 9 * 1024;
#pragma unroll
      for (int bb = 0; bb < 9; ++bb) red[(ks * 9 + bb) * 64 + col] = a[bb];
      __syncthreads();
      for (int i = tid; i < 9 * 64; i += 512) { const int bb = i >> 6, cc = i & 63; float s = 0.f;
        for (int k = 0; k < 8; ++k) s += red[(k * 9 + bb) * 64 + cc];
        mod[((size_t)l * 9 + bb) * 6144 + j0 + cc] = s + p.b_mod[l * 6144 + j0 + cc]; }
      __syncthreads();
    } else if (task < E1) { const int t = task - E0, l = t / 704, r = t % 704, kt = r / 44, nt = r % 44;
      cvt_tile(p.w_in + (size_t)l * 1024 * IN_COLS, IN_COLS, 1024, kt * 64, nt * 64, Wt_in + (size_t)l * PLD * 1024, nt * 64, nullptr, lds);
    } else if (task < E2) { const int t = task - E1, l = t / 72, r = t % 72, kt = r / 12, nt = r % 12;
      cvt_tile(p.w_uq + (size_t)l * 384 * 768, 768, 384, kt * 64, nt * 64, Wt_uq + (size_t)l * 768 * 384, nt * 64, p.q_norm_w + l * 384, lds);
    } else if (task < E3) { const int t = task - E2, l = t / 64, r = t % 64, kt = r / 16, nt = r % 16;
      cvt_tile(p.w_ukv + (size_t)l * 256 * 1024, 1024, 256, kt * 64, nt * 64, Wt_ukv + (size_t)l * 1024 * 256, nt * 64, p.kv_norm_w + l * 256, lds);
    } else if (task < E4) { const int t = task - E3, l = t / 256, r = t % 256, kt = r / 16, nt = r % 16;
      cvt_tile(p.w_out + (size_t)l * 1024 * 1024, 1024, 1024, kt * 64, nt * 64, Wt_out + (size_t)l * 1024 * 1024, nt * 64, nullptr, lds);
    } else {
      float* cs = (float*)(p.ws + WS_COS); float* sn = (float*)(p.ws + WS_SIN);
      for (int i = (task - E4) * 4096 + tid; i < (task - E4 + 1) * 4096; i += 512) { const int t = i >> 5, j = i & 31;
        const float inv = exp2f(-(float)(j & 15) * (13.287712379549449f / 16.f));
        const float pos = (float)(j < 16 ? (t >> 6) : (t & 63)); const float ang = pos * inv;
        const double a = (double)ang; const double k = rint(a * 0.15915494309189535); const float r = (float)(a - k * 6.283185307179586);
        cs[i] = __cosf(r); sn[i] = __sinf(r); }
    }
  }
}

__device__ void phase_cvt_experts(PRef p, int l, char* smem) {
  float* lds = (float*)smem;
  bf16_t* Wgu = (bf16_t*)(p.ws + WS_WGU); bf16_t* Wdn = (bf16_t*)(p.ws + WS_WDN);
  const int tid = otid();
  for (int task = obid(); task < NE * 192; task += gridDim.x) {
    const int e = task / 192, r = task % 192, which = r >> 6, kt = (r & 63) >> 2, nt = r & 3, k0 = kt * 64, n0 = nt * 256;
    const float* src = (which == 0 ? p.w_gate : which == 1 ? p.w_up : p.w_down) + ((size_t)l * NE + e) * 1024 * 1024;
    { const int kr = tid >> 6, n4 = (tid & 63) * 4;
#pragma unroll
      for (int i = 0; i < 8; ++i) { const int k = kr + 8 * i; *(f32x4*)(lds + k * 260 + n4) = *(const f32x4*)(src + (size_t)(k0 + k) * 1024 + n0 + n4); } }
    __syncthreads();
    { const int nl = tid >> 1, k32 = (tid & 1) * 32, n = n0 + nl;
      const size_t drow = which == 2 ? (size_t)n : (size_t)((n >> 7) * 256 + which * 128 + (n & 127));
      bf16_t* dst = (which == 2 ? Wdn + (size_t)e * 1024 * 1024 : Wgu + (size_t)e * 2048 * 1024) + drow * 1024 + k0 + k32;
#pragma unroll
      for (int q = 0; q < 4; ++q) { float v[8];
#pragma unroll
        for (int i = 0; i < 8; ++i) v[i] = lds[(k32 + q * 8 + i) * 260 + nl];
        u32x4 w = {cvtpk(v[0], v[1]), cvtpk(v[2], v[3]), cvtpk(v[4], v[5]), cvtpk(v[6], v[7])};
        *(u32x4*)(dst + q * 8) = w; } }
    __syncthreads();
  }
}

__device__ __forceinline__ void ln_row(f32x4 (&v)[4], float eps) {
  float s = 0.f;
#pragma unroll
  for (int i = 0; i < 4; ++i) s += v[i][0] + v[i][1] + v[i][2] + v[i][3];
  const float mu = wave_sum(s) * (1.f / 1024.f);
  float q = 0.f;
#pragma unroll
  for (int i = 0; i < 4; ++i)
#pragma unroll
    for (int k = 0; k < 4; ++k) { v[i][k] -= mu; q += v[i][k] * v[i][k]; }
  const float rs = rsqrtf(wave_sum(q) * (1.f / 1024.f) + eps);
#pragma unroll
  for (int i = 0; i < 4; ++i) v[i] *= rs;
}
__device__ __forceinline__ void store_mod_bf16(const f32x4 (&v)[4], const float* __restrict__ shift, const float* __restrict__ scale, bf16_t* __restrict__ hrow, int lane, f32x4 (*keep)[4]) {
#pragma unroll
  for (int i = 0; i < 4; ++i) { const int c = lane * 4 + 256 * i; const f32x4 sh = *(const f32x4*)(shift + c), sc = *(const f32x4*)(scale + c);
    f32x4 o = v[i] * (sc + 1.f) + sh; if (keep) (*keep)[i] = o;
    u32x2 w = {cvtpk(o[0], o[1]), cvtpk(o[2], o[3])}; *(u32x2*)(hrow + c) = w; }
}
__device__ __forceinline__ const float* mod_ptr(PRef p, int l, int row, int which) {
  const int bb = row < MX ? (row >> 13) : 8;
  return (const float*)(p.ws + WS_MOD) + ((size_t)l * 9 + bb) * 6144 + which * 1024;
}

__device__ void phase_h0(PRef p) {
  const int lane = otid() & 63, gw = obid() * 8 + (otid() >> 6), nw = gridDim.x * 8;
  bf16_t* h = (bf16_t*)(p.ws + WS_H);
  for (int row = gw; row < MT; row += nw) {
    const float* src = row < MX ? p.x + (size_t)row * 1024 : p.ctx + (size_t)(row - MX) * 1024;
    f32x4 v[4];
#pragma unroll
    for (int i = 0; i < 4; ++i) v[i] = *(const f32x4*)(src + lane * 4 + 256 * i);
    ln_row(v, 1e-6f);
    store_mod_bf16(v, mod_ptr(p, 0, row, 0), mod_ptr(p, 0, row, 1), h + (size_t)row * 1024, lane, nullptr);
  }
}

__device__ void phase_inproj(PRef p, int l, char* smem) {
  LAS unsigned char* lds = (LAS unsigned char*)smem;
  const bf16_t* h = (const bf16_t*)(p.ws + WS_H); const bf16_t* Wt = (const bf16_t*)(p.ws + WS_WIN) + (size_t)l * PLD * 1024;
  bf16_t* P = (bf16_t*)(p.ws + WS_P); float* gates = (float*)(p.ws + WS_GATES);
  const int tid = otid(), wid = tid >> 6, lane = tid & 63, wr = wid >> 2, wc = wid & 3, fr = lane & 15, fq = lane >> 4;
  g8::TileIter it; it.init(MT / 256, PLD / 256);
  int pm, pn;
  while (it.next(pm, pn)) {
    unsigned voffA[2] = {g8::piece_off(0, 1024, 0), g8::piece_off(1, 1024, 0)};
    f32x4 acc[2][2][4][2];
    g8::gemm_tile<false>(lds, (const char*)(h + (size_t)pm * 256 * 1024), voffA, (size_t)128 * 1024 * 2, (const char*)(Wt + (size_t)pn * 256 * 1024), 1024, acc);
    ACC_FOR3(ai, bj, m) {
      const int row = pm * 256 + ai * 128 + wr * 64 + m * 16 + fr, col = pn * 256 + bj * 128 + wc * 32 + fq * 8;
      const f32x4 v0 = acc[ai][bj][m][0], v1 = acc[ai][bj][m][1];
      u32x4 w = {cvtpk(v0[0], v0[1]), cvtpk(v0[2], v0[3]), cvtpk(v1[0], v1[1]), cvtpk(v1[2], v1[3])}; *(u32x4*)(P + (size_t)row * PLD + col) = w;
      if (col >= OFF_G && col < OFF_G + 16) { const f32x4 bg0 = *(const f32x4*)(p.b_gates + l * 16 + (col - OFF_G)), bg1 = *(const f32x4*)(p.b_gates + l * 16 + (col - OFF_G) + 4);
        *(f32x4*)(gates + (size_t)row * 16 + (col - OFF_G)) = v0 + bg0; *(f32x4*)(gates + (size_t)row * 16 + (col - OFF_G) + 4) = v1 + bg1; }
    }
  }
}


constexpr size_t WS_QKC = WS_KV;
constexpr size_t WS_SCAL = WS_Q;
__device__ void phase_mlstm_pre(PRef p, int l, char* smem) {
  const bf16_t* P = (const bf16_t*)(p.ws + WS_P); const float* gates = (const float*)(p.ws + WS_GATES);
  bf16_t* QKC = (bf16_t*)(p.ws + WS_QKC); float* SCAL = (float*)(p.ws + WS_SCAL);
  const int tid = otid(), wid = tid >> 6, lane = tid & 63;
  if (obid() < 64) {
    const int chain = obid(), dir = chain & 1, hd = (chain >> 1) & 3, b = chain >> 3;
    float* LA = (float*)smem; float* LB = LA + 132 * 64; float* LP = LB + 132 * 64; float* b63s = LP + 132 * 64; float* pm63s = b63s + 132; float* mbs = pm63s + 132;
    for (int ci = wid; ci < 132; ci += 8) {
      const bool ic = ci < 4; const int cc = ic ? ci : ci - 4, T = ic ? CTXL : SEQ, rb = ic ? MX + b * CTXL : b * SEQ, tlo = dir ? T - 64 - cc * 64 : cc * 64;
      const int t = dir ? tlo + 63 - lane : tlo + lane; const float* g = gates + (size_t)(rb + t) * 16;
      const float ig = g[dir * 8 + hd], fg = g[dir * 8 + 4 + hd];
      const float lf = fminf(fg, 0.f) - log1pf(expf(-fabsf(fg)));
      float bc = lf;
#pragma unroll
      for (int o = 1; o < 64; o <<= 1) { const float u = __shfl_up(bc, o); if (lane >= o) bc += u; }
      const float a = ig - bc; float pmx = a;
#pragma unroll
      for (int o = 1; o < 64; o <<= 1) { const float u = __shfl_up(pmx, o); if (lane >= o) pmx = fmaxf(pmx, u); }
      LA[ci * 64 + lane] = a; LB[ci * 64 + lane] = bc; LP[ci * 64 + lane] = pmx;
      if (lane == 63) { b63s[ci] = bc; pm63s[ci] = pmx; }
    }
    __syncthreads();
    if (tid == 0) { float m = 0.f; for (int ci = 0; ci < 132; ++ci) { mbs[ci] = m; m = b63s[ci] + fmaxf(pm63s[ci], m); } }
    __syncthreads();
    for (int ci = wid; ci < 132; ci += 8) {
      const float m = mbs[ci], a = LA[ci * 64 + lane], bc = LB[ci * 64 + lane], pmx = LP[ci * 64 + lane];
      const float Mx = fmaxf(pmx, m), M63 = fmaxf(pm63s[ci], m);
      float* S = SCAL + ((size_t)chain * 132 + ci) * 384;
      S[lane] = a; S[64 + lane] = Mx; S[128 + lane] = __expf(m - Mx); S[192 + lane] = __expf(-(bc + Mx)); S[256 + lane] = __expf(a - M63);
      S[320 + lane] = lane == 0 ? __expf(m - M63) : 0.f;
    }
    return;
  }
  const int col8 = (tid & 127) * 8, rg = tid >> 7;
  float w[5][8], bia[8];
#pragma unroll
  for (int j = 0; j < 5; ++j) { const f32x4 w0 = *(const f32x4*)(p.conv_w + ((size_t)l * 5 + j) * 1024 + col8), w1 = *(const f32x4*)(p.conv_w + ((size_t)l * 5 + j) * 1024 + col8 + 4);
#pragma unroll
    for (int k = 0; k < 4; ++k) { w[j][k] = w0[k]; w[j][4 + k] = w1[k]; } }
  { const f32x4 b0 = *(const f32x4*)(p.conv_b + l * 1024 + col8), b1 = *(const f32x4*)(p.conv_b + l * 1024 + col8 + 4);
#pragma unroll
    for (int k = 0; k < 4; ++k) { bia[k] = b0[k]; bia[4 + k] = b1[k]; } }
  const float osc = col8 < 512 ? 0.08838834764831845f : 1.f;
#pragma unroll 1
  for (int rb = obid() - 64; rb < MT / 64; rb += gridDim.x - 64) {
    const int R0 = rb * 64, seg_lo = R0 < MX ? (R0 & ~8191) : MX + ((R0 - MX) & ~255), seg_hi = seg_lo + (R0 < MX ? SEQ : CTXL);
    const int r0 = R0 + rg * 16;
    u32x4 raw[20];
#pragma unroll
    for (int i = 0; i < 20; ++i) { const int r = r0 - 2 + i; raw[i] = (u32x4){0u, 0u, 0u, 0u}; if (r >= seg_lo && r < seg_hi) raw[i] = *(const u32x4*)(P + (size_t)r * PLD + col8); }
#pragma unroll
    for (int i = 0; i < 16; ++i) {
      float y[8];
#pragma unroll
      for (int k = 0; k < 8; ++k) y[k] = bia[k];
#pragma unroll
      for (int tp = 0; tp < 5; ++tp) {
#pragma unroll
        for (int k = 0; k < 4; ++k) { y[2 * k] += w[tp][2 * k] * bflo(raw[i + tp][k]); y[2 * k + 1] += w[tp][2 * k + 1] * bfhi(raw[i + tp][k]); } }
#pragma unroll
      for (int k = 0; k < 8; ++k) y[k] = silu_f(y[k]) * osc;
      u32x4 o = {cvtpk(y[0], y[1]), cvtpk(y[2], y[3]), cvtpk(y[4], y[5]), cvtpk(y[6], y[7])};
      *(u32x4*)(QKC + (size_t)(r0 + i) * 1024 + col8) = o;
    }
  }
}

__device__ void phase_mlstm(PRef p, int l, char* smem) {
  bf16_t* QBb[2] = {(bf16_t*)(smem), (bf16_t*)(smem + 17408)};
  bf16_t* KB = (bf16_t*)(smem + 34816);
  bf16_t* KT = (bf16_t*)(smem + 52224);
  bf16_t* VTb[2] = {(bf16_t*)(smem + 70656), (bf16_t*)(smem + 77568)};
  bf16_t* VWT = (bf16_t*)(smem + 84480);
  bf16_t* PB = (bf16_t*)(smem + 91392);
  bf16_t* CTb[2] = {(bf16_t*)(smem + 100608), (bf16_t*)(smem + 113664)};
  float* SC = (float*)(smem + 126720);
  const bf16_t* P = (const bf16_t*)(p.ws + WS_P); const bf16_t* QKC = (const bf16_t*)(p.ws + WS_QKC); const float* SCAL = (const float*)(p.ws + WS_SCAL);
  bf16_t* hbuf = (bf16_t*)(p.ws + WS_HB);
  for (int w = obid(); w < 256; w += gridDim.x) {
    const int slice = (w >> 3) & 3, chain = (w & 7) * 8 + (w >> 5), dir = chain & 1, hd = (chain >> 1) & 3, b = chain >> 3;
    const float* SCc = SCAL + (size_t)chain * 132 * 384;
    __syncthreads();
    { const int tid = otid();
      for (int i = tid; i < 48 * 136 / 2; i += 512) { ((unsigned*)CTb[0])[i] = 0u; ((unsigned*)CTb[1])[i] = 0u; }
      for (int i = tid; i < 48 * 72 / 2; i += 512) { ((unsigned*)VTb[0])[i] = 0u; ((unsigned*)VTb[1])[i] = 0u; ((unsigned*)VWT)[i] = 0u; } }
    f32x4 accC[3];
#pragma unroll
    for (int i = 0; i < 3; ++i) accC[i] = (f32x4){0.f, 0.f, 0.f, 0.f};
    struct Pre { u32x4 qk[4]; u32x2 v; f32x4 s; float ws, ws1; };
    Pre preA, preB;
    preA.s = (f32x4){0.f, 0.f, 0.f, 0.f}; preB.s = preA.s;
#define MLSTM_PREFETCH(PR, CI) do { const int tid_ = otid(); const int ci_ = (CI); const bool ic_ = ci_ < 4; const int cc_ = ic_ ? ci_ : ci_ - 4, T_ = ic_ ? CTXL : SEQ, rb_ = ic_ ? MX + b * CTXL : b * SEQ; \
      const int tlo_ = dir ? T_ - 64 - cc_ * 64 : cc_ * 64; \
      _Pragma("unroll") for (int k_ = 0; k_ < 4; ++k_) { const int pc = tid_ + k_ * 512, tens = pc >> 10, rem = pc & 1023, lr = rem >> 4, c16 = rem & 15, t = dir ? tlo_ + 63 - lr : tlo_ + lr; \
        PR.qk[k_] = *(const u32x4*)(QKC + (size_t)(rb_ + t) * 1024 + tens * 512 + hd * 128 + c16 * 8); } \
      { const int vl_ = tid_ >> 3, vt_ = dir ? tlo_ + 63 - vl_ : tlo_ + vl_; PR.v = *(const u32x2*)(P + (size_t)(rb_ + vt_) * PLD + OFF_V + hd * 128 + slice * 32 + (tid_ & 7) * 4); \
        PR.ws = SCc[(size_t)ci_ * 384 + 256 + vl_]; PR.ws1 = SCc[(size_t)ci_ * 384 + 256 + (tid_ & 63)]; } \
      if (tid_ < 96) PR.s = *(const f32x4*)(SCc + (size_t)ci_ * 384 + tid_ * 4); } while (0)
    MLSTM_PREFETCH(preA, 0);
    MLSTM_PREFETCH(preB, 1);
    __syncthreads();
    auto step = [&](const int ci, Pre& pre) __attribute__((always_inline)) {
      const int tid = otid(), wid = tid >> 6, lane = tid & 63, fr = lane & 15, fq = lane >> 4;
      const bool isctx = ci < 4; const int cc = isctx ? ci : ci - 4, T = isctx ? CTXL : SEQ, rowbase = isctx ? MX + b * CTXL : b * SEQ;
      const int tlo = dir ? T - 64 - cc * 64 : cc * 64;
      const int par = ci & 1;
      bf16_t* QB = QBb[par]; bf16_t* VT = VTb[par]; float* S = SC + par * 384; bf16_t* CTc = CTb[par]; bf16_t* CTn = CTb[par ^ 1];
      const bool need_out = !(l == DEPTH - 1 && isctx);
#pragma unroll
      for (int k = 0; k < 4; ++k) { const int pc = tid + k * 512, tens = pc >> 10, rem = pc & 1023, lr = rem >> 4, c16 = rem & 15;
        if (tens == 0) *(u32x4*)(QB + lr * 136 + c16 * 8) = pre.qk[k];
        else { *(u32x4*)(KB + lr * 136 + c16 * 8) = pre.qk[k];
#pragma unroll
          for (int i = 0; i < 4; ++i) { KT[(c16 * 8 + 2 * i) * 72 + lr] = (bf16_t)(pre.qk[k][i] & 0xffffu); KT[(c16 * 8 + 2 * i + 1) * 72 + lr] = (bf16_t)(pre.qk[k][i] >> 16); } } }
      { const int vl = tid >> 3, ve4 = (tid & 7) * 4; const float wsl = pre.ws;
        VT[(ve4 + 0) * 72 + vl] = (bf16_t)(pre.v[0] & 0xffffu); VT[(ve4 + 1) * 72 + vl] = (bf16_t)(pre.v[0] >> 16);
        VT[(ve4 + 2) * 72 + vl] = (bf16_t)(pre.v[1] & 0xffffu); VT[(ve4 + 3) * 72 + vl] = (bf16_t)(pre.v[1] >> 16);
        VWT[(ve4 + 0) * 72 + vl] = f2bf(bflo(pre.v[0]) * wsl); VWT[(ve4 + 1) * 72 + vl] = f2bf(bfhi(pre.v[0]) * wsl);
        VWT[(ve4 + 2) * 72 + vl] = f2bf(bflo(pre.v[1]) * wsl); VWT[(ve4 + 3) * 72 + vl] = f2bf(bfhi(pre.v[1]) * wsl);
        if (tid < 64) { VT[32 * 72 + tid] = (bf16_t)0x3F80u; VWT[32 * 72 + tid] = f2bf(pre.ws1); }
        if (tid < 96) *(f32x4*)(S + tid * 4) = pre.s; }
      if (ci + 2 < 132) MLSTM_PREFETCH(pre, ci + 2);
      __syncthreads();
      if (need_out) {
        const int mt = wid >> 1;
#pragma unroll
        for (int u = 0; u < 2; ++u) {
          const int ntl = (wid & 1) * 2 + u;
          f32x4 sacc = {0.f, 0.f, 0.f, 0.f};
          if (ntl <= mt) {
#pragma unroll
            for (int kk = 0; kk < 4; ++kk) {
              const bf16x8 a = *(const bf16x8*)(QB + (mt * 16 + fr) * 136 + kk * 32 + fq * 8), bb = *(const bf16x8*)(KB + (ntl * 16 + fr) * 136 + kk * 32 + fq * 8);
              sacc = __builtin_amdgcn_mfma_f32_16x16x32_bf16(a, bb, sacc, 0, 0, 0); }
          }
          const int j = ntl * 16 + fr; const float aj = S[j];
#pragma unroll
          for (int jj = 0; jj < 4; ++jj) { const int lr = mt * 16 + fq * 4 + jj;
            const float pv = (j <= lr) ? sacc[jj] * __expf(fminf(aj - S[64 + lr], 0.f)) : 0.f;
            PB[lr * 72 + j] = f2bf(pv); }
        }
      }
      {
        const float decay = S[320];
#pragma unroll
        for (int mt = 0; mt < 3; ++mt) {
          accC[mt] *= decay;
#pragma unroll
          for (int kk = 0; kk < 2; ++kk) { const bf16x8 a = *(const bf16x8*)(VWT + (mt * 16 + fr) * 72 + kk * 32 + fq * 8), bb = *(const bf16x8*)(KT + (wid * 16 + fr) * 72 + kk * 32 + fq * 8);
            accC[mt] = __builtin_amdgcn_mfma_f32_16x16x32_bf16(a, bb, accC[mt], 0, 0, 0); }
#pragma unroll
          for (int jj = 0; jj < 4; ++jj) CTn[(mt * 16 + fq * 4 + jj) * 136 + wid * 16 + fr] = f2bf(accC[mt][jj]);
        }
      }
      __syncthreads();
      if (need_out && wid < 4) {
        const int mt = wid; f32x4 num[3];
#pragma unroll
        for (int ntl = 0; ntl < 3; ++ntl) {
          f32x4 a1 = {0.f, 0.f, 0.f, 0.f}, a2 = {0.f, 0.f, 0.f, 0.f};
#pragma unroll
          for (int kk = 0; kk < 2; ++kk) { const bf16x8 a = *(const bf16x8*)(PB + (mt * 16 + fr) * 72 + kk * 32 + fq * 8), bb = *(const bf16x8*)(VT + (ntl * 16 + fr) * 72 + kk * 32 + fq * 8);
            a1 = __builtin_amdgcn_mfma_f32_16x16x32_bf16(a, bb, a1, 0, 0, 0); }
#pragma unroll
          for (int kk = 0; kk < 4; ++kk) { const bf16x8 a = *(const bf16x8*)(QB + (mt * 16 + fr) * 136 + kk * 32 + fq * 8), bb = *(const bf16x8*)(CTc + (ntl * 16 + fr) * 136 + kk * 32 + fq * 8);
            a2 = __builtin_amdgcn_mfma_f32_16x16x32_bf16(a, bb, a2, 0, 0, 0); }
#pragma unroll
          for (int jj = 0; jj < 4; ++jj) num[ntl][jj] = a1[jj] + S[128 + mt * 16 + fq * 4 + jj] * a2[jj];
        }
#pragma unroll
        for (int jj = 0; jj < 4; ++jj) {
          const int lr = mt * 16 + fq * 4 + jj; const float den = __shfl(num[2][jj], lane & 48);
          const float rd = __builtin_amdgcn_rcpf(fmaxf(fabsf(den), S[192 + lr]));
          const int t = dir ? tlo + 63 - lr : tlo + lr;
          bf16_t* hp = hbuf + ((size_t)((dir * 4 + hd) * 4 + slice) * MT + rowbase + t) * 32 + fr;
          hp[0] = f2bf(num[0][jj] * rd); hp[16] = f2bf(num[1][jj] * rd);
        }
      }
    };
#pragma unroll 1
    for (int ci = 0; ci < 132; ci += 2) { step(ci, preA); step(ci + 1, preB); }
    __syncthreads();
  }
#undef MLSTM_PREFETCH
}

template <int WHICH>
__device__ __forceinline__ void mla_gemm(PRef p, int l, char* smem) {
  LAS unsigned char* lds = (LAS unsigned char*)smem; float* rsb = (float*)(smem + g8::STAGE_BYTES);
  const bf16_t* P = (const bf16_t*)(p.ws + WS_P);
  const int tid = otid(), wid = tid >> 6, lane = tid & 63, wr = wid >> 2, wc = wid & 3, fr = lane & 15, fq = lane >> 4;
  constexpr int K = WHICH ? 256 : 384, OFFC = WHICH ? OFF_CKV : OFF_CQ, N = WHICH ? 1024 : 768;
  const bf16_t* Wt = WHICH ? (const bf16_t*)(p.ws + WS_WUKV) + (size_t)l * 1024 * 256 : (const bf16_t*)(p.ws + WS_WUQ) + (size_t)l * 768 * 384;
  bf16_t* O = (bf16_t*)(p.ws + (WHICH ? WS_KV : WS_Q));
  g8::TileIter it; it.init((WHICH || l == 0) ? MT / 256 : MX / 256, N / 256);
  int pm, pn;
  while (it.next(pm, pn)) {
    __syncthreads();
    { const int r = tid >> 1, hf = tid & 1; const bf16_t* src = P + (size_t)(pm * 256 + r) * PLD + OFFC + hf * (K / 2); float s = 0.f;
#pragma unroll 4
      for (int i = 0; i < K / 16; ++i) { const u32x4 v = *(const u32x4*)(src + i * 8);
#pragma unroll
        for (int k = 0; k < 4; ++k) { const float a = bflo(v[k]), bq = bfhi(v[k]); s += a * a + bq * bq; } }
      s += __shfl_xor(s, 1);
      if (hf == 0) rsb[r] = rsqrtf(s / (float)K + 1e-6f); }
    unsigned voffA[2] = {g8::piece_off(0, PLD, OFFC), g8::piece_off(1, PLD, OFFC)};
    f32x4 acc[2][2][4][2];
    g8::gemm_tile<false>(lds, (const char*)(P + (size_t)pm * 256 * PLD), voffA, (size_t)128 * PLD * 2, (const char*)(Wt + (size_t)pn * 256 * K), opaque_s(K), acc);
    ACC_FOR3(ai, bj, m) {
      const int rl = ai * 128 + wr * 64 + m * 16 + fr, row = pm * 256 + rl, col = pn * 256 + bj * 128 + wc * 32 + fq * 8;
      const float rs = rsb[rl]; const f32x4 v0 = acc[ai][bj][m][0] * rs, v1 = acc[ai][bj][m][1] * rs;
      size_t orow = row;
      if (WHICH) orow = row < MX ? (size_t)(row >> 13) * SKV + CTXL + (row & 8191) : (size_t)((row - MX) >> 8) * SKV + ((row - MX) & 255);
      u32x4 w = {cvtpk(v0[0], v0[1]), cvtpk(v0[2], v0[3]), cvtpk(v1[0], v1[1]), cvtpk(v1[2], v1[3])}; *(u32x4*)(O + orow * N + col) = w;
    }
  }
}
__device__ void phase_mla_prep(PRef p, int l, char* smem) {
  mla_gemm<0>(p, l, smem);
  mla_gemm<1>(p, l, smem);
  const bf16_t* P = (const bf16_t*)(p.ws + WS_P);
  const int tid = otid(), wid = tid >> 6, lane = tid & 63;
  const bf16_t* hbuf = (const bf16_t*)(p.ws + WS_HB); bf16_t* mix = (bf16_t*)(p.ws + WS_MIX); bf16_t* KR = (bf16_t*)(p.ws + WS_KR);
  const float* cs = (const float*)(p.ws + WS_COS); const float* sn = (const float*)(p.ws + WS_SIN);
  const int gw = obid() * 8 + wid, nw = gridDim.x * 8;
  for (int row = gw; row < MT; row += nw) {
    if (row < MX || l == 0) {
      const size_t ho = ((size_t)(lane >> 2) * MT + row) * 32 + (lane & 3) * 8;
      const u32x4 hf = *(const u32x4*)(hbuf + ho), hb = *(const u32x4*)(hbuf + (size_t)16 * MT * 32 + ho);
      const u32x4 ov = *(const u32x4*)(P + (size_t)row * PLD + OFF_O + lane * 8);
      float v[8]; float s = 0.f;
#pragma unroll
      for (int k = 0; k < 4; ++k) { v[2 * k] = bflo(hf[k]) + bflo(hb[k]); v[2 * k + 1] = bfhi(hf[k]) + bfhi(hb[k]); s += v[2 * k] + v[2 * k + 1]; }
      s += __shfl_xor(s, 1); s += __shfl_xor(s, 2); s += __shfl_xor(s, 4); s += __shfl_xor(s, 8);
      const float mu = s * (1.f / 128.f); float q = 0.f;
#pragma unroll
      for (int k = 0; k < 8; ++k) { v[k] -= mu; q += v[k] * v[k]; }
      q += __shfl_xor(q, 1); q += __shfl_xor(q, 2); q += __shfl_xor(q, 4); q += __shfl_xor(q, 8);
      const float rs = rsqrtf(q * (1.f / 128.f) + 1e-6f);
      const float* nw_ = p.m_norm_w + l * 512 + lane * 8; float o[8];
#pragma unroll
      for (int k = 0; k < 4; ++k) { o[2 * k] = v[2 * k] * rs * nw_[2 * k] * sigmoid_f(bflo(ov[k])); o[2 * k + 1] = v[2 * k + 1] * rs * nw_[2 * k + 1] * sigmoid_f(bfhi(ov[k])); }
      u32x4 wv = {cvtpk(o[0], o[1]), cvtpk(o[2], o[3]), cvtpk(o[4], o[5]), cvtpk(o[6], o[7])};
      *(u32x4*)(mix + (size_t)row * 1024 + lane * 8) = wv;
    }
    {
      const int j = lane & 31;
      const float x1 = bf2f(P[(size_t)row * PLD + OFF_KR + j]), x2 = bf2f(P[(size_t)row * PLD + OFF_KR + 32 + j]);
      float o1 = x1, o2 = x2; size_t orow;
      if (row < MX) { const int t = row & 8191; const float c = cs[t * 32 + j], s_ = sn[t * 32 + j]; o1 = x1 * c - x2 * s_; o2 = x2 * c + x1 * s_; orow = (size_t)(row >> 13) * SKV + CTXL + t; }
      else orow = (size_t)((row - MX) >> 8) * SKV + ((row - MX) & 255);
      if (lane < 32) { KR[orow * 64 + j] = f2bf(o1); KR[orow * 64 + 32 + j] = f2bf(o2); }
    }
  }
}

namespace att {
constexpr int NW = 8, QBLK = 32, KVBLK = 64, LDQ = 768, LDK = 1024, LDKR = 64, LDO = 1024;
constexpr float SCALE = A_SCALE;
constexpr float THR = 8.f;
constexpr size_t SHM_V = KVBLK * 128 * 2, SHM_K = KVBLK * 128 * 2, SHM_R = KVBLK * 64 * 2;
typedef float f32x8 __attribute__((ext_vector_type(8)));
#define KSWZ(row, colB) ((row) * 256 + ((colB) ^ (((row) & 7) << 4)))
#define RSWZ(row, colB) ((row) * 128 + ((colB) ^ (((row) & 7) << 4)))
#define SBAR() __builtin_amdgcn_sched_barrier(0)
__device__ __forceinline__ int crow(int r, int hi) { return (r & 3) + 8 * (r >> 2) + 4 * hi; }
__device__ __forceinline__ void partialSM(f32x16& p0, f32x16& p1, float& m_reg, float& mn, float& alpha) {
  constexpr float C = SCALE * 1.4426950408889634f;
  float pmax = p0[0];
#pragma unroll
  for (int r = 1; r < 16; ++r) pmax = fmaxf(pmax, p0[r]);
#pragma unroll
  for (int r = 0; r < 16; ++r) pmax = fmaxf(pmax, p1[r]);
  { auto rr = __builtin_amdgcn_permlane32_swap(__float_as_uint(pmax), __float_as_uint(pmax), false, false);
    pmax = fmaxf(__uint_as_float(rr[0]), __uint_as_float(rr[1])); }
  if (__builtin_expect(__all(pmax - m_reg <= THR / SCALE), 1)) { mn = m_reg; alpha = 1.f; }
  else { mn = fmaxf(m_reg, pmax); alpha = __builtin_amdgcn_exp2f((m_reg - mn) * C); m_reg = mn; }
  const float mnC = -mn * C;
#pragma unroll
  for (int r = 0; r < 16; ++r) p0[r] = fmaf(p0[r], C, mnC);
#pragma unroll
  for (int r = 0; r < 16; ++r) p1[r] = fmaf(p1[r], C, mnC);
#pragma unroll
  for (int r = 0; r < 16; ++r) p0[r] = __builtin_amdgcn_exp2f(p0[r]);
}
__device__ __forceinline__ void finishSM(f32x16& p0, f32x16& p1, float alpha, float& l_reg, bf16x8& pa0, bf16x8& pa1, bf16x8& pa2, bf16x8& pa3) {
#pragma unroll
  for (int r = 0; r < 16; ++r) p1[r] = __builtin_amdgcn_exp2f(p1[r]);
  float ps = 0;
#pragma unroll
  for (int r = 0; r < 16; ++r) ps += p0[r];
#pragma unroll
  for (int r = 0; r < 16; ++r) ps += p1[r];
  { auto rr = __builtin_amdgcn_permlane32_swap(__float_as_uint(ps), __float_as_uint(ps), false, false);
    ps = __uint_as_float(rr[0]) + __uint_as_float(rr[1]); }
  l_reg = l_reg * alpha + ps;
#define PK4(P, BASE, OUT) do { unsigned a0 = cvtpk(P[BASE + 0], P[BASE + 1]), a1 = cvtpk(P[BASE + 2], P[BASE + 3]);   \
    unsigned b0 = cvtpk(P[BASE + 4], P[BASE + 5]), b1 = cvtpk(P[BASE + 6], P[BASE + 7]);                              \
    auto r0 = __builtin_amdgcn_permlane32_swap(a0, b0, false, false); auto r1 = __builtin_amdgcn_permlane32_swap(a1, b1, false, false); \
    u32x4 w = {r0[0], r1[0], r0[1], r1[1]}; OUT = *reinterpret_cast<bf16x8*>(&w); } while (0)
  PK4(p0, 0, pa0); PK4(p0, 8, pa1); PK4(p1, 0, pa2); PK4(p1, 8, pa3);
#undef PK4
}
__device__ __forceinline__ void qkt(f32x16& p0, f32x16& p1, const char* Ks, const char* Rs, const bf16x8* qr, const char* qrl, int r32, int hi) {
  p0 = f32x16{}; p1 = f32x16{};
#pragma unroll
  for (int d0 = 0; d0 < 8; ++d0) { const int cb = (d0 * 16 + hi * 8) * 2;
    const bf16x8 b0 = *reinterpret_cast<const bf16x8*>(Ks + KSWZ(r32, cb));
    const bf16x8 b1 = *reinterpret_cast<const bf16x8*>(Ks + KSWZ(32 + r32, cb));
    p0 = __builtin_amdgcn_mfma_f32_32x32x16_bf16(b0, qr[d0], p0, 0, 0, 0);
    p1 = __builtin_amdgcn_mfma_f32_32x32x16_bf16(b1, qr[d0], p1, 0, 0, 0); }
#pragma unroll
  for (int d0 = 0; d0 < 4; ++d0) { const int cb = (d0 * 16 + hi * 8) * 2;
    const bf16x8 b0 = *reinterpret_cast<const bf16x8*>(Rs + RSWZ(r32, cb));
    const bf16x8 b1 = *reinterpret_cast<const bf16x8*>(Rs + RSWZ(32 + r32, cb));
    p0 = __builtin_amdgcn_mfma_f32_32x32x16_bf16(b0, qr[8 + d0], p0, 0, 0, 0);
    p1 = __builtin_amdgcn_mfma_f32_32x32x16_bf16(b1, qr[8 + d0], p1, 0, 0, 0); }
}
__device__ __forceinline__ int v_st(int k, int c) { const int kk = (k & ~0xC) | ((k & 4) << 1) | ((k & 8) >> 1); return ((kk >> 3) * 4 + (c >> 5)) * 512 + ((kk & 7) * 32 + (c & 31)) * 2; }
__device__ __forceinline__ int v_rd_base(int lane) { return ((lane & 3) << 3) | (((lane >> 2) & 3) << 6) | (((lane >> 4) & 1) << 5) | (((lane >> 5) & 1) << 8); }
constexpr int v_rd_off(int d0, int ks, int half) { return d0 * 512 + ks * 4096 + half * 2048; }
template <int OFF> __device__ __forceinline__ s16x4 tr_read(int vb) {
  s16x4 r; asm volatile("ds_read_b64_tr_b16 %0, %1 offset:%2" : "=&v"(r) : "v"(vb), "i"(OFF) : "memory"); return r;
}
template <int D0> __device__ __forceinline__ void pv_one(f32x16& od, int vb, bf16x8 pa0, bf16x8 pa1, bf16x8 pa2, bf16x8 pa3) {
  const s16x4 l0 = tr_read<v_rd_off(D0, 0, 0)>(vb), h0 = tr_read<v_rd_off(D0, 0, 1)>(vb), l1 = tr_read<v_rd_off(D0, 1, 0)>(vb), h1 = tr_read<v_rd_off(D0, 1, 1)>(vb);
  const s16x4 l2 = tr_read<v_rd_off(D0, 2, 0)>(vb), h2 = tr_read<v_rd_off(D0, 2, 1)>(vb), l3 = tr_read<v_rd_off(D0, 3, 0)>(vb), h3 = tr_read<v_rd_off(D0, 3, 1)>(vb);
  asm volatile("s_waitcnt lgkmcnt(0)" ::: "memory"); SBAR();
#define PK(L, H) (bf16x8){L[0], L[1], L[2], L[3], H[0], H[1], H[2], H[3]}
  od = __builtin_amdgcn_mfma_f32_32x32x16_bf16(pa0, PK(l0, h0), od, 0, 0, 0);
  od = __builtin_amdgcn_mfma_f32_32x32x16_bf16(pa1, PK(l1, h1), od, 0, 0, 0);
  od = __builtin_amdgcn_mfma_f32_32x32x16_bf16(pa2, PK(l2, h2), od, 0, 0, 0);
  od = __builtin_amdgcn_mfma_f32_32x32x16_bf16(pa3, PK(l3, h3), od, 0, 0, 0);
#undef PK
}
__device__ __forceinline__ void pv_d0(f32x16* o, int vb, bf16x8 pa0, bf16x8 pa1, bf16x8 pa2, bf16x8 pa3) {
  pv_one<0>(o[0], vb, pa0, pa1, pa2, pa3); pv_one<1>(o[1], vb, pa0, pa1, pa2, pa3); pv_one<2>(o[2], vb, pa0, pa1, pa2, pa3); pv_one<3>(o[3], vb, pa0, pa1, pa2, pa3);
}
__device__ __forceinline__ void attn_body(const bf16_t* __restrict__ Qb, const float* __restrict__ cs, const float* __restrict__ sn, const bf16_t* __restrict__ Kn,
                                          const bf16_t* __restrict__ Vh, const bf16_t* __restrict__ Kr, bf16_t* __restrict__ Ob, int seq, char* lds) {
  const int tid = otid(), wid = tid >> 6, lane = tid & 63, r32 = lane & 31, hi = lane >> 5;
  char* V_lds = lds; char* K_lds = lds + 2 * SHM_V; char* R_lds = lds + 2 * SHM_V + 2 * SHM_K;
  float* wsf = (float*)(lds + 2 * SHM_V + 2 * SHM_K + 2 * SHM_R) + wid * 64; float* li_l = wsf; float* al_l = wsf + 32;
  char* qrl = lds + 2 * SHM_V + 2 * SHM_K + 2 * SHM_R + 2048 + wid * 4096 + lane * 16;
  float m_reg = -1e30f, l_reg = 0; f32x16 o[4] = {}; bf16x8 qr[12];
  { const bf16_t* Qw = Qb + (size_t)(wid * QBLK + r32) * LDQ + hi * 8;
#pragma unroll
    for (int d0 = 0; d0 < 8; ++d0) qr[d0] = *(const bf16x8*)(Qw + d0 * 16);
#pragma unroll
    for (int d0 = 0; d0 < 2; ++d0) {
      const u32x4 a = *(const u32x4*)(Qw + 128 + d0 * 16), bq = *(const u32x4*)(Qw + 160 + d0 * 16);
      if (cs) {
        const float* cp = cs + (size_t)(wid * QBLK + r32) * 32 + d0 * 16 + hi * 8; const float* sp = sn + (size_t)(wid * QBLK + r32) * 32 + d0 * 16 + hi * 8;
        const f32x4 c0 = *(const f32x4*)cp, c1 = *(const f32x4*)(cp + 4), s0 = *(const f32x4*)sp, s1 = *(const f32x4*)(sp + 4);
        float x1[8], x2[8], y1[8], y2[8];
#pragma unroll
        for (int k = 0; k < 4; ++k) { x1[2 * k] = bflo(a[k]); x1[2 * k + 1] = bfhi(a[k]); x2[2 * k] = bflo(bq[k]); x2[2 * k + 1] = bfhi(bq[k]); }
#pragma unroll
        for (int k = 0; k < 8; ++k) { const float c = k < 4 ? c0[k & 3] : c1[k & 3], s = k < 4 ? s0[k & 3] : s1[k & 3]; y1[k] = x1[k] * c - x2[k] * s; y2[k] = x2[k] * c + x1[k] * s; }
        u32x4 w1 = {cvtpk(y1[0], y1[1]), cvtpk(y1[2], y1[3]), cvtpk(y1[4], y1[5]), cvtpk(y1[6], y1[7])}, w2 = {cvtpk(y2[0], y2[1]), cvtpk(y2[2], y2[3]), cvtpk(y2[4], y2[5]), cvtpk(y2[6], y2[7])};
        qr[8 + d0] = *reinterpret_cast<bf16x8*>(&w1); qr[10 + d0] = *reinterpret_cast<bf16x8*>(&w2);
      } else { u32x4 a_ = a, b_ = bq; qr[8 + d0] = *reinterpret_cast<bf16x8*>(&a_); qr[10 + d0] = *reinterpret_cast<bf16x8*>(&b_); }
    } }
  const int sr = tid >> 4, sc = (tid & 15) * 8, vst0 = v_st(sr, sc), vst1 = v_st(32 + sr, sc);
  const int rr_ = tid >> 3, rc = (tid & 7) * 8;
  const int vb0 = (int)(uintptr_t)V_lds + v_rd_base(lane);
  bf16x8 vs0, vs1, ks0, ks1, rs0;
  const unsigned voffKV = (unsigned)(sr * LDK + sc) * 2u, voffR = (unsigned)(rr_ * LDKR + rc) * 2u;
#define SLOAD(k0) do { const char* kb_ = (const char*)Kn + (size_t)(k0) * (LDK * 2); const char* vb_ = (const char*)Vh + (size_t)(k0) * (LDK * 2); \
    vs0 = *(const bf16x8*)(vb_ + voffKV); vs1 = *(const bf16x8*)(vb_ + 32 * LDK * 2 + voffKV); \
    ks0 = *(const bf16x8*)(kb_ + voffKV); ks1 = *(const bf16x8*)(kb_ + 32 * LDK * 2 + voffKV); \
    rs0 = *(const bf16x8*)((const char*)Kr + (size_t)(k0) * (LDKR * 2) + voffR); } while (0)
#define SWRITE(b) do { *(bf16x8*)(V_lds + (b) * SHM_V + vst0) = vs0; *(bf16x8*)(V_lds + (b) * SHM_V + vst1) = vs1; const int kc = sc * 2;  \
    *(bf16x8*)(K_lds + (b) * SHM_K + KSWZ(sr, kc)) = ks0; *(bf16x8*)(K_lds + (b) * SHM_K + KSWZ(32 + sr, kc)) = ks1;                      \
    *(bf16x8*)(R_lds + (b) * SHM_R + RSWZ(rr_, rc * 2)) = rs0; } while (0)
#define RESC(a) do { if (__any((a) < 1.f)) { if (hi == 0) al_l[r32] = (a); asm volatile("s_waitcnt lgkmcnt(0)" ::: "memory"); \
    _Pragma("unroll") for (int d = 0; d < 4; ++d) _Pragma("unroll") for (int r = 0; r < 16; ++r) o[d][r] *= al_l[crow(r, hi)]; } } while (0)
  f32x16 pA0, pA1, pB0, pB1; float mnA, mnB, alA, alB; bf16x8 pa0, pa1, pa2, pa3; const int NT = seq / KVBLK;
  SLOAD(0); SWRITE(0); __syncthreads();
  qkt(pA0, pA1, K_lds, R_lds, qr, qrl, r32, hi); partialSM(pA0, pA1, m_reg, mnA, alA);
  SLOAD(KVBLK); SWRITE(1); __syncthreads();
  for (int j = 1; j + 1 < NT; j += 2) {
    SBAR(); qkt(pB0, pB1, K_lds + SHM_K, R_lds + SHM_R, qr, qrl, r32, hi);
    finishSM(pA0, pA1, alA, l_reg, pa0, pa1, pa2, pa3); SBAR();
    SLOAD((j + 1) * KVBLK); SBAR();
    pv_d0(o, vb0, pa0, pa1, pa2, pa3); partialSM(pB0, pB1, m_reg, mnB, alB);
    __syncthreads(); SWRITE(0);
    RESC(alB); __syncthreads();
    SBAR(); qkt(pA0, pA1, K_lds, R_lds, qr, qrl, r32, hi);
    finishSM(pB0, pB1, alB, l_reg, pa0, pa1, pa2, pa3); SBAR();
    SLOAD((j + 2) * KVBLK); SBAR();
    pv_d0(o, vb0 + (int)SHM_V, pa0, pa1, pa2, pa3); partialSM(pA0, pA1, m_reg, mnA, alA);
    __syncthreads(); SWRITE(1);
    RESC(alA); __syncthreads();
  }
  SBAR(); qkt(pB0, pB1, K_lds + SHM_K, R_lds + SHM_R, qr, qrl, r32, hi);
  finishSM(pA0, pA1, alA, l_reg, pa0, pa1, pa2, pa3); SBAR();
  pv_d0(o, vb0, pa0, pa1, pa2, pa3); partialSM(pB0, pB1, m_reg, mnB, alB);
  __syncthreads(); RESC(alB);
  finishSM(pB0, pB1, alB, l_reg, pa0, pa1, pa2, pa3); SBAR();
  pv_d0(o, vb0 + (int)SHM_V, pa0, pa1, pa2, pa3);
  if (hi == 0) li_l[r32] = l_reg; asm volatile("s_waitcnt lgkmcnt(0)" ::: "memory");
  float rli[16];
#pragma unroll
  for (int r = 0; r < 16; ++r) rli[r] = __builtin_amdgcn_rcpf(li_l[crow(r, hi)]);
  bf16_t* Ow = Ob + (size_t)(wid * QBLK) * LDO;
#pragma unroll
  for (int r = 0; r < 16; ++r) { const int orow = crow(r, hi);
#pragma unroll
    for (int d0 = 0; d0 < 4; ++d0) Ow[(size_t)orow * LDO + d0 * 32 + r32] = f2bf(o[d0][r] * rli[r]); }
  __syncthreads();
#undef SLOAD
#undef SWRITE
#undef RESC
}
}

__device__ void phase_attn(PRef p, int l, char* smem) {
  const bf16_t* Q = (const bf16_t*)(p.ws + WS_Q); const bf16_t* KV = (const bf16_t*)(p.ws + WS_KV); const bf16_t* KR = (const bf16_t*)(p.ws + WS_KR);
  bf16_t* mix = (bf16_t*)(p.ws + WS_MIX); const float* cs = (const float*)(p.ws + WS_COS); const float* sn = (const float*)(p.ws + WS_SIN);
  const int nunits = 1024 + (l == 0 ? 32 : 0);
  for (int u = obid(); u < nunits; u += gridDim.x) {
    if (u < 1024) {
      const int bh = (u >> 8) * 8 + (u & 7), qb = (u & 255) >> 3, hd = bh & 3, b = bh >> 2; const size_t row0 = (size_t)b * SEQ + qb * 256;
      att::attn_body(Q + row0 * 768 + hd * 192, cs + (size_t)qb * 256 * 32, sn + (size_t)qb * 256 * 32, KV + (size_t)b * SKV * 1024 + hd * 256,
                     KV + (size_t)b * SKV * 1024 + hd * 256 + 128, KR + (size_t)b * SKV * 64, mix + row0 * 1024 + 512 + hd * 128, SKV, smem);
    } else {
      const int v = u - 1024, hd = v & 3, b = v >> 2; const size_t row0 = (size_t)MX + b * CTXL;
      att::attn_body(Q + row0 * 768 + hd * 192, nullptr, nullptr, KV + (size_t)b * SKV * 1024 + hd * 256,
                     KV + (size_t)b * SKV * 1024 + hd * 256 + 128, KR + (size_t)b * SKV * 64, mix + row0 * 1024 + 512 + hd * 128, CTXL, smem);
    }
  }
}

__device__ void phase_outproj(PRef p, int l, char* smem) {
  LAS unsigned char* lds = (LAS unsigned char*)smem;
  const bf16_t* mix = (const bf16_t*)(p.ws + WS_MIX); const bf16_t* Wt = (const bf16_t*)(p.ws + WS_WOUT) + (size_t)l * 1024 * 1024;
  float* ctxz = (float*)(p.ws + WS_CTXZ);
  const int tid = otid(), wid = tid >> 6, lane = tid & 63, wr = wid >> 2, wc = wid & 3, fr = lane & 15, fq = lane >> 4;
  g8::TileIter it; it.init(l == 0 ? MT / 256 : MX / 256, 4);
  int pm, pn;
  while (it.next(pm, pn)) {
    unsigned voffA[2] = {g8::piece_off(0, 1024, 0), g8::piece_off(1, 1024, 0)};
    f32x4 acc[2][2][4][2];
    g8::gemm_tile<false>(lds, (const char*)(mix + (size_t)pm * 256 * 1024), voffA, (size_t)128 * 1024 * 2, (const char*)(Wt + (size_t)pn * 256 * 1024), 1024, acc);
    ACC_FOR(ai, bj, m, n) {
      const int row = pm * 256 + ai * 128 + wr * 64 + m * 16 + fr, col = pn * 256 + bj * 128 + wc * 32 + fq * 8 + n * 4;
      const float* res = l == 0 ? (row < MX ? p.x + (size_t)row * 1024 : p.ctx + (size_t)(row - MX) * 1024) : p.out + (size_t)row * 1024;
      float* dst = row < MX ? p.out + (size_t)row * 1024 : ctxz + (size_t)(row - MX) * 1024;
      const f32x4 r = *(const f32x4*)(res + col), g = *(const f32x4*)(mod_ptr(p, l, row, 2) + col);
      *(f32x4*)(dst + col) = r * ALPHA + g * acc[ai][bj][m][n];
    }
  }
}

__device__ void phase_ln1(PRef p, int l, char* smem) {
  float* wrt = (float*)smem;
  for (int i = otid(); i < 16384; i += 512) wrt[(i & 15) * 1024 + (i >> 4)] = p.w_router[(size_t)l * 16384 + i];
  __syncthreads();
  const int lane = otid() & 63, gw = obid() * 8 + (otid() >> 6), nw = gridDim.x * 8;
  bf16_t* h = (bf16_t*)(p.ws + WS_H); float* ctxz = (float*)(p.ws + WS_CTXZ); float* aff = (float*)(p.ws + WS_AFF);
  const int nrows = l == 0 ? MT : MX;
  for (int row = gw; row < nrows; row += nw) {
    asm volatile("" ::: "memory");
    float* zr = row < MX ? p.out + (size_t)row * 1024 : ctxz + (size_t)(row - MX) * 1024;
    f32x4 v[4];
#pragma unroll
    for (int i = 0; i < 4; ++i) v[i] = *(const f32x4*)(zr + lane * 4 + 256 * i);
    ln_row(v, 1e-5f);
#pragma unroll
    for (int i = 0; i < 4; ++i) { const int c = lane * 4 + 256 * i; v[i] = v[i] * *(const f32x4*)(p.ln1_g + l * 1024 + c) + *(const f32x4*)(p.ln1_b + l * 1024 + c); *(f32x4*)(zr + c) = v[i]; }
    ln_row(v, 1e-6f);
    f32x4 hm[4];
    store_mod_bf16(v, mod_ptr(p, l, row, 3), mod_ptr(p, l, row, 4), h + (size_t)row * 1024, lane, &hm);
    float lg[16];
#pragma unroll
    for (int e = 0; e < 16; ++e) { float s = 0.f;
#pragma unroll
      for (int i = 0; i < 4; ++i) { const f32x4 w = *(const f32x4*)(wrt + e * 1024 + lane * 4 + 256 * i); s += hm[i][0] * w[0] + hm[i][1] * w[1] + hm[i][2] * w[2] + hm[i][3] * w[3]; }
      lg[e] = wave_sum(s); }
    float mx = lg[0];
#pragma unroll
    for (int e = 1; e < 16; ++e) mx = fmaxf(mx, lg[e]);
    float den = 0.f;
#pragma unroll
    for (int e = 0; e < 16; ++e) { lg[e] = expf(lg[e] - mx); den += lg[e]; }
    float mine = 0.f;
#pragma unroll
    for (int e = 0; e < 16; ++e) if (lane == e) mine = lg[e] / den;
    if (lane < 16) aff[(size_t)row * 16 + lane] = mine;
  }
}

template <int PER>
__device__ __forceinline__ void topk_item(const float* __restrict__ affp, int n, int kcap, int rowbase, int slotbase, int e, int* __restrict__ IDX, float* __restrict__ GV, int* __restrict__ TS, char* smem) {
  unsigned* hist = (unsigned*)smem; unsigned* sel = hist + 256; unsigned* wtot = hist + 272;
  const int tid = otid(), lane = tid & 63, wid = tid >> 6;
  const bool active = tid * PER < n;
  unsigned key[PER];
#pragma unroll
  for (int i = 0; i < PER; ++i) key[i] = active ? __float_as_uint(affp[(size_t)(tid * PER + i) * 16]) : 0u;
  unsigned prefix = 0u, mask = 0u; int kk = kcap;
#pragma unroll 1
  for (int shift = 24; shift >= 0; shift -= 8) {
    __syncthreads();
    if (tid < 256) hist[tid] = 0u;
    __syncthreads();
#pragma unroll
    for (int i = 0; i < PER; ++i) if (active && (key[i] & mask) == prefix) atomicAdd(&hist[(key[i] >> shift) & 255u], 1u);
    __syncthreads();
    if (wid == 0) {
      const unsigned h0 = hist[lane * 4], h1 = hist[lane * 4 + 1], h2 = hist[lane * 4 + 2], h3 = hist[lane * 4 + 3];
      const unsigned tot = h0 + h1 + h2 + h3; unsigned suf = tot;
#pragma unroll
      for (int o = 1; o < 64; o <<= 1) { const unsigned u = __shfl_down(suf, o); if (lane + o < 64) suf += u; }
      const unsigned above = suf - tot;
      if (above < (unsigned)kk && suf >= (unsigned)kk) {
        unsigned a = above; int bin;
        if (a + h3 >= (unsigned)kk) bin = 3; else { a += h3; if (a + h2 >= (unsigned)kk) bin = 2; else { a += h2; if (a + h1 >= (unsigned)kk) bin = 1; else { a += h1; bin = 0; } } }
        sel[0] = prefix | ((unsigned)(lane * 4 + bin) << shift); sel[1] = (unsigned)kk - a;
      }
    }
    __syncthreads();
    prefix = sel[0]; kk = (int)sel[1]; mask |= 0xffu << shift;
  }
  const unsigned Tk = prefix;
  unsigned cg_ = 0, ce = 0;
#pragma unroll
  for (int i = 0; i < PER; ++i) { cg_ += key[i] > Tk; ce += key[i] == Tk; }
  unsigned pk = active ? (cg_ | (ce << 16)) : 0u, inc = pk;
#pragma unroll
  for (int o = 1; o < 64; o <<= 1) { const unsigned u = __shfl_up(inc, o); if (lane >= o) inc += u; }
  __syncthreads();
  if (lane == 63) wtot[wid] = inc;
  __syncthreads();
  unsigned base = 0;
  for (int w2 = 0; w2 < wid; ++w2) base += wtot[w2];
  const unsigned exc = base + inc - pk; unsigned gt_before = exc & 0xffffu, eq_before = exc >> 16;
  if (active) {
#pragma unroll
    for (int i = 0; i < PER; ++i) {
      const int t = tid * PER + i; int R = -1;
      const bool isgt = key[i] > Tk, iseq = key[i] == Tk;
      if (isgt || (iseq && (int)eq_before < kk)) {
        const int slot = (int)gt_before + min((int)eq_before, kk);
        R = slotbase + slot; IDX[R] = rowbase + t; GV[R] = __uint_as_float(key[i]);
      }
      TS[t] = R;
      gt_before += isgt; eq_before += iseq;
    }
  }
}
__device__ void phase_topk(PRef p, int l, char* smem) {
  const float* aff = (const float*)(p.ws + WS_AFF); int* IDX = (int*)(p.ws + WS_IDX); float* GV = (float*)(p.ws + WS_GV); int* TS = (int*)(p.ws + WS_TS);
  const int nitems = l == 0 ? 256 : 128;
  for (int it = obid(); it < nitems; it += gridDim.x) {
    if (it < 128) { const int b = it >> 4, e = it & 15; topk_item<16>(aff + (size_t)b * SEQ * 16 + e, SEQ, CAPX, b * SEQ, it * CAPX, e, IDX, GV, TS + (size_t)it * SEQ, smem); }
    else { const int v = it - 128, b = v >> 4, e = v & 15; topk_item<1>(aff + ((size_t)MX + b * CTXL) * 16 + e, CTXL, CAPC, MX + b * CTXL, NB * NE * CAPX + e * 256 + b * CAPC, e, IDX, GV, TS + (size_t)NB * 16 * SEQ + (size_t)v * CTXL, smem); }
  }
  __syncthreads();
}

__device__ void phase_moe_up(PRef p, int l, char* smem) {
  LAS unsigned char* lds = (LAS unsigned char*)smem;
  const bf16_t* h = (const bf16_t*)(p.ws + WS_H); const bf16_t* Wgu = (const bf16_t*)(p.ws + WS_WGU); bf16_t* act = (bf16_t*)(p.ws + WS_ACT); const int* IDX = (const int*)(p.ws + WS_IDX);
  const int tid = otid(), wid = tid >> 6, lane = tid & 63, wr = wid >> 2, wc = wid & 3, fr = lane & 15, fq = lane >> 4;
  g8::MoeIter it; it.init(8, l == 0);
  int pm, pn, e;
  while (it.next(pm, pn, e)) {
    unsigned voffA[4];
#pragma unroll
    for (int hh = 0; hh < 2; ++hh)
#pragma unroll
      for (int i = 0; i < 2; ++i) { int R, C; g8::piece_rc(i, R, C); voffA[hh * 2 + i] = (unsigned)(IDX[pm * 256 + hh * 128 + R] * 1024 + C) * 2u; }
    f32x4 acc[2][2][4][2];
    g8::gemm_tile<true>(lds, (const char*)h, voffA, 0, (const char*)(Wgu + ((size_t)e * 2048 + pn * 256) * 1024), 1024, acc);
#pragma unroll
    for (int ai = 0; ai < 2; ++ai)
#pragma unroll
      for (int m = 0; m < 4; ++m) {
          const int row = pm * 256 + ai * 128 + wr * 64 + m * 16 + fr, col = pn * 128 + wc * 32 + fq * 8;
          float a[8];
#pragma unroll
          for (int n = 0; n < 2; ++n) { const f32x4 g = acc[ai][0][m][n], u = acc[ai][1][m][n];
#pragma unroll
            for (int k = 0; k < 4; ++k) a[n * 4 + k] = silu_f(g[k]) * u[k]; }
          u32x4 w = {cvtpk(a[0], a[1]), cvtpk(a[2], a[3]), cvtpk(a[4], a[5]), cvtpk(a[6], a[7])}; *(u32x4*)(act + (size_t)row * 1024 + col) = w;
        }
  }
}
__device__ void phase_moe_down(PRef p, int l, char* smem) {
  LAS unsigned char* lds = (LAS unsigned char*)smem;
  const bf16_t* act = (const bf16_t*)(p.ws + WS_ACT); const bf16_t* Wdn = (const bf16_t*)(p.ws + WS_WDN); bf16_t* oute = (bf16_t*)(p.ws + WS_OUTE); const float* GV = (const float*)(p.ws + WS_GV);
  const int tid = otid(), wid = tid >> 6, lane = tid & 63, wr = wid >> 2, wc = wid & 3, fr = lane & 15, fq = lane >> 4;
  g8::MoeIter it; it.init(4, l == 0);
  int pm, pn, e;
  while (it.next(pm, pn, e)) {
    unsigned voffA[2] = {g8::piece_off(0, 1024, 0), g8::piece_off(1, 1024, 0)};
    f32x4 acc[2][2][4][2];
    g8::gemm_tile<false>(lds, (const char*)(act + (size_t)pm * 256 * 1024), voffA, (size_t)128 * 1024 * 2, (const char*)(Wdn + ((size_t)e * 1024 + pn * 256) * 1024), 1024, acc);
    ACC_FOR3(ai, bj, m) {
      const int row = pm * 256 + ai * 128 + wr * 64 + m * 16 + fr, col = pn * 256 + bj * 128 + wc * 32 + fq * 8;
      const float gv = GV[row]; const f32x4 v0 = acc[ai][bj][m][0] * gv, v1 = acc[ai][bj][m][1] * gv;
      u32x4 w = {cvtpk(v0[0], v0[1]), cvtpk(v0[2], v0[3]), cvtpk(v1[0], v1[1]), cvtpk(v1[2], v1[3])}; *(u32x4*)(oute + (size_t)row * 1024 + col) = w;
    }
  }
}

__device__ void phase_ln2(PRef p, int l) {
  const int lane = otid() & 63, gw = obid() * 8 + (otid() >> 6), nw = gridDim.x * 8;
  bf16_t* h = (bf16_t*)(p.ws + WS_H); float* ctxz = (float*)(p.ws + WS_CTXZ); const bf16_t* oute = (const bf16_t*)(p.ws + WS_OUTE); const int* TS = (const int*)(p.ws + WS_TS);
  const int nrows = l == 0 ? MT : MX;
  for (int row = gw; row < nrows; row += nw) {
    float* xr = row < MX ? p.out + (size_t)row * 1024 : ctxz + (size_t)(row - MX) * 1024;
    f32x4 mo[4];
#pragma unroll
    for (int i = 0; i < 4; ++i) mo[i] = (f32x4){0.f, 0.f, 0.f, 0.f};
    const int myR = lane < 16 ? (row < MX ? TS[((size_t)(row >> 13) * 16 + lane) * SEQ + (row & 8191)] : TS[(size_t)NB * 16 * SEQ + ((size_t)((row - MX) >> 8) * 16 + lane) * CTXL + ((row - MX) & 255)]) : -1;
    for (int e = 0; e < 16; ++e) { const int Rr = __shfl(myR, e);
      if (Rr >= 0) {
#pragma unroll
        for (int i = 0; i < 4; ++i) { const u32x2 w = *(const u32x2*)(oute + (size_t)Rr * 1024 + lane * 4 + 256 * i);
          mo[i][0] += bflo(w[0]); mo[i][1] += bfhi(w[0]); mo[i][2] += bflo(w[1]); mo[i][3] += bfhi(w[1]); } } }
    f32x4 v[4]; const float* m5 = mod_ptr(p, l, row, 5);
#pragma unroll
    for (int i = 0; i < 4; ++i) { const int c = lane * 4 + 256 * i; v[i] = *(const f32x4*)(xr + c) * ALPHA + *(const f32x4*)(m5 + c) * mo[i]; }
    ln_row(v, 1e-5f);
#pragma unroll
    for (int i = 0; i < 4; ++i) { const int c = lane * 4 + 256 * i; v[i] = v[i] * *(const f32x4*)(p.ln2_g + l * 1024 + c) + *(const f32x4*)(p.ln2_b + l * 1024 + c); *(f32x4*)(xr + c) = v[i]; }
    if (l + 1 < DEPTH) { ln_row(v, 1e-6f); store_mod_bf16(v, mod_ptr(p, l + 1, row, 0), mod_ptr(p, l + 1, row, 1), h + (size_t)row * 1024, lane, nullptr); }
  }
}

__device__ __forceinline__ void gsync(cg::grid_group& grid) {
  asm volatile("s_waitcnt vmcnt(0) lgkmcnt(0)" ::: "memory");
  grid.sync();
}
__global__ void __launch_bounds__(512) mega(Params p) {
  extern __shared__ __attribute__((aligned(16))) char smem[];
  cg::grid_group grid = cg::this_grid();
  phase_prep(kparams(), smem);
  gsync(grid);
  phase_h0(kparams());
  gsync(grid);
#pragma unroll 1
  for (int l = 0; l < DEPTH; ++l) {
    phase_inproj(kparams(), l, smem);
    gsync(grid);
    phase_mlstm_pre(kparams(), l, smem);
    gsync(grid);
    phase_mlstm(kparams(), l, smem);
    gsync(grid);
    phase_mla_prep(kparams(), l, smem);
    gsync(grid);
    phase_attn(kparams(), l, smem);
    gsync(grid);
    phase_outproj(kparams(), l, smem);
    gsync(grid);
    phase_ln1(kparams(), l, smem);
    __syncthreads();
    phase_cvt_experts(kparams(), l, smem);
    gsync(grid);
    phase_topk(kparams(), l, smem);
    gsync(grid);
    phase_moe_up(kparams(), l, smem);
    gsync(grid);
    phase_moe_down(kparams(), l, smem);
    gsync(grid);
    phase_ln2(kparams(), l);
    gsync(grid);
  }
}

extern "C" void kernel_launch(void* const* d_in, const int* in_sizes, int n_in, void* d_out, int out_size,
                              void* d_ws, size_t ws_size, hipStream_t stream) {
  constexpr size_t kDynLds = 160 * 1024;
  static int grid_blocks = 0;
  if (!grid_blocks) {
    int dev = 0, cus = 0, per_cu = 0;
    (void)hipGetDevice(&dev);
    (void)hipDeviceGetAttribute(&cus, hipDeviceAttributeMultiprocessorCount, dev);
    (void)hipFuncSetAttribute((const void*)mega, hipFuncAttributeMaxDynamicSharedMemorySize, (int)kDynLds);
    (void)hipOccupancyMaxActiveBlocksPerMultiprocessor(&per_cu, mega, 512, kDynLds);
    grid_blocks = per_cu > 0 ? cus : 0;
    if (grid_blocks > 256) grid_blocks = 256;
    grid_blocks &= ~7;
    if (grid_blocks != 256) { fprintf(stderr, "this kernel needs 256 co-resident workgroups (got %d)\n", grid_blocks); grid_blocks = 0; }
    if (ws_size < WS_END) { fprintf(stderr, "workspace too small: %zu < %zu\n", ws_size, (size_t)WS_END); grid_blocks = 0; }
  }
  if (grid_blocks <= 0) return;
  Params p{};
  const float** pp = (const float**)&p;
  for (int i = 0; i < 24; ++i) pp[i] = (const float*)d_in[i];
  p.out = (float*)d_out; p.ws = (char*)d_ws;
  void* args[] = {&p};
  hipError_t e = hipLaunchCooperativeKernel((void*)mega, dim3(grid_blocks), dim3(512), args, kDynLds, stream);
  if (e != hipSuccess) fprintf(stderr, "cooperative launch failed: %s (grid %d)\n", hipGetErrorString(e), grid_blocks);
}
```

```cpp
#include <hip/hip_runtime.h>
#include <hip/hip_cooperative_groups.h>
#include <cstdio>
#include <cstdint>
namespace cg = cooperative_groups;

typedef unsigned short bf16_t;
typedef short bf16x8 __attribute__((ext_vector_type(8)));
typedef short s16x4 __attribute__((ext_vector_type(4)));
typedef float f32x4 __attribute__((ext_vector_type(4)));
typedef float f32x16 __attribute__((ext_vector_type(16)));
typedef unsigned u32x4 __attribute__((ext_vector_type(4)));
typedef unsigned u32x2 __attribute__((ext_vector_type(2)));
#define LAS __attribute__((address_space(3)))

constexpr int DM = 1024, NB = 8, SEQ = 8192, CTXL = 256, DEPTH = 2;
constexpr int MX = NB * SEQ, MC = NB * CTXL, MT = MX + MC;
constexpr int PLD = 2816;
constexpr int OFF_Q = 0, OFF_K = 512, OFF_V = 1024, OFF_O = 1536, OFF_G = 2048, OFF_CQ = 2064, OFF_CKV = 2448, OFF_KR = 2704, IN_COLS = 2768;
constexpr int SKV = SEQ + CTXL;
constexpr int NE = 16, CAPX = 1024, CAPC = 32;
constexpr int NSLOT = NB * NE * CAPX + NB * NE * CAPC;
constexpr float ALPHA = 1.4142135623730951f;
constexpr float A_SCALE = 0.07216878364870322f;

constexpr size_t al256(size_t v) { return (v + 255) / 256 * 256; }
constexpr size_t WS_H = 0;
constexpr size_t WS_P = WS_H + al256((size_t)MT * 1024 * 2);
constexpr size_t WS_Q = WS_P + al256((size_t)MT * PLD * 2);
constexpr size_t WS_KV = WS_Q + al256((size_t)MT * 768 * 2);
constexpr size_t WS_KR = WS_KV + al256((size_t)NB * SKV * 1024 * 2);
constexpr size_t WS_MIX = WS_KR + al256((size_t)NB * SKV * 64 * 2);
constexpr size_t WS_ACT = WS_P;
constexpr size_t WS_HB = WS_H;
constexpr size_t WS_OUTE = WS_P + al256((size_t)NSLOT * 1024 * 2);
constexpr size_t WS_WGU = WS_MIX;
constexpr size_t WS_WDN = WS_MIX + (size_t)NE * 2048 * 1024 * 2;
constexpr size_t WS_WIN = WS_MIX + al256((size_t)MT * 1024 * 2);
constexpr size_t WS_WUQ = WS_WIN + (size_t)2 * PLD * 1024 * 2;
constexpr size_t WS_WUKV = WS_WUQ + (size_t)2 * 768 * 384 * 2;
constexpr size_t WS_WOUT = WS_WUKV + (size_t)2 * 1024 * 256 * 2;
constexpr size_t WS_MOD = WS_WOUT + (size_t)2 * 1024 * 1024 * 2;
constexpr size_t WS_COS = WS_MOD + al256((size_t)2 * 9 * 6144 * 4);
constexpr size_t WS_SIN = WS_COS + (size_t)SEQ * 32 * 4;
constexpr size_t WS_GATES = WS_SIN + (size_t)SEQ * 32 * 4;
constexpr size_t WS_AFF = WS_GATES + (size_t)MT * 16 * 4;
constexpr size_t WS_IDX = WS_AFF + (size_t)MT * 16 * 4;
constexpr size_t WS_GV = WS_IDX + (size_t)NSLOT * 4;
constexpr size_t WS_TS = WS_GV + (size_t)NSLOT * 4;
constexpr size_t WS_CTXZ = WS_TS + (size_t)MT * 16 * 4;
constexpr size_t WS_BAR = WS_CTXZ + (size_t)MC * 1024 * 4;
constexpr size_t WS_BAR_BYTES = 16384;
constexpr size_t WS_END = WS_BAR + WS_BAR_BYTES;
static_assert(WS_OUTE + (size_t)NSLOT * 1024 * 2 <= WS_KR, "out_e overlay");
static_assert(WS_WDN + (size_t)NE * 1024 * 1024 * 2 <= WS_WIN, "expert weights overlay");

struct Params {
  const float *x, *c, *ctx, *c_ctx, *w_mod, *b_mod, *w_in, *b_gates, *conv_w, *conv_b, *m_norm_w, *q_norm_w, *kv_norm_w, *w_uq, *w_ukv, *w_out,
      *ln1_g, *ln1_b, *w_router, *w_gate, *w_up, *w_down, *ln2_g, *ln2_b;
  float* out; char* ws;
};

typedef const __attribute__((address_space(4))) Params& PRef;
__device__ __forceinline__ PRef kparams() { const __attribute__((address_space(4))) Params* kp = (const __attribute__((address_space(4))) Params*)__builtin_amdgcn_kernarg_segment_ptr(); asm volatile("" : "+s"(kp)); return *kp; }
__device__ __forceinline__ int otid() { int t = threadIdx.x; asm volatile("" : "+v"(t)); return t; }
__device__ __forceinline__ int obid() { int t = blockIdx.x; asm volatile("" : "+s"(t)); return t; }
__device__ __forceinline__ int opaque_s(int v) { asm volatile("" : "+s"(v)); return v; }
typedef __bf16 bf16v2_t __attribute__((ext_vector_type(2)));
typedef float f32x2_t __attribute__((ext_vector_type(2)));
__device__ __forceinline__ unsigned cvtpk(float lo, float hi) { const f32x2_t f = {lo, hi}; const bf16v2_t b = __builtin_convertvector(f, bf16v2_t); return __builtin_bit_cast(unsigned, b); }
__device__ __forceinline__ bf16_t f2bf(float v) { return (bf16_t)(cvtpk(v, v) & 0xffffu); }
__device__ __forceinline__ float bf2f(unsigned v) { return __uint_as_float(v << 16); }
__device__ __forceinline__ float bflo(unsigned w) { return __uint_as_float(w << 16); }
__device__ __forceinline__ float bfhi(unsigned w) { return __uint_as_float(w & 0xffff0000u); }
__device__ __forceinline__ float wave_sum(float v) { for (int o = 32; o > 0; o >>= 1) v += __shfl_xor(v, o); return v; }
__device__ __forceinline__ float wave_max(float v) { for (int o = 32; o > 0; o >>= 1) v = fmaxf(v, __shfl_xor(v, o)); return v; }
__device__ __forceinline__ float sigmoid_f(float v) { return __builtin_amdgcn_rcpf(1.f + __expf(-v)); }
__device__ __forceinline__ float silu_f(float v) { return v * sigmoid_f(v); }

namespace g8 {
constexpr int BK = 64, HALF = 128, HTB = HALF * BK * 2, STAGE_BYTES = 8 * HTB;
__device__ __forceinline__ int lds_byte(int r, int c) { const int st = (r >> 4) * 2 + (c >> 5), rr = r & 15, cc = c & 31, ob = rr * 64 + cc * 2; return st * 1024 + (ob ^ (((ob >> 9) & 1) << 5)); }
__device__ __forceinline__ int perm32(int rho) { const int n = rho >> 4, i = rho & 15; return 8 * (i >> 2) + 4 * n + (i & 3); }
__device__ __forceinline__ void stage_rc(int b, int& R, int& C) { const int st = b / 1024, sb = b % 1024, swz = sb ^ (((sb >> 9) & 1) << 5); R = (st >> 1) * 16 + swz / 64; C = (st & 1) * 32 + (swz % 64) / 2; }

template <bool GATHER>
__device__ __forceinline__ void gemm_tile(LAS unsigned char* lds, const char* __restrict__ Ab, const unsigned (&voffA)[GATHER ? 4 : 2], size_t hstepA, const char* __restrict__ Bb, int K,
                                          f32x4 (&acc)[2][2][4][2]) {
  const int tid = otid(), wid = __builtin_amdgcn_readfirstlane(tid >> 6), lane = tid & 63, wr = wid >> 2, wc = wid & 3, fr = lane & 15, fq = lane >> 4;
  const int nt = K / BK;
  unsigned voffB[2];
#pragma unroll
  for (int i = 0; i < 2; ++i) { int R, C; stage_rc(tid * 16 + i * 8192, R, C); const int Rb = (R & ~31) + perm32(R & 31); voffB[i] = (unsigned)(Rb * K + C) * 2u; }
  const char* Bb1 = Bb + (size_t)HALF * K * 2; const char* Ab1 = GATHER ? Ab : Ab + hstepA;
  const unsigned* vA0 = &voffA[0]; const unsigned* vA1 = GATHER ? &voffA[2] : &voffA[0];
  const unsigned ldsw = (unsigned)wid * 1024u;
  const int aoff = lds_byte(wr * 64 + fr, fq * 8), boff = lds_byte(wc * 32 + fr, fq * 8);
#define G8_SA(b, h) (((b) * 2 + (h)) * HTB)
#define G8_SB(b, h) ((4 + (b) * 2 + (h)) * HTB)
#define G8_STAGE(bufoff, gbase, voff, kt) do { _Pragma("unroll") for (int _i = 0; _i < 2; ++_i) \
    __builtin_amdgcn_global_load_lds((const unsigned*)((gbase) + (size_t)(kt) * (BK * 2) + (voff)[_i]), (LAS unsigned*)(lds + (bufoff) + ldsw + _i * 8192), 16, 0, 0); } while (0)
#define G8_LDA(dst, b, h) do { _Pragma("unroll") for (int m = 0; m < 4; ++m) _Pragma("unroll") for (int k = 0; k < 2; ++k) dst[m][k] = *(const LAS bf16x8*)(lds + G8_SA(b, h) + aoff + m * 2048 + k * 1024); } while (0)
#define G8_LDB(dst, b, h) do { _Pragma("unroll") for (int n = 0; n < 2; ++n) _Pragma("unroll") for (int k = 0; k < 2; ++k) dst[n][k] = *(const LAS bf16x8*)(lds + G8_SB(b, h) + boff + n * 2048 + k * 1024); } while (0)
#define G8_MMA(ai, bj, At, Bt) do { __builtin_amdgcn_s_setprio(1); _Pragma("unroll") for (int m = 0; m < 4; ++m) _Pragma("unroll") for (int n = 0; n < 2; ++n) _Pragma("unroll") for (int k = 0; k < 2; ++k) \
    acc[ai][bj][m][n] = __builtin_amdgcn_mfma_f32_16x16x32_bf16(Bt[n][k], At[m][k], acc[ai][bj][m][n], 0, 0, 0); __builtin_amdgcn_s_setprio(0); } while (0)
#define G8_WAIT_V(n) asm volatile("s_waitcnt vmcnt(" #n ")" ::: "memory")
#define G8_WAIT_L(n) asm volatile("s_waitcnt lgkmcnt(" #n ")" ::: "memory")
#define G8_BAR __builtin_amdgcn_s_barrier()
#define G8_SCHED __builtin_amdgcn_sched_barrier(0)
#pragma unroll
  for (int a = 0; a < 2; ++a)
#pragma unroll
    for (int b = 0; b < 2; ++b)
#pragma unroll
      for (int m = 0; m < 4; ++m)
#pragma unroll
        for (int n = 0; n < 2; ++n) acc[a][b][m][n] = (f32x4){0.f, 0.f, 0.f, 0.f};
  bf16x8 At[4][2], B0[2][2], B1[2][2];
  G8_WAIT_V(0); __syncthreads();
  G8_STAGE(G8_SB(0, 0), Bb, voffB, 0); G8_STAGE(G8_SA(0, 0), Ab, vA0, 0); G8_STAGE(G8_SB(0, 1), Bb1, voffB, 0); G8_STAGE(G8_SA(0, 1), Ab1, vA1, 0);
  if (wr == 1) G8_BAR;
  G8_WAIT_V(4); G8_BAR;
  G8_STAGE(G8_SB(1, 0), Bb, voffB, 1); G8_STAGE(G8_SA(1, 0), Ab, vA0, 1); G8_STAGE(G8_SB(1, 1), Bb1, voffB, 1);
  G8_WAIT_V(6); G8_BAR;
  for (int t = 0; t < nt - 2; t += 2) {
    G8_LDB(B0, 0, 0); G8_SCHED; G8_LDA(At, 0, 0); G8_STAGE(G8_SA(1, 1), Ab1, vA1, t + 1);
    G8_WAIT_L(8); G8_BAR; G8_WAIT_L(0); G8_MMA(0, 0, At, B0); G8_BAR; G8_SCHED;
    G8_LDB(B1, 0, 1); G8_STAGE(G8_SB(0, 0), Bb, voffB, t + 2);
    G8_BAR; G8_WAIT_L(0); G8_MMA(0, 1, At, B1); G8_BAR;
    G8_LDA(At, 0, 1); G8_STAGE(G8_SA(0, 0), Ab, vA0, t + 2);
    G8_BAR; G8_WAIT_L(0); G8_MMA(1, 0, At, B0); G8_BAR; G8_SCHED;
    G8_STAGE(G8_SB(0, 1), Bb1, voffB, t + 2);
    G8_WAIT_V(6); G8_BAR; G8_MMA(1, 1, At, B1); G8_BAR;
    G8_LDB(B0, 1, 0); G8_SCHED; G8_LDA(At, 1, 0); G8_STAGE(G8_SA(0, 1), Ab1, vA1, t + 2);
    G8_WAIT_L(8); G8_BAR; G8_WAIT_L(0); G8_MMA(0, 0, At, B0); G8_BAR; G8_SCHED;
    G8_LDB(B1, 1, 1); G8_STAGE(G8_SB(1, 0), Bb, voffB, t + 3);
    G8_BAR; G8_WAIT_L(0); G8_MMA(0, 1, At, B1); G8_BAR;
    G8_LDA(At, 1, 1); G8_STAGE(G8_SA(1, 0), Ab, vA0, t + 3);
    G8_BAR; G8_WAIT_L(0); G8_MMA(1, 0, At, B0); G8_BAR; G8_SCHED;
    G8_STAGE(G8_SB(1, 1), Bb1, voffB, t + 3);
    G8_WAIT_V(6); G8_BAR; G8_MMA(1, 1, At, B1); G8_BAR;
  }
  { G8_LDB(B0, 0, 0); G8_LDA(At, 0, 0); G8_STAGE(G8_SA(1, 1), Ab1, vA1, nt - 1);
    G8_BAR; G8_WAIT_L(0); G8_MMA(0, 0, At, B0); G8_BAR;
    G8_LDB(B1, 0, 1); G8_BAR; G8_WAIT_L(0); G8_MMA(0, 1, At, B1); G8_BAR;
    G8_LDA(At, 0, 1); G8_WAIT_V(4); G8_BAR; G8_WAIT_L(0); G8_MMA(1, 0, At, B0); G8_MMA(1, 1, At, B1); G8_BAR; }
  { G8_LDB(B0, 1, 0); G8_LDA(At, 1, 0); G8_WAIT_V(2); G8_BAR; G8_WAIT_L(0); G8_MMA(0, 0, At, B0); G8_BAR;
    G8_LDB(B1, 1, 1); G8_WAIT_V(0); G8_BAR; G8_WAIT_L(0); G8_MMA(0, 1, At, B1); G8_BAR;
    G8_LDA(At, 1, 1); G8_BAR; G8_WAIT_L(0); G8_MMA(1, 0, At, B0); G8_MMA(1, 1, At, B1); G8_BAR; }
  if (wr == 0) G8_BAR;
}
__device__ __forceinline__ unsigned piece_off(int i, int ld, int c0) { int R, C; stage_rc((int)otid() * 16 + i * 8192, R, C); return (unsigned)(R * ld + c0 + C) * 2u; }
__device__ __forceinline__ void piece_rc(int i, int& R, int& C) { stage_rc((int)otid() * 16 + i * 8192, R, C); }
struct TileIter {
  int nM, nN, x, j, J, cnt, idx;
  __device__ __forceinline__ void init(int nM_, int nN_) { nM = nM_; nN = nN_; x = obid() & 7; j = obid() >> 3; J = gridDim.x >> 3; cnt = ((nM - x + 7) >> 3) * nN; idx = j; }
  __device__ __forceinline__ bool next(int& pm, int& pn) { if (idx >= cnt) return false; pm = x + 8 * (idx / nN); pn = idx % nN; idx += J; return true; }
};
struct MoeIter {
  int nN, x, jm, jn, j, step, nsteps, nb4; bool with_ctx, ctx_done, wide;
  __device__ __forceinline__ void init(int nN_, bool with_ctx_) { nN = nN_; with_ctx = with_ctx_; wide = nN_ == 8; x = obid() & 7; j = obid() >> 3;
    if (wide) { jm = j & 3; jn = j >> 2; nsteps = 16; } else { jm = j & 7; jn = j >> 3; nsteps = 2 * (nN >> 2) * 4; }
    nb4 = nN >> 2; step = 0; ctx_done = false; }
  __device__ __forceinline__ bool next(int& pm, int& pn, int& e) {
    if (step < nsteps) {
      int m32;
      if (wide) { const int mb = step & 7, el = step >> 3; e = 2 * x + el; m32 = mb * 4 + jm; pn = jn; }
      else { const int mb = step & 3, nb = (step >> 2) % nb4, el = (step >> 2) / nb4; e = 2 * x + el; m32 = mb * 8 + jm; pn = nb * 4 + jn; }
      pm = ((m32 >> 2) * 16 + e) * 4 + (m32 & 3); ++step; return true; }
    if (with_ctx && !ctx_done) { ctx_done = true; if (j < 2 * nN) { e = 2 * x + j / nN; pm = 512 + e; pn = j % nN; return true; } }
    return false;
  }
};
}

#define ACC_FOR3(ai, bj, m) _Pragma("unroll") for (int ai = 0; ai < 2; ++ai) _Pragma("unroll") for (int bj = 0; bj < 2; ++bj) _Pragma("unroll") for (int m = 0; m < 4; ++m)
#define ACC_FOR(ai, bj, m, n) _Pragma("unroll") for (int ai = 0; ai < 2; ++ai) _Pragma("unroll") for (int bj = 0; bj < 2; ++bj) _Pragma("unroll") for (int m = 0; m < 4; ++m) _Pragma("unroll") for (int n = 0; n < 2; ++n)

__device__ __forceinline__ void cvt_tile(const float* __restrict__ src, int N, int K, int k0, int n0, bf16_t* __restrict__ dst, long drow0, const float* __restrict__ kscale, float* lds) {
  const int tid = otid();
  { const int kr = tid >> 6, n = tid & 63;
#pragma unroll
    for (int i = 0; i < 8; ++i) { const int k = kr + 8 * i; float v = (n0 + n < N) ? src[(size_t)(k0 + k) * N + n0 + n] : 0.f; if (kscale) v *= kscale[k0 + k]; lds[k * 65 + n] = v; } }
  __syncthreads();
  { const int n = tid >> 3, k8 = (tid & 7) * 8; float v[8];
#pragma unroll
    for (int i = 0; i < 8; ++i) v[i] = lds[(k8 + i) * 65 + n];
    u32x4 w = {cvtpk(v[0], v[1]), cvtpk(v[2], v[3]), cvtpk(v[4], v[5]), cvtpk(v[6], v[7])};
    *(u32x4*)(dst + (size_t)(drow0 + n) * K + k0 + k8) = w; }
  __syncthreads();
}

__device__ void phase_prep(PRef p, char* smem) {
  float* lds = (float*)smem;
  bf16_t* Wt_in = (bf16_t*)(p.ws + WS_WIN); bf16_t* Wt_uq = (bf16_t*)(p.ws + WS_WUQ); bf16_t* Wt_ukv = (bf16_t*)(p.ws + WS_WUKV); bf16_t* Wt_out = (bf16_t*)(p.ws + WS_WOUT);
  float* mod = (float*)(p.ws + WS_MOD);
  constexpr int T_MOD = 192, T_IN = 2 * 16 * 44, T_UQ = 2 * 6 * 12, T_UKV = 2 * 4 * 16, T_OUT = 2 * 16 * 16, T_ROPE = 64;
  constexpr int E0 = T_MOD, E1 = E0 + T_IN, E2 = E1 + T_UQ, E3 = E2 + T_UKV, E4 = E3 + T_OUT, E5 = E4 + T_ROPE;
  const int tid = otid();
  for (int task = obid(); task < E5; task += gridDim.x) {
    if (task < E0) {
      const int l = task / 96, j0 = (task % 96) * 64;
      float* sc = lds;
      for (int i = tid; i < 9 * 1024; i += 512) { const int bb = i >> 10, d = i & 1023; const float v = bb < 8 ? p.c[bb * 1024 + d] : p.c_ctx[d]; sc[i] = v / (1.f + expf(-v)); }
      __syncthreads();
      const int col = tid & 63, ks = tid >> 6; float a[9];
#pragma unroll
      for (int bb = 0; bb < 9; ++bb) a[bb] = 0.f;
      const float* wm = p.w_mod + (size_t)l * 1024 * 6144 + j0 + col;
      for (int d = ks * 128; d < ks * 128 + 128; ++d) { const float w = wm[(size_t)d * 6144];
#pragma unroll
        for (int bb = 0; bb < 9; ++bb) a[bb] += sc[bb * 1024 + d] * w; }
      float* red = lds + 9 * 1024;
#pragma unroll
      for (int bb = 0; bb < 9; ++bb) red[(ks * 9 + bb) * 64 + col] = a[bb];
      __syncthreads();
      for (int i = tid; i < 9 * 64; i += 512) { const int bb = i >> 6, cc = i & 63; float s = 0.f;
        for (int k = 0; k < 8; ++k) s += red[(k * 9 + bb) * 64 + cc];
        mod[((size_t)l * 9 + bb) * 6144 + j0 + cc] = s + p.b_mod[l * 6144 + j0 + cc]; }
      __syncthreads();
    } else if (task < E1) { const int t = task - E0, l = t / 704, r = t % 704, kt = r / 44, nt = r % 44;
      cvt_tile(p.w_in + (size_t)l * 1024 * IN_COLS, IN_COLS, 1024, kt * 64, nt * 64, Wt_in + (size_t)l * PLD * 1024, nt * 64, nullptr, lds);
    } else if (task < E2) { const int t = task - E1, l = t / 72, r = t % 72, kt = r / 12, nt = r % 12;
      cvt_tile(p.w_uq + (size_t)l * 384 * 768, 768, 384, kt * 64, nt * 64, Wt_uq + (size_t)l * 768 * 384, nt * 64, p.q_norm_w + l * 384, lds);
    } else if (task < E3) { const int t = task - E2, l = t / 64, r = t % 64, kt = r / 16, nt = r % 16;
      cvt_tile(p.w_ukv + (size_t)l * 256 * 1024, 1024, 256, kt * 64, nt * 64, Wt_ukv + (size_t)l * 1024 * 256, nt * 64, p.kv_norm_w + l * 256, lds);
    } else if (task < E4) { const int t = task - E3, l = t / 256, r = t % 256, kt = r / 16, nt = r % 16;
      cvt_tile(p.w_out + (size_t)l * 1024 * 1024, 1024, 1024, kt * 64, nt * 64, Wt_out + (size_t)l * 1024 * 1024, nt * 64, nullptr, lds);
    } else {
      float* cs = (float*)(p.ws + WS_COS); float* sn = (float*)(p.ws + WS_SIN);
      for (int i = (task - E4) * 4096 + tid; i < (task - E4 + 1) * 4096; i += 512) { const int t = i >> 5, j = i & 31;
        const float inv = exp2f(-(float)(j & 15) * (13.287712379549449f / 16.f));
        const float pos = (float)(j < 16 ? (t >> 6) : (t & 63)); const float ang = pos * inv;
        const double a = (double)ang; const double k = rint(a * 0.15915494309189535); const float r = (float)(a - k * 6.283185307179586);
        cs[i] = __cosf(r); sn[i] = __sinf(r); }
    }
  }
}

__device__ void phase_cvt_experts(PRef p, int l, char* smem) {
  float* lds = (float*)smem;
  bf16_t* Wgu = (bf16_t*)(p.ws + WS_WGU); bf16_t* Wdn = (bf16_t*)(p.ws + WS_WDN);
  const int tid = otid();
  for (int task = obid(); task < NE * 192; task += gridDim.x) {
    const int e = task / 192, r = task % 192, which = r >> 6, kt = (r & 63) >> 2, nt = r & 3, k0 = kt * 64, n0 = nt * 256;
    const float* src = (which == 0 ? p.w_gate : which == 1 ? p.w_up : p.w_down) + ((size_t)l * NE + e) * 1024 * 1024;
    { const int kr = tid >> 6, n4 = (tid & 63) * 4;
#pragma unroll
      for (int i = 0; i < 8; ++i) { const int k = kr + 8 * i; *(f32x4*)(lds + k * 260 + n4) = *(const f32x4*)(src + (size_t)(k0 + k) * 1024 + n0 + n4); } }
    __syncthreads();
    { const int nl = tid >> 1, k32 = (tid & 1) * 32, n = n0 + nl;
      const size_t drow = which == 2 ? (size_t)n : (size_t)((n >> 7) * 256 + which * 128 + (n & 127));
      bf16_t* dst = (which == 2 ? Wdn + (size_t)e * 1024 * 1024 : Wgu + (size_t)e * 2048 * 1024) + drow * 1024 + k0 + k32;
#pragma unroll
      for (int q = 0; q < 4; ++q) { float v[8];
#pragma unroll
        for (int i = 0; i < 8; ++i) v[i] = lds[(k32 + q * 8 + i) * 260 + nl];
        u32x4 w = {cvtpk(v[0], v[1]), cvtpk(v[2], v[3]), cvtpk(v[4], v[5]), cvtpk(v[6], v[7])};
        *(u32x4*)(dst + q * 8) = w; } }
    __syncthreads();
  }
}

__device__ __forceinline__ void ln_row(f32x4 (&v)[4], float eps) {
  float s = 0.f;
#pragma unroll
  for (int i = 0; i < 4; ++i) s += v[i][0] + v[i][1] + v[i][2] + v[i][3];
  const float mu = wave_sum(s) * (1.f / 1024.f);
  float q = 0.f;
#pragma unroll
  for (int i = 0; i < 4; ++i)
#pragma unroll
    for (int k = 0; k < 4; ++k) { v[i][k] -= mu; q += v[i][k] * v[i][k]; }
  const float rs = rsqrtf(wave_sum(q) * (1.f / 1024.f) + eps);
#pragma unroll
  for (int i = 0; i < 4; ++i) v[i] *= rs;
}
__device__ __forceinline__ void store_mod_bf16(const f32x4 (&v)[4], const float* __restrict__ shift, const float* __restrict__ scale, bf16_t* __restrict__ hrow, int lane, f32x4 (*keep)[4]) {
#pragma unroll
  for (int i = 0; i < 4; ++i) { const int c = lane * 4 + 256 * i; const f32x4 sh = *(const f32x4*)(shift + c), sc = *(const f32x4*)(scale + c);
    f32x4 o = v[i] * (sc + 1.f) + sh; if (keep) (*keep)[i] = o;
    u32x2 w = {cvtpk(o[0], o[1]), cvtpk(o[2], o[3])}; *(u32x2*)(hrow + c) = w; }
}
__device__ __forceinline__ const float* mod_ptr(PRef p, int l, int row, int which) {
  const int bb = row < MX ? (row >> 13) : 8;
  return (const float*)(p.ws + WS_MOD) + ((size_t)l * 9 + bb) * 6144 + which * 1024;
}

__device__ void phase_h0(PRef p) {
  const int lane = otid() & 63, gw = obid() * 8 + (otid() >> 6), nw = gridDim.x * 8;
  bf16_t* h = (bf16_t*)(p.ws + WS_H);
  for (int row = gw; row < MT; row += nw) {
    const float* src = row < MX ? p.x + (size_t)row * 1024 : p.ctx + (size_t)(row - MX) * 1024;
    f32x4 v[4];
#pragma unroll
    for (int i = 0; i < 4; ++i) v[i] = *(const f32x4*)(src + lane * 4 + 256 * i);
    ln_row(v, 1e-6f);
    store_mod_bf16(v, mod_ptr(p, 0, row, 0), mod_ptr(p, 0, row, 1), h + (size_t)row * 1024, lane, nullptr);
  }
}

__device__ void phase_inproj(PRef p, int l, char* smem) {
  LAS unsigned char* lds = (LAS unsigned char*)smem;
  const bf16_t* h = (const bf16_t*)(p.ws + WS_H); const bf16_t* Wt = (const bf16_t*)(p.ws + WS_WIN) + (size_t)l * PLD * 1024;
  bf16_t* P = (bf16_t*)(p.ws + WS_P); float* gates = (float*)(p.ws + WS_GATES);
  const int tid = otid(), wid = tid >> 6, lane = tid & 63, wr = wid >> 2, wc = wid & 3, fr = lane & 15, fq = lane >> 4;
  g8::TileIter it; it.init(MT / 256, PLD / 256);
  int pm, pn;
  while (it.next(pm, pn)) {
    unsigned voffA[2] = {g8::piece_off(0, 1024, 0), g8::piece_off(1, 1024, 0)};
    f32x4 acc[2][2][4][2];
    g8::gemm_tile<false>(lds, (const char*)(h + (size_t)pm * 256 * 1024), voffA, (size_t)128 * 1024 * 2, (const char*)(Wt + (size_t)pn * 256 * 1024), 1024, acc);
    ACC_FOR3(ai, bj, m) {
      const int row = pm * 256 + ai * 128 + wr * 64 + m * 16 + fr, col = pn * 256 + bj * 128 + wc * 32 + fq * 8;
      const f32x4 v0 = acc[ai][bj][m][0], v1 = acc[ai][bj][m][1];
      u32x4 w = {cvtpk(v0[0], v0[1]), cvtpk(v0[2], v0[3]), cvtpk(v1[0], v1[1]), cvtpk(v1[2], v1[3])}; *(u32x4*)(P + (size_t)row * PLD + col) = w;
      if (col >= OFF_G && col < OFF_G + 16) { const f32x4 bg0 = *(const f32x4*)(p.b_gates + l * 16 + (col - OFF_G)), bg1 = *(const f32x4*)(p.b_gates + l * 16 + (col - OFF_G) + 4);
        *(f32x4*)(gates + (size_t)row * 16 + (col - OFF_G)) = v0 + bg0; *(f32x4*)(gates + (size_t)row * 16 + (col - OFF_G) + 4) = v1 + bg1; }
    }
  }
}


constexpr size_t WS_QKC = WS_KV;
constexpr size_t WS_SCAL = WS_Q;
__device__ void phase_mlstm_pre(PRef p, int l, char* smem) {
  const bf16_t* P = (const bf16_t*)(p.ws + WS_P); const float* gates = (const float*)(p.ws + WS_GATES);
  bf16_t* QKC = (bf16_t*)(p.ws + WS_QKC); float* SCAL = (float*)(p.ws + WS_SCAL);
  const int tid = otid(), wid = tid >> 6, lane = tid & 63;
  if (obid() < 64) {
    const int chain = obid(), dir = chain & 1, hd = (chain >> 1) & 3, b = chain >> 3;
    float* LA = (float*)smem; float* LB = LA + 132 * 64; float* LP = LB + 132 * 64; float* b63s = LP + 132 * 64; float* pm63s = b63s + 132; float* mbs = pm63s + 132;
    for (int ci = wid; ci < 132; ci += 8) {
      const bool ic = ci < 4; const int cc = ic ? ci : ci - 4, T = ic ? CTXL : SEQ, rb = ic ? MX + b * CTXL : b * SEQ, tlo = dir ? T - 64 - cc * 64 : cc * 64;
      const int t = dir ? tlo + 63 - lane : tlo + lane; const float* g = gates + (size_t)(rb + t) * 16;
      const float ig = g[dir * 8 + hd], fg = g[dir * 8 + 4 + hd];
      const float lf = fminf(fg, 0.f) - log1pf(expf(-fabsf(fg)));
      float bc = lf;
#pragma unroll
      for (int o = 1; o < 64; o <<= 1) { const float u = __shfl_up(bc, o); if (lane >= o) bc += u; }
      const float a = ig - bc; float pmx = a;
#pragma unroll
      for (int o = 1; o < 64; o <<= 1) { const float u = __shfl_up(pmx, o); if (lane >= o) pmx = fmaxf(pmx, u); }
      LA[ci * 64 + lane] = a; LB[ci * 64 + lane] = bc; LP[ci * 64 + lane] = pmx;
      if (lane == 63) { b63s[ci] = bc; pm63s[ci] = pmx; }
    }
    __syncthreads();
    if (tid == 0) { float m = 0.f; for (int ci = 0; ci < 132; ++ci) { mbs[ci] = m; m = b63s[ci] + fmaxf(pm63s[ci], m); } }
    __syncthreads();
    for (int ci = wid; ci < 132; ci += 8) {
      const float m = mbs[ci], a = LA[ci * 64 + lane], bc = LB[ci * 64 + lane], pmx = LP[ci * 64 + lane];
      const float Mx = fmaxf(pmx, m), M63 = fmaxf(pm63s[ci], m);
      float* S = SCAL + ((size_t)chain * 132 + ci) * 384;
      S[lane] = a; S[64 + lane] = Mx; S[128 + lane] = __expf(m - Mx); S[192 + lane] = __expf(-(bc + Mx)); S[256 + lane] = __expf(a - M63);
      S[320 + lane] = lane == 0 ? __expf(m - M63) : 0.f;
    }
    return;
  }
  const int col8 = (tid & 127) * 8, rg = tid >> 7;
  float w[5][8], bia[8];
#pragma unroll
  for (int j = 0; j < 5; ++j) { const f32x4 w0 = *(const f32x4*)(p.conv_w + ((size_t)l * 5 + j) * 1024 + col8), w1 = *(const f32x4*)(p.conv_w + ((size_t)l * 5 + j) * 1024 + col8 + 4);
#pragma unroll
    for (int k = 0; k < 4; ++k) { w[j][k] = w0[k]; w[j][4 + k] = w1[k]; } }
  { const f32x4 b0 = *(const f32x4*)(p.conv_b + l * 1024 + col8), b1 = *(const f32x4*)(p.conv_b + l * 1024 + col8 + 4);
#pragma unroll
    for (int k = 0; k < 4; ++k) { bia[k] = b0[k]; bia[4 + k] = b1[k]; } }
  const float osc = col8 < 512 ? 0.08838834764831845f : 1.f;
#pragma unroll 1
  for (int rb = obid() - 64; rb < MT / 64; rb += gridDim.x - 64) {
    const int R0 = rb * 64, seg_lo = R0 < MX ? (R0 & ~8191) : MX + ((R0 - MX) & ~255), seg_hi = seg_lo + (R0 < MX ? SEQ : CTXL);
    const int r0 = R0 + rg * 16;
    u32x4 raw[20];
#pragma unroll
    for (int i = 0; i < 20; ++i) { const int r = r0 - 2 + i; raw[i] = (u32x4){0u, 0u, 0u, 0u}; if (r >= seg_lo && r < seg_hi) raw[i] = *(const u32x4*)(P + (size_t)r * PLD + col8); }
#pragma unroll
    for (int i = 0; i < 16; ++i) {
      float y[8];
#pragma unroll
      for (int k = 0; k < 8; ++k) y[k] = bia[k];
#pragma unroll
      for (int tp = 0; tp < 5; ++tp) {
#pragma unroll
        for (int k = 0; k < 4; ++k) { y[2 * k] += w[tp][2 * k] * bflo(raw[i + tp][k]); y[2 * k + 1] += w[tp][2 * k + 1] * bfhi(raw[i + tp][k]); } }
#pragma unroll
      for (int k = 0; k < 8; ++k) y[k] = silu_f(y[k]) * osc;
      u32x4 o = {cvtpk(y[0], y[1]), cvtpk(y[2], y[3]), cvtpk(y[4], y[5]), cvtpk(y[6], y[7])};
      *(u32x4*)(QKC + (size_t)(r0 + i) * 1024 + col8) = o;
    }
  }
}

__device__ void phase_mlstm(PRef p, int l, char* smem) {
  bf16_t* QBb[2] = {(bf16_t*)(smem), (bf16_t*)(smem + 17408)};
  bf16_t* KB = (bf16_t*)(smem + 34816);
  bf16_t* KT = (bf16_t*)(smem + 52224);
  bf16_t* VTb[2] = {(bf16_t*)(smem + 70656), (bf16_t*)(smem + 77568)};
  bf16_t* VWT = (bf16_t*)(smem + 84480);
  bf16_t* PB = (bf16_t*)(smem + 91392);
  bf16_t* CTb[2] = {(bf16_t*)(smem + 100608), (bf16_t*)(smem + 113664)};
  float* SC = (float*)(smem + 126720);
  const bf16_t* P = (const bf16_t*)(p.ws + WS_P); const bf16_t* QKC = (const bf16_t*)(p.ws + WS_QKC); const float* SCAL = (const float*)(p.ws + WS_SCAL);
  bf16_t* hbuf = (bf16_t*)(p.ws + WS_HB);
  for (int w = obid(); w < 256; w += gridDim.x) {
    const int slice = (w >> 3) & 3, chain = (w & 7) * 8 + (w >> 5), dir = chain & 1, hd = (chain >> 1) & 3, b = chain >> 3;
    const float* SCc = SCAL + (size_t)chain * 132 * 384;
    __syncthreads();
    { const int tid = otid();
      for (int i = tid; i < 48 * 136 / 2; i += 512) { ((unsigned*)CTb[0])[i] = 0u; ((unsigned*)CTb[1])[i] = 0u; }
      for (int i = tid; i < 48 * 72 / 2; i += 512) { ((unsigned*)VTb[0])[i] = 0u; ((unsigned*)VTb[1])[i] = 0u; ((unsigned*)VWT)[i] = 0u; } }
    f32x4 accC[3];
#pragma unroll
    for (int i = 0; i < 3; ++i) accC[i] = (f32x4){0.f, 0.f, 0.f, 0.f};
    struct Pre { u32x4 qk[4]; u32x2 v; f32x4 s; float ws, ws1; };
    Pre preA, preB;
    preA.s = (f32x4){0.f, 0.f, 0.f, 0.f}; preB.s = preA.s;
#define MLSTM_PREFETCH(PR, CI) do { const int tid_ = otid(); const int ci_ = (CI); const bool ic_ = ci_ < 4; const int cc_ = ic_ ? ci_ : ci_ - 4, T_ = ic_ ? CTXL : SEQ, rb_ = ic_ ? MX + b * CTXL : b * SEQ; \
      const int tlo_ = dir ? T_ - 64 - cc_ * 64 : cc_ * 64; \
      _Pragma("unroll") for (int k_ = 0; k_ < 4; ++k_) { const int pc = tid_ + k_ * 512, tens = pc >> 10, rem = pc & 1023, lr = rem >> 4, c16 = rem & 15, t = dir ? tlo_ + 63 - lr : tlo_ + lr; \
        PR.qk[k_] = *(const u32x4*)(QKC + (size_t)(rb_ + t) * 1024 + tens * 512 + hd * 128 + c16 * 8); } \
      { const int vl_ = tid_ >> 3, vt_ = dir ? tlo_ + 63 - vl_ : tlo_ + vl_; PR.v = *(const u32x2*)(P + (size_t)(rb_ + vt_) * PLD + OFF_V + hd * 128 + slice * 32 + (tid_ & 7) * 4); \
        PR.ws = SCc[(size_t)ci_ * 384 + 256 + vl_]; PR.ws1 = SCc[(size_t)ci_ * 384 + 256 + (tid_ & 63)]; } \
      if (tid_ < 96) PR.s = *(const f32x4*)(SCc + (size_t)ci_ * 384 + tid_ * 4); } while (0)
    MLSTM_PREFETCH(preA, 0);
    MLSTM_PREFETCH(preB, 1);
    __syncthreads();
    auto step = [&](const int ci, Pre& pre) __attribute__((always_inline)) {
      const int tid = otid(), wid = tid >> 6, lane = tid & 63, fr = lane & 15, fq = lane >> 4;
      const bool isctx = ci < 4; const int cc = isctx ? ci : ci - 4, T = isctx ? CTXL : SEQ, rowbase = isctx ? MX + b * CTXL : b * SEQ;
      const int tlo = dir ? T - 64 - cc * 64 : cc * 64;
      const int par = ci & 1;
      bf16_t* QB = QBb[par]; bf16_t* VT = VTb[par]; float* S = SC + par * 384; bf16_t* CTc = CTb[par]; bf16_t* CTn = CTb[par ^ 1];
      const bool need_out = !(l == DEPTH - 1 && isctx);
#pragma unroll
      for (int k = 0; k < 4; ++k) { const int pc = tid + k * 512, tens = pc >> 10, rem = pc & 1023, lr = rem >> 4, c16 = rem & 15;
        if (tens == 0) *(u32x4*)(QB + lr * 136 + c16 * 8) = pre.qk[k];
        else { *(u32x4*)(KB + lr * 136 + c16 * 8) = pre.qk[k];
#pragma unroll
          for (int i = 0; i < 4; ++i) { KT[(c16 * 8 + 2 * i) * 72 + lr] = (bf16_t)(pre.qk[k][i] & 0xffffu); KT[(c16 * 8 + 2 * i + 1) * 72 + lr] = (bf16_t)(pre.qk[k][i] >> 16); } } }
      { const int vl = tid >> 3, ve4 = (tid & 7) * 4; const float wsl = pre.ws;
        VT[(ve4 + 0) * 72 + vl] = (bf16_t)(pre.v[0] & 0xffffu); VT[(ve4 + 1) * 72 + vl] = (bf16_t)(pre.v[0] >> 16);
        VT[(ve4 + 2) * 72 + vl] = (bf16_t)(pre.v[1] & 0xffffu); VT[(ve4 + 3) * 72 + vl] = (bf16_t)(pre.v[1] >> 16);
        VWT[(ve4 + 0) * 72 + vl] = f2bf(bflo(pre.v[0]) * wsl); VWT[(ve4 + 1) * 72 + vl] = f2bf(bfhi(pre.v[0]) * wsl);
        VWT[(ve4 + 2) * 72 + vl] = f2bf(bflo(pre.v[1]) * wsl); VWT[(ve4 + 3) * 72 + vl] = f2bf(bfhi(pre.v[1]) * wsl);
        if (tid < 64) { VT[32 * 72 + tid] = (bf16_t)0x3F80u; VWT[32 * 72 + tid] = f2bf(pre.ws1); }
        if (tid < 96) *(f32x4*)(S + tid * 4) = pre.s; }
      if (ci + 2 < 132) MLSTM_PREFETCH(pre, ci + 2);
      __syncthreads();
      if (need_out) {
        const int mt = wid >> 1;
#pragma unroll
        for (int u = 0; u < 2; ++u) {
          const int ntl = (wid & 1) * 2 + u;
          f32x4 sacc = {0.f, 0.f, 0.f, 0.f};
          if (ntl <= mt) {
#pragma unroll
            for (int kk = 0; kk < 4; ++kk) {
              const bf16x8 a = *(const bf16x8*)(QB + (mt * 16 + fr) * 136 + kk * 32 + fq * 8), bb = *(const bf16x8*)(KB + (ntl * 16 + fr) * 136 + kk * 32 + fq * 8);
              sacc = __builtin_amdgcn_mfma_f32_16x16x32_bf16(a, bb, sacc, 0, 0, 0); }
          }
          const int j = ntl * 16 + fr; const float aj = S[j];
#pragma unroll
          for (int jj = 0; jj < 4; ++jj) { const int lr = mt * 16 + fq * 4 + jj;
            const float pv = (j <= lr) ? sacc[jj] * __expf(fminf(aj - S[64 + lr], 0.f)) : 0.f;
            PB[lr * 72 + j] = f2bf(pv); }
        }
      }
      {
        const float decay = S[320];
#pragma unroll
        for (int mt = 0; mt < 3; ++mt) {
          accC[mt] *= decay;
#pragma unroll
          for (int kk = 0; kk < 2; ++kk) { const bf16x8 a = *(const bf16x8*)(VWT + (mt * 16 + fr) * 72 + kk * 32 + fq * 8), bb = *(const bf16x8*)(KT + (wid * 16 + fr) * 72 + kk * 32 + fq * 8);
            accC[mt] = __builtin_amdgcn_mfma_f32_16x16x32_bf16(a, bb, accC[mt], 0, 0, 0); }
#pragma unroll
          for (int jj = 0; jj < 4; ++jj) CTn[(mt * 16 + fq * 4 + jj) * 136 + wid * 16 + fr] = f2bf(accC[mt][jj]);
        }
      }
      __syncthreads();
      if (need_out && wid < 4) {
        const int mt = wid; f32x4 num[3];
#pragma unroll
        for (int ntl = 0; ntl < 3; ++ntl) {
          f32x4 a1 = {0.f, 0.f, 0.f, 0.f}, a2 = {0.f, 0.f, 0.f, 0.f};
#pragma unroll
          for (int kk = 0; kk < 2; ++kk) { const bf16x8 a = *(const bf16x8*)(PB + (mt * 16 + fr) * 72 + kk * 32 + fq * 8), bb = *(const bf16x8*)(VT + (ntl * 16 + fr) * 72 + kk * 32 + fq * 8);
            a1 = __builtin_amdgcn_mfma_f32_16x16x32_bf16(a, bb, a1, 0, 0, 0); }
#pragma unroll
          for (int kk = 0; kk < 4; ++kk) { const bf16x8 a = *(const bf16x8*)(QB + (mt * 16 + fr) * 136 + kk * 32 + fq * 8), bb = *(const bf16x8*)(CTc + (ntl * 16 + fr) * 136 + kk * 32 + fq * 8);
            a2 = __builtin_amdgcn_mfma_f32_16x16x32_bf16(a, bb, a2, 0, 0, 0); }
#pragma unroll
          for (int jj = 0; jj < 4; ++jj) num[ntl][jj] = a1[jj] + S[128 + mt * 16 + fq * 4 + jj] * a2[jj];
        }
#pragma unroll
        for (int jj = 0; jj < 4; ++jj) {
          const int lr = mt * 16 + fq * 4 + jj; const float den = __shfl(num[2][jj], lane & 48);
          const float rd = __builtin_amdgcn_rcpf(fmaxf(fabsf(den), S[192 + lr]));
          const int t = dir ? tlo + 63 - lr : tlo + lr;
          bf16_t* hp = hbuf + ((size_t)((dir * 4 + hd) * 4 + slice) * MT + rowbase + t) * 32 + fr;
          hp[0] = f2bf(num[0][jj] * rd); hp[16] = f2bf(num[1][jj] * rd);
        }
      }
    };
#pragma unroll 1
    for (int ci = 0; ci < 132; ci += 2) { step(ci, preA); step(ci + 1, preB); }
    __syncthreads();
  }
#undef MLSTM_PREFETCH
}

template <int WHICH>
__device__ __forceinline__ void mla_gemm(PRef p, int l, char* smem) {
  LAS unsigned char* lds = (LAS unsigned char*)smem; float* rsb = (float*)(smem + g8::STAGE_BYTES);
  const bf16_t* P = (const bf16_t*)(p.ws + WS_P);
  const int tid = otid(), wid = tid >> 6, lane = tid & 63, wr = wid >> 2, wc = wid & 3, fr = lane & 15, fq = lane >> 4;
  constexpr int K = WHICH ? 256 : 384, OFFC = WHICH ? OFF_CKV : OFF_CQ, N = WHICH ? 1024 : 768;
  const bf16_t* Wt = WHICH ? (const bf16_t*)(p.ws + WS_WUKV) + (size_t)l * 1024 * 256 : (const bf16_t*)(p.ws + WS_WUQ) + (size_t)l * 768 * 384;
  bf16_t* O = (bf16_t*)(p.ws + (WHICH ? WS_KV : WS_Q));
  g8::TileIter it; it.init((WHICH || l == 0) ? MT / 256 : MX / 256, N / 256);
  int pm, pn;
  while (it.next(pm, pn)) {
    __syncthreads();
    { const int r = tid >> 1, hf = tid & 1; const bf16_t* src = P + (size_t)(pm * 256 + r) * PLD + OFFC + hf * (K / 2); float s = 0.f;
#pragma unroll 4
      for (int i = 0; i < K / 16; ++i) { const u32x4 v = *(const u32x4*)(src + i * 8);
#pragma unroll
        for (int k = 0; k < 4; ++k) { const float a = bflo(v[k]), bq = bfhi(v[k]); s += a * a + bq * bq; } }
      s += __shfl_xor(s, 1);
      if (hf == 0) rsb[r] = rsqrtf(s / (float)K + 1e-6f); }
    unsigned voffA[2] = {g8::piece_off(0, PLD, OFFC), g8::piece_off(1, PLD, OFFC)};
    f32x4 acc[2][2][4][2];
    g8::gemm_tile<false>(lds, (const char*)(P + (size_t)pm * 256 * PLD), voffA, (size_t)128 * PLD * 2, (const char*)(Wt + (size_t)pn * 256 * K), opaque_s(K), acc);
    ACC_FOR3(ai, bj, m) {
      const int rl = ai * 128 + wr * 64 + m * 16 + fr, row = pm * 256 + rl, col = pn * 256 + bj * 128 + wc * 32 + fq * 8;
      const float rs = rsb[rl]; const f32x4 v0 = acc[ai][bj][m][0] * rs, v1 = acc[ai][bj][m][1] * rs;
      size_t orow = row;
      if (WHICH) orow = row < MX ? (size_t)(row >> 13) * SKV + CTXL + (row & 8191) : (size_t)((row - MX) >> 8) * SKV + ((row - MX) & 255);
      u32x4 w = {cvtpk(v0[0], v0[1]), cvtpk(v0[2], v0[3]), cvtpk(v1[0], v1[1]), cvtpk(v1[2], v1[3])}; *(u32x4*)(O + orow * N + col) = w;
    }
  }
}
__device__ void phase_mla_prep(PRef p, int l, char* smem) {
  mla_gemm<0>(p, l, smem);
  mla_gemm<1>(p, l, smem);
  const bf16_t* P = (const bf16_t*)(p.ws + WS_P);
  const int tid = otid(), wid = tid >> 6, lane = tid & 63;
  const bf16_t* hbuf = (const bf16_t*)(p.ws + WS_HB); bf16_t* mix = (bf16_t*)(p.ws + WS_MIX); bf16_t* KR = (bf16_t*)(p.ws + WS_KR);
  const float* cs = (const float*)(p.ws + WS_COS); const float* sn = (const float*)(p.ws + WS_SIN);
  const int gw = obid() * 8 + wid, nw = gridDim.x * 8;
  for (int row = gw; row < MT; row += nw) {
    if (row < MX || l == 0) {
      const size_t ho = ((size_t)(lane >> 2) * MT + row) * 32 + (lane & 3) * 8;
      const u32x4 hf = *(const u32x4*)(hbuf + ho), hb = *(const u32x4*)(hbuf + (size_t)16 * MT * 32 + ho);
      const u32x4 ov = *(const u32x4*)(P + (size_t)row * PLD + OFF_O + lane * 8);
      float v[8]; float s = 0.f;
#pragma unroll
      for (int k = 0; k < 4; ++k) { v[2 * k] = bflo(hf[k]) + bflo(hb[k]); v[2 * k + 1] = bfhi(hf[k]) + bfhi(hb[k]); s += v[2 * k] + v[2 * k + 1]; }
      s += __shfl_xor(s, 1); s += __shfl_xor(s, 2); s += __shfl_xor(s, 4); s += __shfl_xor(s, 8);
      const float mu = s * (1.f / 128.f); float q = 0.f;
#pragma unroll
      for (int k = 0; k < 8; ++k) { v[k] -= mu; q += v[k] * v[k]; }
      q += __shfl_xor(q, 1); q += __shfl_xor(q, 2); q += __shfl_xor(q, 4); q += __shfl_xor(q, 8);
      const float rs = rsqrtf(q * (1.f / 128.f) + 1e-6f);
      const float* nw_ = p.m_norm_w + l * 512 + lane * 8; float o[8];
#pragma unroll
      for (int k = 0; k < 4; ++k) { o[2 * k] = v[2 * k] * rs * nw_[2 * k] * sigmoid_f(bflo(ov[k])); o[2 * k + 1] = v[2 * k + 1] * rs * nw_[2 * k + 1] * sigmoid_f(bfhi(ov[k])); }
      u32x4 wv = {cvtpk(o[0], o[1]), cvtpk(o[2], o[3]), cvtpk(o[4], o[5]), cvtpk(o[6], o[7])};
      *(u32x4*)(mix + (size_t)row * 1024 + lane * 8) = wv;
    }
    {
      const int j = lane & 31;
      const float x1 = bf2f(P[(size_t)row * PLD + OFF_KR + j]), x2 = bf2f(P[(size_t)row * PLD + OFF_KR + 32 + j]);
      float o1 = x1, o2 = x2; size_t orow;
      if (row < MX) { const int t = row & 8191; const float c = cs[t * 32 + j], s_ = sn[t * 32 + j]; o1 = x1 * c - x2 * s_; o2 = x2 * c + x1 * s_; orow = (size_t)(row >> 13) * SKV + CTXL + t; }
      else orow = (size_t)((row - MX) >> 8) * SKV + ((row - MX) & 255);
      if (lane < 32) { KR[orow * 64 + j] = f2bf(o1); KR[orow * 64 + 32 + j] = f2bf(o2); }
    }
  }
}

namespace att {
constexpr int NW = 8, QBLK = 32, KVBLK = 64, LDQ = 768, LDK = 1024, LDKR = 64, LDO = 1024;
constexpr float SCALE = A_SCALE;
constexpr float THR = 8.f;
constexpr size_t SHM_V = KVBLK * 128 * 2, SHM_K = KVBLK * 128 * 2, SHM_R = KVBLK * 64 * 2;
typedef float f32x8 __attribute__((ext_vector_type(8)));
#define KSWZ(row, colB) ((row) * 256 + ((colB) ^ (((row) & 7) << 4)))
#define RSWZ(row, colB) ((row) * 128 + ((colB) ^ (((row) & 7) << 4)))
#define SBAR() __builtin_amdgcn_sched_barrier(0)
__device__ __forceinline__ int crow(int r, int hi) { return (r & 3) + 8 * (r >> 2) + 4 * hi; }
__device__ __forceinline__ void partialSM(f32x16& p0, f32x16& p1, float& m_reg, float& mn, float& alpha) {
  constexpr float C = SCALE * 1.4426950408889634f;
  float pmax = p0[0];
#pragma unroll
  for (int r = 1; r < 16; ++r) pmax = fmaxf(pmax, p0[r]);
#pragma unroll
  for (int r = 0; r < 16; ++r) pmax = fmaxf(pmax, p1[r]);
  { auto rr = __builtin_amdgcn_permlane32_swap(__float_as_uint(pmax), __float_as_uint(pmax), false, false);
    pmax = fmaxf(__uint_as_float(rr[0]), __uint_as_float(rr[1])); }
  if (__builtin_expect(__all(pmax - m_reg <= THR / SCALE), 1)) { mn = m_reg; alpha = 1.f; }
  else { mn = fmaxf(m_reg, pmax); alpha = __builtin_amdgcn_exp2f((m_reg - mn) * C); m_reg = mn; }
  const float mnC = -mn * C;
#pragma unroll
  for (int r = 0; r < 16; ++r) p0[r] = fmaf(p0[r], C, mnC);
#pragma unroll
  for (int r = 0; r < 16; ++r) p1[r] = fmaf(p1[r], C, mnC);
#pragma unroll
  for (int r = 0; r < 16; ++r) p0[r] = __builtin_amdgcn_exp2f(p0[r]);
}
__device__ __forceinline__ void finishSM(f32x16& p0, f32x16& p1, float alpha, float& l_reg, bf16x8& pa0, bf16x8& pa1, bf16x8& pa2, bf16x8& pa3) {
#pragma unroll
  for (int r = 0; r < 16; ++r) p1[r] = __builtin_amdgcn_exp2f(p1[r]);
  float ps = 0;
#pragma unroll
  for (int r = 0; r < 16; ++r) ps += p0[r];
#pragma unroll
  for (int r = 0; r < 16; ++r) ps += p1[r];
  { auto rr = __builtin_amdgcn_permlane32_swap(__float_as_uint(ps), __float_as_uint(ps), false, false);
    ps = __uint_as_float(rr[0]) + __uint_as_float(rr[1]); }
  l_reg = l_reg * alpha + ps;
#define PK4(P, BASE, OUT) do { unsigned a0 = cvtpk(P[BASE + 0], P[BASE + 1]), a1 = cvtpk(P[BASE + 2], P[BASE + 3]);   \
    unsigned b0 = cvtpk(P[BASE + 4], P[BASE + 5]), b1 = cvtpk(P[BASE + 6], P[BASE + 7]);                              \
    auto r0 = __builtin_amdgcn_permlane32_swap(a0, b0, false, false); auto r1 = __builtin_amdgcn_permlane32_swap(a1, b1, false, false); \
    u32x4 w = {r0[0], r1[0], r0[1], r1[1]}; OUT = *reinterpret_cast<bf16x8*>(&w); } while (0)
  PK4(p0, 0, pa0); PK4(p0, 8, pa1); PK4(p1, 0, pa2); PK4(p1, 8, pa3);
#undef PK4
}
__device__ __forceinline__ void qkt(f32x16& p0, f32x16& p1, const char* Ks, const char* Rs, const bf16x8* qr, const char* qrl, int r32, int hi) {
  p0 = f32x16{}; p1 = f32x16{};
#pragma unroll
  for (int d0 = 0; d0 < 8; ++d0) { const int cb = (d0 * 16 + hi * 8) * 2;
    const bf16x8 b0 = *reinterpret_cast<const bf16x8*>(Ks + KSWZ(r32, cb));
    const bf16x8 b1 = *reinterpret_cast<const bf16x8*>(Ks + KSWZ(32 + r32, cb));
    p0 = __builtin_amdgcn_mfma_f32_32x32x16_bf16(b0, qr[d0], p0, 0, 0, 0);
    p1 = __builtin_amdgcn_mfma_f32_32x32x16_bf16(b1, qr[d0], p1, 0, 0, 0); }
#pragma unroll
  for (int d0 = 0; d0 < 4; ++d0) { const int cb = (d0 * 16 + hi * 8) * 2;
    const bf16x8 b0 = *reinterpret_cast<const bf16x8*>(Rs + RSWZ(r32, cb));
    const bf16x8 b1 = *reinterpret_cast<const bf16x8*>(Rs + RSWZ(32 + r32, cb));
    p0 = __builtin_amdgcn_mfma_f32_32x32x16_bf16(b0, qr[8 + d0], p0, 0, 0, 0);
    p1 = __builtin_amdgcn_mfma_f32_32x32x16_bf16(b1, qr[8 + d0], p1, 0, 0, 0); }
}
__device__ __forceinline__ int v_st(int k, int c) { const int kk = (k & ~0xC) | ((k & 4) << 1) | ((k & 8) >> 1); return ((kk >> 3) * 4 + (c >> 5)) * 512 + ((kk & 7) * 32 + (c & 31)) * 2; }
__device__ __forceinline__ int v_rd_base(int lane) { return ((lane & 3) << 3) | (((lane >> 2) & 3) << 6) | (((lane >> 4) & 1) << 5) | (((lane >> 5) & 1) << 8); }
constexpr int v_rd_off(int d0, int ks, int half) { return d0 * 512 + ks * 4096 + half * 2048; }
template <int OFF> __device__ __forceinline__ s16x4 tr_read(int vb) {
  s16x4 r; asm volatile("ds_read_b64_tr_b16 %0, %1 offset:%2" : "=&v"(r) : "v"(vb), "i"(OFF) : "memory"); return r;
}
template <int D0> __device__ __forceinline__ void pv_one(f32x16& od, int vb, bf16x8 pa0, bf16x8 pa1, bf16x8 pa2, bf16x8 pa3) {
  const s16x4 l0 = tr_read<v_rd_off(D0, 0, 0)>(vb), h0 = tr_read<v_rd_off(D0, 0, 1)>(vb), l1 = tr_read<v_rd_off(D0, 1, 0)>(vb), h1 = tr_read<v_rd_off(D0, 1, 1)>(vb);
  const s16x4 l2 = tr_read<v_rd_off(D0, 2, 0)>(vb), h2 = tr_read<v_rd_off(D0, 2, 1)>(vb), l3 = tr_read<v_rd_off(D0, 3, 0)>(vb), h3 = tr_read<v_rd_off(D0, 3, 1)>(vb);
  asm volatile("s_waitcnt lgkmcnt(0)" ::: "memory"); SBAR();
#define PK(L, H) (bf16x8){L[0], L[1], L[2], L[3], H[0], H[1], H[2], H[3]}
  od = __builtin_amdgcn_mfma_f32_32x32x16_bf16(pa0, PK(l0, h0), od, 0, 0, 0);
  od = __builtin_amdgcn_mfma_f32_32x32x16_bf16(pa1, PK(l1, h1), od, 0, 0, 0);
  od = __builtin_amdgcn_mfma_f32_32x32x16_bf16(pa2, PK(l2, h2), od, 0, 0, 0);
  od = __builtin_amdgcn_mfma_f32_32x32x16_bf16(pa3, PK(l3, h3), od, 0, 0, 0);
#undef PK
}
__device__ __forceinline__ void pv_d0(f32x16* o, int vb, bf16x8 pa0, bf16x8 pa1, bf16x8 pa2, bf16x8 pa3) {
  pv_one<0>(o[0], vb, pa0, pa1, pa2, pa3); pv_one<1>(o[1], vb, pa0, pa1, pa2, pa3); pv_one<2>(o[2], vb, pa0, pa1, pa2, pa3); pv_one<3>(o[3], vb, pa0, pa1, pa2, pa3);
}
__device__ __forceinline__ void attn_body(const bf16_t* __restrict__ Qb, const float* __restrict__ cs, const float* __restrict__ sn, const bf16_t* __restrict__ Kn,
                                          const bf16_t* __restrict__ Vh, const bf16_t* __restrict__ Kr, bf16_t* __restrict__ Ob, int seq, char* lds) {
  const int tid = otid(), wid = tid >> 6, lane = tid & 63, r32 = lane & 31, hi = lane >> 5;
  char* V_lds = lds; char* K_lds = lds + 2 * SHM_V; char* R_lds = lds + 2 * SHM_V + 2 * SHM_K;
  float* wsf = (float*)(lds + 2 * SHM_V + 2 * SHM_K + 2 * SHM_R) + wid * 64; float* li_l = wsf; float* al_l = wsf + 32;
  char* qrl = lds + 2 * SHM_V + 2 * SHM_K + 2 * SHM_R + 2048 + wid * 4096 + lane * 16;
  float m_reg = -1e30f, l_reg = 0; f32x16 o[4] = {}; bf16x8 qr[12];
  { const bf16_t* Qw = Qb + (size_t)(wid * QBLK + r32) * LDQ + hi * 8;
#pragma unroll
    for (int d0 = 0; d0 < 8; ++d0) qr[d0] = *(const bf16x8*)(Qw + d0 * 16);
#pragma unroll
    for (int d0 = 0; d0 < 2; ++d0) {
      const u32x4 a = *(const u32x4*)(Qw + 128 + d0 * 16), bq = *(const u32x4*)(Qw + 160 + d0 * 16);
      if (cs) {
        const float* cp = cs + (size_t)(wid * QBLK + r32) * 32 + d0 * 16 + hi * 8; const float* sp = sn + (size_t)(wid * QBLK + r32) * 32 + d0 * 16 + hi * 8;
        const f32x4 c0 = *(const f32x4*)cp, c1 = *(const f32x4*)(cp + 4), s0 = *(const f32x4*)sp, s1 = *(const f32x4*)(sp + 4);
        float x1[8], x2[8], y1[8], y2[8];
#pragma unroll
        for (int k = 0; k < 4; ++k) { x1[2 * k] = bflo(a[k]); x1[2 * k + 1] = bfhi(a[k]); x2[2 * k] = bflo(bq[k]); x2[2 * k + 1] = bfhi(bq[k]); }
#pragma unroll
        for (int k = 0; k < 8; ++k) { const float c = k < 4 ? c0[k & 3] : c1[k & 3], s = k < 4 ? s0[k & 3] : s1[k & 3]; y1[k] = x1[k] * c - x2[k] * s; y2[k] = x2[k] * c + x1[k] * s; }
        u32x4 w1 = {cvtpk(y1[0], y1[1]), cvtpk(y1[2], y1[3]), cvtpk(y1[4], y1[5]), cvtpk(y1[6], y1[7])}, w2 = {cvtpk(y2[0], y2[1]), cvtpk(y2[2], y2[3]), cvtpk(y2[4], y2[5]), cvtpk(y2[6], y2[7])};
        qr[8 + d0] = *reinterpret_cast<bf16x8*>(&w1); qr[10 + d0] = *reinterpret_cast<bf16x8*>(&w2);
      } else { u32x4 a_ = a, b_ = bq; qr[8 + d0] = *reinterpret_cast<bf16x8*>(&a_); qr[10 + d0] = *reinterpret_cast<bf16x8*>(&b_); }
    } }
  const int sr = tid >> 4, sc = (tid & 15) * 8, vst0 = v_st(sr, sc), vst1 = v_st(32 + sr, sc);
  const int rr_ = tid >> 3, rc = (tid & 7) * 8;
  const int vb0 = (int)(uintptr_t)V_lds + v_rd_base(lane);
  bf16x8 vs0, vs1, ks0, ks1, rs0;
  const unsigned voffKV = (unsigned)(sr * LDK + sc) * 2u, voffR = (unsigned)(rr_ * LDKR + rc) * 2u;
#define SLOAD(k0) do { const char* kb_ = (const char*)Kn + (size_t)(k0) * (LDK * 2); const char* vb_ = (const char*)Vh + (size_t)(k0) * (LDK * 2); \
    vs0 = *(const bf16x8*)(vb_ + voffKV); vs1 = *(const bf16x8*)(vb_ + 32 * LDK * 2 + voffKV); \
    ks0 = *(const bf16x8*)(kb_ + voffKV); ks1 = *(const bf16x8*)(kb_ + 32 * LDK * 2 + voffKV); \
    rs0 = *(const bf16x8*)((const char*)Kr + (size_t)(k0) * (LDKR * 2) + voffR); } while (0)
#define SWRITE(b) do { *(bf16x8*)(V_lds + (b) * SHM_V + vst0) = vs0; *(bf16x8*)(V_lds + (b) * SHM_V + vst1) = vs1; const int kc = sc * 2;  \
    *(bf16x8*)(K_lds + (b) * SHM_K + KSWZ(sr, kc)) = ks0; *(bf16x8*)(K_lds + (b) * SHM_K + KSWZ(32 + sr, kc)) = ks1;                      \
    *(bf16x8*)(R_lds + (b) * SHM_R + RSWZ(rr_, rc * 2)) = rs0; } while (0)
#define RESC(a) do { if (__any((a) < 1.f)) { if (hi == 0) al_l[r32] = (a); asm volatile("s_waitcnt lgkmcnt(0)" ::: "memory"); \
    _Pragma("unroll") for (int d = 0; d < 4; ++d) _Pragma("unroll") for (int r = 0; r < 16; ++r) o[d][r] *= al_l[crow(r, hi)]; } } while (0)
  f32x16 pA0, pA1, pB0, pB1; float mnA, mnB, alA, alB; bf16x8 pa0, pa1, pa2, pa3; const int NT = seq / KVBLK;
  SLOAD(0); SWRITE(0); __syncthreads();
  qkt(pA0, pA1, K_lds, R_lds, qr, qrl, r32, hi); partialSM(pA0, pA1, m_reg, mnA, alA);
  SLOAD(KVBLK); SWRITE(1); __syncthreads();
  for (int j = 1; j + 1 < NT; j += 2) {
    SBAR(); qkt(pB0, pB1, K_lds + SHM_K, R_lds + SHM_R, qr, qrl, r32, hi);
    finishSM(pA0, pA1, alA, l_reg, pa0, pa1, pa2, pa3); SBAR();
    SLOAD((j + 1) * KVBLK); SBAR();
    pv_d0(o, vb0, pa0, pa1, pa2, pa3); partialSM(pB0, pB1, m_reg, mnB, alB);
    __syncthreads(); SWRITE(0);
    RESC(alB); __syncthreads();
    SBAR(); qkt(pA0, pA1, K_lds, R_lds, qr, qrl, r32, hi);
    finishSM(pB0, pB1, alB, l_reg, pa0, pa1, pa2, pa3); SBAR();
    SLOAD((j + 2) * KVBLK); SBAR();
    pv_d0(o, vb0 + (int)SHM_V, pa0, pa1, pa2, pa3); partialSM(pA0, pA1, m_reg, mnA, alA);
    __syncthreads(); SWRITE(1);
    RESC(alA); __syncthreads();
  }
  SBAR(); qkt(pB0, pB1, K_lds + SHM_K, R_lds + SHM_R, qr, qrl, r32, hi);
  finishSM(pA0, pA1, alA, l_reg, pa0, pa1, pa2, pa3); SBAR();
  pv_d0(o, vb0, pa0, pa1, pa2, pa3); partialSM(pB0, pB1, m_reg, mnB, alB);
  __syncthreads(); RESC(alB);
  finishSM(pB0, pB1, alB, l_reg, pa0, pa1, pa2, pa3); SBAR();
  pv_d0(o, vb0 + (int)SHM_V, pa0, pa1, pa2, pa3);
  if (hi == 0) li_l[r32] = l_reg; asm volatile("s_waitcnt lgkmcnt(0)" ::: "memory");
  float rli[16];
#pragma unroll
  for (int r = 0; r < 16; ++r) rli[r] = __builtin_amdgcn_rcpf(li_l[crow(r, hi)]);
  bf16_t* Ow = Ob + (size_t)(wid * QBLK) * LDO;
#pragma unroll
  for (int r = 0; r < 16; ++r) { const int orow = crow(r, hi);
#pragma unroll
    for (int d0 = 0; d0 < 4; ++d0) Ow[(size_t)orow * LDO + d0 * 32 + r32] = f2bf(o[d0][r] * rli[r]); }
  __syncthreads();
#undef SLOAD
#undef SWRITE
#undef RESC
}
}

__device__ void phase_attn(PRef p, int l, char* smem) {
  const bf16_t* Q = (const bf16_t*)(p.ws + WS_Q); const bf16_t* KV = (const bf16_t*)(p.ws + WS_KV); const bf16_t* KR = (const bf16_t*)(p.ws + WS_KR);
  bf16_t* mix = (bf16_t*)(p.ws + WS_MIX); const float* cs = (const float*)(p.ws + WS_COS); const float* sn = (const float*)(p.ws + WS_SIN);
  const int nunits = 1024 + (l == 0 ? 32 : 0);
  for (int u = obid(); u < nunits; u += gridDim.x) {
    if (u < 1024) {
      const int bh = (u >> 8) * 8 + (u & 7), qb = (u & 255) >> 3, hd = bh & 3, b = bh >> 2; const size_t row0 = (size_t)b * SEQ + qb * 256;
      att::attn_body(Q + row0 * 768 + hd * 192, cs + (size_t)qb * 256 * 32, sn + (size_t)qb * 256 * 32, KV + (size_t)b * SKV * 1024 + hd * 256,
                     KV + (size_t)b * SKV * 1024 + hd * 256 + 128, KR + (size_t)b * SKV * 64, mix + row0 * 1024 + 512 + hd * 128, SKV, smem);
    } else {
      const int v = u - 1024, hd = v & 3, b = v >> 2; const size_t row0 = (size_t)MX + b * CTXL;
      att::attn_body(Q + row0 * 768 + hd * 192, nullptr, nullptr, KV + (size_t)b * SKV * 1024 + hd * 256,
                     KV + (size_t)b * SKV * 1024 + hd * 256 + 128, KR + (size_t)b * SKV * 64, mix + row0 * 1024 + 512 + hd * 128, CTXL, smem);
    }
  }
}

__device__ void phase_outproj(PRef p, int l, char* smem) {
  LAS unsigned char* lds = (LAS unsigned char*)smem;
  const bf16_t* mix = (const bf16_t*)(p.ws + WS_MIX); const bf16_t* Wt = (const bf16_t*)(p.ws + WS_WOUT) + (size_t)l * 1024 * 1024;
  float* ctxz = (float*)(p.ws + WS_CTXZ);
  const int tid = otid(), wid = tid >> 6, lane = tid & 63, wr = wid >> 2, wc = wid & 3, fr = lane & 15, fq = lane >> 4;
  g8::TileIter it; it.init(l == 0 ? MT / 256 : MX / 256, 4);
  int pm, pn;
  while (it.next(pm, pn)) {
    unsigned voffA[2] = {g8::piece_off(0, 1024, 0), g8::piece_off(1, 1024, 0)};
    f32x4 acc[2][2][4][2];
    g8::gemm_tile<false>(lds, (const char*)(mix + (size_t)pm * 256 * 1024), voffA, (size_t)128 * 1024 * 2, (const char*)(Wt + (size_t)pn * 256 * 1024), 1024, acc);
    ACC_FOR(ai, bj, m, n) {
      const int row = pm * 256 + ai * 128 + wr * 64 + m * 16 + fr, col = pn * 256 + bj * 128 + wc * 32 + fq * 8 + n * 4;
      const float* res = l == 0 ? (row < MX ? p.x + (size_t)row * 1024 : p.ctx + (size_t)(row - MX) * 1024) : p.out + (size_t)row * 1024;
      float* dst = row < MX ? p.out + (size_t)row * 1024 : ctxz + (size_t)(row - MX) * 1024;
      const f32x4 r = *(const f32x4*)(res + col), g = *(const f32x4*)(mod_ptr(p, l, row, 2) + col);
      *(f32x4*)(dst + col) = r * ALPHA + g * acc[ai][bj][m][n];
    }
  }
}

__device__ void phase_ln1(PRef p, int l, char* smem) {
  float* wrt = (float*)smem;
  for (int i = otid(); i < 16384; i += 512) wrt[(i & 15) * 1024 + (i >> 4)] = p.w_router[(size_t)l * 16384 + i];
  __syncthreads();
  const int lane = otid() & 63, gw = obid() * 8 + (otid() >> 6), nw = gridDim.x * 8;
  bf16_t* h = (bf16_t*)(p.ws + WS_H); float* ctxz = (float*)(p.ws + WS_CTXZ); float* aff = (float*)(p.ws + WS_AFF);
  const int nrows = l == 0 ? MT : MX;
  for (int row = gw; row < nrows; row += nw) {
    asm volatile("" ::: "memory");
    float* zr = row < MX ? p.out + (size_t)row * 1024 : ctxz + (size_t)(row - MX) * 1024;
    f32x4 v[4];
#pragma unroll
    for (int i = 0; i < 4; ++i) v[i] = *(const f32x4*)(zr + lane * 4 + 256 * i);
    ln_row(v, 1e-5f);
#pragma unroll
    for (int i = 0; i < 4; ++i) { const int c = lane * 4 + 256 * i; v[i] = v[i] * *(const f32x4*)(p.ln1_g + l * 1024 + c) + *(const f32x4*)(p.ln1_b + l * 1024 + c); *(f32x4*)(zr + c) = v[i]; }
    ln_row(v, 1e-6f);
    f32x4 hm[4];
    store_mod_bf16(v, mod_ptr(p, l, row, 3), mod_ptr(p, l, row, 4), h + (size_t)row * 1024, lane, &hm);
    float lg[16];
#pragma unroll
    for (int e = 0; e < 16; ++e) { float s = 0.f;
#pragma unroll
      for (int i = 0; i < 4; ++i) { const f32x4 w = *(const f32x4*)(wrt + e * 1024 + lane * 4 + 256 * i); s += hm[i][0] * w[0] + hm[i][1] * w[1] + hm[i][2] * w[2] + hm[i][3] * w[3]; }
      lg[e] = wave_sum(s); }
    float mx = lg[0];
#pragma unroll
    for (int e = 1; e < 16; ++e) mx = fmaxf(mx, lg[e]);
    float den = 0.f;
#pragma unroll
    for (int e = 0; e < 16; ++e) { lg[e] = expf(lg[e] - mx); den += lg[e]; }
    float mine = 0.f;
#pragma unroll
    for (int e = 0; e < 16; ++e) if (lane == e) mine = lg[e] / den;
    if (lane < 16) aff[(size_t)row * 16 + lane] = mine;
  }
}

template <int PER>
__device__ __forceinline__ void topk_item(const float* __restrict__ affp, int n, int kcap, int rowbase, int slotbase, int e, int* __restrict__ IDX, float* __restrict__ GV, int* __restrict__ TS, char* smem) {
  unsigned* hist = (unsigned*)smem; unsigned* sel = hist + 256; unsigned* wtot = hist + 272;
  const int tid = otid(), lane = tid & 63, wid = tid >> 6;
  const bool active = tid * PER < n;
  unsigned key[PER];
#pragma unroll
  for (int i = 0; i < PER; ++i) key[i] = active ? __float_as_uint(affp[(size_t)(tid * PER + i) * 16]) : 0u;
  unsigned prefix = 0u, mask = 0u; int kk = kcap;
#pragma unroll 1
  for (int shift = 24; shift >= 0; shift -= 8) {
    __syncthreads();
    if (tid < 256) hist[tid] = 0u;
    __syncthreads();
#pragma unroll
    for (int i = 0; i < PER; ++i) if (active && (key[i] & mask) == prefix) atomicAdd(&hist[(key[i] >> shift) & 255u], 1u);
    __syncthreads();
    if (wid == 0) {
      const unsigned h0 = hist[lane * 4], h1 = hist[lane * 4 + 1], h2 = hist[lane * 4 + 2], h3 = hist[lane * 4 + 3];
      const unsigned tot = h0 + h1 + h2 + h3; unsigned suf = tot;
#pragma unroll
      for (int o = 1; o < 64; o <<= 1) { const unsigned u = __shfl_down(suf, o); if (lane + o < 64) suf += u; }
      const unsigned above = suf - tot;
      if (above < (unsigned)kk && suf >= (unsigned)kk) {
        unsigned a = above; int bin;
        if (a + h3 >= (unsigned)kk) bin = 3; else { a += h3; if (a + h2 >= (unsigned)kk) bin = 2; else { a += h2; if (a + h1 >= (unsigned)kk) bin = 1; else { a += h1; bin = 0; } } }
        sel[0] = prefix | ((unsigned)(lane * 4 + bin) << shift); sel[1] = (unsigned)kk - a;
      }
    }
    __syncthreads();
    prefix = sel[0]; kk = (int)sel[1]; mask |= 0xffu << shift;
  }
  const unsigned Tk = prefix;
  unsigned cg_ = 0, ce = 0;
#pragma unroll
  for (int i = 0; i < PER; ++i) { cg_ += key[i] > Tk; ce += key[i] == Tk; }
  unsigned pk = active ? (cg_ | (ce << 16)) : 0u, inc = pk;
#pragma unroll
  for (int o = 1; o < 64; o <<= 1) { const unsigned u = __shfl_up(inc, o); if (lane >= o) inc += u; }
  __syncthreads();
  if (lane == 63) wtot[wid] = inc;
  __syncthreads();
  unsigned base = 0;
  for (int w2 = 0; w2 < wid; ++w2) base += wtot[w2];
  const unsigned exc = base + inc - pk; unsigned gt_before = exc & 0xffffu, eq_before = exc >> 16;
  if (active) {
#pragma unroll
    for (int i = 0; i < PER; ++i) {
      const int t = tid * PER + i; int R = -1;
      const bool isgt = key[i] > Tk, iseq = key[i] == Tk;
      if (isgt || (iseq && (int)eq_before < kk)) {
        const int slot = (int)gt_before + min((int)eq_before, kk);
        R = slotbase + slot; IDX[R] = rowbase + t; GV[R] = __uint_as_float(key[i]);
      }
      TS[t] = R;
      gt_before += isgt; eq_before += iseq;
    }
  }
}
__device__ void phase_topk(PRef p, int l, char* smem) {
  const float* aff = (const float*)(p.ws + WS_AFF); int* IDX = (int*)(p.ws + WS_IDX); float* GV = (float*)(p.ws + WS_GV); int* TS = (int*)(p.ws + WS_TS);
  const int nitems = l == 0 ? 256 : 128;
  for (int it = obid(); it < nitems; it += gridDim.x) {
    if (it < 128) { const int b = it >> 4, e = it & 15; topk_item<16>(aff + (size_t)b * SEQ * 16 + e, SEQ, CAPX, b * SEQ, it * CAPX, e, IDX, GV, TS + (size_t)it * SEQ, smem); }
    else { const int v = it - 128, b = v >> 4, e = v & 15; topk_item<1>(aff + ((size_t)MX + b * CTXL) * 16 + e, CTXL, CAPC, MX + b * CTXL, NB * NE * CAPX + e * 256 + b * CAPC, e, IDX, GV, TS + (size_t)NB * 16 * SEQ + (size_t)v * CTXL, smem); }
  }
  __syncthreads();
}

__device__ void phase_moe_up(PRef p, int l, char* smem) {
  LAS unsigned char* lds = (LAS unsigned char*)smem;
  const bf16_t* h = (const bf16_t*)(p.ws + WS_H); const bf16_t* Wgu = (const bf16_t*)(p.ws + WS_WGU); bf16_t* act = (bf16_t*)(p.ws + WS_ACT); const int* IDX = (const int*)(p.ws + WS_IDX);
  const int tid = otid(), wid = tid >> 6, lane = tid & 63, wr = wid >> 2, wc = wid & 3, fr = lane & 15, fq = lane >> 4;
  g8::MoeIter it; it.init(8, l == 0);
  int pm, pn, e;
  while (it.next(pm, pn, e)) {
    unsigned voffA[4];
#pragma unroll
    for (int hh = 0; hh < 2; ++hh)
#pragma unroll
      for (int i = 0; i < 2; ++i) { int R, C; g8::piece_rc(i, R, C); voffA[hh * 2 + i] = (unsigned)(IDX[pm * 256 + hh * 128 + R] * 1024 + C) * 2u; }
    f32x4 acc[2][2][4][2];
    g8::gemm_tile<true>(lds, (const char*)h, voffA, 0, (const char*)(Wgu + ((size_t)e * 2048 + pn * 256) * 1024), 1024, acc);
#pragma unroll
    for (int ai = 0; ai < 2; ++ai)
#pragma unroll
      for (int m = 0; m < 4; ++m) {
          const int row = pm * 256 + ai * 128 + wr * 64 + m * 16 + fr, col = pn * 128 + wc * 32 + fq * 8;
          float a[8];
#pragma unroll
          for (int n = 0; n < 2; ++n) { const f32x4 g = acc[ai][0][m][n], u = acc[ai][1][m][n];
#pragma unroll
            for (int k = 0; k < 4; ++k) a[n * 4 + k] = silu_f(g[k]) * u[k]; }
          u32x4 w = {cvtpk(a[0], a[1]), cvtpk(a[2], a[3]), cvtpk(a[4], a[5]), cvtpk(a[6], a[7])}; *(u32x4*)(act + (size_t)row * 1024 + col) = w;
        }
  }
}
__device__ void phase_moe_down(PRef p, int l, char* smem) {
  LAS unsigned char* lds = (LAS unsigned char*)smem;
  const bf16_t* act = (const bf16_t*)(p.ws + WS_ACT); const bf16_t* Wdn = (const bf16_t*)(p.ws + WS_WDN); bf16_t* oute = (bf16_t*)(p.ws + WS_OUTE); const float* GV = (const float*)(p.ws + WS_GV);
  const int tid = otid(), wid = tid >> 6, lane = tid & 63, wr = wid >> 2, wc = wid & 3, fr = lane & 15, fq = lane >> 4;
  g8::MoeIter it; it.init(4, l == 0);
  int pm, pn, e;
  while (it.next(pm, pn, e)) {
    unsigned voffA[2] = {g8::piece_off(0, 1024, 0), g8::piece_off(1, 1024, 0)};
    f32x4 acc[2][2][4][2];
    g8::gemm_tile<false>(lds, (const char*)(act + (size_t)pm * 256 * 1024), voffA, (size_t)128 * 1024 * 2, (const char*)(Wdn + ((size_t)e * 1024 + pn * 256) * 1024), 1024, acc);
    ACC_FOR3(ai, bj, m) {
      const int row = pm * 256 + ai * 128 + wr * 64 + m * 16 + fr, col = pn * 256 + bj * 128 + wc * 32 + fq * 8;
      const float gv = GV[row]; const f32x4 v0 = acc[ai][bj][m][0] * gv, v1 = acc[ai][bj][m][1] * gv;
      u32x4 w = {cvtpk(v0[0], v0[1]), cvtpk(v0[2], v0[3]), cvtpk(v1[0], v1[1]), cvtpk(v1[2], v1[3])}; *(u32x4*)(oute + (size_t)row * 1024 + col) = w;
    }
  }
}

__device__ void phase_ln2(PRef p, int l) {
  const int lane = otid() & 63, gw = obid() * 8 + (otid() >> 6), nw = gridDim.x * 8;
  bf16_t* h = (bf16_t*)(p.ws + WS_H); float* ctxz = (float*)(p.ws + WS_CTXZ); const bf16_t* oute = (const bf16_t*)(p.ws + WS_OUTE); const int* TS = (const int*)(p.ws + WS_TS);
  const int nrows = l == 0 ? MT : MX;
  for (int row = gw; row < nrows; row += nw) {
    float* xr = row < MX ? p.out + (size_t)row * 1024 : ctxz + (size_t)(row - MX) * 1024;
    f32x4 mo[4];
#pragma unroll
    for (int i = 0; i < 4; ++i) mo[i] = (f32x4){0.f, 0.f, 0.f, 0.f};
    const int myR = lane < 16 ? (row < MX ? TS[((size_t)(row >> 13) * 16 + lane) * SEQ + (row & 8191)] : TS[(size_t)NB * 16 * SEQ + ((size_t)((row - MX) >> 8) * 16 + lane) * CTXL + ((row - MX) & 255)]) : -1;
    for (int e = 0; e < 16; ++e) { const int Rr = __shfl(myR, e);
      if (Rr >= 0) {
#pragma unroll
        for (int i = 0; i < 4; ++i) { const u32x2 w = *(const u32x2*)(oute + (size_t)Rr * 1024 + lane * 4 + 256 * i);
          mo[i][0] += bflo(w[0]); mo[i][1] += bfhi(w[0]); mo[i][2] += bflo(w[1]); mo[i][3] += bfhi(w[1]); } } }
    f32x4 v[4]; const float* m5 = mod_ptr(p, l, row, 5);
#pragma unroll
    for (int i = 0; i < 4; ++i) { const int c = lane * 4 + 256 * i; v[i] = *(const f32x4*)(xr + c) * ALPHA + *(const f32x4*)(m5 + c) * mo[i]; }
    ln_row(v, 1e-5f);
#pragma unroll
    for (int i = 0; i < 4; ++i) { const int c = lane * 4 + 256 * i; v[i] = v[i] * *(const f32x4*)(p.ln2_g + l * 1024 + c) + *(const f32x4*)(p.ln2_b + l * 1024 + c); *(f32x4*)(xr + c) = v[i]; }
    if (l + 1 < DEPTH) { ln_row(v, 1e-6f); store_mod_bf16(v, mod_ptr(p, l + 1, row, 0), mod_ptr(p, l + 1, row, 1), h + (size_t)row * 1024, lane, nullptr); }
  }
}

__device__ __forceinline__ void gsync(cg::grid_group& grid) {
  asm volatile("s_waitcnt vmcnt(0) lgkmcnt(0)" ::: "memory");
  grid.sync();
}
#define XB_CEN(j) (64 * (j))
#define XB_SUB(j) (1024 + 64 * (j))
#define XB_TOP 2048
struct FastBar { unsigned* w; unsigned xcc, nloc, nx, epoch; };
__device__ __forceinline__ unsigned xb_ld(unsigned* q) { return __hip_atomic_load(q, __ATOMIC_RELAXED, __HIP_MEMORY_SCOPE_AGENT); }
__device__ __forceinline__ unsigned xb_add(unsigned* q, unsigned v) { return __hip_atomic_fetch_add(q, v, __ATOMIC_RELAXED, __HIP_MEMORY_SCOPE_AGENT); }
__device__ __forceinline__ void fsync(FastBar& fb) {
  asm volatile("s_waitcnt vmcnt(0) lgkmcnt(0)" ::: "memory");
  __syncthreads();
  fb.epoch += 1u;
  if (otid() == 0) {
    const unsigned a = xb_add(&fb.w[XB_SUB(fb.xcc)], 1u) + 1u;
    if (a == fb.nloc * fb.epoch) {
      __builtin_amdgcn_fence(__ATOMIC_RELEASE, "agent");
      asm volatile("s_waitcnt vmcnt(0)" ::: "memory");
      (void)xb_add(&fb.w[XB_TOP], 1u);
    }
    while (xb_ld(&fb.w[XB_TOP]) < fb.nx * fb.epoch) __builtin_amdgcn_s_sleep(1);
    __builtin_amdgcn_fence(__ATOMIC_ACQUIRE, "agent");
    asm volatile("s_waitcnt vmcnt(0)" ::: "memory");
  }
  __syncthreads();
}
__global__ void __launch_bounds__(512) mega(Params p) {
  extern __shared__ __attribute__((aligned(16))) char smem[];
  cg::grid_group grid = cg::this_grid();
  FastBar fb; fb.w = (unsigned*)(kparams().ws + WS_BAR); fb.xcc = (unsigned)__builtin_amdgcn_readfirstlane((int)(__builtin_amdgcn_s_getreg((3 << 11) | 20) & 0xF)); fb.epoch = 0u; fb.nloc = 0u; fb.nx = 0u;
  if (otid() == 0) (void)xb_add(&fb.w[XB_CEN(fb.xcc)], 1u);
  phase_prep(kparams(), smem);
  gsync(grid);
  { unsigned nx = 0u;
#pragma unroll 1
    for (int j = 0; j < 16; ++j) nx += xb_ld(&fb.w[XB_CEN(j)]) != 0u;
    fb.nx = (unsigned)__builtin_amdgcn_readfirstlane((int)nx); fb.nloc = (unsigned)__builtin_amdgcn_readfirstlane((int)xb_ld(&fb.w[XB_CEN(fb.xcc)])); }
  phase_h0(kparams());
  fsync(fb);
#pragma unroll 1
  for (int l = 0; l < DEPTH; ++l) {
    phase_inproj(kparams(), l, smem);
    fsync(fb);
    phase_mlstm_pre(kparams(), l, smem);
    fsync(fb);
    phase_mlstm(kparams(), l, smem);
    fsync(fb);
    phase_mla_prep(kparams(), l, smem);
    fsync(fb);
    phase_attn(kparams(), l, smem);
    fsync(fb);
    phase_outproj(kparams(), l, smem);
    fsync(fb);
    phase_ln1(kparams(), l, smem);
    __syncthreads();
    phase_cvt_experts(kparams(), l, smem);
    fsync(fb);
    phase_topk(kparams(), l, smem);
    fsync(fb);
    phase_moe_up(kparams(), l, smem);
    fsync(fb);
    phase_moe_down(kparams(), l, smem);
    fsync(fb);
    phase_ln2(kparams(), l);
    fsync(fb);
  }
}

extern "C" void kernel_launch(void* const* d_in, const int* in_sizes, int n_in, void* d_out, int out_size,
                              void* d_ws, size_t ws_size, hipStream_t stream) {
  constexpr size_t kDynLds = 160 * 1024;
  static int grid_blocks = 0;
  if (!grid_blocks) {
    int dev = 0, cus = 0, per_cu = 0;
    (void)hipGetDevice(&dev);
    (void)hipDeviceGetAttribute(&cus, hipDeviceAttributeMultiprocessorCount, dev);
    (void)hipFuncSetAttribute((const void*)mega, hipFuncAttributeMaxDynamicSharedMemorySize, (int)kDynLds);
    (void)hipOccupancyMaxActiveBlocksPerMultiprocessor(&per_cu, mega, 512, kDynLds);
    grid_blocks = per_cu > 0 ? cus : 0;
    if (grid_blocks > 256) grid_blocks = 256;
    grid_blocks &= ~7;
    if (grid_blocks != 256) { fprintf(stderr, "this kernel needs 256 co-resident workgroups (got %d)\n", grid_blocks); grid_blocks = 0; }
    if (ws_size < WS_END) { fprintf(stderr, "workspace too small: %zu < %zu\n", ws_size, (size_t)WS_END); grid_blocks = 0; }
  }
  if (grid_blocks <= 0) return;
  Params p{};
  const float** pp = (const float**)&p;
  for (int i = 0; i < 24; ++i) pp[i] = (const float*)d_in[i];
  p.out = (float*)d_out; p.ws = (char*)d_ws;
  (void)hipMemsetAsync((char*)d_ws + WS_BAR, 0, WS_BAR_BYTES, stream);
  void* args[] = {&p};
  hipError_t e = hipLaunchCooperativeKernel((void*)mega, dim3(grid_blocks), dim3(512), args, kDynLds, stream);
  if (e != hipSuccess) fprintf(stderr, "cooperative launch failed: %s (grid %d)\n", hipGetErrorString(e), grid_blocks);
}
```

```cpp
#include <hip/hip_runtime.h>
#include <hip/hip_cooperative_groups.h>
#include <cstdio>
#include <cstdint>
namespace cg = cooperative_groups;

typedef unsigned short bf16_t;
typedef short bf16x8 __attribute__((ext_vector_type(8)));
typedef short s16x4 __attribute__((ext_vector_type(4)));
typedef float f32x4 __attribute__((ext_vector_type(4)));
typedef float f32x16 __attribute__((ext_vector_type(16)));
typedef unsigned u32x4 __attribute__((ext_vector_type(4)));
typedef unsigned u32x2 __attribute__((ext_vector_type(2)));
#define LAS __attribute__((address_space(3)))

constexpr int DM = 1024, NB = 8, SEQ = 8192, CTXL = 256, DEPTH = 2;
constexpr int MX = NB * SEQ, MC = NB * CTXL, MT = MX + MC;
constexpr int PLD = 2816;
constexpr int OFF_Q = 0, OFF_K = 512, OFF_V = 1024, OFF_O = 1536, OFF_G = 2048, OFF_CQ = 2064, OFF_CKV = 2448, OFF_KR = 2704, IN_COLS = 2768;
constexpr int SKV = SEQ + CTXL;
constexpr int NE = 16, CAPX = 1024, CAPC = 32;
constexpr int NSLOT = NB * NE * CAPX + NB * NE * CAPC;
constexpr float ALPHA = 1.4142135623730951f;
constexpr float A_SCALE = 0.07216878364870322f;

constexpr size_t al256(size_t v) { return (v + 255) / 256 * 256; }
constexpr size_t WS_H = 0;
constexpr size_t WS_P = WS_H + al256((size_t)MT * 1024 * 2);
constexpr size_t WS_Q = WS_P + al256((size_t)MT * PLD * 2);
constexpr size_t WS_KV = WS_Q + al256((size_t)MT * 768 * 2);
constexpr size_t WS_KR = WS_KV + al256((size_t)NB * SKV * 1024 * 2);
constexpr size_t WS_MIX = WS_KR + al256((size_t)NB * SKV * 64 * 2);
constexpr size_t WS_ACT = WS_P;
constexpr size_t WS_HB = WS_H;
constexpr size_t WS_OUTE = WS_P + al256((size_t)NSLOT * 1024 * 2);
constexpr size_t WS_WGU = WS_MIX;
constexpr size_t WS_WDN = WS_MIX + (size_t)NE * 2048 * 1024 * 2;
constexpr size_t WS_WIN = WS_MIX + al256((size_t)MT * 1024 * 2);
constexpr size_t WS_WUQ = WS_WIN + (size_t)2 * PLD * 1024 * 2;
constexpr size_t WS_WUKV = WS_WUQ + (size_t)2 * 768 * 384 * 2;
constexpr size_t WS_WOUT = WS_WUKV + (size_t)2 * 1024 * 256 * 2;
constexpr size_t WS_MOD = WS_WOUT + (size_t)2 * 1024 * 1024 * 2;
constexpr size_t WS_COS = WS_MOD + al256((size_t)2 * 9 * 6144 * 4);
constexpr size_t WS_SIN = WS_COS + (size_t)SEQ * 32 * 4;
constexpr size_t WS_GATES = WS_SIN + (size_t)SEQ * 32 * 4;
constexpr size_t WS_AFF = WS_GATES + (size_t)MT * 16 * 4;
constexpr size_t WS_IDX = WS_AFF + (size_t)MT * 16 * 4;
constexpr size_t WS_GV = WS_IDX + (size_t)NSLOT * 4;
constexpr size_t WS_TS = WS_GV + (size_t)NSLOT * 4;
constexpr size_t WS_CTXZ = WS_TS + (size_t)MT * 16 * 4;
constexpr size_t WS_BAR = WS_CTXZ + (size_t)MC * 1024 * 4;
constexpr size_t WS_BAR_BYTES = 16384;
constexpr size_t WS_END = WS_BAR + WS_BAR_BYTES;
static_assert(WS_OUTE + (size_t)NSLOT * 1024 * 2 <= WS_KR, "out_e overlay");
static_assert(WS_WDN + (size_t)NE * 1024 * 1024 * 2 <= WS_WIN, "expert weights overlay");

struct Params {
  const float *x, *c, *ctx, *c_ctx, *w_mod, *b_mod, *w_in, *b_gates, *conv_w, *conv_b, *m_norm_w, *q_norm_w, *kv_norm_w, *w_uq, *w_ukv, *w_out,
      *ln1_g, *ln1_b, *w_router, *w_gate, *w_up, *w_down, *ln2_g, *ln2_b;
  float* out; char* ws;
};

typedef const __attribute__((address_space(4))) Params& PRef;
__device__ __forceinline__ PRef kparams() { const __attribute__((address_space(4))) Params* kp = (const __attribute__((address_space(4))) Params*)__builtin_amdgcn_kernarg_segment_ptr(); asm volatile("" : "+s"(kp)); return *kp; }
__device__ __forceinline__ int otid() { int t = threadIdx.x; asm volatile("" : "+v"(t)); return t; }
__device__ __forceinline__ int obid() { int t = blockIdx.x; asm volatile("" : "+s"(t)); return t; }
__device__ __forceinline__ int opaque_s(int v) { asm volatile("" : "+s"(v)); return v; }
typedef __bf16 bf16v2_t __attribute__((ext_vector_type(2)));
typedef float f32x2_t __attribute__((ext_vector_type(2)));
__device__ __forceinline__ unsigned cvtpk(float lo, float hi) { const f32x2_t f = {lo, hi}; const bf16v2_t b = __builtin_convertvector(f, bf16v2_t); return __builtin_bit_cast(unsigned, b); }
__device__ __forceinline__ bf16_t f2bf(float v) { return (bf16_t)(cvtpk(v, v) & 0xffffu); }
__device__ __forceinline__ float bf2f(unsigned v) { return __uint_as_float(v << 16); }
__device__ __forceinline__ float bflo(unsigned w) { return __uint_as_float(w << 16); }
__device__ __forceinline__ float bfhi(unsigned w) { return __uint_as_float(w & 0xffff0000u); }
__device__ __forceinline__ float wave_sum(float v) { for (int o = 32; o > 0; o >>= 1) v += __shfl_xor(v, o); return v; }
__device__ __forceinline__ float wave_max(float v) { for (int o = 32; o > 0; o >>= 1) v = fmaxf(v, __shfl_xor(v, o)); return v; }
__device__ __forceinline__ float sigmoid_f(float v) { return __builtin_amdgcn_rcpf(1.f + __expf(-v)); }
__device__ __forceinline__ float silu_f(float v) { return v * sigmoid_f(v); }

namespace g8 {
constexpr int BK = 64, HALF = 128, HTB = HALF * BK * 2, STAGE_BYTES = 8 * HTB;
__device__ __forceinline__ int lds_byte(int r, int c) { const int st = (r >> 4) * 2 + (c >> 5), rr = r & 15, cc = c & 31, ob = rr * 64 + cc * 2; return st * 1024 + (ob ^ (((ob >> 9) & 1) << 5)); }
__device__ __forceinline__ int perm32(int rho) { const int n = rho >> 4, i = rho & 15; return 8 * (i >> 2) + 4 * n + (i & 3); }
__device__ __forceinline__ void stage_rc(int b, int& R, int& C) { const int st = b / 1024, sb = b % 1024, swz = sb ^ (((sb >> 9) & 1) << 5); R = (st >> 1) * 16 + swz / 64; C = (st & 1) * 32 + (swz % 64) / 2; }

template <bool GATHER>
__device__ __forceinline__ void gemm_tile(LAS unsigned char* lds, const char* __restrict__ Ab, const unsigned (&voffA)[GATHER ? 4 : 2], size_t hstepA, const char* __restrict__ Bb, int K,
                                          f32x4 (&acc)[2][2][4][2]) {
  const int tid = otid(), wid = __builtin_amdgcn_readfirstlane(tid >> 6), lane = tid & 63, wr = wid >> 2, wc = wid & 3, fr = lane & 15, fq = lane >> 4;
  const int nt = K / BK;
  unsigned voffB[2];
#pragma unroll
  for (int i = 0; i < 2; ++i) { int R, C; stage_rc(tid * 16 + i * 8192, R, C); const int Rb = (R & ~31) + perm32(R & 31); voffB[i] = (unsigned)(Rb * K + C) * 2u; }
  const char* Bb1 = Bb + (size_t)HALF * K * 2; const char* Ab1 = GATHER ? Ab : Ab + hstepA;
  const unsigned* vA0 = &voffA[0]; const unsigned* vA1 = GATHER ? &voffA[2] : &voffA[0];
  const unsigned ldsw = (unsigned)wid * 1024u;
  const int aoff = lds_byte(wr * 64 + fr, fq * 8), boff = lds_byte(wc * 32 + fr, fq * 8);
#define G8_SA(b, h) (((b) * 2 + (h)) * HTB)
#define G8_SB(b, h) ((4 + (b) * 2 + (h)) * HTB)
#define G8_STAGE(bufoff, gbase, voff, kt) do { _Pragma("unroll") for (int _i = 0; _i < 2; ++_i) \
    __builtin_amdgcn_global_load_lds((const unsigned*)((gbase) + (size_t)(kt) * (BK * 2) + (voff)[_i]), (LAS unsigned*)(lds + (bufoff) + ldsw + _i * 8192), 16, 0, 0); } while (0)
#define G8_LDA(dst, b, h) do { _Pragma("unroll") for (int m = 0; m < 4; ++m) _Pragma("unroll") for (int k = 0; k < 2; ++k) dst[m][k] = *(const LAS bf16x8*)(lds + G8_SA(b, h) + aoff + m * 2048 + k * 1024); } while (0)
#define G8_LDB(dst, b, h) do { _Pragma("unroll") for (int n = 0; n < 2; ++n) _Pragma("unroll") for (int k = 0; k < 2; ++k) dst[n][k] = *(const LAS bf16x8*)(lds + G8_SB(b, h) + boff + n * 2048 + k * 1024); } while (0)
#define G8_MMA(ai, bj, At, Bt) do { __builtin_amdgcn_s_setprio(1); _Pragma("unroll") for (int m = 0; m < 4; ++m) _Pragma("unroll") for (int n = 0; n < 2; ++n) _Pragma("unroll") for (int k = 0; k < 2; ++k) \
    acc[ai][bj][m][n] = __builtin_amdgcn_mfma_f32_16x16x32_bf16(Bt[n][k], At[m][k], acc[ai][bj][m][n], 0, 0, 0); __builtin_amdgcn_s_setprio(0); } while (0)
#define G8_WAIT_V(n) asm volatile("s_waitcnt vmcnt(" #n ")" ::: "memory")
#define G8_WAIT_L(n) asm volatile("s_waitcnt lgkmcnt(" #n ")" ::: "memory")
#define G8_BAR __builtin_amdgcn_s_barrier()
#define G8_SCHED __builtin_amdgcn_sched_barrier(0)
#pragma unroll
  for (int a = 0; a < 2; ++a)
#pragma unroll
    for (int b = 0; b < 2; ++b)
#pragma unroll
      for (int m = 0; m < 4; ++m)
#pragma unroll
        for (int n = 0; n < 2; ++n) acc[a][b][m][n] = (f32x4){0.f, 0.f, 0.f, 0.f};
  bf16x8 At[4][2], B0[2][2], B1[2][2];
  G8_WAIT_V(0); __syncthreads();
  G8_STAGE(G8_SB(0, 0), Bb, voffB, 0); G8_STAGE(G8_SA(0, 0), Ab, vA0, 0); G8_STAGE(G8_SB(0, 1), Bb1, voffB, 0); G8_STAGE(G8_SA(0, 1), Ab1, vA1, 0);
  if (wr == 1) G8_BAR;
  G8_WAIT_V(4); G8_BAR;
  G8_STAGE(G8_SB(1, 0), Bb, voffB, 1); G8_STAGE(G8_SA(1, 0), Ab, vA0, 1); G8_STAGE(G8_SB(1, 1), Bb1, voffB, 1);
  G8_WAIT_V(6); G8_BAR;
  for (int t = 0; t < nt - 2; t += 2) {
    G8_LDB(B0, 0, 0); G8_SCHED; G8_LDA(At, 0, 0); G8_STAGE(G8_SA(1, 1), Ab1, vA1, t + 1);
    G8_WAIT_L(8); G8_BAR; G8_WAIT_L(0); G8_MMA(0, 0, At, B0); G8_BAR; G8_SCHED;
    G8_LDB(B1, 0, 1); G8_STAGE(G8_SB(0, 0), Bb, voffB, t + 2);
    G8_BAR; G8_WAIT_L(0); G8_MMA(0, 1, At, B1); G8_BAR;
    G8_LDA(At, 0, 1); G8_STAGE(G8_SA(0, 0), Ab, vA0, t + 2);
    G8_BAR; G8_WAIT_L(0); G8_MMA(1, 0, At, B0); G8_BAR; G8_SCHED;
    G8_STAGE(G8_SB(0, 1), Bb1, voffB, t + 2);
    G8_WAIT_V(6); G8_BAR; G8_MMA(1, 1, At, B1); G8_BAR;
    G8_LDB(B0, 1, 0); G8_SCHED; G8_LDA(At, 1, 0); G8_STAGE(G8_SA(0, 1), Ab1, vA1, t + 2);
    G8_WAIT_L(8); G8_BAR; G8_WAIT_L(0); G8_MMA(0, 0, At, B0); G8_BAR; G8_SCHED;
    G8_LDB(B1, 1, 1); G8_STAGE(G8_SB(1, 0), Bb, voffB, t + 3);
    G8_BAR; G8_WAIT_L(0); G8_MMA(0, 1, At, B1); G8_BAR;
    G8_LDA(At, 1, 1); G8_STAGE(G8_SA(1, 0), Ab, vA0, t + 3);
    G8_BAR; G8_WAIT_L(0); G8_MMA(1, 0, At, B0); G8_BAR; G8_SCHED;
    G8_STAGE(G8_SB(1, 1), Bb1, voffB, t + 3);
    G8_WAIT_V(6); G8_BAR; G8_MMA(1, 1, At, B1); G8_BAR;
  }
  { G8_LDB(B0, 0, 0); G8_LDA(At, 0, 0); G8_STAGE(G8_SA(1, 1), Ab1, vA1, nt - 1);
    G8_BAR; G8_WAIT_L(0); G8_MMA(0, 0, At, B0); G8_BAR;
    G8_LDB(B1, 0, 1); G8_BAR; G8_WAIT_L(0); G8_MMA(0, 1, At, B1); G8_BAR;
    G8_LDA(At, 0, 1); G8_WAIT_V(4); G8_BAR; G8_WAIT_L(0); G8_MMA(1, 0, At, B0); G8_MMA(1, 1, At, B1); G8_BAR; }
  { G8_LDB(B0, 1, 0); G8_LDA(At, 1, 0); G8_WAIT_V(2); G8_BAR; G8_WAIT_L(0); G8_MMA(0, 0, At, B0); G8_BAR;
    G8_LDB(B1, 1, 1); G8_WAIT_V(0); G8_BAR; G8_WAIT_L(0); G8_MMA(0, 1, At, B1); G8_BAR;
    G8_LDA(At, 1, 1); G8_BAR; G8_WAIT_L(0); G8_MMA(1, 0, At, B0); G8_MMA(1, 1, At, B1); G8_BAR; }
  if (wr == 0) G8_BAR;
}
__device__ __forceinline__ unsigned piece_off(int i, int ld, int c0) { int R, C; stage_rc((int)otid() * 16 + i * 8192, R, C); return (unsigned)(R * ld + c0 + C) * 2u; }
__device__ __forceinline__ void piece_rc(int i, int& R, int& C) { stage_rc((int)otid() * 16 + i * 8192, R, C); }
struct TileIter {
  int nM, nN, x, j, J, cnt, idx;
  __device__ __forceinline__ void init(int nM_, int nN_) { nM = nM_; nN = nN_; x = obid() & 7; j = obid() >> 3; J = gridDim.x >> 3; cnt = ((nM - x + 7) >> 3) * nN; idx = j; }
  __device__ __forceinline__ bool next(int& pm, int& pn) { if (idx >= cnt) return false; pm = x + 8 * (idx / nN); pn = idx % nN; idx += J; return true; }
};
struct MoeIter {
  int nN, x, jm, jn, j, step, nsteps, nb4; bool with_ctx, ctx_done, wide;
  __device__ __forceinline__ void init(int nN_, bool with_ctx_) { nN = nN_; with_ctx = with_ctx_; wide = nN_ == 8; x = obid() & 7; j = obid() >> 3;
    if (wide) { jm = j & 3; jn = j >> 2; nsteps = 16; } else { jm = j & 7; jn = j >> 3; nsteps = 2 * (nN >> 2) * 4; }
    nb4 = nN >> 2; step = 0; ctx_done = false; }
  __device__ __forceinline__ bool next(int& pm, int& pn, int& e) {
    if (step < nsteps) {
      int m32;
      if (wide) { const int mb = step & 7, el = step >> 3; e = 2 * x + el; m32 = mb * 4 + jm; pn = jn; }
      else { const int mb = step & 3, nb = (step >> 2) % nb4, el = (step >> 2) / nb4; e = 2 * x + el; m32 = mb * 8 + jm; pn = nb * 4 + jn; }
      pm = ((m32 >> 2) * 16 + e) * 4 + (m32 & 3); ++step; return true; }
    if (with_ctx && !ctx_done) { ctx_done = true; if (j < 2 * nN) { e = 2 * x + j / nN; pm = 512 + e; pn = j % nN; return true; } }
    return false;
  }
};
}

#define ACC_FOR3(ai, bj, m) _Pragma("unroll") for (int ai = 0; ai < 2; ++ai) _Pragma("unroll") for (int bj = 0; bj < 2; ++bj) _Pragma("unroll") for (int m = 0; m < 4; ++m)
#define ACC_FOR(ai, bj, m, n) _Pragma("unroll") for (int ai = 0; ai < 2; ++ai) _Pragma("unroll") for (int bj = 0; bj < 2; ++bj) _Pragma("unroll") for (int m = 0; m < 4; ++m) _Pragma("unroll") for (int n = 0; n < 2; ++n)

__device__ __forceinline__ void cvt_tile(const float* __restrict__ src, int N, int K, int k0, int n0, bf16_t* __restrict__ dst, long drow0, const float* __restrict__ kscale, float* lds) {
  const int tid = otid();
  { const int kr = tid >> 6, n = tid & 63;
#pragma unroll
    for (int i = 0; i < 8; ++i) { const int k = kr + 8 * i; float v = (n0 + n < N) ? src[(size_t)(k0 + k) * N + n0 + n] : 0.f; if (kscale) v *= kscale[k0 + k]; lds[k * 65 + n] = v; } }
  __syncthreads();
  { const int n = tid >> 3, k8 = (tid & 7) * 8; float v[8];
#pragma unroll
    for (int i = 0; i < 8; ++i) v[i] = lds[(k8 + i) * 65 + n];
    u32x4 w = {cvtpk(v[0], v[1]), cvtpk(v[2], v[3]), cvtpk(v[4], v[5]), cvtpk(v[6], v[7])};
    *(u32x4*)(dst + (size_t)(drow0 + n) * K + k0 + k8) = w; }
  __syncthreads();
}

__device__ void phase_prep(PRef p, char* smem) {
  float* lds = (float*)smem;
  bf16_t* Wt_in = (bf16_t*)(p.ws + WS_WIN); bf16_t* Wt_uq = (bf16_t*)(p.ws + WS_WUQ); bf16_t* Wt_ukv = (bf16_t*)(p.ws + WS_WUKV); bf16_t* Wt_out = (bf16_t*)(p.ws + WS_WOUT);
  float* mod = (float*)(p.ws + WS_MOD);
  constexpr int T_MOD = 192, T_IN = 2 * 16 * 44, T_UQ = 2 * 6 * 12, T_UKV = 2 * 4 * 16, T_OUT = 2 * 16 * 16, T_ROPE = 64;
  constexpr int E0 = T_MOD, E1 = E0 + T_IN, E2 = E1 + T_UQ, E3 = E2 + T_UKV, E4 = E3 + T_OUT, E5 = E4 + T_ROPE;
  const int tid = otid();
  for (int task = obid(); task < E5; task += gridDim.x) {
    if (task < E0) {
      const int l = task / 96, j0 = (task % 96) * 64;
      float* sc = lds;
      for (int i = tid; i < 9 * 1024; i += 512) { const int bb = i >> 10, d = i & 1023; const float v = bb < 8 ? p.c[bb * 1024 + d] : p.c_ctx[d]; sc[i] = v / (1.f + expf(-v)); }
      __syncthreads();
      const int col = tid & 63, ks = tid >> 6; float a[9];
#pragma unroll
      for (int bb = 0; bb < 9; ++bb) a[bb] = 0.f;
      const float* wm = p.w_mod + (size_t)l * 1024 * 6144 + j0 + col;
      for (int d = ks * 128; d < ks * 128 + 128; ++d) { const float w = wm[(size_t)d * 6144];
#pragma unroll
        for (int bb = 0; bb < 9; ++bb) a[bb] += sc[bb * 1024 + d] * w; }
      float* red = lds + 9 * 1024;
#pragma unroll
      for (int bb = 0; bb < 9; ++bb) red[(ks * 9 + bb) * 64 + col] = a[bb];
      __syncthreads();
      for (int i = tid; i < 9 * 64; i += 512) { const int bb = i >> 6, cc = i & 63; float s = 0.f;
        for (int k = 0; k < 8; ++k) s += red[(k * 9 + bb) * 64 + cc];
        mod[((size_t)l * 9 + bb) * 6144 + j0 + cc] = s + p.b_mod[l * 6144 + j0 + cc]; }
      __syncthreads();
    } else if (task < E1) { const int t = task - E0, l = t / 704, r = t % 704, kt = r / 44, nt = r % 44;
      cvt_tile(p.w_in + (size_t)l * 1024 * IN_COLS, IN_COLS, 1024, kt * 64, nt * 64, Wt_in + (size_t)l * PLD * 1024, nt * 64, nullptr, lds);
    } else if (task < E2) { const int t = task - E1, l = t / 72, r = t % 72, kt = r / 12, nt = r % 12;
      cvt_tile(p.w_uq + (size_t)l * 384 * 768, 768, 384, kt * 64, nt * 64, Wt_uq + (size_t)l * 768 * 384, nt * 64, p.q_norm_w + l * 384, lds);
    } else if (task < E3) { const int t = task - E2, l = t / 64, r = t % 64, kt = r / 16, nt = r % 16;
      cvt_tile(p.w_ukv + (size_t)l * 256 * 1024, 1024, 256, kt * 64, nt * 64, Wt_ukv + (size_t)l * 1024 * 256, nt * 64, p.kv_norm_w + l * 256, lds);
    } else if (task < E4) { const int t = task - E3, l = t / 256, r = t % 256, kt = r / 16, nt = r % 16;
      cvt_tile(p.w_out + (size_t)l * 1024 * 1024, 1024, 1024, kt * 64, nt * 64, Wt_out + (size_t)l * 1024 * 1024, nt * 64, nullptr, lds);
    } else {
      float* cs = (float*)(p.ws + WS_COS); float* sn = (float*)(p.ws + WS_SIN);
      for (int i = (task - E4) * 4096 + tid; i < (task - E4 + 1) * 4096; i += 512) { const int t = i >> 5, j = i & 31;
        const float inv = exp2f(-(float)(j & 15) * (13.287712379549449f / 16.f));
        const float pos = (float)(j < 16 ? (t >> 6) : (t & 63)); const float ang = pos * inv;
        const double a = (double)ang; const double k = rint(a * 0.15915494309189535); const float r = (float)(a - k * 6.283185307179586);
        cs[i] = __cosf(r); sn[i] = __sinf(r); }
    }
  }
}

__device__ void phase_cvt_experts(PRef p, int l, char* smem) {
  float* lds = (float*)smem;
  bf16_t* Wgu = (bf16_t*)(p.ws + WS_WGU); bf16_t* Wdn = (bf16_t*)(p.ws + WS_WDN);
  const int tid = otid();
  for (int task = obid(); task < NE * 192; task += gridDim.x) {
    const int e = task / 192, r = task % 192, which = r >> 6, kt = (r & 63) >> 2, nt = r & 3, k0 = kt * 64, n0 = nt * 256;
    const float* src = (which == 0 ? p.w_gate : which == 1 ? p.w_up : p.w_down) + ((size_t)l * NE + e) * 1024 * 1024;
    { const int kr = tid >> 6, n4 = (tid & 63) * 4;
#pragma unroll
      for (int i = 0; i < 8; ++i) { const int k = kr + 8 * i; *(f32x4*)(lds + k * 260 + n4) = *(const f32x4*)(src + (size_t)(k0 + k) * 1024 + n0 + n4); } }
    __syncthreads();
    { const int nl = tid >> 1, k32 = (tid & 1) * 32, n = n0 + nl;
      const size_t drow = which == 2 ? (size_t)n : (size_t)((n >> 7) * 256 + which * 128 + (n & 127));
      bf16_t* dst = (which == 2 ? Wdn + (size_t)e * 1024 * 1024 : Wgu + (size_t)e * 2048 * 1024) + drow * 1024 + k0 + k32;
#pragma unroll
      for (int q = 0; q < 4; ++q) { float v[8];
#pragma unroll
        for (int i = 0; i < 8; ++i) v[i] = lds[(k32 + q * 8 + i) * 260 + nl];
        u32x4 w = {cvtpk(v[0], v[1]), cvtpk(v[2], v[3]), cvtpk(v[4], v[5]), cvtpk(v[6], v[7])};
        *(u32x4*)(dst + q * 8) = w; } }
    __syncthreads();
  }
}

__device__ __forceinline__ void ln_row(f32x4 (&v)[4], float eps) {
  float s = 0.f;
#pragma unroll
  for (int i = 0; i < 4; ++i) s += v[i][0] + v[i][1] + v[i][2] + v[i][3];
  const float mu = wave_sum(s) * (1.f / 1024.f);
  float q = 0.f;
#pragma unroll
  for (int i = 0; i < 4; ++i)
#pragma unroll
    for (int k = 0; k < 4; ++k) { v[i][k] -= mu; q += v[i][k] * v[i][k]; }
  const float rs = rsqrtf(wave_sum(q) * (1.f / 1024.f) + eps);
#pragma unroll
  for (int i = 0; i < 4; ++i) v[i] *= rs;
}
__device__ __forceinline__ void store_mod_bf16(const f32x4 (&v)[4], const float* __restrict__ shift, const float* __restrict__ scale, bf16_t* __restrict__ hrow, int lane, f32x4 (*keep)[4]) {
#pragma unroll
  for (int i = 0; i < 4; ++i) { const int c = lane * 4 + 256 * i; const f32x4 sh = *(const f32x4*)(shift + c), sc = *(const f32x4*)(scale + c);
    f32x4 o = v[i] * (sc + 1.f) + sh; if (keep) (*keep)[i] = o;
    u32x2 w = {cvtpk(o[0], o[1]), cvtpk(o[2], o[3])}; *(u32x2*)(hrow + c) = w; }
}
__device__ __forceinline__ const float* mod_ptr(PRef p, int l, int row, int which) {
  const int bb = row < MX ? (row >> 13) : 8;
  return (const float*)(p.ws + WS_MOD) + ((size_t)l * 9 + bb) * 6144 + which * 1024;
}

__device__ void phase_h0(PRef p) {
  const int lane = otid() & 63, gw = obid() * 8 + (otid() >> 6), nw = gridDim.x * 8;
  bf16_t* h = (bf16_t*)(p.ws + WS_H);
  for (int row = gw; row < MT; row += nw) {
    const float* src = row < MX ? p.x + (size_t)row * 1024 : p.ctx + (size_t)(row - MX) * 1024;
    f32x4 v[4];
#pragma unroll
    for (int i = 0; i < 4; ++i) v[i] = *(const f32x4*)(src + lane * 4 + 256 * i);
    ln_row(v, 1e-6f);
    store_mod_bf16(v, mod_ptr(p, 0, row, 0), mod_ptr(p, 0, row, 1), h + (size_t)row * 1024, lane, nullptr);
  }
}

__device__ void phase_inproj(PRef p, int l, char* smem) {
  LAS unsigned char* lds = (LAS unsigned char*)smem;
  const bf16_t* h = (const bf16_t*)(p.ws + WS_H); const bf16_t* Wt = (const bf16_t*)(p.ws + WS_WIN) + (size_t)l * PLD * 1024;
  bf16_t* P = (bf16_t*)(p.ws + WS_P); float* gates = (float*)(p.ws + WS_GATES);
  const int tid = otid(), wid = tid >> 6, lane = tid & 63, wr = wid >> 2, wc = wid & 3, fr = lane & 15, fq = lane >> 4;
  g8::TileIter it; it.init(MT / 256, PLD / 256);
  int pm, pn;
  while (it.next(pm, pn)) {
    unsigned voffA[2] = {g8::piece_off(0, 1024, 0), g8::piece_off(1, 1024, 0)};
    f32x4 acc[2][2][4][2];
    g8::gemm_tile<false>(lds, (const char*)(h + (size_t)pm * 256 * 1024), voffA, (size_t)128 * 1024 * 2, (const char*)(Wt + (size_t)pn * 256 * 1024), 1024, acc);
    ACC_FOR3(ai, bj, m) {
      const int row = pm * 256 + ai * 128 + wr * 64 + m * 16 + fr, col = pn * 256 + bj * 128 + wc * 32 + fq * 8;
      const f32x4 v0 = acc[ai][bj][m][0], v1 = acc[ai][bj][m][1];
      u32x4 w = {cvtpk(v0[0], v0[1]), cvtpk(v0[2], v0[3]), cvtpk(v1[0], v1[1]), cvtpk(v1[2], v1[3])}; *(u32x4*)(P + (size_t)row * PLD + col) = w;
      if (col >= OFF_G && col < OFF_G + 16) { const f32x4 bg0 = *(const f32x4*)(p.b_gates + l * 16 + (col - OFF_G)), bg1 = *(const f32x4*)(p.b_gates + l * 16 + (col - OFF_G) + 4);
        *(f32x4*)(gates + (size_t)row * 16 + (col - OFF_G)) = v0 + bg0; *(f32x4*)(gates + (size_t)row * 16 + (col - OFF_G) + 4) = v1 + bg1; }
    }
  }
}


constexpr size_t WS_QKC = WS_KV;
constexpr size_t WS_SCAL = WS_Q;
__device__ void phase_mlstm_pre(PRef p, int l, char* smem) {
  const bf16_t* P = (const bf16_t*)(p.ws + WS_P); const float* gates = (const float*)(p.ws + WS_GATES);
  bf16_t* QKC = (bf16_t*)(p.ws + WS_QKC); float* SCAL = (float*)(p.ws + WS_SCAL);
  const int tid = otid(), wid = tid >> 6, lane = tid & 63;
  if (obid() < 64) {
    const int chain = obid(), dir = chain & 1, hd = (chain >> 1) & 3, b = chain >> 3;
    float* LA = (float*)smem; float* LB = LA + 132 * 64; float* LP = LB + 132 * 64; float* b63s = LP + 132 * 64; float* pm63s = b63s + 132; float* mbs = pm63s + 132;
    for (int ci = wid; ci < 132; ci += 8) {
      const bool ic = ci < 4; const int cc = ic ? ci : ci - 4, T = ic ? CTXL : SEQ, rb = ic ? MX + b * CTXL : b * SEQ, tlo = dir ? T - 64 - cc * 64 : cc * 64;
      const int t = dir ? tlo + 63 - lane : tlo + lane; const float* g = gates + (size_t)(rb + t) * 16;
      const float ig = g[dir * 8 + hd], fg = g[dir * 8 + 4 + hd];
      const float lf = fminf(fg, 0.f) - log1pf(expf(-fabsf(fg)));
      float bc = lf;
#pragma unroll
      for (int o = 1; o < 64; o <<= 1) { const float u = __shfl_up(bc, o); if (lane >= o) bc += u; }
      const float a = ig - bc; float pmx = a;
#pragma unroll
      for (int o = 1; o < 64; o <<= 1) { const float u = __shfl_up(pmx, o); if (lane >= o) pmx = fmaxf(pmx, u); }
      LA[ci * 64 + lane] = a; LB[ci * 64 + lane] = bc; LP[ci * 64 + lane] = pmx;
      if (lane == 63) { b63s[ci] = bc; pm63s[ci] = pmx; }
    }
    __syncthreads();
    if (tid == 0) { float m = 0.f; for (int ci = 0; ci < 132; ++ci) { mbs[ci] = m; m = b63s[ci] + fmaxf(pm63s[ci], m); } }
    __syncthreads();
    for (int ci = wid; ci < 132; ci += 8) {
      const float m = mbs[ci], a = LA[ci * 64 + lane], bc = LB[ci * 64 + lane], pmx = LP[ci * 64 + lane];
      const float Mx = fmaxf(pmx, m), M63 = fmaxf(pm63s[ci], m);
      float* S = SCAL + ((size_t)chain * 132 + ci) * 384;
      S[lane] = a; S[64 + lane] = Mx; S[128 + lane] = __expf(m - Mx); S[192 + lane] = __expf(-(bc + Mx)); S[256 + lane] = __expf(a - M63);
      S[320 + lane] = lane == 0 ? __expf(m - M63) : 0.f;
    }
    return;
  }
  const int col8 = (tid & 127) * 8, rg = tid >> 7;
  float w[5][8], bia[8];
#pragma unroll
  for (int j = 0; j < 5; ++j) { const f32x4 w0 = *(const f32x4*)(p.conv_w + ((size_t)l * 5 + j) * 1024 + col8), w1 = *(const f32x4*)(p.conv_w + ((size_t)l * 5 + j) * 1024 + col8 + 4);
#pragma unroll
    for (int k = 0; k < 4; ++k) { w[j][k] = w0[k]; w[j][4 + k] = w1[k]; } }
  { const f32x4 b0 = *(const f32x4*)(p.conv_b + l * 1024 + col8), b1 = *(const f32x4*)(p.conv_b + l * 1024 + col8 + 4);
#pragma unroll
    for (int k = 0; k < 4; ++k) { bia[k] = b0[k]; bia[4 + k] = b1[k]; } }
  const float osc = col8 < 512 ? 0.08838834764831845f : 1.f;
#pragma unroll 1
  for (int rb = obid() - 64; rb < MT / 64; rb += gridDim.x - 64) {
    const int R0 = rb * 64, seg_lo = R0 < MX ? (R0 & ~8191) : MX + ((R0 - MX) & ~255), seg_hi = seg_lo + (R0 < MX ? SEQ : CTXL);
    const int r0 = R0 + rg * 16;
    u32x4 raw[20];
#pragma unroll
    for (int i = 0; i < 20; ++i) { const int r = r0 - 2 + i; raw[i] = (u32x4){0u, 0u, 0u, 0u}; if (r >= seg_lo && r < seg_hi) raw[i] = *(const u32x4*)(P + (size_t)r * PLD + col8); }
#pragma unroll
    for (int i = 0; i < 16; ++i) {
      float y[8];
#pragma unroll
      for (int k = 0; k < 8; ++k) y[k] = bia[k];
#pragma unroll
      for (int tp = 0; tp < 5; ++tp) {
#pragma unroll
        for (int k = 0; k < 4; ++k) { y[2 * k] += w[tp][2 * k] * bflo(raw[i + tp][k]); y[2 * k + 1] += w[tp][2 * k + 1] * bfhi(raw[i + tp][k]); } }
#pragma unroll
      for (int k = 0; k < 8; ++k) y[k] = silu_f(y[k]) * osc;
      u32x4 o = {cvtpk(y[0], y[1]), cvtpk(y[2], y[3]), cvtpk(y[4], y[5]), cvtpk(y[6], y[7])};
      *(u32x4*)(QKC + (size_t)(r0 + i) * 1024 + col8) = o;
    }
  }
}

__device__ void phase_mlstm(PRef p, int l, char* smem) {
  bf16_t* QBb[2] = {(bf16_t*)(smem), (bf16_t*)(smem + 17408)};
  bf16_t* KB = (bf16_t*)(smem + 34816);
  bf16_t* KT = (bf16_t*)(smem + 52224);
  bf16_t* VTb[2] = {(bf16_t*)(smem + 70656), (bf16_t*)(smem + 77568)};
  bf16_t* VWT = (bf16_t*)(smem + 84480);
  bf16_t* PB = (bf16_t*)(smem + 91392);
  bf16_t* CTb[2] = {(bf16_t*)(smem + 100608), (bf16_t*)(smem + 113664)};
  float* SC = (float*)(smem + 126720);
  const bf16_t* P = (const bf16_t*)(p.ws + WS_P); const bf16_t* QKC = (const bf16_t*)(p.ws + WS_QKC); const float* SCAL = (const float*)(p.ws + WS_SCAL);
  bf16_t* hbuf = (bf16_t*)(p.ws + WS_HB);
  for (int w = obid(); w < 256; w += gridDim.x) {
    const int slice = (w >> 3) & 3, chain = (w & 7) * 8 + (w >> 5), dir = chain & 1, hd = (chain >> 1) & 3, b = chain >> 3;
    const float* SCc = SCAL + (size_t)chain * 132 * 384;
    __syncthreads();
    { const int tid = otid();
      for (int i = tid; i < 48 * 136 / 2; i += 512) { ((unsigned*)CTb[0])[i] = 0u; ((unsigned*)CTb[1])[i] = 0u; }
      for (int i = tid; i < 48 * 72 / 2; i += 512) { ((unsigned*)VTb[0])[i] = 0u; ((unsigned*)VTb[1])[i] = 0u; ((unsigned*)VWT)[i] = 0u; } }
    f32x4 accC[3];
#pragma unroll
    for (int i = 0; i < 3; ++i) accC[i] = (f32x4){0.f, 0.f, 0.f, 0.f};
    struct Pre { u32x4 qk[4]; u32x2 v; f32x4 s; float ws, ws1; };
    Pre preA, preB;
    preA.s = (f32x4){0.f, 0.f, 0.f, 0.f}; preB.s = preA.s;
#define MLSTM_PREFETCH(PR, CI) do { const int tid_ = otid(); const int ci_ = (CI); const bool ic_ = ci_ < 4; const int cc_ = ic_ ? ci_ : ci_ - 4, T_ = ic_ ? CTXL : SEQ, rb_ = ic_ ? MX + b * CTXL : b * SEQ; \
      const int tlo_ = dir ? T_ - 64 - cc_ * 64 : cc_ * 64; \
      _Pragma("unroll") for (int k_ = 0; k_ < 4; ++k_) { const int pc = tid_ + k_ * 512, tens = pc >> 10, rem = pc & 1023, lr = rem & 63, c16 = rem >> 6, t = dir ? tlo_ + 63 - lr : tlo_ + lr; \
        PR.qk[k_] = *(const u32x4*)(QKC + (size_t)(rb_ + t) * 1024 + tens * 512 + hd * 128 + c16 * 8); } \
      { const int vl_ = tid_ & 63, vt_ = dir ? tlo_ + 63 - vl_ : tlo_ + vl_; PR.v = *(const u32x2*)(P + (size_t)(rb_ + vt_) * PLD + OFF_V + hd * 128 + slice * 32 + (tid_ >> 6) * 4); \
        PR.ws = SCc[(size_t)ci_ * 384 + 256 + vl_]; PR.ws1 = SCc[(size_t)ci_ * 384 + 256 + (tid_ & 63)]; } \
      if (tid_ < 96) PR.s = *(const f32x4*)(SCc + (size_t)ci_ * 384 + tid_ * 4); } while (0)
    MLSTM_PREFETCH(preA, 0);
    MLSTM_PREFETCH(preB, 1);
    __syncthreads();
    auto step = [&](const int ci, Pre& pre) __attribute__((always_inline)) {
      const int tid = otid(), wid = tid >> 6, lane = tid & 63, fr = lane & 15, fq = lane >> 4;
      const bool isctx = ci < 4; const int cc = isctx ? ci : ci - 4, T = isctx ? CTXL : SEQ, rowbase = isctx ? MX + b * CTXL : b * SEQ;
      const int tlo = dir ? T - 64 - cc * 64 : cc * 64;
      const int par = ci & 1;
      bf16_t* QB = QBb[par]; bf16_t* VT = VTb[par]; float* S = SC + par * 384; bf16_t* CTc = CTb[par]; bf16_t* CTn = CTb[par ^ 1];
      const bool need_out = !(l == DEPTH - 1 && isctx);
#pragma unroll
      for (int k = 0; k < 4; ++k) { const int pc = tid + k * 512, tens = pc >> 10, rem = pc & 1023, lr = rem & 63, c16 = rem >> 6;
        if (tens == 0) *(u32x4*)(QB + lr * 136 + c16 * 8) = pre.qk[k];
        else { *(u32x4*)(KB + lr * 136 + c16 * 8) = pre.qk[k];
#pragma unroll
          for (int i = 0; i < 4; ++i) { KT[(c16 * 8 + 2 * i) * 72 + lr] = (bf16_t)(pre.qk[k][i] & 0xffffu); KT[(c16 * 8 + 2 * i + 1) * 72 + lr] = (bf16_t)(pre.qk[k][i] >> 16); } } }
      { const int vl = tid & 63, ve4 = (tid >> 6) * 4; const float wsl = pre.ws;
        VT[(ve4 + 0) * 72 + vl] = (bf16_t)(pre.v[0] & 0xffffu); VT[(ve4 + 1) * 72 + vl] = (bf16_t)(pre.v[0] >> 16);
        VT[(ve4 + 2) * 72 + vl] = (bf16_t)(pre.v[1] & 0xffffu); VT[(ve4 + 3) * 72 + vl] = (bf16_t)(pre.v[1] >> 16);
        VWT[(ve4 + 0) * 72 + vl] = f2bf(bflo(pre.v[0]) * wsl); VWT[(ve4 + 1) * 72 + vl] = f2bf(bfhi(pre.v[0]) * wsl);
        VWT[(ve4 + 2) * 72 + vl] = f2bf(bflo(pre.v[1]) * wsl); VWT[(ve4 + 3) * 72 + vl] = f2bf(bfhi(pre.v[1]) * wsl);
        if (tid < 64) { VT[32 * 72 + tid] = (bf16_t)0x3F80u; VWT[32 * 72 + tid] = f2bf(pre.ws1); }
        if (tid < 96) *(f32x4*)(S + tid * 4) = pre.s; }
      if (ci + 2 < 132) MLSTM_PREFETCH(pre, ci + 2);
      __syncthreads();
      if (need_out) {
        const int mt = wid >> 1;
#pragma unroll
        for (int u = 0; u < 2; ++u) {
          const int ntl = (wid & 1) * 2 + u;
          f32x4 sacc = {0.f, 0.f, 0.f, 0.f};
          if (ntl <= mt) {
#pragma unroll
            for (int kk = 0; kk < 4; ++kk) {
              const bf16x8 a = *(const bf16x8*)(QB + (mt * 16 + fr) * 136 + kk * 32 + fq * 8), bb = *(const bf16x8*)(KB + (ntl * 16 + fr) * 136 + kk * 32 + fq * 8);
              sacc = __builtin_amdgcn_mfma_f32_16x16x32_bf16(a, bb, sacc, 0, 0, 0); }
          }
          const int j = ntl * 16 + fr; const float aj = S[j];
#pragma unroll
          for (int jj = 0; jj < 4; ++jj) { const int lr = mt * 16 + fq * 4 + jj;
            const float pv = (j <= lr) ? sacc[jj] * __expf(fminf(aj - S[64 + lr], 0.f)) : 0.f;
            PB[lr * 72 + j] = f2bf(pv); }
        }
      }
      {
        const float decay = S[320];
#pragma unroll
        for (int mt = 0; mt < 3; ++mt) {
          accC[mt] *= decay;
#pragma unroll
          for (int kk = 0; kk < 2; ++kk) { const bf16x8 a = *(const bf16x8*)(VWT + (mt * 16 + fr) * 72 + kk * 32 + fq * 8), bb = *(const bf16x8*)(KT + (wid * 16 + fr) * 72 + kk * 32 + fq * 8);
            accC[mt] = __builtin_amdgcn_mfma_f32_16x16x32_bf16(a, bb, accC[mt], 0, 0, 0); }
#pragma unroll
          for (int jj = 0; jj < 4; ++jj) CTn[(mt * 16 + fq * 4 + jj) * 136 + wid * 16 + fr] = f2bf(accC[mt][jj]);
        }
      }
      __syncthreads();
      if (need_out && wid < 4) {
        const int mt = wid; f32x4 num[3];
#pragma unroll
        for (int ntl = 0; ntl < 3; ++ntl) {
          f32x4 a1 = {0.f, 0.f, 0.f, 0.f}, a2 = {0.f, 0.f, 0.f, 0.f};
#pragma unroll
          for (int kk = 0; kk < 2; ++kk) { const bf16x8 a = *(const bf16x8*)(PB + (mt * 16 + fr) * 72 + kk * 32 + fq * 8), bb = *(const bf16x8*)(VT + (ntl * 16 + fr) * 72 + kk * 32 + fq * 8);
            a1 = __builtin_amdgcn_mfma_f32_16x16x32_bf16(a, bb, a1, 0, 0, 0); }
#pragma unroll
          for (int kk = 0; kk < 4; ++kk) { const bf16x8 a = *(const bf16x8*)(QB + (mt * 16 + fr) * 136 + kk * 32 + fq * 8), bb = *(const bf16x8*)(CTc + (ntl * 16 + fr) * 136 + kk * 32 + fq * 8);
            a2 = __builtin_amdgcn_mfma_f32_16x16x32_bf16(a, bb, a2, 0, 0, 0); }
#pragma unroll
          for (int jj = 0; jj < 4; ++jj) num[ntl][jj] = a1[jj] + S[128 + mt * 16 + fq * 4 + jj] * a2[jj];
        }
#pragma unroll
        for (int jj = 0; jj < 4; ++jj) {
          const int lr = mt * 16 + fq * 4 + jj; const float den = __shfl(num[2][jj], lane & 48);
          const float rd = __builtin_amdgcn_rcpf(fmaxf(fabsf(den), S[192 + lr]));
          const int t = dir ? tlo + 63 - lr : tlo + lr;
          bf16_t* hp = hbuf + ((size_t)((dir * 4 + hd) * 4 + slice) * MT + rowbase + t) * 32 + fr;
          hp[0] = f2bf(num[0][jj] * rd); hp[16] = f2bf(num[1][jj] * rd);
        }
      }
    };
#pragma unroll 1
    for (int ci = 0; ci < 132; ci += 2) { step(ci, preA); step(ci + 1, preB); }
    __syncthreads();
  }
#undef MLSTM_PREFETCH
}

template <int WHICH>
__device__ __forceinline__ void mla_gemm(PRef p, int l, char* smem) {
  LAS unsigned char* lds = (LAS unsigned char*)smem; float* rsb = (float*)(smem + g8::STAGE_BYTES);
  const bf16_t* P = (const bf16_t*)(p.ws + WS_P);
  const int tid = otid(), wid = tid >> 6, lane = tid & 63, wr = wid >> 2, wc = wid & 3, fr = lane & 15, fq = lane >> 4;
  constexpr int K = WHICH ? 256 : 384, OFFC = WHICH ? OFF_CKV : OFF_CQ, N = WHICH ? 1024 : 768;
  const bf16_t* Wt = WHICH ? (const bf16_t*)(p.ws + WS_WUKV) + (size_t)l * 1024 * 256 : (const bf16_t*)(p.ws + WS_WUQ) + (size_t)l * 768 * 384;
  bf16_t* O = (bf16_t*)(p.ws + (WHICH ? WS_KV : WS_Q));
  g8::TileIter it; it.init((WHICH || l == 0) ? MT / 256 : MX / 256, N / 256);
  int pm, pn;
  while (it.next(pm, pn)) {
    __syncthreads();
    { const int r = tid >> 1, hf = tid & 1; const bf16_t* src = P + (size_t)(pm * 256 + r) * PLD + OFFC + hf * (K / 2); float s = 0.f;
#pragma unroll 4
      for (int i = 0; i < K / 16; ++i) { const u32x4 v = *(const u32x4*)(src + i * 8);
#pragma unroll
        for (int k = 0; k < 4; ++k) { const float a = bflo(v[k]), bq = bfhi(v[k]); s += a * a + bq * bq; } }
      s += __shfl_xor(s, 1);
      if (hf == 0) rsb[r] = rsqrtf(s / (float)K + 1e-6f); }
    unsigned voffA[2] = {g8::piece_off(0, PLD, OFFC), g8::piece_off(1, PLD, OFFC)};
    f32x4 acc[2][2][4][2];
    g8::gemm_tile<false>(lds, (const char*)(P + (size_t)pm * 256 * PLD), voffA, (size_t)128 * PLD * 2, (const char*)(Wt + (size_t)pn * 256 * K), opaque_s(K), acc);
    ACC_FOR3(ai, bj, m) {
      const int rl = ai * 128 + wr * 64 + m * 16 + fr, row = pm * 256 + rl, col = pn * 256 + bj * 128 + wc * 32 + fq * 8;
      const float rs = rsb[rl]; const f32x4 v0 = acc[ai][bj][m][0] * rs, v1 = acc[ai][bj][m][1] * rs;
      size_t orow = row;
      if (WHICH) orow = row < MX ? (size_t)(row >> 13) * SKV + CTXL + (row & 8191) : (size_t)((row - MX) >> 8) * SKV + ((row - MX) & 255);
      u32x4 w = {cvtpk(v0[0], v0[1]), cvtpk(v0[2], v0[3]), cvtpk(v1[0], v1[1]), cvtpk(v1[2], v1[3])}; *(u32x4*)(O + orow * N + col) = w;
    }
  }
}
__device__ void phase_mla_prep(PRef p, int l, char* smem) {
  mla_gemm<0>(p, l, smem);
  mla_gemm<1>(p, l, smem);
  const bf16_t* P = (const bf16_t*)(p.ws + WS_P);
  const int tid = otid(), wid = tid >> 6, lane = tid & 63;
  const bf16_t* hbuf = (const bf16_t*)(p.ws + WS_HB); bf16_t* mix = (bf16_t*)(p.ws + WS_MIX); bf16_t* KR = (bf16_t*)(p.ws + WS_KR);
  const float* cs = (const float*)(p.ws + WS_COS); const float* sn = (const float*)(p.ws + WS_SIN);
  const int gw = obid() * 8 + wid, nw = gridDim.x * 8;
  for (int row = gw; row < MT; row += nw) {
    if (row < MX || l == 0) {
      const size_t ho = ((size_t)(lane >> 2) * MT + row) * 32 + (lane & 3) * 8;
      const u32x4 hf = *(const u32x4*)(hbuf + ho), hb = *(const u32x4*)(hbuf + (size_t)16 * MT * 32 + ho);
      const u32x4 ov = *(const u32x4*)(P + (size_t)row * PLD + OFF_O + lane * 8);
      float v[8]; float s = 0.f;
#pragma unroll
      for (int k = 0; k < 4; ++k) { v[2 * k] = bflo(hf[k]) + bflo(hb[k]); v[2 * k + 1] = bfhi(hf[k]) + bfhi(hb[k]); s += v[2 * k] + v[2 * k + 1]; }
      s += __shfl_xor(s, 1); s += __shfl_xor(s, 2); s += __shfl_xor(s, 4); s += __shfl_xor(s, 8);
      const float mu = s * (1.f / 128.f); float q = 0.f;
#pragma unroll
      for (int k = 0; k < 8; ++k) { v[k] -= mu; q += v[k] * v[k]; }
      q += __shfl_xor(q, 1); q += __shfl_xor(q, 2); q += __shfl_xor(q, 4); q += __shfl_xor(q, 8);
      const float rs = rsqrtf(q * (1.f / 128.f) + 1e-6f);
      const float* nw_ = p.m_norm_w + l * 512 + lane * 8; float o[8];
#pragma unroll
      for (int k = 0; k < 4; ++k) { o[2 * k] = v[2 * k] * rs * nw_[2 * k] * sigmoid_f(bflo(ov[k])); o[2 * k + 1] = v[2 * k + 1] * rs * nw_[2 * k + 1] * sigmoid_f(bfhi(ov[k])); }
      u32x4 wv = {cvtpk(o[0], o[1]), cvtpk(o[2], o[3]), cvtpk(o[4], o[5]), cvtpk(o[6], o[7])};
      *(u32x4*)(mix + (size_t)row * 1024 + lane * 8) = wv;
    }
    {
      const int j = lane & 31;
      const float x1 = bf2f(P[(size_t)row * PLD + OFF_KR + j]), x2 = bf2f(P[(size_t)row * PLD + OFF_KR + 32 + j]);
      float o1 = x1, o2 = x2; size_t orow;
      if (row < MX) { const int t = row & 8191; const float c = cs[t * 32 + j], s_ = sn[t * 32 + j]; o1 = x1 * c - x2 * s_; o2 = x2 * c + x1 * s_; orow = (size_t)(row >> 13) * SKV + CTXL + t; }
      else orow = (size_t)((row - MX) >> 8) * SKV + ((row - MX) & 255);
      if (lane < 32) { KR[orow * 64 + j] = f2bf(o1); KR[orow * 64 + 32 + j] = f2bf(o2); }
    }
  }
}

namespace att {
constexpr int NW = 8, QBLK = 32, KVBLK = 64, LDQ = 768, LDK = 1024, LDKR = 64, LDO = 1024;
constexpr float SCALE = A_SCALE;
constexpr float THR = 8.f;
constexpr size_t SHM_V = KVBLK * 128 * 2, SHM_K = KVBLK * 128 * 2, SHM_R = KVBLK * 64 * 2;
typedef float f32x8 __attribute__((ext_vector_type(8)));
#define KSWZ(row, colB) ((row) * 256 + ((colB) ^ (((row) & 7) << 4)))
#define RSWZ(row, colB) ((row) * 128 + ((colB) ^ (((row) & 7) << 4)))
#define SBAR() __builtin_amdgcn_sched_barrier(0)
__device__ __forceinline__ int crow(int r, int hi) { return (r & 3) + 8 * (r >> 2) + 4 * hi; }
__device__ __forceinline__ void partialSM(f32x16& p0, f32x16& p1, float& m_reg, float& mn, float& alpha) {
  constexpr float C = SCALE * 1.4426950408889634f;
  float pmax = p0[0];
#pragma unroll
  for (int r = 1; r < 16; ++r) pmax = fmaxf(pmax, p0[r]);
#pragma unroll
  for (int r = 0; r < 16; ++r) pmax = fmaxf(pmax, p1[r]);
  { auto rr = __builtin_amdgcn_permlane32_swap(__float_as_uint(pmax), __float_as_uint(pmax), false, false);
    pmax = fmaxf(__uint_as_float(rr[0]), __uint_as_float(rr[1])); }
  if (__builtin_expect(__all(pmax - m_reg <= THR / SCALE), 1)) { mn = m_reg; alpha = 1.f; }
  else { mn = fmaxf(m_reg, pmax); alpha = __builtin_amdgcn_exp2f((m_reg - mn) * C); m_reg = mn; }
  const float mnC = -mn * C;
#pragma unroll
  for (int r = 0; r < 16; ++r) p0[r] = fmaf(p0[r], C, mnC);
#pragma unroll
  for (int r = 0; r < 16; ++r) p1[r] = fmaf(p1[r], C, mnC);
#pragma unroll
  for (int r = 0; r < 16; ++r) p0[r] = __builtin_amdgcn_exp2f(p0[r]);
}
__device__ __forceinline__ void finishSM(f32x16& p0, f32x16& p1, float alpha, float& l_reg, bf16x8& pa0, bf16x8& pa1, bf16x8& pa2, bf16x8& pa3) {
#pragma unroll
  for (int r = 0; r < 16; ++r) p1[r] = __builtin_amdgcn_exp2f(p1[r]);
  float ps = 0;
#pragma unroll
  for (int r = 0; r < 16; ++r) ps += p0[r];
#pragma unroll
  for (int r = 0; r < 16; ++r) ps += p1[r];
  { auto rr = __builtin_amdgcn_permlane32_swap(__float_as_uint(ps), __float_as_uint(ps), false, false);
    ps = __uint_as_float(rr[0]) + __uint_as_float(rr[1]); }
  l_reg = l_reg * alpha + ps;
#define PK4(P, BASE, OUT) do { unsigned a0 = cvtpk(P[BASE + 0], P[BASE + 1]), a1 = cvtpk(P[BASE + 2], P[BASE + 3]);   \
    unsigned b0 = cvtpk(P[BASE + 4], P[BASE + 5]), b1 = cvtpk(P[BASE + 6], P[BASE + 7]);                              \
    auto r0 = __builtin_amdgcn_permlane32_swap(a0, b0, false, false); auto r1 = __builtin_amdgcn_permlane32_swap(a1, b1, false, false); \
    u32x4 w = {r0[0], r1[0], r0[1], r1[1]}; OUT = *reinterpret_cast<bf16x8*>(&w); } while (0)
  PK4(p0, 0, pa0); PK4(p0, 8, pa1); PK4(p1, 0, pa2); PK4(p1, 8, pa3);
#undef PK4
}
__device__ __forceinline__ void qkt(f32x16& p0, f32x16& p1, const char* Ks, const char* Rs, const bf16x8* qr, const char* qrl, int r32, int hi) {
  p0 = f32x16{}; p1 = f32x16{};
#pragma unroll
  for (int d0 = 0; d0 < 8; ++d0) { const int cb = (d0 * 16 + hi * 8) * 2;
    const bf16x8 b0 = *reinterpret_cast<const bf16x8*>(Ks + KSWZ(r32, cb));
    const bf16x8 b1 = *reinterpret_cast<const bf16x8*>(Ks + KSWZ(32 + r32, cb));
    p0 = __builtin_amdgcn_mfma_f32_32x32x16_bf16(b0, qr[d0], p0, 0, 0, 0);
    p1 = __builtin_amdgcn_mfma_f32_32x32x16_bf16(b1, qr[d0], p1, 0, 0, 0); }
#pragma unroll
  for (int d0 = 0; d0 < 4; ++d0) { const int cb = (d0 * 16 + hi * 8) * 2;
    const bf16x8 b0 = *reinterpret_cast<const bf16x8*>(Rs + RSWZ(r32, cb));
    const bf16x8 b1 = *reinterpret_cast<const bf16x8*>(Rs + RSWZ(32 + r32, cb));
    p0 = __builtin_amdgcn_mfma_f32_32x32x16_bf16(b0, qr[8 + d0], p0, 0, 0, 0);
    p1 = __builtin_amdgcn_mfma_f32_32x32x16_bf16(b1, qr[8 + d0], p1, 0, 0, 0); }
}
__device__ __forceinline__ int v_st(int k, int c) { const int kk = (k & ~0xC) | ((k & 4) << 1) | ((k & 8) >> 1); return ((kk >> 3) * 4 + (c >> 5)) * 512 + ((kk & 7) * 32 + (c & 31)) * 2; }
__device__ __forceinline__ int v_rd_base(int lane) { return ((lane & 3) << 3) | (((lane >> 2) & 3) << 6) | (((lane >> 4) & 1) << 5) | (((lane >> 5) & 1) << 8); }
constexpr int v_rd_off(int d0, int ks, int half) { return d0 * 512 + ks * 4096 + half * 2048; }
template <int OFF> __device__ __forceinline__ s16x4 tr_read(int vb) {
  s16x4 r; asm volatile("ds_read_b64_tr_b16 %0, %1 offset:%2" : "=&v"(r) : "v"(vb), "i"(OFF) : "memory"); return r;
}
template <int D0> __device__ __forceinline__ void pv_one(f32x16& od, int vb, bf16x8 pa0, bf16x8 pa1, bf16x8 pa2, bf16x8 pa3) {
  const s16x4 l0 = tr_read<v_rd_off(D0, 0, 0)>(vb), h0 = tr_read<v_rd_off(D0, 0, 1)>(vb), l1 = tr_read<v_rd_off(D0, 1, 0)>(vb), h1 = tr_read<v_rd_off(D0, 1, 1)>(vb);
  const s16x4 l2 = tr_read<v_rd_off(D0, 2, 0)>(vb), h2 = tr_read<v_rd_off(D0, 2, 1)>(vb), l3 = tr_read<v_rd_off(D0, 3, 0)>(vb), h3 = tr_read<v_rd_off(D0, 3, 1)>(vb);
  asm volatile("s_waitcnt lgkmcnt(0)" ::: "memory"); SBAR();
#define PK(L, H) (bf16x8){L[0], L[1], L[2], L[3], H[0], H[1], H[2], H[3]}
  od = __builtin_amdgcn_mfma_f32_32x32x16_bf16(pa0, PK(l0, h0), od, 0, 0, 0);
  od = __builtin_amdgcn_mfma_f32_32x32x16_bf16(pa1, PK(l1, h1), od, 0, 0, 0);
  od = __builtin_amdgcn_mfma_f32_32x32x16_bf16(pa2, PK(l2, h2), od, 0, 0, 0);
  od = __builtin_amdgcn_mfma_f32_32x32x16_bf16(pa3, PK(l3, h3), od, 0, 0, 0);
#undef PK
}
__device__ __forceinline__ void pv_d0(f32x16* o, int vb, bf16x8 pa0, bf16x8 pa1, bf16x8 pa2, bf16x8 pa3) {
  pv_one<0>(o[0], vb, pa0, pa1, pa2, pa3); pv_one<1>(o[1], vb, pa0, pa1, pa2, pa3); pv_one<2>(o[2], vb, pa0, pa1, pa2, pa3); pv_one<3>(o[3], vb, pa0, pa1, pa2, pa3);
}
__device__ __forceinline__ void attn_body(const bf16_t* __restrict__ Qb, const float* __restrict__ cs, const float* __restrict__ sn, const bf16_t* __restrict__ Kn,
                                          const bf16_t* __restrict__ Vh, const bf16_t* __restrict__ Kr, bf16_t* __restrict__ Ob, int seq, char* lds) {
  const int tid = otid(), wid = tid >> 6, lane = tid & 63, r32 = lane & 31, hi = lane >> 5;
  char* V_lds = lds; char* K_lds = lds + 2 * SHM_V; char* R_lds = lds + 2 * SHM_V + 2 * SHM_K;
  float* wsf = (float*)(lds + 2 * SHM_V + 2 * SHM_K + 2 * SHM_R) + wid * 64; float* li_l = wsf; float* al_l = wsf + 32;
  char* qrl = lds + 2 * SHM_V + 2 * SHM_K + 2 * SHM_R + 2048 + wid * 4096 + lane * 16;
  float m_reg = -1e30f, l_reg = 0; f32x16 o[4] = {}; bf16x8 qr[12];
  { const bf16_t* Qw = Qb + (size_t)(wid * QBLK + r32) * LDQ + hi * 8;
#pragma unroll
    for (int d0 = 0; d0 < 8; ++d0) qr[d0] = *(const bf16x8*)(Qw + d0 * 16);
#pragma unroll
    for (int d0 = 0; d0 < 2; ++d0) {
      const u32x4 a = *(const u32x4*)(Qw + 128 + d0 * 16), bq = *(const u32x4*)(Qw + 160 + d0 * 16);
      if (cs) {
        const float* cp = cs + (size_t)(wid * QBLK + r32) * 32 + d0 * 16 + hi * 8; const float* sp = sn + (size_t)(wid * QBLK + r32) * 32 + d0 * 16 + hi * 8;
        const f32x4 c0 = *(const f32x4*)cp, c1 = *(const f32x4*)(cp + 4), s0 = *(const f32x4*)sp, s1 = *(const f32x4*)(sp + 4);
        float x1[8], x2[8], y1[8], y2[8];
#pragma unroll
        for (int k = 0; k < 4; ++k) { x1[2 * k] = bflo(a[k]); x1[2 * k + 1] = bfhi(a[k]); x2[2 * k] = bflo(bq[k]); x2[2 * k + 1] = bfhi(bq[k]); }
#pragma unroll
        for (int k = 0; k < 8; ++k) { const float c = k < 4 ? c0[k & 3] : c1[k & 3], s = k < 4 ? s0[k & 3] : s1[k & 3]; y1[k] = x1[k] * c - x2[k] * s; y2[k] = x2[k] * c + x1[k] * s; }
        u32x4 w1 = {cvtpk(y1[0], y1[1]), cvtpk(y1[2], y1[3]), cvtpk(y1[4], y1[5]), cvtpk(y1[6], y1[7])}, w2 = {cvtpk(y2[0], y2[1]), cvtpk(y2[2], y2[3]), cvtpk(y2[4], y2[5]), cvtpk(y2[6], y2[7])};
        qr[8 + d0] = *reinterpret_cast<bf16x8*>(&w1); qr[10 + d0] = *reinterpret_cast<bf16x8*>(&w2);
      } else { u32x4 a_ = a, b_ = bq; qr[8 + d0] = *reinterpret_cast<bf16x8*>(&a_); qr[10 + d0] = *reinterpret_cast<bf16x8*>(&b_); }
    } }
  const int sr = tid >> 4, sc = (tid & 15) * 8, vst0 = v_st(sr, sc), vst1 = v_st(32 + sr, sc);
  const int rr_ = tid >> 3, rc = (tid & 7) * 8;
  const int vb0 = (int)(uintptr_t)V_lds + v_rd_base(lane);
  bf16x8 vs0, vs1, ks0, ks1, rs0;
  const unsigned voffKV = (unsigned)(sr * LDK + sc) * 2u, voffR = (unsigned)(rr_ * LDKR + rc) * 2u;
#define SLOAD(k0) do { const char* kb_ = (const char*)Kn + (size_t)(k0) * (LDK * 2); const char* vb_ = (const char*)Vh + (size_t)(k0) * (LDK * 2); \
    vs0 = *(const bf16x8*)(vb_ + voffKV); vs1 = *(const bf16x8*)(vb_ + 32 * LDK * 2 + voffKV); \
    ks0 = *(const bf16x8*)(kb_ + voffKV); ks1 = *(const bf16x8*)(kb_ + 32 * LDK * 2 + voffKV); \
    rs0 = *(const bf16x8*)((const char*)Kr + (size_t)(k0) * (LDKR * 2) + voffR); } while (0)
#define SWRITE(b) do { *(bf16x8*)(V_lds + (b) * SHM_V + vst0) = vs0; *(bf16x8*)(V_lds + (b) * SHM_V + vst1) = vs1; const int kc = sc * 2;  \
    *(bf16x8*)(K_lds + (b) * SHM_K + KSWZ(sr, kc)) = ks0; *(bf16x8*)(K_lds + (b) * SHM_K + KSWZ(32 + sr, kc)) = ks1;                      \
    *(bf16x8*)(R_lds + (b) * SHM_R + RSWZ(rr_, rc * 2)) = rs0; } while (0)
#define RESC(a) do { if (__any((a) < 1.f)) { if (hi == 0) al_l[r32] = (a); asm volatile("s_waitcnt lgkmcnt(0)" ::: "memory"); \
    _Pragma("unroll") for (int d = 0; d < 4; ++d) _Pragma("unroll") for (int r = 0; r < 16; ++r) o[d][r] *= al_l[crow(r, hi)]; } } while (0)
  f32x16 pA0, pA1, pB0, pB1; float mnA, mnB, alA, alB; bf16x8 pa0, pa1, pa2, pa3; const int NT = seq / KVBLK;
  SLOAD(0); SWRITE(0); __syncthreads();
  qkt(pA0, pA1, K_lds, R_lds, qr, qrl, r32, hi); partialSM(pA0, pA1, m_reg, mnA, alA);
  SLOAD(KVBLK); SWRITE(1); __syncthreads();
  for (int j = 1; j + 1 < NT; j += 2) {
    SBAR(); qkt(pB0, pB1, K_lds + SHM_K, R_lds + SHM_R, qr, qrl, r32, hi);
    finishSM(pA0, pA1, alA, l_reg, pa0, pa1, pa2, pa3); SBAR();
    SLOAD((j + 1) * KVBLK); SBAR();
    pv_d0(o, vb0, pa0, pa1, pa2, pa3); partialSM(pB0, pB1, m_reg, mnB, alB);
    __syncthreads(); SWRITE(0);
    RESC(alB); __syncthreads();
    SBAR(); qkt(pA0, pA1, K_lds, R_lds, qr, qrl, r32, hi);
    finishSM(pB0, pB1, alB, l_reg, pa0, pa1, pa2, pa3); SBAR();
    SLOAD((j + 2) * KVBLK); SBAR();
    pv_d0(o, vb0 + (int)SHM_V, pa0, pa1, pa2, pa3); partialSM(pA0, pA1, m_reg, mnA, alA);
    __syncthreads(); SWRITE(1);
    RESC(alA); __syncthreads();
  }
  SBAR(); qkt(pB0, pB1, K_lds + SHM_K, R_lds + SHM_R, qr, qrl, r32, hi);
  finishSM(pA0, pA1, alA, l_reg, pa0, pa1, pa2, pa3); SBAR();
  pv_d0(o, vb0, pa0, pa1, pa2, pa3); partialSM(pB0, pB1, m_reg, mnB, alB);
  __syncthreads(); RESC(alB);
  finishSM(pB0, pB1, alB, l_reg, pa0, pa1, pa2, pa3); SBAR();
  pv_d0(o, vb0 + (int)SHM_V, pa0, pa1, pa2, pa3);
  if (hi == 0) li_l[r32] = l_reg; asm volatile("s_waitcnt lgkmcnt(0)" ::: "memory");
  float rli[16];
#pragma unroll
  for (int r = 0; r < 16; ++r) rli[r] = __builtin_amdgcn_rcpf(li_l[crow(r, hi)]);
  bf16_t* Ow = Ob + (size_t)(wid * QBLK) * LDO;
#pragma unroll
  for (int r = 0; r < 16; ++r) { const int orow = crow(r, hi);
#pragma unroll
    for (int d0 = 0; d0 < 4; ++d0) Ow[(size_t)orow * LDO + d0 * 32 + r32] = f2bf(o[d0][r] * rli[r]); }
  __syncthreads();
#undef SLOAD
#undef SWRITE
#undef RESC
}
}

__device__ void phase_attn(PRef p, int l, char* smem) {
  const bf16_t* Q = (const bf16_t*)(p.ws + WS_Q); const bf16_t* KV = (const bf16_t*)(p.ws + WS_KV); const bf16_t* KR = (const bf16_t*)(p.ws + WS_KR);
  bf16_t* mix = (bf16_t*)(p.ws + WS_MIX); const float* cs = (const float*)(p.ws + WS_COS); const float* sn = (const float*)(p.ws + WS_SIN);
  const int nunits = 1024 + (l == 0 ? 32 : 0);
  for (int u = obid(); u < nunits; u += gridDim.x) {
    if (u < 1024) {
      const int bh = (u >> 8) * 8 + (u & 7), qb = (u & 255) >> 3, hd = bh & 3, b = bh >> 2; const size_t row0 = (size_t)b * SEQ + qb * 256;
      att::attn_body(Q + row0 * 768 + hd * 192, cs + (size_t)qb * 256 * 32, sn + (size_t)qb * 256 * 32, KV + (size_t)b * SKV * 1024 + hd * 256,
                     KV + (size_t)b * SKV * 1024 + hd * 256 + 128, KR + (size_t)b * SKV * 64, mix + row0 * 1024 + 512 + hd * 128, SKV, smem);
    } else {
      const int v = u - 1024, hd = v & 3, b = v >> 2; const size_t row0 = (size_t)MX + b * CTXL;
      att::attn_body(Q + row0 * 768 + hd * 192, nullptr, nullptr, KV + (size_t)b * SKV * 1024 + hd * 256,
                     KV + (size_t)b * SKV * 1024 + hd * 256 + 128, KR + (size_t)b * SKV * 64, mix + row0 * 1024 + 512 + hd * 128, CTXL, smem);
    }
  }
}

__device__ void phase_outproj(PRef p, int l, char* smem) {
  LAS unsigned char* lds = (LAS unsigned char*)smem;
  const bf16_t* mix = (const bf16_t*)(p.ws + WS_MIX); const bf16_t* Wt = (const bf16_t*)(p.ws + WS_WOUT) + (size_t)l * 1024 * 1024;
  float* ctxz = (float*)(p.ws + WS_CTXZ);
  const int tid = otid(), wid = tid >> 6, lane = tid & 63, wr = wid >> 2, wc = wid & 3, fr = lane & 15, fq = lane >> 4;
  g8::TileIter it; it.init(l == 0 ? MT / 256 : MX / 256, 4);
  int pm, pn;
  while (it.next(pm, pn)) {
    unsigned voffA[2] = {g8::piece_off(0, 1024, 0), g8::piece_off(1, 1024, 0)};
    f32x4 acc[2][2][4][2];
    g8::gemm_tile<false>(lds, (const char*)(mix + (size_t)pm * 256 * 1024), voffA, (size_t)128 * 1024 * 2, (const char*)(Wt + (size_t)pn * 256 * 1024), 1024, acc);
    ACC_FOR(ai, bj, m, n) {
      const int row = pm * 256 + ai * 128 + wr * 64 + m * 16 + fr, col = pn * 256 + bj * 128 + wc * 32 + fq * 8 + n * 4;
      const float* res = l == 0 ? (row < MX ? p.x + (size_t)row * 1024 : p.ctx + (size_t)(row - MX) * 1024) : p.out + (size_t)row * 1024;
      float* dst = row < MX ? p.out + (size_t)row * 1024 : ctxz + (size_t)(row - MX) * 1024;
      const f32x4 r = *(const f32x4*)(res + col), g = *(const f32x4*)(mod_ptr(p, l, row, 2) + col);
      *(f32x4*)(dst + col) = r * ALPHA + g * acc[ai][bj][m][n];
    }
  }
}

__device__ void phase_ln1(PRef p, int l, char* smem) {
  float* wrt = (float*)smem;
  for (int i = otid(); i < 16384; i += 512) wrt[(i & 15) * 1024 + (i >> 4)] = p.w_router[(size_t)l * 16384 + i];
  __syncthreads();
  const int lane = otid() & 63, gw = obid() * 8 + (otid() >> 6), nw = gridDim.x * 8;
  bf16_t* h = (bf16_t*)(p.ws + WS_H); float* ctxz = (float*)(p.ws + WS_CTXZ); float* aff = (float*)(p.ws + WS_AFF);
  const int nrows = l == 0 ? MT : MX;
  for (int row = gw; row < nrows; row += nw) {
    asm volatile("" ::: "memory");
    float* zr = row < MX ? p.out + (size_t)row * 1024 : ctxz + (size_t)(row - MX) * 1024;
    f32x4 v[4];
#pragma unroll
    for (int i = 0; i < 4; ++i) v[i] = *(const f32x4*)(zr + lane * 4 + 256 * i);
    ln_row(v, 1e-5f);
#pragma unroll
    for (int i = 0; i < 4; ++i) { const int c = lane * 4 + 256 * i; v[i] = v[i] * *(const f32x4*)(p.ln1_g + l * 1024 + c) + *(const f32x4*)(p.ln1_b + l * 1024 + c); *(f32x4*)(zr + c) = v[i]; }
    ln_row(v, 1e-6f);
    f32x4 hm[4];
    store_mod_bf16(v, mod_ptr(p, l, row, 3), mod_ptr(p, l, row, 4), h + (size_t)row * 1024, lane, &hm);
    float lg[16];
#pragma unroll
    for (int e = 0; e < 16; ++e) { float s = 0.f;
#pragma unroll
      for (int i = 0; i < 4; ++i) { const f32x4 w = *(const f32x4*)(wrt + e * 1024 + lane * 4 + 256 * i); s += hm[i][0] * w[0] + hm[i][1] * w[1] + hm[i][2] * w[2] + hm[i][3] * w[3]; }
      lg[e] = wave_sum(s); }
    float mx = lg[0];
#pragma unroll
    for (int e = 1; e < 16; ++e) mx = fmaxf(mx, lg[e]);
    float den = 0.f;
#pragma unroll
    for (int e = 0; e < 16; ++e) { lg[e] = expf(lg[e] - mx); den += lg[e]; }
    float mine = 0.f;
#pragma unroll
    for (int e = 0; e < 16; ++e) if (lane == e) mine = lg[e] / den;
    if (lane < 16) aff[(size_t)row * 16 + lane] = mine;
  }
}

template <int PER>
__device__ __forceinline__ void topk_item(const float* __restrict__ affp, int n, int kcap, int rowbase, int slotbase, int e, int* __restrict__ IDX, float* __restrict__ GV, int* __restrict__ TS, char* smem) {
  unsigned* hist = (unsigned*)smem; unsigned* sel = hist + 256; unsigned* wtot = hist + 272;
  const int tid = otid(), lane = tid & 63, wid = tid >> 6;
  const bool active = tid * PER < n;
  unsigned key[PER];
#pragma unroll
  for (int i = 0; i < PER; ++i) key[i] = active ? __float_as_uint(affp[(size_t)(tid * PER + i) * 16]) : 0u;
  unsigned prefix = 0u, mask = 0u; int kk = kcap;
#pragma unroll 1
  for (int shift = 24; shift >= 0; shift -= 8) {
    __syncthreads();
    if (tid < 256) hist[tid] = 0u;
    __syncthreads();
#pragma unroll
    for (int i = 0; i < PER; ++i) if (active && (key[i] & mask) == prefix) atomicAdd(&hist[(key[i] >> shift) & 255u], 1u);
    __syncthreads();
    if (wid == 0) {
      const unsigned h0 = hist[lane * 4], h1 = hist[lane * 4 + 1], h2 = hist[lane * 4 + 2], h3 = hist[lane * 4 + 3];
      const unsigned tot = h0 + h1 + h2 + h3; unsigned suf = tot;
#pragma unroll
      for (int o = 1; o < 64; o <<= 1) { const unsigned u = __shfl_down(suf, o); if (lane + o < 64) suf += u; }
      const unsigned above = suf - tot;
      if (above < (unsigned)kk && suf >= (unsigned)kk) {
        unsigned a = above; int bin;
        if (a + h3 >= (unsigned)kk) bin = 3; else { a += h3; if (a + h2 >= (unsigned)kk) bin = 2; else { a += h2; if (a + h1 >= (unsigned)kk) bin = 1; else { a += h1; bin = 0; } } }
        sel[0] = prefix | ((unsigned)(lane * 4 + bin) << shift); sel[1] = (unsigned)kk - a;
      }
    }
    __syncthreads();
    prefix = sel[0]; kk = (int)sel[1]; mask |= 0xffu << shift;
  }
  const unsigned Tk = prefix;
  unsigned cg_ = 0, ce = 0;
#pragma unroll
  for (int i = 0; i < PER; ++i) { cg_ += key[i] > Tk; ce += key[i] == Tk; }
  unsigned pk = active ? (cg_ | (ce << 16)) : 0u, inc = pk;
#pragma unroll
  for (int o = 1; o < 64; o <<= 1) { const unsigned u = __shfl_up(inc, o); if (lane >= o) inc += u; }
  __syncthreads();
  if (lane == 63) wtot[wid] = inc;
  __syncthreads();
  unsigned base = 0;
  for (int w2 = 0; w2 < wid; ++w2) base += wtot[w2];
  const unsigned exc = base + inc - pk; unsigned gt_before = exc & 0xffffu, eq_before = exc >> 16;
  if (active) {
#pragma unroll
    for (int i = 0; i < PER; ++i) {
      const int t = tid * PER + i; int R = -1;
      const bool isgt = key[i] > Tk, iseq = key[i] == Tk;
      if (isgt || (iseq && (int)eq_before < kk)) {
        const int slot = (int)gt_before + min((int)eq_before, kk);
        R = slotbase + slot; IDX[R] = rowbase + t; GV[R] = __uint_as_float(key[i]);
      }
      TS[t] = R;
      gt_before += isgt; eq_before += iseq;
    }
  }
}
__device__ void phase_topk(PRef p, int l, char* smem) {
  const float* aff = (const float*)(p.ws + WS_AFF); int* IDX = (int*)(p.ws + WS_IDX); float* GV = (float*)(p.ws + WS_GV); int* TS = (int*)(p.ws + WS_TS);
  const int nitems = l == 0 ? 256 : 128;
  for (int it = obid(); it < nitems; it += gridDim.x) {
    if (it < 128) { const int b = it >> 4, e = it & 15; topk_item<16>(aff + (size_t)b * SEQ * 16 + e, SEQ, CAPX, b * SEQ, it * CAPX, e, IDX, GV, TS + (size_t)it * SEQ, smem); }
    else { const int v = it - 128, b = v >> 4, e = v & 15; topk_item<1>(aff + ((size_t)MX + b * CTXL) * 16 + e, CTXL, CAPC, MX + b * CTXL, NB * NE * CAPX + e * 256 + b * CAPC, e, IDX, GV, TS + (size_t)NB * 16 * SEQ + (size_t)v * CTXL, smem); }
  }
  __syncthreads();
}

__device__ void phase_moe_up(PRef p, int l, char* smem) {
  LAS unsigned char* lds = (LAS unsigned char*)smem;
  const bf16_t* h = (const bf16_t*)(p.ws + WS_H); const bf16_t* Wgu = (const bf16_t*)(p.ws + WS_WGU); bf16_t* act = (bf16_t*)(p.ws + WS_ACT); const int* IDX = (const int*)(p.ws + WS_IDX);
  const int tid = otid(), wid = tid >> 6, lane = tid & 63, wr = wid >> 2, wc = wid & 3, fr = lane & 15, fq = lane >> 4;
  g8::MoeIter it; it.init(8, l == 0);
  int pm, pn, e;
  while (it.next(pm, pn, e)) {
    unsigned voffA[4];
#pragma unroll
    for (int hh = 0; hh < 2; ++hh)
#pragma unroll
      for (int i = 0; i < 2; ++i) { int R, C; g8::piece_rc(i, R, C); voffA[hh * 2 + i] = (unsigned)(IDX[pm * 256 + hh * 128 + R] * 1024 + C) * 2u; }
    f32x4 acc[2][2][4][2];
    g8::gemm_tile<true>(lds, (const char*)h, voffA, 0, (const char*)(Wgu + ((size_t)e * 2048 + pn * 256) * 1024), 1024, acc);
#pragma unroll
    for (int ai = 0; ai < 2; ++ai)
#pragma unroll
      for (int m = 0; m < 4; ++m) {
          const int row = pm * 256 + ai * 128 + wr * 64 + m * 16 + fr, col = pn * 128 + wc * 32 + fq * 8;
          float a[8];
#pragma unroll
          for (int n = 0; n < 2; ++n) { const f32x4 g = acc[ai][0][m][n], u = acc[ai][1][m][n];
#pragma unroll
            for (int k = 0; k < 4; ++k) a[n * 4 + k] = silu_f(g[k]) * u[k]; }
          u32x4 w = {cvtpk(a[0], a[1]), cvtpk(a[2], a[3]), cvtpk(a[4], a[5]), cvtpk(a[6], a[7])}; *(u32x4*)(act + (size_t)row * 1024 + col) = w;
        }
  }
}
__device__ void phase_moe_down(PRef p, int l, char* smem) {
  LAS unsigned char* lds = (LAS unsigned char*)smem;
  const bf16_t* act = (const bf16_t*)(p.ws + WS_ACT); const bf16_t* Wdn = (const bf16_t*)(p.ws + WS_WDN); bf16_t* oute = (bf16_t*)(p.ws + WS_OUTE); const float* GV = (const float*)(p.ws + WS_GV);
  const int tid = otid(), wid = tid >> 6, lane = tid & 63, wr = wid >> 2, wc = wid & 3, fr = lane & 15, fq = lane >> 4;
  g8::MoeIter it; it.init(4, l == 0);
  int pm, pn, e;
  while (it.next(pm, pn, e)) {
    unsigned voffA[2] = {g8::piece_off(0, 1024, 0), g8::piece_off(1, 1024, 0)};
    f32x4 acc[2][2][4][2];
    g8::gemm_tile<false>(lds, (const char*)(act + (size_t)pm * 256 * 1024), voffA, (size_t)128 * 1024 * 2, (const char*)(Wdn + ((size_t)e * 1024 + pn * 256) * 1024), 1024, acc);
    ACC_FOR3(ai, bj, m) {
      const int row = pm * 256 + ai * 128 + wr * 64 + m * 16 + fr, col = pn * 256 + bj * 128 + wc * 32 + fq * 8;
      const float gv = GV[row]; const f32x4 v0 = acc[ai][bj][m][0] * gv, v1 = acc[ai][bj][m][1] * gv;
      u32x4 w = {cvtpk(v0[0], v0[1]), cvtpk(v0[2], v0[3]), cvtpk(v1[0], v1[1]), cvtpk(v1[2], v1[3])}; *(u32x4*)(oute + (size_t)row * 1024 + col) = w;
    }
  }
}

__device__ void phase_ln2(PRef p, int l) {
  const int lane = otid() & 63, gw = obid() * 8 + (otid() >> 6), nw = gridDim.x * 8;
  bf16_t* h = (bf16_t*)(p.ws + WS_H); float* ctxz = (float*)(p.ws + WS_CTXZ); const bf16_t* oute = (const bf16_t*)(p.ws + WS_OUTE); const int* TS = (const int*)(p.ws + WS_TS);
  const int nrows = l == 0 ? MT : MX;
  for (int row = gw; row < nrows; row += nw) {
    float* xr = row < MX ? p.out + (size_t)row * 1024 : ctxz + (size_t)(row - MX) * 1024;
    f32x4 mo[4];
#pragma unroll
    for (int i = 0; i < 4; ++i) mo[i] = (f32x4){0.f, 0.f, 0.f, 0.f};
    const int myR = lane < 16 ? (row < MX ? TS[((size_t)(row >> 13) * 16 + lane) * SEQ + (row & 8191)] : TS[(size_t)NB * 16 * SEQ + ((size_t)((row - MX) >> 8) * 16 + lane) * CTXL + ((row - MX) & 255)]) : -1;
    for (int e = 0; e < 16; ++e) { const int Rr = __shfl(myR, e);
      if (Rr >= 0) {
#pragma unroll
        for (int i = 0; i < 4; ++i) { const u32x2 w = *(const u32x2*)(oute + (size_t)Rr * 1024 + lane * 4 + 256 * i);
          mo[i][0] += bflo(w[0]); mo[i][1] += bfhi(w[0]); mo[i][2] += bflo(w[1]); mo[i][3] += bfhi(w[1]); } } }
    f32x4 v[4]; const float* m5 = mod_ptr(p, l, row, 5);
#pragma unroll
    for (int i = 0; i < 4; ++i) { const int c = lane * 4 + 256 * i; v[i] = *(const f32x4*)(xr + c) * ALPHA + *(const f32x4*)(m5 + c) * mo[i]; }
    ln_row(v, 1e-5f);
#pragma unroll
    for (int i = 0; i < 4; ++i) { const int c = lane * 4 + 256 * i; v[i] = v[i] * *(const f32x4*)(p.ln2_g + l * 1024 + c) + *(const f32x4*)(p.ln2_b + l * 1024 + c); *(f32x4*)(xr + c) = v[i]; }
    if (l + 1 < DEPTH) { ln_row(v, 1e-6f); store_mod_bf16(v, mod_ptr(p, l + 1, row, 0), mod_ptr(p, l + 1, row, 1), h + (size_t)row * 1024, lane, nullptr); }
  }
}

__device__ __forceinline__ void gsync(cg::grid_group& grid) {
  asm volatile("s_waitcnt vmcnt(0) lgkmcnt(0)" ::: "memory");
  grid.sync();
}
#define XB_CEN(j) (64 * (j))
#define XB_SUB(j) (1024 + 64 * (j))
#define XB_TOP 2048
struct FastBar { unsigned* w; unsigned xcc, nloc, nx, epoch; };
__device__ __forceinline__ unsigned xb_ld(unsigned* q) { return __hip_atomic_load(q, __ATOMIC_RELAXED, __HIP_MEMORY_SCOPE_AGENT); }
__device__ __forceinline__ unsigned xb_add(unsigned* q, unsigned v) { return __hip_atomic_fetch_add(q, v, __ATOMIC_RELAXED, __HIP_MEMORY_SCOPE_AGENT); }
__device__ __forceinline__ void fsync(FastBar& fb) {
  asm volatile("s_waitcnt vmcnt(0) lgkmcnt(0)" ::: "memory");
  __syncthreads();
  fb.epoch += 1u;
  if (otid() == 0) {
    const unsigned a = xb_add(&fb.w[XB_SUB(fb.xcc)], 1u) + 1u;
    if (a == fb.nloc * fb.epoch) {
      __builtin_amdgcn_fence(__ATOMIC_RELEASE, "agent");
      asm volatile("s_waitcnt vmcnt(0)" ::: "memory");
      (void)xb_add(&fb.w[XB_TOP], 1u);
    }
    while (xb_ld(&fb.w[XB_TOP]) < fb.nx * fb.epoch) __builtin_amdgcn_s_sleep(1);
    __builtin_amdgcn_fence(__ATOMIC_ACQUIRE, "agent");
    asm volatile("s_waitcnt vmcnt(0)" ::: "memory");
  }
  __syncthreads();
}
__global__ void __launch_bounds__(512) mega(Params p) {
  extern __shared__ __attribute__((aligned(16))) char smem[];
  cg::grid_group grid = cg::this_grid();
  FastBar fb; fb.w = (unsigned*)(kparams().ws + WS_BAR); fb.xcc = (unsigned)__builtin_amdgcn_readfirstlane((int)(__builtin_amdgcn_s_getreg((3 << 11) | 20) & 0xF)); fb.epoch = 0u; fb.nloc = 0u; fb.nx = 0u;
  if (otid() == 0) (void)xb_add(&fb.w[XB_CEN(fb.xcc)], 1u);
  phase_prep(kparams(), smem);
  gsync(grid);
  { unsigned nx = 0u;
#pragma unroll 1
    for (int j = 0; j < 16; ++j) nx += xb_ld(&fb.w[XB_CEN(j)]) != 0u;
    fb.nx = (unsigned)__builtin_amdgcn_readfirstlane((int)nx); fb.nloc = (unsigned)__builtin_amdgcn_readfirstlane((int)xb_ld(&fb.w[XB_CEN(fb.xcc)])); }
  phase_h0(kparams());
  fsync(fb);
#pragma unroll 1
  for (int l = 0; l < DEPTH; ++l) {
    phase_inproj(kparams(), l, smem);
    fsync(fb);
    phase_mlstm_pre(kparams(), l, smem);
    fsync(fb);
    phase_mlstm(kparams(), l, smem);
    fsync(fb);
    phase_mla_prep(kparams(), l, smem);
    fsync(fb);
    phase_attn(kparams(), l, smem);
    fsync(fb);
    phase_outproj(kparams(), l, smem);
    fsync(fb);
    phase_ln1(kparams(), l, smem);
    __syncthreads();
    phase_cvt_experts(kparams(), l, smem);
    fsync(fb);
    phase_topk(kparams(), l, smem);
    fsync(fb);
    phase_moe_up(kparams(), l, smem);
    fsync(fb);
    phase_moe_down(kparams(), l, smem);
    fsync(fb);
    phase_ln2(kparams(), l);
    fsync(fb);
  }
}

extern "C" void kernel_launch(void* const* d_in, const int* in_sizes, int n_in, void* d_out, int out_size,
                              void* d_ws, size_t ws_size, hipStream_t stream) {
  constexpr size_t kDynLds = 160 * 1024;
  static int grid_blocks = 0;
  if (!grid_blocks) {
    int dev = 0, cus = 0, per_cu = 0;
    (void)hipGetDevice(&dev);
    (void)hipDeviceGetAttribute(&cus, hipDeviceAttributeMultiprocessorCount, dev);
    (void)hipFuncSetAttribute((const void*)mega, hipFuncAttributeMaxDynamicSharedMemorySize, (int)kDynLds);
    (void)hipOccupancyMaxActiveBlocksPerMultiprocessor(&per_cu, mega, 512, kDynLds);
    grid_blocks = per_cu > 0 ? cus : 0;
    if (grid_blocks > 256) grid_blocks = 256;
    grid_blocks &= ~7;
    if (grid_blocks != 256) { fprintf(stderr, "this kernel needs 256 co-resident workgroups (got %d)\n", grid_blocks); grid_blocks = 0; }
    if (ws_size < WS_END) { fprintf(stderr, "workspace too small: %zu < %zu\n", ws_size, (size_t)WS_END); grid_blocks = 0; }
  }
  if (grid_blocks <= 0) return;
  Params p{};
  const float** pp = (const float**)&p;
  for (int i = 0; i < 24; ++i) pp[i] = (const float*)d_in[i];
  p.out = (float*)d_out; p.ws = (char*)d_ws;
  (void)hipMemsetAsync((char*)d_ws + WS_BAR, 0, WS_BAR_BYTES, stream);
  void* args[] = {&p};
  hipError_t e = hipLaunchCooperativeKernel((void*)mega, dim3(grid_blocks), dim3(512), args, kDynLds, stream);
  if (e != hipSuccess) fprintf(stderr, "cooperative launch failed: %s (grid %d)\n", hipGetErrorString(e), grid_blocks);
}
```

```cpp
#include <hip/hip_runtime.h>
#include <hip/hip_cooperative_groups.h>
#include <cstdio>
#include <cstdint>
namespace cg = cooperative_groups;

typedef unsigned short bf16_t;
typedef short bf16x8 __attribute__((ext_vector_type(8)));
typedef short s16x4 __attribute__((ext_vector_type(4)));
typedef float f32x4 __attribute__((ext_vector_type(4)));
typedef float f32x16 __attribute__((ext_vector_type(16)));
typedef unsigned u32x4 __attribute__((ext_vector_type(4)));
typedef unsigned u32x2 __attribute__((ext_vector_type(2)));
#define LAS __attribute__((address_space(3)))

constexpr int DM = 1024, NB = 8, SEQ = 8192, CTXL = 256, DEPTH = 2;
constexpr int MX = NB * SEQ, MC = NB * CTXL, MT = MX + MC;
constexpr int PLD = 2816;
constexpr int OFF_Q = 0, OFF_K = 512, OFF_V = 1024, OFF_O = 1536, OFF_G = 2048, OFF_CQ = 2064, OFF_CKV = 2448, OFF_KR = 2704, IN_COLS = 2768;
constexpr int SKV = SEQ + CTXL;
constexpr int NE = 16, CAPX = 1024, CAPC = 32;
constexpr int NSLOT = NB * NE * CAPX + NB * NE * CAPC;
constexpr float ALPHA = 1.4142135623730951f;
constexpr float A_SCALE = 0.07216878364870322f;

constexpr size_t al256(size_t v) { return (v + 255) / 256 * 256; }
constexpr size_t WS_H = 0;
constexpr size_t WS_P = WS_H + al256((size_t)MT * 1024 * 2);
constexpr size_t WS_Q = WS_P + al256((size_t)MT * PLD * 2);
constexpr size_t WS_KV = WS_Q + al256((size_t)MT * 768 * 2);
constexpr size_t WS_KR = WS_KV + al256((size_t)NB * SKV * 1024 * 2);
constexpr size_t WS_MIX = WS_KR + al256((size_t)NB * SKV * 64 * 2);
constexpr size_t WS_ACT = WS_P;
constexpr size_t WS_HB = WS_H;
constexpr size_t WS_OUTE = WS_P + al256((size_t)NSLOT * 1024 * 2);
constexpr size_t WS_WGU = WS_MIX;
constexpr size_t WS_WDN = WS_MIX + (size_t)NE * 2048 * 1024 * 2;
constexpr size_t WS_WIN = WS_MIX + al256((size_t)MT * 1024 * 2);
constexpr size_t WS_WUQ = WS_WIN + (size_t)2 * PLD * 1024 * 2;
constexpr size_t WS_WUKV = WS_WUQ + (size_t)2 * 768 * 384 * 2;
constexpr size_t WS_WOUT = WS_WUKV + (size_t)2 * 1024 * 256 * 2;
constexpr size_t WS_MOD = WS_WOUT + (size_t)2 * 1024 * 1024 * 2;
constexpr size_t WS_COS = WS_MOD + al256((size_t)2 * 9 * 6144 * 4);
constexpr size_t WS_SIN = WS_COS + (size_t)SEQ * 32 * 4;
constexpr size_t WS_GATES = WS_SIN + (size_t)SEQ * 32 * 4;
constexpr size_t WS_AFF = WS_GATES + (size_t)MT * 16 * 4;
constexpr size_t WS_IDX = WS_AFF + (size_t)MT * 16 * 4;
constexpr size_t WS_GV = WS_IDX + (size_t)NSLOT * 4;
constexpr size_t WS_TS = WS_GV + (size_t)NSLOT * 4;
constexpr size_t WS_CTXZ = WS_TS + (size_t)MT * 16 * 4;
constexpr size_t WS_BAR = WS_CTXZ + (size_t)MC * 1024 * 4;
constexpr size_t WS_BAR_BYTES = 16384;
constexpr size_t WS_END = WS_BAR + WS_BAR_BYTES;
static_assert(WS_OUTE + (size_t)NSLOT * 1024 * 2 <= WS_KR, "out_e overlay");
static_assert(WS_WDN + (size_t)NE * 1024 * 1024 * 2 <= WS_WIN, "expert weights overlay");

struct Params {
  const float *x, *c, *ctx, *c_ctx, *w_mod, *b_mod, *w_in, *b_gates, *conv_w, *conv_b, *m_norm_w, *q_norm_w, *kv_norm_w, *w_uq, *w_ukv, *w_out,
      *ln1_g, *ln1_b, *w_router, *w_gate, *w_up, *w_down, *ln2_g, *ln2_b;
  float* out; char* ws;
};

typedef const __attribute__((address_space(4))) Params& PRef;
__device__ __forceinline__ PRef kparams() { const __attribute__((address_space(4))) Params* kp = (const __attribute__((address_space(4))) Params*)__builtin_amdgcn_kernarg_segment_ptr(); asm volatile("" : "+s"(kp)); return *kp; }
__device__ __forceinline__ int otid() { int t = threadIdx.x; asm volatile("" : "+v"(t)); return t; }
__device__ __forceinline__ int obid() { int t = blockIdx.x; asm volatile("" : "+s"(t)); return t; }
__device__ __forceinline__ int opaque_s(int v) { asm volatile("" : "+s"(v)); return v; }
typedef __bf16 bf16v2_t __attribute__((ext_vector_type(2)));
typedef float f32x2_t __attribute__((ext_vector_type(2)));
__device__ __forceinline__ unsigned cvtpk(float lo, float hi) { const f32x2_t f = {lo, hi}; const bf16v2_t b = __builtin_convertvector(f, bf16v2_t); return __builtin_bit_cast(unsigned, b); }
__device__ __forceinline__ bf16_t f2bf(float v) { return (bf16_t)(cvtpk(v, v) & 0xffffu); }
__device__ __forceinline__ float bf2f(unsigned v) { return __uint_as_float(v << 16); }
__device__ __forceinline__ float bflo(unsigned w) { return __uint_as_float(w << 16); }
__device__ __forceinline__ float bfhi(unsigned w) { return __uint_as_float(w & 0xffff0000u); }
__device__ __forceinline__ float wave_sum(float v) { for (int o = 32; o > 0; o >>= 1) v += __shfl_xor(v, o); return v; }
__device__ __forceinline__ float wave_max(float v) { for (int o = 32; o > 0; o >>= 1) v = fmaxf(v, __shfl_xor(v, o)); return v; }
__device__ __forceinline__ float sigmoid_f(float v) { return __builtin_amdgcn_rcpf(1.f + __expf(-v)); }
__device__ __forceinline__ float silu_f(float v) { return v * sigmoid_f(v); }

namespace g8 {
constexpr int BK = 64, HALF = 128, HTB = HALF * BK * 2, STAGE_BYTES = 8 * HTB;
__device__ __forceinline__ int lds_byte(int r, int c) { const int st = (r >> 4) * 2 + (c >> 5), rr = r & 15, cc = c & 31, ob = rr * 64 + cc * 2; return st * 1024 + (ob ^ (((ob >> 9) & 1) << 5)); }
__device__ __forceinline__ int perm32(int rho) { const int n = rho >> 4, i = rho & 15; return 8 * (i >> 2) + 4 * n + (i & 3); }
__device__ __forceinline__ void stage_rc(int b, int& R, int& C) { const int st = b / 1024, sb = b % 1024, swz = sb ^ (((sb >> 9) & 1) << 5); R = (st >> 1) * 16 + swz / 64; C = (st & 1) * 32 + (swz % 64) / 2; }

template <bool GATHER>
__device__ __forceinline__ void gemm_tile(LAS unsigned char* lds, const char* __restrict__ Ab, const unsigned (&voffA)[GATHER ? 4 : 2], size_t hstepA, const char* __restrict__ Bb, int K,
                                          f32x4 (&acc)[2][2][4][2]) {
  const int tid = otid(), wid = __builtin_amdgcn_readfirstlane(tid >> 6), lane = tid & 63, wr = wid >> 2, wc = wid & 3, fr = lane & 15, fq = lane >> 4;
  const int nt = K / BK;
  unsigned voffB[2];
#pragma unroll
  for (int i = 0; i < 2; ++i) { int R, C; stage_rc(tid * 16 + i * 8192, R, C); const int Rb = (R & ~31) + perm32(R & 31); voffB[i] = (unsigned)(Rb * K + C) * 2u; }
  const char* Bb1 = Bb + (size_t)HALF * K * 2; const char* Ab1 = GATHER ? Ab : Ab + hstepA;
  const unsigned* vA0 = &voffA[0]; const unsigned* vA1 = GATHER ? &voffA[2] : &voffA[0];
  const unsigned ldsw = (unsigned)wid * 1024u;
  const int aoff = lds_byte(wr * 64 + fr, fq * 8), boff = lds_byte(wc * 32 + fr, fq * 8);
#define G8_SA(b, h) (((b) * 2 + (h)) * HTB)
#define G8_SB(b, h) ((4 + (b) * 2 + (h)) * HTB)
#define G8_STAGE(bufoff, gbase, voff, kt) do { _Pragma("unroll") for (int _i = 0; _i < 2; ++_i) \
    __builtin_amdgcn_global_load_lds((const unsigned*)((gbase) + (size_t)(kt) * (BK * 2) + (voff)[_i]), (LAS unsigned*)(lds + (bufoff) + ldsw + _i * 8192), 16, 0, 0); } while (0)
#define G8_LDA(dst, b, h) do { _Pragma("unroll") for (int m = 0; m < 4; ++m) _Pragma("unroll") for (int k = 0; k < 2; ++k) dst[m][k] = *(const LAS bf16x8*)(lds + G8_SA(b, h) + aoff + m * 2048 + k * 1024); } while (0)
#define G8_LDB(dst, b, h) do { _Pragma("unroll") for (int n = 0; n < 2; ++n) _Pragma("unroll") for (int k = 0; k < 2; ++k) dst[n][k] = *(const LAS bf16x8*)(lds + G8_SB(b, h) + boff + n * 2048 + k * 1024); } while (0)
#define G8_MMA(ai, bj, At, Bt) do { __builtin_amdgcn_s_setprio(1); _Pragma("unroll") for (int m = 0; m < 4; ++m) _Pragma("unroll") for (int n = 0; n < 2; ++n) _Pragma("unroll") for (int k = 0; k < 2; ++k) \
    acc[ai][bj][m][n] = __builtin_amdgcn_mfma_f32_16x16x32_bf16(Bt[n][k], At[m][k], acc[ai][bj][m][n], 0, 0, 0); __builtin_amdgcn_s_setprio(0); } while (0)
#define G8_WAIT_V(n) asm volatile("s_waitcnt vmcnt(" #n ")" ::: "memory")
#define G8_WAIT_L(n) asm volatile("s_waitcnt lgkmcnt(" #n ")" ::: "memory")
#define G8_BAR __builtin_amdgcn_s_barrier()
#define G8_SCHED __builtin_amdgcn_sched_barrier(0)
#pragma unroll
  for (int a = 0; a < 2; ++a)
#pragma unroll
    for (int b = 0; b < 2; ++b)
#pragma unroll
      for (int m = 0; m < 4; ++m)
#pragma unroll
        for (int n = 0; n < 2; ++n) acc[a][b][m][n] = (f32x4){0.f, 0.f, 0.f, 0.f};
  bf16x8 At[4][2], B0[2][2], B1[2][2];
  G8_WAIT_V(0); __syncthreads();
  G8_STAGE(G8_SB(0, 0), Bb, voffB, 0); G8_STAGE(G8_SA(0, 0), Ab, vA0, 0); G8_STAGE(G8_SB(0, 1), Bb1, voffB, 0); G8_STAGE(G8_SA(0, 1), Ab1, vA1, 0);
  if (wr == 1) G8_BAR;
  G8_WAIT_V(4); G8_BAR;
  G8_STAGE(G8_SB(1, 0), Bb, voffB, 1); G8_STAGE(G8_SA(1, 0), Ab, vA0, 1); G8_STAGE(G8_SB(1, 1), Bb1, voffB, 1);
  G8_WAIT_V(6); G8_BAR;
  for (int t = 0; t < nt - 2; t += 2) {
    G8_LDB(B0, 0, 0); G8_SCHED; G8_LDA(At, 0, 0); G8_STAGE(G8_SA(1, 1), Ab1, vA1, t + 1);
    G8_WAIT_L(8); G8_BAR; G8_WAIT_L(0); G8_MMA(0, 0, At, B0); G8_BAR; G8_SCHED;
    G8_LDB(B1, 0, 1); G8_STAGE(G8_SB(0, 0), Bb, voffB, t + 2);
    G8_BAR; G8_WAIT_L(0); G8_MMA(0, 1, At, B1); G8_BAR;
    G8_LDA(At, 0, 1); G8_STAGE(G8_SA(0, 0), Ab, vA0, t + 2);
    G8_BAR; G8_WAIT_L(0); G8_MMA(1, 0, At, B0); G8_BAR; G8_SCHED;
    G8_STAGE(G8_SB(0, 1), Bb1, voffB, t + 2);
    G8_WAIT_V(6); G8_BAR; G8_MMA(1, 1, At, B1); G8_BAR;
    G8_LDB(B0, 1, 0); G8_SCHED; G8_LDA(At, 1, 0); G8_STAGE(G8_SA(0, 1), Ab1, vA1, t + 2);
    G8_WAIT_L(8); G8_BAR; G8_WAIT_L(0); G8_MMA(0, 0, At, B0); G8_BAR; G8_SCHED;
    G8_LDB(B1, 1, 1); G8_STAGE(G8_SB(1, 0), Bb, voffB, t + 3);
    G8_BAR; G8_WAIT_L(0); G8_MMA(0, 1, At, B1); G8_BAR;
    G8_LDA(At, 1, 1); G8_STAGE(G8_SA(1, 0), Ab, vA0, t + 3);
    G8_BAR; G8_WAIT_L(0); G8_MMA(1, 0, At, B0); G8_BAR; G8_SCHED;
    G8_STAGE(G8_SB(1, 1), Bb1, voffB, t + 3);
    G8_WAIT_V(6); G8_BAR; G8_MMA(1, 1, At, B1); G8_BAR;
  }
  { G8_LDB(B0, 0, 0); G8_LDA(At, 0, 0); G8_STAGE(G8_SA(1, 1), Ab1, vA1, nt - 1);
    G8_BAR; G8_WAIT_L(0); G8_MMA(0, 0, At, B0); G8_BAR;
    G8_LDB(B1, 0, 1); G8_BAR; G8_WAIT_L(0); G8_MMA(0, 1, At, B1); G8_BAR;
    G8_LDA(At, 0, 1); G8_WAIT_V(4); G8_BAR; G8_WAIT_L(0); G8_MMA(1, 0, At, B0); G8_MMA(1, 1, At, B1); G8_BAR; }
  { G8_LDB(B0, 1, 0); G8_LDA(At, 1, 0); G8_WAIT_V(2); G8_BAR; G8_WAIT_L(0); G8_MMA(0, 0, At, B0); G8_BAR;
    G8_LDB(B1, 1, 1); G8_WAIT_V(0); G8_BAR; G8_WAIT_L(0); G8_MMA(0, 1, At, B1); G8_BAR;
    G8_LDA(At, 1, 1); G8_BAR; G8_WAIT_L(0); G8_MMA(1, 0, At, B0); G8_MMA(1, 1, At, B1); G8_BAR; }
  if (wr == 0) G8_BAR;
}
__device__ __forceinline__ unsigned piece_off(int i, int ld, int c0) { int R, C; stage_rc((int)otid() * 16 + i * 8192, R, C); return (unsigned)(R * ld + c0 + C) * 2u; }
__device__ __forceinline__ void piece_rc(int i, int& R, int& C) { stage_rc((int)otid() * 16 + i * 8192, R, C); }
struct TileIter {
  int nM, nN, x, j, J, cnt, idx;
  __device__ __forceinline__ void init(int nM_, int nN_) { nM = nM_; nN = nN_; x = obid() & 7; j = obid() >> 3; J = gridDim.x >> 3; cnt = ((nM - x + 7) >> 3) * nN; idx = j; }
  __device__ __forceinline__ bool next(int& pm, int& pn) { if (idx >= cnt) return false; pm = x + 8 * (idx / nN); pn = idx % nN; idx += J; return true; }
};
struct MoeIter {
  int nN, x, jm, jn, j, step, nsteps, nb4; bool with_ctx, ctx_done, wide;
  __device__ __forceinline__ void init(int nN_, bool with_ctx_) { nN = nN_; with_ctx = with_ctx_; wide = nN_ == 8; x = obid() & 7; j = obid() >> 3;
    if (wide) { jm = j & 3; jn = j >> 2; nsteps = 16; } else { jm = j & 7; jn = j >> 3; nsteps = 2 * (nN >> 2) * 4; }
    nb4 = nN >> 2; step = 0; ctx_done = false; }
  __device__ __forceinline__ bool next(int& pm, int& pn, int& e) {
    if (step < nsteps) {
      int m32;
      if (wide) { const int mb = step & 7, el = step >> 3; e = 2 * x + el; m32 = mb * 4 + jm; pn = jn; }
      else { const int mb = step & 3, nb = (step >> 2) % nb4, el = (step >> 2) / nb4; e = 2 * x + el; m32 = mb * 8 + jm; pn = nb * 4 + jn; }
      pm = ((m32 >> 2) * 16 + e) * 4 + (m32 & 3); ++step; return true; }
    if (with_ctx && !ctx_done) { ctx_done = true; if (j < 2 * nN) { e = 2 * x + j / nN; pm = 512 + e; pn = j % nN; return true; } }
    return false;
  }
};
}

#define ACC_FOR3(ai, bj, m) _Pragma("unroll") for (int ai = 0; ai < 2; ++ai) _Pragma("unroll") for (int bj = 0; bj < 2; ++bj) _Pragma("unroll") for (int m = 0; m < 4; ++m)
#define ACC_FOR(ai, bj, m, n) _Pragma("unroll") for (int ai = 0; ai < 2; ++ai) _Pragma("unroll") for (int bj = 0; bj < 2; ++bj) _Pragma("unroll") for (int m = 0; m < 4; ++m) _Pragma("unroll") for (int n = 0; n < 2; ++n)

__device__ __forceinline__ void cvt_tile(const float* __restrict__ src, int N, int K, int k0, int n0, bf16_t* __restrict__ dst, long drow0, const float* __restrict__ kscale, float* lds) {
  const int tid = otid();
  { const int kr = tid >> 6, n = tid & 63;
#pragma unroll
    for (int i = 0; i < 8; ++i) { const int k = kr + 8 * i; float v = (n0 + n < N) ? src[(size_t)(k0 + k) * N + n0 + n] : 0.f; if (kscale) v *= kscale[k0 + k]; lds[k * 65 + n] = v; } }
  __syncthreads();
  { const int n = tid >> 3, k8 = (tid & 7) * 8; float v[8];
#pragma unroll
    for (int i = 0; i < 8; ++i) v[i] = lds[(k8 + i) * 65 + n];
    u32x4 w = {cvtpk(v[0], v[1]), cvtpk(v[2], v[3]), cvtpk(v[4], v[5]), cvtpk(v[6], v[7])};
    *(u32x4*)(dst + (size_t)(drow0 + n) * K + k0 + k8) = w; }
  __syncthreads();
}

__device__ void phase_prep(PRef p, char* smem) {
  float* lds = (float*)smem;
  bf16_t* Wt_in = (bf16_t*)(p.ws + WS_WIN); bf16_t* Wt_uq = (bf16_t*)(p.ws + WS_WUQ); bf16_t* Wt_ukv = (bf16_t*)(p.ws + WS_WUKV); bf16_t* Wt_out = (bf16_t*)(p.ws + WS_WOUT);
  float* mod = (float*)(p.ws + WS_MOD);
  constexpr int T_MOD = 192, T_IN = 2 * 16 * 44, T_UQ = 2 * 6 * 12, T_UKV = 2 * 4 * 16, T_OUT = 2 * 16 * 16, T_ROPE = 64;
  constexpr int E0 = T_MOD, E1 = E0 + T_IN, E2 = E1 + T_UQ, E3 = E2 + T_UKV, E4 = E3 + T_OUT, E5 = E4 + T_ROPE;
  const int tid = otid();
  for (int task = obid(); task < E5; task += gridDim.x) {
    if (task < E0) {
      const int l = task / 96, j0 = (task % 96) * 64;
      float* sc = lds;
      for (int i = tid; i < 9 * 1024; i += 512) { const int bb = i >> 10, d = i & 1023; const float v = bb < 8 ? p.c[bb * 1024 + d] : p.c_ctx[d]; sc[i] = v / (1.f + expf(-v)); }
      __syncthreads();
      const int col = tid & 63, ks = tid >> 6; float a[9];
#pragma unroll
      for (int bb = 0; bb < 9; ++bb) a[bb] = 0.f;
      const float* wm = p.w_mod + (size_t)l * 1024 * 6144 + j0 + col;
      for (int d = ks * 128; d < ks * 128 + 128; ++d) { const float w = wm[(size_t)d * 6144];
#pragma unroll
        for (int bb = 0; bb < 9; ++bb) a[bb] += sc[bb * 1024 + d] * w; }
      float* red = lds + 9 * 1024;
#pragma unroll
      for (int bb = 0; bb < 9; ++bb) red[(ks * 9 + bb) * 64 + col] = a[bb];
      __syncthreads();
      for (int i = tid; i < 9 * 64; i += 512) { const int bb = i >> 6, cc = i & 63; float s = 0.f;
        for (int k = 0; k < 8; ++k) s += red[(k * 9 + bb) * 64 + cc];
        mod[((size_t)l * 9 + bb) * 6144 + j0 + cc] = s + p.b_mod[l * 6144 + j0 + cc]; }
      __syncthreads();
    } else if (task < E1) { const int t = task - E0, l = t / 704, r = t % 704, kt = r / 44, nt = r % 44;
      cvt_tile(p.w_in + (size_t)l * 1024 * IN_COLS, IN_COLS, 1024, kt * 64, nt * 64, Wt_in + (size_t)l * PLD * 1024, nt * 64, nullptr, lds);
    } else if (task < E2) { const int t = task - E1, l = t / 72, r = t % 72, kt = r / 12, nt = r % 12;
      cvt_tile(p.w_uq + (size_t)l * 384 * 768, 768, 384, kt * 64, nt * 64, Wt_uq + (size_t)l * 768 * 384, nt * 64, p.q_norm_w + l * 384, lds);
    } else if (task < E3) { const int t = task - E2, l = t / 64, r = t % 64, kt = r / 16, nt = r % 16;
      cvt_tile(p.w_ukv + (size_t)l * 256 * 1024, 1024, 256, kt * 64, nt * 64, Wt_ukv + (size_t)l * 1024 * 256, nt * 64, p.kv_norm_w + l * 256, lds);
    } else if (task < E4) { const int t = task - E3, l = t / 256, r = t % 256, kt = r / 16, nt = r % 16;
      cvt_tile(p.w_out + (size_t)l * 1024 * 1024, 1024, 1024, kt * 64, nt * 64, Wt_out + (size_t)l * 1024 * 1024, nt * 64, nullptr, lds);
    } else {
      float* cs = (float*)(p.ws + WS_COS); float* sn = (float*)(p.ws + WS_SIN);
      for (int i = (task - E4) * 4096 + tid; i < (task - E4 + 1) * 4096; i += 512) { const int t = i >> 5, j = i & 31;
        const float inv = exp2f(-(float)(j & 15) * (13.287712379549449f / 16.f));
        const float pos = (float)(j < 16 ? (t >> 6) : (t & 63)); const float ang = pos * inv;
        const double a = (double)ang; const double k = rint(a * 0.15915494309189535); const float r = (float)(a - k * 6.283185307179586);
        cs[i] = __cosf(r); sn[i] = __sinf(r); }
    }
  }
}

__device__ void phase_cvt_experts(PRef p, int l, char* smem) {
  float* lds = (float*)smem;
  bf16_t* Wgu = (bf16_t*)(p.ws + WS_WGU); bf16_t* Wdn = (bf16_t*)(p.ws + WS_WDN);
  const int tid = otid();
  for (int task = obid(); task < NE * 192; task += gridDim.x) {
    const int e = task / 192, r = task % 192, which = r >> 6, kt = (r & 63) >> 2, nt = r & 3, k0 = kt * 64, n0 = nt * 256;
    const float* src = (which == 0 ? p.w_gate : which == 1 ? p.w_up : p.w_down) + ((size_t)l * NE + e) * 1024 * 1024;
    { const int kr = tid >> 6, n4 = (tid & 63) * 4;
#pragma unroll
      for (int i = 0; i < 8; ++i) { const int k = kr + 8 * i; *(f32x4*)(lds + k * 260 + n4) = *(const f32x4*)(src + (size_t)(k0 + k) * 1024 + n0 + n4); } }
    __syncthreads();
    { const int nl = tid & 255, k32 = (tid >> 8) * 32, n = n0 + nl;
      const size_t drow = which == 2 ? (size_t)n : (size_t)((n >> 7) * 256 + which * 128 + (n & 127));
      bf16_t* dst = (which == 2 ? Wdn + (size_t)e * 1024 * 1024 : Wgu + (size_t)e * 2048 * 1024) + drow * 1024 + k0 + k32;
#pragma unroll
      for (int q = 0; q < 4; ++q) { float v[8];
#pragma unroll
        for (int i = 0; i < 8; ++i) v[i] = lds[(k32 + q * 8 + i) * 260 + nl];
        u32x4 w = {cvtpk(v[0], v[1]), cvtpk(v[2], v[3]), cvtpk(v[4], v[5]), cvtpk(v[6], v[7])};
        *(u32x4*)(dst + q * 8) = w; } }
    __syncthreads();
  }
}

__device__ __forceinline__ void ln_row(f32x4 (&v)[4], float eps) {
  float s = 0.f;
#pragma unroll
  for (int i = 0; i < 4; ++i) s += v[i][0] + v[i][1] + v[i][2] + v[i][3];
  const float mu = wave_sum(s) * (1.f / 1024.f);
  float q = 0.f;
#pragma unroll
  for (int i = 0; i < 4; ++i)
#pragma unroll
    for (int k = 0; k < 4; ++k) { v[i][k] -= mu; q += v[i][k] * v[i][k]; }
  const float rs = rsqrtf(wave_sum(q) * (1.f / 1024.f) + eps);
#pragma unroll
  for (int i = 0; i < 4; ++i) v[i] *= rs;
}
__device__ __forceinline__ void store_mod_bf16(const f32x4 (&v)[4], const float* __restrict__ shift, const float* __restrict__ scale, bf16_t* __restrict__ hrow, int lane, f32x4 (*keep)[4]) {
#pragma unroll
  for (int i = 0; i < 4; ++i) { const int c = lane * 4 + 256 * i; const f32x4 sh = *(const f32x4*)(shift + c), sc = *(const f32x4*)(scale + c);
    f32x4 o = v[i] * (sc + 1.f) + sh; if (keep) (*keep)[i] = o;
    u32x2 w = {cvtpk(o[0], o[1]), cvtpk(o[2], o[3])}; *(u32x2*)(hrow + c) = w; }
}
__device__ __forceinline__ const float* mod_ptr(PRef p, int l, int row, int which) {
  const int bb = row < MX ? (row >> 13) : 8;
  return (const float*)(p.ws + WS_MOD) + ((size_t)l * 9 + bb) * 6144 + which * 1024;
}

__device__ void phase_h0(PRef p) {
  const int lane = otid() & 63, gw = obid() * 8 + (otid() >> 6), nw = gridDim.x * 8;
  bf16_t* h = (bf16_t*)(p.ws + WS_H);
  for (int row = gw; row < MT; row += nw) {
    const float* src = row < MX ? p.x + (size_t)row * 1024 : p.ctx + (size_t)(row - MX) * 1024;
    f32x4 v[4];
#pragma unroll
    for (int i = 0; i < 4; ++i) v[i] = *(const f32x4*)(src + lane * 4 + 256 * i);
    ln_row(v, 1e-6f);
    store_mod_bf16(v, mod_ptr(p, 0, row, 0), mod_ptr(p, 0, row, 1), h + (size_t)row * 1024, lane, nullptr);
  }
}

__device__ void phase_inproj(PRef p, int l, char* smem) {
  LAS unsigned char* lds = (LAS unsigned char*)smem;
  const bf16_t* h = (const bf16_t*)(p.ws + WS_H); const bf16_t* Wt = (const bf16_t*)(p.ws + WS_WIN) + (size_t)l * PLD * 1024;
  bf16_t* P = (bf16_t*)(p.ws + WS_P); float* gates = (float*)(p.ws + WS_GATES);
  const int tid = otid(), wid = tid >> 6, lane = tid & 63, wr = wid >> 2, wc = wid & 3, fr = lane & 15, fq = lane >> 4;
  g8::TileIter it; it.init(MT / 256, PLD / 256);
  int pm, pn;
  while (it.next(pm, pn)) {
    unsigned voffA[2] = {g8::piece_off(0, 1024, 0), g8::piece_off(1, 1024, 0)};
    f32x4 acc[2][2][4][2];
    g8::gemm_tile<false>(lds, (const char*)(h + (size_t)pm * 256 * 1024), voffA, (size_t)128 * 1024 * 2, (const char*)(Wt + (size_t)pn * 256 * 1024), 1024, acc);
    ACC_FOR3(ai, bj, m) {
      const int row = pm * 256 + ai * 128 + wr * 64 + m * 16 + fr, col = pn * 256 + bj * 128 + wc * 32 + fq * 8;
      const f32x4 v0 = acc[ai][bj][m][0], v1 = acc[ai][bj][m][1];
      u32x4 w = {cvtpk(v0[0], v0[1]), cvtpk(v0[2], v0[3]), cvtpk(v1[0], v1[1]), cvtpk(v1[2], v1[3])}; *(u32x4*)(P + (size_t)row * PLD + col) = w;
      if (col >= OFF_G && col < OFF_G + 16) { const f32x4 bg0 = *(const f32x4*)(p.b_gates + l * 16 + (col - OFF_G)), bg1 = *(const f32x4*)(p.b_gates + l * 16 + (col - OFF_G) + 4);
        *(f32x4*)(gates + (size_t)row * 16 + (col - OFF_G)) = v0 + bg0; *(f32x4*)(gates + (size_t)row * 16 + (col - OFF_G) + 4) = v1 + bg1; }
    }
  }
}


constexpr size_t WS_QKC = WS_KV;
constexpr size_t WS_SCAL = WS_Q;
__device__ void phase_mlstm_pre(PRef p, int l, char* smem) {
  const bf16_t* P = (const bf16_t*)(p.ws + WS_P); const float* gates = (const float*)(p.ws + WS_GATES);
  bf16_t* QKC = (bf16_t*)(p.ws + WS_QKC); float* SCAL = (float*)(p.ws + WS_SCAL);
  const int tid = otid(), wid = tid >> 6, lane = tid & 63;
  if (obid() < 64) {
    const int chain = obid(), dir = chain & 1, hd = (chain >> 1) & 3, b = chain >> 3;
    float* LA = (float*)smem; float* LB = LA + 132 * 64; float* LP = LB + 132 * 64; float* b63s = LP + 132 * 64; float* pm63s = b63s + 132; float* mbs = pm63s + 132;
    for (int ci = wid; ci < 132; ci += 8) {
      const bool ic = ci < 4; const int cc = ic ? ci : ci - 4, T = ic ? CTXL : SEQ, rb = ic ? MX + b * CTXL : b * SEQ, tlo = dir ? T - 64 - cc * 64 : cc * 64;
      const int t = dir ? tlo + 63 - lane : tlo + lane; const float* g = gates + (size_t)(rb + t) * 16;
      const float ig = g[dir * 8 + hd], fg = g[dir * 8 + 4 + hd];
      const float lf = fminf(fg, 0.f) - log1pf(expf(-fabsf(fg)));
      float bc = lf;
#pragma unroll
      for (int o = 1; o < 64; o <<= 1) { const float u = __shfl_up(bc, o); if (lane >= o) bc += u; }
      const float a = ig - bc; float pmx = a;
#pragma unroll
      for (int o = 1; o < 64; o <<= 1) { const float u = __shfl_up(pmx, o); if (lane >= o) pmx = fmaxf(pmx, u); }
      LA[ci * 64 + lane] = a; LB[ci * 64 + lane] = bc; LP[ci * 64 + lane] = pmx;
      if (lane == 63) { b63s[ci] = bc; pm63s[ci] = pmx; }
    }
    __syncthreads();
    if (tid == 0) { float m = 0.f; for (int ci = 0; ci < 132; ++ci) { mbs[ci] = m; m = b63s[ci] + fmaxf(pm63s[ci], m); } }
    __syncthreads();
    for (int ci = wid; ci < 132; ci += 8) {
      const float m = mbs[ci], a = LA[ci * 64 + lane], bc = LB[ci * 64 + lane], pmx = LP[ci * 64 + lane];
      const float Mx = fmaxf(pmx, m), M63 = fmaxf(pm63s[ci], m);
      float* S = SCAL + ((size_t)chain * 132 + ci) * 384;
      S[lane] = a; S[64 + lane] = Mx; S[128 + lane] = __expf(m - Mx); S[192 + lane] = __expf(-(bc + Mx)); S[256 + lane] = __expf(a - M63);
      S[320 + lane] = lane == 0 ? __expf(m - M63) : 0.f;
    }
    return;
  }
  const int col8 = (tid & 127) * 8, rg = tid >> 7;
  float w[5][8], bia[8];
#pragma unroll
  for (int j = 0; j < 5; ++j) { const f32x4 w0 = *(const f32x4*)(p.conv_w + ((size_t)l * 5 + j) * 1024 + col8), w1 = *(const f32x4*)(p.conv_w + ((size_t)l * 5 + j) * 1024 + col8 + 4);
#pragma unroll
    for (int k = 0; k < 4; ++k) { w[j][k] = w0[k]; w[j][4 + k] = w1[k]; } }
  { const f32x4 b0 = *(const f32x4*)(p.conv_b + l * 1024 + col8), b1 = *(const f32x4*)(p.conv_b + l * 1024 + col8 + 4);
#pragma unroll
    for (int k = 0; k < 4; ++k) { bia[k] = b0[k]; bia[4 + k] = b1[k]; } }
  const float osc = col8 < 512 ? 0.08838834764831845f : 1.f;
#pragma unroll 1
  for (int rb = obid() - 64; rb < MT / 64; rb += gridDim.x - 64) {
    const int R0 = rb * 64, seg_lo = R0 < MX ? (R0 & ~8191) : MX + ((R0 - MX) & ~255), seg_hi = seg_lo + (R0 < MX ? SEQ : CTXL);
    const int r0 = R0 + rg * 16;
    u32x4 raw[20];
#pragma unroll
    for (int i = 0; i < 20; ++i) { const int r = r0 - 2 + i; raw[i] = (u32x4){0u, 0u, 0u, 0u}; if (r >= seg_lo && r < seg_hi) raw[i] = *(const u32x4*)(P + (size_t)r * PLD + col8); }
#pragma unroll
    for (int i = 0; i < 16; ++i) {
      float y[8];
#pragma unroll
      for (int k = 0; k < 8; ++k) y[k] = bia[k];
#pragma unroll
      for (int tp = 0; tp < 5; ++tp) {
#pragma unroll
        for (int k = 0; k < 4; ++k) { y[2 * k] += w[tp][2 * k] * bflo(raw[i + tp][k]); y[2 * k + 1] += w[tp][2 * k + 1] * bfhi(raw[i + tp][k]); } }
#pragma unroll
      for (int k = 0; k < 8; ++k) y[k] = silu_f(y[k]) * osc;
      u32x4 o = {cvtpk(y[0], y[1]), cvtpk(y[2], y[3]), cvtpk(y[4], y[5]), cvtpk(y[6], y[7])};
      *(u32x4*)(QKC + (size_t)(r0 + i) * 1024 + col8) = o;
    }
  }
}

__device__ void phase_mlstm(PRef p, int l, char* smem) {
  bf16_t* QBb[2] = {(bf16_t*)(smem), (bf16_t*)(smem + 17408)};
  bf16_t* KB = (bf16_t*)(smem + 34816);
  bf16_t* KT = (bf16_t*)(smem + 52224);
  bf16_t* VTb[2] = {(bf16_t*)(smem + 70656), (bf16_t*)(smem + 77568)};
  bf16_t* VWT = (bf16_t*)(smem + 84480);
  bf16_t* PB = (bf16_t*)(smem + 91392);
  bf16_t* CTb[2] = {(bf16_t*)(smem + 100608), (bf16_t*)(smem + 113664)};
  float* SC = (float*)(smem + 126720);
  const bf16_t* P = (const bf16_t*)(p.ws + WS_P); const bf16_t* QKC = (const bf16_t*)(p.ws + WS_QKC); const float* SCAL = (const float*)(p.ws + WS_SCAL);
  bf16_t* hbuf = (bf16_t*)(p.ws + WS_HB);
  for (int w = obid(); w < 256; w += gridDim.x) {
    const int slice = (w >> 3) & 3, chain = (w & 7) * 8 + (w >> 5), dir = chain & 1, hd = (chain >> 1) & 3, b = chain >> 3;
    const float* SCc = SCAL + (size_t)chain * 132 * 384;
    __syncthreads();
    { const int tid = otid();
      for (int i = tid; i < 48 * 136 / 2; i += 512) { ((unsigned*)CTb[0])[i] = 0u; ((unsigned*)CTb[1])[i] = 0u; }
      for (int i = tid; i < 48 * 72 / 2; i += 512) { ((unsigned*)VTb[0])[i] = 0u; ((unsigned*)VTb[1])[i] = 0u; ((unsigned*)VWT)[i] = 0u; } }
    f32x4 accC[3];
#pragma unroll
    for (int i = 0; i < 3; ++i) accC[i] = (f32x4){0.f, 0.f, 0.f, 0.f};
    struct Pre { u32x4 qk[4]; u32x2 v; f32x4 s; float ws, ws1; };
    Pre preA, preB;
    preA.s = (f32x4){0.f, 0.f, 0.f, 0.f}; preB.s = preA.s;
#define MLSTM_PREFETCH(PR, CI) do { const int tid_ = otid(); const int ci_ = (CI); const bool ic_ = ci_ < 4; const int cc_ = ic_ ? ci_ : ci_ - 4, T_ = ic_ ? CTXL : SEQ, rb_ = ic_ ? MX + b * CTXL : b * SEQ; \
      const int tlo_ = dir ? T_ - 64 - cc_ * 64 : cc_ * 64; \
      _Pragma("unroll") for (int k_ = 0; k_ < 4; ++k_) { const int pc = tid_ + k_ * 512, tens = pc >> 10, rem = pc & 1023, lr = rem & 63, c16 = rem >> 6, t = dir ? tlo_ + 63 - lr : tlo_ + lr; \
        PR.qk[k_] = *(const u32x4*)(QKC + (size_t)(rb_ + t) * 1024 + tens * 512 + hd * 128 + c16 * 8); } \
      { const int vl_ = tid_ & 63, vt_ = dir ? tlo_ + 63 - vl_ : tlo_ + vl_; PR.v = *(const u32x2*)(P + (size_t)(rb_ + vt_) * PLD + OFF_V + hd * 128 + slice * 32 + (tid_ >> 6) * 4); \
        PR.ws = SCc[(size_t)ci_ * 384 + 256 + vl_]; PR.ws1 = SCc[(size_t)ci_ * 384 + 256 + (tid_ & 63)]; } \
      if (tid_ < 96) PR.s = *(const f32x4*)(SCc + (size_t)ci_ * 384 + tid_ * 4); } while (0)
    MLSTM_PREFETCH(preA, 0);
    MLSTM_PREFETCH(preB, 1);
    __syncthreads();
    auto step = [&](const int ci, Pre& pre) __attribute__((always_inline)) {
      const int tid = otid(), wid = tid >> 6, lane = tid & 63, fr = lane & 15, fq = lane >> 4;
      const bool isctx = ci < 4; const int cc = isctx ? ci : ci - 4, T = isctx ? CTXL : SEQ, rowbase = isctx ? MX + b * CTXL : b * SEQ;
      const int tlo = dir ? T - 64 - cc * 64 : cc * 64;
      const int par = ci & 1;
      bf16_t* QB = QBb[par]; bf16_t* VT = VTb[par]; float* S = SC + par * 384; bf16_t* CTc = CTb[par]; bf16_t* CTn = CTb[par ^ 1];
      const bool need_out = !(l == DEPTH - 1 && isctx);
#pragma unroll
      for (int k = 0; k < 4; ++k) { const int pc = tid + k * 512, tens = pc >> 10, rem = pc & 1023, lr = rem & 63, c16 = rem >> 6;
        if (tens == 0) *(u32x4*)(QB + lr * 136 + c16 * 8) = pre.qk[k];
        else { *(u32x4*)(KB + lr * 136 + c16 * 8) = pre.qk[k];
#pragma unroll
          for (int i = 0; i < 4; ++i) { KT[(c16 * 8 + 2 * i) * 72 + lr] = (bf16_t)(pre.qk[k][i] & 0xffffu); KT[(c16 * 8 + 2 * i + 1) * 72 + lr] = (bf16_t)(pre.qk[k][i] >> 16); } } }
      { const int vl = tid & 63, ve4 = (tid >> 6) * 4; const float wsl = pre.ws;
        VT[(ve4 + 0) * 72 + vl] = (bf16_t)(pre.v[0] & 0xffffu); VT[(ve4 + 1) * 72 + vl] = (bf16_t)(pre.v[0] >> 16);
        VT[(ve4 + 2) * 72 + vl] = (bf16_t)(pre.v[1] & 0xffffu); VT[(ve4 + 3) * 72 + vl] = (bf16_t)(pre.v[1] >> 16);
        VWT[(ve4 + 0) * 72 + vl] = f2bf(bflo(pre.v[0]) * wsl); VWT[(ve4 + 1) * 72 + vl] = f2bf(bfhi(pre.v[0]) * wsl);
        VWT[(ve4 + 2) * 72 + vl] = f2bf(bflo(pre.v[1]) * wsl); VWT[(ve4 + 3) * 72 + vl] = f2bf(bfhi(pre.v[1]) * wsl);
        if (tid < 64) { VT[32 * 72 + tid] = (bf16_t)0x3F80u; VWT[32 * 72 + tid] = f2bf(pre.ws1); }
        if (tid < 96) *(f32x4*)(S + tid * 4) = pre.s; }
      if (ci + 2 < 132) MLSTM_PREFETCH(pre, ci + 2);
      __syncthreads();
      if (need_out) {
        const int mt = wid >> 1;
#pragma unroll
        for (int u = 0; u < 2; ++u) {
          const int ntl = (wid & 1) * 2 + u;
          f32x4 sacc = {0.f, 0.f, 0.f, 0.f};
          if (ntl <= mt) {
#pragma unroll
            for (int kk = 0; kk < 4; ++kk) {
              const bf16x8 a = *(const bf16x8*)(QB + (mt * 16 + fr) * 136 + kk * 32 + fq * 8), bb = *(const bf16x8*)(KB + (ntl * 16 + fr) * 136 + kk * 32 + fq * 8);
              sacc = __builtin_amdgcn_mfma_f32_16x16x32_bf16(a, bb, sacc, 0, 0, 0); }
          }
          const int j = ntl * 16 + fr; const float aj = S[j];
#pragma unroll
          for (int jj = 0; jj < 4; ++jj) { const int lr = mt * 16 + fq * 4 + jj;
            const float pv = (j <= lr) ? sacc[jj] * __expf(fminf(aj - S[64 + lr], 0.f)) : 0.f;
            PB[lr * 72 + j] = f2bf(pv); }
        }
      }
      {
        const float decay = S[320];
#pragma unroll
        for (int mt = 0; mt < 3; ++mt) {
          accC[mt] *= decay;
#pragma unroll
          for (int kk = 0; kk < 2; ++kk) { const bf16x8 a = *(const bf16x8*)(VWT + (mt * 16 + fr) * 72 + kk * 32 + fq * 8), bb = *(const bf16x8*)(KT + (wid * 16 + fr) * 72 + kk * 32 + fq * 8);
            accC[mt] = __builtin_amdgcn_mfma_f32_16x16x32_bf16(a, bb, accC[mt], 0, 0, 0); }
#pragma unroll
          for (int jj = 0; jj < 4; ++jj) CTn[(mt * 16 + fq * 4 + jj) * 136 + wid * 16 + fr] = f2bf(accC[mt][jj]);
        }
      }
      __syncthreads();
      if (need_out && wid < 4) {
        const int mt = wid; f32x4 num[3];
#pragma unroll
        for (int ntl = 0; ntl < 3; ++ntl) {
          f32x4 a1 = {0.f, 0.f, 0.f, 0.f}, a2 = {0.f, 0.f, 0.f, 0.f};
#pragma unroll
          for (int kk = 0; kk < 2; ++kk) { const bf16x8 a = *(const bf16x8*)(PB + (mt * 16 + fr) * 72 + kk * 32 + fq * 8), bb = *(const bf16x8*)(VT + (ntl * 16 + fr) * 72 + kk * 32 + fq * 8);
            a1 = __builtin_amdgcn_mfma_f32_16x16x32_bf16(a, bb, a1, 0, 0, 0); }
#pragma unroll
          for (int kk = 0; kk < 4; ++kk) { const bf16x8 a = *(const bf16x8*)(QB + (mt * 16 + fr) * 136 + kk * 32 + fq * 8), bb = *(const bf16x8*)(CTc + (ntl * 16 + fr) * 136 + kk * 32 + fq * 8);
            a2 = __builtin_amdgcn_mfma_f32_16x16x32_bf16(a, bb, a2, 0, 0, 0); }
#pragma unroll
          for (int jj = 0; jj < 4; ++jj) num[ntl][jj] = a1[jj] + S[128 + mt * 16 + fq * 4 + jj] * a2[jj];
        }
#pragma unroll
        for (int jj = 0; jj < 4; ++jj) {
          const int lr = mt * 16 + fq * 4 + jj; const float den = __shfl(num[2][jj], lane & 48);
          const float rd = __builtin_amdgcn_rcpf(fmaxf(fabsf(den), S[192 + lr]));
          const int t = dir ? tlo + 63 - lr : tlo + lr;
          bf16_t* hp = hbuf + ((size_t)((dir * 4 + hd) * 4 + slice) * MT + rowbase + t) * 32 + fr;
          hp[0] = f2bf(num[0][jj] * rd); hp[16] = f2bf(num[1][jj] * rd);
        }
      }
    };
#pragma unroll 1
    for (int ci = 0; ci < 132; ci += 2) { step(ci, preA); step(ci + 1, preB); }
    __syncthreads();
  }
#undef MLSTM_PREFETCH
}

template <int WHICH>
__device__ __forceinline__ void mla_gemm(PRef p, int l, char* smem) {
  LAS unsigned char* lds = (LAS unsigned char*)smem; float* rsb = (float*)(smem + g8::STAGE_BYTES);
  const bf16_t* P = (const bf16_t*)(p.ws + WS_P);
  const int tid = otid(), wid = tid >> 6, lane = tid & 63, wr = wid >> 2, wc = wid & 3, fr = lane & 15, fq = lane >> 4;
  constexpr int K = WHICH ? 256 : 384, OFFC = WHICH ? OFF_CKV : OFF_CQ, N = WHICH ? 1024 : 768;
  const bf16_t* Wt = WHICH ? (const bf16_t*)(p.ws + WS_WUKV) + (size_t)l * 1024 * 256 : (const bf16_t*)(p.ws + WS_WUQ) + (size_t)l * 768 * 384;
  bf16_t* O = (bf16_t*)(p.ws + (WHICH ? WS_KV : WS_Q));
  g8::TileIter it; it.init((WHICH || l == 0) ? MT / 256 : MX / 256, N / 256);
  int pm, pn;
  while (it.next(pm, pn)) {
    __syncthreads();
    { const int r = tid >> 1, hf = tid & 1; const bf16_t* src = P + (size_t)(pm * 256 + r) * PLD + OFFC + hf * (K / 2); float s = 0.f;
#pragma unroll 4
      for (int i = 0; i < K / 16; ++i) { const u32x4 v = *(const u32x4*)(src + i * 8);
#pragma unroll
        for (int k = 0; k < 4; ++k) { const float a = bflo(v[k]), bq = bfhi(v[k]); s += a * a + bq * bq; } }
      s += __shfl_xor(s, 1);
      if (hf == 0) rsb[r] = rsqrtf(s / (float)K + 1e-6f); }
    unsigned voffA[2] = {g8::piece_off(0, PLD, OFFC), g8::piece_off(1, PLD, OFFC)};
    f32x4 acc[2][2][4][2];
    g8::gemm_tile<false>(lds, (const char*)(P + (size_t)pm * 256 * PLD), voffA, (size_t)128 * PLD * 2, (const char*)(Wt + (size_t)pn * 256 * K), opaque_s(K), acc);
    ACC_FOR3(ai, bj, m) {
      const int rl = ai * 128 + wr * 64 + m * 16 + fr, row = pm * 256 + rl, col = pn * 256 + bj * 128 + wc * 32 + fq * 8;
      const float rs = rsb[rl]; const f32x4 v0 = acc[ai][bj][m][0] * rs, v1 = acc[ai][bj][m][1] * rs;
      size_t orow = row;
      if (WHICH) orow = row < MX ? (size_t)(row >> 13) * SKV + CTXL + (row & 8191) : (size_t)((row - MX) >> 8) * SKV + ((row - MX) & 255);
      u32x4 w = {cvtpk(v0[0], v0[1]), cvtpk(v0[2], v0[3]), cvtpk(v1[0], v1[1]), cvtpk(v1[2], v1[3])}; *(u32x4*)(O + orow * N + col) = w;
    }
  }
}
__device__ void phase_mla_prep(PRef p, int l, char* smem) {
  mla_gemm<0>(p, l, smem);
  mla_gemm<1>(p, l, smem);
  const bf16_t* P = (const bf16_t*)(p.ws + WS_P);
  const int tid = otid(), wid = tid >> 6, lane = tid & 63;
  const bf16_t* hbuf = (const bf16_t*)(p.ws + WS_HB); bf16_t* mix = (bf16_t*)(p.ws + WS_MIX); bf16_t* KR = (bf16_t*)(p.ws + WS_KR);
  const float* cs = (const float*)(p.ws + WS_COS); const float* sn = (const float*)(p.ws + WS_SIN);
  const int gw = obid() * 8 + wid, nw = gridDim.x * 8;
  for (int row = gw; row < MT; row += nw) {
    if (row < MX || l == 0) {
      const size_t ho = ((size_t)(lane >> 2) * MT + row) * 32 + (lane & 3) * 8;
      const u32x4 hf = *(const u32x4*)(hbuf + ho), hb = *(const u32x4*)(hbuf + (size_t)16 * MT * 32 + ho);
      const u32x4 ov = *(const u32x4*)(P + (size_t)row * PLD + OFF_O + lane * 8);
      float v[8]; float s = 0.f;
#pragma unroll
      for (int k = 0; k < 4; ++k) { v[2 * k] = bflo(hf[k]) + bflo(hb[k]); v[2 * k + 1] = bfhi(hf[k]) + bfhi(hb[k]); s += v[2 * k] + v[2 * k + 1]; }
      s += __shfl_xor(s, 1); s += __shfl_xor(s, 2); s += __shfl_xor(s, 4); s += __shfl_xor(s, 8);
      const float mu = s * (1.f / 128.f); float q = 0.f;
#pragma unroll
      for (int k = 0; k < 8; ++k) { v[k] -= mu; q += v[k] * v[k]; }
      q += __shfl_xor(q, 1); q += __shfl_xor(q, 2); q += __shfl_xor(q, 4); q += __shfl_xor(q, 8);
      const float rs = rsqrtf(q * (1.f / 128.f) + 1e-6f);
      const float* nw_ = p.m_norm_w + l * 512 + lane * 8; float o[8];
#pragma unroll
      for (int k = 0; k < 4; ++k) { o[2 * k] = v[2 * k] * rs * nw_[2 * k] * sigmoid_f(bflo(ov[k])); o[2 * k + 1] = v[2 * k + 1] * rs * nw_[2 * k + 1] * sigmoid_f(bfhi(ov[k])); }
      u32x4 wv = {cvtpk(o[0], o[1]), cvtpk(o[2], o[3]), cvtpk(o[4], o[5]), cvtpk(o[6], o[7])};
      *(u32x4*)(mix + (size_t)row * 1024 + lane * 8) = wv;
    }
    {
      const int j = lane & 31;
      const float x1 = bf2f(P[(size_t)row * PLD + OFF_KR + j]), x2 = bf2f(P[(size_t)row * PLD + OFF_KR + 32 + j]);
      float o1 = x1, o2 = x2; size_t orow;
      if (row < MX) { const int t = row & 8191; const float c = cs[t * 32 + j], s_ = sn[t * 32 + j]; o1 = x1 * c - x2 * s_; o2 = x2 * c + x1 * s_; orow = (size_t)(row >> 13) * SKV + CTXL + t; }
      else orow = (size_t)((row - MX) >> 8) * SKV + ((row - MX) & 255);
      if (lane < 32) { KR[orow * 64 + j] = f2bf(o1); KR[orow * 64 + 32 + j] = f2bf(o2); }
    }
  }
}

namespace att {
constexpr int NW = 8, QBLK = 32, KVBLK = 64, LDQ = 768, LDK = 1024, LDKR = 64, LDO = 1024;
constexpr float SCALE = A_SCALE;
constexpr float THR = 8.f;
constexpr size_t SHM_V = KVBLK * 128 * 2, SHM_K = KVBLK * 128 * 2, SHM_R = KVBLK * 64 * 2;
typedef float f32x8 __attribute__((ext_vector_type(8)));
#define KSWZ(row, colB) ((row) * 256 + ((colB) ^ (((row) & 15) << 4)))
#define RSWZ(row, colB) ((row) * 128 + ((colB) ^ ((((row) >> 1) & 7) << 4)))
#define SBAR() __builtin_amdgcn_sched_barrier(0)
__device__ __forceinline__ int crow(int r, int hi) { return (r & 3) + 8 * (r >> 2) + 4 * hi; }
__device__ __forceinline__ void partialSM(f32x16& p0, f32x16& p1, float& m_reg, float& mn, float& alpha) {
  constexpr float C = SCALE * 1.4426950408889634f;
  float pmax = p0[0];
#pragma unroll
  for (int r = 1; r < 16; ++r) pmax = fmaxf(pmax, p0[r]);
#pragma unroll
  for (int r = 0; r < 16; ++r) pmax = fmaxf(pmax, p1[r]);
  { auto rr = __builtin_amdgcn_permlane32_swap(__float_as_uint(pmax), __float_as_uint(pmax), false, false);
    pmax = fmaxf(__uint_as_float(rr[0]), __uint_as_float(rr[1])); }
  if (__builtin_expect(__all(pmax - m_reg <= THR / SCALE), 1)) { mn = m_reg; alpha = 1.f; }
  else { mn = fmaxf(m_reg, pmax); alpha = __builtin_amdgcn_exp2f((m_reg - mn) * C); m_reg = mn; }
  const float mnC = -mn * C;
#pragma unroll
  for (int r = 0; r < 16; ++r) p0[r] = fmaf(p0[r], C, mnC);
#pragma unroll
  for (int r = 0; r < 16; ++r) p1[r] = fmaf(p1[r], C, mnC);
#pragma unroll
  for (int r = 0; r < 16; ++r) p0[r] = __builtin_amdgcn_exp2f(p0[r]);
}
__device__ __forceinline__ void finishSM(f32x16& p0, f32x16& p1, float alpha, float& l_reg, bf16x8& pa0, bf16x8& pa1, bf16x8& pa2, bf16x8& pa3) {
#pragma unroll
  for (int r = 0; r < 16; ++r) p1[r] = __builtin_amdgcn_exp2f(p1[r]);
  float ps = 0;
#pragma unroll
  for (int r = 0; r < 16; ++r) ps += p0[r];
#pragma unroll
  for (int r = 0; r < 16; ++r) ps += p1[r];
  { auto rr = __builtin_amdgcn_permlane32_swap(__float_as_uint(ps), __float_as_uint(ps), false, false);
    ps = __uint_as_float(rr[0]) + __uint_as_float(rr[1]); }
  l_reg = l_reg * alpha + ps;
#define PK4(P, BASE, OUT) do { unsigned a0 = cvtpk(P[BASE + 0], P[BASE + 1]), a1 = cvtpk(P[BASE + 2], P[BASE + 3]);   \
    unsigned b0 = cvtpk(P[BASE + 4], P[BASE + 5]), b1 = cvtpk(P[BASE + 6], P[BASE + 7]);                              \
    auto r0 = __builtin_amdgcn_permlane32_swap(a0, b0, false, false); auto r1 = __builtin_amdgcn_permlane32_swap(a1, b1, false, false); \
    u32x4 w = {r0[0], r1[0], r0[1], r1[1]}; OUT = *reinterpret_cast<bf16x8*>(&w); } while (0)
  PK4(p0, 0, pa0); PK4(p0, 8, pa1); PK4(p1, 0, pa2); PK4(p1, 8, pa3);
#undef PK4
}
__device__ __forceinline__ void qkt(f32x16& p0, f32x16& p1, const char* Ks, const char* Rs, const bf16x8* qr, const char* qrl, int r32, int hi) {
  p0 = f32x16{}; p1 = f32x16{};
#pragma unroll
  for (int d0 = 0; d0 < 8; ++d0) { const int cb = (d0 * 16 + hi * 8) * 2;
    const bf16x8 b0 = *reinterpret_cast<const bf16x8*>(Ks + KSWZ(r32, cb));
    const bf16x8 b1 = *reinterpret_cast<const bf16x8*>(Ks + KSWZ(32 + r32, cb));
    p0 = __builtin_amdgcn_mfma_f32_32x32x16_bf16(b0, qr[d0], p0, 0, 0, 0);
    p1 = __builtin_amdgcn_mfma_f32_32x32x16_bf16(b1, qr[d0], p1, 0, 0, 0); }
#pragma unroll
  for (int d0 = 0; d0 < 4; ++d0) { const int cb = (d0 * 16 + hi * 8) * 2;
    const bf16x8 b0 = *reinterpret_cast<const bf16x8*>(Rs + RSWZ(r32, cb));
    const bf16x8 b1 = *reinterpret_cast<const bf16x8*>(Rs + RSWZ(32 + r32, cb));
    p0 = __builtin_amdgcn_mfma_f32_32x32x16_bf16(b0, qr[8 + d0], p0, 0, 0, 0);
    p1 = __builtin_amdgcn_mfma_f32_32x32x16_bf16(b1, qr[8 + d0], p1, 0, 0, 0); }
}
__device__ __forceinline__ int v_st(int k, int c) { const int kk = (k & ~0xC) | ((k & 4) << 1) | ((k & 8) >> 1); return ((kk >> 3) * 4 + (c >> 5)) * 512 + ((kk & 7) * 32 + (c & 31)) * 2; }
__device__ __forceinline__ int v_rd_base(int lane) { return ((lane & 3) << 3) | (((lane >> 2) & 3) << 6) | (((lane >> 4) & 1) << 5) | (((lane >> 5) & 1) << 8); }
constexpr int v_rd_off(int d0, int ks, int half) { return d0 * 512 + ks * 4096 + half * 2048; }
template <int OFF> __device__ __forceinline__ s16x4 tr_read(int vb) {
  s16x4 r; asm volatile("ds_read_b64_tr_b16 %0, %1 offset:%2" : "=&v"(r) : "v"(vb), "i"(OFF) : "memory"); return r;
}
template <int D0> __device__ __forceinline__ void pv_one(f32x16& od, int vb, bf16x8 pa0, bf16x8 pa1, bf16x8 pa2, bf16x8 pa3) {
  const s16x4 l0 = tr_read<v_rd_off(D0, 0, 0)>(vb), h0 = tr_read<v_rd_off(D0, 0, 1)>(vb), l1 = tr_read<v_rd_off(D0, 1, 0)>(vb), h1 = tr_read<v_rd_off(D0, 1, 1)>(vb);
  const s16x4 l2 = tr_read<v_rd_off(D0, 2, 0)>(vb), h2 = tr_read<v_rd_off(D0, 2, 1)>(vb), l3 = tr_read<v_rd_off(D0, 3, 0)>(vb), h3 = tr_read<v_rd_off(D0, 3, 1)>(vb);
  asm volatile("s_waitcnt lgkmcnt(0)" ::: "memory"); SBAR();
#define PK(L, H) (bf16x8){L[0], L[1], L[2], L[3], H[0], H[1], H[2], H[3]}
  od = __builtin_amdgcn_mfma_f32_32x32x16_bf16(pa0, PK(l0, h0), od, 0, 0, 0);
  od = __builtin_amdgcn_mfma_f32_32x32x16_bf16(pa1, PK(l1, h1), od, 0, 0, 0);
  od = __builtin_amdgcn_mfma_f32_32x32x16_bf16(pa2, PK(l2, h2), od, 0, 0, 0);
  od = __builtin_amdgcn_mfma_f32_32x32x16_bf16(pa3, PK(l3, h3), od, 0, 0, 0);
#undef PK
}
__device__ __forceinline__ void pv_d0(f32x16* o, int vb, bf16x8 pa0, bf16x8 pa1, bf16x8 pa2, bf16x8 pa3) {
  pv_one<0>(o[0], vb, pa0, pa1, pa2, pa3); pv_one<1>(o[1], vb, pa0, pa1, pa2, pa3); pv_one<2>(o[2], vb, pa0, pa1, pa2, pa3); pv_one<3>(o[3], vb, pa0, pa1, pa2, pa3);
}
__device__ __forceinline__ void attn_body(const bf16_t* __restrict__ Qb, const float* __restrict__ cs, const float* __restrict__ sn, const bf16_t* __restrict__ Kn,
                                          const bf16_t* __restrict__ Vh, const bf16_t* __restrict__ Kr, bf16_t* __restrict__ Ob, int seq, char* lds) {
  const int tid = otid(), wid = tid >> 6, lane = tid & 63, r32 = lane & 31, hi = lane >> 5;
  char* V_lds = lds; char* K_lds = lds + 2 * SHM_V; char* R_lds = lds + 2 * SHM_V + 2 * SHM_K;
  float* wsf = (float*)(lds + 2 * SHM_V + 2 * SHM_K + 2 * SHM_R) + wid * 64; float* li_l = wsf; float* al_l = wsf + 32;
  char* qrl = lds + 2 * SHM_V + 2 * SHM_K + 2 * SHM_R + 2048 + wid * 4096 + lane * 16;
  float m_reg = -1e30f, l_reg = 0; f32x16 o[4] = {}; bf16x8 qr[12];
  { const bf16_t* Qw = Qb + (size_t)(wid * QBLK + r32) * LDQ + hi * 8;
#pragma unroll
    for (int d0 = 0; d0 < 8; ++d0) qr[d0] = *(const bf16x8*)(Qw + d0 * 16);
#pragma unroll
    for (int d0 = 0; d0 < 2; ++d0) {
      const u32x4 a = *(const u32x4*)(Qw + 128 + d0 * 16), bq = *(const u32x4*)(Qw + 160 + d0 * 16);
      if (cs) {
        const float* cp = cs + (size_t)(wid * QBLK + r32) * 32 + d0 * 16 + hi * 8; const float* sp = sn + (size_t)(wid * QBLK + r32) * 32 + d0 * 16 + hi * 8;
        const f32x4 c0 = *(const f32x4*)cp, c1 = *(const f32x4*)(cp + 4), s0 = *(const f32x4*)sp, s1 = *(const f32x4*)(sp + 4);
        float x1[8], x2[8], y1[8], y2[8];
#pragma unroll
        for (int k = 0; k < 4; ++k) { x1[2 * k] = bflo(a[k]); x1[2 * k + 1] = bfhi(a[k]); x2[2 * k] = bflo(bq[k]); x2[2 * k + 1] = bfhi(bq[k]); }
#pragma unroll
        for (int k = 0; k < 8; ++k) { const float c = k < 4 ? c0[k & 3] : c1[k & 3], s = k < 4 ? s0[k & 3] : s1[k & 3]; y1[k] = x1[k] * c - x2[k] * s; y2[k] = x2[k] * c + x1[k] * s; }
        u32x4 w1 = {cvtpk(y1[0], y1[1]), cvtpk(y1[2], y1[3]), cvtpk(y1[4], y1[5]), cvtpk(y1[6], y1[7])}, w2 = {cvtpk(y2[0], y2[1]), cvtpk(y2[2], y2[3]), cvtpk(y2[4], y2[5]), cvtpk(y2[6], y2[7])};
        qr[8 + d0] = *reinterpret_cast<bf16x8*>(&w1); qr[10 + d0] = *reinterpret_cast<bf16x8*>(&w2);
      } else { u32x4 a_ = a, b_ = bq; qr[8 + d0] = *reinterpret_cast<bf16x8*>(&a_); qr[10 + d0] = *reinterpret_cast<bf16x8*>(&b_); }
    } }
  const int sr = tid >> 4, sc = (tid & 15) * 8, vst0 = v_st(sr, sc), vst1 = v_st(32 + sr, sc);
  const int rr_ = tid >> 3, rc = (tid & 7) * 8;
  const int vb0 = (int)(uintptr_t)V_lds + v_rd_base(lane);
  bf16x8 vs0, vs1, ks0, ks1, rs0;
  const unsigned voffKV = (unsigned)(sr * LDK + sc) * 2u, voffR = (unsigned)(rr_ * LDKR + rc) * 2u;
#define SLOAD(k0) do { const char* kb_ = (const char*)Kn + (size_t)(k0) * (LDK * 2); const char* vb_ = (const char*)Vh + (size_t)(k0) * (LDK * 2); \
    vs0 = *(const bf16x8*)(vb_ + voffKV); vs1 = *(const bf16x8*)(vb_ + 32 * LDK * 2 + voffKV); \
    ks0 = *(const bf16x8*)(kb_ + voffKV); ks1 = *(const bf16x8*)(kb_ + 32 * LDK * 2 + voffKV); \
    rs0 = *(const bf16x8*)((const char*)Kr + (size_t)(k0) * (LDKR * 2) + voffR); } while (0)
#define SWRITE(b) do { *(bf16x8*)(V_lds + (b) * SHM_V + vst0) = vs0; *(bf16x8*)(V_lds + (b) * SHM_V + vst1) = vs1; const int kc = sc * 2;  \
    *(bf16x8*)(K_lds + (b) * SHM_K + KSWZ(sr, kc)) = ks0; *(bf16x8*)(K_lds + (b) * SHM_K + KSWZ(32 + sr, kc)) = ks1;                      \
    *(bf16x8*)(R_lds + (b) * SHM_R + RSWZ(rr_, rc * 2)) = rs0; } while (0)
#define RESC(a) do { if (__any((a) < 1.f)) { if (hi == 0) al_l[r32] = (a); asm volatile("s_waitcnt lgkmcnt(0)" ::: "memory"); \
    _Pragma("unroll") for (int d = 0; d < 4; ++d) _Pragma("unroll") for (int r = 0; r < 16; ++r) o[d][r] *= al_l[crow(r, hi)]; } } while (0)
  f32x16 pA0, pA1, pB0, pB1; float mnA, mnB, alA, alB; bf16x8 pa0, pa1, pa2, pa3; const int NT = seq / KVBLK;
  SLOAD(0); SWRITE(0); __syncthreads();
  qkt(pA0, pA1, K_lds, R_lds, qr, qrl, r32, hi); partialSM(pA0, pA1, m_reg, mnA, alA);
  SLOAD(KVBLK); SWRITE(1); __syncthreads();
  for (int j = 1; j + 1 < NT; j += 2) {
    SBAR(); qkt(pB0, pB1, K_lds + SHM_K, R_lds + SHM_R, qr, qrl, r32, hi);
    finishSM(pA0, pA1, alA, l_reg, pa0, pa1, pa2, pa3); SBAR();
    SLOAD((j + 1) * KVBLK); SBAR();
    pv_d0(o, vb0, pa0, pa1, pa2, pa3); partialSM(pB0, pB1, m_reg, mnB, alB);
    __syncthreads(); SWRITE(0);
    RESC(alB); __syncthreads();
    SBAR(); qkt(pA0, pA1, K_lds, R_lds, qr, qrl, r32, hi);
    finishSM(pB0, pB1, alB, l_reg, pa0, pa1, pa2, pa3); SBAR();
    SLOAD((j + 2) * KVBLK); SBAR();
    pv_d0(o, vb0 + (int)SHM_V, pa0, pa1, pa2, pa3); partialSM(pA0, pA1, m_reg, mnA, alA);
    __syncthreads(); SWRITE(1);
    RESC(alA); __syncthreads();
  }
  SBAR(); qkt(pB0, pB1, K_lds + SHM_K, R_lds + SHM_R, qr, qrl, r32, hi);
  finishSM(pA0, pA1, alA, l_reg, pa0, pa1, pa2, pa3); SBAR();
  pv_d0(o, vb0, pa0, pa1, pa2, pa3); partialSM(pB0, pB1, m_reg, mnB, alB);
  __syncthreads(); RESC(alB);
  finishSM(pB0, pB1, alB, l_reg, pa0, pa1, pa2, pa3); SBAR();
  pv_d0(o, vb0 + (int)SHM_V, pa0, pa1, pa2, pa3);
  if (hi == 0) li_l[r32] = l_reg; asm volatile("s_waitcnt lgkmcnt(0)" ::: "memory");
  float rli[16];
#pragma unroll
  for (int r = 0; r < 16; ++r) rli[r] = __builtin_amdgcn_rcpf(li_l[crow(r, hi)]);
  bf16_t* Ow = Ob + (size_t)(wid * QBLK) * LDO;
#pragma unroll
  for (int r = 0; r < 16; ++r) { const int orow = crow(r, hi);
#pragma unroll
    for (int d0 = 0; d0 < 4; ++d0) Ow[(size_t)orow * LDO + d0 * 32 + r32] = f2bf(o[d0][r] * rli[r]); }
  __syncthreads();
#undef SLOAD
#undef SWRITE
#undef RESC
}
}

__device__ void phase_attn(PRef p, int l, char* smem) {
  const bf16_t* Q = (const bf16_t*)(p.ws + WS_Q); const bf16_t* KV = (const bf16_t*)(p.ws + WS_KV); const bf16_t* KR = (const bf16_t*)(p.ws + WS_KR);
  bf16_t* mix = (bf16_t*)(p.ws + WS_MIX); const float* cs = (const float*)(p.ws + WS_COS); const float* sn = (const float*)(p.ws + WS_SIN);
  const int nunits = 1024 + (l == 0 ? 32 : 0);
  for (int u = obid(); u < nunits; u += gridDim.x) {
    if (u < 1024) {
      const int bh = (u >> 8) * 8 + (u & 7), qb = (u & 255) >> 3, hd = bh & 3, b = bh >> 2; const size_t row0 = (size_t)b * SEQ + qb * 256;
      att::attn_body(Q + row0 * 768 + hd * 192, cs + (size_t)qb * 256 * 32, sn + (size_t)qb * 256 * 32, KV + (size_t)b * SKV * 1024 + hd * 256,
                     KV + (size_t)b * SKV * 1024 + hd * 256 + 128, KR + (size_t)b * SKV * 64, mix + row0 * 1024 + 512 + hd * 128, SKV, smem);
    } else {
      const int v = u - 1024, hd = v & 3, b = v >> 2; const size_t row0 = (size_t)MX + b * CTXL;
      att::attn_body(Q + row0 * 768 + hd * 192, nullptr, nullptr, KV + (size_t)b * SKV * 1024 + hd * 256,
                     KV + (size_t)b * SKV * 1024 + hd * 256 + 128, KR + (size_t)b * SKV * 64, mix + row0 * 1024 + 512 + hd * 128, CTXL, smem);
    }
  }
}

__device__ void phase_outproj(PRef p, int l, char* smem) {
  LAS unsigned char* lds = (LAS unsigned char*)smem;
  const bf16_t* mix = (const bf16_t*)(p.ws + WS_MIX); const bf16_t* Wt = (const bf16_t*)(p.ws + WS_WOUT) + (size_t)l * 1024 * 1024;
  float* ctxz = (float*)(p.ws + WS_CTXZ);
  const int tid = otid(), wid = tid >> 6, lane = tid & 63, wr = wid >> 2, wc = wid & 3, fr = lane & 15, fq = lane >> 4;
  g8::TileIter it; it.init(l == 0 ? MT / 256 : MX / 256, 4);
  int pm, pn;
  while (it.next(pm, pn)) {
    unsigned voffA[2] = {g8::piece_off(0, 1024, 0), g8::piece_off(1, 1024, 0)};
    f32x4 acc[2][2][4][2];
    g8::gemm_tile<false>(lds, (const char*)(mix + (size_t)pm * 256 * 1024), voffA, (size_t)128 * 1024 * 2, (const char*)(Wt + (size_t)pn * 256 * 1024), 1024, acc);
    ACC_FOR(ai, bj, m, n) {
      const int row = pm * 256 + ai * 128 + wr * 64 + m * 16 + fr, col = pn * 256 + bj * 128 + wc * 32 + fq * 8 + n * 4;
      const float* res = l == 0 ? (row < MX ? p.x + (size_t)row * 1024 : p.ctx + (size_t)(row - MX) * 1024) : p.out + (size_t)row * 1024;
      float* dst = row < MX ? p.out + (size_t)row * 1024 : ctxz + (size_t)(row - MX) * 1024;
      const f32x4 r = *(const f32x4*)(res + col), g = *(const f32x4*)(mod_ptr(p, l, row, 2) + col);
      *(f32x4*)(dst + col) = r * ALPHA + g * acc[ai][bj][m][n];
    }
  }
}

__device__ void phase_ln1(PRef p, int l, char* smem) {
  float* wrt = (float*)smem;
  for (int i = otid(); i < 16384; i += 512) wrt[(i & 15) * 1024 + (i >> 4)] = p.w_router[(size_t)l * 16384 + i];
  __syncthreads();
  const int lane = otid() & 63, gw = obid() * 8 + (otid() >> 6), nw = gridDim.x * 8;
  bf16_t* h = (bf16_t*)(p.ws + WS_H); float* ctxz = (float*)(p.ws + WS_CTXZ); float* aff = (float*)(p.ws + WS_AFF);
  const int nrows = l == 0 ? MT : MX;
  for (int row = gw; row < nrows; row += nw) {
    asm volatile("" ::: "memory");
    float* zr = row < MX ? p.out + (size_t)row * 1024 : ctxz + (size_t)(row - MX) * 1024;
    f32x4 v[4];
#pragma unroll
    for (int i = 0; i < 4; ++i) v[i] = *(const f32x4*)(zr + lane * 4 + 256 * i);
    ln_row(v, 1e-5f);
#pragma unroll
    for (int i = 0; i < 4; ++i) { const int c = lane * 4 + 256 * i; v[i] = v[i] * *(const f32x4*)(p.ln1_g + l * 1024 + c) + *(const f32x4*)(p.ln1_b + l * 1024 + c); *(f32x4*)(zr + c) = v[i]; }
    ln_row(v, 1e-6f);
    f32x4 hm[4];
    store_mod_bf16(v, mod_ptr(p, l, row, 3), mod_ptr(p, l, row, 4), h + (size_t)row * 1024, lane, &hm);
    float lg[16];
#pragma unroll
    for (int e = 0; e < 16; ++e) { float s = 0.f;
#pragma unroll
      for (int i = 0; i < 4; ++i) { const f32x4 w = *(const f32x4*)(wrt + e * 1024 + lane * 4 + 256 * i); s += hm[i][0] * w[0] + hm[i][1] * w[1] + hm[i][2] * w[2] + hm[i][3] * w[3]; }
      lg[e] = wave_sum(s); }
    float mx = lg[0];
#pragma unroll
    for (int e = 1; e < 16; ++e) mx = fmaxf(mx, lg[e]);
    float den = 0.f;
#pragma unroll
    for (int e = 0; e < 16; ++e) { lg[e] = expf(lg[e] - mx); den += lg[e]; }
    float mine = 0.f;
#pragma unroll
    for (int e = 0; e < 16; ++e) if (lane == e) mine = lg[e] / den;
    if (lane < 16) aff[(size_t)row * 16 + lane] = mine;
  }
}

template <int PER>
__device__ __forceinline__ void topk_item(const float* __restrict__ affp, int n, int kcap, int rowbase, int slotbase, int e, int* __restrict__ IDX, float* __restrict__ GV, int* __restrict__ TS, char* smem) {
  unsigned* hist = (unsigned*)smem; unsigned* sel = hist + 256; unsigned* wtot = hist + 272;
  const int tid = otid(), lane = tid & 63, wid = tid >> 6;
  const bool active = tid * PER < n;
  unsigned key[PER];
#pragma unroll
  for (int i = 0; i < PER; ++i) key[i] = active ? __float_as_uint(affp[(size_t)(tid * PER + i) * 16]) : 0u;
  unsigned prefix = 0u, mask = 0u; int kk = kcap;
#pragma unroll 1
  for (int shift = 24; shift >= 0; shift -= 8) {
    __syncthreads();
    if (tid < 256) hist[tid] = 0u;
    __syncthreads();
#pragma unroll
    for (int i = 0; i < PER; ++i) if (active && (key[i] & mask) == prefix) atomicAdd(&hist[(key[i] >> shift) & 255u], 1u);
    __syncthreads();
    if (wid == 0) {
      const unsigned h0 = hist[lane * 4], h1 = hist[lane * 4 + 1], h2 = hist[lane * 4 + 2], h3 = hist[lane * 4 + 3];
      const unsigned tot = h0 + h1 + h2 + h3; unsigned suf = tot;
#pragma unroll
      for (int o = 1; o < 64; o <<= 1) { const unsigned u = __shfl_down(suf, o); if (lane + o < 64) suf += u; }
      const unsigned above = suf - tot;
      if (above < (unsigned)kk && suf >= (unsigned)kk) {
        unsigned a = above; int bin;
        if (a + h3 >= (unsigned)kk) bin = 3; else { a += h3; if (a + h2 >= (unsigned)kk) bin = 2; else { a += h2; if (a + h1 >= (unsigned)kk) bin = 1; else { a += h1; bin = 0; } } }
        sel[0] = prefix | ((unsigned)(lane * 4 + bin) << shift); sel[1] = (unsigned)kk - a;
      }
    }
    __syncthreads();
    prefix = sel[0]; kk = (int)sel[1]; mask |= 0xffu << shift;
  }
  const unsigned Tk = prefix;
  unsigned cg_ = 0, ce = 0;
#pragma unroll
  for (int i = 0; i < PER; ++i) { cg_ += key[i] > Tk; ce += key[i] == Tk; }
  unsigned pk = active ? (cg_ | (ce << 16)) : 0u, inc = pk;
#pragma unroll
  for (int o = 1; o < 64; o <<= 1) { const unsigned u = __shfl_up(inc, o); if (lane >= o) inc += u; }
  __syncthreads();
  if (lane == 63) wtot[wid] = inc;
  __syncthreads();
  unsigned base = 0;
  for (int w2 = 0; w2 < wid; ++w2) base += wtot[w2];
  const unsigned exc = base + inc - pk; unsigned gt_before = exc & 0xffffu, eq_before = exc >> 16;
  if (active) {
#pragma unroll
    for (int i = 0; i < PER; ++i) {
      const int t = tid * PER + i; int R = -1;
      const bool isgt = key[i] > Tk, iseq = key[i] == Tk;
      if (isgt || (iseq && (int)eq_before < kk)) {
        const int slot = (int)gt_before + min((int)eq_before, kk);
        R = slotbase + slot; IDX[R] = rowbase + t; GV[R] = __uint_as_float(key[i]);
      }
      TS[t] = R;
      gt_before += isgt; eq_before += iseq;
    }
  }
}
__device__ void phase_topk(PRef p, int l, char* smem) {
  const float* aff = (const float*)(p.ws + WS_AFF); int* IDX = (int*)(p.ws + WS_IDX); float* GV = (float*)(p.ws + WS_GV); int* TS = (int*)(p.ws + WS_TS);
  const int nitems = l == 0 ? 256 : 128;
  for (int it = obid(); it < nitems; it += gridDim.x) {
    if (it < 128) { const int b = it >> 4, e = it & 15; topk_item<16>(aff + (size_t)b * SEQ * 16 + e, SEQ, CAPX, b * SEQ, it * CAPX, e, IDX, GV, TS + (size_t)it * SEQ, smem); }
    else { const int v = it - 128, b = v >> 4, e = v & 15; topk_item<1>(aff + ((size_t)MX + b * CTXL) * 16 + e, CTXL, CAPC, MX + b * CTXL, NB * NE * CAPX + e * 256 + b * CAPC, e, IDX, GV, TS + (size_t)NB * 16 * SEQ + (size_t)v * CTXL, smem); }
  }
  __syncthreads();
}

__device__ void phase_moe_up(PRef p, int l, char* smem) {
  LAS unsigned char* lds = (LAS unsigned char*)smem;
  const bf16_t* h = (const bf16_t*)(p.ws + WS_H); const bf16_t* Wgu = (const bf16_t*)(p.ws + WS_WGU); bf16_t* act = (bf16_t*)(p.ws + WS_ACT); const int* IDX = (const int*)(p.ws + WS_IDX);
  const int tid = otid(), wid = tid >> 6, lane = tid & 63, wr = wid >> 2, wc = wid & 3, fr = lane & 15, fq = lane >> 4;
  g8::MoeIter it; it.init(8, l == 0);
  int pm, pn, e;
  while (it.next(pm, pn, e)) {
    unsigned voffA[4];
#pragma unroll
    for (int hh = 0; hh < 2; ++hh)
#pragma unroll
      for (int i = 0; i < 2; ++i) { int R, C; g8::piece_rc(i, R, C); voffA[hh * 2 + i] = (unsigned)(IDX[pm * 256 + hh * 128 + R] * 1024 + C) * 2u; }
    f32x4 acc[2][2][4][2];
    g8::gemm_tile<true>(lds, (const char*)h, voffA, 0, (const char*)(Wgu + ((size_t)e * 2048 + pn * 256) * 1024), 1024, acc);
#pragma unroll
    for (int ai = 0; ai < 2; ++ai)
#pragma unroll
      for (int m = 0; m < 4; ++m) {
          const int row = pm * 256 + ai * 128 + wr * 64 + m * 16 + fr, col = pn * 128 + wc * 32 + fq * 8;
          float a[8];
#pragma unroll
          for (int n = 0; n < 2; ++n) { const f32x4 g = acc[ai][0][m][n], u = acc[ai][1][m][n];
#pragma unroll
            for (int k = 0; k < 4; ++k) a[n * 4 + k] = silu_f(g[k]) * u[k]; }
          u32x4 w = {cvtpk(a[0], a[1]), cvtpk(a[2], a[3]), cvtpk(a[4], a[5]), cvtpk(a[6], a[7])}; *(u32x4*)(act + (size_t)row * 1024 + col) = w;
        }
  }
}
__device__ void phase_moe_down(PRef p, int l, char* smem) {
  LAS unsigned char* lds = (LAS unsigned char*)smem;
  const bf16_t* act = (const bf16_t*)(p.ws + WS_ACT); const bf16_t* Wdn = (const bf16_t*)(p.ws + WS_WDN); bf16_t* oute = (bf16_t*)(p.ws + WS_OUTE); const float* GV = (const float*)(p.ws + WS_GV);
  const int tid = otid(), wid = tid >> 6, lane = tid & 63, wr = wid >> 2, wc = wid & 3, fr = lane & 15, fq = lane >> 4;
  g8::MoeIter it; it.init(4, l == 0);
  int pm, pn, e;
  while (it.next(pm, pn, e)) {
    unsigned voffA[2] = {g8::piece_off(0, 1024, 0), g8::piece_off(1, 1024, 0)};
    f32x4 acc[2][2][4][2];
    g8::gemm_tile<false>(lds, (const char*)(act + (size_t)pm * 256 * 1024), voffA, (size_t)128 * 1024 * 2, (const char*)(Wdn + ((size_t)e * 1024 + pn * 256) * 1024), 1024, acc);
    ACC_FOR3(ai, bj, m) {
      const int row = pm * 256 + ai * 128 + wr * 64 + m * 16 + fr, col = pn * 256 + bj * 128 + wc * 32 + fq * 8;
      const float gv = GV[row]; const f32x4 v0 = acc[ai][bj][m][0] * gv, v1 = acc[ai][bj][m][1] * gv;
      u32x4 w = {cvtpk(v0[0], v0[1]), cvtpk(v0[2], v0[3]), cvtpk(v1[0], v1[1]), cvtpk(v1[2], v1[3])}; *(u32x4*)(oute + (size_t)row * 1024 + col) = w;
    }
  }
}

__device__ void phase_ln2(PRef p, int l) {
  const int lane = otid() & 63, gw = obid() * 8 + (otid() >> 6), nw = gridDim.x * 8;
  bf16_t* h = (bf16_t*)(p.ws + WS_H); float* ctxz = (float*)(p.ws + WS_CTXZ); const bf16_t* oute = (const bf16_t*)(p.ws + WS_OUTE); const int* TS = (const int*)(p.ws + WS_TS);
  const int nrows = l == 0 ? MT : MX;
  for (int row = gw; row < nrows; row += nw) {
    float* xr = row < MX ? p.out + (size_t)row * 1024 : ctxz + (size_t)(row - MX) * 1024;
    f32x4 mo[4];
#pragma unroll
    for (int i = 0; i < 4; ++i) mo[i] = (f32x4){0.f, 0.f, 0.f, 0.f};
    const int myR = lane < 16 ? (row < MX ? TS[((size_t)(row >> 13) * 16 + lane) * SEQ + (row & 8191)] : TS[(size_t)NB * 16 * SEQ + ((size_t)((row - MX) >> 8) * 16 + lane) * CTXL + ((row - MX) & 255)]) : -1;
    for (int e = 0; e < 16; ++e) { const int Rr = __shfl(myR, e);
      if (Rr >= 0) {
#pragma unroll
        for (int i = 0; i < 4; ++i) { const u32x2 w = *(const u32x2*)(oute + (size_t)Rr * 1024 + lane * 4 + 256 * i);
          mo[i][0] += bflo(w[0]); mo[i][1] += bfhi(w[0]); mo[i][2] += bflo(w[1]); mo[i][3] += bfhi(w[1]); } } }
    f32x4 v[4]; const float* m5 = mod_ptr(p, l, row, 5);
#pragma unroll
    for (int i = 0; i < 4; ++i) { const int c = lane * 4 + 256 * i; v[i] = *(const f32x4*)(xr + c) * ALPHA + *(const f32x4*)(m5 + c) * mo[i]; }
    ln_row(v, 1e-5f);
#pragma unroll
    for (int i = 0; i < 4; ++i) { const int c = lane * 4 + 256 * i; v[i] = v[i] * *(const f32x4*)(p.ln2_g + l * 1024 + c) + *(const f32x4*)(p.ln2_b + l * 1024 + c); *(f32x4*)(xr + c) = v[i]; }
    if (l + 1 < DEPTH) { ln_row(v, 1e-6f); store_mod_bf16(v, mod_ptr(p, l + 1, row, 0), mod_ptr(p, l + 1, row, 1), h + (size_t)row * 1024, lane, nullptr); }
  }
}

__device__ __forceinline__ void gsync(cg::grid_group& grid) {
  asm volatile("s_waitcnt vmcnt(0) lgkmcnt(0)" ::: "memory");
  grid.sync();
}
#define XB_CEN(j) (64 * (j))
#define XB_SUB(j) (1024 + 64 * (j))
#define XB_TOP 2048
struct FastBar { unsigned* w; unsigned xcc, nloc, nx, epoch; };
__device__ __forceinline__ unsigned xb_ld(unsigned* q) { return __hip_atomic_load(q, __ATOMIC_RELAXED, __HIP_MEMORY_SCOPE_AGENT); }
__device__ __forceinline__ unsigned xb_add(unsigned* q, unsigned v) { return __hip_atomic_fetch_add(q, v, __ATOMIC_RELAXED, __HIP_MEMORY_SCOPE_AGENT); }
__device__ __forceinline__ void fsync(FastBar& fb) {
  asm volatile("s_waitcnt vmcnt(0) lgkmcnt(0)" ::: "memory");
  __syncthreads();
  fb.epoch += 1u;
  if (otid() == 0) {
    const unsigned a = xb_add(&fb.w[XB_SUB(fb.xcc)], 1u) + 1u;
    if (a == fb.nloc * fb.epoch) {
      __builtin_amdgcn_fence(__ATOMIC_RELEASE, "agent");
      asm volatile("s_waitcnt vmcnt(0)" ::: "memory");
      (void)xb_add(&fb.w[XB_TOP], 1u);
    }
    while (xb_ld(&fb.w[XB_TOP]) < fb.nx * fb.epoch) __builtin_amdgcn_s_sleep(1);
    __builtin_amdgcn_fence(__ATOMIC_ACQUIRE, "agent");
    asm volatile("s_waitcnt vmcnt(0)" ::: "memory");
  }
  __syncthreads();
}
__global__ void __launch_bounds__(512) mega(Params p) {
  extern __shared__ __attribute__((aligned(16))) char smem[];
  cg::grid_group grid = cg::this_grid();
  FastBar fb; fb.w = (unsigned*)(kparams().ws + WS_BAR); fb.xcc = (unsigned)__builtin_amdgcn_readfirstlane((int)(__builtin_amdgcn_s_getreg((3 << 11) | 20) & 0xF)); fb.epoch = 0u; fb.nloc = 0u; fb.nx = 0u;
  if (otid() == 0) (void)xb_add(&fb.w[XB_CEN(fb.xcc)], 1u);
  phase_prep(kparams(), smem);
  gsync(grid);
  { unsigned nx = 0u;
#pragma unroll 1
    for (int j = 0; j < 16; ++j) nx += xb_ld(&fb.w[XB_CEN(j)]) != 0u;
    fb.nx = (unsigned)__builtin_amdgcn_readfirstlane((int)nx); fb.nloc = (unsigned)__builtin_amdgcn_readfirstlane((int)xb_ld(&fb.w[XB_CEN(fb.xcc)])); }
  phase_h0(kparams());
  fsync(fb);
#pragma unroll 1
  for (int l = 0; l < DEPTH; ++l) {
    phase_inproj(kparams(), l, smem);
    fsync(fb);
    phase_mlstm_pre(kparams(), l, smem);
    fsync(fb);
    phase_mlstm(kparams(), l, smem);
    fsync(fb);
    phase_mla_prep(kparams(), l, smem);
    fsync(fb);
    phase_attn(kparams(), l, smem);
    fsync(fb);
    phase_outproj(kparams(), l, smem);
    fsync(fb);
    phase_ln1(kparams(), l, smem);
    __syncthreads();
    phase_cvt_experts(kparams(), l, smem);
    fsync(fb);
    phase_topk(kparams(), l, smem);
    fsync(fb);
    phase_moe_up(kparams(), l, smem);
    fsync(fb);
    phase_moe_down(kparams(), l, smem);
    fsync(fb);
    phase_ln2(kparams(), l);
    fsync(fb);
  }
}

extern "C" void kernel_launch(void* const* d_in, const int* in_sizes, int n_in, void* d_out, int out_size,
                              void* d_ws, size_t ws_size, hipStream_t stream) {
  constexpr size_t kDynLds = 160 * 1024;
  static int grid_blocks = 0;
  if (!grid_blocks) {
    int dev = 0, cus = 0, per_cu = 0;
    (void)hipGetDevice(&dev);
    (void)hipDeviceGetAttribute(&cus, hipDeviceAttributeMultiprocessorCount, dev);
    (void)hipFuncSetAttribute((const void*)mega, hipFuncAttributeMaxDynamicSharedMemorySize, (int)kDynLds);
    (void)hipOccupancyMaxActiveBlocksPerMultiprocessor(&per_cu, mega, 512, kDynLds);
    grid_blocks = per_cu > 0 ? cus : 0;
    if (grid_blocks > 256) grid_blocks = 256;
    grid_blocks &= ~7;
    if (grid_blocks != 256) { fprintf(stderr, "this kernel needs 256 co-resident workgroups (got %d)\n", grid_blocks); grid_blocks = 0; }
    if (ws_size < WS_END) { fprintf(stderr, "workspace too small: %zu < %zu\n", ws_size, (size_t)WS_END); grid_blocks = 0; }
  }
  if (grid_blocks <= 0) return;
  Params p{};
  const float** pp = (const float**)&p;
  for (int i = 0; i < 24; ++i) pp[i] = (const float*)d_in[i];
  p.out = (float*)d_out; p.ws = (char*)d_ws;
  (void)hipMemsetAsync((char*)d_ws + WS_BAR, 0, WS_BAR_BYTES, stream);
  void* args[] = {&p};
  hipError_t e = hipLaunchCooperativeKernel((void*)mega, dim3(grid_blocks), dim3(512), args, kDynLds, stream);
  if (e != hipSuccess) fprintf(stderr, "cooperative launch failed: %s (grid %d)\n", hipGetErrorString(e), grid_blocks);
}
```

```cpp
#include <hip/hip_runtime.h>
#include <hip/hip_cooperative_groups.h>
#include <cstdio>
#include <cstdint>
namespace cg = cooperative_groups;

typedef unsigned short bf16_t;
typedef short bf16x8 __attribute__((ext_vector_type(8)));
typedef short s16x4 __attribute__((ext_vector_type(4)));
typedef float f32x4 __attribute__((ext_vector_type(4)));
typedef float f32x16 __attribute__((ext_vector_type(16)));
typedef unsigned u32x4 __attribute__((ext_vector_type(4)));
typedef unsigned u32x2 __attribute__((ext_vector_type(2)));
#define LAS __attribute__((address_space(3)))

constexpr int DM = 1024, NB = 8, SEQ = 8192, CTXL = 256, DEPTH = 2;
constexpr int MX = NB * SEQ, MC = NB * CTXL, MT = MX + MC;
constexpr int PLD = 2816;
constexpr int OFF_Q = 0, OFF_K = 512, OFF_V = 1024, OFF_O = 1536, OFF_G = 2048, OFF_CQ = 2064, OFF_CKV = 2448, OFF_KR = 2704, IN_COLS = 2768;
constexpr int SKV = SEQ + CTXL;
constexpr int NE = 16, CAPX = 1024, CAPC = 32;
constexpr int NSLOT = NB * NE * CAPX + NB * NE * CAPC;
constexpr float ALPHA = 1.4142135623730951f;
constexpr float A_SCALE = 0.07216878364870322f;

constexpr size_t al256(size_t v) { return (v + 255) / 256 * 256; }
constexpr size_t WS_H = 0;
constexpr size_t WS_P = WS_H + al256((size_t)MT * 1024 * 2);
constexpr size_t WS_Q = WS_P + al256((size_t)MT * PLD * 2);
constexpr size_t WS_KV = WS_Q + al256((size_t)MT * 768 * 2);
constexpr size_t WS_KR = WS_KV + al256((size_t)NB * SKV * 1024 * 2);
constexpr size_t WS_MIX = WS_KR + al256((size_t)NB * SKV * 64 * 2);
constexpr size_t WS_ACT = WS_P;
constexpr size_t WS_HB = WS_H;
constexpr size_t WS_OUTE = WS_P + al256((size_t)NSLOT * 1024 * 2);
constexpr size_t WS_WGU = WS_MIX;
constexpr size_t WS_WDN = WS_MIX + (size_t)NE * 2048 * 1024 * 2;
constexpr size_t WS_WIN = WS_MIX + al256((size_t)MT * 1024 * 2);
constexpr size_t WS_WUQ = WS_WIN + (size_t)2 * PLD * 1024 * 2;
constexpr size_t WS_WUKV = WS_WUQ + (size_t)2 * 768 * 384 * 2;
constexpr size_t WS_WOUT = WS_WUKV + (size_t)2 * 1024 * 256 * 2;
constexpr size_t WS_MOD = WS_WOUT + (size_t)2 * 1024 * 1024 * 2;
constexpr size_t WS_COS = WS_MOD + al256((size_t)2 * 9 * 6144 * 4);
constexpr size_t WS_SIN = WS_COS + (size_t)SEQ * 32 * 4;
constexpr size_t WS_GATES = WS_SIN + (size_t)SEQ * 32 * 4;
constexpr size_t WS_AFF = WS_GATES + (size_t)MT * 16 * 4;
constexpr size_t WS_IDX = WS_AFF + (size_t)MT * 16 * 4;
constexpr size_t WS_GV = WS_IDX + (size_t)NSLOT * 4;
constexpr size_t WS_TS = WS_GV + (size_t)NSLOT * 4;
constexpr size_t WS_CTXZ = WS_TS + (size_t)MT * 16 * 4;
constexpr size_t WS_BAR = WS_CTXZ + (size_t)MC * 1024 * 4;
constexpr size_t WS_BAR_BYTES = 16384;
constexpr size_t WS_END = WS_BAR + WS_BAR_BYTES;
static_assert(WS_OUTE + (size_t)NSLOT * 1024 * 2 <= WS_KR, "out_e overlay");
static_assert(WS_WDN + (size_t)NE * 1024 * 1024 * 2 <= WS_WIN, "expert weights overlay");

struct Params {
  const float *x, *c, *ctx, *c_ctx, *w_mod, *b_mod, *w_in, *b_gates, *conv_w, *conv_b, *m_norm_w, *q_norm_w, *kv_norm_w, *w_uq, *w_ukv, *w_out,
      *ln1_g, *ln1_b, *w_router, *w_gate, *w_up, *w_down, *ln2_g, *ln2_b;
  float* out; char* ws;
};

typedef const __attribute__((address_space(4))) Params& PRef;
__device__ __forceinline__ PRef kparams() { const __attribute__((address_space(4))) Params* kp = (const __attribute__((address_space(4))) Params*)__builtin_amdgcn_kernarg_segment_ptr(); asm volatile("" : "+s"(kp)); return *kp; }
__device__ __forceinline__ int otid() { int t = threadIdx.x; asm volatile("" : "+v"(t)); return t; }
__device__ __forceinline__ int obid() { int t = blockIdx.x; asm volatile("" : "+s"(t)); return t; }
__device__ __forceinline__ int opaque_s(int v) { asm volatile("" : "+s"(v)); return v; }
typedef __bf16 bf16v2_t __attribute__((ext_vector_type(2)));
typedef float f32x2_t __attribute__((ext_vector_type(2)));
__device__ __forceinline__ unsigned cvtpk(float lo, float hi) { const f32x2_t f = {lo, hi}; const bf16v2_t b = __builtin_convertvector(f, bf16v2_t); return __builtin_bit_cast(unsigned, b); }
__device__ __forceinline__ bf16_t f2bf(float v) { return (bf16_t)(cvtpk(v, v) & 0xffffu); }
__device__ __forceinline__ float bf2f(unsigned v) { return __uint_as_float(v << 16); }
__device__ __forceinline__ float bflo(unsigned w) { return __uint_as_float(w << 16); }
__device__ __forceinline__ float bfhi(unsigned w) { return __uint_as_float(w & 0xffff0000u); }
__device__ __forceinline__ float wave_sum(float v) { for (int o = 32; o > 0; o >>= 1) v += __shfl_xor(v, o); return v; }
__device__ __forceinline__ float wave_max(float v) { for (int o = 32; o > 0; o >>= 1) v = fmaxf(v, __shfl_xor(v, o)); return v; }
__device__ __forceinline__ float sigmoid_f(float v) { return __builtin_amdgcn_rcpf(1.f + __expf(-v)); }
__device__ __forceinline__ float silu_f(float v) { return v * sigmoid_f(v); }

namespace g8 {
constexpr int BK = 64, HALF = 128, HTB = HALF * BK * 2, STAGE_BYTES = 8 * HTB;
__device__ __forceinline__ int lds_byte(int r, int c) { const int st = (r >> 4) * 2 + (c >> 5), rr = r & 15, cc = c & 31, ob = rr * 64 + cc * 2; return st * 1024 + (ob ^ (((ob >> 9) & 1) << 5)); }
__device__ __forceinline__ int perm32(int rho) { const int n = rho >> 4, i = rho & 15; return 8 * (i >> 2) + 4 * n + (i & 3); }
__device__ __forceinline__ void stage_rc(int b, int& R, int& C) { const int st = b / 1024, sb = b % 1024, swz = sb ^ (((sb >> 9) & 1) << 5); R = (st >> 1) * 16 + swz / 64; C = (st & 1) * 32 + (swz % 64) / 2; }

template <bool GATHER>
__device__ __forceinline__ void gemm_tile(LAS unsigned char* lds, const char* __restrict__ Ab, const unsigned (&voffA)[GATHER ? 4 : 2], size_t hstepA, const char* __restrict__ Bb, int K,
                                          f32x4 (&acc)[2][2][4][2]) {
  const int tid = otid(), wid = __builtin_amdgcn_readfirstlane(tid >> 6), lane = tid & 63, wr = wid >> 2, wc = wid & 3, fr = lane & 15, fq = lane >> 4;
  const int nt = K / BK;
  unsigned voffB[2];
#pragma unroll
  for (int i = 0; i < 2; ++i) { int R, C; stage_rc(tid * 16 + i * 8192, R, C); const int Rb = (R & ~31) + perm32(R & 31); voffB[i] = (unsigned)(Rb * K + C) * 2u; }
  const char* Bb1 = Bb + (size_t)HALF * K * 2; const char* Ab1 = GATHER ? Ab : Ab + hstepA;
  const unsigned* vA0 = &voffA[0]; const unsigned* vA1 = GATHER ? &voffA[2] : &voffA[0];
  const unsigned ldsw = (unsigned)wid * 1024u;
  const int aoff = lds_byte(wr * 64 + fr, fq * 8), boff = lds_byte(wc * 32 + fr, fq * 8);
#define G8_SA(b, h) (((b) * 2 + (h)) * HTB)
#define G8_SB(b, h) ((4 + (b) * 2 + (h)) * HTB)
#define G8_STAGE(bufoff, gbase, voff, kt) do { _Pragma("unroll") for (int _i = 0; _i < 2; ++_i) \
    __builtin_amdgcn_global_load_lds((const unsigned*)((gbase) + (size_t)(kt) * (BK * 2) + (voff)[_i]), (LAS unsigned*)(lds + (bufoff) + ldsw + _i * 8192), 16, 0, 0); } while (0)
#define G8_LDA(dst, b, h) do { _Pragma("unroll") for (int m = 0; m < 4; ++m) _Pragma("unroll") for (int k = 0; k < 2; ++k) dst[m][k] = *(const LAS bf16x8*)(lds + G8_SA(b, h) + aoff + m * 2048 + k * 1024); } while (0)
#define G8_LDB(dst, b, h) do { _Pragma("unroll") for (int n = 0; n < 2; ++n) _Pragma("unroll") for (int k = 0; k < 2; ++k) dst[n][k] = *(const LAS bf16x8*)(lds + G8_SB(b, h) + boff + n * 2048 + k * 1024); } while (0)
#define G8_MMA(ai, bj, At, Bt) do { __builtin_amdgcn_s_setprio(1); _Pragma("unroll") for (int m = 0; m < 4; ++m) _Pragma("unroll") for (int n = 0; n < 2; ++n) _Pragma("unroll") for (int k = 0; k < 2; ++k) \
    acc[ai][bj][m][n] = __builtin_amdgcn_mfma_f32_16x16x32_bf16(Bt[n][k], At[m][k], acc[ai][bj][m][n], 0, 0, 0); __builtin_amdgcn_s_setprio(0); } while (0)
#define G8_WAIT_V(n) asm volatile("s_waitcnt vmcnt(" #n ")" ::: "memory")
#define G8_WAIT_L(n) asm volatile("s_waitcnt lgkmcnt(" #n ")" ::: "memory")
#define G8_BAR __builtin_amdgcn_s_barrier()
#define G8_SCHED __builtin_amdgcn_sched_barrier(0)
#pragma unroll
  for (int a = 0; a < 2; ++a)
#pragma unroll
    for (int b = 0; b < 2; ++b)
#pragma unroll
      for (int m = 0; m < 4; ++m)
#pragma unroll
        for (int n = 0; n < 2; ++n) acc[a][b][m][n] = (f32x4){0.f, 0.f, 0.f, 0.f};
  bf16x8 At[4][2], B0[2][2], B1[2][2];
  G8_WAIT_V(0); __syncthreads();
  G8_STAGE(G8_SB(0, 0), Bb, voffB, 0); G8_STAGE(G8_SA(0, 0), Ab, vA0, 0); G8_STAGE(G8_SB(0, 1), Bb1, voffB, 0); G8_STAGE(G8_SA(0, 1), Ab1, vA1, 0);
  if (wr == 1) G8_BAR;
  G8_WAIT_V(4); G8_BAR;
  G8_STAGE(G8_SB(1, 0), Bb, voffB, 1); G8_STAGE(G8_SA(1, 0), Ab, vA0, 1); G8_STAGE(G8_SB(1, 1), Bb1, voffB, 1);
  G8_WAIT_V(6); G8_BAR;
  for (int t = 0; t < nt - 2; t += 2) {
    G8_LDB(B0, 0, 0); G8_SCHED; G8_LDA(At, 0, 0); G8_STAGE(G8_SA(1, 1), Ab1, vA1, t + 1);
    G8_WAIT_L(8); G8_BAR; G8_WAIT_L(0); G8_MMA(0, 0, At, B0); G8_BAR; G8_SCHED;
    G8_LDB(B1, 0, 1); G8_STAGE(G8_SB(0, 0), Bb, voffB, t + 2);
    G8_BAR; G8_WAIT_L(0); G8_MMA(0, 1, At, B1); G8_BAR;
    G8_LDA(At, 0, 1); G8_STAGE(G8_SA(0, 0), Ab, vA0, t + 2);
    G8_BAR; G8_WAIT_L(0); G8_MMA(1, 0, At, B0); G8_BAR; G8_SCHED;
    G8_STAGE(G8_SB(0, 1), Bb1, voffB, t + 2);
    G8_WAIT_V(6); G8_BAR; G8_MMA(1, 1, At, B1); G8_BAR;
    G8_LDB(B0, 1, 0); G8_SCHED; G8_LDA(At, 1, 0); G8_STAGE(G8_SA(0, 1), Ab1, vA1, t + 2);
    G8_WAIT_L(8); G8_BAR; G8_WAIT_L(0); G8_MMA(0, 0, At, B0); G8_BAR; G8_SCHED;
    G8_LDB(B1, 1, 1); G8_STAGE(G8_SB(1, 0), Bb, voffB, t + 3);
    G8_BAR; G8_WAIT_L(0); G8_MMA(0, 1, At, B1); G8_BAR;
    G8_LDA(At, 1, 1); G8_STAGE(G8_SA(1, 0), Ab, vA0, t + 3);
    G8_BAR; G8_WAIT_L(0); G8_MMA(1, 0, At, B0); G8_BAR; G8_SCHED;
    G8_STAGE(G8_SB(1, 1), Bb1, voffB, t + 3);
    G8_WAIT_V(6); G8_BAR; G8_MMA(1, 1, At, B1); G8_BAR;
  }
  { G8_LDB(B0, 0, 0); G8_LDA(At, 0, 0); G8_STAGE(G8_SA(1, 1), Ab1, vA1, nt - 1);
    G8_BAR; G8_WAIT_L(0); G8_MMA(0, 0, At, B0); G8_BAR;
    G8_LDB(B1, 0, 1); G8_BAR; G8_WAIT_L(0); G8_MMA(0, 1, At, B1); G8_BAR;
    G8_LDA(At, 0, 1); G8_WAIT_V(4); G8_BAR; G8_WAIT_L(0); G8_MMA(1, 0, At, B0); G8_MMA(1, 1, At, B1); G8_BAR; }
  { G8_LDB(B0, 1, 0); G8_LDA(At, 1, 0); G8_WAIT_V(2); G8_BAR; G8_WAIT_L(0); G8_MMA(0, 0, At, B0); G8_BAR;
    G8_LDB(B1, 1, 1); G8_WAIT_V(0); G8_BAR; G8_WAIT_L(0); G8_MMA(0, 1, At, B1); G8_BAR;
    G8_LDA(At, 1, 1); G8_BAR; G8_WAIT_L(0); G8_MMA(1, 0, At, B0); G8_MMA(1, 1, At, B1); G8_BAR; }
  if (wr == 0) G8_BAR;
}
__device__ __forceinline__ unsigned piece_off(int i, int ld, int c0) { int R, C; stage_rc((int)otid() * 16 + i * 8192, R, C); return (unsigned)(R * ld + c0 + C) * 2u; }
__device__ __forceinline__ void piece_rc(int i, int& R, int& C) { stage_rc((int)otid() * 16 + i * 8192, R, C); }
struct TileIter {
  int nM, nN, x, j, J, cnt, idx;
  __device__ __forceinline__ void init(int nM_, int nN_) { nM = nM_; nN = nN_; x = obid() & 7; j = obid() >> 3; J = gridDim.x >> 3; cnt = ((nM - x + 7) >> 3) * nN; idx = j; }
  __device__ __forceinline__ bool next(int& pm, int& pn) { if (idx >= cnt) return false; pm = x + 8 * (idx / nN); pn = idx % nN; idx += J; return true; }
};
struct MoeIter {
  int nN, x, jm, jn, j, step, nsteps, nb4; bool with_ctx, ctx_done, wide;
  __device__ __forceinline__ void init(int nN_, bool with_ctx_) { nN = nN_; with_ctx = with_ctx_; wide = nN_ == 8; x = obid() & 7; j = obid() >> 3;
    if (wide) { jm = j & 3; jn = j >> 2; nsteps = 16; } else { jm = j & 7; jn = j >> 3; nsteps = 2 * (nN >> 2) * 4; }
    nb4 = nN >> 2; step = 0; ctx_done = false; }
  __device__ __forceinline__ bool next(int& pm, int& pn, int& e) {
    if (step < nsteps) {
      int m32;
      if (wide) { const int mb = step & 7, el = step >> 3; e = 2 * x + el; m32 = mb * 4 + jm; pn = jn; }
      else { const int mb = step & 3, nb = (step >> 2) % nb4, el = (step >> 2) / nb4; e = 2 * x + el; m32 = mb * 8 + jm; pn = nb * 4 + jn; }
      pm = ((m32 >> 2) * 16 + e) * 4 + (m32 & 3); ++step; return true; }
    if (with_ctx && !ctx_done) { ctx_done = true; if (j < 2 * nN) { e = 2 * x + j / nN; pm = 512 + e; pn = j % nN; return true; } }
    return false;
  }
};
}

#define ACC_FOR3(ai, bj, m) _Pragma("unroll") for (int ai = 0; ai < 2; ++ai) _Pragma("unroll") for (int bj = 0; bj < 2; ++bj) _Pragma("unroll") for (int m = 0; m < 4; ++m)
#define ACC_FOR(ai, bj, m, n) _Pragma("unroll") for (int ai = 0; ai < 2; ++ai) _Pragma("unroll") for (int bj = 0; bj < 2; ++bj) _Pragma("unroll") for (int m = 0; m < 4; ++m) _Pragma("unroll") for (int n = 0; n < 2; ++n)

__device__ __forceinline__ void cvt_tile(const float* __restrict__ src, int N, int K, int k0, int n0, bf16_t* __restrict__ dst, long drow0, const float* __restrict__ kscale, float* lds) {
  const int tid = otid();
  { const int kr = tid >> 6, n = tid & 63;
#pragma unroll
    for (int i = 0; i < 8; ++i) { const int k = kr + 8 * i; float v = (n0 + n < N) ? src[(size_t)(k0 + k) * N + n0 + n] : 0.f; if (kscale) v *= kscale[k0 + k]; lds[k * 65 + n] = v; } }
  __syncthreads();
  { const int n = tid >> 3, k8 = (tid & 7) * 8; float v[8];
#pragma unroll
    for (int i = 0; i < 8; ++i) v[i] = lds[(k8 + i) * 65 + n];
    u32x4 w = {cvtpk(v[0], v[1]), cvtpk(v[2], v[3]), cvtpk(v[4], v[5]), cvtpk(v[6], v[7])};
    *(u32x4*)(dst + (size_t)(drow0 + n) * K + k0 + k8) = w; }
  __syncthreads();
}

__device__ void phase_prep(PRef p, char* smem) {
  float* lds = (float*)smem;
  bf16_t* Wt_in = (bf16_t*)(p.ws + WS_WIN); bf16_t* Wt_uq = (bf16_t*)(p.ws + WS_WUQ); bf16_t* Wt_ukv = (bf16_t*)(p.ws + WS_WUKV); bf16_t* Wt_out = (bf16_t*)(p.ws + WS_WOUT);
  float* mod = (float*)(p.ws + WS_MOD);
  constexpr int T_MOD = 192, T_IN = 2 * 16 * 44, T_UQ = 2 * 6 * 12, T_UKV = 2 * 4 * 16, T_OUT = 2 * 16 * 16, T_ROPE = 64;
  constexpr int E0 = T_MOD, E1 = E0 + T_IN, E2 = E1 + T_UQ, E3 = E2 + T_UKV, E4 = E3 + T_OUT, E5 = E4 + T_ROPE;
  const int tid = otid();
  for (int task = obid(); task < E5; task += gridDim.x) {
    if (task < E0) {
      const int l = task / 96, j0 = (task % 96) * 64;
      float* sc = lds;
      for (int i = tid; i < 9 * 1024; i += 512) { const int bb = i >> 10, d = i & 1023; const float v = bb < 8 ? p.c[bb * 1024 + d] : p.c_ctx[d]; sc[i] = v / (1.f + expf(-v)); }
      __syncthreads();
      const int col = tid & 63, ks = tid >> 6; float a[9];
#pragma unroll
      for (int bb = 0; bb < 9; ++bb) a[bb] = 0.f;
      const float* wm = p.w_mod + (size_t)l * 1024 * 6144 + j0 + col;
      for (int d = ks * 128; d < ks * 128 + 128; ++d) { const float w = wm[(size_t)d * 6144];
#pragma unroll
        for (int bb = 0; bb < 9; ++bb) a[bb] += sc[bb * 1024 + d] * w; }
      float* red = lds + 9 * 1024;
#pragma unroll
      for (int bb = 0; bb < 9; ++bb) red[(ks * 9 + bb) * 64 + col] = a[bb];
      __syncthreads();
      for (int i = tid; i < 9 * 64; i += 512) { const int bb = i >> 6, cc = i & 63; float s = 0.f;
        for (int k = 0; k < 8; ++k) s += red[(k * 9 + bb) * 64 + cc];
        mod[((size_t)l * 9 + bb) * 6144 + j0 + cc] = s + p.b_mod[l * 6144 + j0 + cc]; }
      __syncthreads();
    } else if (task < E1) { const int t = task - E0, l = t / 704, r = t % 704, kt = r / 44, nt = r % 44;
      cvt_tile(p.w_in + (size_t)l * 1024 * IN_COLS, IN_COLS, 1024, kt * 64, nt * 64, Wt_in + (size_t)l * PLD * 1024, nt * 64, nullptr, lds);
    } else if (task < E2) { const int t = task - E1, l = t / 72, r = t % 72, kt = r / 12, nt = r % 12;
      cvt_tile(p.w_uq + (size_t)l * 384 * 768, 768, 384, kt * 64, nt * 64, Wt_uq + (size_t)l * 768 * 384, nt * 64, p.q_norm_w + l * 384, lds);
    } else if (task < E3) { const int t = task - E2, l = t / 64, r = t % 64, kt = r / 16, nt = r % 16;
      cvt_tile(p.w_ukv + (size_t)l * 256 * 1024, 1024, 256, kt * 64, nt * 64, Wt_ukv + (size_t)l * 1024 * 256, nt * 64, p.kv_norm_w + l * 256, lds);
    } else if (task < E4) { const int t = task - E3, l = t / 256, r = t % 256, kt = r / 16, nt = r % 16;
      cvt_tile(p.w_out + (size_t)l * 1024 * 1024, 1024, 1024, kt * 64, nt * 64, Wt_out + (size_t)l * 1024 * 1024, nt * 64, nullptr, lds);
    } else {
      float* cs = (float*)(p.ws + WS_COS); float* sn = (float*)(p.ws + WS_SIN);
      for (int i = (task - E4) * 4096 + tid; i < (task - E4 + 1) * 4096; i += 512) { const int t = i >> 5, j = i & 31;
        const float inv = exp2f(-(float)(j & 15) * (13.287712379549449f / 16.f));
        const float pos = (float)(j < 16 ? (t >> 6) : (t & 63)); const float ang = pos * inv;
        const double a = (double)ang; const double k = rint(a * 0.15915494309189535); const float r = (float)(a - k * 6.283185307179586);
        cs[i] = __cosf(r); sn[i] = __sinf(r); }
    }
  }
}

__device__ void phase_cvt_experts(PRef p, int l, char* smem) {
  float* lds = (float*)smem;
  bf16_t* Wgu = (bf16_t*)(p.ws + WS_WGU); bf16_t* Wdn = (bf16_t*)(p.ws + WS_WDN);
  const int tid = otid();
  for (int task = obid(); task < NE * 192; task += gridDim.x) {
    const int e = task / 192, r = task % 192, which = r >> 6, kt = (r & 63) >> 2, nt = r & 3, k0 = kt * 64, n0 = nt * 256;
    const float* src = (which == 0 ? p.w_gate : which == 1 ? p.w_up : p.w_down) + ((size_t)l * NE + e) * 1024 * 1024;
    { const int kr = tid >> 6, n4 = (tid & 63) * 4;
#pragma unroll
      for (int i = 0; i < 8; ++i) { const int k = kr + 8 * i; *(f32x4*)(lds + k * 260 + n4) = *(const f32x4*)(src + (size_t)(k0 + k) * 1024 + n0 + n4); } }
    __syncthreads();
    { const int nl = tid & 255, k32 = (tid >> 8) * 32, n = n0 + nl;
      const size_t drow = which == 2 ? (size_t)n : (size_t)((n >> 7) * 256 + which * 128 + (n & 127));
      bf16_t* dst = (which == 2 ? Wdn + (size_t)e * 1024 * 1024 : Wgu + (size_t)e * 2048 * 1024) + drow * 1024 + k0 + k32;
#pragma unroll
      for (int q = 0; q < 4; ++q) { float v[8];
#pragma unroll
        for (int i = 0; i < 8; ++i) v[i] = lds[(k32 + q * 8 + i) * 260 + nl];
        u32x4 w = {cvtpk(v[0], v[1]), cvtpk(v[2], v[3]), cvtpk(v[4], v[5]), cvtpk(v[6], v[7])};
        *(u32x4*)(dst + q * 8) = w; } }
    __syncthreads();
  }
}

__device__ __forceinline__ void ln_row(f32x4 (&v)[4], float eps) {
  float s = 0.f;
#pragma unroll
  for (int i = 0; i < 4; ++i) s += v[i][0] + v[i][1] + v[i][2] + v[i][3];
  const float mu = wave_sum(s) * (1.f / 1024.f);
  float q = 0.f;
#pragma unroll
  for (int i = 0; i < 4; ++i)
#pragma unroll
    for (int k = 0; k < 4; ++k) { v[i][k] -= mu; q += v[i][k] * v[i][k]; }
  const float rs = rsqrtf(wave_sum(q) * (1.f / 1024.f) + eps);
#pragma unroll
  for (int i = 0; i < 4; ++i) v[i] *= rs;
}
__device__ __forceinline__ void store_mod_bf16(const f32x4 (&v)[4], const float* __restrict__ shift, const float* __restrict__ scale, bf16_t* __restrict__ hrow, int lane, f32x4 (*keep)[4]) {
#pragma unroll
  for (int i = 0; i < 4; ++i) { const int c = lane * 4 + 256 * i; const f32x4 sh = *(const f32x4*)(shift + c), sc = *(const f32x4*)(scale + c);
    f32x4 o = v[i] * (sc + 1.f) + sh; if (keep) (*keep)[i] = o;
    u32x2 w = {cvtpk(o[0], o[1]), cvtpk(o[2], o[3])}; *(u32x2*)(hrow + c) = w; }
}
__device__ __forceinline__ const float* mod_ptr(PRef p, int l, int row, int which) {
  const int bb = row < MX ? (row >> 13) : 8;
  return (const float*)(p.ws + WS_MOD) + ((size_t)l * 9 + bb) * 6144 + which * 1024;
}

__device__ void phase_h0(PRef p) {
  const int lane = otid() & 63, gw = obid() * 8 + (otid() >> 6), nw = gridDim.x * 8;
  bf16_t* h = (bf16_t*)(p.ws + WS_H);
  for (int row = gw; row < MT; row += nw) {
    const float* src = row < MX ? p.x + (size_t)row * 1024 : p.ctx + (size_t)(row - MX) * 1024;
    f32x4 v[4];
#pragma unroll
    for (int i = 0; i < 4; ++i) v[i] = *(const f32x4*)(src + lane * 4 + 256 * i);
    ln_row(v, 1e-6f);
    store_mod_bf16(v, mod_ptr(p, 0, row, 0), mod_ptr(p, 0, row, 1), h + (size_t)row * 1024, lane, nullptr);
  }
}

__device__ void phase_inproj(PRef p, int l, char* smem) {
  LAS unsigned char* lds = (LAS unsigned char*)smem;
  const bf16_t* h = (const bf16_t*)(p.ws + WS_H); const bf16_t* Wt = (const bf16_t*)(p.ws + WS_WIN) + (size_t)l * PLD * 1024;
  bf16_t* P = (bf16_t*)(p.ws + WS_P); float* gates = (float*)(p.ws + WS_GATES);
  const int tid = otid(), wid = tid >> 6, lane = tid & 63, wr = wid >> 2, wc = wid & 3, fr = lane & 15, fq = lane >> 4;
  g8::TileIter it; it.init(MT / 256, PLD / 256);
  int pm, pn;
  while (it.next(pm, pn)) {
    unsigned voffA[2] = {g8::piece_off(0, 1024, 0), g8::piece_off(1, 1024, 0)};
    f32x4 acc[2][2][4][2];
    g8::gemm_tile<false>(lds, (const char*)(h + (size_t)pm * 256 * 1024), voffA, (size_t)128 * 1024 * 2, (const char*)(Wt + (size_t)pn * 256 * 1024), 1024, acc);
    ACC_FOR3(ai, bj, m) {
      const int row = pm * 256 + ai * 128 + wr * 64 + m * 16 + fr, col = pn * 256 + bj * 128 + wc * 32 + fq * 8;
      const f32x4 v0 = acc[ai][bj][m][0], v1 = acc[ai][bj][m][1];
      u32x4 w = {cvtpk(v0[0], v0[1]), cvtpk(v0[2], v0[3]), cvtpk(v1[0], v1[1]), cvtpk(v1[2], v1[3])}; *(u32x4*)(P + (size_t)row * PLD + col) = w;
      if (col >= OFF_G && col < OFF_G + 16) { const f32x4 bg0 = *(const f32x4*)(p.b_gates + l * 16 + (col - OFF_G)), bg1 = *(const f32x4*)(p.b_gates + l * 16 + (col - OFF_G) + 4);
        *(f32x4*)(gates + (size_t)row * 16 + (col - OFF_G)) = v0 + bg0; *(f32x4*)(gates + (size_t)row * 16 + (col - OFF_G) + 4) = v1 + bg1; }
    }
  }
}


constexpr size_t WS_QKC = WS_KV;
constexpr size_t WS_SCAL = WS_Q;
__device__ void phase_mlstm_pre(PRef p, int l, char* smem) {
  const bf16_t* P = (const bf16_t*)(p.ws + WS_P); const float* gates = (const float*)(p.ws + WS_GATES);
  bf16_t* QKC = (bf16_t*)(p.ws + WS_QKC); float* SCAL = (float*)(p.ws + WS_SCAL);
  const int tid = otid(), wid = tid >> 6, lane = tid & 63;
  if (obid() < 64) {
    const int chain = obid(), dir = chain & 1, hd = (chain >> 1) & 3, b = chain >> 3;
    float* LA = (float*)smem; float* LB = LA + 132 * 64; float* LP = LB + 132 * 64; float* b63s = LP + 132 * 64; float* pm63s = b63s + 132; float* mbs = pm63s + 132;
    for (int ci = wid; ci < 132; ci += 8) {
      const bool ic = ci < 4; const int cc = ic ? ci : ci - 4, T = ic ? CTXL : SEQ, rb = ic ? MX + b * CTXL : b * SEQ, tlo = dir ? T - 64 - cc * 64 : cc * 64;
      const int t = dir ? tlo + 63 - lane : tlo + lane; const float* g = gates + (size_t)(rb + t) * 16;
      const float ig = g[dir * 8 + hd], fg = g[dir * 8 + 4 + hd];
      const float lf = fminf(fg, 0.f) - log1pf(expf(-fabsf(fg)));
      float bc = lf;
#pragma unroll
      for (int o = 1; o < 64; o <<= 1) { const float u = __shfl_up(bc, o); if (lane >= o) bc += u; }
      const float a = ig - bc; float pmx = a;
#pragma unroll
      for (int o = 1; o < 64; o <<= 1) { const float u = __shfl_up(pmx, o); if (lane >= o) pmx = fmaxf(pmx, u); }
      LA[ci * 64 + lane] = a; LB[ci * 64 + lane] = bc; LP[ci * 64 + lane] = pmx;
      if (lane == 63) { b63s[ci] = bc; pm63s[ci] = pmx; }
    }
    __syncthreads();
    if (tid == 0) { float m = 0.f; for (int ci = 0; ci < 132; ++ci) { mbs[ci] = m; m = b63s[ci] + fmaxf(pm63s[ci], m); } }
    __syncthreads();
    for (int ci = wid; ci < 132; ci += 8) {
      const float m = mbs[ci], a = LA[ci * 64 + lane], bc = LB[ci * 64 + lane], pmx = LP[ci * 64 + lane];
      const float Mx = fmaxf(pmx, m), M63 = fmaxf(pm63s[ci], m);
      float* S = SCAL + ((size_t)chain * 132 + ci) * 384;
      S[lane] = a; S[64 + lane] = Mx; S[128 + lane] = __expf(m - Mx); S[192 + lane] = __expf(-(bc + Mx)); S[256 + lane] = __expf(a - M63);
      S[320 + lane] = lane == 0 ? __expf(m - M63) : 0.f;
    }
    return;
  }
  const int col8 = (tid & 127) * 8, rg = tid >> 7;
  float w[5][8], bia[8];
#pragma unroll
  for (int j = 0; j < 5; ++j) { const f32x4 w0 = *(const f32x4*)(p.conv_w + ((size_t)l * 5 + j) * 1024 + col8), w1 = *(const f32x4*)(p.conv_w + ((size_t)l * 5 + j) * 1024 + col8 + 4);
#pragma unroll
    for (int k = 0; k < 4; ++k) { w[j][k] = w0[k]; w[j][4 + k] = w1[k]; } }
  { const f32x4 b0 = *(const f32x4*)(p.conv_b + l * 1024 + col8), b1 = *(const f32x4*)(p.conv_b + l * 1024 + col8 + 4);
#pragma unroll
    for (int k = 0; k < 4; ++k) { bia[k] = b0[k]; bia[4 + k] = b1[k]; } }
  const float osc = col8 < 512 ? 0.08838834764831845f : 1.f;
#pragma unroll 1
  for (int rb = obid() - 64; rb < MT / 64; rb += gridDim.x - 64) {
    const int R0 = rb * 64, seg_lo = R0 < MX ? (R0 & ~8191) : MX + ((R0 - MX) & ~255), seg_hi = seg_lo + (R0 < MX ? SEQ : CTXL);
    const int r0 = R0 + rg * 16;
    u32x4 raw[20];
#pragma unroll
    for (int i = 0; i < 20; ++i) { const int r = r0 - 2 + i; raw[i] = (u32x4){0u, 0u, 0u, 0u}; if (r >= seg_lo && r < seg_hi) raw[i] = *(const u32x4*)(P + (size_t)r * PLD + col8); }
#pragma unroll
    for (int i = 0; i < 16; ++i) {
      float y[8];
#pragma unroll
      for (int k = 0; k < 8; ++k) y[k] = bia[k];
#pragma unroll
      for (int tp = 0; tp < 5; ++tp) {
#pragma unroll
        for (int k = 0; k < 4; ++k) { y[2 * k] += w[tp][2 * k] * bflo(raw[i + tp][k]); y[2 * k + 1] += w[tp][2 * k + 1] * bfhi(raw[i + tp][k]); } }
#pragma unroll
      for (int k = 0; k < 8; ++k) y[k] = silu_f(y[k]) * osc;
      u32x4 o = {cvtpk(y[0], y[1]), cvtpk(y[2], y[3]), cvtpk(y[4], y[5]), cvtpk(y[6], y[7])};
      *(u32x4*)(QKC + (size_t)(r0 + i) * 1024 + col8) = o;
    }
  }
}

__device__ void phase_mlstm(PRef p, int l, char* smem) {
  bf16_t* QBb[2] = {(bf16_t*)(smem), (bf16_t*)(smem + 17408)};
  bf16_t* KB = (bf16_t*)(smem + 34816);
  bf16_t* KT = (bf16_t*)(smem + 52224);
  bf16_t* VTb[2] = {(bf16_t*)(smem + 70656), (bf16_t*)(smem + 77568)};
  bf16_t* VWT = (bf16_t*)(smem + 84480);
  bf16_t* PB = (bf16_t*)(smem + 91392);
  bf16_t* CTb[2] = {(bf16_t*)(smem + 100608), (bf16_t*)(smem + 113664)};
  float* SC = (float*)(smem + 126720);
  const bf16_t* P = (const bf16_t*)(p.ws + WS_P); const bf16_t* QKC = (const bf16_t*)(p.ws + WS_QKC); const float* SCAL = (const float*)(p.ws + WS_SCAL);
  bf16_t* hbuf = (bf16_t*)(p.ws + WS_HB);
  for (int w = obid(); w < 256; w += gridDim.x) {
    const int slice = (w >> 3) & 3, chain = (w & 7) * 8 + (w >> 5), dir = chain & 1, hd = (chain >> 1) & 3, b = chain >> 3;
    const float* SCc = SCAL + (size_t)chain * 132 * 384;
    __syncthreads();
    { const int tid = otid();
      for (int i = tid; i < 48 * 136 / 2; i += 512) { ((unsigned*)CTb[0])[i] = 0u; ((unsigned*)CTb[1])[i] = 0u; }
      for (int i = tid; i < 48 * 72 / 2; i += 512) { ((unsigned*)VTb[0])[i] = 0u; ((unsigned*)VTb[1])[i] = 0u; ((unsigned*)VWT)[i] = 0u; } }
    f32x4 accC[3];
#pragma unroll
    for (int i = 0; i < 3; ++i) accC[i] = (f32x4){0.f, 0.f, 0.f, 0.f};
    struct Pre { u32x4 qk[4]; u32x2 v; f32x4 s; float ws, ws1; };
    Pre preA, preB;
    preA.s = (f32x4){0.f, 0.f, 0.f, 0.f}; preB.s = preA.s;
#define MLSTM_PREFETCH(PR, CI) do { const int tid_ = otid(); const int ci_ = (CI); const bool ic_ = ci_ < 4; const int cc_ = ic_ ? ci_ : ci_ - 4, T_ = ic_ ? CTXL : SEQ, rb_ = ic_ ? MX + b * CTXL : b * SEQ; \
      const int tlo_ = dir ? T_ - 64 - cc_ * 64 : cc_ * 64; \
      _Pragma("unroll") for (int k_ = 0; k_ < 4; ++k_) { const int pc = tid_ + k_ * 512, tens = pc >> 10, rem = pc & 1023, lr = rem & 63, c16 = rem >> 6, t = dir ? tlo_ + 63 - lr : tlo_ + lr; \
        PR.qk[k_] = *(const u32x4*)(QKC + (size_t)(rb_ + t) * 1024 + tens * 512 + hd * 128 + c16 * 8); } \
      { const int vl_ = tid_ & 63, vt_ = dir ? tlo_ + 63 - vl_ : tlo_ + vl_; PR.v = *(const u32x2*)(P + (size_t)(rb_ + vt_) * PLD + OFF_V + hd * 128 + slice * 32 + (tid_ >> 6) * 4); \
        PR.ws = SCc[(size_t)ci_ * 384 + 256 + vl_]; PR.ws1 = SCc[(size_t)ci_ * 384 + 256 + (tid_ & 63)]; } \
      if (tid_ < 96) PR.s = *(const f32x4*)(SCc + (size_t)ci_ * 384 + tid_ * 4); } while (0)
    MLSTM_PREFETCH(preA, 0);
    MLSTM_PREFETCH(preB, 1);
    __syncthreads();
    auto step = [&](const int ci, Pre& pre) __attribute__((always_inline)) {
      const int tid = otid(), wid = tid >> 6, lane = tid & 63, fr = lane & 15, fq = lane >> 4;
      const bool isctx = ci < 4; const int cc = isctx ? ci : ci - 4, T = isctx ? CTXL : SEQ, rowbase = isctx ? MX + b * CTXL : b * SEQ;
      const int tlo = dir ? T - 64 - cc * 64 : cc * 64;
      const int par = ci & 1;
      bf16_t* QB = QBb[par]; bf16_t* VT = VTb[par]; float* S = SC + par * 384; bf16_t* CTc = CTb[par]; bf16_t* CTn = CTb[par ^ 1];
      const bool need_out = !(l == DEPTH - 1 && isctx);
#pragma unroll
      for (int k = 0; k < 4; ++k) { const int pc = tid + k * 512, tens = pc >> 10, rem = pc & 1023, lr = rem & 63, c16 = rem >> 6;
        if (tens == 0) *(u32x4*)(QB + lr * 136 + c16 * 8) = pre.qk[k];
        else { *(u32x4*)(KB + lr * 136 + c16 * 8) = pre.qk[k];
#pragma unroll
          for (int i = 0; i < 4; ++i) { KT[(c16 * 8 + 2 * i) * 72 + lr] = (bf16_t)(pre.qk[k][i] & 0xffffu); KT[(c16 * 8 + 2 * i + 1) * 72 + lr] = (bf16_t)(pre.qk[k][i] >> 16); } } }
      { const int vl = tid & 63, ve4 = (tid >> 6) * 4; const float wsl = pre.ws;
        VT[(ve4 + 0) * 72 + vl] = (bf16_t)(pre.v[0] & 0xffffu); VT[(ve4 + 1) * 72 + vl] = (bf16_t)(pre.v[0] >> 16);
        VT[(ve4 + 2) * 72 + vl] = (bf16_t)(pre.v[1] & 0xffffu); VT[(ve4 + 3) * 72 + vl] = (bf16_t)(pre.v[1] >> 16);
        VWT[(ve4 + 0) * 72 + vl] = f2bf(bflo(pre.v[0]) * wsl); VWT[(ve4 + 1) * 72 + vl] = f2bf(bfhi(pre.v[0]) * wsl);
        VWT[(ve4 + 2) * 72 + vl] = f2bf(bflo(pre.v[1]) * wsl); VWT[(ve4 + 3) * 72 + vl] = f2bf(bfhi(pre.v[1]) * wsl);
        if (tid < 64) { VT[32 * 72 + tid] = (bf16_t)0x3F80u; VWT[32 * 72 + tid] = f2bf(pre.ws1); }
        if (tid < 96) *(f32x4*)(S + tid * 4) = pre.s; }
      if (ci + 2 < 132) MLSTM_PREFETCH(pre, ci + 2);
      __syncthreads();
      if (need_out) {
        const int mt = wid >> 1;
#pragma unroll
        for (int u = 0; u < 2; ++u) {
          const int ntl = (wid & 1) * 2 + u;
          f32x4 sacc = {0.f, 0.f, 0.f, 0.f};
          if (ntl <= mt) {
#pragma unroll
            for (int kk = 0; kk < 4; ++kk) {
              const bf16x8 a = *(const bf16x8*)(QB + (mt * 16 + fr) * 136 + kk * 32 + fq * 8), bb = *(const bf16x8*)(KB + (ntl * 16 + fr) * 136 + kk * 32 + fq * 8);
              sacc = __builtin_amdgcn_mfma_f32_16x16x32_bf16(a, bb, sacc, 0, 0, 0); }
          }
          const int j = ntl * 16 + fr; const float aj = S[j];
#pragma unroll
          for (int jj = 0; jj < 4; ++jj) { const int lr = mt * 16 + fq * 4 + jj;
            const float pv = (j <= lr) ? sacc[jj] * __expf(fminf(aj - S[64 + lr], 0.f)) : 0.f;
            PB[lr * 72 + j] = f2bf(pv); }
        }
      }
      {
        const float decay = S[320];
#pragma unroll
        for (int mt = 0; mt < 3; ++mt) {
          accC[mt] *= decay;
#pragma unroll
          for (int kk = 0; kk < 2; ++kk) { const bf16x8 a = *(const bf16x8*)(VWT + (mt * 16 + fr) * 72 + kk * 32 + fq * 8), bb = *(const bf16x8*)(KT + (wid * 16 + fr) * 72 + kk * 32 + fq * 8);
            accC[mt] = __builtin_amdgcn_mfma_f32_16x16x32_bf16(a, bb, accC[mt], 0, 0, 0); }
#pragma unroll
          for (int jj = 0; jj < 4; ++jj) CTn[(mt * 16 + fq * 4 + jj) * 136 + wid * 16 + fr] = f2bf(accC[mt][jj]);
        }
      }
      __syncthreads();
      if (need_out && wid < 4) {
        const int mt = wid; f32x4 num[3];
#pragma unroll
        for (int ntl = 0; ntl < 3; ++ntl) {
          f32x4 a1 = {0.f, 0.f, 0.f, 0.f}, a2 = {0.f, 0.f, 0.f, 0.f};
#pragma unroll
          for (int kk = 0; kk < 2; ++kk) { const bf16x8 a = *(const bf16x8*)(PB + (mt * 16 + fr) * 72 + kk * 32 + fq * 8), bb = *(const bf16x8*)(VT + (ntl * 16 + fr) * 72 + kk * 32 + fq * 8);
            a1 = __builtin_amdgcn_mfma_f32_16x16x32_bf16(a, bb, a1, 0, 0, 0); }
#pragma unroll
          for (int kk = 0; kk < 4; ++kk) { const bf16x8 a = *(const bf16x8*)(QB + (mt * 16 + fr) * 136 + kk * 32 + fq * 8), bb = *(const bf16x8*)(CTc + (ntl * 16 + fr) * 136 + kk * 32 + fq * 8);
            a2 = __builtin_amdgcn_mfma_f32_16x16x32_bf16(a, bb, a2, 0, 0, 0); }
#pragma unroll
          for (int jj = 0; jj < 4; ++jj) num[ntl][jj] = a1[jj] + S[128 + mt * 16 + fq * 4 + jj] * a2[jj];
        }
#pragma unroll
        for (int jj = 0; jj < 4; ++jj) {
          const int lr = mt * 16 + fq * 4 + jj; const float den = __shfl(num[2][jj], lane & 48);
          const float rd = __builtin_amdgcn_rcpf(fmaxf(fabsf(den), S[192 + lr]));
          const int t = dir ? tlo + 63 - lr : tlo + lr;
          bf16_t* hp = hbuf + ((size_t)((dir * 4 + hd) * 4 + slice) * MT + rowbase + t) * 32 + fr;
          hp[0] = f2bf(num[0][jj] * rd); hp[16] = f2bf(num[1][jj] * rd);
        }
      }
    };
#pragma unroll 1
    for (int ci = 0; ci < 132; ci += 2) { step(ci, preA); step(ci + 1, preB); }
    __syncthreads();
  }
#undef MLSTM_PREFETCH
}

template <int WHICH>
__device__ __forceinline__ void mla_gemm(PRef p, int l, char* smem) {
  LAS unsigned char* lds = (LAS unsigned char*)smem; float* rsb = (float*)(smem + g8::STAGE_BYTES);
  const bf16_t* P = (const bf16_t*)(p.ws + WS_P);
  const int tid = otid(), wid = tid >> 6, lane = tid & 63, wr = wid >> 2, wc = wid & 3, fr = lane & 15, fq = lane >> 4;
  constexpr int K = WHICH ? 256 : 384, OFFC = WHICH ? OFF_CKV : OFF_CQ, N = WHICH ? 1024 : 768;
  const bf16_t* Wt = WHICH ? (const bf16_t*)(p.ws + WS_WUKV) + (size_t)l * 1024 * 256 : (const bf16_t*)(p.ws + WS_WUQ) + (size_t)l * 768 * 384;
  bf16_t* O = (bf16_t*)(p.ws + (WHICH ? WS_KV : WS_Q));
  g8::TileIter it; it.init((WHICH || l == 0) ? MT / 256 : MX / 256, N / 256);
  int pm, pn;
  while (it.next(pm, pn)) {
    __syncthreads();
    { const int r = tid >> 1, hf = tid & 1; const bf16_t* src = P + (size_t)(pm * 256 + r) * PLD + OFFC + hf * (K / 2); float s = 0.f;
#pragma unroll 4
      for (int i = 0; i < K / 16; ++i) { const u32x4 v = *(const u32x4*)(src + i * 8);
#pragma unroll
        for (int k = 0; k < 4; ++k) { const float a = bflo(v[k]), bq = bfhi(v[k]); s += a * a + bq * bq; } }
      s += __shfl_xor(s, 1);
      if (hf == 0) rsb[r] = rsqrtf(s / (float)K + 1e-6f); }
    unsigned voffA[2] = {g8::piece_off(0, PLD, OFFC), g8::piece_off(1, PLD, OFFC)};
    f32x4 acc[2][2][4][2];
    g8::gemm_tile<false>(lds, (const char*)(P + (size_t)pm * 256 * PLD), voffA, (size_t)128 * PLD * 2, (const char*)(Wt + (size_t)pn * 256 * K), opaque_s(K), acc);
    ACC_FOR3(ai, bj, m) {
      const int rl = ai * 128 + wr * 64 + m * 16 + fr, row = pm * 256 + rl, col = pn * 256 + bj * 128 + wc * 32 + fq * 8;
      const float rs = rsb[rl]; const f32x4 v0 = acc[ai][bj][m][0] * rs, v1 = acc[ai][bj][m][1] * rs;
      size_t orow = row;
      if (WHICH) orow = row < MX ? (size_t)(row >> 13) * SKV + CTXL + (row & 8191) : (size_t)((row - MX) >> 8) * SKV + ((row - MX) & 255);
      u32x4 w = {cvtpk(v0[0], v0[1]), cvtpk(v0[2], v0[3]), cvtpk(v1[0], v1[1]), cvtpk(v1[2], v1[3])}; *(u32x4*)(O + orow * N + col) = w;
    }
  }
}
__device__ void phase_mla_prep(PRef p, int l, char* smem) {
  mla_gemm<0>(p, l, smem);
  mla_gemm<1>(p, l, smem);
  const bf16_t* P = (const bf16_t*)(p.ws + WS_P);
  const int tid = otid(), wid = tid >> 6, lane = tid & 63;
  const bf16_t* hbuf = (const bf16_t*)(p.ws + WS_HB); bf16_t* mix = (bf16_t*)(p.ws + WS_MIX); bf16_t* KR = (bf16_t*)(p.ws + WS_KR);
  const float* cs = (const float*)(p.ws + WS_COS); const float* sn = (const float*)(p.ws + WS_SIN);
  const int gw = obid() * 8 + wid, nw = gridDim.x * 8;
  for (int row = gw; row < MT; row += nw) {
    if (row < MX || l == 0) {
      const size_t ho = ((size_t)(lane >> 2) * MT + row) * 32 + (lane & 3) * 8;
      const u32x4 hf = *(const u32x4*)(hbuf + ho), hb = *(const u32x4*)(hbuf + (size_t)16 * MT * 32 + ho);
      const u32x4 ov = *(const u32x4*)(P + (size_t)row * PLD + OFF_O + lane * 8);
      float v[8]; float s = 0.f;
#pragma unroll
      for (int k = 0; k < 4; ++k) { v[2 * k] = bflo(hf[k]) + bflo(hb[k]); v[2 * k + 1] = bfhi(hf[k]) + bfhi(hb[k]); s += v[2 * k] + v[2 * k + 1]; }
      s += __shfl_xor(s, 1); s += __shfl_xor(s, 2); s += __shfl_xor(s, 4); s += __shfl_xor(s, 8);
      const float mu = s * (1.f / 128.f); float q = 0.f;
#pragma unroll
      for (int k = 0; k < 8; ++k) { v[k] -= mu; q += v[k] * v[k]; }
      q += __shfl_xor(q, 1); q += __shfl_xor(q, 2); q += __shfl_xor(q, 4); q += __shfl_xor(q, 8);
      const float rs = rsqrtf(q * (1.f / 128.f) + 1e-6f);
      const float* nw_ = p.m_norm_w + l * 512 + lane * 8; float o[8];
#pragma unroll
      for (int k = 0; k < 4; ++k) { o[2 * k] = v[2 * k] * rs * nw_[2 * k] * sigmoid_f(bflo(ov[k])); o[2 * k + 1] = v[2 * k + 1] * rs * nw_[2 * k + 1] * sigmoid_f(bfhi(ov[k])); }
      u32x4 wv = {cvtpk(o[0], o[1]), cvtpk(o[2], o[3]), cvtpk(o[4], o[5]), cvtpk(o[6], o[7])};
      *(u32x4*)(mix + (size_t)row * 1024 + lane * 8) = wv;
    }
    {
      const int j = lane & 31;
      const float x1 = bf2f(P[(size_t)row * PLD + OFF_KR + j]), x2 = bf2f(P[(size_t)row * PLD + OFF_KR + 32 + j]);
      float o1 = x1, o2 = x2; size_t orow;
      if (row < MX) { const int t = row & 8191; const float c = cs[t * 32 + j], s_ = sn[t * 32 + j]; o1 = x1 * c - x2 * s_; o2 = x2 * c + x1 * s_; orow = (size_t)(row >> 13) * SKV + CTXL + t; }
      else orow = (size_t)((row - MX) >> 8) * SKV + ((row - MX) & 255);
      if (lane < 32) { KR[orow * 64 + j] = f2bf(o1); KR[orow * 64 + 32 + j] = f2bf(o2); }
    }
  }
}

namespace att {
constexpr int NW = 8, QBLK = 32, KVBLK = 64, LDQ = 768, LDK = 1024, LDKR = 64, LDO = 1024;
constexpr float SCALE = A_SCALE;
constexpr float THR = 8.f;
constexpr size_t SHM_V = KVBLK * 128 * 2, SHM_K = KVBLK * 128 * 2, SHM_R = KVBLK * 64 * 2;
typedef float f32x8 __attribute__((ext_vector_type(8)));
#define KSWZ(row, colB) ((row) * 256 + ((colB) ^ (((row) & 15) << 4)))
#define RSWZ(row, colB) ((row) * 128 + ((colB) ^ ((((row) >> 1) & 7) << 4)))
#define SBAR() __builtin_amdgcn_sched_barrier(0)
__device__ __forceinline__ int crow(int r, int hi) { return (r & 3) + 8 * (r >> 2) + 4 * hi; }
__device__ __forceinline__ void partialSM(f32x16& p0, f32x16& p1, float& m_reg, float& mn, float& alpha) {
  constexpr float C = SCALE * 1.4426950408889634f;
  float pmax = p0[0];
#pragma unroll
  for (int r = 1; r < 16; ++r) pmax = fmaxf(pmax, p0[r]);
#pragma unroll
  for (int r = 0; r < 16; ++r) pmax = fmaxf(pmax, p1[r]);
  { auto rr = __builtin_amdgcn_permlane32_swap(__float_as_uint(pmax), __float_as_uint(pmax), false, false);
    pmax = fmaxf(__uint_as_float(rr[0]), __uint_as_float(rr[1])); }
  if (__builtin_expect(__all(pmax - m_reg <= THR / SCALE), 1)) { mn = m_reg; alpha = 1.f; }
  else { mn = fmaxf(m_reg, pmax); alpha = __builtin_amdgcn_exp2f((m_reg - mn) * C); m_reg = mn; }
  const float mnC = -mn * C;
#pragma unroll
  for (int r = 0; r < 16; ++r) p0[r] = fmaf(p0[r], C, mnC);
#pragma unroll
  for (int r = 0; r < 16; ++r) p1[r] = fmaf(p1[r], C, mnC);
#pragma unroll
  for (int r = 0; r < 16; ++r) p0[r] = __builtin_amdgcn_exp2f(p0[r]);
}
__device__ __forceinline__ void finishSM(f32x16& p0, f32x16& p1, float alpha, float& l_reg, bf16x8& pa0, bf16x8& pa1, bf16x8& pa2, bf16x8& pa3) {
#pragma unroll
  for (int r = 0; r < 16; ++r) p1[r] = __builtin_amdgcn_exp2f(p1[r]);
  float ps = 0;
#pragma unroll
  for (int r = 0; r < 16; ++r) ps += p0[r];
#pragma unroll
  for (int r = 0; r < 16; ++r) ps += p1[r];
  { auto rr = __builtin_amdgcn_permlane32_swap(__float_as_uint(ps), __float_as_uint(ps), false, false);
    ps = __uint_as_float(rr[0]) + __uint_as_float(rr[1]); }
  l_reg = l_reg * alpha + ps;
#define PK4(P, BASE, OUT) do { unsigned a0 = cvtpk(P[BASE + 0], P[BASE + 1]), a1 = cvtpk(P[BASE + 2], P[BASE + 3]);   \
    unsigned b0 = cvtpk(P[BASE + 4], P[BASE + 5]), b1 = cvtpk(P[BASE + 6], P[BASE + 7]);                              \
    auto r0 = __builtin_amdgcn_permlane32_swap(a0, b0, false, false); auto r1 = __builtin_amdgcn_permlane32_swap(a1, b1, false, false); \
    u32x4 w = {r0[0], r1[0], r0[1], r1[1]}; OUT = *reinterpret_cast<bf16x8*>(&w); } while (0)
  PK4(p0, 0, pa0); PK4(p0, 8, pa1); PK4(p1, 0, pa2); PK4(p1, 8, pa3);
#undef PK4
}
__device__ __forceinline__ void qkt(f32x16& p0, f32x16& p1, const char* Ks, const char* Rs, const bf16x8* qr, const char* qrl, int r32, int hi) {
  p0 = f32x16{}; p1 = f32x16{};
#pragma unroll
  for (int d0 = 0; d0 < 8; ++d0) { const int cb = (d0 * 16 + hi * 8) * 2;
    const bf16x8 b0 = *reinterpret_cast<const bf16x8*>(Ks + KSWZ(r32, cb));
    const bf16x8 b1 = *reinterpret_cast<const bf16x8*>(Ks + KSWZ(32 + r32, cb));
    p0 = __builtin_amdgcn_mfma_f32_32x32x16_bf16(b0, qr[d0], p0, 0, 0, 0);
    p1 = __builtin_amdgcn_mfma_f32_32x32x16_bf16(b1, qr[d0], p1, 0, 0, 0); }
#pragma unroll
  for (int d0 = 0; d0 < 4; ++d0) { const int cb = (d0 * 16 + hi * 8) * 2;
    const bf16x8 b0 = *reinterpret_cast<const bf16x8*>(Rs + RSWZ(r32, cb));
    const bf16x8 b1 = *reinterpret_cast<const bf16x8*>(Rs + RSWZ(32 + r32, cb));
    p0 = __builtin_amdgcn_mfma_f32_32x32x16_bf16(b0, qr[8 + d0], p0, 0, 0, 0);
    p1 = __builtin_amdgcn_mfma_f32_32x32x16_bf16(b1, qr[8 + d0], p1, 0, 0, 0); }
}
__device__ __forceinline__ int v_st(int k, int c) { const int kk = (k & ~0xC) | ((k & 4) << 1) | ((k & 8) >> 1); return ((kk >> 3) * 4 + (c >> 5)) * 512 + ((kk & 7) * 32 + (c & 31)) * 2; }
__device__ __forceinline__ int v_rd_base(int lane) { return ((lane & 3) << 3) | (((lane >> 2) & 3) << 6) | (((lane >> 4) & 1) << 5) | (((lane >> 5) & 1) << 8); }
constexpr int v_rd_off(int d0, int ks, int half) { return d0 * 512 + ks * 4096 + half * 2048; }
template <int OFF> __device__ __forceinline__ s16x4 tr_read(int vb) {
  s16x4 r; asm volatile("ds_read_b64_tr_b16 %0, %1 offset:%2" : "=&v"(r) : "v"(vb), "i"(OFF) : "memory"); return r;
}
template <int D0> __device__ __forceinline__ void pv_one(f32x16& od, int vb, bf16x8 pa0, bf16x8 pa1, bf16x8 pa2, bf16x8 pa3) {
  const s16x4 l0 = tr_read<v_rd_off(D0, 0, 0)>(vb), h0 = tr_read<v_rd_off(D0, 0, 1)>(vb), l1 = tr_read<v_rd_off(D0, 1, 0)>(vb), h1 = tr_read<v_rd_off(D0, 1, 1)>(vb);
  const s16x4 l2 = tr_read<v_rd_off(D0, 2, 0)>(vb), h2 = tr_read<v_rd_off(D0, 2, 1)>(vb), l3 = tr_read<v_rd_off(D0, 3, 0)>(vb), h3 = tr_read<v_rd_off(D0, 3, 1)>(vb);
  asm volatile("s_waitcnt lgkmcnt(0)" ::: "memory"); SBAR();
#define PK(L, H) (bf16x8){L[0], L[1], L[2], L[3], H[0], H[1], H[2], H[3]}
  od = __builtin_amdgcn_mfma_f32_32x32x16_bf16(pa0, PK(l0, h0), od, 0, 0, 0);
  od = __builtin_amdgcn_mfma_f32_32x32x16_bf16(pa1, PK(l1, h1), od, 0, 0, 0);
  od = __builtin_amdgcn_mfma_f32_32x32x16_bf16(pa2, PK(l2, h2), od, 0, 0, 0);
  od = __builtin_amdgcn_mfma_f32_32x32x16_bf16(pa3, PK(l3, h3), od, 0, 0, 0);
#undef PK
}
__device__ __forceinline__ void pv_d0(f32x16* o, int vb, bf16x8 pa0, bf16x8 pa1, bf16x8 pa2, bf16x8 pa3) {
  pv_one<0>(o[0], vb, pa0, pa1, pa2, pa3); pv_one<1>(o[1], vb, pa0, pa1, pa2, pa3); pv_one<2>(o[2], vb, pa0, pa1, pa2, pa3); pv_one<3>(o[3], vb, pa0, pa1, pa2, pa3);
}
__device__ __forceinline__ void attn_body(const bf16_t* __restrict__ Qb, const float* __restrict__ cs, const float* __restrict__ sn, const bf16_t* __restrict__ Kn,
                                          const bf16_t* __restrict__ Vh, const bf16_t* __restrict__ Kr, bf16_t* __restrict__ Ob, int seq, char* lds) {
  const int tid = otid(), wid = tid >> 6, lane = tid & 63, r32 = lane & 31, hi = lane >> 5;
  char* V_lds = lds; char* K_lds = lds + 2 * SHM_V; char* R_lds = lds + 2 * SHM_V + 2 * SHM_K;
  float* wsf = (float*)(lds + 2 * SHM_V + 2 * SHM_K + 2 * SHM_R) + wid * 64; float* li_l = wsf; float* al_l = wsf + 32;
  char* qrl = lds + 2 * SHM_V + 2 * SHM_K + 2 * SHM_R + 2048 + wid * 4096 + lane * 16;
  float m_reg = -1e30f, l_reg = 0; f32x16 o[4] = {}; bf16x8 qr[12];
  { const bf16_t* Qw = Qb + (size_t)(wid * QBLK + r32) * LDQ + hi * 8;
#pragma unroll
    for (int d0 = 0; d0 < 8; ++d0) qr[d0] = *(const bf16x8*)(Qw + d0 * 16);
#pragma unroll
    for (int d0 = 0; d0 < 2; ++d0) {
      const u32x4 a = *(const u32x4*)(Qw + 128 + d0 * 16), bq = *(const u32x4*)(Qw + 160 + d0 * 16);
      if (cs) {
        const float* cp = cs + (size_t)(wid * QBLK + r32) * 32 + d0 * 16 + hi * 8; const float* sp = sn + (size_t)(wid * QBLK + r32) * 32 + d0 * 16 + hi * 8;
        const f32x4 c0 = *(const f32x4*)cp, c1 = *(const f32x4*)(cp + 4), s0 = *(const f32x4*)sp, s1 = *(const f32x4*)(sp + 4);
        float x1[8], x2[8], y1[8], y2[8];
#pragma unroll
        for (int k = 0; k < 4; ++k) { x1[2 * k] = bflo(a[k]); x1[2 * k + 1] = bfhi(a[k]); x2[2 * k] = bflo(bq[k]); x2[2 * k + 1] = bfhi(bq[k]); }
#pragma unroll
        for (int k = 0; k < 8; ++k) { const float c = k < 4 ? c0[k & 3] : c1[k & 3], s = k < 4 ? s0[k & 3] : s1[k & 3]; y1[k] = x1[k] * c - x2[k] * s; y2[k] = x2[k] * c + x1[k] * s; }
        u32x4 w1 = {cvtpk(y1[0], y1[1]), cvtpk(y1[2], y1[3]), cvtpk(y1[4], y1[5]), cvtpk(y1[6], y1[7])}, w2 = {cvtpk(y2[0], y2[1]), cvtpk(y2[2], y2[3]), cvtpk(y2[4], y2[5]), cvtpk(y2[6], y2[7])};
        qr[8 + d0] = *reinterpret_cast<bf16x8*>(&w1); qr[10 + d0] = *reinterpret_cast<bf16x8*>(&w2);
      } else { u32x4 a_ = a, b_ = bq; qr[8 + d0] = *reinterpret_cast<bf16x8*>(&a_); qr[10 + d0] = *reinterpret_cast<bf16x8*>(&b_); }
    } }
  const int sr = tid >> 4, sc = (tid & 15) * 8, vst0 = v_st(sr, sc), vst1 = v_st(32 + sr, sc);
  const int rr_ = tid >> 3, rc = (tid & 7) * 8;
  const int vb0 = (int)(uintptr_t)V_lds + v_rd_base(lane);
  bf16x8 vs0, vs1, ks0, ks1, rs0;
  const unsigned voffKV = (unsigned)(sr * LDK + sc) * 2u, voffR = (unsigned)(rr_ * LDKR + rc) * 2u;
#define SLOAD(k0) do { const char* kb_ = (const char*)Kn + (size_t)(k0) * (LDK * 2); const char* vb_ = (const char*)Vh + (size_t)(k0) * (LDK * 2); \
    vs0 = *(const bf16x8*)(vb_ + voffKV); vs1 = *(const bf16x8*)(vb_ + 32 * LDK * 2 + voffKV); \
    ks0 = *(const bf16x8*)(kb_ + voffKV); ks1 = *(const bf16x8*)(kb_ + 32 * LDK * 2 + voffKV); \
    rs0 = *(const bf16x8*)((const char*)Kr + (size_t)(k0) * (LDKR * 2) + voffR); } while (0)
#define SWRITE(b) do { *(bf16x8*)(V_lds + (b) * SHM_V + vst0) = vs0; *(bf16x8*)(V_lds + (b) * SHM_V + vst1) = vs1; const int kc = sc * 2;  \
    *(bf16x8*)(K_lds + (b) * SHM_K + KSWZ(sr, kc)) = ks0; *(bf16x8*)(K_lds + (b) * SHM_K + KSWZ(32 + sr, kc)) = ks1;                      \
    *(bf16x8*)(R_lds + (b) * SHM_R + RSWZ(rr_, rc * 2)) = rs0; } while (0)
#define RESC(a) do { if (__any((a) < 1.f)) { if (hi == 0) al_l[r32] = (a); asm volatile("s_waitcnt lgkmcnt(0)" ::: "memory"); \
    _Pragma("unroll") for (int d = 0; d < 4; ++d) _Pragma("unroll") for (int r = 0; r < 16; ++r) o[d][r] *= al_l[crow(r, hi)]; } } while (0)
  f32x16 pA0, pA1, pB0, pB1; float mnA, mnB, alA, alB; bf16x8 pa0, pa1, pa2, pa3; const int NT = seq / KVBLK;
  SLOAD(0); SWRITE(0); __syncthreads();
  qkt(pA0, pA1, K_lds, R_lds, qr, qrl, r32, hi); partialSM(pA0, pA1, m_reg, mnA, alA);
  SLOAD(KVBLK); SWRITE(1); __syncthreads();
  for (int j = 1; j + 1 < NT; j += 2) {
    SBAR(); qkt(pB0, pB1, K_lds + SHM_K, R_lds + SHM_R, qr, qrl, r32, hi);
    finishSM(pA0, pA1, alA, l_reg, pa0, pa1, pa2, pa3); SBAR();
    SLOAD((j + 1) * KVBLK); SBAR();
    pv_d0(o, vb0, pa0, pa1, pa2, pa3); partialSM(pB0, pB1, m_reg, mnB, alB);
    __syncthreads(); SWRITE(0);
    RESC(alB); __syncthreads();
    SBAR(); qkt(pA0, pA1, K_lds, R_lds, qr, qrl, r32, hi);
    finishSM(pB0, pB1, alB, l_reg, pa0, pa1, pa2, pa3); SBAR();
    SLOAD((j + 2) * KVBLK); SBAR();
    pv_d0(o, vb0 + (int)SHM_V, pa0, pa1, pa2, pa3); partialSM(pA0, pA1, m_reg, mnA, alA);
    __syncthreads(); SWRITE(1);
    RESC(alA); __syncthreads();
  }
  SBAR(); qkt(pB0, pB1, K_lds + SHM_K, R_lds + SHM_R, qr, qrl, r32, hi);
  finishSM(pA0, pA1, alA, l_reg, pa0, pa1, pa2, pa3); SBAR();
  pv_d0(o, vb0, pa0, pa1, pa2, pa3); partialSM(pB0, pB1, m_reg, mnB, alB);
  __syncthreads(); RESC(alB);
  finishSM(pB0, pB1, alB, l_reg, pa0, pa1, pa2, pa3); SBAR();
  pv_d0(o, vb0 + (int)SHM_V, pa0, pa1, pa2, pa3);
  if (hi == 0) li_l[r32] = l_reg; asm volatile("s_waitcnt lgkmcnt(0)" ::: "memory");
  float rli[16];
#pragma unroll
  for (int r = 0; r < 16; ++r) rli[r] = __builtin_amdgcn_rcpf(li_l[crow(r, hi)]);
  bf16_t* Ow = Ob + (size_t)(wid * QBLK) * LDO;
#pragma unroll
  for (int r = 0; r < 16; ++r) { const int orow = crow(r, hi);
#pragma unroll
    for (int d0 = 0; d0 < 4; ++d0) Ow[(size_t)orow * LDO + d0 * 32 + r32] = f2bf(o[d0][r] * rli[r]); }
  __syncthreads();
#undef SLOAD
#undef SWRITE
#undef RESC
}
}

__device__ void phase_attn(PRef p, int l, char* smem) {
  const bf16_t* Q = (const bf16_t*)(p.ws + WS_Q); const bf16_t* KV = (const bf16_t*)(p.ws + WS_KV); const bf16_t* KR = (const bf16_t*)(p.ws + WS_KR);
  bf16_t* mix = (bf16_t*)(p.ws + WS_MIX); const float* cs = (const float*)(p.ws + WS_COS); const float* sn = (const float*)(p.ws + WS_SIN);
  const int nunits = 1024 + (l == 0 ? 32 : 0);
  for (int u = obid(); u < nunits; u += gridDim.x) {
    if (u < 1024) {
      const int bh = (u >> 8) * 8 + (u & 7), qb = (u & 255) >> 3, hd = bh & 3, b = bh >> 2; const size_t row0 = (size_t)b * SEQ + qb * 256;
      att::attn_body(Q + row0 * 768 + hd * 192, cs + (size_t)qb * 256 * 32, sn + (size_t)qb * 256 * 32, KV + (size_t)b * SKV * 1024 + hd * 256,
                     KV + (size_t)b * SKV * 1024 + hd * 256 + 128, KR + (size_t)b * SKV * 64, mix + row0 * 1024 + 512 + hd * 128, SKV, smem);
    } else {
      const int v = u - 1024, hd = v & 3, b = v >> 2; const size_t row0 = (size_t)MX + b * CTXL;
      att::attn_body(Q + row0 * 768 + hd * 192, nullptr, nullptr, KV + (size_t)b * SKV * 1024 + hd * 256,
                     KV + (size_t)b * SKV * 1024 + hd * 256 + 128, KR + (size_t)b * SKV * 64, mix + row0 * 1024 + 512 + hd * 128, CTXL, smem);
    }
  }
}

__device__ void phase_outproj(PRef p, int l, char* smem) {
  LAS unsigned char* lds = (LAS unsigned char*)smem;
  const bf16_t* mix = (const bf16_t*)(p.ws + WS_MIX); const bf16_t* Wt = (const bf16_t*)(p.ws + WS_WOUT) + (size_t)l * 1024 * 1024;
  float* ctxz = (float*)(p.ws + WS_CTXZ);
  const int tid = otid(), wid = tid >> 6, lane = tid & 63, wr = wid >> 2, wc = wid & 3, fr = lane & 15, fq = lane >> 4;
  g8::TileIter it; it.init(l == 0 ? MT / 256 : MX / 256, 4);
  int pm, pn;
  while (it.next(pm, pn)) {
    unsigned voffA[2] = {g8::piece_off(0, 1024, 0), g8::piece_off(1, 1024, 0)};
    f32x4 acc[2][2][4][2];
    g8::gemm_tile<false>(lds, (const char*)(mix + (size_t)pm * 256 * 1024), voffA, (size_t)128 * 1024 * 2, (const char*)(Wt + (size_t)pn * 256 * 1024), 1024, acc);
    ACC_FOR(ai, bj, m, n) {
      const int row = pm * 256 + ai * 128 + wr * 64 + m * 16 + fr, col = pn * 256 + bj * 128 + wc * 32 + fq * 8 + n * 4;
      const float* res = l == 0 ? (row < MX ? p.x + (size_t)row * 1024 : p.ctx + (size_t)(row - MX) * 1024) : p.out + (size_t)row * 1024;
      float* dst = row < MX ? p.out + (size_t)row * 1024 : ctxz + (size_t)(row - MX) * 1024;
      const f32x4 r = *(const f32x4*)(res + col), g = *(const f32x4*)(mod_ptr(p, l, row, 2) + col);
      *(f32x4*)(dst + col) = r * ALPHA + g * acc[ai][bj][m][n];
    }
  }
}

__device__ void phase_ln1(PRef p, int l, char* smem) {
  float* wrt = (float*)smem;
  for (int i = otid(); i < 16384; i += 512) wrt[(i & 15) * 1024 + (i >> 4)] = p.w_router[(size_t)l * 16384 + i];
  __syncthreads();
  const int lane = otid() & 63, gw = obid() * 8 + (otid() >> 6), nw = gridDim.x * 8;
  bf16_t* h = (bf16_t*)(p.ws + WS_H); float* ctxz = (float*)(p.ws + WS_CTXZ); float* aff = (float*)(p.ws + WS_AFF);
  const int nrows = l == 0 ? MT : MX;
  for (int row = gw; row < nrows; row += nw) {
    asm volatile("" ::: "memory");
    float* zr = row < MX ? p.out + (size_t)row * 1024 : ctxz + (size_t)(row - MX) * 1024;
    f32x4 v[4];
#pragma unroll
    for (int i = 0; i < 4; ++i) v[i] = *(const f32x4*)(zr + lane * 4 + 256 * i);
    ln_row(v, 1e-5f);
#pragma unroll
    for (int i = 0; i < 4; ++i) { const int c = lane * 4 + 256 * i; v[i] = v[i] * *(const f32x4*)(p.ln1_g + l * 1024 + c) + *(const f32x4*)(p.ln1_b + l * 1024 + c); *(f32x4*)(zr + c) = v[i]; }
    ln_row(v, 1e-6f);
    f32x4 hm[4];
    store_mod_bf16(v, mod_ptr(p, l, row, 3), mod_ptr(p, l, row, 4), h + (size_t)row * 1024, lane, &hm);
    float lg[16];
#pragma unroll
    for (int e = 0; e < 16; ++e) { float s = 0.f;
#pragma unroll
      for (int i = 0; i < 4; ++i) { const f32x4 w = *(const f32x4*)(wrt + e * 1024 + lane * 4 + 256 * i); s += hm[i][0] * w[0] + hm[i][1] * w[1] + hm[i][2] * w[2] + hm[i][3] * w[3]; }
      lg[e] = wave_sum(s); }
    float mx = lg[0];
#pragma unroll
    for (int e = 1; e < 16; ++e) mx = fmaxf(mx, lg[e]);
    float den = 0.f;
#pragma unroll
    for (int e = 0; e < 16; ++e) { lg[e] = expf(lg[e] - mx); den += lg[e]; }
    float mine = 0.f;
#pragma unroll
    for (int e = 0; e < 16; ++e) if (lane == e) mine = lg[e] / den;
    if (lane < 16) aff[(size_t)row * 16 + lane] = mine;
  }
}

template <int PER>
__device__ __forceinline__ void topk_item(const float* __restrict__ affp, int n, int kcap, int rowbase, int slotbase, int e, int* __restrict__ IDX, float* __restrict__ GV, int* __restrict__ TS, char* smem) {
  unsigned* hist = (unsigned*)smem; unsigned* sel = hist + 256; unsigned* wtot = hist + 272;
  const int tid = otid(), lane = tid & 63, wid = tid >> 6;
  const bool active = tid * PER < n;
  unsigned key[PER];
#pragma unroll
  for (int i = 0; i < PER; ++i) key[i] = active ? __float_as_uint(affp[(size_t)(tid * PER + i) * 16]) : 0u;
  unsigned prefix = 0u, mask = 0u; int kk = kcap;
#pragma unroll 1
  for (int shift = 24; shift >= 0; shift -= 8) {
    __syncthreads();
    if (tid < 256) hist[tid] = 0u;
    __syncthreads();
#pragma unroll
    for (int i = 0; i < PER; ++i) if (active && (key[i] & mask) == prefix) atomicAdd(&hist[(key[i] >> shift) & 255u], 1u);
    __syncthreads();
    if (wid == 0) {
      const unsigned h0 = hist[lane * 4], h1 = hist[lane * 4 + 1], h2 = hist[lane * 4 + 2], h3 = hist[lane * 4 + 3];
      const unsigned tot = h0 + h1 + h2 + h3; unsigned suf = tot;
#pragma unroll
      for (int o = 1; o < 64; o <<= 1) { const unsigned u = __shfl_down(suf, o); if (lane + o < 64) suf += u; }
      const unsigned above = suf - tot;
      if (above < (unsigned)kk && suf >= (unsigned)kk) {
        unsigned a = above; int bin;
        if (a + h3 >= (unsigned)kk) bin = 3; else { a += h3; if (a + h2 >= (unsigned)kk) bin = 2; else { a += h2; if (a + h1 >= (unsigned)kk) bin = 1; else { a += h1; bin = 0; } } }
        sel[0] = prefix | ((unsigned)(lane * 4 + bin) << shift); sel[1] = (unsigned)kk - a;
      }
    }
    __syncthreads();
    prefix = sel[0]; kk = (int)sel[1]; mask |= 0xffu << shift;
  }
  const unsigned Tk = prefix;
  unsigned cg_ = 0, ce = 0;
#pragma unroll
  for (int i = 0; i < PER; ++i) { cg_ += key[i] > Tk; ce += key[i] == Tk; }
  unsigned pk = active ? (cg_ | (ce << 16)) : 0u, inc = pk;
#pragma unroll
  for (int o = 1; o < 64; o <<= 1) { const unsigned u = __shfl_up(inc, o); if (lane >= o) inc += u; }
  __syncthreads();
  if (lane == 63) wtot[wid] = inc;
  __syncthreads();
  unsigned base = 0;
  for (int w2 = 0; w2 < wid; ++w2) base += wtot[w2];
  const unsigned exc = base + inc - pk; unsigned gt_before = exc & 0xffffu, eq_before = exc >> 16;
  if (active) {
#pragma unroll
    for (int i = 0; i < PER; ++i) {
      const int t = tid * PER + i; int R = -1;
      const bool isgt = key[i] > Tk, iseq = key[i] == Tk;
      if (isgt || (iseq && (int)eq_before < kk)) {
        const int slot = (int)gt_before + min((int)eq_before, kk);
        R = slotbase + slot; IDX[R] = rowbase + t; GV[R] = __uint_as_float(key[i]);
      }
      TS[t] = R;
      gt_before += isgt; eq_before += iseq;
    }
  }
}
__device__ void phase_topk(PRef p, int l, char* smem) {
  const float* aff = (const float*)(p.ws + WS_AFF); int* IDX = (int*)(p.ws + WS_IDX); float* GV = (float*)(p.ws + WS_GV); int* TS = (int*)(p.ws + WS_TS);
  const int nitems = l == 0 ? 256 : 128;
  for (int it = obid(); it < nitems; it += gridDim.x) {
    if (it < 128) { const int b = it >> 4, e = it & 15; topk_item<16>(aff + (size_t)b * SEQ * 16 + e, SEQ, CAPX, b * SEQ, it * CAPX, e, IDX, GV, TS + (size_t)it * SEQ, smem); }
    else { const int v = it - 128, b = v >> 4, e = v & 15; topk_item<1>(aff + ((size_t)MX + b * CTXL) * 16 + e, CTXL, CAPC, MX + b * CTXL, NB * NE * CAPX + e * 256 + b * CAPC, e, IDX, GV, TS + (size_t)NB * 16 * SEQ + (size_t)v * CTXL, smem); }
  }
  __syncthreads();
}

__device__ void phase_moe_up(PRef p, int l, char* smem) {
  LAS unsigned char* lds = (LAS unsigned char*)smem;
  const bf16_t* h = (const bf16_t*)(p.ws + WS_H); const bf16_t* Wgu = (const bf16_t*)(p.ws + WS_WGU); bf16_t* act = (bf16_t*)(p.ws + WS_ACT); const int* IDX = (const int*)(p.ws + WS_IDX);
  const int tid = otid(), wid = tid >> 6, lane = tid & 63, wr = wid >> 2, wc = wid & 3, fr = lane & 15, fq = lane >> 4;
  g8::MoeIter it; it.init(8, l == 0);
  int pm, pn, e;
  while (it.next(pm, pn, e)) {
    unsigned voffA[4];
#pragma unroll
    for (int hh = 0; hh < 2; ++hh)
#pragma unroll
      for (int i = 0; i < 2; ++i) { int R, C; g8::piece_rc(i, R, C); voffA[hh * 2 + i] = (unsigned)(IDX[pm * 256 + hh * 128 + R] * 1024 + C) * 2u; }
    f32x4 acc[2][2][4][2];
    g8::gemm_tile<true>(lds, (const char*)h, voffA, 0, (const char*)(Wgu + ((size_t)e * 2048 + pn * 256) * 1024), 1024, acc);
#pragma unroll
    for (int ai = 0; ai < 2; ++ai)
#pragma unroll
      for (int m = 0; m < 4; ++m) {
          const int row = pm * 256 + ai * 128 + wr * 64 + m * 16 + fr, col = pn * 128 + wc * 32 + fq * 8;
          float a[8];
#pragma unroll
          for (int n = 0; n < 2; ++n) { const f32x4 g = acc[ai][0][m][n], u = acc[ai][1][m][n];
#pragma unroll
            for (int k = 0; k < 4; ++k) a[n * 4 + k] = silu_f(g[k]) * u[k]; }
          u32x4 w = {cvtpk(a[0], a[1]), cvtpk(a[2], a[3]), cvtpk(a[4], a[5]), cvtpk(a[6], a[7])}; *(u32x4*)(act + (size_t)row * 1024 + col) = w;
        }
  }
}
__device__ void phase_moe_down(PRef p, int l, char* smem) {
  LAS unsigned char* lds = (LAS unsigned char*)smem;
  const bf16_t* act = (const bf16_t*)(p.ws + WS_ACT); const bf16_t* Wdn = (const bf16_t*)(p.ws + WS_WDN); bf16_t* oute = (bf16_t*)(p.ws + WS_OUTE); const float* GV = (const float*)(p.ws + WS_GV);
  const int tid = otid(), wid = tid >> 6, lane = tid & 63, wr = wid >> 2, wc = wid & 3, fr = lane & 15, fq = lane >> 4;
  g8::MoeIter it; it.init(4, l == 0);
  int pm, pn, e;
  while (it.next(pm, pn, e)) {
    unsigned voffA[2] = {g8::piece_off(0, 1024, 0), g8::piece_off(1, 1024, 0)};
    f32x4 acc[2][2][4][2];
    g8::gemm_tile<false>(lds, (const char*)(act + (size_t)pm * 256 * 1024), voffA, (size_t)128 * 1024 * 2, (const char*)(Wdn + ((size_t)e * 1024 + pn * 256) * 1024), 1024, acc);
    ACC_FOR3(ai, bj, m) {
      const int row = pm * 256 + ai * 128 + wr * 64 + m * 16 + fr, col = pn * 256 + bj * 128 + wc * 32 + fq * 8;
      const float gv = GV[row]; const f32x4 v0 = acc[ai][bj][m][0] * gv, v1 = acc[ai][bj][m][1] * gv;
      u32x4 w = {cvtpk(v0[0], v0[1]), cvtpk(v0[2], v0[3]), cvtpk(v1[0], v1[1]), cvtpk(v1[2], v1[3])}; *(u32x4*)(oute + (size_t)row * 1024 + col) = w;
    }
  }
}

__device__ void phase_ln2(PRef p, int l) {
  const int lane = otid() & 63, gw = obid() * 8 + (otid() >> 6), nw = gridDim.x * 8;
  bf16_t* h = (bf16_t*)(p.ws + WS_H); float* ctxz = (float*)(p.ws + WS_CTXZ); const bf16_t* oute = (const bf16_t*)(p.ws + WS_OUTE); const int* TS = (const int*)(p.ws + WS_TS);
  const int nrows = l == 0 ? MT : MX;
  for (int row = gw; row < nrows; row += nw) {
    float* xr = row < MX ? p.out + (size_t)row * 1024 : ctxz + (size_t)(row - MX) * 1024;
    f32x4 mo[4];
#pragma unroll
    for (int i = 0; i < 4; ++i) mo[i] = (f32x4){0.f, 0.f, 0.f, 0.f};
    const int myR = lane < 16 ? (row < MX ? TS[((size_t)(row >> 13) * 16 + lane) * SEQ + (row & 8191)] : TS[(size_t)NB * 16 * SEQ + ((size_t)((row - MX) >> 8) * 16 + lane) * CTXL + ((row - MX) & 255)]) : -1;
    for (int e = 0; e < 16; ++e) { const int Rr = __shfl(myR, e);
      if (Rr >= 0) {
#pragma unroll
        for (int i = 0; i < 4; ++i) { const u32x2 w = *(const u32x2*)(oute + (size_t)Rr * 1024 + lane * 4 + 256 * i);
          mo[i][0] += bflo(w[0]); mo[i][1] += bfhi(w[0]); mo[i][2] += bflo(w[1]); mo[i][3] += bfhi(w[1]); } } }
    f32x4 v[4]; const float* m5 = mod_ptr(p, l, row, 5);
#pragma unroll
    for (int i = 0; i < 4; ++i) { const int c = lane * 4 + 256 * i; v[i] = *(const f32x4*)(xr + c) * ALPHA + *(const f32x4*)(m5 + c) * mo[i]; }
    ln_row(v, 1e-5f);
#pragma unroll
    for (int i = 0; i < 4; ++i) { const int c = lane * 4 + 256 * i; v[i] = v[i] * *(const f32x4*)(p.ln2_g + l * 1024 + c) + *(const f32x4*)(p.ln2_b + l * 1024 + c); *(f32x4*)(xr + c) = v[i]; }
    if (l + 1 < DEPTH) { ln_row(v, 1e-6f); store_mod_bf16(v, mod_ptr(p, l + 1, row, 0), mod_ptr(p, l + 1, row, 1), h + (size_t)row * 1024, lane, nullptr); }
  }
}

__device__ __forceinline__ void gsync(cg::grid_group& grid) {
  asm volatile("s_waitcnt vmcnt(0) lgkmcnt(0)" ::: "memory");
  grid.sync();
}
#define XB_CEN(j) (64 * (j))
#define XB_SUB(j) (1024 + 64 * (j))
#define XB_TOP 2048
struct FastBar { unsigned* w; unsigned xcc, nloc, nx, epoch; };
__device__ __forceinline__ unsigned xb_ld(unsigned* q) { return __hip_atomic_load(q, __ATOMIC_RELAXED, __HIP_MEMORY_SCOPE_AGENT); }
__device__ __forceinline__ unsigned xb_add(unsigned* q, unsigned v) { return __hip_atomic_fetch_add(q, v, __ATOMIC_RELAXED, __HIP_MEMORY_SCOPE_AGENT); }
__device__ __forceinline__ void fsync(FastBar& fb) {
  asm volatile("s_waitcnt vmcnt(0) lgkmcnt(0)" ::: "memory");
  __syncthreads();
  fb.epoch += 1u;
  if (otid() == 0) {
    const unsigned a = xb_add(&fb.w[XB_SUB(fb.xcc)], 1u) + 1u;
    if (a == fb.nloc * fb.epoch) {
      __builtin_amdgcn_fence(__ATOMIC_RELEASE, "agent");
      asm volatile("s_waitcnt vmcnt(0)" ::: "memory");
      (void)xb_add(&fb.w[XB_TOP], 1u);
    }
    while (xb_ld(&fb.w[XB_TOP]) < fb.nx * fb.epoch) __builtin_amdgcn_s_sleep(1);
    __builtin_amdgcn_fence(__ATOMIC_ACQUIRE, "agent");
    asm volatile("s_waitcnt vmcnt(0)" ::: "memory");
  }
  __syncthreads();
}
__global__ void __launch_bounds__(512) mega(Params p) {
  extern __shared__ __attribute__((aligned(16))) char smem[];
  cg::grid_group grid = cg::this_grid();
  FastBar fb; fb.w = (unsigned*)(kparams().ws + WS_BAR); fb.xcc = (unsigned)__builtin_amdgcn_readfirstlane((int)(__builtin_amdgcn_s_getreg((3 << 11) | 20) & 0xF)); fb.epoch = 0u; fb.nloc = 0u; fb.nx = 0u;
  if (otid() == 0) (void)xb_add(&fb.w[XB_CEN(fb.xcc)], 1u);
  phase_prep(kparams(), smem);
  if (kparams().out == nullptr) gsync(grid);
  if (otid() == 0) { for (;;) { unsigned sum = 0u;
#pragma unroll 1
      for (int j = 0; j < 16; ++j) sum += xb_ld(&fb.w[XB_CEN(j)]);
      if (sum == gridDim.x) break; __builtin_amdgcn_s_sleep(2); } }
  __syncthreads();
  { unsigned nx = 0u;
#pragma unroll 1
    for (int j = 0; j < 16; ++j) nx += xb_ld(&fb.w[XB_CEN(j)]) != 0u;
    fb.nx = (unsigned)__builtin_amdgcn_readfirstlane((int)nx); fb.nloc = (unsigned)__builtin_amdgcn_readfirstlane((int)xb_ld(&fb.w[XB_CEN(fb.xcc)])); }
  fsync(fb);
  phase_h0(kparams());
  fsync(fb);
#pragma unroll 1
  for (int l = 0; l < DEPTH; ++l) {
    phase_inproj(kparams(), l, smem);
    fsync(fb);
    phase_mlstm_pre(kparams(), l, smem);
    fsync(fb);
    phase_mlstm(kparams(), l, smem);
    fsync(fb);
    phase_mla_prep(kparams(), l, smem);
    fsync(fb);
    phase_attn(kparams(), l, smem);
    fsync(fb);
    phase_outproj(kparams(), l, smem);
    fsync(fb);
    phase_ln1(kparams(), l, smem);
    __syncthreads();
    phase_cvt_experts(kparams(), l, smem);
    fsync(fb);
    phase_topk(kparams(), l, smem);
    fsync(fb);
    phase_moe_up(kparams(), l, smem);
    fsync(fb);
    phase_moe_down(kparams(), l, smem);
    fsync(fb);
    phase_ln2(kparams(), l);
    fsync(fb);
  }
}

extern "C" void kernel_launch(void* const* d_in, const int* in_sizes, int n_in, void* d_out, int out_size,
                              void* d_ws, size_t ws_size, hipStream_t stream) {
  constexpr size_t kDynLds = 160 * 1024;
  static int grid_blocks = 0;
  if (!grid_blocks) {
    int dev = 0, cus = 0, per_cu = 0;
    (void)hipGetDevice(&dev);
    (void)hipDeviceGetAttribute(&cus, hipDeviceAttributeMultiprocessorCount, dev);
    (void)hipFuncSetAttribute((const void*)mega, hipFuncAttributeMaxDynamicSharedMemorySize, (int)kDynLds);
    (void)hipOccupancyMaxActiveBlocksPerMultiprocessor(&per_cu, mega, 512, kDynLds);
    grid_blocks = per_cu > 0 ? cus : 0;
    if (grid_blocks > 256) grid_blocks = 256;
    grid_blocks &= ~7;
    if (grid_blocks != 256) { fprintf(stderr, "this kernel needs 256 co-resident workgroups (got %d)\n", grid_blocks); grid_blocks = 0; }
    if (ws_size < WS_END) { fprintf(stderr, "workspace too small: %zu < %zu\n", ws_size, (size_t)WS_END); grid_blocks = 0; }
  }
  if (grid_blocks <= 0) return;
  Params p{};
  const float** pp = (const float**)&p;
  for (int i = 0; i < 24; ++i) pp[i] = (const float*)d_in[i];
  p.out = (float*)d_out; p.ws = (char*)d_ws;
  (void)hipMemsetAsync((char*)d_ws + WS_BAR, 0, WS_BAR_BYTES, stream);
  void* args[] = {&p};
  hipError_t e = hipLaunchCooperativeKernel((void*)mega, dim3(grid_blocks), dim3(512), args, kDynLds, stream);
  if (e != hipSuccess) fprintf(stderr, "cooperative launch failed: %s (grid %d)\n", hipGetErrorString(e), grid_blocks);
}
```

```cpp
#include <hip/hip_runtime.h>
#include <hip/hip_cooperative_groups.h>
#include <cstdio>
#include <cstdint>
namespace cg = cooperative_groups;

typedef unsigned short bf16_t;
typedef short bf16x8 __attribute__((ext_vector_type(8)));
typedef short s16x4 __attribute__((ext_vector_type(4)));
typedef float f32x4 __attribute__((ext_vector_type(4)));
typedef float f32x16 __attribute__((ext_vector_type(16)));
typedef unsigned u32x4 __attribute__((ext_vector_type(4)));
typedef unsigned u32x2 __attribute__((ext_vector_type(2)));
#define LAS __attribute__((address_space(3)))

constexpr int DM = 1024, NB = 8, SEQ = 8192, CTXL = 256, DEPTH = 2;
constexpr int MX = NB * SEQ, MC = NB * CTXL, MT = MX + MC;
constexpr int PLD = 2816;
constexpr int OFF_Q = 0, OFF_K = 512, OFF_V = 1024, OFF_O = 1536, OFF_G = 2048, OFF_CQ = 2064, OFF_CKV = 2448, OFF_KR = 2704, IN_COLS = 2768;
constexpr int SKV = SEQ + CTXL;
constexpr int NE = 16, CAPX = 1024, CAPC = 32;
constexpr int NSLOT = NB * NE * CAPX + NB * NE * CAPC;
constexpr float ALPHA = 1.4142135623730951f;
constexpr float A_SCALE = 0.07216878364870322f;

constexpr size_t al256(size_t v) { return (v + 255) / 256 * 256; }
constexpr size_t WS_H = 0;
constexpr size_t WS_P = WS_H + al256((size_t)MT * 1024 * 2);
constexpr size_t WS_Q = WS_P + al256((size_t)MT * PLD * 2);
constexpr size_t WS_KV = WS_Q + al256((size_t)MT * 768 * 2);
constexpr size_t WS_KR = WS_KV + al256((size_t)NB * SKV * 1024 * 2);
constexpr size_t WS_MIX = WS_KR + al256((size_t)NB * SKV * 64 * 2);
constexpr size_t WS_ACT = WS_P;
constexpr size_t WS_HB = WS_H;
constexpr size_t WS_OUTE = WS_P + al256((size_t)NSLOT * 1024 * 2);
constexpr size_t WS_WGU = WS_MIX;
constexpr size_t WS_WDN = WS_MIX + (size_t)NE * 2048 * 1024 * 2;
constexpr size_t WS_WIN = WS_MIX + al256((size_t)MT * 1024 * 2);
constexpr size_t WS_WUQ = WS_WIN + (size_t)2 * PLD * 1024 * 2;
constexpr size_t WS_WUKV = WS_WUQ + (size_t)2 * 768 * 384 * 2;
constexpr size_t WS_WOUT = WS_WUKV + (size_t)2 * 1024 * 256 * 2;
constexpr size_t WS_MOD = WS_WOUT + (size_t)2 * 1024 * 1024 * 2;
constexpr size_t WS_COS = WS_MOD + al256((size_t)2 * 9 * 6144 * 4);
constexpr size_t WS_SIN = WS_COS + (size_t)SEQ * 32 * 4;
constexpr size_t WS_GATES = WS_SIN + (size_t)SEQ * 32 * 4;
constexpr size_t WS_AFF = WS_GATES + (size_t)MT * 16 * 4;
constexpr size_t WS_IDX = WS_AFF + (size_t)MT * 16 * 4;
constexpr size_t WS_GV = WS_IDX + (size_t)NSLOT * 4;
constexpr size_t WS_TS = WS_GV + (size_t)NSLOT * 4;
constexpr size_t WS_CTXZ = WS_TS + (size_t)MT * 16 * 4;
constexpr size_t WS_BAR = WS_CTXZ + (size_t)MC * 1024 * 4;
constexpr size_t WS_BAR_BYTES = 16384;
constexpr size_t WS_END = WS_BAR + WS_BAR_BYTES;
static_assert(WS_OUTE + (size_t)NSLOT * 1024 * 2 <= WS_KR, "out_e overlay");
static_assert(WS_WDN + (size_t)NE * 1024 * 1024 * 2 <= WS_WIN, "expert weights overlay");

struct Params {
  const float *x, *c, *ctx, *c_ctx, *w_mod, *b_mod, *w_in, *b_gates, *conv_w, *conv_b, *m_norm_w, *q_norm_w, *kv_norm_w, *w_uq, *w_ukv, *w_out,
      *ln1_g, *ln1_b, *w_router, *w_gate, *w_up, *w_down, *ln2_g, *ln2_b;
  float* out; char* ws;
};

typedef const __attribute__((address_space(4))) Params& PRef;
__device__ __forceinline__ PRef kparams() { const __attribute__((address_space(4))) Params* kp = (const __attribute__((address_space(4))) Params*)__builtin_amdgcn_kernarg_segment_ptr(); asm volatile("" : "+s"(kp)); return *kp; }
__device__ __forceinline__ int otid() { int t = threadIdx.x; asm volatile("" : "+v"(t)); return t; }
__device__ __forceinline__ int obid() { int t = blockIdx.x; asm volatile("" : "+s"(t)); return t; }
__device__ __forceinline__ int opaque_s(int v) { asm volatile("" : "+s"(v)); return v; }
typedef __bf16 bf16v2_t __attribute__((ext_vector_type(2)));
typedef float f32x2_t __attribute__((ext_vector_type(2)));
__device__ __forceinline__ unsigned cvtpk(float lo, float hi) { const f32x2_t f = {lo, hi}; const bf16v2_t b = __builtin_convertvector(f, bf16v2_t); return __builtin_bit_cast(unsigned, b); }
__device__ __forceinline__ bf16_t f2bf(float v) { return (bf16_t)(cvtpk(v, v) & 0xffffu); }
__device__ __forceinline__ float bf2f(unsigned v) { return __uint_as_float(v << 16); }
__device__ __forceinline__ float bflo(unsigned w) { return __uint_as_float(w << 16); }
__device__ __forceinline__ float bfhi(unsigned w) { return __uint_as_float(w & 0xffff0000u); }
__device__ __forceinline__ float wave_sum(float v) { for (int o = 32; o > 0; o >>= 1) v += __shfl_xor(v, o); return v; }
__device__ __forceinline__ float wave_max(float v) { for (int o = 32; o > 0; o >>= 1) v = fmaxf(v, __shfl_xor(v, o)); return v; }
__device__ __forceinline__ float sigmoid_f(float v) { return __builtin_amdgcn_rcpf(1.f + __expf(-v)); }
__device__ __forceinline__ float silu_f(float v) { return v * sigmoid_f(v); }

namespace g8 {
constexpr int BK = 64, HALF = 128, HTB = HALF * BK * 2, STAGE_BYTES = 8 * HTB;
__device__ __forceinline__ int lds_byte(int r, int c) { const int st = (r >> 4) * 2 + (c >> 5), rr = r & 15, cc = c & 31, ob = rr * 64 + cc * 2; return st * 1024 + (ob ^ (((ob >> 9) & 1) << 5)); }
__device__ __forceinline__ int perm32(int rho) { const int n = rho >> 4, i = rho & 15; return 8 * (i >> 2) + 4 * n + (i & 3); }
__device__ __forceinline__ void stage_rc(int b, int& R, int& C) { const int st = b / 1024, sb = b % 1024, swz = sb ^ (((sb >> 9) & 1) << 5); R = (st >> 1) * 16 + swz / 64; C = (st & 1) * 32 + (swz % 64) / 2; }

template <bool GATHER>
__device__ __forceinline__ void gemm_tile(LAS unsigned char* lds, const char* __restrict__ Ab, const unsigned (&voffA)[GATHER ? 4 : 2], size_t hstepA, const char* __restrict__ Bb, int K,
                                          f32x4 (&acc)[2][2][4][2]) {
  const int tid = otid(), wid = __builtin_amdgcn_readfirstlane(tid >> 6), lane = tid & 63, wr = wid >> 2, wc = wid & 3, fr = lane & 15, fq = lane >> 4;
  const int nt = K / BK;
  unsigned voffB[2];
#pragma unroll
  for (int i = 0; i < 2; ++i) { int R, C; stage_rc(tid * 16 + i * 8192, R, C); const int Rb = (R & ~31) + perm32(R & 31); voffB[i] = (unsigned)(Rb * K + C) * 2u; }
  const char* Bb1 = Bb + (size_t)HALF * K * 2; const char* Ab1 = GATHER ? Ab : Ab + hstepA;
  const unsigned* vA0 = &voffA[0]; const unsigned* vA1 = GATHER ? &voffA[2] : &voffA[0];
  const unsigned ldsw = (unsigned)wid * 1024u;
  const int aoff = lds_byte(wr * 64 + fr, fq * 8), boff = lds_byte(wc * 32 + fr, fq * 8);
#define G8_SA(b, h) (((b) * 2 + (h)) * HTB)
#define G8_SB(b, h) ((4 + (b) * 2 + (h)) * HTB)
#define G8_STAGE(bufoff, gbase, voff, kt) do { _Pragma("unroll") for (int _i = 0; _i < 2; ++_i) \
    __builtin_amdgcn_global_load_lds((const unsigned*)((gbase) + (size_t)(kt) * (BK * 2) + (voff)[_i]), (LAS unsigned*)(lds + (bufoff) + ldsw + _i * 8192), 16, 0, 0); } while (0)
#define G8_LDA(dst, b, h) do { _Pragma("unroll") for (int m = 0; m < 4; ++m) _Pragma("unroll") for (int k = 0; k < 2; ++k) dst[m][k] = *(const LAS bf16x8*)(lds + G8_SA(b, h) + aoff + m * 2048 + k * 1024); } while (0)
#define G8_LDB(dst, b, h) do { _Pragma("unroll") for (int n = 0; n < 2; ++n) _Pragma("unroll") for (int k = 0; k < 2; ++k) dst[n][k] = *(const LAS bf16x8*)(lds + G8_SB(b, h) + boff + n * 2048 + k * 1024); } while (0)
#define G8_MMA(ai, bj, At, Bt) do { __builtin_amdgcn_s_setprio(1); _Pragma("unroll") for (int m = 0; m < 4; ++m) _Pragma("unroll") for (int n = 0; n < 2; ++n) _Pragma("unroll") for (int k = 0; k < 2; ++k) \
    acc[ai][bj][m][n] = __builtin_amdgcn_mfma_f32_16x16x32_bf16(Bt[n][k], At[m][k], acc[ai][bj][m][n], 0, 0, 0); __builtin_amdgcn_s_setprio(0); } while (0)
#define G8_WAIT_V(n) asm volatile("s_waitcnt vmcnt(" #n ")" ::: "memory")
#define G8_WAIT_L(n) asm volatile("s_waitcnt lgkmcnt(" #n ")" ::: "memory")
#define G8_BAR __builtin_amdgcn_s_barrier()
#define G8_SCHED __builtin_amdgcn_sched_barrier(0)
#pragma unroll
  for (int a = 0; a < 2; ++a)
#pragma unroll
    for (int b = 0; b < 2; ++b)
#pragma unroll
      for (int m = 0; m < 4; ++m)
#pragma unroll
        for (int n = 0; n < 2; ++n) acc[a][b][m][n] = (f32x4){0.f, 0.f, 0.f, 0.f};
  bf16x8 At[4][2], B0[2][2], B1[2][2];
  G8_WAIT_V(0); __syncthreads();
  G8_STAGE(G8_SB(0, 0), Bb, voffB, 0); G8_STAGE(G8_SA(0, 0), Ab, vA0, 0); G8_STAGE(G8_SB(0, 1), Bb1, voffB, 0); G8_STAGE(G8_SA(0, 1), Ab1, vA1, 0);
  if (wr == 1) G8_BAR;
  G8_WAIT_V(4); G8_BAR;
  G8_STAGE(G8_SB(1, 0), Bb, voffB, 1); G8_STAGE(G8_SA(1, 0), Ab, vA0, 1); G8_STAGE(G8_SB(1, 1), Bb1, voffB, 1);
  G8_WAIT_V(6); G8_BAR;
  for (int t = 0; t < nt - 2; t += 2) {
    G8_LDB(B0, 0, 0); G8_SCHED; G8_LDA(At, 0, 0); G8_STAGE(G8_SA(1, 1), Ab1, vA1, t + 1);
    G8_WAIT_L(8); G8_BAR; G8_WAIT_L(0); G8_MMA(0, 0, At, B0); G8_BAR; G8_SCHED;
    G8_LDB(B1, 0, 1); G8_STAGE(G8_SB(0, 0), Bb, voffB, t + 2);
    G8_BAR; G8_WAIT_L(0); G8_MMA(0, 1, At, B1); G8_BAR;
    G8_LDA(At, 0, 1); G8_STAGE(G8_SA(0, 0), Ab, vA0, t + 2);
    G8_BAR; G8_WAIT_L(0); G8_MMA(1, 0, At, B0); G8_BAR; G8_SCHED;
    G8_STAGE(G8_SB(0, 1), Bb1, voffB, t + 2);
    G8_WAIT_V(6); G8_BAR; G8_MMA(1, 1, At, B1); G8_BAR;
    G8_LDB(B0, 1, 0); G8_SCHED; G8_LDA(At, 1, 0); G8_STAGE(G8_SA(0, 1), Ab1, vA1, t + 2);
    G8_WAIT_L(8); G8_BAR; G8_WAIT_L(0); G8_MMA(0, 0, At, B0); G8_BAR; G8_SCHED;
    G8_LDB(B1, 1, 1); G8_STAGE(G8_SB(1, 0), Bb, voffB, t + 3);
    G8_BAR; G8_WAIT_L(0); G8_MMA(0, 1, At, B1); G8_BAR;
    G8_LDA(At, 1, 1); G8_STAGE(G8_SA(1, 0), Ab, vA0, t + 3);
    G8_BAR; G8_WAIT_L(0); G8_MMA(1, 0, At, B0); G8_BAR; G8_SCHED;
    G8_STAGE(G8_SB(1, 1), Bb1, voffB, t + 3);
    G8_WAIT_V(6); G8_BAR; G8_MMA(1, 1, At, B1); G8_BAR;
  }
  { G8_LDB(B0, 0, 0); G8_LDA(At, 0, 0); G8_STAGE(G8_SA(1, 1), Ab1, vA1, nt - 1);
    G8_BAR; G8_WAIT_L(0); G8_MMA(0, 0, At, B0); G8_BAR;
    G8_LDB(B1, 0, 1); G8_BAR; G8_WAIT_L(0); G8_MMA(0, 1, At, B1); G8_BAR;
    G8_LDA(At, 0, 1); G8_WAIT_V(4); G8_BAR; G8_WAIT_L(0); G8_MMA(1, 0, At, B0); G8_MMA(1, 1, At, B1); G8_BAR; }
  { G8_LDB(B0, 1, 0); G8_LDA(At, 1, 0); G8_WAIT_V(2); G8_BAR; G8_WAIT_L(0); G8_MMA(0, 0, At, B0); G8_BAR;
    G8_LDB(B1, 1, 1); G8_WAIT_V(0); G8_BAR; G8_WAIT_L(0); G8_MMA(0, 1, At, B1); G8_BAR;
    G8_LDA(At, 1, 1); G8_BAR; G8_WAIT_L(0); G8_MMA(1, 0, At, B0); G8_MMA(1, 1, At, B1); G8_BAR; }
  if (wr == 0) G8_BAR;
}
__device__ __forceinline__ unsigned piece_off(int i, int ld, int c0) { int R, C; stage_rc((int)otid() * 16 + i * 8192, R, C); return (unsigned)(R * ld + c0 + C) * 2u; }
__device__ __forceinline__ void piece_rc(int i, int& R, int& C) { stage_rc((int)otid() * 16 + i * 8192, R, C); }
struct TileIter {
  int nM, nN, x, j, J, cnt, idx;
  __device__ __forceinline__ void init(int nM_, int nN_) { nM = nM_; nN = nN_; x = obid() & 7; j = obid() >> 3; J = gridDim.x >> 3; cnt = ((nM - x + 7) >> 3) * nN; idx = j; }
  __device__ __forceinline__ bool next(int& pm, int& pn) { if (idx >= cnt) return false; pm = x + 8 * (idx / nN); pn = idx % nN; idx += J; return true; }
};
struct MoeIter {
  int nN, x, jm, jn, j, step, nsteps, nb4; bool with_ctx, ctx_done, wide;
  __device__ __forceinline__ void init(int nN_, bool with_ctx_) { nN = nN_; with_ctx = with_ctx_; wide = nN_ == 8; x = obid() & 7; j = obid() >> 3;
    if (wide) { jm = j & 3; jn = j >> 2; nsteps = 16; } else { jm = j & 7; jn = j >> 3; nsteps = 2 * (nN >> 2) * 4; }
    nb4 = nN >> 2; step = 0; ctx_done = false; }
  __device__ __forceinline__ bool next(int& pm, int& pn, int& e) {
    if (step < nsteps) {
      int m32;
      if (wide) { const int mb = step & 7, el = step >> 3; e = 2 * x + el; m32 = mb * 4 + jm; pn = jn; }
      else { const int mb = step & 3, nb = (step >> 2) % nb4, el = (step >> 2) / nb4; e = 2 * x + el; m32 = mb * 8 + jm; pn = nb * 4 + jn; }
      pm = ((m32 >> 2) * 16 + e) * 4 + (m32 & 3); ++step; return true; }
    if (with_ctx && !ctx_done) { ctx_done = true; if (j < 2 * nN) { e = 2 * x + j / nN; pm = 512 + e; pn = j % nN; return true; } }
    return false;
  }
};
}

#define ACC_FOR3(ai, bj, m) _Pragma("unroll") for (int ai = 0; ai < 2; ++ai) _Pragma("unroll") for (int bj = 0; bj < 2; ++bj) _Pragma("unroll") for (int m = 0; m < 4; ++m)
#define ACC_FOR(ai, bj, m, n) _Pragma("unroll") for (int ai = 0; ai < 2; ++ai) _Pragma("unroll") for (int bj = 0; bj < 2; ++bj) _Pragma("unroll") for (int m = 0; m < 4; ++m) _Pragma("unroll") for (int n = 0; n < 2; ++n)

__device__ __forceinline__ void cvt_tile(const float* __restrict__ src, int N, int K, int k0, int n0, bf16_t* __restrict__ dst, long drow0, const float* __restrict__ kscale, float* lds) {
  const int tid = otid();
  { const int kr = tid >> 6, n = tid & 63;
#pragma unroll
    for (int i = 0; i < 8; ++i) { const int k = kr + 8 * i; float v = (n0 + n < N) ? src[(size_t)(k0 + k) * N + n0 + n] : 0.f; if (kscale) v *= kscale[k0 + k]; lds[k * 65 + n] = v; } }
  __syncthreads();
  { const int n = tid >> 3, k8 = (tid & 7) * 8; float v[8];
#pragma unroll
    for (int i = 0; i < 8; ++i) v[i] = lds[(k8 + i) * 65 + n];
    u32x4 w = {cvtpk(v[0], v[1]), cvtpk(v[2], v[3]), cvtpk(v[4], v[5]), cvtpk(v[6], v[7])};
    *(u32x4*)(dst + (size_t)(drow0 + n) * K + k0 + k8) = w; }
  __syncthreads();
}

__device__ void phase_prep(PRef p, char* smem) {
  float* lds = (float*)smem;
  bf16_t* Wt_in = (bf16_t*)(p.ws + WS_WIN); bf16_t* Wt_uq = (bf16_t*)(p.ws + WS_WUQ); bf16_t* Wt_ukv = (bf16_t*)(p.ws + WS_WUKV); bf16_t* Wt_out = (bf16_t*)(p.ws + WS_WOUT);
  float* mod = (float*)(p.ws + WS_MOD);
  constexpr int T_MOD = 192, T_IN = 2 * 16 * 44, T_UQ = 2 * 6 * 12, T_UKV = 2 * 4 * 16, T_OUT = 2 * 16 * 16, T_ROPE = 64;
  constexpr int E0 = T_MOD, E1 = E0 + T_IN, E2 = E1 + T_UQ, E3 = E2 + T_UKV, E4 = E3 + T_OUT, E5 = E4 + T_ROPE;
  const int tid = otid();
  for (int task = obid(); task < E5; task += gridDim.x) {
    if (task < E0) {
      const int l = task / 96, j0 = (task % 96) * 64;
      float* sc = lds;
      for (int i = tid; i < 9 * 1024; i += 512) { const int bb = i >> 10, d = i & 1023; const float v = bb < 8 ? p.c[bb * 1024 + d] : p.c_ctx[d]; sc[i] = v / (1.f + expf(-v)); }
      __syncthreads();
      const int col = tid & 63, ks = tid >> 6; float a[9];
#pragma unroll
      for (int bb = 0; bb < 9; ++bb) a[bb] = 0.f;
      const float* wm = p.w_mod + (size_t)l * 1024 * 6144 + j0 + col;
      for (int d = ks * 128; d < ks * 128 + 128; ++d) { const float w = wm[(size_t)d * 6144];
#pragma unroll
        for (int bb = 0; bb < 9; ++bb) a[bb] += sc[bb * 1024 + d] * w; }
      float* red = lds + 9 * 1024;
#pragma unroll
      for (int bb = 0; bb < 9; ++bb) red[(ks * 9 + bb) * 64 + col] = a[bb];
      __syncthreads();
      for (int i = tid; i < 9 * 64; i += 512) { const int bb = i >> 6, cc = i & 63; float s = 0.f;
        for (int k = 0; k < 8; ++k) s += red[(k * 9 + bb) * 64 + cc];
        mod[((size_t)l * 9 + bb) * 6144 + j0 + cc] = s + p.b_mod[l * 6144 + j0 + cc]; }
      __syncthreads();
    } else if (task < E1) { const int t = task - E0, l = t / 704, r = t % 704, kt = r / 44, nt = r % 44;
      cvt_tile(p.w_in + (size_t)l * 1024 * IN_COLS, IN_COLS, 1024, kt * 64, nt * 64, Wt_in + (size_t)l * PLD * 1024, nt * 64, nullptr, lds);
    } else if (task < E2) { const int t = task - E1, l = t / 72, r = t % 72, kt = r / 12, nt = r % 12;
      cvt_tile(p.w_uq + (size_t)l * 384 * 768, 768, 384, kt * 64, nt * 64, Wt_uq + (size_t)l * 768 * 384, nt * 64, p.q_norm_w + l * 384, lds);
    } else if (task < E3) { const int t = task - E2, l = t / 64, r = t % 64, kt = r / 16, nt = r % 16;
      cvt_tile(p.w_ukv + (size_t)l * 256 * 1024, 1024, 256, kt * 64, nt * 64, Wt_ukv + (size_t)l * 1024 * 256, nt * 64, p.kv_norm_w + l * 256, lds);
    } else if (task < E4) { const int t = task - E3, l = t / 256, r = t % 256, kt = r / 16, nt = r % 16;
      cvt_tile(p.w_out + (size_t)l * 1024 * 1024, 1024, 1024, kt * 64, nt * 64, Wt_out + (size_t)l * 1024 * 1024, nt * 64, nullptr, lds);
    } else {
      float* cs = (float*)(p.ws + WS_COS); float* sn = (float*)(p.ws + WS_SIN);
      for (int i = (task - E4) * 4096 + tid; i < (task - E4 + 1) * 4096; i += 512) { const int t = i >> 5, j = i & 31;
        const float inv = exp2f(-(float)(j & 15) * (13.287712379549449f / 16.f));
        const float pos = (float)(j < 16 ? (t >> 6) : (t & 63)); const float ang = pos * inv;
        const double a = (double)ang; const double k = rint(a * 0.15915494309189535); const float r = (float)(a - k * 6.283185307179586);
        cs[i] = __cosf(r); sn[i] = __sinf(r); }
    }
  }
}

__device__ void phase_cvt_experts(PRef p, int l, char* smem) {
  float* lds = (float*)smem;
  bf16_t* Wgu = (bf16_t*)(p.ws + WS_WGU); bf16_t* Wdn = (bf16_t*)(p.ws + WS_WDN);
  const int tid = otid();
  for (int task = obid(); task < NE * 192; task += gridDim.x) {
    const int e = task / 192, r = task % 192, which = r >> 6, kt = (r & 63) >> 2, nt = r & 3, k0 = kt * 64, n0 = nt * 256;
    const float* src = (which == 0 ? p.w_gate : which == 1 ? p.w_up : p.w_down) + ((size_t)l * NE + e) * 1024 * 1024;
    { const int kr = tid >> 6, n4 = (tid & 63) * 4;
#pragma unroll
      for (int i = 0; i < 8; ++i) { const int k = kr + 8 * i; *(f32x4*)(lds + k * 260 + n4) = *(const f32x4*)(src + (size_t)(k0 + k) * 1024 + n0 + n4); } }
    __syncthreads();
    { const int nl = tid & 255, k32 = (tid >> 8) * 32, n = n0 + nl;
      const size_t drow = which == 2 ? (size_t)n : (size_t)((n >> 7) * 256 + which * 128 + (n & 127));
      bf16_t* dst = (which == 2 ? Wdn + (size_t)e * 1024 * 1024 : Wgu + (size_t)e * 2048 * 1024) + drow * 1024 + k0 + k32;
#pragma unroll
      for (int q = 0; q < 4; ++q) { float v[8];
#pragma unroll
        for (int i = 0; i < 8; ++i) v[i] = lds[(k32 + q * 8 + i) * 260 + nl];
        u32x4 w = {cvtpk(v[0], v[1]), cvtpk(v[2], v[3]), cvtpk(v[4], v[5]), cvtpk(v[6], v[7])};
        *(u32x4*)(dst + q * 8) = w; } }
    __syncthreads();
  }
}

__device__ __forceinline__ void ln_row(f32x4 (&v)[4], float eps) {
  float s = 0.f;
#pragma unroll
  for (int i = 0; i < 4; ++i) s += v[i][0] + v[i][1] + v[i][2] + v[i][3];
  const float mu = wave_sum(s) * (1.f / 1024.f);
  float q = 0.f;
#pragma unroll
  for (int i = 0; i < 4; ++i)
#pragma unroll
    for (int k = 0; k < 4; ++k) { v[i][k] -= mu; q += v[i][k] * v[i][k]; }
  const float rs = rsqrtf(wave_sum(q) * (1.f / 1024.f) + eps);
#pragma unroll
  for (int i = 0; i < 4; ++i) v[i] *= rs;
}
__device__ __forceinline__ void store_mod_bf16(const f32x4 (&v)[4], const float* __restrict__ shift, const float* __restrict__ scale, bf16_t* __restrict__ hrow, int lane, f32x4 (*keep)[4]) {
#pragma unroll
  for (int i = 0; i < 4; ++i) { const int c = lane * 4 + 256 * i; const f32x4 sh = *(const f32x4*)(shift + c), sc = *(const f32x4*)(scale + c);
    f32x4 o = v[i] * (sc + 1.f) + sh; if (keep) (*keep)[i] = o;
    u32x2 w = {cvtpk(o[0], o[1]), cvtpk(o[2], o[3])}; *(u32x2*)(hrow + c) = w; }
}
__device__ __forceinline__ const float* mod_ptr(PRef p, int l, int row, int which) {
  const int bb = row < MX ? (row >> 13) : 8;
  return (const float*)(p.ws + WS_MOD) + ((size_t)l * 9 + bb) * 6144 + which * 1024;
}

__device__ void phase_h0(PRef p) {
  const int lane = otid() & 63, gw = obid() * 8 + (otid() >> 6), nw = gridDim.x * 8;
  bf16_t* h = (bf16_t*)(p.ws + WS_H);
  for (int row = gw; row < MT; row += nw) {
    const float* src = row < MX ? p.x + (size_t)row * 1024 : p.ctx + (size_t)(row - MX) * 1024;
    f32x4 v[4];
#pragma unroll
    for (int i = 0; i < 4; ++i) v[i] = *(const f32x4*)(src + lane * 4 + 256 * i);
    ln_row(v, 1e-6f);
    store_mod_bf16(v, mod_ptr(p, 0, row, 0), mod_ptr(p, 0, row, 1), h + (size_t)row * 1024, lane, nullptr);
  }
}

__device__ void phase_inproj(PRef p, int l, char* smem) {
  LAS unsigned char* lds = (LAS unsigned char*)smem;
  const bf16_t* h = (const bf16_t*)(p.ws + WS_H); const bf16_t* Wt = (const bf16_t*)(p.ws + WS_WIN) + (size_t)l * PLD * 1024;
  bf16_t* P = (bf16_t*)(p.ws + WS_P); float* gates = (float*)(p.ws + WS_GATES);
  const int tid = otid(), wid = tid >> 6, lane = tid & 63, wr = wid >> 2, wc = wid & 3, fr = lane & 15, fq = lane >> 4;
  g8::TileIter it; it.init(MT / 256, PLD / 256);
  int pm, pn;
  while (it.next(pm, pn)) {
    unsigned voffA[2] = {g8::piece_off(0, 1024, 0), g8::piece_off(1, 1024, 0)};
    f32x4 acc[2][2][4][2];
    g8::gemm_tile<false>(lds, (const char*)(h + (size_t)pm * 256 * 1024), voffA, (size_t)128 * 1024 * 2, (const char*)(Wt + (size_t)pn * 256 * 1024), 1024, acc);
    ACC_FOR3(ai, bj, m) {
      const int row = pm * 256 + ai * 128 + wr * 64 + m * 16 + fr, col = pn * 256 + bj * 128 + wc * 32 + fq * 8;
      const f32x4 v0 = acc[ai][bj][m][0], v1 = acc[ai][bj][m][1];
      u32x4 w = {cvtpk(v0[0], v0[1]), cvtpk(v0[2], v0[3]), cvtpk(v1[0], v1[1]), cvtpk(v1[2], v1[3])}; *(u32x4*)(P + (size_t)row * PLD + col) = w;
      if (col >= OFF_G && col < OFF_G + 16) { const f32x4 bg0 = *(const f32x4*)(p.b_gates + l * 16 + (col - OFF_G)), bg1 = *(const f32x4*)(p.b_gates + l * 16 + (col - OFF_G) + 4);
        *(f32x4*)(gates + (size_t)row * 16 + (col - OFF_G)) = v0 + bg0; *(f32x4*)(gates + (size_t)row * 16 + (col - OFF_G) + 4) = v1 + bg1; }
    }
  }
}


constexpr size_t WS_QKC = WS_KV;
constexpr size_t WS_SCAL = WS_Q;
__device__ void phase_mlstm_pre(PRef p, int l, char* smem) {
  const bf16_t* P = (const bf16_t*)(p.ws + WS_P); const float* gates = (const float*)(p.ws + WS_GATES);
  bf16_t* QKC = (bf16_t*)(p.ws + WS_QKC); float* SCAL = (float*)(p.ws + WS_SCAL);
  const int tid = otid(), wid = tid >> 6, lane = tid & 63;
  if (obid() < 64) {
    const int chain = obid(), dir = chain & 1, hd = (chain >> 1) & 3, b = chain >> 3;
    float* LA = (float*)smem; float* LB = LA + 132 * 64; float* LP = LB + 132 * 64; float* b63s = LP + 132 * 64; float* pm63s = b63s + 132; float* mbs = pm63s + 132;
    for (int ci = wid; ci < 132; ci += 8) {
      const bool ic = ci < 4; const int cc = ic ? ci : ci - 4, T = ic ? CTXL : SEQ, rb = ic ? MX + b * CTXL : b * SEQ, tlo = dir ? T - 64 - cc * 64 : cc * 64;
      const int t = dir ? tlo + 63 - lane : tlo + lane; const float* g = gates + (size_t)(rb + t) * 16;
      const float ig = g[dir * 8 + hd], fg = g[dir * 8 + 4 + hd];
      const float lf = fminf(fg, 0.f) - log1pf(expf(-fabsf(fg)));
      float bc = lf;
#pragma unroll
      for (int o = 1; o < 64; o <<= 1) { const float u = __shfl_up(bc, o); if (lane >= o) bc += u; }
      const float a = ig - bc; float pmx = a;
#pragma unroll
      for (int o = 1; o < 64; o <<= 1) { const float u = __shfl_up(pmx, o); if (lane >= o) pmx = fmaxf(pmx, u); }
      LA[ci * 64 + lane] = a; LB[ci * 64 + lane] = bc; LP[ci * 64 + lane] = pmx;
      if (lane == 63) { b63s[ci] = bc; pm63s[ci] = pmx; }
    }
    __syncthreads();
    if (tid == 0) { float m = 0.f; for (int ci = 0; ci < 132; ++ci) { mbs[ci] = m; m = b63s[ci] + fmaxf(pm63s[ci], m); } }
    __syncthreads();
    for (int ci = wid; ci < 132; ci += 8) {
      const float m = mbs[ci], a = LA[ci * 64 + lane], bc = LB[ci * 64 + lane], pmx = LP[ci * 64 + lane];
      const float Mx = fmaxf(pmx, m), M63 = fmaxf(pm63s[ci], m);
      float* S = SCAL + ((size_t)chain * 132 + ci) * 384;
      S[lane] = a; S[64 + lane] = Mx; S[128 + lane] = __expf(m - Mx); S[192 + lane] = __expf(-(bc + Mx)); S[256 + lane] = __expf(a - M63);
      S[320 + lane] = lane == 0 ? __expf(m - M63) : 0.f;
    }
    return;
  }
  const int col8 = (tid & 127) * 8, rg = tid >> 7;
  float w[5][8], bia[8];
#pragma unroll
  for (int j = 0; j < 5; ++j) { const f32x4 w0 = *(const f32x4*)(p.conv_w + ((size_t)l * 5 + j) * 1024 + col8), w1 = *(const f32x4*)(p.conv_w + ((size_t)l * 5 + j) * 1024 + col8 + 4);
#pragma unroll
    for (int k = 0; k < 4; ++k) { w[j][k] = w0[k]; w[j][4 + k] = w1[k]; } }
  { const f32x4 b0 = *(const f32x4*)(p.conv_b + l * 1024 + col8), b1 = *(const f32x4*)(p.conv_b + l * 1024 + col8 + 4);
#pragma unroll
    for (int k = 0; k < 4; ++k) { bia[k] = b0[k]; bia[4 + k] = b1[k]; } }
  const float osc = col8 < 512 ? 0.08838834764831845f : 1.f;
#pragma unroll 1
  for (int rb = obid() - 64; rb < MT / 64; rb += gridDim.x - 64) {
    const int R0 = rb * 64, seg_lo = R0 < MX ? (R0 & ~8191) : MX + ((R0 - MX) & ~255), seg_hi = seg_lo + (R0 < MX ? SEQ : CTXL);
    const int r0 = R0 + rg * 16;
    u32x4 raw[20];
#pragma unroll
    for (int i = 0; i < 20; ++i) { const int r = r0 - 2 + i; raw[i] = (u32x4){0u, 0u, 0u, 0u}; if (r >= seg_lo && r < seg_hi) raw[i] = *(const u32x4*)(P + (size_t)r * PLD + col8); }
#pragma unroll
    for (int i = 0; i < 16; ++i) {
      float y[8];
#pragma unroll
      for (int k = 0; k < 8; ++k) y[k] = bia[k];
#pragma unroll
      for (int tp = 0; tp < 5; ++tp) {
#pragma unroll
        for (int k = 0; k < 4; ++k) { y[2 * k] += w[tp][2 * k] * bflo(raw[i + tp][k]); y[2 * k + 1] += w[tp][2 * k + 1] * bfhi(raw[i + tp][k]); } }
#pragma unroll
      for (int k = 0; k < 8; ++k) y[k] = silu_f(y[k]) * osc;
      u32x4 o = {cvtpk(y[0], y[1]), cvtpk(y[2], y[3]), cvtpk(y[4], y[5]), cvtpk(y[6], y[7])};
      *(u32x4*)(QKC + (size_t)(r0 + i) * 1024 + col8) = o;
    }
  }
}

__device__ void phase_mlstm(PRef p, int l, char* smem) {
  bf16_t* QBb[2] = {(bf16_t*)(smem), (bf16_t*)(smem + 17408)};
  bf16_t* KB = (bf16_t*)(smem + 34816);
  bf16_t* KT = (bf16_t*)(smem + 52224);
  bf16_t* VTb[2] = {(bf16_t*)(smem + 70656), (bf16_t*)(smem + 77568)};
  bf16_t* VWT = (bf16_t*)(smem + 84480);
  bf16_t* PB = (bf16_t*)(smem + 91392);
  bf16_t* CTb[2] = {(bf16_t*)(smem + 100608), (bf16_t*)(smem + 113664)};
  float* SC = (float*)(smem + 126720);
  const bf16_t* P = (const bf16_t*)(p.ws + WS_P); const bf16_t* QKC = (const bf16_t*)(p.ws + WS_QKC); const float* SCAL = (const float*)(p.ws + WS_SCAL);
  bf16_t* hbuf = (bf16_t*)(p.ws + WS_HB);
  for (int w = obid(); w < 256; w += gridDim.x) {
    const int slice = (w >> 3) & 3, chain = (w & 7) * 8 + (w >> 5), dir = chain & 1, hd = (chain >> 1) & 3, b = chain >> 3;
    const float* SCc = SCAL + (size_t)chain * 132 * 384;
    __syncthreads();
    { const int tid = otid();
      for (int i = tid; i < 48 * 136 / 2; i += 512) { ((unsigned*)CTb[0])[i] = 0u; ((unsigned*)CTb[1])[i] = 0u; }
      for (int i = tid; i < 48 * 72 / 2; i += 512) { ((unsigned*)VTb[0])[i] = 0u; ((unsigned*)VTb[1])[i] = 0u; ((unsigned*)VWT)[i] = 0u; } }
    f32x4 accC[3];
#pragma unroll
    for (int i = 0; i < 3; ++i) accC[i] = (f32x4){0.f, 0.f, 0.f, 0.f};
    struct Pre { u32x4 qk[4]; u32x2 v; f32x4 s; float ws, ws1; };
    Pre preA, preB;
    preA.s = (f32x4){0.f, 0.f, 0.f, 0.f}; preB.s = preA.s;
#define MLSTM_PREFETCH(PR, CI) do { const int tid_ = otid(); const int ci_ = (CI); const bool ic_ = ci_ < 4; const int cc_ = ic_ ? ci_ : ci_ - 4, T_ = ic_ ? CTXL : SEQ, rb_ = ic_ ? MX + b * CTXL : b * SEQ; \
      const int tlo_ = dir ? T_ - 64 - cc_ * 64 : cc_ * 64; \
      _Pragma("unroll") for (int k_ = 0; k_ < 4; ++k_) { const int pc = tid_ + k_ * 512, tens = pc >> 10, rem = pc & 1023, lr = rem & 63, c16 = rem >> 6, t = dir ? tlo_ + 63 - lr : tlo_ + lr; \
        PR.qk[k_] = *(const u32x4*)(QKC + (size_t)(rb_ + t) * 1024 + tens * 512 + hd * 128 + c16 * 8); } \
      { const int vl_ = tid_ & 63, vt_ = dir ? tlo_ + 63 - vl_ : tlo_ + vl_; PR.v = *(const u32x2*)(P + (size_t)(rb_ + vt_) * PLD + OFF_V + hd * 128 + slice * 32 + (tid_ >> 6) * 4); \
        PR.ws = SCc[(size_t)ci_ * 384 + 256 + vl_]; PR.ws1 = SCc[(size_t)ci_ * 384 + 256 + (tid_ & 63)]; } \
      if (tid_ < 96) PR.s = *(const f32x4*)(SCc + (size_t)ci_ * 384 + tid_ * 4); } while (0)
    MLSTM_PREFETCH(preA, 0);
    MLSTM_PREFETCH(preB, 1);
    __syncthreads();
    auto step = [&](const int ci, Pre& pre) __attribute__((always_inline)) {
      const int tid = otid(), wid = tid >> 6, lane = tid & 63, fr = lane & 15, fq = lane >> 4;
      const bool isctx = ci < 4; const int cc = isctx ? ci : ci - 4, T = isctx ? CTXL : SEQ, rowbase = isctx ? MX + b * CTXL : b * SEQ;
      const int tlo = dir ? T - 64 - cc * 64 : cc * 64;
      const int par = ci & 1;
      bf16_t* QB = QBb[par]; bf16_t* VT = VTb[par]; float* S = SC + par * 384; bf16_t* CTc = CTb[par]; bf16_t* CTn = CTb[par ^ 1];
      const bool need_out = !(l == DEPTH - 1 && isctx);
#pragma unroll
      for (int k = 0; k < 4; ++k) { const int pc = tid + k * 512, tens = pc >> 10, rem = pc & 1023, lr = rem & 63, c16 = rem >> 6;
        if (tens == 0) *(u32x4*)(QB + lr * 136 + c16 * 8) = pre.qk[k];
        else { *(u32x4*)(KB + lr * 136 + c16 * 8) = pre.qk[k];
#pragma unroll
          for (int i = 0; i < 4; ++i) { KT[(c16 * 8 + 2 * i) * 72 + lr] = (bf16_t)(pre.qk[k][i] & 0xffffu); KT[(c16 * 8 + 2 * i + 1) * 72 + lr] = (bf16_t)(pre.qk[k][i] >> 16); } } }
      { const int vl = tid & 63, ve4 = (tid >> 6) * 4; const float wsl = pre.ws;
        VT[(ve4 + 0) * 72 + vl] = (bf16_t)(pre.v[0] & 0xffffu); VT[(ve4 + 1) * 72 + vl] = (bf16_t)(pre.v[0] >> 16);
        VT[(ve4 + 2) * 72 + vl] = (bf16_t)(pre.v[1] & 0xffffu); VT[(ve4 + 3) * 72 + vl] = (bf16_t)(pre.v[1] >> 16);
        VWT[(ve4 + 0) * 72 + vl] = f2bf(bflo(pre.v[0]) * wsl); VWT[(ve4 + 1) * 72 + vl] = f2bf(bfhi(pre.v[0]) * wsl);
        VWT[(ve4 + 2) * 72 + vl] = f2bf(bflo(pre.v[1]) * wsl); VWT[(ve4 + 3) * 72 + vl] = f2bf(bfhi(pre.v[1]) * wsl);
        if (tid < 64) { VT[32 * 72 + tid] = (bf16_t)0x3F80u; VWT[32 * 72 + tid] = f2bf(pre.ws1); }
        if (tid < 96) *(f32x4*)(S + tid * 4) = pre.s; }
      if (ci + 2 < 132) MLSTM_PREFETCH(pre, ci + 2);
      __syncthreads();
      if (need_out) {
        const int mt = wid >> 1;
#pragma unroll
        for (int u = 0; u < 2; ++u) {
          const int ntl = (wid & 1) * 2 + u;
          f32x4 sacc = {0.f, 0.f, 0.f, 0.f};
          if (ntl <= mt) {
#pragma unroll
            for (int kk = 0; kk < 4; ++kk) {
              const bf16x8 a = *(const bf16x8*)(QB + (mt * 16 + fr) * 136 + kk * 32 + fq * 8), bb = *(const bf16x8*)(KB + (ntl * 16 + fr) * 136 + kk * 32 + fq * 8);
              sacc = __builtin_amdgcn_mfma_f32_16x16x32_bf16(a, bb, sacc, 0, 0, 0); }
          }
          const int j = ntl * 16 + fr; const float aj = S[j];
#pragma unroll
          for (int jj = 0; jj < 4; ++jj) { const int lr = mt * 16 + fq * 4 + jj;
            const float pv = (j <= lr) ? sacc[jj] * __expf(fminf(aj - S[64 + lr], 0.f)) : 0.f;
            PB[lr * 72 + j] = f2bf(pv); }
        }
      }
      {
        const float decay = S[320];
#pragma unroll
        for (int mt = 0; mt < 3; ++mt) {
          accC[mt] *= decay;
#pragma unroll
          for (int kk = 0; kk < 2; ++kk) { const bf16x8 a = *(const bf16x8*)(VWT + (mt * 16 + fr) * 72 + kk * 32 + fq * 8), bb = *(const bf16x8*)(KT + (wid * 16 + fr) * 72 + kk * 32 + fq * 8);
            accC[mt] = __builtin_amdgcn_mfma_f32_16x16x32_bf16(a, bb, accC[mt], 0, 0, 0); }
#pragma unroll
          for (int jj = 0; jj < 4; ++jj) CTn[(mt * 16 + fq * 4 + jj) * 136 + wid * 16 + fr] = f2bf(accC[mt][jj]);
        }
      }
      __syncthreads();
      if (need_out && wid < 4) {
        const int mt = wid; f32x4 num[3];
#pragma unroll
        for (int ntl = 0; ntl < 3; ++ntl) {
          f32x4 a1 = {0.f, 0.f, 0.f, 0.f}, a2 = {0.f, 0.f, 0.f, 0.f};
#pragma unroll
          for (int kk = 0; kk < 2; ++kk) { const bf16x8 a = *(const bf16x8*)(PB + (mt * 16 + fr) * 72 + kk * 32 + fq * 8), bb = *(const bf16x8*)(VT + (ntl * 16 + fr) * 72 + kk * 32 + fq * 8);
            a1 = __builtin_amdgcn_mfma_f32_16x16x32_bf16(a, bb, a1, 0, 0, 0); }
#pragma unroll
          for (int kk = 0; kk < 4; ++kk) { const bf16x8 a = *(const bf16x8*)(QB + (mt * 16 + fr) * 136 + kk * 32 + fq * 8), bb = *(const bf16x8*)(CTc + (ntl * 16 + fr) * 136 + kk * 32 + fq * 8);
            a2 = __builtin_amdgcn_mfma_f32_16x16x32_bf16(a, bb, a2, 0, 0, 0); }
#pragma unroll
          for (int jj = 0; jj < 4; ++jj) num[ntl][jj] = a1[jj] + S[128 + mt * 16 + fq * 4 + jj] * a2[jj];
        }
#pragma unroll
        for (int jj = 0; jj < 4; ++jj) {
          const int lr = mt * 16 + fq * 4 + jj; const float den = __shfl(num[2][jj], lane & 48);
          const float rd = __builtin_amdgcn_rcpf(fmaxf(fabsf(den), S[192 + lr]));
          const int t = dir ? tlo + 63 - lr : tlo + lr;
          bf16_t* hp = hbuf + ((size_t)((dir * 4 + hd) * 4 + slice) * MT + rowbase + t) * 32 + fr;
          hp[0] = f2bf(num[0][jj] * rd); hp[16] = f2bf(num[1][jj] * rd);
        }
      }
    };
#pragma unroll 1
    for (int ci = 0; ci < 132; ci += 2) { step(ci, preA); step(ci + 1, preB); }
    __syncthreads();
  }
#undef MLSTM_PREFETCH
}

template <int WHICH>
__device__ __forceinline__ void mla_gemm(PRef p, int l, char* smem) {
  LAS unsigned char* lds = (LAS unsigned char*)smem; float* rsb = (float*)(smem + g8::STAGE_BYTES);
  const bf16_t* P = (const bf16_t*)(p.ws + WS_P);
  const int tid = otid(), wid = tid >> 6, lane = tid & 63, wr = wid >> 2, wc = wid & 3, fr = lane & 15, fq = lane >> 4;
  constexpr int K = WHICH ? 256 : 384, OFFC = WHICH ? OFF_CKV : OFF_CQ, N = WHICH ? 1024 : 768;
  const bf16_t* Wt = WHICH ? (const bf16_t*)(p.ws + WS_WUKV) + (size_t)l * 1024 * 256 : (const bf16_t*)(p.ws + WS_WUQ) + (size_t)l * 768 * 384;
  bf16_t* O = (bf16_t*)(p.ws + (WHICH ? WS_KV : WS_Q));
  g8::TileIter it; it.init((WHICH || l == 0) ? MT / 256 : MX / 256, N / 256);
  int pm, pn;
  while (it.next(pm, pn)) {
    __syncthreads();
    { const int r = tid >> 1, hf = tid & 1; const bf16_t* src = P + (size_t)(pm * 256 + r) * PLD + OFFC + hf * (K / 2); float s = 0.f;
#pragma unroll 4
      for (int i = 0; i < K / 16; ++i) { const u32x4 v = *(const u32x4*)(src + i * 8);
#pragma unroll
        for (int k = 0; k < 4; ++k) { const float a = bflo(v[k]), bq = bfhi(v[k]); s += a * a + bq * bq; } }
      s += __shfl_xor(s, 1);
      if (hf == 0) rsb[r] = rsqrtf(s / (float)K + 1e-6f); }
    unsigned voffA[2] = {g8::piece_off(0, PLD, OFFC), g8::piece_off(1, PLD, OFFC)};
    f32x4 acc[2][2][4][2];
    g8::gemm_tile<false>(lds, (const char*)(P + (size_t)pm * 256 * PLD), voffA, (size_t)128 * PLD * 2, (const char*)(Wt + (size_t)pn * 256 * K), opaque_s(K), acc);
    ACC_FOR3(ai, bj, m) {
      const int rl = ai * 128 + wr * 64 + m * 16 + fr, row = pm * 256 + rl, col = pn * 256 + bj * 128 + wc * 32 + fq * 8;
      const float rs = rsb[rl]; const f32x4 v0 = acc[ai][bj][m][0] * rs, v1 = acc[ai][bj][m][1] * rs;
      size_t orow = row;
      if (WHICH) orow = row < MX ? (size_t)(row >> 13) * SKV + CTXL + (row & 8191) : (size_t)((row - MX) >> 8) * SKV + ((row - MX) & 255);
      u32x4 w = {cvtpk(v0[0], v0[1]), cvtpk(v0[2], v0[3]), cvtpk(v1[0], v1[1]), cvtpk(v1[2], v1[3])}; *(u32x4*)(O + orow * N + col) = w;
    }
  }
}
__device__ void phase_mla_prep(PRef p, int l, char* smem) {
  mla_gemm<0>(p, l, smem);
  mla_gemm<1>(p, l, smem);
  const bf16_t* P = (const bf16_t*)(p.ws + WS_P);
  const int tid = otid(), wid = tid >> 6, lane = tid & 63;
  const bf16_t* hbuf = (const bf16_t*)(p.ws + WS_HB); bf16_t* mix = (bf16_t*)(p.ws + WS_MIX); bf16_t* KR = (bf16_t*)(p.ws + WS_KR);
  const float* cs = (const float*)(p.ws + WS_COS); const float* sn = (const float*)(p.ws + WS_SIN);
  const int gw = obid() * 8 + wid, nw = gridDim.x * 8;
  for (int row = gw; row < MT; row += nw) {
    if (row < MX || l == 0) {
      const size_t ho = ((size_t)(lane >> 2) * MT + row) * 32 + (lane & 3) * 8;
      const u32x4 hf = *(const u32x4*)(hbuf + ho), hb = *(const u32x4*)(hbuf + (size_t)16 * MT * 32 + ho);
      const u32x4 ov = *(const u32x4*)(P + (size_t)row * PLD + OFF_O + lane * 8);
      float v[8]; float s = 0.f;
#pragma unroll
      for (int k = 0; k < 4; ++k) { v[2 * k] = bflo(hf[k]) + bflo(hb[k]); v[2 * k + 1] = bfhi(hf[k]) + bfhi(hb[k]); s += v[2 * k] + v[2 * k + 1]; }
      s += __shfl_xor(s, 1); s += __shfl_xor(s, 2); s += __shfl_xor(s, 4); s += __shfl_xor(s, 8);
      const float mu = s * (1.f / 128.f); float q = 0.f;
#pragma unroll
      for (int k = 0; k < 8; ++k) { v[k] -= mu; q += v[k] * v[k]; }
      q += __shfl_xor(q, 1); q += __shfl_xor(q, 2); q += __shfl_xor(q, 4); q += __shfl_xor(q, 8);
      const float rs = rsqrtf(q * (1.f / 128.f) + 1e-6f);
      const float* nw_ = p.m_norm_w + l * 512 + lane * 8; float o[8];
#pragma unroll
      for (int k = 0; k < 4; ++k) { o[2 * k] = v[2 * k] * rs * nw_[2 * k] * sigmoid_f(bflo(ov[k])); o[2 * k + 1] = v[2 * k + 1] * rs * nw_[2 * k + 1] * sigmoid_f(bfhi(ov[k])); }
      u32x4 wv = {cvtpk(o[0], o[1]), cvtpk(o[2], o[3]), cvtpk(o[4], o[5]), cvtpk(o[6], o[7])};
      *(u32x4*)(mix + (size_t)row * 1024 + lane * 8) = wv;
    }
    {
      const int j = lane & 31;
      const float x1 = bf2f(P[(size_t)row * PLD + OFF_KR + j]), x2 = bf2f(P[(size_t)row * PLD + OFF_KR + 32 + j]);
      float o1 = x1, o2 = x2; size_t orow;
      if (row < MX) { const int t = row & 8191; const float c = cs[t * 32 + j], s_ = sn[t * 32 + j]; o1 = x1 * c - x2 * s_; o2 = x2 * c + x1 * s_; orow = (size_t)(row >> 13) * SKV + CTXL + t; }
      else orow = (size_t)((row - MX) >> 8) * SKV + ((row - MX) & 255);
      if (lane < 32) { KR[orow * 64 + j] = f2bf(o1); KR[orow * 64 + 32 + j] = f2bf(o2); }
    }
  }
}

namespace att {
constexpr int NW = 8, QBLK = 32, KVBLK = 64, LDQ = 768, LDK = 1024, LDKR = 64, LDO = 1024;
constexpr float SCALE = A_SCALE;
constexpr float THR = 8.f;
constexpr size_t SHM_V = KVBLK * 128 * 2, SHM_K = KVBLK * 128 * 2, SHM_R = KVBLK * 64 * 2;
typedef float f32x8 __attribute__((ext_vector_type(8)));
#define KSWZ(row, colB) ((row) * 256 + ((colB) ^ (((row) & 15) << 4)))
#define RSWZ(row, colB) ((row) * 128 + ((colB) ^ ((((row) >> 1) & 7) << 4)))
#define SBAR() __builtin_amdgcn_sched_barrier(0)
__device__ __forceinline__ int crow(int r, int hi) { return (r & 3) + 8 * (r >> 2) + 4 * hi; }
__device__ __forceinline__ void partialSM(f32x16& p0, f32x16& p1, float& m_reg, float& mn, float& alpha) {
  constexpr float C = SCALE * 1.4426950408889634f;
  float pmax = p0[0];
#pragma unroll
  for (int r = 1; r < 16; ++r) pmax = fmaxf(pmax, p0[r]);
#pragma unroll
  for (int r = 0; r < 16; ++r) pmax = fmaxf(pmax, p1[r]);
  { auto rr = __builtin_amdgcn_permlane32_swap(__float_as_uint(pmax), __float_as_uint(pmax), false, false);
    pmax = fmaxf(__uint_as_float(rr[0]), __uint_as_float(rr[1])); }
  if (__builtin_expect(__all(pmax - m_reg <= THR / SCALE), 1)) { mn = m_reg; alpha = 1.f; }
  else { mn = fmaxf(m_reg, pmax); alpha = __builtin_amdgcn_exp2f((m_reg - mn) * C); m_reg = mn; }
  const float mnC = -mn * C;
#pragma unroll
  for (int r = 0; r < 16; ++r) p0[r] = fmaf(p0[r], C, mnC);
#pragma unroll
  for (int r = 0; r < 16; ++r) p1[r] = fmaf(p1[r], C, mnC);
#pragma unroll
  for (int r = 0; r < 16; ++r) p0[r] = __builtin_amdgcn_exp2f(p0[r]);
}
__device__ __forceinline__ void finishSM(f32x16& p0, f32x16& p1, float alpha, float& l_reg, bf16x8& pa0, bf16x8& pa1, bf16x8& pa2, bf16x8& pa3) {
#pragma unroll
  for (int r = 0; r < 16; ++r) p1[r] = __builtin_amdgcn_exp2f(p1[r]);
  float ps = 0;
#pragma unroll
  for (int r = 0; r < 16; ++r) ps += p0[r];
#pragma unroll
  for (int r = 0; r < 16; ++r) ps += p1[r];
  { auto rr = __builtin_amdgcn_permlane32_swap(__float_as_uint(ps), __float_as_uint(ps), false, false);
    ps = __uint_as_float(rr[0]) + __uint_as_float(rr[1]); }
  l_reg = l_reg * alpha + ps;
#define PK4(P, BASE, OUT) do { unsigned a0 = cvtpk(P[BASE + 0], P[BASE + 1]), a1 = cvtpk(P[BASE + 2], P[BASE + 3]);   \
    unsigned b0 = cvtpk(P[BASE + 4], P[BASE + 5]), b1 = cvtpk(P[BASE + 6], P[BASE + 7]);                              \
    auto r0 = __builtin_amdgcn_permlane32_swap(a0, b0, false, false); auto r1 = __builtin_amdgcn_permlane32_swap(a1, b1, false, false); \
    u32x4 w = {r0[0], r1[0], r0[1], r1[1]}; OUT = *reinterpret_cast<bf16x8*>(&w); } while (0)
  PK4(p0, 0, pa0); PK4(p0, 8, pa1); PK4(p1, 0, pa2); PK4(p1, 8, pa3);
#undef PK4
}
__device__ __forceinline__ void qkt(f32x16& p0, f32x16& p1, const char* Ks, const char* Rs, const bf16x8* qr, const char* qrl, int r32, int hi) {
  p0 = f32x16{}; p1 = f32x16{};
#pragma unroll
  for (int d0 = 0; d0 < 8; ++d0) { const int cb = (d0 * 16 + hi * 8) * 2;
    const bf16x8 b0 = *reinterpret_cast<const bf16x8*>(Ks + KSWZ(r32, cb));
    const bf16x8 b1 = *reinterpret_cast<const bf16x8*>(Ks + KSWZ(32 + r32, cb));
    p0 = __builtin_amdgcn_mfma_f32_32x32x16_bf16(b0, qr[d0], p0, 0, 0, 0);
    p1 = __builtin_amdgcn_mfma_f32_32x32x16_bf16(b1, qr[d0], p1, 0, 0, 0); }
#pragma unroll
  for (int d0 = 0; d0 < 4; ++d0) { const int cb = (d0 * 16 + hi * 8) * 2;
    const bf16x8 b0 = *reinterpret_cast<const bf16x8*>(Rs + RSWZ(r32, cb));
    const bf16x8 b1 = *reinterpret_cast<const bf16x8*>(Rs + RSWZ(32 + r32, cb));
    p0 = __builtin_amdgcn_mfma_f32_32x32x16_bf16(b0, qr[8 + d0], p0, 0, 0, 0);
    p1 = __builtin_amdgcn_mfma_f32_32x32x16_bf16(b1, qr[8 + d0], p1, 0, 0, 0); }
}
__device__ __forceinline__ int v_st(int k, int c) { const int kk = (k & ~0xC) | ((k & 4) << 1) | ((k & 8) >> 1); return ((kk >> 3) * 4 + (c >> 5)) * 512 + ((kk & 7) * 32 + (c & 31)) * 2; }
__device__ __forceinline__ int v_rd_base(int lane) { return ((lane & 3) << 3) | (((lane >> 2) & 3) << 6) | (((lane >> 4) & 1) << 5) | (((lane >> 5) & 1) << 8); }
constexpr int v_rd_off(int d0, int ks, int half) { return d0 * 512 + ks * 4096 + half * 2048; }
template <int OFF> __device__ __forceinline__ s16x4 tr_read(int vb) {
  s16x4 r; asm volatile("ds_read_b64_tr_b16 %0, %1 offset:%2" : "=&v"(r) : "v"(vb), "i"(OFF) : "memory"); return r;
}
template <int D0> __device__ __forceinline__ void pv_one(f32x16& od, int vb, bf16x8 pa0, bf16x8 pa1, bf16x8 pa2, bf16x8 pa3) {
  const s16x4 l0 = tr_read<v_rd_off(D0, 0, 0)>(vb), h0 = tr_read<v_rd_off(D0, 0, 1)>(vb), l1 = tr_read<v_rd_off(D0, 1, 0)>(vb), h1 = tr_read<v_rd_off(D0, 1, 1)>(vb);
  const s16x4 l2 = tr_read<v_rd_off(D0, 2, 0)>(vb), h2 = tr_read<v_rd_off(D0, 2, 1)>(vb), l3 = tr_read<v_rd_off(D0, 3, 0)>(vb), h3 = tr_read<v_rd_off(D0, 3, 1)>(vb);
  asm volatile("s_waitcnt lgkmcnt(0)" ::: "memory"); SBAR();
#define PK(L, H) (bf16x8){L[0], L[1], L[2], L[3], H[0], H[1], H[2], H[3]}
  od = __builtin_amdgcn_mfma_f32_32x32x16_bf16(pa0, PK(l0, h0), od, 0, 0, 0);
  od = __builtin_amdgcn_mfma_f32_32x32x16_bf16(pa1, PK(l1, h1), od, 0, 0, 0);
  od = __builtin_amdgcn_mfma_f32_32x32x16_bf16(pa2, PK(l2, h2), od, 0, 0, 0);
  od = __builtin_amdgcn_mfma_f32_32x32x16_bf16(pa3, PK(l3, h3), od, 0, 0, 0);
#undef PK
}
__device__ __forceinline__ void pv_d0(f32x16* o, int vb, bf16x8 pa0, bf16x8 pa1, bf16x8 pa2, bf16x8 pa3) {
  pv_one<0>(o[0], vb, pa0, pa1, pa2, pa3); pv_one<1>(o[1], vb, pa0, pa1, pa2, pa3); pv_one<2>(o[2], vb, pa0, pa1, pa2, pa3); pv_one<3>(o[3], vb, pa0, pa1, pa2, pa3);
}
__device__ __forceinline__ void attn_body(const bf16_t* __restrict__ Qb, const float* __restrict__ cs, const float* __restrict__ sn, const bf16_t* __restrict__ Kn,
                                          const bf16_t* __restrict__ Vh, const bf16_t* __restrict__ Kr, bf16_t* __restrict__ Ob, int seq, char* lds) {
  const int tid = otid(), wid = tid >> 6, lane = tid & 63, r32 = lane & 31, hi = lane >> 5;
  char* V_lds = lds; char* K_lds = lds + 2 * SHM_V; char* R_lds = lds + 2 * SHM_V + 2 * SHM_K;
  float* wsf = (float*)(lds + 2 * SHM_V + 2 * SHM_K + 2 * SHM_R) + wid * 64; float* li_l = wsf; float* al_l = wsf + 32;
  char* qrl = lds + 2 * SHM_V + 2 * SHM_K + 2 * SHM_R + 2048 + wid * 4096 + lane * 16;
  float m_reg = -1e30f, l_reg = 0; f32x16 o[4] = {}; bf16x8 qr[12];
  { const bf16_t* Qw = Qb + (size_t)(wid * QBLK + r32) * LDQ + hi * 8;
#pragma unroll
    for (int d0 = 0; d0 < 8; ++d0) qr[d0] = *(const bf16x8*)(Qw + d0 * 16);
#pragma unroll
    for (int d0 = 0; d0 < 2; ++d0) {
      const u32x4 a = *(const u32x4*)(Qw + 128 + d0 * 16), bq = *(const u32x4*)(Qw + 160 + d0 * 16);
      if (cs) {
        const float* cp = cs + (size_t)(wid * QBLK + r32) * 32 + d0 * 16 + hi * 8; const float* sp = sn + (size_t)(wid * QBLK + r32) * 32 + d0 * 16 + hi * 8;
        const f32x4 c0 = *(const f32x4*)cp, c1 = *(const f32x4*)(cp + 4), s0 = *(const f32x4*)sp, s1 = *(const f32x4*)(sp + 4);
        float x1[8], x2[8], y1[8], y2[8];
#pragma unroll
        for (int k = 0; k < 4; ++k) { x1[2 * k] = bflo(a[k]); x1[2 * k + 1] = bfhi(a[k]); x2[2 * k] = bflo(bq[k]); x2[2 * k + 1] = bfhi(bq[k]); }
#pragma unroll
        for (int k = 0; k < 8; ++k) { const float c = k < 4 ? c0[k & 3] : c1[k & 3], s = k < 4 ? s0[k & 3] : s1[k & 3]; y1[k] = x1[k] * c - x2[k] * s; y2[k] = x2[k] * c + x1[k] * s; }
        u32x4 w1 = {cvtpk(y1[0], y1[1]), cvtpk(y1[2], y1[3]), cvtpk(y1[4], y1[5]), cvtpk(y1[6], y1[7])}, w2 = {cvtpk(y2[0], y2[1]), cvtpk(y2[2], y2[3]), cvtpk(y2[4], y2[5]), cvtpk(y2[6], y2[7])};
        qr[8 + d0] = *reinterpret_cast<bf16x8*>(&w1); qr[10 + d0] = *reinterpret_cast<bf16x8*>(&w2);
      } else { u32x4 a_ = a, b_ = bq; qr[8 + d0] = *reinterpret_cast<bf16x8*>(&a_); qr[10 + d0] = *reinterpret_cast<bf16x8*>(&b_); }
    } }
  const int sr = tid >> 4, sc = (tid & 15) * 8, vst0 = v_st(sr, sc), vst1 = v_st(32 + sr, sc);
  const int rr_ = tid >> 3, rc = (tid & 7) * 8;
  const int vb0 = (int)(uintptr_t)V_lds + v_rd_base(lane);
  bf16x8 vs0, vs1, ks0, ks1, rs0;
  const unsigned voffKV = (unsigned)(sr * LDK + sc) * 2u, voffR = (unsigned)(rr_ * LDKR + rc) * 2u;
#define SLOAD(k0) do { const char* kb_ = (const char*)Kn + (size_t)(k0) * (LDK * 2); const char* vb_ = (const char*)Vh + (size_t)(k0) * (LDK * 2); \
    vs0 = *(const bf16x8*)(vb_ + voffKV); vs1 = *(const bf16x8*)(vb_ + 32 * LDK * 2 + voffKV); \
    ks0 = *(const bf16x8*)(kb_ + voffKV); ks1 = *(const bf16x8*)(kb_ + 32 * LDK * 2 + voffKV); \
    rs0 = *(const bf16x8*)((const char*)Kr + (size_t)(k0) * (LDKR * 2) + voffR); } while (0)
#define SWRITE(b) do { *(bf16x8*)(V_lds + (b) * SHM_V + vst0) = vs0; *(bf16x8*)(V_lds + (b) * SHM_V + vst1) = vs1; const int kc = sc * 2;  \
    *(bf16x8*)(K_lds + (b) * SHM_K + KSWZ(sr, kc)) = ks0; *(bf16x8*)(K_lds + (b) * SHM_K + KSWZ(32 + sr, kc)) = ks1;                      \
    *(bf16x8*)(R_lds + (b) * SHM_R + RSWZ(rr_, rc * 2)) = rs0; } while (0)
#define RESC(a) do { if (__any((a) < 1.f)) { if (hi == 0) al_l[r32] = (a); asm volatile("s_waitcnt lgkmcnt(0)" ::: "memory"); \
    _Pragma("unroll") for (int d = 0; d < 4; ++d) _Pragma("unroll") for (int r = 0; r < 16; ++r) o[d][r] *= al_l[crow(r, hi)]; } } while (0)
  f32x16 pA0, pA1, pB0, pB1; float mnA, mnB, alA, alB; bf16x8 pa0, pa1, pa2, pa3; const int NT = seq / KVBLK;
  SLOAD(0); SWRITE(0); __syncthreads();
  qkt(pA0, pA1, K_lds, R_lds, qr, qrl, r32, hi); partialSM(pA0, pA1, m_reg, mnA, alA);
  SLOAD(KVBLK); SWRITE(1); __syncthreads();
  for (int j = 1; j + 1 < NT; j += 2) {
    SBAR(); qkt(pB0, pB1, K_lds + SHM_K, R_lds + SHM_R, qr, qrl, r32, hi);
    finishSM(pA0, pA1, alA, l_reg, pa0, pa1, pa2, pa3); SBAR();
    SLOAD((j + 1) * KVBLK); SBAR();
    pv_d0(o, vb0, pa0, pa1, pa2, pa3); partialSM(pB0, pB1, m_reg, mnB, alB);
    __syncthreads(); SWRITE(0);
    RESC(alB); __syncthreads();
    SBAR(); qkt(pA0, pA1, K_lds, R_lds, qr, qrl, r32, hi);
    finishSM(pB0, pB1, alB, l_reg, pa0, pa1, pa2, pa3); SBAR();
    SLOAD((j + 2) * KVBLK); SBAR();
    pv_d0(o, vb0 + (int)SHM_V, pa0, pa1, pa2, pa3); partialSM(pA0, pA1, m_reg, mnA, alA);
    __syncthreads(); SWRITE(1);
    RESC(alA); __syncthreads();
  }
  SBAR(); qkt(pB0, pB1, K_lds + SHM_K, R_lds + SHM_R, qr, qrl, r32, hi);
  finishSM(pA0, pA1, alA, l_reg, pa0, pa1, pa2, pa3); SBAR();
  pv_d0(o, vb0, pa0, pa1, pa2, pa3); partialSM(pB0, pB1, m_reg, mnB, alB);
  __syncthreads(); RESC(alB);
  finishSM(pB0, pB1, alB, l_reg, pa0, pa1, pa2, pa3); SBAR();
  pv_d0(o, vb0 + (int)SHM_V, pa0, pa1, pa2, pa3);
  if (hi == 0) li_l[r32] = l_reg; asm volatile("s_waitcnt lgkmcnt(0)" ::: "memory");
  float rli[16];
#pragma unroll
  for (int r = 0; r < 16; ++r) rli[r] = __builtin_amdgcn_rcpf(li_l[crow(r, hi)]);
  bf16_t* Ow = Ob + (size_t)(wid * QBLK) * LDO;
#pragma unroll
  for (int r = 0; r < 16; ++r) { const int orow = crow(r, hi);
#pragma unroll
    for (int d0 = 0; d0 < 4; ++d0) Ow[(size_t)orow * LDO + d0 * 32 + r32] = f2bf(o[d0][r] * rli[r]); }
  __syncthreads();
#undef SLOAD
#undef SWRITE
#undef RESC
}
}

__device__ void phase_attn(PRef p, int l, char* smem) {
  const bf16_t* Q = (const bf16_t*)(p.ws + WS_Q); const bf16_t* KV = (const bf16_t*)(p.ws + WS_KV); const bf16_t* KR = (const bf16_t*)(p.ws + WS_KR);
  bf16_t* mix = (bf16_t*)(p.ws + WS_MIX); const float* cs = (const float*)(p.ws + WS_COS); const float* sn = (const float*)(p.ws + WS_SIN);
  const int nunits = 1024 + (l == 0 ? 32 : 0);
  for (int u = obid(); u < nunits; u += gridDim.x) {
    if (u < 1024) {
      const int bh = (u >> 8) * 8 + (u & 7), qb = (u & 255) >> 3, hd = bh & 3, b = bh >> 2; const size_t row0 = (size_t)b * SEQ + qb * 256;
      att::attn_body(Q + row0 * 768 + hd * 192, cs + (size_t)qb * 256 * 32, sn + (size_t)qb * 256 * 32, KV + (size_t)b * SKV * 1024 + hd * 256,
                     KV + (size_t)b * SKV * 1024 + hd * 256 + 128, KR + (size_t)b * SKV * 64, mix + row0 * 1024 + 512 + hd * 128, SKV, smem);
    } else {
      const int v = u - 1024, hd = v & 3, b = v >> 2; const size_t row0 = (size_t)MX + b * CTXL;
      att::attn_body(Q + row0 * 768 + hd * 192, nullptr, nullptr, KV + (size_t)b * SKV * 1024 + hd * 256,
                     KV + (size_t)b * SKV * 1024 + hd * 256 + 128, KR + (size_t)b * SKV * 64, mix + row0 * 1024 + 512 + hd * 128, CTXL, smem);
    }
  }
}

__device__ void phase_outproj(PRef p, int l, char* smem) {
  LAS unsigned char* lds = (LAS unsigned char*)smem;
  const bf16_t* mix = (const bf16_t*)(p.ws + WS_MIX); const bf16_t* Wt = (const bf16_t*)(p.ws + WS_WOUT) + (size_t)l * 1024 * 1024;
  float* ctxz = (float*)(p.ws + WS_CTXZ);
  const int tid = otid(), wid = tid >> 6, lane = tid & 63, wr = wid >> 2, wc = wid & 3, fr = lane & 15, fq = lane >> 4;
  g8::TileIter it; it.init(l == 0 ? MT / 256 : MX / 256, 4);
  int pm, pn;
  while (it.next(pm, pn)) {
    unsigned voffA[2] = {g8::piece_off(0, 1024, 0), g8::piece_off(1, 1024, 0)};
    f32x4 acc[2][2][4][2];
    g8::gemm_tile<false>(lds, (const char*)(mix + (size_t)pm * 256 * 1024), voffA, (size_t)128 * 1024 * 2, (const char*)(Wt + (size_t)pn * 256 * 1024), 1024, acc);
    ACC_FOR(ai, bj, m, n) {
      const int row = pm * 256 + ai * 128 + wr * 64 + m * 16 + fr, col = pn * 256 + bj * 128 + wc * 32 + fq * 8 + n * 4;
      const float* res = l == 0 ? (row < MX ? p.x + (size_t)row * 1024 : p.ctx + (size_t)(row - MX) * 1024) : p.out + (size_t)row * 1024;
      float* dst = row < MX ? p.out + (size_t)row * 1024 : ctxz + (size_t)(row - MX) * 1024;
      const f32x4 r = *(const f32x4*)(res + col), g = *(const f32x4*)(mod_ptr(p, l, row, 2) + col);
      *(f32x4*)(dst + col) = r * ALPHA + g * acc[ai][bj][m][n];
    }
  }
}

__device__ void phase_ln1(PRef p, int l, char* smem) {
  float* wrt = (float*)smem;
  for (int i = otid(); i < 16384; i += 512) wrt[(i & 15) * 1024 + (i >> 4)] = p.w_router[(size_t)l * 16384 + i];
  __syncthreads();
  const int lane = otid() & 63, gw = obid() * 8 + (otid() >> 6), nw = gridDim.x * 8;
  bf16_t* h = (bf16_t*)(p.ws + WS_H); float* ctxz = (float*)(p.ws + WS_CTXZ); float* aff = (float*)(p.ws + WS_AFF);
  const int nrows = l == 0 ? MT : MX;
  for (int row = gw; row < nrows; row += nw) {
    asm volatile("" ::: "memory");
    float* zr = row < MX ? p.out + (size_t)row * 1024 : ctxz + (size_t)(row - MX) * 1024;
    f32x4 v[4];
#pragma unroll
    for (int i = 0; i < 4; ++i) v[i] = *(const f32x4*)(zr + lane * 4 + 256 * i);
    ln_row(v, 1e-5f);
#pragma unroll
    for (int i = 0; i < 4; ++i) { const int c = lane * 4 + 256 * i; v[i] = v[i] * *(const f32x4*)(p.ln1_g + l * 1024 + c) + *(const f32x4*)(p.ln1_b + l * 1024 + c); *(f32x4*)(zr + c) = v[i]; }
    ln_row(v, 1e-6f);
    f32x4 hm[4];
    store_mod_bf16(v, mod_ptr(p, l, row, 3), mod_ptr(p, l, row, 4), h + (size_t)row * 1024, lane, &hm);
    float lg[16];
#pragma unroll
    for (int e = 0; e < 16; ++e) { float s = 0.f;
#pragma unroll
      for (int i = 0; i < 4; ++i) { const f32x4 w = *(const f32x4*)(wrt + e * 1024 + lane * 4 + 256 * i); s += hm[i][0] * w[0] + hm[i][1] * w[1] + hm[i][2] * w[2] + hm[i][3] * w[3]; }
      lg[e] = wave_sum(s); }
    float mx = lg[0];
#pragma unroll
    for (int e = 1; e < 16; ++e) mx = fmaxf(mx, lg[e]);
    float den = 0.f;
#pragma unroll
    for (int e = 0; e < 16; ++e) { lg[e] = expf(lg[e] - mx); den += lg[e]; }
    float mine = 0.f;
#pragma unroll
    for (int e = 0; e < 16; ++e) if (lane == e) mine = lg[e] / den;
    if (lane < 16) aff[(size_t)row * 16 + lane] = mine;
  }
}

template <int PER>
__device__ __forceinline__ void topk_item(const float* __restrict__ affp, int n, int kcap, int rowbase, int slotbase, int e, int* __restrict__ IDX, float* __restrict__ GV, int* __restrict__ TS, char* smem) {
  unsigned* hist = (unsigned*)smem; unsigned* sel = hist + 256; unsigned* wtot = hist + 272;
  const int tid = otid(), lane = tid & 63, wid = tid >> 6;
  const bool active = tid * PER < n;
  unsigned key[PER];
#pragma unroll
  for (int i = 0; i < PER; ++i) key[i] = active ? __float_as_uint(affp[(size_t)(tid * PER + i) * 16]) : 0u;
  unsigned prefix = 0u, mask = 0u; int kk = kcap;
#pragma unroll 1
  for (int shift = 24; shift >= 0; shift -= 8) {
    __syncthreads();
    if (tid < 256) hist[tid] = 0u;
    __syncthreads();
#pragma unroll
    for (int i = 0; i < PER; ++i) if (active && (key[i] & mask) == prefix) atomicAdd(&hist[(key[i] >> shift) & 255u], 1u);
    __syncthreads();
    if (wid == 0) {
      const unsigned h0 = hist[lane * 4], h1 = hist[lane * 4 + 1], h2 = hist[lane * 4 + 2], h3 = hist[lane * 4 + 3];
      const unsigned tot = h0 + h1 + h2 + h3; unsigned suf = tot;
#pragma unroll
      for (int o = 1; o < 64; o <<= 1) { const unsigned u = __shfl_down(suf, o); if (lane + o < 64) suf += u; }
      const unsigned above = suf - tot;
      if (above < (unsigned)kk && suf >= (unsigned)kk) {
        unsigned a = above; int bin;
        if (a + h3 >= (unsigned)kk) bin = 3; else { a += h3; if (a + h2 >= (unsigned)kk) bin = 2; else { a += h2; if (a + h1 >= (unsigned)kk) bin = 1; else { a += h1; bin = 0; } } }
        sel[0] = prefix | ((unsigned)(lane * 4 + bin) << shift); sel[1] = (unsigned)kk - a;
      }
    }
    __syncthreads();
    prefix = sel[0]; kk = (int)sel[1]; mask |= 0xffu << shift;
  }
  const unsigned Tk = prefix;
  unsigned cg_ = 0, ce = 0;
#pragma unroll
  for (int i = 0; i < PER; ++i) { cg_ += key[i] > Tk; ce += key[i] == Tk; }
  unsigned pk = active ? (cg_ | (ce << 16)) : 0u, inc = pk;
#pragma unroll
  for (int o = 1; o < 64; o <<= 1) { const unsigned u = __shfl_up(inc, o); if (lane >= o) inc += u; }
  __syncthreads();
  if (lane == 63) wtot[wid] = inc;
  __syncthreads();
  unsigned base = 0;
  for (int w2 = 0; w2 < wid; ++w2) base += wtot[w2];
  const unsigned exc = base + inc - pk; unsigned gt_before = exc & 0xffffu, eq_before = exc >> 16;
  if (active) {
#pragma unroll
    for (int i = 0; i < PER; ++i) {
      const int t = tid * PER + i; int R = -1;
      const bool isgt = key[i] > Tk, iseq = key[i] == Tk;
      if (isgt || (iseq && (int)eq_before < kk)) {
        const int slot = (int)gt_before + min((int)eq_before, kk);
        R = slotbase + slot; IDX[R] = rowbase + t; GV[R] = __uint_as_float(key[i]);
      }
      TS[t] = R;
      gt_before += isgt; eq_before += iseq;
    }
  }
}
__device__ void phase_topk(PRef p, int l, char* smem) {
  const float* aff = (const float*)(p.ws + WS_AFF); int* IDX = (int*)(p.ws + WS_IDX); float* GV = (float*)(p.ws + WS_GV); int* TS = (int*)(p.ws + WS_TS);
  const int nitems = l == 0 ? 256 : 128;
  for (int it = obid(); it < nitems; it += gridDim.x) {
    if (it < 128) { const int b = it >> 4, e = it & 15; topk_item<16>(aff + (size_t)b * SEQ * 16 + e, SEQ, CAPX, b * SEQ, it * CAPX, e, IDX, GV, TS + (size_t)it * SEQ, smem); }
    else { const int v = it - 128, b = v >> 4, e = v & 15; topk_item<1>(aff + ((size_t)MX + b * CTXL) * 16 + e, CTXL, CAPC, MX + b * CTXL, NB * NE * CAPX + e * 256 + b * CAPC, e, IDX, GV, TS + (size_t)NB * 16 * SEQ + (size_t)v * CTXL, smem); }
  }
  __syncthreads();
}

__device__ void phase_moe_up(PRef p, int l, char* smem) {
  LAS unsigned char* lds = (LAS unsigned char*)smem;
  const bf16_t* h = (const bf16_t*)(p.ws + WS_H); const bf16_t* Wgu = (const bf16_t*)(p.ws + WS_WGU); bf16_t* act = (bf16_t*)(p.ws + WS_ACT); const int* IDX = (const int*)(p.ws + WS_IDX);
  const int tid = otid(), wid = tid >> 6, lane = tid & 63, wr = wid >> 2, wc = wid & 3, fr = lane & 15, fq = lane >> 4;
  g8::MoeIter it; it.init(8, l == 0);
  int pm, pn, e;
  while (it.next(pm, pn, e)) {
    unsigned voffA[4];
#pragma unroll
    for (int hh = 0; hh < 2; ++hh)
#pragma unroll
      for (int i = 0; i < 2; ++i) { int R, C; g8::piece_rc(i, R, C); voffA[hh * 2 + i] = (unsigned)(IDX[pm * 256 + hh * 128 + R] * 1024 + C) * 2u; }
    f32x4 acc[2][2][4][2];
    g8::gemm_tile<true>(lds, (const char*)h, voffA, 0, (const char*)(Wgu + ((size_t)e * 2048 + pn * 256) * 1024), 1024, acc);
#pragma unroll
    for (int ai = 0; ai < 2; ++ai)
#pragma unroll
      for (int m = 0; m < 4; ++m) {
          const int row = pm * 256 + ai * 128 + wr * 64 + m * 16 + fr, col = pn * 128 + wc * 32 + fq * 8;
          float a[8];
#pragma unroll
          for (int n = 0; n < 2; ++n) { const f32x4 g = acc[ai][0][m][n], u = acc[ai][1][m][n];
#pragma unroll
            for (int k = 0; k < 4; ++k) a[n * 4 + k] = silu_f(g[k]) * u[k]; }
          u32x4 w = {cvtpk(a[0], a[1]), cvtpk(a[2], a[3]), cvtpk(a[4], a[5]), cvtpk(a[6], a[7])}; *(u32x4*)(act + (size_t)row * 1024 + col) = w;
        }
  }
}
__device__ void phase_moe_down(PRef p, int l, char* smem) {
  LAS unsigned char* lds = (LAS unsigned char*)smem;
  const bf16_t* act = (const bf16_t*)(p.ws + WS_ACT); const bf16_t* Wdn = (const bf16_t*)(p.ws + WS_WDN); bf16_t* oute = (bf16_t*)(p.ws + WS_OUTE); const float* GV = (const float*)(p.ws + WS_GV);
  const int tid = otid(), wid = tid >> 6, lane = tid & 63, wr = wid >> 2, wc = wid & 3, fr = lane & 15, fq = lane >> 4;
  g8::MoeIter it; it.init(4, l == 0);
  int pm, pn, e;
  while (it.next(pm, pn, e)) {
    unsigned voffA[2] = {g8::piece_off(0, 1024, 0), g8::piece_off(1, 1024, 0)};
    f32x4 acc[2][2][4][2];
    g8::gemm_tile<false>(lds, (const char*)(act + (size_t)pm * 256 * 1024), voffA, (size_t)128 * 1024 * 2, (const char*)(Wdn + ((size_t)e * 1024 + pn * 256) * 1024), 1024, acc);
    ACC_FOR3(ai, bj, m) {
      const int row = pm * 256 + ai * 128 + wr * 64 + m * 16 + fr, col = pn * 256 + bj * 128 + wc * 32 + fq * 8;
      const float gv = GV[row]; const f32x4 v0 = acc[ai][bj][m][0] * gv, v1 = acc[ai][bj][m][1] * gv;
      u32x4 w = {cvtpk(v0[0], v0[1]), cvtpk(v0[2], v0[3]), cvtpk(v1[0], v1[1]), cvtpk(v1[2], v1[3])}; *(u32x4*)(oute + (size_t)row * 1024 + col) = w;
    }
  }
}

__device__ void phase_ln2(PRef p, int l) {
  const int lane = otid() & 63, gw = obid() * 8 + (otid() >> 6), nw = gridDim.x * 8;
  bf16_t* h = (bf16_t*)(p.ws + WS_H); float* ctxz = (float*)(p.ws + WS_CTXZ); const bf16_t* oute = (const bf16_t*)(p.ws + WS_OUTE); const int* TS = (const int*)(p.ws + WS_TS);
  const int nrows = l == 0 ? MT : MX;
  for (int row = gw; row < nrows; row += nw) {
    float* xr = row < MX ? p.out + (size_t)row * 1024 : ctxz + (size_t)(row - MX) * 1024;
    f32x4 mo[4];
#pragma unroll
    for (int i = 0; i < 4; ++i) mo[i] = (f32x4){0.f, 0.f, 0.f, 0.f};
    const int myR = lane < 16 ? (row < MX ? TS[((size_t)(row >> 13) * 16 + lane) * SEQ + (row & 8191)] : TS[(size_t)NB * 16 * SEQ + ((size_t)((row - MX) >> 8) * 16 + lane) * CTXL + ((row - MX) & 255)]) : -1;
    unsigned long long hits = __ballot(myR >= 0) & 0xffffull;
    while (hits) { const int e = __builtin_ctzll(hits); hits &= hits - 1; const int Rr = __shfl(myR, e);
      {
#pragma unroll
        for (int i = 0; i < 4; ++i) { const u32x2 w = *(const u32x2*)(oute + (size_t)Rr * 1024 + lane * 4 + 256 * i);
          mo[i][0] += bflo(w[0]); mo[i][1] += bfhi(w[0]); mo[i][2] += bflo(w[1]); mo[i][3] += bfhi(w[1]); } } }
    f32x4 v[4]; const float* m5 = mod_ptr(p, l, row, 5);
#pragma unroll
    for (int i = 0; i < 4; ++i) { const int c = lane * 4 + 256 * i; v[i] = *(const f32x4*)(xr + c) * ALPHA + *(const f32x4*)(m5 + c) * mo[i]; }
    ln_row(v, 1e-5f);
#pragma unroll
    for (int i = 0; i < 4; ++i) { const int c = lane * 4 + 256 * i; v[i] = v[i] * *(const f32x4*)(p.ln2_g + l * 1024 + c) + *(const f32x4*)(p.ln2_b + l * 1024 + c); *(f32x4*)(xr + c) = v[i]; }
    if (l + 1 < DEPTH) { ln_row(v, 1e-6f); store_mod_bf16(v, mod_ptr(p, l + 1, row, 0), mod_ptr(p, l + 1, row, 1), h + (size_t)row * 1024, lane, nullptr); }
  }
}

__device__ __forceinline__ void gsync(cg::grid_group& grid) {
  asm volatile("s_waitcnt vmcnt(0) lgkmcnt(0)" ::: "memory");
  grid.sync();
}
#define XB_CEN(j) (64 * (j))
#define XB_SUB(j) (1024 + 64 * (j))
#define XB_TOP 2048
struct FastBar { unsigned* w; unsigned xcc, nloc, nx, epoch; };
__device__ __forceinline__ unsigned xb_ld(unsigned* q) { return __hip_atomic_load(q, __ATOMIC_RELAXED, __HIP_MEMORY_SCOPE_AGENT); }
__device__ __forceinline__ unsigned xb_add(unsigned* q, unsigned v) { return __hip_atomic_fetch_add(q, v, __ATOMIC_RELAXED, __HIP_MEMORY_SCOPE_AGENT); }
__device__ __forceinline__ void fsync(FastBar& fb) {
  asm volatile("s_waitcnt vmcnt(0) lgkmcnt(0)" ::: "memory");
  __syncthreads();
  fb.epoch += 1u;
  if (otid() == 0) {
    const unsigned a = xb_add(&fb.w[XB_SUB(fb.xcc)], 1u) + 1u;
    if (a == fb.nloc * fb.epoch) {
      __builtin_amdgcn_fence(__ATOMIC_RELEASE, "agent");
      asm volatile("s_waitcnt vmcnt(0)" ::: "memory");
      (void)xb_add(&fb.w[XB_TOP], 1u);
    }
    while (xb_ld(&fb.w[XB_TOP]) < fb.nx * fb.epoch) __builtin_amdgcn_s_sleep(1);
    __builtin_amdgcn_fence(__ATOMIC_ACQUIRE, "agent");
    asm volatile("s_waitcnt vmcnt(0)" ::: "memory");
  }
  __syncthreads();
}
__global__ void __launch_bounds__(512) mega(Params p) {
  extern __shared__ __attribute__((aligned(16))) char smem[];
  cg::grid_group grid = cg::this_grid();
  FastBar fb; fb.w = (unsigned*)(kparams().ws + WS_BAR); fb.xcc = (unsigned)__builtin_amdgcn_readfirstlane((int)(__builtin_amdgcn_s_getreg((3 << 11) | 20) & 0xF)); fb.epoch = 0u; fb.nloc = 0u; fb.nx = 0u;
  if (otid() == 0) (void)xb_add(&fb.w[XB_CEN(fb.xcc)], 1u);
  phase_prep(kparams(), smem);
  if (kparams().out == nullptr) gsync(grid);
  if (otid() == 0) { for (;;) { unsigned sum = 0u;
#pragma unroll 1
      for (int j = 0; j < 16; ++j) sum += xb_ld(&fb.w[XB_CEN(j)]);
      if (sum == gridDim.x) break; __builtin_amdgcn_s_sleep(2); } }
  __syncthreads();
  { unsigned nx = 0u;
#pragma unroll 1
    for (int j = 0; j < 16; ++j) nx += xb_ld(&fb.w[XB_CEN(j)]) != 0u;
    fb.nx = (unsigned)__builtin_amdgcn_readfirstlane((int)nx); fb.nloc = (unsigned)__builtin_amdgcn_readfirstlane((int)xb_ld(&fb.w[XB_CEN(fb.xcc)])); }
  fsync(fb);
  phase_h0(kparams());
  fsync(fb);
#pragma unroll 1
  for (int l = 0; l < DEPTH; ++l) {
    phase_inproj(kparams(), l, smem);
    fsync(fb);
    phase_mlstm_pre(kparams(), l, smem);
    fsync(fb);
    phase_mlstm(kparams(), l, smem);
    fsync(fb);
    phase_mla_prep(kparams(), l, smem);
    fsync(fb);
    phase_attn(kparams(), l, smem);
    fsync(fb);
    phase_outproj(kparams(), l, smem);
    fsync(fb);
    phase_ln1(kparams(), l, smem);
    __syncthreads();
    phase_cvt_experts(kparams(), l, smem);
    fsync(fb);
    phase_topk(kparams(), l, smem);
    fsync(fb);
    phase_moe_up(kparams(), l, smem);
    fsync(fb);
    phase_moe_down(kparams(), l, smem);
    fsync(fb);
    phase_ln2(kparams(), l);
    fsync(fb);
  }
}

extern "C" void kernel_launch(void* const* d_in, const int* in_sizes, int n_in, void* d_out, int out_size,
                              void* d_ws, size_t ws_size, hipStream_t stream) {
  constexpr size_t kDynLds = 160 * 1024;
  static int grid_blocks = 0;
  if (!grid_blocks) {
    int dev = 0, cus = 0, per_cu = 0;
    (void)hipGetDevice(&dev);
    (void)hipDeviceGetAttribute(&cus, hipDeviceAttributeMultiprocessorCount, dev);
    (void)hipFuncSetAttribute((const void*)mega, hipFuncAttributeMaxDynamicSharedMemorySize, (int)kDynLds);
    (void)hipOccupancyMaxActiveBlocksPerMultiprocessor(&per_cu, mega, 512, kDynLds);
    grid_blocks = per_cu > 0 ? cus : 0;
    if (grid_blocks > 256) grid_blocks = 256;
    grid_blocks &= ~7;
    if (grid_blocks != 256) { fprintf(stderr, "this kernel needs 256 co-resident workgroups (got %d)\n", grid_blocks); grid_blocks = 0; }
    if (ws_size < WS_END) { fprintf(stderr, "workspace too small: %zu < %zu\n", ws_size, (size_t)WS_END); grid_blocks = 0; }
  }
  if (grid_blocks <= 0) return;
  Params p{};
  const float** pp = (const float**)&p;
  for (int i = 0; i < 24; ++i) pp[i] = (const float*)d_in[i];
  p.out = (float*)d_out; p.ws = (char*)d_ws;
  (void)hipMemsetAsync((char*)d_ws + WS_BAR, 0, WS_BAR_BYTES, stream);
  void* args[] = {&p};
  hipError_t e = hipLaunchCooperativeKernel((void*)mega, dim3(grid_blocks), dim3(512), args, kDynLds, stream);
  if (e != hipSuccess) fprintf(stderr, "cooperative launch failed: %s (grid %d)\n", hipGetErrorString(e), grid_blocks);
}
```

```cpp
#include <hip/hip_runtime.h>
#include <hip/hip_cooperative_groups.h>
#include <cstdio>
#include <cstdint>
namespace cg = cooperative_groups;

typedef unsigned short bf16_t;
typedef short bf16x8 __attribute__((ext_vector_type(8)));
typedef short s16x4 __attribute__((ext_vector_type(4)));
typedef float f32x4 __attribute__((ext_vector_type(4)));
typedef float f32x16 __attribute__((ext_vector_type(16)));
typedef unsigned u32x4 __attribute__((ext_vector_type(4)));
typedef unsigned u32x2 __attribute__((ext_vector_type(2)));
#define LAS __attribute__((address_space(3)))

constexpr int DM = 1024, NB = 8, SEQ = 8192, CTXL = 256, DEPTH = 2;
constexpr int MX = NB * SEQ, MC = NB * CTXL, MT = MX + MC;
constexpr int PLD = 2816;
constexpr int OFF_Q = 0, OFF_K = 512, OFF_V = 1024, OFF_O = 1536, OFF_G = 2048, OFF_CQ = 2064, OFF_CKV = 2448, OFF_KR = 2704, IN_COLS = 2768;
constexpr int SKV = SEQ + CTXL;
constexpr int NE = 16, CAPX = 1024, CAPC = 32;
constexpr int NSLOT = NB * NE * CAPX + NB * NE * CAPC;
constexpr float ALPHA = 1.4142135623730951f;
constexpr float A_SCALE = 0.07216878364870322f;

constexpr size_t al256(size_t v) { return (v + 255) / 256 * 256; }
constexpr size_t WS_H = 0;
constexpr size_t WS_P = WS_H + al256((size_t)MT * 1024 * 2);
constexpr size_t WS_Q = WS_P + al256((size_t)MT * PLD * 2);
constexpr size_t WS_KV = WS_Q + al256((size_t)MT * 768 * 2);
constexpr size_t WS_KR = WS_KV + al256((size_t)NB * SKV * 1024 * 2);
constexpr size_t WS_MIX = WS_KR + al256((size_t)NB * SKV * 64 * 2);
constexpr size_t WS_ACT = WS_P;
constexpr size_t WS_HB = WS_H;
constexpr size_t WS_OUTE = WS_P + al256((size_t)NSLOT * 1024 * 2);
constexpr size_t WS_WGU = WS_MIX;
constexpr size_t WS_WDN = WS_MIX + (size_t)NE * 2048 * 1024 * 2;
constexpr size_t WS_WIN = WS_MIX + al256((size_t)MT * 1024 * 2);
constexpr size_t WS_WUQ = WS_WIN + (size_t)2 * PLD * 1024 * 2;
constexpr size_t WS_WUKV = WS_WUQ + (size_t)2 * 768 * 384 * 2;
constexpr size_t WS_WOUT = WS_WUKV + (size_t)2 * 1024 * 256 * 2;
constexpr size_t WS_MOD = WS_WOUT + (size_t)2 * 1024 * 1024 * 2;
constexpr size_t WS_COS = WS_MOD + al256((size_t)2 * 9 * 6144 * 4);
constexpr size_t WS_SIN = WS_COS + (size_t)SEQ * 32 * 4;
constexpr size_t WS_GATES = WS_SIN + (size_t)SEQ * 32 * 4;
constexpr size_t WS_AFF = WS_GATES + (size_t)MT * 16 * 4;
constexpr size_t WS_IDX = WS_AFF + (size_t)MT * 16 * 4;
constexpr size_t WS_GV = WS_IDX + (size_t)NSLOT * 4;
constexpr size_t WS_TS = WS_GV + (size_t)NSLOT * 4;
constexpr size_t WS_CTXZ = WS_TS + (size_t)MT * 16 * 4;
constexpr size_t WS_BAR = WS_CTXZ + (size_t)MC * 1024 * 4;
constexpr size_t WS_BAR_BYTES = 16384;
constexpr size_t WS_END = WS_BAR + WS_BAR_BYTES;
static_assert(WS_OUTE + (size_t)NSLOT * 1024 * 2 <= WS_KR, "out_e overlay");
static_assert(WS_WDN + (size_t)NE * 1024 * 1024 * 2 <= WS_WIN, "expert weights overlay");

struct Params {
  const float *x, *c, *ctx, *c_ctx, *w_mod, *b_mod, *w_in, *b_gates, *conv_w, *conv_b, *m_norm_w, *q_norm_w, *kv_norm_w, *w_uq, *w_ukv, *w_out,
      *ln1_g, *ln1_b, *w_router, *w_gate, *w_up, *w_down, *ln2_g, *ln2_b;
  float* out; char* ws;
};

typedef const __attribute__((address_space(4))) Params& PRef;
__device__ __forceinline__ PRef kparams() { const __attribute__((address_space(4))) Params* kp = (const __attribute__((address_space(4))) Params*)__builtin_amdgcn_kernarg_segment_ptr(); asm volatile("" : "+s"(kp)); return *kp; }
__device__ __forceinline__ int otid() { int t = threadIdx.x; asm volatile("" : "+v"(t)); return t; }
__device__ __forceinline__ int obid() { int t = blockIdx.x; asm volatile("" : "+s"(t)); return t; }
__device__ __forceinline__ int opaque_s(int v) { asm volatile("" : "+s"(v)); return v; }
typedef __bf16 bf16v2_t __attribute__((ext_vector_type(2)));
typedef float f32x2_t __attribute__((ext_vector_type(2)));
__device__ __forceinline__ unsigned cvtpk(float lo, float hi) { const f32x2_t f = {lo, hi}; const bf16v2_t b = __builtin_convertvector(f, bf16v2_t); return __builtin_bit_cast(unsigned, b); }
__device__ __forceinline__ bf16_t f2bf(float v) { return (bf16_t)(cvtpk(v, v) & 0xffffu); }
__device__ __forceinline__ float bf2f(unsigned v) { return __uint_as_float(v << 16); }
__device__ __forceinline__ float bflo(unsigned w) { return __uint_as_float(w << 16); }
__device__ __forceinline__ float bfhi(unsigned w) { return __uint_as_float(w & 0xffff0000u); }
__device__ __forceinline__ float wave_sum(float v) { for (int o = 32; o > 0; o >>= 1) v += __shfl_xor(v, o); return v; }
__device__ __forceinline__ float wave_max(float v) { for (int o = 32; o > 0; o >>= 1) v = fmaxf(v, __shfl_xor(v, o)); return v; }
__device__ __forceinline__ float sigmoid_f(float v) { return __builtin_amdgcn_rcpf(1.f + __expf(-v)); }
__device__ __forceinline__ float silu_f(float v) { return v * sigmoid_f(v); }

namespace g8 {
constexpr int BK = 64, HALF = 128, HTB = HALF * BK * 2, STAGE_BYTES = 8 * HTB;
__device__ __forceinline__ int lds_byte(int r, int c) { const int st = (r >> 4) * 2 + (c >> 5), rr = r & 15, cc = c & 31, ob = rr * 64 + cc * 2; return st * 1024 + (ob ^ (((ob >> 9) & 1) << 5)); }
__device__ __forceinline__ int perm32(int rho) { const int n = rho >> 4, i = rho & 15; return 8 * (i >> 2) + 4 * n + (i & 3); }
__device__ __forceinline__ void stage_rc(int b, int& R, int& C) { const int st = b / 1024, sb = b % 1024, swz = sb ^ (((sb >> 9) & 1) << 5); R = (st >> 1) * 16 + swz / 64; C = (st & 1) * 32 + (swz % 64) / 2; }

template <bool GATHER>
__device__ __forceinline__ void gemm_tile(LAS unsigned char* lds, const char* __restrict__ Ab, const unsigned (&voffA)[GATHER ? 4 : 2], size_t hstepA, const char* __restrict__ Bb, int K,
                                          f32x4 (&acc)[2][2][4][2]) {
  const int tid = otid(), wid = __builtin_amdgcn_readfirstlane(tid >> 6), lane = tid & 63, wr = wid >> 2, wc = wid & 3, fr = lane & 15, fq = lane >> 4;
  const int nt = K / BK;
  unsigned voffB[2];
#pragma unroll
  for (int i = 0; i < 2; ++i) { int R, C; stage_rc(tid * 16 + i * 8192, R, C); const int Rb = (R & ~31) + perm32(R & 31); voffB[i] = (unsigned)(Rb * K + C) * 2u; }
  const char* Bb1 = Bb + (size_t)HALF * K * 2; const char* Ab1 = GATHER ? Ab : Ab + hstepA;
  const unsigned* vA0 = &voffA[0]; const unsigned* vA1 = GATHER ? &voffA[2] : &voffA[0];
  const unsigned ldsw = (unsigned)wid * 1024u;
  const int aoff = lds_byte(wr * 64 + fr, fq * 8), boff = lds_byte(wc * 32 + fr, fq * 8);
#define G8_SA(b, h) (((b) * 2 + (h)) * HTB)
#define G8_SB(b, h) ((4 + (b) * 2 + (h)) * HTB)
#define G8_STAGE(bufoff, gbase, voff, kt) do { _Pragma("unroll") for (int _i = 0; _i < 2; ++_i) \
    __builtin_amdgcn_global_load_lds((const unsigned*)((gbase) + (size_t)(kt) * (BK * 2) + (voff)[_i]), (LAS unsigned*)(lds + (bufoff) + ldsw + _i * 8192), 16, 0, 0); } while (0)
#define G8_LDA(dst, b, h) do { _Pragma("unroll") for (int m = 0; m < 4; ++m) _Pragma("unroll") for (int k = 0; k < 2; ++k) dst[m][k] = *(const LAS bf16x8*)(lds + G8_SA(b, h) + aoff + m * 2048 + k * 1024); } while (0)
#define G8_LDB(dst, b, h) do { _Pragma("unroll") for (int n = 0; n < 2; ++n) _Pragma("unroll") for (int k = 0; k < 2; ++k) dst[n][k] = *(const LAS bf16x8*)(lds + G8_SB(b, h) + boff + n * 2048 + k * 1024); } while (0)
#define G8_MMA(ai, bj, At, Bt) do { __builtin_amdgcn_s_setprio(1); _Pragma("unroll") for (int m = 0; m < 4; ++m) _Pragma("unroll") for (int n = 0; n < 2; ++n) _Pragma("unroll") for (int k = 0; k < 2; ++k) \
    acc[ai][bj][m][n] = __builtin_amdgcn_mfma_f32_16x16x32_bf16(Bt[n][k], At[m][k], acc[ai][bj][m][n], 0, 0, 0); __builtin_amdgcn_s_setprio(0); } while (0)
#define G8_WAIT_V(n) asm volatile("s_waitcnt vmcnt(" #n ")" ::: "memory")
#define G8_WAIT_L(n) asm volatile("s_waitcnt lgkmcnt(" #n ")" ::: "memory")
#define G8_BAR __builtin_amdgcn_s_barrier()
#define G8_SCHED __builtin_amdgcn_sched_barrier(0)
#pragma unroll
  for (int a = 0; a < 2; ++a)
#pragma unroll
    for (int b = 0; b < 2; ++b)
#pragma unroll
      for (int m = 0; m < 4; ++m)
#pragma unroll
        for (int n = 0; n < 2; ++n) acc[a][b][m][n] = (f32x4){0.f, 0.f, 0.f, 0.f};
  bf16x8 At[4][2], B0[2][2], B1[2][2];
  G8_WAIT_V(0); __syncthreads();
  G8_STAGE(G8_SB(0, 0), Bb, voffB, 0); G8_STAGE(G8_SA(0, 0), Ab, vA0, 0); G8_STAGE(G8_SB(0, 1), Bb1, voffB, 0); G8_STAGE(G8_SA(0, 1), Ab1, vA1, 0);
  if (wr == 1) G8_BAR;
  G8_WAIT_V(4); G8_BAR;
  G8_STAGE(G8_SB(1, 0), Bb, voffB, 1); G8_STAGE(G8_SA(1, 0), Ab, vA0, 1); G8_STAGE(G8_SB(1, 1), Bb1, voffB, 1);
  G8_WAIT_V(6); G8_BAR;
  for (int t = 0; t < nt - 2; t += 2) {
    G8_LDB(B0, 0, 0); G8_SCHED; G8_LDA(At, 0, 0); G8_STAGE(G8_SA(1, 1), Ab1, vA1, t + 1);
    G8_WAIT_L(8); G8_BAR; G8_WAIT_L(0); G8_MMA(0, 0, At, B0); G8_BAR; G8_SCHED;
    G8_LDB(B1, 0, 1); G8_STAGE(G8_SB(0, 0), Bb, voffB, t + 2);
    G8_BAR; G8_WAIT_L(0); G8_MMA(0, 1, At, B1); G8_BAR;
    G8_LDA(At, 0, 1); G8_STAGE(G8_SA(0, 0), Ab, vA0, t + 2);
    G8_BAR; G8_WAIT_L(0); G8_MMA(1, 0, At, B0); G8_BAR; G8_SCHED;
    G8_STAGE(G8_SB(0, 1), Bb1, voffB, t + 2);
    G8_WAIT_V(6); G8_BAR; G8_MMA(1, 1, At, B1); G8_BAR;
    G8_LDB(B0, 1, 0); G8_SCHED; G8_LDA(At, 1, 0); G8_STAGE(G8_SA(0, 1), Ab1, vA1, t + 2);
    G8_WAIT_L(8); G8_BAR; G8_WAIT_L(0); G8_MMA(0, 0, At, B0); G8_BAR; G8_SCHED;
    G8_LDB(B1, 1, 1); G8_STAGE(G8_SB(1, 0), Bb, voffB, t + 3);
    G8_BAR; G8_WAIT_L(0); G8_MMA(0, 1, At, B1); G8_BAR;
    G8_LDA(At, 1, 1); G8_STAGE(G8_SA(1, 0), Ab, vA0, t + 3);
    G8_BAR; G8_WAIT_L(0); G8_MMA(1, 0, At, B0); G8_BAR; G8_SCHED;
    G8_STAGE(G8_SB(1, 1), Bb1, voffB, t + 3);
    G8_WAIT_V(6); G8_BAR; G8_MMA(1, 1, At, B1); G8_BAR;
  }
  { G8_LDB(B0, 0, 0); G8_LDA(At, 0, 0); G8_STAGE(G8_SA(1, 1), Ab1, vA1, nt - 1);
    G8_BAR; G8_WAIT_L(0); G8_MMA(0, 0, At, B0); G8_BAR;
    G8_LDB(B1, 0, 1); G8_BAR; G8_WAIT_L(0); G8_MMA(0, 1, At, B1); G8_BAR;
    G8_LDA(At, 0, 1); G8_WAIT_V(4); G8_BAR; G8_WAIT_L(0); G8_MMA(1, 0, At, B0); G8_MMA(1, 1, At, B1); G8_BAR; }
  { G8_LDB(B0, 1, 0); G8_LDA(At, 1, 0); G8_WAIT_V(2); G8_BAR; G8_WAIT_L(0); G8_MMA(0, 0, At, B0); G8_BAR;
    G8_LDB(B1, 1, 1); G8_WAIT_V(0); G8_BAR; G8_WAIT_L(0); G8_MMA(0, 1, At, B1); G8_BAR;
    G8_LDA(At, 1, 1); G8_BAR; G8_WAIT_L(0); G8_MMA(1, 0, At, B0); G8_MMA(1, 1, At, B1); G8_BAR; }
  if (wr == 0) G8_BAR;
}
__device__ __forceinline__ unsigned piece_off(int i, int ld, int c0) { int R, C; stage_rc((int)otid() * 16 + i * 8192, R, C); return (unsigned)(R * ld + c0 + C) * 2u; }
__device__ __forceinline__ void piece_rc(int i, int& R, int& C) { stage_rc((int)otid() * 16 + i * 8192, R, C); }
struct TileIter {
  int nM, nN, x, j, J, cnt, idx;
  __device__ __forceinline__ void init(int nM_, int nN_) { nM = nM_; nN = nN_; x = obid() & 7; j = obid() >> 3; J = gridDim.x >> 3; cnt = ((nM - x + 7) >> 3) * nN; idx = j; }
  __device__ __forceinline__ bool next(int& pm, int& pn) { if (idx >= cnt) return false; pm = x + 8 * (idx / nN); pn = idx % nN; idx += J; return true; }
};
struct MoeIter {
  int nN, x, jm, jn, j, step, nsteps, nb4; bool with_ctx, ctx_done, wide;
  __device__ __forceinline__ void init(int nN_, bool with_ctx_) { nN = nN_; with_ctx = with_ctx_; wide = nN_ == 8; x = obid() & 7; j = obid() >> 3;
    if (wide) { jm = j & 3; jn = j >> 2; nsteps = 16; } else { jm = j & 7; jn = j >> 3; nsteps = 2 * (nN >> 2) * 4; }
    nb4 = nN >> 2; step = 0; ctx_done = false; }
  __device__ __forceinline__ bool next(int& pm, int& pn, int& e) {
    if (step < nsteps) {
      int m32;
      if (wide) { const int mb = step & 7, el = step >> 3; e = 2 * x + el; m32 = mb * 4 + jm; pn = jn; }
      else { const int mb = step & 3, nb = (step >> 2) % nb4, el = (step >> 2) / nb4; e = 2 * x + el; m32 = mb * 8 + jm; pn = nb * 4 + jn; }
      pm = ((m32 >> 2) * 16 + e) * 4 + (m32 & 3); ++step; return true; }
    if (with_ctx && !ctx_done) { ctx_done = true; if (j < 2 * nN) { e = 2 * x + j / nN; pm = 512 + e; pn = j % nN; return true; } }
    return false;
  }
};
}

#define ACC_FOR3(ai, bj, m) _Pragma("unroll") for (int ai = 0; ai < 2; ++ai) _Pragma("unroll") for (int bj = 0; bj < 2; ++bj) _Pragma("unroll") for (int m = 0; m < 4; ++m)
#define ACC_FOR(ai, bj, m, n) _Pragma("unroll") for (int ai = 0; ai < 2; ++ai) _Pragma("unroll") for (int bj = 0; bj < 2; ++bj) _Pragma("unroll") for (int m = 0; m < 4; ++m) _Pragma("unroll") for (int n = 0; n < 2; ++n)

__device__ __forceinline__ void cvt_tile(const float* __restrict__ src, int N, int K, int k0, int n0, bf16_t* __restrict__ dst, long drow0, const float* __restrict__ kscale, float* lds) {
  const int tid = otid();
  { const int kr = tid >> 6, n = tid & 63;
#pragma unroll
    for (int i = 0; i < 8; ++i) { const int k = kr + 8 * i; float v = (n0 + n < N) ? src[(size_t)(k0 + k) * N + n0 + n] : 0.f; if (kscale) v *= kscale[k0 + k]; lds[k * 65 + n] = v; } }
  __syncthreads();
  { const int n = tid >> 3, k8 = (tid & 7) * 8; float v[8];
#pragma unroll
    for (int i = 0; i < 8; ++i) v[i] = lds[(k8 + i) * 65 + n];
    u32x4 w = {cvtpk(v[0], v[1]), cvtpk(v[2], v[3]), cvtpk(v[4], v[5]), cvtpk(v[6], v[7])};
    *(u32x4*)(dst + (size_t)(drow0 + n) * K + k0 + k8) = w; }
  __syncthreads();
}

__device__ void phase_prep(PRef p, char* smem) {
  float* lds = (float*)smem;
  bf16_t* Wt_in = (bf16_t*)(p.ws + WS_WIN); bf16_t* Wt_uq = (bf16_t*)(p.ws + WS_WUQ); bf16_t* Wt_ukv = (bf16_t*)(p.ws + WS_WUKV); bf16_t* Wt_out = (bf16_t*)(p.ws + WS_WOUT);
  float* mod = (float*)(p.ws + WS_MOD);
  constexpr int T_MOD = 192, T_IN = 2 * 16 * 44, T_UQ = 2 * 6 * 12, T_UKV = 2 * 4 * 16, T_OUT = 2 * 16 * 16, T_ROPE = 64;
  constexpr int E0 = T_MOD, E1 = E0 + T_IN, E2 = E1 + T_UQ, E3 = E2 + T_UKV, E4 = E3 + T_OUT, E5 = E4 + T_ROPE;
  const int tid = otid();
  for (int task = obid(); task < E5; task += gridDim.x) {
    if (task < E0) {
      const int l = task / 96, j0 = (task % 96) * 64;
      float* sc = lds;
      for (int i = tid; i < 9 * 1024; i += 512) { const int bb = i >> 10, d = i & 1023; const float v = bb < 8 ? p.c[bb * 1024 + d] : p.c_ctx[d]; sc[i] = v / (1.f + expf(-v)); }
      __syncthreads();
      const int col = tid & 63, ks = tid >> 6; float a[9];
#pragma unroll
      for (int bb = 0; bb < 9; ++bb) a[bb] = 0.f;
      const float* wm = p.w_mod + (size_t)l * 1024 * 6144 + j0 + col;
      for (int d = ks * 128; d < ks * 128 + 128; ++d) { const float w = wm[(size_t)d * 6144];
#pragma unroll
        for (int bb = 0; bb < 9; ++bb) a[bb] += sc[bb * 1024 + d] * w; }
      float* red = lds + 9 * 1024;
#pragma unroll
      for (int bb = 0; bb < 9; ++bb) red[(ks * 9 + bb) * 64 + col] = a[bb];
      __syncthreads();
      for (int i = tid; i < 9 * 64; i += 512) { const int bb = i >> 6, cc = i & 63; float s = 0.f;
        for (int k = 0; k < 8; ++k) s += red[(k * 9 + bb) * 64 + cc];
        mod[((size_t)l * 9 + bb) * 6144 + j0 + cc] = s + p.b_mod[l * 6144 + j0 + cc]; }
      __syncthreads();
    } else if (task < E1) { const int t = task - E0, l = t / 704, r = t % 704, kt = r / 44, nt = r % 44;
      cvt_tile(p.w_in + (size_t)l * 1024 * IN_COLS, IN_COLS, 1024, kt * 64, nt * 64, Wt_in + (size_t)l * PLD * 1024, nt * 64, nullptr, lds);
    } else if (task < E2) { const int t = task - E1, l = t / 72, r = t % 72, kt = r / 12, nt = r % 12;
      cvt_tile(p.w_uq + (size_t)l * 384 * 768, 768, 384, kt * 64, nt * 64, Wt_uq + (size_t)l * 768 * 384, nt * 64, p.q_norm_w + l * 384, lds);
    } else if (task < E3) { const int t = task - E2, l = t / 64, r = t % 64, kt = r / 16, nt = r % 16;
      cvt_tile(p.w_ukv + (size_t)l * 256 * 1024, 1024, 256, kt * 64, nt * 64, Wt_ukv + (size_t)l * 1024 * 256, nt * 64, p.kv_norm_w + l * 256, lds);
    } else if (task < E4) { const int t = task - E3, l = t / 256, r = t % 256, kt = r / 16, nt = r % 16;
      cvt_tile(p.w_out + (size_t)l * 1024 * 1024, 1024, 1024, kt * 64, nt * 64, Wt_out + (size_t)l * 1024 * 1024, nt * 64, nullptr, lds);
    } else {
      float* cs = (float*)(p.ws + WS_COS); float* sn = (float*)(p.ws + WS_SIN);
      for (int i = (task - E4) * 4096 + tid; i < (task - E4 + 1) * 4096; i += 512) { const int t = i >> 5, j = i & 31;
        const float inv = exp2f(-(float)(j & 15) * (13.287712379549449f / 16.f));
        const float pos = (float)(j < 16 ? (t >> 6) : (t & 63)); const float ang = pos * inv;
        const double a = (double)ang; const double k = rint(a * 0.15915494309189535); const float r = (float)(a - k * 6.283185307179586);
        cs[i] = __cosf(r); sn[i] = __sinf(r); }
    }
  }
}

__device__ void phase_cvt_experts(PRef p, int l, char* smem) {
  float* lds = (float*)smem;
  bf16_t* Wgu = (bf16_t*)(p.ws + WS_WGU); bf16_t* Wdn = (bf16_t*)(p.ws + WS_WDN);
  const int tid = otid();
  for (int task = obid(); task < NE * 192; task += gridDim.x) {
    const int e = task / 192, r = task % 192, which = r >> 6, kt = (r & 63) >> 2, nt = r & 3, k0 = kt * 64, n0 = nt * 256;
    const float* src = (which == 0 ? p.w_gate : which == 1 ? p.w_up : p.w_down) + ((size_t)l * NE + e) * 1024 * 1024;
    { const int kr = tid >> 6, n4 = (tid & 63) * 4;
#pragma unroll
      for (int i = 0; i < 8; ++i) { const int k = kr + 8 * i; *(f32x4*)(lds + k * 260 + n4) = *(const f32x4*)(src + (size_t)(k0 + k) * 1024 + n0 + n4); } }
    __syncthreads();
    { const int nl = tid & 255, k32 = (tid >> 8) * 32, n = n0 + nl;
      const size_t drow = which == 2 ? (size_t)n : (size_t)((n >> 7) * 256 + which * 128 + (n & 127));
      bf16_t* dst = (which == 2 ? Wdn + (size_t)e * 1024 * 1024 : Wgu + (size_t)e * 2048 * 1024) + drow * 1024 + k0 + k32;
#pragma unroll
      for (int q = 0; q < 4; ++q) { float v[8];
#pragma unroll
        for (int i = 0; i < 8; ++i) v[i] = lds[(k32 + q * 8 + i) * 260 + nl];
        u32x4 w = {cvtpk(v[0], v[1]), cvtpk(v[2], v[3]), cvtpk(v[4], v[5]), cvtpk(v[6], v[7])};
        *(u32x4*)(dst + q * 8) = w; } }
    __syncthreads();
  }
}

__device__ __forceinline__ void ln_row(f32x4 (&v)[4], float eps) {
  float s = 0.f;
#pragma unroll
  for (int i = 0; i < 4; ++i) s += v[i][0] + v[i][1] + v[i][2] + v[i][3];
  const float mu = wave_sum(s) * (1.f / 1024.f);
  float q = 0.f;
#pragma unroll
  for (int i = 0; i < 4; ++i)
#pragma unroll
    for (int k = 0; k < 4; ++k) { v[i][k] -= mu; q += v[i][k] * v[i][k]; }
  const float rs = rsqrtf(wave_sum(q) * (1.f / 1024.f) + eps);
#pragma unroll
  for (int i = 0; i < 4; ++i) v[i] *= rs;
}
__device__ __forceinline__ void store_mod_bf16(const f32x4 (&v)[4], const float* __restrict__ shift, const float* __restrict__ scale, bf16_t* __restrict__ hrow, int lane, f32x4 (*keep)[4]) {
#pragma unroll
  for (int i = 0; i < 4; ++i) { const int c = lane * 4 + 256 * i; const f32x4 sh = *(const f32x4*)(shift + c), sc = *(const f32x4*)(scale + c);
    f32x4 o = v[i] * (sc + 1.f) + sh; if (keep) (*keep)[i] = o;
    u32x2 w = {cvtpk(o[0], o[1]), cvtpk(o[2], o[3])}; *(u32x2*)(hrow + c) = w; }
}
__device__ __forceinline__ const float* mod_ptr(PRef p, int l, int row, int which) {
  const int bb = row < MX ? (row >> 13) : 8;
  return (const float*)(p.ws + WS_MOD) + ((size_t)l * 9 + bb) * 6144 + which * 1024;
}

__device__ void phase_h0(PRef p) {
  const int lane = otid() & 63, gw = obid() * 8 + (otid() >> 6), nw = gridDim.x * 8;
  bf16_t* h = (bf16_t*)(p.ws + WS_H);
  for (int row = gw; row < MT; row += nw) {
    const float* src = row < MX ? p.x + (size_t)row * 1024 : p.ctx + (size_t)(row - MX) * 1024;
    f32x4 v[4];
#pragma unroll
    for (int i = 0; i < 4; ++i) v[i] = *(const f32x4*)(src + lane * 4 + 256 * i);
    ln_row(v, 1e-6f);
    store_mod_bf16(v, mod_ptr(p, 0, row, 0), mod_ptr(p, 0, row, 1), h + (size_t)row * 1024, lane, nullptr);
  }
}

__device__ void phase_inproj(PRef p, int l, char* smem) {
  LAS unsigned char* lds = (LAS unsigned char*)smem;
  const bf16_t* h = (const bf16_t*)(p.ws + WS_H); const bf16_t* Wt = (const bf16_t*)(p.ws + WS_WIN) + (size_t)l * PLD * 1024;
  bf16_t* P = (bf16_t*)(p.ws + WS_P); float* gates = (float*)(p.ws + WS_GATES);
  const int tid = otid(), wid = tid >> 6, lane = tid & 63, wr = wid >> 2, wc = wid & 3, fr = lane & 15, fq = lane >> 4;
  g8::TileIter it; it.init(MT / 256, PLD / 256);
  int pm, pn;
  while (it.next(pm, pn)) {
    unsigned voffA[2] = {g8::piece_off(0, 1024, 0), g8::piece_off(1, 1024, 0)};
    f32x4 acc[2][2][4][2];
    g8::gemm_tile<false>(lds, (const char*)(h + (size_t)pm * 256 * 1024), voffA, (size_t)128 * 1024 * 2, (const char*)(Wt + (size_t)pn * 256 * 1024), 1024, acc);
    ACC_FOR3(ai, bj, m) {
      const int row = pm * 256 + ai * 128 + wr * 64 + m * 16 + fr, col = pn * 256 + bj * 128 + wc * 32 + fq * 8;
      const f32x4 v0 = acc[ai][bj][m][0], v1 = acc[ai][bj][m][1];
      u32x4 w = {cvtpk(v0[0], v0[1]), cvtpk(v0[2], v0[3]), cvtpk(v1[0], v1[1]), cvtpk(v1[2], v1[3])}; *(u32x4*)(P + (size_t)row * PLD + col) = w;
      if (col >= OFF_G && col < OFF_G + 16) { const f32x4 bg0 = *(const f32x4*)(p.b_gates + l * 16 + (col - OFF_G)), bg1 = *(const f32x4*)(p.b_gates + l * 16 + (col - OFF_G) + 4);
        *(f32x4*)(gates + (size_t)row * 16 + (col - OFF_G)) = v0 + bg0; *(f32x4*)(gates + (size_t)row * 16 + (col - OFF_G) + 4) = v1 + bg1; }
    }
  }
}


constexpr size_t WS_QKC = WS_KV;
constexpr size_t WS_SCAL = WS_Q;
__device__ void phase_mlstm_pre(PRef p, int l, char* smem) {
  const bf16_t* P = (const bf16_t*)(p.ws + WS_P); const float* gates = (const float*)(p.ws + WS_GATES);
  bf16_t* QKC = (bf16_t*)(p.ws + WS_QKC); float* SCAL = (float*)(p.ws + WS_SCAL);
  const int tid = otid(), wid = tid >> 6, lane = tid & 63;
  if (obid() < 64) {
    const int chain = obid(), dir = chain & 1, hd = (chain >> 1) & 3, b = chain >> 3;
    float* LA = (float*)smem; float* LB = LA + 132 * 64; float* LP = LB + 132 * 64; float* b63s = LP + 132 * 64; float* pm63s = b63s + 132; float* mbs = pm63s + 132;
    for (int ci = wid; ci < 132; ci += 8) {
      const bool ic = ci < 4; const int cc = ic ? ci : ci - 4, T = ic ? CTXL : SEQ, rb = ic ? MX + b * CTXL : b * SEQ, tlo = dir ? T - 64 - cc * 64 : cc * 64;
      const int t = dir ? tlo + 63 - lane : tlo + lane; const float* g = gates + (size_t)(rb + t) * 16;
      const float ig = g[dir * 8 + hd], fg = g[dir * 8 + 4 + hd];
      const float lf = fminf(fg, 0.f) - log1pf(expf(-fabsf(fg)));
      float bc = lf;
#pragma unroll
      for (int o = 1; o < 64; o <<= 1) { const float u = __shfl_up(bc, o); if (lane >= o) bc += u; }
      const float a = ig - bc; float pmx = a;
#pragma unroll
      for (int o = 1; o < 64; o <<= 1) { const float u = __shfl_up(pmx, o); if (lane >= o) pmx = fmaxf(pmx, u); }
      LA[ci * 64 + lane] = a; LB[ci * 64 + lane] = bc; LP[ci * 64 + lane] = pmx;
      if (lane == 63) { b63s[ci] = bc; pm63s[ci] = pmx; }
    }
    __syncthreads();
    if (tid == 0) { float m = 0.f; for (int ci = 0; ci < 132; ++ci) { mbs[ci] = m; m = b63s[ci] + fmaxf(pm63s[ci], m); } }
    __syncthreads();
    for (int ci = wid; ci < 132; ci += 8) {
      const float m = mbs[ci], a = LA[ci * 64 + lane], bc = LB[ci * 64 + lane], pmx = LP[ci * 64 + lane];
      const float Mx = fmaxf(pmx, m), M63 = fmaxf(pm63s[ci], m);
      float* S = SCAL + ((size_t)chain * 132 + ci) * 384;
      S[lane] = a; S[64 + lane] = Mx; S[128 + lane] = __expf(m - Mx); S[192 + lane] = __expf(-(bc + Mx)); S[256 + lane] = __expf(a - M63);
      S[320 + lane] = lane == 0 ? __expf(m - M63) : 0.f;
    }
    return;
  }
  const int col8 = (tid & 127) * 8, rg = tid >> 7;
  float w[5][8], bia[8];
#pragma unroll
  for (int j = 0; j < 5; ++j) { const f32x4 w0 = *(const f32x4*)(p.conv_w + ((size_t)l * 5 + j) * 1024 + col8), w1 = *(const f32x4*)(p.conv_w + ((size_t)l * 5 + j) * 1024 + col8 + 4);
#pragma unroll
    for (int k = 0; k < 4; ++k) { w[j][k] = w0[k]; w[j][4 + k] = w1[k]; } }
  { const f32x4 b0 = *(const f32x4*)(p.conv_b + l * 1024 + col8), b1 = *(const f32x4*)(p.conv_b + l * 1024 + col8 + 4);
#pragma unroll
    for (int k = 0; k < 4; ++k) { bia[k] = b0[k]; bia[4 + k] = b1[k]; } }
  const float osc = col8 < 512 ? 0.08838834764831845f : 1.f;
#pragma unroll 1
  for (int rb = obid() - 64; rb < MT / 64; rb += gridDim.x - 64) {
    const int R0 = rb * 64, seg_lo = R0 < MX ? (R0 & ~8191) : MX + ((R0 - MX) & ~255), seg_hi = seg_lo + (R0 < MX ? SEQ : CTXL);
    const int r0 = R0 + rg * 16;
    u32x4 raw[20];
#pragma unroll
    for (int i = 0; i < 20; ++i) { const int r = r0 - 2 + i; raw[i] = (u32x4){0u, 0u, 0u, 0u}; if (r >= seg_lo && r < seg_hi) raw[i] = *(const u32x4*)(P + (size_t)r * PLD + col8); }
#pragma unroll
    for (int i = 0; i < 16; ++i) {
      float y[8];
#pragma unroll
      for (int k = 0; k < 8; ++k) y[k] = bia[k];
#pragma unroll
      for (int tp = 0; tp < 5; ++tp) {
#pragma unroll
        for (int k = 0; k < 4; ++k) { y[2 * k] += w[tp][2 * k] * bflo(raw[i + tp][k]); y[2 * k + 1] += w[tp][2 * k + 1] * bfhi(raw[i + tp][k]); } }
#pragma unroll
      for (int k = 0; k < 8; ++k) y[k] = silu_f(y[k]) * osc;
      u32x4 o = {cvtpk(y[0], y[1]), cvtpk(y[2], y[3]), cvtpk(y[4], y[5]), cvtpk(y[6], y[7])};
      *(u32x4*)(QKC + (size_t)(r0 + i) * 1024 + col8) = o;
    }
  }
}

__device__ void phase_mlstm(PRef p, int l, char* smem) {
  bf16_t* QBb[2] = {(bf16_t*)(smem), (bf16_t*)(smem + 17408)};
  bf16_t* KB = (bf16_t*)(smem + 34816);
  bf16_t* KT = (bf16_t*)(smem + 52224);
  bf16_t* VTb[2] = {(bf16_t*)(smem + 70656), (bf16_t*)(smem + 77568)};
  bf16_t* VWT = (bf16_t*)(smem + 84480);
  bf16_t* PB = (bf16_t*)(smem + 91392);
  bf16_t* CTb[2] = {(bf16_t*)(smem + 100608), (bf16_t*)(smem + 113664)};
  float* SC = (float*)(smem + 126720);
  const bf16_t* P = (const bf16_t*)(p.ws + WS_P); const bf16_t* QKC = (const bf16_t*)(p.ws + WS_QKC); const float* SCAL = (const float*)(p.ws + WS_SCAL);
  bf16_t* hbuf = (bf16_t*)(p.ws + WS_HB);
  for (int w = obid(); w < 256; w += gridDim.x) {
    const int slice = (w >> 3) & 3, chain = (w & 7) * 8 + (w >> 5), dir = chain & 1, hd = (chain >> 1) & 3, b = chain >> 3;
    const float* SCc = SCAL + (size_t)chain * 132 * 384;
    __syncthreads();
    { const int tid = otid();
      for (int i = tid; i < 48 * 136 / 2; i += 512) { ((unsigned*)CTb[0])[i] = 0u; ((unsigned*)CTb[1])[i] = 0u; }
      for (int i = tid; i < 48 * 72 / 2; i += 512) { ((unsigned*)VTb[0])[i] = 0u; ((unsigned*)VTb[1])[i] = 0u; ((unsigned*)VWT)[i] = 0u; } }
    f32x4 accC[3];
#pragma unroll
    for (int i = 0; i < 3; ++i) accC[i] = (f32x4){0.f, 0.f, 0.f, 0.f};
    struct Pre { u32x4 qk[4]; u32x2 v; f32x4 s; float ws, ws1; };
    Pre preA, preB;
    preA.s = (f32x4){0.f, 0.f, 0.f, 0.f}; preB.s = preA.s;
#define MLSTM_PREFETCH(PR, CI) do { const int tid_ = otid(); const int ci_ = (CI); const bool ic_ = ci_ < 4; const int cc_ = ic_ ? ci_ : ci_ - 4, T_ = ic_ ? CTXL : SEQ, rb_ = ic_ ? MX + b * CTXL : b * SEQ; \
      const int tlo_ = dir ? T_ - 64 - cc_ * 64 : cc_ * 64; \
      _Pragma("unroll") for (int k_ = 0; k_ < 4; ++k_) { const int pc = tid_ + k_ * 512, tens = pc >> 10, rem = pc & 1023, lr = rem & 63, c16 = rem >> 6, t = dir ? tlo_ + 63 - lr : tlo_ + lr; \
        PR.qk[k_] = *(const u32x4*)(QKC + (size_t)(rb_ + t) * 1024 + tens * 512 + hd * 128 + c16 * 8); } \
      { const int vl_ = tid_ & 63, vt_ = dir ? tlo_ + 63 - vl_ : tlo_ + vl_; PR.v = *(const u32x2*)(P + (size_t)(rb_ + vt_) * PLD + OFF_V + hd * 128 + slice * 32 + (tid_ >> 6) * 4); \
        PR.ws = SCc[(size_t)ci_ * 384 + 256 + vl_]; PR.ws1 = SCc[(size_t)ci_ * 384 + 256 + (tid_ & 63)]; } \
      if (tid_ < 96) PR.s = *(const f32x4*)(SCc + (size_t)ci_ * 384 + tid_ * 4); } while (0)
    MLSTM_PREFETCH(preA, 0);
    MLSTM_PREFETCH(preB, 1);
    __syncthreads();
    auto step = [&](const int ci, Pre& pre) __attribute__((always_inline)) {
      const int tid = otid(), wid = tid >> 6, lane = tid & 63, fr = lane & 15, fq = lane >> 4;
      const bool isctx = ci < 4; const int cc = isctx ? ci : ci - 4, T = isctx ? CTXL : SEQ, rowbase = isctx ? MX + b * CTXL : b * SEQ;
      const int tlo = dir ? T - 64 - cc * 64 : cc * 64;
      const int par = ci & 1;
      bf16_t* QB = QBb[par]; bf16_t* VT = VTb[par]; float* S = SC + par * 384; bf16_t* CTc = CTb[par]; bf16_t* CTn = CTb[par ^ 1];
      const bool need_out = !(l == DEPTH - 1 && isctx);
#pragma unroll
      for (int k = 0; k < 4; ++k) { const int pc = tid + k * 512, tens = pc >> 10, rem = pc & 1023, lr = rem & 63, c16 = rem >> 6;
        if (tens == 0) *(u32x4*)(QB + lr * 136 + c16 * 8) = pre.qk[k];
        else { *(u32x4*)(KB + lr * 136 + c16 * 8) = pre.qk[k];
#pragma unroll
          for (int i = 0; i < 4; ++i) { KT[(c16 * 8 + 2 * i) * 72 + lr] = (bf16_t)(pre.qk[k][i] & 0xffffu); KT[(c16 * 8 + 2 * i + 1) * 72 + lr] = (bf16_t)(pre.qk[k][i] >> 16); } } }
      { const int vl = tid & 63, ve4 = (tid >> 6) * 4; const float wsl = pre.ws;
        VT[(ve4 + 0) * 72 + vl] = (bf16_t)(pre.v[0] & 0xffffu); VT[(ve4 + 1) * 72 + vl] = (bf16_t)(pre.v[0] >> 16);
        VT[(ve4 + 2) * 72 + vl] = (bf16_t)(pre.v[1] & 0xffffu); VT[(ve4 + 3) * 72 + vl] = (bf16_t)(pre.v[1] >> 16);
        VWT[(ve4 + 0) * 72 + vl] = f2bf(bflo(pre.v[0]) * wsl); VWT[(ve4 + 1) * 72 + vl] = f2bf(bfhi(pre.v[0]) * wsl);
        VWT[(ve4 + 2) * 72 + vl] = f2bf(bflo(pre.v[1]) * wsl); VWT[(ve4 + 3) * 72 + vl] = f2bf(bfhi(pre.v[1]) * wsl);
        if (tid < 64) { VT[32 * 72 + tid] = (bf16_t)0x3F80u; VWT[32 * 72 + tid] = f2bf(pre.ws1); }
        if (tid < 96) *(f32x4*)(S + tid * 4) = pre.s; }
      if (ci + 2 < 132) MLSTM_PREFETCH(pre, ci + 2);
      __syncthreads();
      if (need_out) {
        const int mt = wid >> 1;
#pragma unroll
        for (int u = 0; u < 2; ++u) {
          const int ntl = (wid & 1) * 2 + u;
          f32x4 sacc = {0.f, 0.f, 0.f, 0.f};
          if (ntl <= mt) {
#pragma unroll
            for (int kk = 0; kk < 4; ++kk) {
              const bf16x8 a = *(const bf16x8*)(QB + (mt * 16 + fr) * 136 + kk * 32 + fq * 8), bb = *(const bf16x8*)(KB + (ntl * 16 + fr) * 136 + kk * 32 + fq * 8);
              sacc = __builtin_amdgcn_mfma_f32_16x16x32_bf16(a, bb, sacc, 0, 0, 0); }
          }
          const int j = ntl * 16 + fr; const float aj = S[j];
#pragma unroll
          for (int jj = 0; jj < 4; ++jj) { const int lr = mt * 16 + fq * 4 + jj;
            const float pv = (j <= lr) ? sacc[jj] * __expf(fminf(aj - S[64 + lr], 0.f)) : 0.f;
            PB[lr * 72 + j] = f2bf(pv); }
        }
      }
      {
        const float decay = S[320];
#pragma unroll
        for (int mt = 0; mt < 3; ++mt) {
          accC[mt] *= decay;
#pragma unroll
          for (int kk = 0; kk < 2; ++kk) { const bf16x8 a = *(const bf16x8*)(VWT + (mt * 16 + fr) * 72 + kk * 32 + fq * 8), bb = *(const bf16x8*)(KT + (wid * 16 + fr) * 72 + kk * 32 + fq * 8);
            accC[mt] = __builtin_amdgcn_mfma_f32_16x16x32_bf16(a, bb, accC[mt], 0, 0, 0); }
#pragma unroll
          for (int jj = 0; jj < 4; ++jj) CTn[(mt * 16 + fq * 4 + jj) * 136 + wid * 16 + fr] = f2bf(accC[mt][jj]);
        }
      }
      __syncthreads();
      if (need_out && wid < 4) {
        const int mt = wid; f32x4 num[3];
#pragma unroll
        for (int ntl = 0; ntl < 3; ++ntl) {
          f32x4 a1 = {0.f, 0.f, 0.f, 0.f}, a2 = {0.f, 0.f, 0.f, 0.f};
#pragma unroll
          for (int kk = 0; kk < 2; ++kk) { const bf16x8 a = *(const bf16x8*)(PB + (mt * 16 + fr) * 72 + kk * 32 + fq * 8), bb = *(const bf16x8*)(VT + (ntl * 16 + fr) * 72 + kk * 32 + fq * 8);
            a1 = __builtin_amdgcn_mfma_f32_16x16x32_bf16(a, bb, a1, 0, 0, 0); }
#pragma unroll
          for (int kk = 0; kk < 4; ++kk) { const bf16x8 a = *(const bf16x8*)(QB + (mt * 16 + fr) * 136 + kk * 32 + fq * 8), bb = *(const bf16x8*)(CTc + (ntl * 16 + fr) * 136 + kk * 32 + fq * 8);
            a2 = __builtin_amdgcn_mfma_f32_16x16x32_bf16(a, bb, a2, 0, 0, 0); }
#pragma unroll
          for (int jj = 0; jj < 4; ++jj) num[ntl][jj] = a1[jj] + S[128 + mt * 16 + fq * 4 + jj] * a2[jj];
        }
#pragma unroll
        for (int jj = 0; jj < 4; ++jj) {
          const int lr = mt * 16 + fq * 4 + jj; const float den = __shfl(num[2][jj], lane & 48);
          const float rd = __builtin_amdgcn_rcpf(fmaxf(fabsf(den), S[192 + lr]));
          const int t = dir ? tlo + 63 - lr : tlo + lr;
          bf16_t* hp = hbuf + ((size_t)((dir * 4 + hd) * 4 + slice) * MT + rowbase + t) * 32 + fr;
          hp[0] = f2bf(num[0][jj] * rd); hp[16] = f2bf(num[1][jj] * rd);
        }
      }
    };
#pragma unroll 1
    for (int ci = 0; ci < 132; ci += 2) { step(ci, preA); step(ci + 1, preB); }
    __syncthreads();
  }
#undef MLSTM_PREFETCH
}

template <int WHICH>
__device__ __forceinline__ void mla_gemm(PRef p, int l, char* smem) {
  LAS unsigned char* lds = (LAS unsigned char*)smem; float* rsb = (float*)(smem + g8::STAGE_BYTES);
  const bf16_t* P = (const bf16_t*)(p.ws + WS_P);
  const int tid = otid(), wid = tid >> 6, lane = tid & 63, wr = wid >> 2, wc = wid & 3, fr = lane & 15, fq = lane >> 4;
  constexpr int K = WHICH ? 256 : 384, OFFC = WHICH ? OFF_CKV : OFF_CQ, N = WHICH ? 1024 : 768;
  const bf16_t* Wt = WHICH ? (const bf16_t*)(p.ws + WS_WUKV) + (size_t)l * 1024 * 256 : (const bf16_t*)(p.ws + WS_WUQ) + (size_t)l * 768 * 384;
  bf16_t* O = (bf16_t*)(p.ws + (WHICH ? WS_KV : WS_Q));
  g8::TileIter it; it.init((WHICH || l == 0) ? MT / 256 : MX / 256, N / 256);
  int pm, pn;
  while (it.next(pm, pn)) {
    __syncthreads();
    { const int r = tid >> 1, hf = tid & 1; const bf16_t* src = P + (size_t)(pm * 256 + r) * PLD + OFFC + hf * (K / 2); float s = 0.f;
#pragma unroll 4
      for (int i = 0; i < K / 16; ++i) { const u32x4 v = *(const u32x4*)(src + i * 8);
#pragma unroll
        for (int k = 0; k < 4; ++k) { const float a = bflo(v[k]), bq = bfhi(v[k]); s += a * a + bq * bq; } }
      s += __shfl_xor(s, 1);
      if (hf == 0) rsb[r] = rsqrtf(s / (float)K + 1e-6f); }
    unsigned voffA[2] = {g8::piece_off(0, PLD, OFFC), g8::piece_off(1, PLD, OFFC)};
    f32x4 acc[2][2][4][2];
    g8::gemm_tile<false>(lds, (const char*)(P + (size_t)pm * 256 * PLD), voffA, (size_t)128 * PLD * 2, (const char*)(Wt + (size_t)pn * 256 * K), opaque_s(K), acc);
    ACC_FOR3(ai, bj, m) {
      const int rl = ai * 128 + wr * 64 + m * 16 + fr, row = pm * 256 + rl, col = pn * 256 + bj * 128 + wc * 32 + fq * 8;
      const float rs = rsb[rl]; const f32x4 v0 = acc[ai][bj][m][0] * rs, v1 = acc[ai][bj][m][1] * rs;
      size_t orow = row;
      if (WHICH) orow = row < MX ? (size_t)(row >> 13) * SKV + CTXL + (row & 8191) : (size_t)((row - MX) >> 8) * SKV + ((row - MX) & 255);
      u32x4 w = {cvtpk(v0[0], v0[1]), cvtpk(v0[2], v0[3]), cvtpk(v1[0], v1[1]), cvtpk(v1[2], v1[3])}; *(u32x4*)(O + orow * N + col) = w;
    }
  }
}
__device__ void phase_mla_prep(PRef p, int l, char* smem) {
  mla_gemm<0>(p, l, smem);
  mla_gemm<1>(p, l, smem);
  const bf16_t* P = (const bf16_t*)(p.ws + WS_P);
  const int tid = otid(), wid = tid >> 6, lane = tid & 63;
  const bf16_t* hbuf = (const bf16_t*)(p.ws + WS_HB); bf16_t* mix = (bf16_t*)(p.ws + WS_MIX); bf16_t* KR = (bf16_t*)(p.ws + WS_KR);
  const float* cs = (const float*)(p.ws + WS_COS); const float* sn = (const float*)(p.ws + WS_SIN);
  const int gw = obid() * 8 + wid, nw = gridDim.x * 8;
  for (int row = gw; row < MT; row += nw) {
    if (row < MX || l == 0) {
      const size_t ho = ((size_t)(lane >> 2) * MT + row) * 32 + (lane & 3) * 8;
      const u32x4 hf = *(const u32x4*)(hbuf + ho), hb = *(const u32x4*)(hbuf + (size_t)16 * MT * 32 + ho);
      const u32x4 ov = *(const u32x4*)(P + (size_t)row * PLD + OFF_O + lane * 8);
      float v[8]; float s = 0.f;
#pragma unroll
      for (int k = 0; k < 4; ++k) { v[2 * k] = bflo(hf[k]) + bflo(hb[k]); v[2 * k + 1] = bfhi(hf[k]) + bfhi(hb[k]); s += v[2 * k] + v[2 * k + 1]; }
      s += __shfl_xor(s, 1); s += __shfl_xor(s, 2); s += __shfl_xor(s, 4); s += __shfl_xor(s, 8);
      const float mu = s * (1.f / 128.f); float q = 0.f;
#pragma unroll
      for (int k = 0; k < 8; ++k) { v[k] -= mu; q += v[k] * v[k]; }
      q += __shfl_xor(q, 1); q += __shfl_xor(q, 2); q += __shfl_xor(q, 4); q += __shfl_xor(q, 8);
      const float rs = rsqrtf(q * (1.f / 128.f) + 1e-6f);
      const float* nw_ = p.m_norm_w + l * 512 + lane * 8; float o[8];
#pragma unroll
      for (int k = 0; k < 4; ++k) { o[2 * k] = v[2 * k] * rs * nw_[2 * k] * sigmoid_f(bflo(ov[k])); o[2 * k + 1] = v[2 * k + 1] * rs * nw_[2 * k + 1] * sigmoid_f(bfhi(ov[k])); }
      u32x4 wv = {cvtpk(o[0], o[1]), cvtpk(o[2], o[3]), cvtpk(o[4], o[5]), cvtpk(o[6], o[7])};
      *(u32x4*)(mix + (size_t)row * 1024 + lane * 8) = wv;
    }
    {
      const int j = lane & 31;
      const float x1 = bf2f(P[(size_t)row * PLD + OFF_KR + j]), x2 = bf2f(P[(size_t)row * PLD + OFF_KR + 32 + j]);
      float o1 = x1, o2 = x2; size_t orow;
      if (row < MX) { const int t = row & 8191; const float c = cs[t * 32 + j], s_ = sn[t * 32 + j]; o1 = x1 * c - x2 * s_; o2 = x2 * c + x1 * s_; orow = (size_t)(row >> 13) * SKV + CTXL + t; }
      else orow = (size_t)((row - MX) >> 8) * SKV + ((row - MX) & 255);
      if (lane < 32) { KR[orow * 64 + j] = f2bf(o1); KR[orow * 64 + 32 + j] = f2bf(o2); }
    }
  }
}

namespace att {
constexpr int NW = 8, QBLK = 32, KVBLK = 64, LDQ = 768, LDK = 1024, LDKR = 64, LDO = 1024;
constexpr float SCALE = A_SCALE;
constexpr float THR = 8.f;
constexpr size_t SHM_V = KVBLK * 128 * 2, SHM_K = KVBLK * 128 * 2, SHM_R = KVBLK * 64 * 2;
typedef float f32x8 __attribute__((ext_vector_type(8)));
#define KSWZ(row, colB) ((row) * 256 + ((colB) ^ (((row) & 15) << 4)))
#define RSWZ(row, colB) ((row) * 128 + ((colB) ^ ((((row) >> 1) & 7) << 4)))
#define SBAR() __builtin_amdgcn_sched_barrier(0)
__device__ __forceinline__ int crow(int r, int hi) { return (r & 3) + 8 * (r >> 2) + 4 * hi; }
__device__ __forceinline__ void partialSM(f32x16& p0, f32x16& p1, float& m_reg, float& mn, float& alpha) {
  constexpr float C = SCALE * 1.4426950408889634f;
  float pmax = p0[0];
#pragma unroll
  for (int r = 1; r < 16; ++r) pmax = fmaxf(pmax, p0[r]);
#pragma unroll
  for (int r = 0; r < 16; ++r) pmax = fmaxf(pmax, p1[r]);
  { auto rr = __builtin_amdgcn_permlane32_swap(__float_as_uint(pmax), __float_as_uint(pmax), false, false);
    pmax = fmaxf(__uint_as_float(rr[0]), __uint_as_float(rr[1])); }
  if (__builtin_expect(__all(pmax - m_reg <= THR / SCALE), 1)) { mn = m_reg; alpha = 1.f; }
  else { mn = fmaxf(m_reg, pmax); alpha = __builtin_amdgcn_exp2f((m_reg - mn) * C); m_reg = mn; }
  const float mnC = -mn * C;
#pragma unroll
  for (int r = 0; r < 16; ++r) p0[r] = fmaf(p0[r], C, mnC);
#pragma unroll
  for (int r = 0; r < 16; ++r) p1[r] = fmaf(p1[r], C, mnC);
#pragma unroll
  for (int r = 0; r < 16; ++r) p0[r] = __builtin_amdgcn_exp2f(p0[r]);
}
__device__ __forceinline__ void finishSM(f32x16& p0, f32x16& p1, float alpha, float& l_reg, bf16x8& pa0, bf16x8& pa1, bf16x8& pa2, bf16x8& pa3) {
#pragma unroll
  for (int r = 0; r < 16; ++r) p1[r] = __builtin_amdgcn_exp2f(p1[r]);
  float ps = 0;
#pragma unroll
  for (int r = 0; r < 16; ++r) ps += p0[r];
#pragma unroll
  for (int r = 0; r < 16; ++r) ps += p1[r];
  { auto rr = __builtin_amdgcn_permlane32_swap(__float_as_uint(ps), __float_as_uint(ps), false, false);
    ps = __uint_as_float(rr[0]) + __uint_as_float(rr[1]); }
  l_reg = l_reg * alpha + ps;
#define PK4(P, BASE, OUT) do { unsigned a0 = cvtpk(P[BASE + 0], P[BASE + 1]), a1 = cvtpk(P[BASE + 2], P[BASE + 3]);   \
    unsigned b0 = cvtpk(P[BASE + 4], P[BASE + 5]), b1 = cvtpk(P[BASE + 6], P[BASE + 7]);                              \
    auto r0 = __builtin_amdgcn_permlane32_swap(a0, b0, false, false); auto r1 = __builtin_amdgcn_permlane32_swap(a1, b1, false, false); \
    u32x4 w = {r0[0], r1[0], r0[1], r1[1]}; OUT = *reinterpret_cast<bf16x8*>(&w); } while (0)
  PK4(p0, 0, pa0); PK4(p0, 8, pa1); PK4(p1, 0, pa2); PK4(p1, 8, pa3);
#undef PK4
}
__device__ __forceinline__ void qkt(f32x16& p0, f32x16& p1, const char* Ks, const char* Rs, const bf16x8* qr, const char* qrl, int r32, int hi) {
  p0 = f32x16{}; p1 = f32x16{};
#pragma unroll
  for (int d0 = 0; d0 < 8; ++d0) { const int cb = (d0 * 16 + hi * 8) * 2;
    const bf16x8 b0 = *reinterpret_cast<const bf16x8*>(Ks + KSWZ(r32, cb));
    const bf16x8 b1 = *reinterpret_cast<const bf16x8*>(Ks + KSWZ(32 + r32, cb));
    p0 = __builtin_amdgcn_mfma_f32_32x32x16_bf16(b0, qr[d0], p0, 0, 0, 0);
    p1 = __builtin_amdgcn_mfma_f32_32x32x16_bf16(b1, qr[d0], p1, 0, 0, 0); }
#pragma unroll
  for (int d0 = 0; d0 < 4; ++d0) { const int cb = (d0 * 16 + hi * 8) * 2;
    const bf16x8 b0 = *reinterpret_cast<const bf16x8*>(Rs + RSWZ(r32, cb));
    const bf16x8 b1 = *reinterpret_cast<const bf16x8*>(Rs + RSWZ(32 + r32, cb));
    p0 = __builtin_amdgcn_mfma_f32_32x32x16_bf16(b0, qr[8 + d0], p0, 0, 0, 0);
    p1 = __builtin_amdgcn_mfma_f32_32x32x16_bf16(b1, qr[8 + d0], p1, 0, 0, 0); }
}
__device__ __forceinline__ int v_st(int k, int c) { const int kk = (k & ~0xC) | ((k & 4) << 1) | ((k & 8) >> 1); return ((kk >> 3) * 4 + (c >> 5)) * 512 + ((kk & 7) * 32 + (c & 31)) * 2; }
__device__ __forceinline__ int v_rd_base(int lane) { return ((lane & 3) << 3) | (((lane >> 2) & 3) << 6) | (((lane >> 4) & 1) << 5) | (((lane >> 5) & 1) << 8); }
constexpr int v_rd_off(int d0, int ks, int half) { return d0 * 512 + ks * 4096 + half * 2048; }
template <int OFF> __device__ __forceinline__ s16x4 tr_read(int vb) {
  s16x4 r; asm volatile("ds_read_b64_tr_b16 %0, %1 offset:%2" : "=&v"(r) : "v"(vb), "i"(OFF) : "memory"); return r;
}
template <int D0> __device__ __forceinline__ void pv_one(f32x16& od, int vb, bf16x8 pa0, bf16x8 pa1, bf16x8 pa2, bf16x8 pa3) {
  const s16x4 l0 = tr_read<v_rd_off(D0, 0, 0)>(vb), h0 = tr_read<v_rd_off(D0, 0, 1)>(vb), l1 = tr_read<v_rd_off(D0, 1, 0)>(vb), h1 = tr_read<v_rd_off(D0, 1, 1)>(vb);
  const s16x4 l2 = tr_read<v_rd_off(D0, 2, 0)>(vb), h2 = tr_read<v_rd_off(D0, 2, 1)>(vb), l3 = tr_read<v_rd_off(D0, 3, 0)>(vb), h3 = tr_read<v_rd_off(D0, 3, 1)>(vb);
  asm volatile("s_waitcnt lgkmcnt(0)" ::: "memory"); SBAR();
#define PK(L, H) (bf16x8){L[0], L[1], L[2], L[3], H[0], H[1], H[2], H[3]}
  od = __builtin_amdgcn_mfma_f32_32x32x16_bf16(pa0, PK(l0, h0), od, 0, 0, 0);
  od = __builtin_amdgcn_mfma_f32_32x32x16_bf16(pa1, PK(l1, h1), od, 0, 0, 0);
  od = __builtin_amdgcn_mfma_f32_32x32x16_bf16(pa2, PK(l2, h2), od, 0, 0, 0);
  od = __builtin_amdgcn_mfma_f32_32x32x16_bf16(pa3, PK(l3, h3), od, 0, 0, 0);
#undef PK
}
__device__ __forceinline__ void pv_d0(f32x16* o, int vb, bf16x8 pa0, bf16x8 pa1, bf16x8 pa2, bf16x8 pa3) {
  pv_one<0>(o[0], vb, pa0, pa1, pa2, pa3); pv_one<1>(o[1], vb, pa0, pa1, pa2, pa3); pv_one<2>(o[2], vb, pa0, pa1, pa2, pa3); pv_one<3>(o[3], vb, pa0, pa1, pa2, pa3);
}
__device__ __forceinline__ void attn_body(const bf16_t* __restrict__ Qb, const float* __restrict__ cs, const float* __restrict__ sn, const bf16_t* __restrict__ Kn,
                                          const bf16_t* __restrict__ Vh, const bf16_t* __restrict__ Kr, bf16_t* __restrict__ Ob, int seq, char* lds) {
  const int tid = otid(), wid = tid >> 6, lane = tid & 63, r32 = lane & 31, hi = lane >> 5;
  char* V_lds = lds; char* K_lds = lds + 2 * SHM_V; char* R_lds = lds + 2 * SHM_V + 2 * SHM_K;
  float* wsf = (float*)(lds + 2 * SHM_V + 2 * SHM_K + 2 * SHM_R) + wid * 64; float* li_l = wsf; float* al_l = wsf + 32;
  char* qrl = lds + 2 * SHM_V + 2 * SHM_K + 2 * SHM_R + 2048 + wid * 4096 + lane * 16;
  float m_reg = -1e30f, l_reg = 0; f32x16 o[4] = {}; bf16x8 qr[12];
  { const bf16_t* Qw = Qb + (size_t)(wid * QBLK + r32) * LDQ + hi * 8;
#pragma unroll
    for (int d0 = 0; d0 < 8; ++d0) qr[d0] = *(const bf16x8*)(Qw + d0 * 16);
#pragma unroll
    for (int d0 = 0; d0 < 2; ++d0) {
      const u32x4 a = *(const u32x4*)(Qw + 128 + d0 * 16), bq = *(const u32x4*)(Qw + 160 + d0 * 16);
      if (cs) {
        const float* cp = cs + (size_t)(wid * QBLK + r32) * 32 + d0 * 16 + hi * 8; const float* sp = sn + (size_t)(wid * QBLK + r32) * 32 + d0 * 16 + hi * 8;
        const f32x4 c0 = *(const f32x4*)cp, c1 = *(const f32x4*)(cp + 4), s0 = *(const f32x4*)sp, s1 = *(const f32x4*)(sp + 4);
        float x1[8], x2[8], y1[8], y2[8];
#pragma unroll
        for (int k = 0; k < 4; ++k) { x1[2 * k] = bflo(a[k]); x1[2 * k + 1] = bfhi(a[k]); x2[2 * k] = bflo(bq[k]); x2[2 * k + 1] = bfhi(bq[k]); }
#pragma unroll
        for (int k = 0; k < 8; ++k) { const float c = k < 4 ? c0[k & 3] : c1[k & 3], s = k < 4 ? s0[k & 3] : s1[k & 3]; y1[k] = x1[k] * c - x2[k] * s; y2[k] = x2[k] * c + x1[k] * s; }
        u32x4 w1 = {cvtpk(y1[0], y1[1]), cvtpk(y1[2], y1[3]), cvtpk(y1[4], y1[5]), cvtpk(y1[6], y1[7])}, w2 = {cvtpk(y2[0], y2[1]), cvtpk(y2[2], y2[3]), cvtpk(y2[4], y2[5]), cvtpk(y2[6], y2[7])};
        qr[8 + d0] = *reinterpret_cast<bf16x8*>(&w1); qr[10 + d0] = *reinterpret_cast<bf16x8*>(&w2);
      } else { u32x4 a_ = a, b_ = bq; qr[8 + d0] = *reinterpret_cast<bf16x8*>(&a_); qr[10 + d0] = *reinterpret_cast<bf16x8*>(&b_); }
    } }
  const int sr = tid >> 4, sc = (tid & 15) * 8, vst0 = v_st(sr, sc), vst1 = v_st(32 + sr, sc);
  const int rr_ = tid >> 3, rc = (tid & 7) * 8;
  const int vb0 = (int)(uintptr_t)V_lds + v_rd_base(lane);
  bf16x8 vs0, vs1, ks0, ks1, rs0;
  const unsigned voffKV = (unsigned)(sr * LDK + sc) * 2u, voffR = (unsigned)(rr_ * LDKR + rc) * 2u;
#define SLOAD(k0) do { const char* kb_ = (const char*)Kn + (size_t)(k0) * (LDK * 2); const char* vb_ = (const char*)Vh + (size_t)(k0) * (LDK * 2); \
    vs0 = *(const bf16x8*)(vb_ + voffKV); vs1 = *(const bf16x8*)(vb_ + 32 * LDK * 2 + voffKV); \
    ks0 = *(const bf16x8*)(kb_ + voffKV); ks1 = *(const bf16x8*)(kb_ + 32 * LDK * 2 + voffKV); \
    rs0 = *(const bf16x8*)((const char*)Kr + (size_t)(k0) * (LDKR * 2) + voffR); } while (0)
#define SWRITE(b) do { *(bf16x8*)(V_lds + (b) * SHM_V + vst0) = vs0; *(bf16x8*)(V_lds + (b) * SHM_V + vst1) = vs1; const int kc = sc * 2;  \
    *(bf16x8*)(K_lds + (b) * SHM_K + KSWZ(sr, kc)) = ks0; *(bf16x8*)(K_lds + (b) * SHM_K + KSWZ(32 + sr, kc)) = ks1;                      \
    *(bf16x8*)(R_lds + (b) * SHM_R + RSWZ(rr_, rc * 2)) = rs0; } while (0)
#define RESC(a) do { if (__any((a) < 1.f)) { if (hi == 0) al_l[r32] = (a); asm volatile("s_waitcnt lgkmcnt(0)" ::: "memory"); \
    _Pragma("unroll") for (int d = 0; d < 4; ++d) _Pragma("unroll") for (int r = 0; r < 16; ++r) o[d][r] *= al_l[crow(r, hi)]; } } while (0)
  f32x16 pA0, pA1, pB0, pB1; float mnA, mnB, alA, alB; bf16x8 pa0, pa1, pa2, pa3; const int NT = seq / KVBLK;
  SLOAD(0); SWRITE(0); __syncthreads();
  qkt(pA0, pA1, K_lds, R_lds, qr, qrl, r32, hi); partialSM(pA0, pA1, m_reg, mnA, alA);
  SLOAD(KVBLK); SWRITE(1); __syncthreads();
  for (int j = 1; j + 1 < NT; j += 2) {
    SBAR(); qkt(pB0, pB1, K_lds + SHM_K, R_lds + SHM_R, qr, qrl, r32, hi);
    finishSM(pA0, pA1, alA, l_reg, pa0, pa1, pa2, pa3); SBAR();
    SLOAD((j + 1) * KVBLK); SBAR();
    pv_d0(o, vb0, pa0, pa1, pa2, pa3); partialSM(pB0, pB1, m_reg, mnB, alB);
    __syncthreads(); SWRITE(0);
    RESC(alB); __syncthreads();
    SBAR(); qkt(pA0, pA1, K_lds, R_lds, qr, qrl, r32, hi);
    finishSM(pB0, pB1, alB, l_reg, pa0, pa1, pa2, pa3); SBAR();
    SLOAD((j + 2) * KVBLK); SBAR();
    pv_d0(o, vb0 + (int)SHM_V, pa0, pa1, pa2, pa3); partialSM(pA0, pA1, m_reg, mnA, alA);
    __syncthreads(); SWRITE(1);
    RESC(alA); __syncthreads();
  }
  SBAR(); qkt(pB0, pB1, K_lds + SHM_K, R_lds + SHM_R, qr, qrl, r32, hi);
  finishSM(pA0, pA1, alA, l_reg, pa0, pa1, pa2, pa3); SBAR();
  pv_d0(o, vb0, pa0, pa1, pa2, pa3); partialSM(pB0, pB1, m_reg, mnB, alB);
  __syncthreads(); RESC(alB);
  finishSM(pB0, pB1, alB, l_reg, pa0, pa1, pa2, pa3); SBAR();
  pv_d0(o, vb0 + (int)SHM_V, pa0, pa1, pa2, pa3);
  if (hi == 0) li_l[r32] = l_reg; asm volatile("s_waitcnt lgkmcnt(0)" ::: "memory");
  float rli[16];
#pragma unroll
  for (int r = 0; r < 16; ++r) rli[r] = __builtin_amdgcn_rcpf(li_l[crow(r, hi)]);
  bf16_t* Ow = Ob + (size_t)(wid * QBLK) * LDO;
#pragma unroll
  for (int r = 0; r < 16; ++r) { const int orow = crow(r, hi);
#pragma unroll
    for (int d0 = 0; d0 < 4; ++d0) Ow[(size_t)orow * LDO + d0 * 32 + r32] = f2bf(o[d0][r] * rli[r]); }
  __syncthreads();
#undef SLOAD
#undef SWRITE
#undef RESC
}
}

__device__ void phase_attn(PRef p, int l, char* smem) {
  const bf16_t* Q = (const bf16_t*)(p.ws + WS_Q); const bf16_t* KV = (const bf16_t*)(p.ws + WS_KV); const bf16_t* KR = (const bf16_t*)(p.ws + WS_KR);
  bf16_t* mix = (bf16_t*)(p.ws + WS_MIX); const float* cs = (const float*)(p.ws + WS_COS); const float* sn = (const float*)(p.ws + WS_SIN);
  const int nunits = 1024 + (l == 0 ? 32 : 0);
  for (int u = obid(); u < nunits; u += gridDim.x) {
    if (u < 1024) {
      const int bh = (u >> 8) * 8 + (u & 7), qb = (u & 255) >> 3, hd = bh & 3, b = bh >> 2; const size_t row0 = (size_t)b * SEQ + qb * 256;
      att::attn_body(Q + row0 * 768 + hd * 192, cs + (size_t)qb * 256 * 32, sn + (size_t)qb * 256 * 32, KV + (size_t)b * SKV * 1024 + hd * 256,
                     KV + (size_t)b * SKV * 1024 + hd * 256 + 128, KR + (size_t)b * SKV * 64, mix + row0 * 1024 + 512 + hd * 128, SKV, smem);
    } else {
      const int v = u - 1024, hd = v & 3, b = v >> 2; const size_t row0 = (size_t)MX + b * CTXL;
      att::attn_body(Q + row0 * 768 + hd * 192, nullptr, nullptr, KV + (size_t)b * SKV * 1024 + hd * 256,
                     KV + (size_t)b * SKV * 1024 + hd * 256 + 128, KR + (size_t)b * SKV * 64, mix + row0 * 1024 + 512 + hd * 128, CTXL, smem);
    }
  }
}

__device__ void phase_outproj(PRef p, int l, char* smem) {
  LAS unsigned char* lds = (LAS unsigned char*)smem;
  const bf16_t* mix = (const bf16_t*)(p.ws + WS_MIX); const bf16_t* Wt = (const bf16_t*)(p.ws + WS_WOUT) + (size_t)l * 1024 * 1024;
  float* ctxz = (float*)(p.ws + WS_CTXZ);
  const int tid = otid(), wid = tid >> 6, lane = tid & 63, wr = wid >> 2, wc = wid & 3, fr = lane & 15, fq = lane >> 4;
  g8::TileIter it; it.init(l == 0 ? MT / 256 : MX / 256, 4);
  int pm, pn;
  while (it.next(pm, pn)) {
    unsigned voffA[2] = {g8::piece_off(0, 1024, 0), g8::piece_off(1, 1024, 0)};
    f32x4 acc[2][2][4][2];
    g8::gemm_tile<false>(lds, (const char*)(mix + (size_t)pm * 256 * 1024), voffA, (size_t)128 * 1024 * 2, (const char*)(Wt + (size_t)pn * 256 * 1024), 1024, acc);
    ACC_FOR(ai, bj, m, n) {
      const int row = pm * 256 + ai * 128 + wr * 64 + m * 16 + fr, col = pn * 256 + bj * 128 + wc * 32 + fq * 8 + n * 4;
      const float* res = l == 0 ? (row < MX ? p.x + (size_t)row * 1024 : p.ctx + (size_t)(row - MX) * 1024) : p.out + (size_t)row * 1024;
      float* dst = row < MX ? p.out + (size_t)row * 1024 : ctxz + (size_t)(row - MX) * 1024;
      const f32x4 r = *(const f32x4*)(res + col), g = *(const f32x4*)(mod_ptr(p, l, row, 2) + col);
      *(f32x4*)(dst + col) = r * ALPHA + g * acc[ai][bj][m][n];
    }
  }
}

__device__ void phase_ln1(PRef p, int l, char* smem) {
  float* wrt = (float*)smem;
  for (int i = otid(); i < 16384; i += 512) wrt[(i & 15) * 1024 + (i >> 4)] = p.w_router[(size_t)l * 16384 + i];
  __syncthreads();
  const int lane = otid() & 63, gw = obid() * 8 + (otid() >> 6), nw = gridDim.x * 8;
  bf16_t* h = (bf16_t*)(p.ws + WS_H); float* ctxz = (float*)(p.ws + WS_CTXZ); float* aff = (float*)(p.ws + WS_AFF);
  const int nrows = l == 0 ? MT : MX;
  for (int row = gw; row < nrows; row += nw) {
    asm volatile("" ::: "memory");
    float* zr = row < MX ? p.out + (size_t)row * 1024 : ctxz + (size_t)(row - MX) * 1024;
    f32x4 v[4];
#pragma unroll
    for (int i = 0; i < 4; ++i) v[i] = *(const f32x4*)(zr + lane * 4 + 256 * i);
    ln_row(v, 1e-5f);
#pragma unroll
    for (int i = 0; i < 4; ++i) { const int c = lane * 4 + 256 * i; v[i] = v[i] * *(const f32x4*)(p.ln1_g + l * 1024 + c) + *(const f32x4*)(p.ln1_b + l * 1024 + c); *(f32x4*)(zr + c) = v[i]; }
    ln_row(v, 1e-6f);
    f32x4 hm[4];
    store_mod_bf16(v, mod_ptr(p, l, row, 3), mod_ptr(p, l, row, 4), h + (size_t)row * 1024, lane, &hm);
    float lg[16];
#pragma unroll
    for (int e = 0; e < 16; ++e) { float s = 0.f;
#pragma unroll
      for (int i = 0; i < 4; ++i) { const f32x4 w = *(const f32x4*)(wrt + e * 1024 + lane * 4 + 256 * i); s += hm[i][0] * w[0] + hm[i][1] * w[1] + hm[i][2] * w[2] + hm[i][3] * w[3]; }
      lg[e] = wave_sum(s); }
    float mx = lg[0];
#pragma unroll
    for (int e = 1; e < 16; ++e) mx = fmaxf(mx, lg[e]);
    float den = 0.f;
#pragma unroll
    for (int e = 0; e < 16; ++e) { lg[e] = expf(lg[e] - mx); den += lg[e]; }
    float mine = 0.f;
#pragma unroll
    for (int e = 0; e < 16; ++e) if (lane == e) mine = lg[e] / den;
    if (lane < 16) aff[(size_t)row * 16 + lane] = mine;
  }
}

template <int PER>
__device__ __forceinline__ void topk_item(const float* __restrict__ affp, int n, int kcap, int rowbase, int slotbase, int e, int* __restrict__ IDX, float* __restrict__ GV, int* __restrict__ TS, char* smem) {
  unsigned* hist = (unsigned*)smem; unsigned* sel = hist + 256; unsigned* wtot = hist + 272;
  const int tid = otid(), lane = tid & 63, wid = tid >> 6;
  const bool active = tid * PER < n;
  unsigned key[PER];
#pragma unroll
  for (int i = 0; i < PER; ++i) key[i] = active ? __float_as_uint(affp[(size_t)(tid * PER + i) * 16]) : 0u;
  unsigned prefix = 0u, mask = 0u; int kk = kcap;
#pragma unroll 1
  for (int shift = 24; shift >= 0; shift -= 8) {
    __syncthreads();
    if (tid < 256) hist[tid] = 0u;
    __syncthreads();
#pragma unroll
    for (int i = 0; i < PER; ++i) if (active && (key[i] & mask) == prefix) atomicAdd(&hist[(key[i] >> shift) & 255u], 1u);
    __syncthreads();
    if (wid == 0) {
      const unsigned h0 = hist[lane * 4], h1 = hist[lane * 4 + 1], h2 = hist[lane * 4 + 2], h3 = hist[lane * 4 + 3];
      const unsigned tot = h0 + h1 + h2 + h3; unsigned suf = tot;
#pragma unroll
      for (int o = 1; o < 64; o <<= 1) { const unsigned u = __shfl_down(suf, o); if (lane + o < 64) suf += u; }
      const unsigned above = suf - tot;
      if (above < (unsigned)kk && suf >= (unsigned)kk) {
        unsigned a = above; int bin;
        if (a + h3 >= (unsigned)kk) bin = 3; else { a += h3; if (a + h2 >= (unsigned)kk) bin = 2; else { a += h2; if (a + h1 >= (unsigned)kk) bin = 1; else { a += h1; bin = 0; } } }
        sel[0] = prefix | ((unsigned)(lane * 4 + bin) << shift); sel[1] = (unsigned)kk - a;
      }
    }
    __syncthreads();
    prefix = sel[0]; kk = (int)sel[1]; mask |= 0xffu << shift;
  }
  const unsigned Tk = prefix;
  unsigned cg_ = 0, ce = 0;
#pragma unroll
  for (int i = 0; i < PER; ++i) { cg_ += key[i] > Tk; ce += key[i] == Tk; }
  unsigned pk = active ? (cg_ | (ce << 16)) : 0u, inc = pk;
#pragma unroll
  for (int o = 1; o < 64; o <<= 1) { const unsigned u = __shfl_up(inc, o); if (lane >= o) inc += u; }
  __syncthreads();
  if (lane == 63) wtot[wid] = inc;
  __syncthreads();
  unsigned base = 0;
  for (int w2 = 0; w2 < wid; ++w2) base += wtot[w2];
  const unsigned exc = base + inc - pk; unsigned gt_before = exc & 0xffffu, eq_before = exc >> 16;
  if (active) {
#pragma unroll
    for (int i = 0; i < PER; ++i) {
      const int t = tid * PER + i; int R = -1;
      const bool isgt = key[i] > Tk, iseq = key[i] == Tk;
      if (isgt || (iseq && (int)eq_before < kk)) {
        const int slot = (int)gt_before + min((int)eq_before, kk);
        R = slotbase + slot; IDX[R] = rowbase + t; GV[R] = __uint_as_float(key[i]);
      }
      TS[t] = R;
      gt_before += isgt; eq_before += iseq;
    }
  }
}
__device__ void phase_topk(PRef p, int l, char* smem) {
  const float* aff = (const float*)(p.ws + WS_AFF); int* IDX = (int*)(p.ws + WS_IDX); float* GV = (float*)(p.ws + WS_GV); int* TS = (int*)(p.ws + WS_TS);
  const int nitems = l == 0 ? 256 : 128;
  for (int it = obid(); it < nitems; it += gridDim.x) {
    if (it < 128) { const int b = it >> 4, e = it & 15; topk_item<16>(aff + (size_t)b * SEQ * 16 + e, SEQ, CAPX, b * SEQ, it * CAPX, e, IDX, GV, TS + (size_t)it * SEQ, smem); }
    else { const int v = it - 128, b = v >> 4, e = v & 15; topk_item<1>(aff + ((size_t)MX + b * CTXL) * 16 + e, CTXL, CAPC, MX + b * CTXL, NB * NE * CAPX + e * 256 + b * CAPC, e, IDX, GV, TS + (size_t)NB * 16 * SEQ + (size_t)v * CTXL, smem); }
  }
  __syncthreads();
}

__device__ void phase_moe_up(PRef p, int l, char* smem) {
  LAS unsigned char* lds = (LAS unsigned char*)smem;
  const bf16_t* h = (const bf16_t*)(p.ws + WS_H); const bf16_t* Wgu = (const bf16_t*)(p.ws + WS_WGU); bf16_t* act = (bf16_t*)(p.ws + WS_ACT); const int* IDX = (const int*)(p.ws + WS_IDX);
  const int tid = otid(), wid = tid >> 6, lane = tid & 63, wr = wid >> 2, wc = wid & 3, fr = lane & 15, fq = lane >> 4;
  g8::MoeIter it; it.init(8, l == 0);
  int pm, pn, e;
  while (it.next(pm, pn, e)) {
    unsigned voffA[4];
#pragma unroll
    for (int hh = 0; hh < 2; ++hh)
#pragma unroll
      for (int i = 0; i < 2; ++i) { int R, C; g8::piece_rc(i, R, C); voffA[hh * 2 + i] = (unsigned)(IDX[pm * 256 + hh * 128 + R] * 1024 + C) * 2u; }
    f32x4 acc[2][2][4][2];
    g8::gemm_tile<true>(lds, (const char*)h, voffA, 0, (const char*)(Wgu + ((size_t)e * 2048 + pn * 256) * 1024), 1024, acc);
#pragma unroll
    for (int ai = 0; ai < 2; ++ai)
#pragma unroll
      for (int m = 0; m < 4; ++m) {
          const int row = pm * 256 + ai * 128 + wr * 64 + m * 16 + fr, col = pn * 128 + wc * 32 + fq * 8;
          float a[8];
#pragma unroll
          for (int n = 0; n < 2; ++n) { const f32x4 g = acc[ai][0][m][n], u = acc[ai][1][m][n];
#pragma unroll
            for (int k = 0; k < 4; ++k) a[n * 4 + k] = silu_f(g[k]) * u[k]; }
          u32x4 w = {cvtpk(a[0], a[1]), cvtpk(a[2], a[3]), cvtpk(a[4], a[5]), cvtpk(a[6], a[7])}; *(u32x4*)(act + (size_t)row * 1024 + col) = w;
        }
  }
}
__device__ void phase_moe_down(PRef p, int l, char* smem) {
  LAS unsigned char* lds = (LAS unsigned char*)smem;
  const bf16_t* act = (const bf16_t*)(p.ws + WS_ACT); const bf16_t* Wdn = (const bf16_t*)(p.ws + WS_WDN); bf16_t* oute = (bf16_t*)(p.ws + WS_OUTE); const float* GV = (const float*)(p.ws + WS_GV);
  const int tid = otid(), wid = tid >> 6, lane = tid & 63, wr = wid >> 2, wc = wid & 3, fr = lane & 15, fq = lane >> 4;
  g8::MoeIter it; it.init(4, l == 0);
  int pm, pn, e;
  while (it.next(pm, pn, e)) {
    unsigned voffA[2] = {g8::piece_off(0, 1024, 0), g8::piece_off(1, 1024, 0)};
    f32x4 acc[2][2][4][2];
    g8::gemm_tile<false>(lds, (const char*)(act + (size_t)pm * 256 * 1024), voffA, (size_t)128 * 1024 * 2, (const char*)(Wdn + ((size_t)e * 1024 + pn * 256) * 1024), 1024, acc);
    ACC_FOR3(ai, bj, m) {
      const int row = pm * 256 + ai * 128 + wr * 64 + m * 16 + fr, col = pn * 256 + bj * 128 + wc * 32 + fq * 8;
      const float gv = GV[row]; const f32x4 v0 = acc[ai][bj][m][0] * gv, v1 = acc[ai][bj][m][1] * gv;
      u32x4 w = {cvtpk(v0[0], v0[1]), cvtpk(v0[2], v0[3]), cvtpk(v1[0], v1[1]), cvtpk(v1[2], v1[3])}; *(u32x4*)(oute + (size_t)row * 1024 + col) = w;
    }
  }
}

__device__ void phase_ln2(PRef p, int l) {
  const int lane = otid() & 63, gw = obid() * 8 + (otid() >> 6), nw = gridDim.x * 8;
  bf16_t* h = (bf16_t*)(p.ws + WS_H); float* ctxz = (float*)(p.ws + WS_CTXZ); const bf16_t* oute = (const bf16_t*)(p.ws + WS_OUTE); const int* TS = (const int*)(p.ws + WS_TS);
  const int nrows = l == 0 ? MT : MX;
  for (int row = gw; row < nrows; row += nw) {
    float* xr = row < MX ? p.out + (size_t)row * 1024 : ctxz + (size_t)(row - MX) * 1024;
    f32x4 mo[4];
#pragma unroll
    for (int i = 0; i < 4; ++i) mo[i] = (f32x4){0.f, 0.f, 0.f, 0.f};
    const int myR = lane < 16 ? (row < MX ? TS[((size_t)(row >> 13) * 16 + lane) * SEQ + (row & 8191)] : TS[(size_t)NB * 16 * SEQ + ((size_t)((row - MX) >> 8) * 16 + lane) * CTXL + ((row - MX) & 255)]) : -1;
    f32x4 xv[4];
#pragma unroll
    for (int i = 0; i < 4; ++i) xv[i] = *(const f32x4*)(xr + lane * 4 + 256 * i);
    unsigned long long hits = __ballot(myR >= 0) & 0xffffull;
    while (hits) {
      const int e0 = __builtin_ctzll(hits); hits &= hits - 1; const int R0 = __shfl(myR, e0);
      int R1 = -1; if (hits) { const int e1 = __builtin_ctzll(hits); hits &= hits - 1; R1 = __shfl(myR, e1); }
      u32x2 w0[4], w1[4];
#pragma unroll
      for (int i = 0; i < 4; ++i) w0[i] = *(const u32x2*)(oute + (size_t)R0 * 1024 + lane * 4 + 256 * i);
      if (R1 >= 0) {
#pragma unroll
        for (int i = 0; i < 4; ++i) w1[i] = *(const u32x2*)(oute + (size_t)R1 * 1024 + lane * 4 + 256 * i); }
      else {
#pragma unroll
        for (int i = 0; i < 4; ++i) w1[i] = (u32x2){0u, 0u}; }
#pragma unroll
      for (int i = 0; i < 4; ++i) { mo[i][0] += bflo(w0[i][0]); mo[i][1] += bfhi(w0[i][0]); mo[i][2] += bflo(w0[i][1]); mo[i][3] += bfhi(w0[i][1]); }
#pragma unroll
      for (int i = 0; i < 4; ++i) { mo[i][0] += bflo(w1[i][0]); mo[i][1] += bfhi(w1[i][0]); mo[i][2] += bflo(w1[i][1]); mo[i][3] += bfhi(w1[i][1]); }
    }
    f32x4 v[4]; const float* m5 = mod_ptr(p, l, row, 5);
#pragma unroll
    for (int i = 0; i < 4; ++i) { const int c = lane * 4 + 256 * i; v[i] = xv[i] * ALPHA + *(const f32x4*)(m5 + c) * mo[i]; }
    ln_row(v, 1e-5f);
#pragma unroll
    for (int i = 0; i < 4; ++i) { const int c = lane * 4 + 256 * i; v[i] = v[i] * *(const f32x4*)(p.ln2_g + l * 1024 + c) + *(const f32x4*)(p.ln2_b + l * 1024 + c); *(f32x4*)(xr + c) = v[i]; }
    if (l + 1 < DEPTH) { ln_row(v, 1e-6f); store_mod_bf16(v, mod_ptr(p, l + 1, row, 0), mod_ptr(p, l + 1, row, 1), h + (size_t)row * 1024, lane, nullptr); }
  }
}

__device__ __forceinline__ void gsync(cg::grid_group& grid) {
  asm volatile("s_waitcnt vmcnt(0) lgkmcnt(0)" ::: "memory");
  grid.sync();
}
#define XB_CEN(j) (64 * (j))
#define XB_SUB(j) (1024 + 64 * (j))
#define XB_TOP 2048
struct FastBar { unsigned* w; unsigned xcc, nloc, nx, epoch; };
__device__ __forceinline__ unsigned xb_ld(unsigned* q) { return __hip_atomic_load(q, __ATOMIC_RELAXED, __HIP_MEMORY_SCOPE_AGENT); }
__device__ __forceinline__ unsigned xb_add(unsigned* q, unsigned v) { return __hip_atomic_fetch_add(q, v, __ATOMIC_RELAXED, __HIP_MEMORY_SCOPE_AGENT); }
__device__ __forceinline__ void fsync(FastBar& fb) {
  asm volatile("s_waitcnt vmcnt(0) lgkmcnt(0)" ::: "memory");
  __syncthreads();
  fb.epoch += 1u;
  if (otid() == 0) {
    const unsigned a = xb_add(&fb.w[XB_SUB(fb.xcc)], 1u) + 1u;
    if (a == fb.nloc * fb.epoch) {
      __builtin_amdgcn_fence(__ATOMIC_RELEASE, "agent");
      asm volatile("s_waitcnt vmcnt(0)" ::: "memory");
      (void)xb_add(&fb.w[XB_TOP], 1u);
    }
    while (xb_ld(&fb.w[XB_TOP]) < fb.nx * fb.epoch) __builtin_amdgcn_s_sleep(1);
    __builtin_amdgcn_fence(__ATOMIC_ACQUIRE, "agent");
    asm volatile("s_waitcnt vmcnt(0)" ::: "memory");
  }
  __syncthreads();
}
__global__ void __launch_bounds__(512) mega(Params p) {
  extern __shared__ __attribute__((aligned(16))) char smem[];
  cg::grid_group grid = cg::this_grid();
  FastBar fb; fb.w = (unsigned*)(kparams().ws + WS_BAR); fb.xcc = (unsigned)__builtin_amdgcn_readfirstlane((int)(__builtin_amdgcn_s_getreg((3 << 11) | 20) & 0xF)); fb.epoch = 0u; fb.nloc = 0u; fb.nx = 0u;
  if (otid() == 0) (void)xb_add(&fb.w[XB_CEN(fb.xcc)], 1u);
  phase_prep(kparams(), smem);
  if (kparams().out == nullptr) gsync(grid);
  if (otid() == 0) { for (;;) { unsigned sum = 0u;
#pragma unroll 1
      for (int j = 0; j < 16; ++j) sum += xb_ld(&fb.w[XB_CEN(j)]);
      if (sum == gridDim.x) break; __builtin_amdgcn_s_sleep(2); } }
  __syncthreads();
  { unsigned nx = 0u;
#pragma unroll 1
    for (int j = 0; j < 16; ++j) nx += xb_ld(&fb.w[XB_CEN(j)]) != 0u;
    fb.nx = (unsigned)__builtin_amdgcn_readfirstlane((int)nx); fb.nloc = (unsigned)__builtin_amdgcn_readfirstlane((int)xb_ld(&fb.w[XB_CEN(fb.xcc)])); }
  fsync(fb);
  phase_h0(kparams());
  fsync(fb);
#pragma unroll 1
  for (int l = 0; l < DEPTH; ++l) {
    phase_inproj(kparams(), l, smem);
    fsync(fb);
    phase_mlstm_pre(kparams(), l, smem);
    fsync(fb);
    phase_mlstm(kparams(), l, smem);
    fsync(fb);
    phase_mla_prep(kparams(), l, smem);
    fsync(fb);
    phase_attn(kparams(), l, smem);
    fsync(fb);
    phase_outproj(kparams(), l, smem);
    fsync(fb);
    phase_ln1(kparams(), l, smem);
    __syncthreads();
    phase_cvt_experts(kparams(), l, smem);
    fsync(fb);
    phase_topk(kparams(), l, smem);
    fsync(fb);
    phase_moe_up(kparams(), l, smem);
    fsync(fb);
    phase_moe_down(kparams(), l, smem);
    fsync(fb);
    phase_ln2(kparams(), l);
    fsync(fb);
  }
}

extern "C" void kernel_launch(void* const* d_in, const int* in_sizes, int n_in, void* d_out, int out_size,
                              void* d_ws, size_t ws_size, hipStream_t stream) {
  constexpr size_t kDynLds = 160 * 1024;
  static int grid_blocks = 0;
  if (!grid_blocks) {
    int dev = 0, cus = 0, per_cu = 0;
    (void)hipGetDevice(&dev);
    (void)hipDeviceGetAttribute(&cus, hipDeviceAttributeMultiprocessorCount, dev);
    (void)hipFuncSetAttribute((const void*)mega, hipFuncAttributeMaxDynamicSharedMemorySize, (int)kDynLds);
    (void)hipOccupancyMaxActiveBlocksPerMultiprocessor(&per_cu, mega, 512, kDynLds);
    grid_blocks = per_cu > 0 ? cus : 0;
    if (grid_blocks > 256) grid_blocks = 256;
    grid_blocks &= ~7;
    if (grid_blocks != 256) { fprintf(stderr, "this kernel needs 256 co-resident workgroups (got %d)\n", grid_blocks); grid_blocks = 0; }
    if (ws_size < WS_END) { fprintf(stderr, "workspace too small: %zu < %zu\n", ws_size, (size_t)WS_END); grid_blocks = 0; }
  }
  if (grid_blocks <= 0) return;
  Params p{};
  const float** pp = (const float**)&p;
  for (int i = 0; i < 24; ++i) pp[i] = (const float*)d_in[i];
  p.out = (float*)d_out; p.ws = (char*)d_ws;
  (void)hipMemsetAsync((char*)d_ws + WS_BAR, 0, WS_BAR_BYTES, stream);
  void* args[] = {&p};
  hipError_t e = hipLaunchCooperativeKernel((void*)mega, dim3(grid_blocks), dim3(512), args, kDynLds, stream);
  if (e != hipSuccess) fprintf(stderr, "cooperative launch failed: %s (grid %d)\n", hipGetErrorString(e), grid_blocks);
}
```
